# Optimizing an MI355X kernel written in HIP

```python
import jax, jax.numpy as jnp
from jax import lax
import numpy as np

D_MODEL = 2048
BATCH = 2
SEQ = 4096
DEPTH = 4
DEC_BATCH = 8
DEC_SEQ = 4
PAST_LEN = 16384
PAGE_SIZE = 128

F32 = jnp.float32
L_EVEN = (DEPTH + 1) // 2
L_ODD = DEPTH // 2
ALPHA = (2 * DEPTH) ** 0.25
BETA = (8 * DEPTH) ** -0.25
LN_EPS = 1e-5
A_HEADS = 12
A_HEAD_DIM = 64
A_WIDTH = A_HEADS * A_HEAD_DIM
A_LORA_W = 64
A_LORA_A = 64
A_SHIFT_W = 3 * A_WIDTH + A_LORA_W + A_LORA_A
A_GN_EPS = 64e-5
B_CONFIGS = ((128, 1), (512, 4), (2048, 16))
B_GROUPS = 3
B_HEADS_PER_GROUP = 4
B_HEAD_DIM = 64
B_WIDTH = B_GROUPS * B_HEADS_PER_GROUP * B_HEAD_DIM
B_OUT = B_HEADS_PER_GROUP * B_HEAD_DIM
C_HEADS = 6
C_HEAD_DIM = 256
C_WIDTH = C_HEADS * C_HEAD_DIM
C_CHUNK = 128
C_ROT_BASE = 10000.0
C_NORM_EPS = 1e-6
M_TOKENS = 256
M_HEADS = 4
M_HEAD_DIM = 128
M_WIDTH = M_HEADS * M_HEAD_DIM
EVEN_IN = A_SHIFT_W + A_WIDTH + 3 * B_WIDTH + B_OUT + 2 * M_WIDTH
EVEN_OUT = A_WIDTH + B_OUT + M_WIDTH
ODD_IN = 4 * C_WIDTH + 2 * M_WIDTH
ODD_OUT = C_WIDTH + M_WIDTH

kernel_name = 'rwkv7_dilated_retention_hybrid_step'


def _split(h, sizes):
    return jnp.split(h, np.cumsum(sizes)[:-1].tolist(), axis=-1)


def layer_norm(x, g, b):
    xf = x.astype(F32)
    mu = jnp.mean(xf, -1, keepdims=True)
    var = jnp.mean(jnp.square(xf - mu), -1, keepdims=True)
    return (xf - mu) * lax.rsqrt(var + LN_EPS) * g + b


def _softmax_with_lse(s, mask):
    s = jnp.where(mask, s, -jnp.inf)
    m = jnp.max(s, -1, keepdims=True)
    e = jnp.exp(s - m)
    l = jnp.sum(e, -1, keepdims=True)
    return e / l, (m + jnp.log(l))[..., 0]


def rwkv7_mix(hs, s0, w0, w_up, a0, a_up, k_k, k_a, r_k, lnx_g, lnx_b):
    bn, t, _ = hs.shape
    r, k, v, hw, ha = _split(hs, (A_WIDTH, A_WIDTH, A_WIDTH, A_LORA_W, A_LORA_A))
    w_log = -jax.nn.softplus(-(w0 + jnp.tanh(hw) @ w_up).astype(F32)) - 0.5
    decay = jnp.exp(-jnp.exp(w_log))
    a = jax.nn.sigmoid(a0 + ha @ a_up)
    heads = lambda z: z.reshape(bn, t, A_HEADS, A_HEAD_DIM).astype(F32)
    kk = heads(k * k_k)
    kk = kk * lax.rsqrt(jnp.maximum(jnp.sum(kk * kk, -1, keepdims=True), 1e-24))
    k = k * (1.0 + (a - 1.0) * k_a)
    r_h, k_h, v_h, a_h, d_h = heads(r), heads(k), heads(v), heads(a), heads(decay)

    def step(S, inp):
        r_t, d_t, k_t, v_t, kk_t, a_t = inp
        sa = jnp.einsum('bhij,bhj->bhi', S, -kk_t)
        S = S * d_t[:, :, None, :] + sa[..., None] * (kk_t * a_t)[:, :, None, :] + v_t[..., None] * k_t[:, :, None, :]
        return S, jnp.einsum('bhij,bhj->bhi', S, r_t)

    xs = tuple(jnp.swapaxes(z, 0, 1) for z in (r_h, d_h, k_h, v_h, kk, a_h))
    s_new, y = lax.scan(step, s0.astype(F32), xs)
    y = jnp.swapaxes(y, 0, 1)
    mu = jnp.mean(y, -1, keepdims=True)
    var = jnp.mean(jnp.square(y - mu), -1, keepdims=True)
    y = ((y - mu) * lax.rsqrt(var + A_GN_EPS)).reshape(bn, t, A_WIDTH) * lnx_g + lnx_b
    bonus = jnp.sum(r_h * k_h * r_k, -1, keepdims=True) * v_h
    return y + bonus.reshape(bn, t, A_WIDTH), s_new


def dilated_window_prompt(q, k, v, window, dilation):
    bn, s_len, nh, dh = q.shape
    blk = window // dilation
    unit = blk * dilation
    s_pad = -(-s_len // unit) * unit
    n_blk = s_pad // unit

    def fold(z):
        z = jnp.pad(z, ((0, 0), (0, s_pad - s_len), (0, 0), (0, 0)))
        return z.reshape(bn, n_blk, blk, dilation, nh, dh)

    qb, kb, vb = fold(q), fold(k), fold(v)
    prev = lambda z: jnp.concatenate([jnp.zeros_like(z[:, :1]), z[:, :-1]], axis=1)
    kw = jnp.concatenate([prev(kb), kb], axis=2)
    vw = jnp.concatenate([prev(vb), vb], axis=2)
    s = jnp.einsum('bnirhd,bnjrhd->bnrhij', qb, kw).astype(F32) * dh ** -0.5
    i = jnp.arange(blk)[:, None]
    j = jnp.arange(2 * blk)[None, :]
    band = (j >= i) & (j <= i + blk)
    has_prev = (jnp.arange(n_blk) > 0)[:, None, None] | (j >= blk)[None]
    mask = (band[None] & has_prev)[None, :, None, None]
    p, lse = _softmax_with_lse(s, mask)
    o = jnp.einsum('bnrhij,bnjrhd->bnirhd', p.astype(vw.dtype), vw)
    o = o.reshape(bn, s_pad, nh, dh)[:, :s_len]
    lse = jnp.transpose(lse, (0, 1, 4, 2, 3)).reshape(bn, s_pad, nh)[:, :s_len]
    return o, lse


def dilated_window_decode(q, k, v, buf, window, dilation):
    L = buf.shape[1]
    t = q.shape[1]
    dh = q.shape[-1]
    keys = jnp.concatenate([buf[:, :, 0], k.astype(buf.dtype)], axis=1)
    vals = jnp.concatenate([buf[:, :, 1], v.astype(buf.dtype)], axis=1)
    n_keys = window // dilation + 1
    idx = L + jnp.arange(t)[:, None] - dilation * jnp.arange(n_keys)[None, :]
    valid = idx >= 0
    idx = jnp.maximum(idx, 0)
    kg, vg = keys[:, idx], vals[:, idx]
    s = jnp.einsum('nthd,ntjhd->nthj', q, kg).astype(F32) * dh ** -0.5
    p, lse = _softmax_with_lse(s, valid[None, :, None, :])
    o = jnp.einsum('nthj,ntjhd->nthd', p.astype(vg.dtype), vg)
    return o, lse


def combine_by_denominator(outs, lses):
    wts = jax.nn.softmax(jnp.stack(lses, 0), axis=0)
    return jnp.sum(wts[..., None] * jnp.stack(outs, 0).astype(F32), axis=0)


def memory_attention(q, mkv):
    s = jnp.einsum('bthd,bmhd->bhtm', q, mkv[:, :, 0]).astype(F32) * M_HEAD_DIM ** -0.5
    p = jax.nn.softmax(s, axis=-1)
    return jnp.einsum('bhtm,bmhd->bthd', p.astype(mkv.dtype), mkv[:, :, 1])


def retention_rotate(z, pos):
    angle = 1.0 / (C_ROT_BASE ** jnp.linspace(0.0, 1.0, C_HEAD_DIM // 2, dtype=F32))
    ph = pos[:, None] * jnp.repeat(angle, 2)[None]
    sin, cos = jnp.sin(ph)[None, :, None], jnp.cos(ph)[None, :, None]
    rot = jnp.stack([-z[..., 1::2], z[..., 0::2]], axis=-1).reshape(z.shape)
    return z.astype(F32) * cos + rot.astype(F32) * sin


def retention_chunked(q, k, v, r0):
    bn, t, nh, dk = q.shape
    chunk = C_CHUNK if t % C_CHUNK == 0 else t
    n = t // chunk
    lg = jnp.log(1.0 - 2.0 ** (-5.0 - jnp.arange(nh, dtype=F32)))
    idx = jnp.arange(chunk, dtype=F32)
    diff = idx[:, None] - idx[None, :]
    dmat = jnp.where(diff >= 0, jnp.exp(lg[:, None, None] * jnp.maximum(diff, 0.0)), 0.0)
    xi = jnp.exp(lg[None, :] * (idx[:, None] + 1.0))
    zeta = jnp.exp(lg[None, :] * (chunk - 1.0 - idx[:, None]))
    g_chunk = jnp.exp(lg * chunk)
    to_chunks = lambda z: jnp.moveaxis(z.astype(F32).reshape(bn, n, chunk, nh, z.shape[-1]), 1, 0)

    def step(R, inp):
        qc, kc, vc = inp
        sc = jnp.einsum('bihd,bjhd->bhij', qc, kc) * dmat[None]
        o = jnp.einsum('bhij,bjhe->bihe', sc, vc) + jnp.einsum('bihd,bhde->bihe', qc, R) * xi[None, :, :, None]
        R = R * g_chunk[None, :, None, None] + jnp.einsum('bjhd,bjhe->bhde', kc * zeta[None, :, :, None], vc)
        return R, o

    r_new, o = lax.scan(step, r0.astype(F32), (to_chunks(q), to_chunks(k), to_chunks(v)))
    return jnp.moveaxis(o, 0, 1).reshape(bn, t, nh, v.shape[-1]), r_new


def even_layer(x, mkv, dwa_bufs, s0, shift0, w_in, w_out, ln_g, ln_b, mu, w0, w_up, a0, a_up, k_k, k_a, r_k, lnx_g, lnx_b):
    bn, t, _ = x.shape
    h = x @ w_in
    h_sh, gate_a, q_b, k_b, v_b, gate_b, q_m, gate_m = _split(
        h, (A_SHIFT_W, A_WIDTH, B_WIDTH, B_WIDTH, B_WIDTH, B_OUT, M_WIDTH, M_WIDTH))
    prev = jnp.concatenate([shift0[:, None].astype(h_sh.dtype), h_sh[:, :-1]], axis=1)
    y_a, s_new = rwkv7_mix(h_sh + (prev - h_sh) * mu, s0, w0, w_up, a0, a_up, k_k, k_a, r_k, lnx_g, lnx_b)
    grp = lambda z: z.reshape(bn, t, B_GROUPS, B_HEADS_PER_GROUP, B_HEAD_DIM)
    q_b, k_b, v_b = grp(q_b), grp(k_b), grp(v_b)
    outs, lses, rows = [], [], []
    for g, (win, dil) in enumerate(B_CONFIGS):
        qg, kg, vg = q_b[:, :, g], k_b[:, :, g], v_b[:, :, g]
        if dwa_bufs is None:
            o, lse = dilated_window_prompt(qg, kg, vg, win, dil)
            keep = min(win, t)
            rows.append(jnp.stack([kg[:, t - keep:], vg[:, t - keep:]], axis=2))
        else:
            o, lse = dilated_window_decode(qg, kg, vg, dwa_bufs[g], win, dil)
            rows.append(jnp.stack([kg, vg], axis=2))
        outs.append(o)
        lses.append(lse)
    y_b = combine_by_denominator(outs, lses).reshape(bn, t, B_OUT)
    y_m = memory_attention(q_m.reshape(bn, t, M_HEADS, M_HEAD_DIM), mkv).reshape(bn, t, M_WIDTH)
    u = jnp.concatenate([y_a * jax.nn.silu(gate_a), y_b * jax.nn.silu(gate_b), y_m * jax.nn.silu(gate_m)], axis=-1).astype(x.dtype)
    x = layer_norm(ALPHA * x + u @ w_out, ln_g, ln_b)
    return x, s_new, h_sh[:, -1], rows


def odd_layer(x, mkv, r0, pos0, w_in, w_out, ln_g, ln_b):
    bn, t, _ = x.shape
    h = x @ w_in
    q, k, v, g, q_m, g_m = _split(h, (C_WIDTH, C_WIDTH, C_WIDTH, C_WIDTH, M_WIDTH, M_WIDTH))
    heads = lambda z: z.reshape(bn, t, C_HEADS, C_HEAD_DIM)
    pos = jnp.arange(t, dtype=F32) + pos0
    q = retention_rotate(heads(q), pos)
    k = retention_rotate(heads(k), pos) * C_HEAD_DIM ** -0.5
    y, r_new = retention_chunked(q, k, heads(v), r0)
    y = y * lax.rsqrt(jnp.mean(y * y, -1, keepdims=True) + C_NORM_EPS)
    y_m = memory_attention(q_m.reshape(bn, t, M_HEADS, M_HEAD_DIM), mkv).reshape(bn, t, M_WIDTH)
    u = jnp.concatenate([y.reshape(bn, t, C_WIDTH) * jax.nn.silu(g), y_m * jax.nn.silu(g_m)], axis=-1).astype(x.dtype)
    x = layer_norm(ALPHA * x + u @ w_out, ln_g, ln_b)
    return x, r_new


def setup_inputs(seed: int = 0) -> dict:
    key = jax.random.key(seed)
    ks = iter(jax.random.split(key, 40))

    def nrm(shape, scale=1.0):
        return jax.random.normal(next(ks), shape, F32) * scale

    d = D_MODEL
    rows = [min(w, PAST_LEN) for w, _ in B_CONFIGS]
    return {
        'x_prompt': nrm((BATCH, SEQ, d)),
        'x_sample': nrm((DEC_BATCH, DEC_SEQ, d)),
        'state_rwkv': nrm((L_EVEN, DEC_BATCH, A_HEADS, A_HEAD_DIM, A_HEAD_DIM), 0.5),
        'state_rwkv_shift': nrm((L_EVEN, DEC_BATCH, A_SHIFT_W)),
        'cache_dwa_g0': nrm((L_EVEN, DEC_BATCH, rows[0], 2, B_HEADS_PER_GROUP, B_HEAD_DIM)),
        'cache_dwa_g1': nrm((L_EVEN, DEC_BATCH, rows[1], 2, B_HEADS_PER_GROUP, B_HEAD_DIM)),
        'cache_dwa_g2': nrm((L_EVEN, DEC_BATCH, rows[2], 2, B_HEADS_PER_GROUP, B_HEAD_DIM)),
        'state_ret': nrm((L_ODD, DEC_BATCH, C_HEADS, C_HEAD_DIM, C_HEAD_DIM), 0.5),
        'cache_mem_kv': nrm((DEPTH, DEC_BATCH, M_TOKENS, 2, M_HEADS, M_HEAD_DIM)),
        'mem_prompt': nrm((BATCH, M_TOKENS, d)),
        'w_in_even': nrm((L_EVEN, d, EVEN_IN), d ** -0.5),
        'w_out_even': nrm((L_EVEN, EVEN_OUT, d), BETA * EVEN_OUT ** -0.5),
        'w_in_odd': nrm((L_ODD, d, ODD_IN), d ** -0.5),
        'w_out_odd': nrm((L_ODD, ODD_OUT, d), BETA * ODD_OUT ** -0.5),
        'w_mem_kv': nrm((DEPTH, d, 2 * M_WIDTH), d ** -0.5),
        'ln_g': 1.0 + nrm((DEPTH, d), 0.02),
        'ln_b': nrm((DEPTH, d), 0.02),
        'rwkv_mu': jax.random.uniform(next(ks), (L_EVEN, A_SHIFT_W), F32),
        'rwkv_w0': jnp.linspace(-6.0, -1.0, A_WIDTH, dtype=F32)[None] + nrm((L_EVEN, A_WIDTH), 0.1),
        'rwkv_w_up': nrm((L_EVEN, A_LORA_W, A_WIDTH), 0.1),
        'rwkv_a0': nrm((L_EVEN, A_WIDTH), 0.1),
        'rwkv_a_up': nrm((L_EVEN, A_LORA_A, A_WIDTH), A_LORA_A ** -0.5),
        'rwkv_k_k': 0.85 + nrm((L_EVEN, A_WIDTH), 0.02),
        'rwkv_k_a': 1.0 + nrm((L_EVEN, A_WIDTH), 0.02),
        'rwkv_r_k': nrm((L_EVEN, A_HEADS, A_HEAD_DIM), 0.1),
        'rwkv_lnx_g': 1.0 + nrm((L_EVEN, A_WIDTH), 0.02),
        'rwkv_lnx_b': nrm((L_EVEN, A_WIDTH), 0.02),
    }


def reference(x_prompt, x_sample, state_rwkv, state_rwkv_shift, cache_dwa_g0, cache_dwa_g1, cache_dwa_g2, state_ret, cache_mem_kv, mem_prompt, w_in_even, w_out_even, w_in_odd, w_out_odd, w_mem_kv, ln_g, ln_b, rwkv_mu, rwkv_w0, rwkv_w_up, rwkv_a0, rwkv_a_up, rwkv_k_k, rwkv_k_a, rwkv_r_k, rwkv_lnx_g, rwkv_lnx_b):
    xp, xs = x_prompt, x_sample
    bp = xp.shape[0]
    dwa_cache = (cache_dwa_g0, cache_dwa_g1, cache_dwa_g2)
    rwkv_p, rwkv_s, shift_p, shift_s, ret_p, ret_s, mem_p = [], [], [], [], [], [], []
    dwa_p = [[] for _ in B_CONFIGS]
    dwa_s = [[] for _ in B_CONFIGS]
    for l in range(DEPTH):
        mkv_p = (mem_prompt @ w_mem_kv[l]).reshape(bp, M_TOKENS, 2, M_HEADS, M_HEAD_DIM)
        mem_p.append(mkv_p)
        mkv_s = cache_mem_kv[l]
        if l % 2 == 0:
            e = l // 2
            prm = (w_in_even[e], w_out_even[e], ln_g[l], ln_b[l], rwkv_mu[e], rwkv_w0[e], rwkv_w_up[e], rwkv_a0[e],
                   rwkv_a_up[e], rwkv_k_k[e], rwkv_k_a[e], rwkv_r_k[e], rwkv_lnx_g[e], rwkv_lnx_b[e])
            s0 = jnp.zeros((bp, A_HEADS, A_HEAD_DIM, A_HEAD_DIM), F32)
            sh0 = jnp.zeros((bp, A_SHIFT_W), xp.dtype)
            xp, st, sh, rows = even_layer(xp, mkv_p, None, s0, sh0, *prm)
            rwkv_p.append(st)
            shift_p.append(sh)
            for g in range(B_GROUPS):
                dwa_p[g].append(rows[g])
            bufs = tuple(c[e] for c in dwa_cache)
            xs, st, sh, rows = even_layer(xs, mkv_s, bufs, state_rwkv[e], state_rwkv_shift[e], *prm)
            rwkv_s.append(st)
            shift_s.append(sh)
            for g in range(B_GROUPS):
                dwa_s[g].append(rows[g])
        else:
            o = l // 2
            prm = (w_in_odd[o], w_out_odd[o], ln_g[l], ln_b[l])
            r0 = jnp.zeros((bp, C_HEADS, C_HEAD_DIM, C_HEAD_DIM), F32)
            xp, st = odd_layer(xp, mkv_p, r0, 0, *prm)
            ret_p.append(st)
            xs, st = odd_layer(xs, mkv_s, state_ret[o], PAST_LEN, *prm)
            ret_s.append(st)
    y_prompt, y_sample = xp, xs
    new_rwkv_prompt, new_rwkv_sample = jnp.stack(rwkv_p), jnp.stack(rwkv_s)
    new_shift_prompt, new_shift_sample = jnp.stack(shift_p), jnp.stack(shift_s)
    new_dwa_g0_prompt, new_dwa_g0_sample = jnp.stack(dwa_p[0]), jnp.stack(dwa_s[0])
    new_dwa_g1_prompt, new_dwa_g1_sample = jnp.stack(dwa_p[1]), jnp.stack(dwa_s[1])
    new_dwa_g2_prompt, new_dwa_g2_sample = jnp.stack(dwa_p[2]), jnp.stack(dwa_s[2])
    new_ret_prompt, new_ret_sample = jnp.stack(ret_p), jnp.stack(ret_s)
    new_mem_kv_prompt = jnp.stack(mem_p)
    return (y_prompt, y_sample, new_rwkv_prompt, new_rwkv_sample, new_shift_prompt, new_shift_sample, new_dwa_g0_prompt, new_dwa_g0_sample, new_dwa_g1_prompt, new_dwa_g1_sample, new_dwa_g2_prompt, new_dwa_g2_sample, new_ret_prompt, new_ret_sample, new_mem_kv_prompt)
```

```cpp
#include <hip/hip_runtime.h>
#include <hip/hip_cooperative_groups.h>
#include <cstdio>
#include <cstdint>
namespace cg = cooperative_groups;
#ifndef DIS
#define DIS 0
#endif
#ifndef REPD
#define REPD 1
#endif
#ifndef REPM
#define REPM 1
#endif
#ifndef REPC
#define REPC 1
#endif
#ifndef REPS
#define REPS 1
#endif
#ifndef REP9
#define REP9 1
#endif
#ifndef REP3
#define REP3 1
#endif
#ifndef REP8
#define REP8 1
#endif
#ifndef REP1
#define REP1 1
#endif
#ifndef DUP
#define DUP 0
#endif
#ifndef USE_CG
#define USE_CG 0
#endif
#ifndef ONE_LAUNCH
#define ONE_LAUNCH 1
#endif
namespace pg8 {
#define PG8_LAS __attribute__((address_space(3)))
typedef unsigned short bf16_t;
typedef short bf16x8 __attribute__((ext_vector_type(8)));
typedef float f32x4 __attribute__((ext_vector_type(4)));
typedef unsigned u32x4 __attribute__((ext_vector_type(4)));
constexpr int BM = 256, BK = 64, HALF = 128, HTB = HALF * BK * 2  , STAGE_BYTES = 8 * HTB, NXCD = 8, WGM = 8;

__host__ __device__ __forceinline__ int lds_byte(int r, int c) { const int st = (r >> 4) * 2 + (c >> 5), rr = r & 15, cc = c & 31, ob = rr * 64 + cc * 2; return st * 1024 + (ob ^ (((ob >> 9) & 1) << 5)); }
__host__ __device__ __forceinline__ void stage_rc(int b, int& R, int& C) { const int st = b / 1024, sb = b % 1024, swz = sb ^ (((sb >> 9) & 1) << 5); R = (st >> 1) * 16 + swz / 64; C = (st & 1) * 32 + (swz % 64) / 2; }
__host__ __device__ __forceinline__ int perm32(int rho) { const int n = rho >> 4, i = rho & 15; return 8 * (i >> 2) + 4 * n + (i & 3); }

struct Unit { int pm, pn; };
struct Gemm { const bf16_t* A; const bf16_t* Bt; int M, N, K; };

struct StaticOrder {
    int nM, nN, nwg, G, c;
    __host__ __device__ void init(int M, int N, int G_, int c_) { nM = M / BM; nN = N / BM; nwg = nM * nN; G = G_; c = c_; }
    __host__ __device__ bool next(int i, Unit& u) const {
        const long L = (long)i * G + c; if (L >= nwg) return false;
        int wgid = (int)L; { const int q = nwg / NXCD, r = nwg % NXCD, xcd = wgid % NXCD, off = wgid / NXCD; wgid = (xcd < r ? xcd * (q + 1) : r * (q + 1) + (xcd - r) * q) + off; }
        const int nig = WGM * nN, gid = wgid / nig, fm = gid * WGM, gsz = (nM - fm) < WGM ? (nM - fm) : WGM;
        u.pm = fm + ((wgid % nig) % gsz); u.pn = (wgid % nig) / gsz; return true;
    }
    __device__ __forceinline__ void a_ready(const Unit&) const {}
    __device__ __forceinline__ void done(const Unit&) const {}
};

__device__ __forceinline__ unsigned cvt_pk_bf16(float lo, float hi) { unsigned r; asm volatile("v_cvt_pk_bf16_f32 %0, %1, %2" : "=v"(r) : "v"(lo), "v"(hi)); return r; }
typedef float f32x2 __attribute__((ext_vector_type(2)));
__device__ __forceinline__ f32x2 gelu_pk(f32x2 v) {
    const f32x2 av = __builtin_elementwise_abs(v), d = av * 0.2316418882f + 1.0f;
    f32x2 t; t.x = __builtin_amdgcn_rcpf(d.x); t.y = __builtin_amdgcn_rcpf(d.y);
    f32x2 q = t * 0.5307027145f + (-0.7265760135f); q = q * t + 0.7107068705f; q = q * t + (-0.142248368f); q = q * t + 0.127414796f; q = q * t;
    const f32x2 s = (v * v) * (-0.72134752044f);
    f32x2 e; e.x = __builtin_amdgcn_exp2f(s.x); e.y = __builtin_amdgcn_exp2f(s.y);
    const f32x2 m = v * (q * e), r = v - m;
    f32x2 o; o.x = v.x < 0.f ? m.x : r.x; o.y = v.y < 0.f ? m.y : r.y; return o;
}

template <int ACT  > struct EpiBf16 {
    static constexpr bool PERM = true, AFTER_DRAIN = false; static_assert(ACT == 0 || ACT == 1, "EpiBf16: ACT is 0 (none) or 1 (gelu_pk)");
    bf16_t* O; int ldc; const float* bias; int split_cols; size_t split_stride; float scale0;
    __device__ __forceinline__ void operator()(const f32x4 (&acc)[2][2][4][2], const Unit& u, int wr, int wc, int fr, int fq) const {
        const int row0 = u.pm * BM + wr * 64 + fr; int colt = u.pn * BM; bf16_t* base = O;
        float sc = 1.f; if (split_cols) { const int t = colt / split_cols; base += (size_t)t * split_stride; colt -= t * split_cols; if (t == 0) sc = scale0; }
        const int col0 = colt + wc * 32 + 8 * fq, bcol0 = u.pn * BM + wc * 32 + 8 * fq;
        f32x4 bv[2][2];
#pragma unroll
        for (int bj = 0; bj < 2; ++bj)
#pragma unroll
            for (int n = 0; n < 2; ++n) bv[bj][n] = bias ? *(const f32x4*)(bias + bcol0 + bj * HALF + 4 * n) : (f32x4){0.f, 0.f, 0.f, 0.f};
#pragma unroll
        for (int ai = 0; ai < 2; ++ai)
#pragma unroll
            for (int m = 0; m < 4; ++m) { bf16_t* rowp = base + (size_t)(row0 + ai * HALF + m * 16) * ldc + col0;
#pragma unroll
                for (int bj = 0; bj < 2; ++bj) { f32x4 v0 = acc[ai][bj][m][0] + bv[bj][0], v1 = acc[ai][bj][m][1] + bv[bj][1];
                    if (ACT == 1) { f32x2 a = gelu_pk((f32x2){v0[0], v0[1]}), b = gelu_pk((f32x2){v0[2], v0[3]}), c = gelu_pk((f32x2){v1[0], v1[1]}), d = gelu_pk((f32x2){v1[2], v1[3]});
                        v0 = (f32x4){a.x, a.y, b.x, b.y}; v1 = (f32x4){c.x, c.y, d.x, d.y}; }
                    v0 = v0 * sc; v1 = v1 * sc; u32x4 w; w.x = cvt_pk_bf16(v0[0], v0[1]); w.y = cvt_pk_bf16(v0[2], v0[3]); w.z = cvt_pk_bf16(v1[0], v1[1]); w.w = cvt_pk_bf16(v1[2], v1[3]);
                    *(u32x4*)(rowp + bj * HALF) = w; } }
    }
};
struct EpiF32Split {
    static constexpr bool PERM = false, AFTER_DRAIN = false;
    float* C; int ldc; int split_cols; size_t split_stride; bf16_t* MB;
    __device__ __forceinline__ void operator()(const f32x4 (&acc)[2][2][4][2], const Unit& u, int wr, int wc, int fr, int fq) const {
        typedef unsigned u32x2v __attribute__((ext_vector_type(2)));
        int colt = u.pn * BM; float* base = C; bf16_t* mb = MB;
        if (split_cols) { const int t = colt / split_cols; base += (size_t)t * split_stride; mb += (size_t)t * split_stride; colt -= t * split_cols; }
        const int row0 = u.pm * BM + wr * 64 + fr, col0 = colt + wc * 32 + 4 * fq;
#pragma unroll
        for (int ai = 0; ai < 2; ++ai)
#pragma unroll
            for (int m = 0; m < 4; ++m) { float* rowp = base + (size_t)(row0 + ai * HALF + m * 16) * ldc + col0; bf16_t* rowb = mb + (size_t)(row0 + ai * HALF + m * 16) * ldc + col0;
#pragma unroll
                for (int bj = 0; bj < 2; ++bj)
#pragma unroll
                    for (int n = 0; n < 2; ++n) { const f32x4 v = acc[ai][bj][m][n]; *(f32x4*)(rowp + bj * HALF + n * 16) = v;
                        u32x2v w; w.x = cvt_pk_bf16(v[0], v[1]); w.y = cvt_pk_bf16(v[2], v[3]); *(u32x2v*)(rowb + bj * HALF + n * 16) = w; } }
    }
};
struct EpiBf16NP {
    static constexpr bool PERM = false, AFTER_DRAIN = false;
    bf16_t* O; int ldc; const float* TAB; int rot_cols, kcol0;
    __device__ __forceinline__ void operator()(const f32x4 (&acc)[2][2][4][2], const Unit& u, int wr, int wc, int fr, int fq) const {
        typedef unsigned u32x2v __attribute__((ext_vector_type(2)));
        const int row0 = u.pm * BM + wr * 64 + fr, col0 = u.pn * BM + wc * 32 + 4 * fq;
        const bool rot = u.pn * BM < rot_cols; const float scl = (u.pn * BM >= kcol0) ? 0.0625f : 1.0f;
#pragma unroll
        for (int ai = 0; ai < 2; ++ai)
#pragma unroll
            for (int m = 0; m < 4; ++m) { const int row = row0 + ai * HALF + m * 16; bf16_t* rowp = O + (size_t)row * ldc + col0;
                const int p = row < 8192 ? (row & 4095) : (row < 8224 ? 4096 + ((row - 8192) & 3) : 0);
                const float* tb = TAB + ((size_t)p * 128 + ((col0 & 255) >> 1)) * 2;
#pragma unroll
                for (int bj = 0; bj < 2; ++bj)
#pragma unroll
                    for (int n = 0; n < 2; ++n) { f32x4 v = acc[ai][bj][m][n];
                        if (rot) { const f32x4 cs = *(const f32x4*)(tb + bj * HALF + n * 16);
                            v = (f32x4){(v[0] * cs[0] - v[1] * cs[1]) * scl, (v[1] * cs[0] + v[0] * cs[1]) * scl, (v[2] * cs[2] - v[3] * cs[3]) * scl, (v[3] * cs[2] + v[2] * cs[3]) * scl}; }
                        u32x2v w; w.x = cvt_pk_bf16(v[0], v[1]); w.y = cvt_pk_bf16(v[2], v[3]); *(u32x2v*)(rowp + bj * HALF + n * 16) = w; } }
    }
};
struct EpiResid {
    static constexpr bool PERM = false, AFTER_DRAIN = false;
    const float* __restrict__ X; float* __restrict__ Z; int ldc; float alpha;
    __device__ __forceinline__ void operator()(const f32x4 (&acc)[2][2][4][2], const Unit& u, int wr, int wc, int fr, int fq) const {
        const int row0 = u.pm * BM + wr * 64 + fr, col0 = u.pn * BM + wc * 32 + 4 * fq;
#pragma unroll
        for (int ai = 0; ai < 2; ++ai)
#pragma unroll
            for (int mp = 0; mp < 2; ++mp) { f32x4 xv[2][2][2];
#pragma unroll
                for (int mm = 0; mm < 2; ++mm) { const float* rowp = X + (size_t)(row0 + ai * HALF + (2 * mp + mm) * 16) * ldc + col0;
#pragma unroll
                    for (int bj = 0; bj < 2; ++bj)
#pragma unroll
                        for (int n = 0; n < 2; ++n) xv[mm][bj][n] = *(const f32x4*)(rowp + bj * HALF + n * 16); }
#pragma unroll
                for (int mm = 0; mm < 2; ++mm) { float* rowz = Z + (size_t)(row0 + ai * HALF + (2 * mp + mm) * 16) * ldc + col0;
#pragma unroll
                    for (int bj = 0; bj < 2; ++bj)
#pragma unroll
                        for (int n = 0; n < 2; ++n) *(f32x4*)(rowz + bj * HALF + n * 16) = xv[mm][bj][n] * alpha + acc[ai][bj][2 * mp + mm][n]; } }
    }
};
template <class Epi, class Sched, bool ALIGN_EPI = false, bool SP2 = false>
__device__ __forceinline__ void gemm_phase(PG8_LAS unsigned char* lds, const Gemm g, const Sched& S, const Epi& E) {
    int tid_ = threadIdx.x; asm volatile("" : "+v"(tid_));
    const int tid = tid_, wid = __builtin_amdgcn_readfirstlane(tid >> 6), lane = tid & 63, wr = wid >> 2, wc = wid & 3, fr = lane & 15, fq = lane >> 4;
    const int K = g.K, nt = K / BK;
    unsigned voffA[2], voffB[2];
#pragma unroll
    for (int i = 0; i < 2; ++i) { int R, C; stage_rc(tid * 16 + i * 8192, R, C); const int Rb = Epi::PERM ? ((R & ~31) + perm32(R & 31)) : R;
        voffA[i] = (unsigned)(R * K + C) * 2u; voffB[i] = (unsigned)(Rb * K + C) * 2u; }
    const size_t kstep = (size_t)(BK * 2);
    const size_t hstep = (size_t)HALF * K * 2;
    const size_t tstep = 2 * hstep;
    const unsigned ldsw = (unsigned)wid * 1024u;
    const int aoff = lds_byte(wr * 64 + fr, fq * 8), boff = lds_byte(wc * 32 + fr, fq * 8);
#define PG8_SA(b, h) (((b) * 2 + (h)) * HTB)
#define PG8_SB(b, h) ((4 + (b) * 2 + (h)) * HTB)
#define PG8_STAGE(bufoff, gbase, voff) do { _Pragma("unroll") for (int _i = 0; _i < 2; ++_i) \
        __builtin_amdgcn_global_load_lds((const unsigned*)((const char*)(gbase) + (voff)[_i]), (PG8_LAS unsigned*)(lds + (bufoff) + ldsw + _i * 8192), 16, 0, 0); } while (0)
#define PG8_LDA(dst, b, h) do { _Pragma("unroll") for (int m = 0; m < 4; ++m) _Pragma("unroll") for (int k = 0; k < 2; ++k) dst[m][k] = *(const PG8_LAS bf16x8*)(lds + PG8_SA(b, h) + aoff + m * 2048 + k * 1024); } while (0)
#define PG8_LDB(dst, b, h) do { _Pragma("unroll") for (int n = 0; n < 2; ++n) _Pragma("unroll") for (int k = 0; k < 2; ++k) dst[n][k] = *(const PG8_LAS bf16x8*)(lds + PG8_SB(b, h) + boff + n * 2048 + k * 1024); } while (0)
#define PG8_MMA(ai, bj, At, Bt) do { __builtin_amdgcn_s_setprio(1); _Pragma("unroll") for (int m = 0; m < 4; ++m) _Pragma("unroll") for (int n = 0; n < 2; ++n) _Pragma("unroll") for (int k = 0; k < 2; ++k) \
        acc[ai][bj][m][n] = __builtin_amdgcn_mfma_f32_16x16x32_bf16(Bt[n][k], At[m][k], acc[ai][bj][m][n], 0, 0, 0); __builtin_amdgcn_s_setprio(0); } while (0)
#define PG8_WAIT_V(n) asm volatile("s_waitcnt vmcnt(" #n ")" ::: "memory")
#define PG8_WAIT_L(n) asm volatile("s_waitcnt lgkmcnt(" #n ")" ::: "memory")
#define PG8_BAR __builtin_amdgcn_s_barrier()
#define PG8_SCHED __builtin_amdgcn_sched_barrier(0)
    Unit cur, nxt; int ui = 0;
    if (!S.next(0, cur)) return;
    f32x4 acc[2][2][4][2];
#pragma unroll
    for (int a = 0; a < 2; ++a)
#pragma unroll
        for (int b = 0; b < 2; ++b)
#pragma unroll
            for (int m = 0; m < 4; ++m)
#pragma unroll
                for (int n = 0; n < 2; ++n) acc[a][b][m][n] = (f32x4){0.f, 0.f, 0.f, 0.f};
    bf16x8 At[4][2], B0[2][2], B1[2][2];
    const char* cA = (const char*)g.A + (size_t)cur.pm * tstep; const char* cB = (const char*)g.Bt + (size_t)cur.pn * tstep;
    S.a_ready(cur);
    if constexpr (SP2) {
        PG8_STAGE(PG8_SB(0, 0), cB, voffB); PG8_STAGE(PG8_SB(0, 1), cB + hstep, voffB); PG8_STAGE(PG8_SA(0, 0), cA, voffA); PG8_STAGE(PG8_SA(0, 1), cA + hstep, voffA);
        if (wr == 1) PG8_BAR;
        PG8_WAIT_V(2); PG8_BAR;
        PG8_STAGE(PG8_SB(1, 0), cB + kstep, voffB); PG8_STAGE(PG8_SA(1, 0), cA + kstep, voffA); PG8_STAGE(PG8_SB(1, 1), cB + hstep + kstep, voffB);
        PG8_WAIT_V(6); PG8_BAR;
    } else {
        PG8_STAGE(PG8_SB(0, 0), cB, voffB); PG8_STAGE(PG8_SA(0, 0), cA, voffA); PG8_STAGE(PG8_SB(0, 1), cB + hstep, voffB); PG8_STAGE(PG8_SA(0, 1), cA + hstep, voffA);
        if (wr == 1) PG8_BAR;
        PG8_WAIT_V(4); PG8_BAR;
        PG8_STAGE(PG8_SB(1, 0), cB + kstep, voffB); PG8_STAGE(PG8_SA(1, 0), cA + kstep, voffA); PG8_STAGE(PG8_SB(1, 1), cB + hstep + kstep, voffB);
        PG8_WAIT_V(6); PG8_BAR;
    }
    for (;;) {
        const bool has_next = S.next(ui + 1, nxt);
        const char* nA = has_next ? (const char*)g.A + (size_t)nxt.pm * tstep : cA; const char* nB = has_next ? (const char*)g.Bt + (size_t)nxt.pn * tstep : cB;
        for (int t = 0; t < nt; t += 2) {
            const bool last = (t == nt - 2);
            const char* a1 = cA + (size_t)(t + 1) * kstep;
            const char* a2 = last ? nA : cA + (size_t)(t + 2) * kstep; const char* b2 = last ? nB : cB + (size_t)(t + 2) * kstep;
            const char* a3 = a2 + kstep; const char* b3 = b2 + kstep;
            if (last && has_next) S.a_ready(nxt);
            if constexpr (SP2) {
            PG8_LDB(B0, 0, 0); PG8_LDB(B1, 0, 1); PG8_SCHED; PG8_LDA(At, 0, 0); PG8_STAGE(PG8_SA(1, 1), a1 + hstep, voffA);
            PG8_WAIT_V(8); PG8_WAIT_L(0); PG8_BAR; PG8_MMA(0, 0, At, B0); PG8_MMA(0, 1, At, B1); PG8_BAR; PG8_SCHED;
            PG8_LDA(At, 0, 1); PG8_STAGE(PG8_SB(0, 0), b2, voffB); PG8_STAGE(PG8_SB(0, 1), b2 + hstep, voffB); PG8_STAGE(PG8_SA(0, 0), a2, voffA);
            PG8_WAIT_V(8); PG8_WAIT_L(0); PG8_BAR; PG8_MMA(1, 0, At, B0); PG8_MMA(1, 1, At, B1); PG8_BAR; PG8_SCHED;
            PG8_LDB(B0, 1, 0); PG8_LDB(B1, 1, 1); PG8_SCHED; PG8_LDA(At, 1, 0); PG8_STAGE(PG8_SA(0, 1), a2 + hstep, voffA);
            PG8_WAIT_V(8); PG8_WAIT_L(0); PG8_BAR; PG8_MMA(0, 0, At, B0); PG8_MMA(0, 1, At, B1); PG8_BAR; PG8_SCHED;
            PG8_LDA(At, 1, 1); PG8_STAGE(PG8_SB(1, 0), b3, voffB); PG8_STAGE(PG8_SB(1, 1), b3 + hstep, voffB); PG8_STAGE(PG8_SA(1, 0), a3, voffA);
            PG8_WAIT_V(8); PG8_WAIT_L(0); PG8_BAR; PG8_MMA(1, 0, At, B0); PG8_MMA(1, 1, At, B1); PG8_BAR; PG8_SCHED;
            } else {
            PG8_LDB(B0, 0, 0); PG8_SCHED; PG8_LDA(At, 0, 0); PG8_STAGE(PG8_SA(1, 1), a1 + hstep, voffA);
            PG8_WAIT_L(8); PG8_BAR; PG8_WAIT_L(0); PG8_MMA(0, 0, At, B0); PG8_BAR; PG8_SCHED;
            PG8_LDB(B1, 0, 1); PG8_STAGE(PG8_SB(0, 0), b2, voffB);
            PG8_BAR; PG8_WAIT_L(0); PG8_MMA(0, 1, At, B1); PG8_BAR;
            PG8_LDA(At, 0, 1); PG8_STAGE(PG8_SA(0, 0), a2, voffA);
            PG8_BAR; PG8_WAIT_L(0); PG8_MMA(1, 0, At, B0); PG8_BAR; PG8_SCHED;
            PG8_STAGE(PG8_SB(0, 1), b2 + hstep, voffB);
            PG8_WAIT_V(6); PG8_BAR; PG8_MMA(1, 1, At, B1); PG8_BAR;
            PG8_LDB(B0, 1, 0); PG8_SCHED; PG8_LDA(At, 1, 0); PG8_STAGE(PG8_SA(0, 1), a2 + hstep, voffA);
            PG8_WAIT_L(8); PG8_BAR; PG8_WAIT_L(0); PG8_MMA(0, 0, At, B0); PG8_BAR; PG8_SCHED;
            PG8_LDB(B1, 1, 1); PG8_STAGE(PG8_SB(1, 0), b3, voffB);
            PG8_BAR; PG8_WAIT_L(0); PG8_MMA(0, 1, At, B1); PG8_BAR;
            PG8_LDA(At, 1, 1); PG8_STAGE(PG8_SA(1, 0), a3, voffA);
            PG8_BAR; PG8_WAIT_L(0); PG8_MMA(1, 0, At, B0); PG8_BAR; PG8_SCHED;
            PG8_STAGE(PG8_SB(1, 1), b3 + hstep, voffB);
            PG8_WAIT_V(6); PG8_BAR; PG8_MMA(1, 1, At, B1); PG8_BAR;
            }
        }
        if constexpr (ALIGN_EPI) { if (wr == 0) PG8_BAR; }
        if constexpr (!Epi::AFTER_DRAIN) { E(acc, cur, wr, wc, fr, fq); S.done(cur); }
        if (!has_next) break;
#pragma unroll
        for (int a = 0; a < 2; ++a)
#pragma unroll
            for (int b = 0; b < 2; ++b)
#pragma unroll
                for (int m = 0; m < 4; ++m)
#pragma unroll
                    for (int n = 0; n < 2; ++n) acc[a][b][m][n] = (f32x4){0.f, 0.f, 0.f, 0.f};
        cur = nxt; cA = nA; cB = nB; ++ui;
        if constexpr (ALIGN_EPI) { if (wr == 1) PG8_BAR; }
    }
    PG8_WAIT_V(0);
    if constexpr (!ALIGN_EPI) { if (wr == 0) PG8_BAR; }
    PG8_BAR;
    if constexpr (Epi::AFTER_DRAIN) { E.fused(acc, cur, wr, wc, fr, fq, lds, wid, lane); S.done(cur); }
#undef PG8_SA
#undef PG8_SB
#undef PG8_STAGE
#undef PG8_LDA
#undef PG8_LDB
#undef PG8_MMA
#undef PG8_WAIT_V
#undef PG8_WAIT_L
#undef PG8_BAR
#undef PG8_SCHED
}
}
constexpr int DM = 2048, SEQ = 4096, TP = 8192, TS = 32, TT = TP + TS, MPAD = 8448;
constexpr int EVEN_IN = 6784, EVEN_INP = 6912, ODD_IN = 7168, LDH = 7168;
constexpr int EVEN_OUT = 1536, ODD_OUT = 2048;
constexpr float ALPHA = 1.6817928305074292f;
constexpr float LN_EPS = 1e-5f;
constexpr int EC_R = 0, EC_K = 768, EC_V = 1536, EC_HW = 2304, EC_HA = 2368, EC_GA = 2432, EC_QB = 3200, EC_KB = 3968, EC_VB = 4736, EC_GB = 5504, EC_QM = 5760, EC_GM = 6272;
constexpr int OC_Q = 0, OC_K = 1536, OC_V = 3072, OC_G = 4608, OC_QM = 6144, OC_GM = 6656;
constexpr size_t O_YP = 0, O_YS = 16777216, O_RWKV_P = O_YS + 65536, O_RWKV_S = O_RWKV_P + 196608, O_SH_P = O_RWKV_S + 786432, O_SH_S = O_SH_P + 9728,
    O_G0P = O_SH_S + 38912, O_G0S = O_G0P + 262144, O_G1P = O_G0S + 32768, O_G1S = O_G1P + 1048576, O_G2P = O_G1S + 32768, O_G2S = O_G2P + 4194304,
    O_RET_P = O_G2S + 32768, O_RET_S = O_RET_P + 1572864, O_MEM = O_RET_S + 6291456, O_END = O_MEM + 2097152;
constexpr size_t MiB = 1u << 20;
constexpr size_t WS_CTL = 0, WS_WTIN = 1 * MiB, WS_WTOUT = 29 * MiB, WS_WTMEM = 37 * MiB, WS_MEMB = 53 * MiB, WS_TAB = 55 * MiB, WS_XB = 60 * MiB, WS_XZ = 93 * MiB,
    WS_HB = 159 * MiB, WS_U = 275 * MiB, WS_YA = 308 * MiB, WS_PREP = 333 * MiB, WS_OG = 478 * MiB, WS_LSE = 478 * MiB + 49 * MiB / 2, WS_MKVB = 503 * MiB, WS_VT = 507 * MiB, WS_WTOUT2 = 509 * MiB, WS_END = 517 * MiB;
constexpr int LDS_BYTES = 147456;

#define LAS __attribute__((address_space(3)))
typedef unsigned short bf16;
typedef float f32x4 __attribute__((ext_vector_type(4)));
typedef short bf16x8 __attribute__((ext_vector_type(8)));
typedef unsigned u32x4 __attribute__((ext_vector_type(4)));
typedef unsigned u32x2 __attribute__((ext_vector_type(2)));

__device__ const double ANG[128] = {
1.0, 0.9300449458481392, 0.8649836012976682, 0.8044736266284181, 0.7481966305138833, 0.6958564947100448, 0.6471778159406796, 0.6019044567806663, 0.5597981979123284, 0.5206374846632574, 0.48421626123015066, 0.45034288645458387, 0.41883912544574814, 0.3895392117442728, 0.362288975092429, 0.336945030221216, 0.31337402238589046, 0.29145192568009903, 0.2710633904364836, 0.2521011362799124, 0.23446538763970548, 0.21806334875063282, 0.20280871538024622, 0.18862122071335174, 0.17542621300415914, 0.1631542627737973, 0.15174079748634942, 0.14112576178114528, 0.13125330147352265, 0.12207146966133185, 0.11353195339077617, 0.10558981944335787, 0.09820327790631257, 0.09133346228248625, 0.08494422498263796, 0.07900194712408967, 0.07347536163492155, 0.06833538873292307, 0.06355498291362295, 0.059108990642279875, 0.05497401800103736, 0.05112830759482943, 0.04755162406834012, 0.04422514763163046, 0.04113137503418572, 0.03825402746632876, 0.03557796490339495, 0.03308910644196496, 0.030774356208980617, 0.02862153445389273, 0.026619313461261302, 0.024757157946593413, 0.023025269621793302, 0.02141453563853956, 0.019916480638308563, 0.018523222156741202, 0.017227429147699425, 0.01602228340877477, 0.014901443705277463, 0.013859012403933875, 0.01288950444072537, 0.01198781845958378, 0.011149209970080915, 0.01036926638287344, 0.009643883791544459, 0.008969245378672715, 0.008341801332506338, 0.007758250168566794, 0.007215521357901014, 0.006710759170575141, 0.006241307649397462, 0.00580469663480544, 0.005398628767382501, 0.005020967399614466, 0.004669725353279709, 0.0043430544633167095, 0.0040392358531509045, 0.003756670890311596, 0.0034938727747491297, 0.0032494587155918425, 0.0030221426551783792, 0.002810728502080728, 0.002614103837511492, 0.002431234061999789, 0.002261156951536743, 0.002102977594546134, 0.0019558636830395095, 0.0018190411331788228, 0.0016917900122028363, 0.0015734407502856099, 0.0014633706173946357, 0.0013610004466105522, 0.001265791586667203, 0.001177243067676929, 0.001094888965127687, 0.0010182959482819048, 0.0009470610000772239, 0.0008808092965317064, 0.0008191922344953685, 0.0007618855973704613, 0.0007085878491488872, 0.0006590185477903263, 0.0006129168695925734, 0.0005700402367896359, 0.0005301630411562774, 0.000493075456902875, 0.00045858233661428085, 0.00042650218442334204, 0.0003966662010161199, 0.00036891739544382435, 0.0003431097590679882, 0.0003191074972923552, 0.00029678431503900375, 0.0002760227522090274, 0.00025671356563109924, 0.00023875515424585844, 0.00022205302450155334, 0.00020651929314796272, 0.00019207222481239299, 0.0001786358019245737, 0.00016613932472747905, 0.0001545170392694147, 0.0001437077914199376, 0.00013365470508911156, 0.00012430488295695166, 0.00011560912813835741, 0.00010752168531898921, 0.0001};
__device__ const float LG2G[6] = {-0.04580368961312479f, -0.02272007650008353f, -0.011315313227834146f, -0.005646563141142063f, -0.0028205190623786626f, -0.0014095702546713536f};

__device__ __forceinline__ float bf2f(unsigned b) { return __uint_as_float(b << 16); }
typedef __bf16 bf16x2_t __attribute__((ext_vector_type(2)));
typedef float f32x2_t __attribute__((ext_vector_type(2)));
__device__ __forceinline__ unsigned f2bf(float f) { return (unsigned)__builtin_bit_cast(unsigned short, (__bf16)f); }
__device__ __forceinline__ unsigned pk2(float lo, float hi) { const f32x2_t v = {lo, hi}; return __builtin_bit_cast(unsigned, __builtin_convertvector(v, bf16x2_t)); }
__device__ __forceinline__ void unpk4(u32x2 w, float (&x)[4]) { x[0] = __uint_as_float(w.x << 16); x[1] = __uint_as_float(w.x & 0xffff0000u); x[2] = __uint_as_float(w.y << 16); x[3] = __uint_as_float(w.y & 0xffff0000u); }
__device__ __forceinline__ void unpk8(u32x4 w, float (&x)[8]) {
    x[0] = __uint_as_float(w.x << 16); x[1] = __uint_as_float(w.x & 0xffff0000u); x[2] = __uint_as_float(w.y << 16); x[3] = __uint_as_float(w.y & 0xffff0000u);
    x[4] = __uint_as_float(w.z << 16); x[5] = __uint_as_float(w.z & 0xffff0000u); x[6] = __uint_as_float(w.w << 16); x[7] = __uint_as_float(w.w & 0xffff0000u); }
template <int CTRL> __device__ __forceinline__ float dppf(float x) { return __builtin_bit_cast(float, __builtin_amdgcn_update_dpp(0, __builtin_bit_cast(int, x), CTRL, 0xF, 0xF, true)); }
__device__ __forceinline__ float red16(float x) { x += dppf<0xB1>(x); x += dppf<0x4E>(x); x += dppf<0x141>(x); x += dppf<0x140>(x); return x; }
__device__ __forceinline__ float wave_sum(float x) { x = red16(x); x += __shfl_xor(x, 16); x += __shfl_xor(x, 32); return x; }
__device__ __forceinline__ float sigmoidf_(float x) { return 1.0f / (1.0f + __expf(-x)); }
__device__ __forceinline__ float siluf_(float x) { return x / (1.0f + __expf(-x)); }
#define LDS_WAIT() asm volatile("s_waitcnt lgkmcnt(0)" ::: "memory")

struct Args { const float* in[27]; float* out; unsigned char* ws; int ph_lo, ph_hi; };
typedef const __attribute__((address_space(4))) Args* ArgsP;
struct Ctx {
    ArgsP ap;
    LAS unsigned char* lds;
    int tid, lane, wave, bid, G;
};
#define C_IN(k) (c.ap->in[k])
#define C_OUT (c.ap->out)
#define C_WTIN ((bf16*)(c.ap->ws + WS_WTIN))
#define C_WTOUT_L(l_) ((bf16*)(c.ap->ws + (((l_) & 1) ? WS_WTOUT2 : WS_WTOUT)))
#define C_WTMEM ((bf16*)(c.ap->ws + WS_WTMEM))
#define C_MEMB ((bf16*)(c.ap->ws + WS_MEMB))
#define C_XB ((bf16*)(c.ap->ws + WS_XB))
#define C_HB ((bf16*)(c.ap->ws + WS_HB))
#define C_U ((bf16*)(c.ap->ws + WS_U))
#define C_TAB ((float*)(c.ap->ws + WS_TAB))
#define C_XZ ((float*)(c.ap->ws + WS_XZ))
#define C_YA ((float*)(c.ap->ws + WS_YA))
#define C_PREP ((float*)(c.ap->ws + WS_PREP))
#define C_CHK ((unsigned char*)(c.ap->ws + WS_PREP))
#define C_PREPS ((float*)(c.ap->ws + WS_PREP + 120 * MiB))
#define C_BONUS ((float*)(c.ap->ws + WS_PREP + 125 * MiB))
#define C_WUT ((bf16*)(c.ap->ws + WS_PREP + 126 * MiB))
#define C_AUT ((bf16*)(c.ap->ws + WS_PREP + 126 * MiB) + 2 * 768 * 64)
constexpr int CHK_BYTES = 40960, CK_A = 0, CK_RQ = 9216, CK_GT = 13824, CK_YVT = 31232;
#define C_YR ((float*)(c.ap->ws + WS_PREP))
#define C_Z ((float*)(c.ap->ws + WS_HB))
#define C_OG ((float*)(c.ap->ws + WS_OG))
#define C_LSE ((float*)(c.ap->ws + WS_LSE))
#define C_MKVB ((bf16*)(c.ap->ws + WS_MKVB))
#define C_VT ((bf16*)(c.ap->ws + WS_VT))

__device__ __forceinline__ void transpose_item(const float* W, int K, int N, bf16* WT, int row_off, LAS float* scr, int item, int lane) {
    const int nblk = N / 32, kb = item / nblk, nb = item % nblk, k0 = 64 * kb, n0 = 32 * nb;
    f32x4 wv[8];
#pragma unroll
    for (int i = 0; i < 8; ++i) { const int kk = 8 * i + (lane >> 3), c4 = 4 * (lane & 7); wv[i] = *(const f32x4*)(W + (size_t)(k0 + kk) * N + n0 + c4); }
#pragma unroll
    for (int i = 0; i < 8; ++i) { const int kk = 8 * i + (lane >> 3), c4 = 4 * (lane & 7); const f32x4 w4 = wv[i];
        scr[kk * 33 + c4] = w4.x; scr[kk * 33 + c4 + 1] = w4.y; scr[kk * 33 + c4 + 2] = w4.z; scr[kk * 33 + c4 + 3] = w4.w; }
    LDS_WAIT(); asm volatile("" ::: "memory");
    const int c = lane & 7;
#pragma unroll
    for (int j = 0; j < 4; ++j) { const int n = (lane >> 3) + 8 * j; const LAS float* s = scr + (8 * c) * 33 + n;
        u32x4 o; o.x = pk2(s[0 * 33], s[1 * 33]); o.y = pk2(s[2 * 33], s[3 * 33]); o.z = pk2(s[4 * 33], s[5 * 33]); o.w = pk2(s[6 * 33], s[7 * 33]);
        *(u32x4*)(WT + (size_t)(row_off + n0 + n) * K + k0 + 8 * c) = o; }
    LDS_WAIT(); asm volatile("" ::: "memory");
}
__device__ __forceinline__ void transpose_matrix(const Ctx& c, const float* W, int K, int N, bf16* WT, int row_off) {
    LAS float* scr = (LAS float*)(c.lds + c.wave * 16384);
    const int gw = c.bid * 8 + c.wave, NGW = c.G * 8, nitems = (K / 64) * (N / 32);
    for (int it = gw; it < nitems; it += NGW) transpose_item(W, K, N, WT, row_off, scr, it, c.lane);
}
__device__ __forceinline__ void convert_layer_weights(const Ctx& c, int l) {
    if ((l & 1) == 0) { const int e = l >> 1;
        transpose_matrix(c, C_IN(10) + (size_t)e * DM * EVEN_IN, DM, EVEN_IN, C_WTIN, 0);
        transpose_matrix(c, C_IN(11) + (size_t)e * EVEN_OUT * DM, EVEN_OUT, DM, C_WTOUT_L(l), 0);
        const int n16 = (EVEN_INP - EVEN_IN) * DM * 2 / 16; u32x4* p = (u32x4*)(C_WTIN + (size_t)EVEN_IN * DM);
        for (int i = c.bid * 512 + c.tid; i < n16; i += c.G * 512) p[i] = (u32x4){0u, 0u, 0u, 0u};
    } else { const int o = l >> 1;
        transpose_matrix(c, C_IN(12) + (size_t)o * DM * ODD_IN, DM, ODD_IN, C_WTIN, 0);
        transpose_matrix(c, C_IN(13) + (size_t)o * ODD_OUT * DM, ODD_OUT, DM, C_WTOUT_L(l), 0);
    }
}

__device__ __forceinline__ void phase_prologue(const Ctx& c) {
    for (int l = 0; l < 4; ++l) transpose_matrix(c, C_IN(14) + (size_t)l * DM * 1024, DM, 1024, C_WTMEM, l * 1024);
    convert_layer_weights(c, 0);
    const int gt = c.bid * 512 + c.tid, NT = c.G * 512;
    for (int i = gt; i < 2 * 768 * 64; i += NT) { const int e = i / (768 * 64), rem = i % (768 * 64), col = rem >> 6, k = rem & 63;
        C_WUT[i] = (bf16)f2bf(C_IN(19)[((size_t)e * 64 + k) * 768 + col]); C_AUT[i] = (bf16)f2bf(C_IN(21)[((size_t)e * 64 + k) * 768 + col]); }
    for (int i = gt; i < 512 * DM / 4; i += NT) { const f32x4 v = ((const f32x4*)C_IN(9))[i]; ((u32x2*)C_MEMB)[i] = (u32x2){pk2(v.x, v.y), pk2(v.z, v.w)}; }
    for (int i = gt; i < MPAD * DM / 4; i += NT) {
        const int row = i / (DM / 4);
        f32x4 v = (f32x4){0.f, 0.f, 0.f, 0.f};
        if (row < TP) v = ((const f32x4*)C_IN(0))[i]; else if (row < TT) v = ((const f32x4*)C_IN(1))[i - TP * (DM / 4)];
        ((f32x4*)C_XZ)[i] = v; ((u32x2*)C_XB)[i] = (u32x2){pk2(v.x, v.y), pk2(v.z, v.w)};
    }
    for (int i = gt; i < 4100 * 128; i += NT) {
        const int p = i >> 7, ci = i & 127; const double pos = (double)(p < 4096 ? p : 16384 + (p - 4096));
        double ph = pos * ANG[ci];
        const double k = __builtin_rint(ph * 0.15915494309189535); ph = __builtin_fma(-k, 6.283185307179586, ph); ph = __builtin_fma(-k, 2.4492935982947064e-16, ph);
        const double q = __builtin_rint(ph * 0.6366197723675814); const double y = __builtin_fma(-q, 1.5707963267948966, ph) - q * 6.123233995736766e-17;
        const double y2 = y * y;
        const double sn = y * (1.0 + y2 * (-1.0 / 6 + y2 * (1.0 / 120 + y2 * (-1.0 / 5040 + y2 * (1.0 / 362880 + y2 * (-1.0 / 39916800 + y2 * (1.0 / 6227020800.0)))))));
        const double cs = 1.0 + y2 * (-0.5 + y2 * (1.0 / 24 + y2 * (-1.0 / 720 + y2 * (1.0 / 40320 + y2 * (-1.0 / 3628800 + y2 * (1.0 / 479001600.0 + y2 * (-1.0 / 87178291200.0)))))));
        const int qi = ((int)q) & 3; double co, si;
        if (qi == 0) { co = cs; si = sn; } else if (qi == 1) { co = -sn; si = cs; } else if (qi == 2) { co = -cs; si = -sn; } else { co = sn; si = -cs; }
        C_TAB[2 * i] = (float)co; C_TAB[2 * i + 1] = (float)si;
    }
}

__device__ __forceinline__ void rwkv_prep_item(const Ctx& c, int it, int e) {
    LAS float* lw = (LAS float*)c.lds;
    LAS float* la = lw + 16 * 64;
    const float* mu = C_IN(17) + e * 2432; const float* shift = C_IN(3) + (size_t)e * 8 * 2432;
    const int R0 = it * 16;
    for (int i = c.tid; i < 16 * 128; i += 512) {
        const int tk = i >> 7, cc = i & 127, R = R0 + tk; float val = 0.f;
        if (R < TT) { const int col = EC_HW + cc; const float hcur = bf2f(C_HB[(size_t)R * LDH + col]);
            float hprev;
            if (R < TP) hprev = ((R & (SEQ - 1)) == 0) ? 0.f : bf2f(C_HB[(size_t)(R - 1) * LDH + col]);
            else { const int n = (R - TP) >> 2, t = (R - TP) & 3; hprev = (t == 0) ? shift[n * 2432 + col] : bf2f(C_HB[(size_t)(R - 1) * LDH + col]); }
            const float hs = hcur + (hprev - hcur) * mu[col];
            val = (cc < 64) ? tanhf(hs) : hs; }
        if (cc < 64) lw[tk * 64 + cc] = val; else la[tk * 64 + (cc - 64)] = val;
    }
    __syncthreads();
    const int tl = c.tid & 255, tg = c.tid >> 8;
    const float* w_up = C_IN(19) + (size_t)e * 64 * 768; const float* a_up = C_IN(21) + (size_t)e * 64 * 768;
    const float* w0 = C_IN(18) + e * 768; const float* a0 = C_IN(20) + e * 768; const float* k_k = C_IN(22) + e * 768; const float* k_a = C_IN(23) + e * 768;
#pragma unroll 1
    for (int m = 0; m < 3; ++m) {
        const int col = tl + 256 * m, h = col >> 6, ci = col & 63;
        float xw[8], xa[8];
#pragma unroll
        for (int t = 0; t < 8; ++t) { xw[t] = 0.f; xa[t] = 0.f; }
#pragma unroll 4
        for (int kk = 0; kk < 64; ++kk) { const float wu = w_up[kk * 768 + col], au = a_up[kk * 768 + col];
#pragma unroll
            for (int t = 0; t < 8; ++t) { xw[t] += lw[(tg * 8 + t) * 64 + kk] * wu; xa[t] += la[(tg * 8 + t) * 64 + kk] * au; } }
        const float w0c = w0[col], a0c = a0[col], kkc = k_k[col], kac = k_a[col], mur = mu[EC_R + col], muk = mu[EC_K + col], muv = mu[EC_V + col];
#pragma unroll
        for (int t = 0; t < 8; ++t) {
            const int R = R0 + tg * 8 + t;
            if (R >= TT || R < TP) continue;
            const bf16* hc = C_HB + (size_t)R * LDH; float pr, pk, pv;
            const float cr = bf2f(hc[EC_R + col]), ck = bf2f(hc[EC_K + col]), cv = bf2f(hc[EC_V + col]);
            bool has_prev_row; int n = 0;
            if (R < TP) has_prev_row = (R & (SEQ - 1)) != 0; else { n = (R - TP) >> 2; has_prev_row = ((R - TP) & 3) != 0; }
            if (has_prev_row) { const bf16* hp = hc - LDH; pr = bf2f(hp[EC_R + col]); pk = bf2f(hp[EC_K + col]); pv = bf2f(hp[EC_V + col]); }
            else if (R < TP) { pr = 0.f; pk = 0.f; pv = 0.f; }
            else { const float* sp = shift + n * 2432; pr = sp[EC_R + col]; pk = sp[EC_K + col]; pv = sp[EC_V + col]; }
            const float r = cr + (pr - cr) * mur, k = ck + (pk - ck) * muk, v = cv + (pv - cv) * muv;
            const float decay = __expf(-0.6065306597126334f * sigmoidf_(w0c + xw[t]));
            const float a = sigmoidf_(a0c + xa[t]);
            float kk = k * kkc; const float ss = wave_sum(kk * kk); kk *= rsqrtf(fmaxf(ss, 1e-24f));
            const float k2 = k * (1.0f + (a - 1.0f) * kac);
            float* dst = C_PREPS + ((size_t)(R - TP) * 12 + h) * 384 + ci;
            dst[0] = r; dst[64] = decay; dst[128] = k2; dst[192] = v; dst[256] = -kk; dst[320] = kk * a;
        }
    }
    __syncthreads();
}

__device__ __forceinline__ void dil_attn_item(const Ctx& c, int R, int hh, int e) {
    const int lane = c.lane, kg = lane >> 4, dl = lane & 15;
    float m = -1e30f, l = 0.f, acc[4] = {0.f, 0.f, 0.f, 0.f};
    const bool is_p = R < TP; const int t = is_p ? (R & (SEQ - 1)) : ((R - TP) & 3); const int n = is_p ? 0 : ((R - TP) >> 2);
    const size_t rowbase = is_p ? (size_t)(R - t) : (size_t)(TP + n * 4);
#pragma unroll
    for (int g = 0; g < 3; ++g) {
        const int dil = (g == 0) ? 1 : (g == 1 ? 4 : 16), W = 128 * dil;
        float q[4]; { const u32x2 w = *(const u32x2*)(C_HB + (size_t)R * LDH + EC_QB + g * 256 + hh * 64 + 4 * dl); unpk4(w, q); }
#pragma unroll
        for (int i = 0; i < 4; ++i) q[i] *= 0.125f;
        const float* cache = ((g == 0) ? C_IN(4) : (g == 1 ? C_IN(5) : C_IN(6))) + ((size_t)(e * 8 + n) * W) * 512;
#pragma unroll 1
        for (int j0 = 0; j0 < 129; j0 += 4) {
            const int j = j0 + kg; bool valid = j < 129; float kf[4] = {0.f, 0.f, 0.f, 0.f}, vf[4] = {0.f, 0.f, 0.f, 0.f};
            if (is_p) { const int pos = t - dil * j; valid = valid && pos >= 0;
                if (valid) { const bf16* kp = C_HB + (rowbase + pos) * LDH + g * 256 + hh * 64 + 4 * dl; unpk4(*(const u32x2*)(kp + EC_KB), kf); unpk4(*(const u32x2*)(kp + EC_VB), vf); } }
            else if (valid) { const int idx = W + t - dil * j;
                if (idx >= W) { const bf16* kp = C_HB + (rowbase + (idx - W)) * LDH + g * 256 + hh * 64 + 4 * dl; unpk4(*(const u32x2*)(kp + EC_KB), kf); unpk4(*(const u32x2*)(kp + EC_VB), vf); }
                else { const float* kp = cache + (size_t)idx * 512 + hh * 64 + 4 * dl; const f32x4 k4 = *(const f32x4*)kp, v4 = *(const f32x4*)(kp + 256);
                    kf[0] = k4.x; kf[1] = k4.y; kf[2] = k4.z; kf[3] = k4.w; vf[0] = v4.x; vf[1] = v4.y; vf[2] = v4.z; vf[3] = v4.w; } }
            float s = q[0] * kf[0] + q[1] * kf[1] + q[2] * kf[2] + q[3] * kf[3];
            s = red16(s);
            if (valid) { const float mn = fmaxf(m, s), sc = __expf(m - mn), p = __expf(s - mn);
                l = l * sc + p;
#pragma unroll
                for (int i = 0; i < 4; ++i) acc[i] = acc[i] * sc + p * vf[i];
                m = mn; }
        }
    }
#pragma unroll
    for (int off = 16; off <= 32; off <<= 1) {
        const float m2 = __shfl_xor(m, off), l2 = __shfl_xor(l, off); float a2[4];
#pragma unroll
        for (int i = 0; i < 4; ++i) a2[i] = __shfl_xor(acc[i], off);
        const float mn = fmaxf(m, m2), s1 = __expf(m - mn), s2 = __expf(m2 - mn);
        l = l * s1 + l2 * s2;
#pragma unroll
        for (int i = 0; i < 4; ++i) acc[i] = acc[i] * s1 + a2[i] * s2;
        m = mn;
    }
    if (kg == 0) { float gt[4]; unpk4(*(const u32x2*)(C_HB + (size_t)R * LDH + EC_GB + hh * 64 + 4 * dl), gt);
        const float inv = 1.0f / l; float o[4];
#pragma unroll
        for (int i = 0; i < 4; ++i) o[i] = acc[i] * inv * siluf_(gt[i]);
        *(u32x2*)(C_U + (size_t)R * EVEN_OUT + 768 + hh * 64 + 4 * dl) = (u32x2){pk2(o[0], o[1]), pk2(o[2], o[3])}; }
}

__device__ __forceinline__ void mem_attn_item(const Ctx& c, int R, int mh, int l, int qcol, int gcol, int ucol, int ldu) {
    const int lane = c.lane, kg = lane >> 5, dl = lane & 31;
    const float* mkv;
    if (R < TP) mkv = C_OUT + O_MEM + ((size_t)l * 512 + (R >> 12) * 256) * 1024; else mkv = C_IN(8) + ((size_t)l * 8 + ((R - TP) >> 2)) * 256 * 1024;
    float q[4]; unpk4(*(const u32x2*)(C_HB + (size_t)R * LDH + qcol + mh * 128 + 4 * dl), q);
#pragma unroll
    for (int i = 0; i < 4; ++i) q[i] *= 0.08838834764831845f;
    float m = -1e30f, lsum = 0.f, acc[4] = {0.f, 0.f, 0.f, 0.f};
#pragma unroll 8
    for (int j0 = 0; j0 < 256; j0 += 2) {
        const float* kp = mkv + (size_t)(j0 + kg) * 1024 + mh * 128 + 4 * dl; const f32x4 k4 = *(const f32x4*)kp, v4 = *(const f32x4*)(kp + 512);
        float s = q[0] * k4.x + q[1] * k4.y + q[2] * k4.z + q[3] * k4.w;
        s = red16(s); s += __shfl_xor(s, 16);
        const float mn = fmaxf(m, s), sc = __expf(m - mn), p = __expf(s - mn);
        lsum = lsum * sc + p; acc[0] = acc[0] * sc + p * v4.x; acc[1] = acc[1] * sc + p * v4.y; acc[2] = acc[2] * sc + p * v4.z; acc[3] = acc[3] * sc + p * v4.w; m = mn;
    }
    { const float m2 = __shfl_xor(m, 32), l2 = __shfl_xor(lsum, 32); float a2[4];
#pragma unroll
        for (int i = 0; i < 4; ++i) a2[i] = __shfl_xor(acc[i], 32);
        const float mn = fmaxf(m, m2), s1 = __expf(m - mn), s2 = __expf(m2 - mn);
        lsum = lsum * s1 + l2 * s2;
#pragma unroll
        for (int i = 0; i < 4; ++i) acc[i] = acc[i] * s1 + a2[i] * s2; }
    if (kg == 0) { float gt[4]; unpk4(*(const u32x2*)(C_HB + (size_t)R * LDH + gcol + mh * 128 + 4 * dl), gt);
        const float inv = 1.0f / lsum; float o[4];
#pragma unroll
        for (int i = 0; i < 4; ++i) o[i] = acc[i] * inv * siluf_(gt[i]);
        *(u32x2*)(C_U + (size_t)R * ldu + ucol + mh * 128 + 4 * dl) = (u32x2){pk2(o[0], o[1]), pk2(o[2], o[3])}; }
}


typedef float f32x16 __attribute__((ext_vector_type(16)));
__device__ __forceinline__ f32x16 mfma32(bf16x8 a, bf16x8 b, f32x16 cacc) { return __builtin_amdgcn_mfma_f32_32x32x16_bf16(a, b, cacc, 0, 0, 0); }
__device__ __forceinline__ void mem_attn_mfma_item(const Ctx& c, int item, int l, int qcol, int gcol, int ucol, int ldu) {
    const int blk = item >> 2, mh = item & 3, R0 = blk * 32, b = R0 >> 12;
    const int lane = c.lane, r = lane & 31, hh = lane >> 5;
    const bf16* Kb = C_MKVB + ((size_t)l * 512 + b * 256) * 1024 + mh * 128 + 8 * hh;
    const bf16* Vt = C_VT + ((size_t)l * 512 + mh * 128) * 512 + b * 256 + 4 * hh;
    bf16x8 Qf[8];
    { const bf16* qp = C_HB + (size_t)(R0 + r) * LDH + qcol + mh * 128 + 8 * hh;
#pragma unroll
        for (int ks = 0; ks < 8; ++ks) Qf[ks] = *(const bf16x8*)(qp + 16 * ks); }
    f32x16 O[4];
#pragma unroll
    for (int dt = 0; dt < 4; ++dt)
#pragma unroll
        for (int i = 0; i < 16; ++i) O[dt][i] = 0.f;
    float m = -1e30f, lsum = 0.f;
    const float cs = 0.08838834764831845f * 1.4426950408889634f;
#pragma unroll 1
    for (int half = 0; half < 2; ++half) {
        f32x16 S[4];
#pragma unroll
        for (int kt = 0; kt < 4; ++kt) {
#pragma unroll
            for (int i = 0; i < 16; ++i) S[kt][i] = 0.f;
            const bf16* kp = Kb + (size_t)(128 * half + 32 * kt + r) * 1024;
#pragma unroll
            for (int ks = 0; ks < 8; ++ks) S[kt] = mfma32(*(const bf16x8*)(kp + 16 * ks), Qf[ks], S[kt]);
        }
        float mx = -1e30f;
#pragma unroll
        for (int kt = 0; kt < 4; ++kt)
#pragma unroll
            for (int i = 0; i < 16; ++i) mx = fmaxf(mx, S[kt][i]);
        mx = fmaxf(mx, __shfl_xor(mx, 32));
        const float mn = fmaxf(m, mx), sc = __builtin_amdgcn_exp2f((m - mn) * cs); m = mn;
        lsum *= sc;
#pragma unroll
        for (int dt = 0; dt < 4; ++dt)
#pragma unroll
            for (int i = 0; i < 16; ++i) O[dt][i] *= sc;
        float ps = 0.f;
#pragma unroll
        for (int kt = 0; kt < 4; ++kt)
#pragma unroll
            for (int i = 0; i < 16; ++i) { const float p = __builtin_amdgcn_exp2f((S[kt][i] - mn) * cs); S[kt][i] = p; ps += p; }
        lsum += ps;
#pragma unroll
        for (int kt = 0; kt < 4; ++kt)
#pragma unroll
            for (int s2 = 0; s2 < 2; ++s2) {
                const u32x4 pw = (u32x4){pk2(S[kt][8 * s2 + 0], S[kt][8 * s2 + 1]), pk2(S[kt][8 * s2 + 2], S[kt][8 * s2 + 3]), pk2(S[kt][8 * s2 + 4], S[kt][8 * s2 + 5]), pk2(S[kt][8 * s2 + 6], S[kt][8 * s2 + 7])};
                const bf16x8 Pf = __builtin_bit_cast(bf16x8, pw);
                const int kb = 128 * half + 32 * kt + 16 * s2;
#pragma unroll
                for (int dt = 0; dt < 4; ++dt) { const bf16* vp = Vt + (size_t)(32 * dt + r) * 512 + kb;
                    const u32x2 v0 = *(const u32x2*)vp, v1 = *(const u32x2*)(vp + 8); const u32x4 vw = (u32x4){v0.x, v0.y, v1.x, v1.y};
                    O[dt] = mfma32(__builtin_bit_cast(bf16x8, vw), Pf, O[dt]); }
            }
    }
    lsum += __shfl_xor(lsum, 32); const float inv = 1.0f / lsum;
    const bf16* gp = C_HB + (size_t)(R0 + r) * LDH + gcol + mh * 128 + 4 * hh; bf16* up = C_U + (size_t)(R0 + r) * ldu + ucol + mh * 128 + 4 * hh;
#pragma unroll
    for (int dt = 0; dt < 4; ++dt)
#pragma unroll
        for (int g4 = 0; g4 < 4; ++g4) { float gt[4]; unpk4(*(const u32x2*)(gp + 32 * dt + 8 * g4), gt);
            const float o0 = O[dt][4 * g4 + 0] * inv * siluf_(gt[0]), o1 = O[dt][4 * g4 + 1] * inv * siluf_(gt[1]), o2 = O[dt][4 * g4 + 2] * inv * siluf_(gt[2]), o3 = O[dt][4 * g4 + 3] * inv * siluf_(gt[3]);
            *(u32x2*)(up + 32 * dt + 8 * g4) = (u32x2){pk2(o0, o1), pk2(o2, o3)}; }
}
__device__ __forceinline__ void mem_attn_all(const Ctx& c, int l, int qcol, int gcol, int ucol, int ldu) {
    constexpr int NM = (TP / 32) * 4, NS = TS * 4;
    for (int wi = c.wave * c.G + c.bid; wi < NM + NS; wi += 8 * c.G) {
        if (wi < NM) mem_attn_mfma_item(c, wi, l, qcol, gcol, ucol, ldu);
        else { const int si = wi - NM; mem_attn_item(c, TP + (si >> 2), si & 3, l, qcol, gcol, ucol, ldu); }
    }
}


typedef short s16x4 __attribute__((ext_vector_type(4)));
__device__ __forceinline__ f32x4 mfma16(bf16x8 a, bf16x8 b, f32x4 cacc) { return __builtin_amdgcn_mfma_f32_16x16x32_bf16(a, b, cacc, 0, 0, 0); }
__device__ __forceinline__ bf16x8 tr_frag(const LAS bf16* p, int rowstride4) {
    const s16x4 a0 = __builtin_amdgcn_ds_read_tr16_b64_v4i16((LAS s16x4*)p), a1 = __builtin_amdgcn_ds_read_tr16_b64_v4i16((LAS s16x4*)(p + rowstride4));
    return (bf16x8){a0[0], a0[1], a0[2], a0[3], a1[0], a1[1], a1[2], a1[3]};
}
__device__ __forceinline__ void dil_attn_mfma_item(const Ctx& c, int item) {
    const int bh = item / 48, rem = item % 48, b = bh >> 2, hh = bh & 3, g = rem >> 4, idx16 = rem & 15;
    const int dil = 1 << (2 * g), nub = 16 >> (2 * g), rho = idx16 / nub, ub = idx16 % nub;
    LAS bf16* Kl = (LAS bf16*)c.lds;
    LAS bf16* Vl = Kl + 384 * 72;
    const int tid = c.tid, lane = c.lane, wave = c.wave, r = lane & 31, hl = lane >> 5;
    const int ubase = ub * 256 - 128;
    const bf16* hb = C_HB + (size_t)b * SEQ * LDH + g * 256 + hh * 64;
    u32x4 kwv[6], vwv[6];
#pragma unroll
    for (int pass = 0; pass < 6; ++pass) { const int kl = pass * 64 + (tid >> 3), part = tid & 7; int up = ubase + kl; up = up < 0 ? 0 : up;
        const bf16* src = hb + (size_t)(rho + dil * up) * LDH + 8 * part;
        kwv[pass] = *(const u32x4*)(src + EC_KB); vwv[pass] = *(const u32x4*)(src + EC_VB); }
    const int u0 = ub * 256 + 32 * wave;
    bf16x8 Qf[4];
    { const bf16* qp = hb + (size_t)(rho + dil * (u0 + r)) * LDH + EC_QB + 8 * hl;
#pragma unroll
        for (int ks = 0; ks < 4; ++ks) Qf[ks] = *(const bf16x8*)(qp + 16 * ks); }
#pragma unroll
    for (int pass = 0; pass < 6; ++pass) { const int kl = pass * 64 + (tid >> 3), part = tid & 7; *(LAS u32x4*)(Kl + kl * 72 + 8 * part) = kwv[pass]; *(LAS u32x4*)(Vl + kl * 72 + 8 * part) = vwv[pass]; }
    __syncthreads();
    f32x16 S[5];
#pragma unroll
    for (int kt = 0; kt < 5; ++kt) {
#pragma unroll
        for (int i = 0; i < 16; ++i) S[kt][i] = 0.f;
        const LAS bf16* kp = Kl + (32 * wave + 32 * kt + r) * 72 + 8 * hl;
#pragma unroll
        for (int ks = 0; ks < 4; ++ks) S[kt] = mfma32(*(const LAS bf16x8*)(kp + 16 * ks), Qf[ks], S[kt]);
    }
    float mx = -1e30f;
#pragma unroll
    for (int kt = 0; kt < 5; ++kt)
#pragma unroll
        for (int i = 0; i < 16; ++i) { const int kl = 32 * kt + (i & 3) + 8 * (i >> 2) + 4 * hl;
            const bool valid = (kl >= r) && (kl - 128 <= r) && (u0 - 128 + kl >= 0);
            const float sv = valid ? S[kt][i] : -1e30f; S[kt][i] = sv; mx = fmaxf(mx, sv); }
    mx = fmaxf(mx, __shfl_xor(mx, 32));
    const float cs = 0.125f * 1.4426950408889634f;
    float lsum = 0.f;
#pragma unroll
    for (int kt = 0; kt < 5; ++kt)
#pragma unroll
        for (int i = 0; i < 16; ++i) { const float p = __builtin_amdgcn_exp2f((S[kt][i] - mx) * cs); S[kt][i] = p; lsum += p; }
    lsum += __shfl_xor(lsum, 32);
    f32x16 O[2];
#pragma unroll
    for (int dt = 0; dt < 2; ++dt)
#pragma unroll
        for (int i = 0; i < 16; ++i) O[dt][i] = 0.f;
    const LAS bf16* vbase = Vl + (32 * wave + 4 * hl + ((lane & 15) >> 2)) * 72 + 16 * ((lane >> 4) & 1) + 4 * (lane & 3);
#pragma unroll
    for (int kt = 0; kt < 5; ++kt)
#pragma unroll
        for (int s2 = 0; s2 < 2; ++s2) {
            const u32x4 pw = (u32x4){pk2(S[kt][8 * s2 + 0], S[kt][8 * s2 + 1]), pk2(S[kt][8 * s2 + 2], S[kt][8 * s2 + 3]), pk2(S[kt][8 * s2 + 4], S[kt][8 * s2 + 5]), pk2(S[kt][8 * s2 + 6], S[kt][8 * s2 + 7])};
            const bf16x8 Pf = __builtin_bit_cast(bf16x8, pw);
#pragma unroll
            for (int dt = 0; dt < 2; ++dt) { const LAS bf16* vp = vbase + (32 * kt + 16 * s2) * 72 + 32 * dt;
                const s16x4 a0 = __builtin_amdgcn_ds_read_tr16_b64_v4i16((LAS s16x4*)vp), a1 = __builtin_amdgcn_ds_read_tr16_b64_v4i16((LAS s16x4*)(vp + 8 * 72));
                const bf16x8 Af = (bf16x8){a0[0], a0[1], a0[2], a0[3], a1[0], a1[1], a1[2], a1[3]};
                O[dt] = mfma32(Af, Pf, O[dt]); }
        }
    const float inv = 1.0f / lsum; const size_t R = (size_t)b * SEQ + rho + dil * (u0 + r);
    float* og = C_OG + ((size_t)g * TT + R) * 256 + hh * 64 + 4 * hl;
#pragma unroll
    for (int dt = 0; dt < 2; ++dt)
#pragma unroll
        for (int g4 = 0; g4 < 4; ++g4) *(f32x4*)(og + 32 * dt + 8 * g4) = (f32x4){O[dt][4 * g4 + 0] * inv, O[dt][4 * g4 + 1] * inv, O[dt][4 * g4 + 2] * inv, O[dt][4 * g4 + 3] * inv};
    if (hl == 0) C_LSE[((size_t)g * TT + R) * 4 + hh] = mx * 0.125f + __logf(lsum);
    __syncthreads();
}
__device__ __forceinline__ void dil_attn_sample_item(const Ctx& c, int sr, int hh, int e) {
    const int lane = c.lane, kg = lane >> 4, dl = lane & 15, R = TP + sr, n = sr >> 2, t = sr & 3;
    float m = -1e30f, l = 0.f, acc[4] = {0.f, 0.f, 0.f, 0.f};
#pragma unroll
    for (int g = 0; g < 3; ++g) {
        const int dil = (g == 0) ? 1 : (g == 1 ? 4 : 16), W = 128 * dil, jn = t / dil;
        float q[4]; unpk4(*(const u32x2*)(C_HB + (size_t)R * LDH + EC_QB + g * 256 + hh * 64 + 4 * dl), q);
#pragma unroll
        for (int i = 0; i < 4; ++i) q[i] *= 0.125f;
        { const int j = kg; const bool valid = j <= jn; const int tt = valid ? t - dil * j : t;
            const bf16* kp = C_HB + (size_t)(TP + n * 4 + tt) * LDH + g * 256 + hh * 64 + 4 * dl; float kf[4], vf[4]; unpk4(*(const u32x2*)(kp + EC_KB), kf); unpk4(*(const u32x2*)(kp + EC_VB), vf);
            float s = red16(q[0] * kf[0] + q[1] * kf[1] + q[2] * kf[2] + q[3] * kf[3]);
            if (valid) { const float mn = fmaxf(m, s), sc = __expf(m - mn), p = __expf(s - mn); l = l * sc + p;
#pragma unroll
                for (int i = 0; i < 4; ++i) acc[i] = acc[i] * sc + p * vf[i];
                m = mn; } }
        const float* cache = ((g == 0) ? C_IN(4) : (g == 1 ? C_IN(5) : C_IN(6))) + ((size_t)(e * 8 + n) * W) * 512 + hh * 64 + 4 * dl;
#pragma unroll 11
        for (int j0 = 0; j0 < 132; j0 += 4) { const int j = j0 + kg; const bool valid = (j > jn) && (j <= 128); const int idx = valid ? W + t - dil * j : 0;
            const float* kp = cache + (size_t)idx * 512; const f32x4 k4 = *(const f32x4*)kp, v4 = *(const f32x4*)(kp + 256);
            const float s = red16(q[0] * k4.x + q[1] * k4.y + q[2] * k4.z + q[3] * k4.w);
            if (valid) { const float mn = fmaxf(m, s), sc = __expf(m - mn), p = __expf(s - mn); l = l * sc + p;
                acc[0] = acc[0] * sc + p * v4.x; acc[1] = acc[1] * sc + p * v4.y; acc[2] = acc[2] * sc + p * v4.z; acc[3] = acc[3] * sc + p * v4.w; m = mn; } }
    }
#pragma unroll
    for (int off = 16; off <= 32; off <<= 1) {
        const float m2 = __shfl_xor(m, off), l2 = __shfl_xor(l, off); float a2[4];
#pragma unroll
        for (int i = 0; i < 4; ++i) a2[i] = __shfl_xor(acc[i], off);
        const float mn = fmaxf(m, m2), s1 = __expf(m - mn), s2 = __expf(m2 - mn);
        l = l * s1 + l2 * s2;
#pragma unroll
        for (int i = 0; i < 4; ++i) acc[i] = acc[i] * s1 + a2[i] * s2;
        m = mn;
    }
    if (kg == 0) { float gt[4]; unpk4(*(const u32x2*)(C_HB + (size_t)R * LDH + EC_GB + hh * 64 + 4 * dl), gt);
        const float inv = 1.0f / l; float o[4];
#pragma unroll
        for (int i = 0; i < 4; ++i) o[i] = acc[i] * inv * siluf_(gt[i]);
        *(u32x2*)(C_U + (size_t)R * EVEN_OUT + 768 + hh * 64 + 4 * dl) = (u32x2){pk2(o[0], o[1]), pk2(o[2], o[3])}; }
}

__device__ __forceinline__ void even_copies(const Ctx& c, int e) {
    const int gt = c.bid * 512 + c.tid, NT = c.G * 512;
    for (int i = gt; i < 10 * 304; i += NT) { const int rw = i / 304, c8 = 8 * (i % 304);
        const size_t src = (rw < 2) ? (size_t)(rw * SEQ + SEQ - 1) : (size_t)(TP + (rw - 2) * 4 + 3);
        float x[8]; unpk8(*(const u32x4*)(C_HB + src * LDH + c8), x);
        float* dst = (rw < 2) ? C_OUT + O_SH_P + ((size_t)e * 2 + rw) * 2432 + c8 : C_OUT + O_SH_S + ((size_t)e * 8 + (rw - 2)) * 2432 + c8;
        *(f32x4*)dst = (f32x4){x[0], x[1], x[2], x[3]}; *(f32x4*)(dst + 4) = (f32x4){x[4], x[5], x[6], x[7]}; }
#pragma unroll 1
    for (int g = 0; g < 3; ++g) {
        const int keep = 128 << (2 * g); const size_t op = (g == 0) ? O_G0P : (g == 1 ? O_G1P : O_G2P), os = (g == 0) ? O_G0S : (g == 1 ? O_G1S : O_G2S);
        for (int i = gt; i < 2 * keep * 64; i += NT) { const int pc = i & 63, r = (i >> 6) % keep, b = (i >> 6) / keep;
            const int col = ((pc & 32) ? EC_VB : EC_KB) + g * 256 + 8 * (pc & 31);
            float x[8]; unpk8(*(const u32x4*)(C_HB + (size_t)(b * SEQ + SEQ - keep + r) * LDH + col), x);
            float* dst = C_OUT + op + ((size_t)e * 2 * keep + (size_t)b * keep + r) * 512 + 8 * pc;
            *(f32x4*)dst = (f32x4){x[0], x[1], x[2], x[3]}; *(f32x4*)(dst + 4) = (f32x4){x[4], x[5], x[6], x[7]}; }
        for (int i = gt; i < 8 * 4 * 64; i += NT) { const int pc = i & 63, row = i >> 6;
            const int col = ((pc & 32) ? EC_VB : EC_KB) + g * 256 + 8 * (pc & 31);
            float x[8]; unpk8(*(const u32x4*)(C_HB + (size_t)(TP + row) * LDH + col), x);
            float* dst = C_OUT + os + ((size_t)e * 32 + row) * 512 + 8 * pc;
            *(f32x4*)dst = (f32x4){x[0], x[1], x[2], x[3]}; *(f32x4*)(dst + 4) = (f32x4){x[4], x[5], x[6], x[7]}; }
    }
}

#define LAUNDER_C(c) do { asm volatile("" : "+s"((c).ap), "+v"((c).tid), "+s"((c).bid), "+s"((c).G)); (c).lane = (c).tid & 63; (c).wave = __builtin_amdgcn_readfirstlane((c).tid >> 6); } while (0)
__device__ __forceinline__ void phase_even_tok_pre(Ctx c, int l);
__device__ __forceinline__ void even_helper_work(Ctx c, int l) {
    const int e = l >> 1;
    for (int rp = 0; rp < REPD; ++rp) { for (int it = c.bid; it < 384; it += c.G) dil_attn_mfma_item(c, it);
    LAUNDER_C(c); }
    { const int gw = (c.G - 1 - c.bid) * 8 + c.wave; if (gw < TS * 4) dil_attn_sample_item(c, gw >> 2, gw & 3, e); }
    LAUNDER_C(c);
    for (int rp = 0; rp < REPM; ++rp) { mem_attn_all(c, l, EC_QM, EC_GM, 1024, EVEN_OUT);
    LAUNDER_C(c); }
    even_copies(c, e);
    LAUNDER_C(c);
    for (int rp = 0; rp < REPC; ++rp) { if (l < 3) convert_layer_weights(c, l + 1); LAUNDER_C(c); }
}

__device__ __forceinline__ void rwkv_scan_item(const Ctx& c, int item, int e) {
    constexpr int CH = 32;
    LAS float* buf = (LAS float*)c.lds;
    LAS float* ybuf = buf + 2 * CH * 384;
    const bool is_p = item < 48; const int st = is_p ? (item >> 1) : ((item - 48) >> 1), half = item & 1;
    const int h = st % 12, bn = st / 12; const int T = is_p ? SEQ : 4; const size_t tok0 = is_p ? (size_t)bn * SEQ : (size_t)(TP + bn * 4);
    const int lane = c.lane, rw = lane >> 4, cgp = lane & 15, il = 4 * c.wave + rw, i = 32 * half + il;
    float s[4];
    if (is_p) { s[0] = s[1] = s[2] = s[3] = 0.f; }
    else { const f32x4 v = *(const f32x4*)(C_IN(2) + ((((size_t)e * 8 + bn) * 12 + h) * 64 + i) * 64 + 4 * cgp); s[0] = v.x; s[1] = v.y; s[2] = v.z; s[3] = v.w; }
    const int nch = (T + CH - 1) / CH;
    f32x4 pre[6];
#define SCAN_GLOAD(ch_) do { _Pragma("unroll") for (int k = 0; k < 6; ++k) { const int idx = c.tid + 512 * k, tl_ = idx / 96, f4 = idx % 96; const int tk = (ch_) * CH + tl_; \
            pre[k] = (tk < T) ? *(const f32x4*)(C_PREPS + ((tok0 - TP + tk) * 12 + h) * 384 + 4 * f4) : (f32x4){0.f, 0.f, 0.f, 0.f}; } } while (0)
#define SCAN_LSTORE(bi_) do { _Pragma("unroll") for (int k = 0; k < 6; ++k) { const int idx = c.tid + 512 * k; *(LAS f32x4*)(buf + (bi_) * CH * 384 + 4 * idx) = pre[k]; } } while (0)
    SCAN_GLOAD(0); SCAN_LSTORE(0); __syncthreads();
#pragma unroll 1
    for (int ch = 0; ch < nch; ++ch) {
        if (ch + 1 < nch) SCAN_GLOAD(ch + 1);
        const LAS float* bb = buf + (ch & 1) * CH * 384;
        const int nt = (T - ch * CH) < CH ? (T - ch * CH) : CH;
#pragma unroll 2
        for (int tl = 0; tl < nt; ++tl) {
            const LAS float* p = bb + tl * 384;
            const f32x4 r4 = *(const LAS f32x4*)(p + 4 * cgp), d4 = *(const LAS f32x4*)(p + 64 + 4 * cgp), k4 = *(const LAS f32x4*)(p + 128 + 4 * cgp),
                        kk4 = *(const LAS f32x4*)(p + 256 + 4 * cgp), b4 = *(const LAS f32x4*)(p + 320 + 4 * cgp);
            const float vi = p[192 + i];
            float sa = s[0] * kk4.x + s[1] * kk4.y + s[2] * kk4.z + s[3] * kk4.w;
            sa = red16(sa);
            s[0] = s[0] * d4.x + (sa * b4.x + vi * k4.x); s[1] = s[1] * d4.y + (sa * b4.y + vi * k4.y);
            s[2] = s[2] * d4.z + (sa * b4.z + vi * k4.z); s[3] = s[3] * d4.w + (sa * b4.w + vi * k4.w);
            float y = s[0] * r4.x + s[1] * r4.y + s[2] * r4.z + s[3] * r4.w;
            y = red16(y);
            if (cgp == 0) ybuf[tl * 32 + il] = y;
        }
        __syncthreads();
        if (ch + 1 < nch) SCAN_LSTORE((ch + 1) & 1);
        for (int idx = c.tid; idx < nt * 32; idx += 512) { const int tl = idx >> 5, r = idx & 31; C_YA[(tok0 + ch * CH + tl) * 768 + h * 64 + 32 * half + r] = ybuf[idx]; }
        __syncthreads();
    }
    float* so = C_OUT + (is_p ? O_RWKV_P + (((size_t)e * 2 + bn) * 12 + h) * 4096 : O_RWKV_S + (((size_t)e * 8 + bn) * 12 + h) * 4096) + (size_t)i * 64 + 4 * cgp;
    *(f32x4*)so = (f32x4){s[0], s[1], s[2], s[3]};
}

typedef float f32x2 __attribute__((ext_vector_type(2)));
__device__ __forceinline__ void rwkv_scan_prompt(const Ctx& c, int item, int e) {
    constexpr int CH = 32, NCH = SEQ / CH;
    LAS float* buf = (LAS float*)c.lds;
    LAS float* ybuf = buf + 2 * CH * 384;
    const int st = item >> 1, half = item & 1, h = st % 12, bn = st / 12; const size_t tok0 = (size_t)bn * SEQ;
    const int lane = c.lane, rw = lane >> 4, cgp = lane & 15, il = 4 * c.wave + rw, i = 32 * half + il;
    f32x2 s01 = (f32x2){0.f, 0.f}, s23 = (f32x2){0.f, 0.f};
    const float* src = C_PREP + (tok0 * 12 + h) * 384;
    float* ya = C_YA + tok0 * 768 + h * 64 + 32 * half;
    f32x4 pre[6];
#define SP_GLOAD(ch_) do { _Pragma("unroll") for (int k = 0; k < 6; ++k) { const int idx = c.tid + 512 * k, tl_ = idx / 96, f4 = idx % 96; \
        pre[k] = *(const f32x4*)(src + (size_t)((ch_) * CH + tl_) * (12 * 384) + 4 * f4); } } while (0)
#define SP_LSTORE(bi_) do { _Pragma("unroll") for (int k = 0; k < 6; ++k) { const int idx = c.tid + 512 * k; *(LAS f32x4*)(buf + (bi_) * CH * 384 + 4 * idx) = pre[k]; } } while (0)
#define SP_YOUT(ch_) do { for (int idx = c.tid; idx < CH * 32; idx += 512) { const int tl_ = idx >> 5, r_ = idx & 31; ya[(size_t)((ch_) * CH + tl_) * 768 + r_] = ybuf[((ch_) & 1) * CH * 32 + idx]; } } while (0)
    SP_GLOAD(0); SP_LSTORE(0); SP_GLOAD(1); __syncthreads();
#pragma unroll 1
    for (int ch = 0; ch < NCH; ++ch) {
        if (ch + 1 < NCH) SP_LSTORE((ch + 1) & 1);
        if (ch + 2 < NCH) SP_GLOAD(ch + 2);
        if (ch > 0) SP_YOUT(ch - 1);
        const LAS float* bb = buf + (ch & 1) * CH * 384 + 4 * cgp; const LAS float* vb = buf + (ch & 1) * CH * 384 + 192 + i;
        LAS float* yw = (cgp == 0) ? (ybuf + (ch & 1) * CH * 32 + il) : (ybuf + 2 * CH * 32 + lane);
        f32x4 r4 = *(const LAS f32x4*)bb, d4 = *(const LAS f32x4*)(bb + 64), k4 = *(const LAS f32x4*)(bb + 128), n4 = *(const LAS f32x4*)(bb + 256), b4 = *(const LAS f32x4*)(bb + 320); float vi = vb[0];
        float sa;
        { f32x2 p = s01 * (f32x2){n4.x, n4.y}; p = s23 * (f32x2){n4.z, n4.w} + p; sa = red16(p.x + p.y); }
#pragma unroll 4
        for (int tl = 0; tl < CH; ++tl) {
            const int tn = (tl + 1 < CH) ? tl + 1 : tl;
            const f32x4 r4n = *(const LAS f32x4*)(bb + tn * 384), d4n = *(const LAS f32x4*)(bb + tn * 384 + 64), k4n = *(const LAS f32x4*)(bb + tn * 384 + 128),
                        n4n = *(const LAS f32x4*)(bb + tn * 384 + 256), b4n = *(const LAS f32x4*)(bb + tn * 384 + 320); const float vin = vb[tn * 384];
            const f32x2 vi2 = (f32x2){vi, vi}, sa2 = (f32x2){sa, sa};
            const f32x2 u01 = s01 * (f32x2){d4.x, d4.y} + vi2 * (f32x2){k4.x, k4.y}, u23 = s23 * (f32x2){d4.z, d4.w} + vi2 * (f32x2){k4.z, k4.w};
            s01 = sa2 * (f32x2){b4.x, b4.y} + u01; s23 = sa2 * (f32x2){b4.z, b4.w} + u23;
            f32x2 yp = s01 * (f32x2){r4.x, r4.y}; yp = s23 * (f32x2){r4.z, r4.w} + yp;
            f32x2 pn = s01 * (f32x2){n4n.x, n4n.y}; pn = s23 * (f32x2){n4n.z, n4n.w} + pn;
            float ya_ = yp.x + yp.y, sb_ = pn.x + pn.y;
            sb_ += dppf<0xB1>(sb_); ya_ += dppf<0xB1>(ya_); sb_ += dppf<0x4E>(sb_); ya_ += dppf<0x4E>(ya_);
            sb_ += dppf<0x141>(sb_); ya_ += dppf<0x141>(ya_); sb_ += dppf<0x140>(sb_); ya_ += dppf<0x140>(ya_);
            sa = sb_;
            yw[tl * 32] = ya_;
            r4 = r4n; d4 = d4n; k4 = k4n; n4 = n4n; b4 = b4n; vi = vin;
        }
        __syncthreads();
    }
    SP_YOUT(NCH - 1);
    float* so = C_OUT + O_RWKV_P + (((size_t)e * 2 + bn) * 12 + h) * 4096 + (size_t)i * 64 + 4 * cgp;
    *(f32x4*)so = (f32x4){s01.x, s01.y, s23.x, s23.y};
    __syncthreads();
#undef SP_GLOAD
#undef SP_LSTORE
#undef SP_YOUT
}

struct PreIn { u32x2 cr, ck, cv, pr, pk, pv; float hcur[8], hprv[8]; };
__device__ __forceinline__ void rwkv_chunk_preload(const Ctx& c, int item, int e, PreIn& P) {
    const bool is_s = item >= 3072; const int sidx = item - 3072;
    const int bh = item >> 7, n = is_s ? 1 : (item & 127), b = bh / 12, h = is_s ? (sidx % 12) : (bh % 12), ns = sidx / 12;
    const size_t R0 = is_s ? (size_t)(TP + 4 * ns) : (size_t)b * SEQ + 32 * n;
    const float* shift = C_IN(3) + ((size_t)e * 8 + ns) * 2432;
    const int tid = c.tid, t_ = tid >> 4, c4 = 4 * (tid & 15), col = h * 64 + c4;
    const bf16* hc = C_HB + (R0 + t_) * LDH + col; const bool hasprev = is_s ? (t_ != 0) : ((32 * n + t_) != 0);
    const u32x2 z2 = (u32x2){0u, 0u};
    P.cr = *(const u32x2*)(hc + EC_R); P.ck = *(const u32x2*)(hc + EC_K); P.cv = *(const u32x2*)(hc + EC_V);
    P.pr = hasprev ? *(const u32x2*)(hc - LDH + EC_R) : z2; P.pk = hasprev ? *(const u32x2*)(hc - LDH + EC_K) : z2; P.pv = hasprev ? *(const u32x2*)(hc - LDH + EC_V) : z2;
    const int cc = tid & 127, cl = EC_HW + cc, tb = tid >> 7;
#pragma unroll
    for (int k = 0; k < 8; ++k) { const int t = tb + 4 * k; P.hcur[k] = bf2f(C_HB[(R0 + t) * LDH + cl]);
        P.hprv[k] = is_s ? (t != 0 ? bf2f(C_HB[(R0 + t - 1) * LDH + cl]) : shift[cl]) : (((32 * n + t) != 0) ? bf2f(C_HB[(R0 + t - 1) * LDH + cl]) : 0.f); }
}
__device__ __forceinline__ void rwkv_chunk_precompute(const Ctx& c, int item, int e, const PreIn& P) {
    const bool is_s = item >= 3072; const int sidx = item - 3072;
    const int bh = item >> 7, n = is_s ? 1 : (item & 127), b = bh / 12, h = is_s ? (sidx % 12) : (bh % 12), ns = sidx / 12, ntok = is_s ? 4 : 32;
    const size_t R0 = is_s ? (size_t)(TP + 4 * ns) : (size_t)b * SEQ + 32 * n;
    const float* shift = C_IN(3) + ((size_t)e * 8 + ns) * 2432;
    LAS unsigned char* L = c.lds;
    LAS float* XW = (LAS float*)(L + 0); LAS float* XA = (LAS float*)(L + 8192);
    LAS bf16* LW = (LAS bf16*)(L + 16384); LAS bf16* LA = (LAS bf16*)(L + 20992);
    LAS float* PS = (LAS float*)(L + 25600);
    LAS bf16* KKt = (LAS bf16*)(L + 33792); LAS bf16* Bt = (LAS bf16*)(L + 38400); LAS bf16* Kt = (LAS bf16*)(L + 43008); LAS bf16* Rt = (LAS bf16*)(L + 47616);
    LAS bf16* Bh = (LAS bf16*)(L + 52224); LAS bf16* Kh = (LAS bf16*)(L + 56832); LAS bf16* Vb = (LAS bf16*)(L + 61440);
    LAS float* LB = (LAS float*)(L + 66048);
    LAS bf16* Lk = (LAS bf16*)(L + 70144); LAS bf16* Mb = (LAS bf16*)(L + 72704); LAS bf16* Mk = (LAS bf16*)(L + 75264);
    LAS float* SOL = (LAS float*)(L + 77824);
    LAS bf16* KTb = (LAS bf16*)(L + 94208); LAS bf16* UVb = (LAS bf16*)(L + 98816);
    LAS float* RTf = (LAS float*)(L + 103424); LAS float* c31 = (LAS float*)(L + 111616);
    const int tid = c.tid, lane = c.lane, wave = c.wave, fr = lane & 15, fq = lane >> 4, trow = (lane & 15) >> 2, tcol = 4 * (lane & 3);
    const int t_ = tid >> 4, c4 = 4 * (tid & 15), col = h * 64 + c4;
    const float* mu = C_IN(17) + e * 2432;
    const bf16* hc = C_HB + (R0 + t_) * LDH + col; const bool hasprev = is_s ? (t_ != 0) : ((32 * n + t_) != 0);
    const u32x2 cr = P.cr, ck = P.ck, cv = P.cv, pr = P.pr, pk = P.pk, pv = P.pv;
    f32x4 sh_r = (f32x4){0.f, 0.f, 0.f, 0.f}, sh_k = sh_r, sh_v = sh_r;
    if (is_s && t_ == 0) { sh_r = *(const f32x4*)(shift + EC_R + col); sh_k = *(const f32x4*)(shift + EC_K + col); sh_v = *(const f32x4*)(shift + EC_V + col); }
    { const int cc = tid & 127, cl = EC_HW + cc, tb = tid >> 7; const float muc = mu[cl];
#pragma unroll
        for (int k = 0; k < 8; ++k) { const int t = tb + 4 * k; const float hs = P.hcur[k] + (P.hprv[k] - P.hcur[k]) * muc;
            if (cc < 64) LW[t * 72 + cc] = (bf16)f2bf(1.0f - 2.0f / (1.0f + __expf(2.0f * hs))); else LA[t * 72 + cc - 64] = (bf16)f2bf(hs); } }
    __syncthreads();
    { const int p = wave >> 2, tt = (wave >> 1) & 1; const LAS bf16* As = p ? LA : LW; const bf16* WT = (p ? C_AUT : C_WUT) + ((size_t)e * 768 + h * 64) * 64; LAS float* X = p ? XA : XW;
#pragma unroll
        for (int cc = 0; cc < 2; ++cc) { const int ct = 2 * (wave & 1) + cc; f32x4 acc = (f32x4){0.f, 0.f, 0.f, 0.f};
#pragma unroll
            for (int ks = 0; ks < 2; ++ks) acc = mfma16(*(const LAS bf16x8*)(As + (16 * tt + fr) * 72 + 32 * ks + 8 * fq), *(const bf16x8*)(WT + (size_t)(16 * ct + fr) * 64 + 32 * ks + 8 * fq), acc);
#pragma unroll
            for (int r = 0; r < 4; ++r) X[(16 * tt + 4 * fq + r) * 64 + 16 * ct + fr] = acc[r]; } }
    __syncthreads();
    float rr[4], k2[4], vv[4], kkv[4], bb[4];
    for (int rep3 = 0; rep3 < REP3; ++rep3) { asm volatile("" ::: "memory");
    { const f32x4 xw4 = *(const LAS f32x4*)(XW + t_ * 64 + c4), xa4 = *(const LAS f32x4*)(XA + t_ * 64 + c4);
        const f32x4 w04 = *(const f32x4*)(C_IN(18) + e * 768 + col), a04 = *(const f32x4*)(C_IN(20) + e * 768 + col), kk4 = *(const f32x4*)(C_IN(22) + e * 768 + col), ka4 = *(const f32x4*)(C_IN(23) + e * 768 + col),
                    rk4 = *(const f32x4*)(C_IN(24) + e * 768 + col), mr4 = *(const f32x4*)(mu + EC_R + col), mk4 = *(const f32x4*)(mu + EC_K + col), mv4 = *(const f32x4*)(mu + EC_V + col);
        float crf[4], ckf[4], cvf[4], prf[4], pkf[4], pvf[4]; unpk4(cr, crf); unpk4(ck, ckf); unpk4(cv, cvf); unpk4(pr, prf); unpk4(pk, pkf); unpk4(pv, pvf);
        const bool tok_ok = t_ < ntok;
#pragma unroll
        for (int i = 0; i < 4; ++i) { prf[i] += sh_r[i]; pkf[i] += sh_k[i]; pvf[i] += sh_v[i]; }
        float wl[4], av[4], ssum = 0.f, bsum = 0.f;
#pragma unroll
        for (int i = 0; i < 4; ++i) { const float r = crf[i] + (prf[i] - crf[i]) * mr4[i], k = ckf[i] + (pkf[i] - ckf[i]) * mk4[i], v = cvf[i] + (pvf[i] - cvf[i]) * mv4[i];
            wl[i] = -0.6065306597126334f * sigmoidf_(w04[i] + xw4[i]); av[i] = sigmoidf_(a04[i] + xa4[i]);
            const float kk = tok_ok ? k * kk4[i] : 0.f; ssum += kk * kk; kkv[i] = kk; k2[i] = tok_ok ? k * (1.0f + (av[i] - 1.0f) * ka4[i]) : 0.f; rr[i] = tok_ok ? r : 0.f; vv[i] = tok_ok ? v : 0.f; bsum += rr[i] * k2[i] * rk4[i];
            if (!tok_ok) wl[i] = 0.f; }
        ssum = red16(ssum); bsum = red16(bsum); const float inv = rsqrtf(fmaxf(ssum, 1e-24f));
#pragma unroll
        for (int i = 0; i < 4; ++i) { kkv[i] *= inv; bb[i] = kkv[i] * av[i]; }
        if ((tid & 15) == 0 && tok_ok) C_BONUS[(R0 + t_) * 12 + h] = bsum;
        *(LAS f32x4*)(PS + t_ * 64 + c4) = (f32x4){wl[0], wl[1], wl[2], wl[3]}; }
    __syncthreads();
    if (tid < 64) { float run = 0.f;
#pragma unroll 8
        for (int t = 0; t < 32; ++t) { run += PS[t * 64 + tid]; PS[t * 64 + tid] = run; } }
    __syncthreads();
    { const f32x4 pt = *(const LAS f32x4*)(PS + t_ * 64 + c4), pe = *(const LAS f32x4*)(PS + 31 * 64 + c4); const f32x4 pp = (t_ > 0) ? *(const LAS f32x4*)(PS + (t_ - 1) * 64 + c4) : (f32x4){0.f, 0.f, 0.f, 0.f};
        float o_kk[4], o_b[4], o_k[4], o_r[4], o_bh[4], o_kh[4];
#pragma unroll
        for (int i = 0; i < 4; ++i) { const float ct = __expf(pt[i]), cp = __expf(pp[i]), ci = __expf(-pt[i]), chh = __expf(pe[i] - pt[i]);
            o_kk[i] = kkv[i] * cp; o_b[i] = bb[i] * ci; o_k[i] = k2[i] * ci; o_r[i] = rr[i] * ct; o_bh[i] = bb[i] * chh; o_kh[i] = k2[i] * chh; }
        *(LAS u32x2*)(KKt + t_ * 72 + c4) = (u32x2){pk2(o_kk[0], o_kk[1]), pk2(o_kk[2], o_kk[3])}; *(LAS u32x2*)(Bt + t_ * 72 + c4) = (u32x2){pk2(o_b[0], o_b[1]), pk2(o_b[2], o_b[3])};
        *(LAS u32x2*)(Kt + t_ * 72 + c4) = (u32x2){pk2(o_k[0], o_k[1]), pk2(o_k[2], o_k[3])}; *(LAS u32x2*)(Rt + t_ * 72 + c4) = (u32x2){pk2(o_r[0], o_r[1]), pk2(o_r[2], o_r[3])};
        *(LAS u32x2*)(Bh + t_ * 72 + c4) = (u32x2){pk2(o_bh[0], o_bh[1]), pk2(o_bh[2], o_bh[3])}; *(LAS u32x2*)(Kh + t_ * 72 + c4) = (u32x2){pk2(o_kh[0], o_kh[1]), pk2(o_kh[2], o_kh[3])};
        *(LAS u32x2*)(Vb + t_ * 72 + c4) = (u32x2){pk2(vv[0], vv[1]), pk2(vv[2], vv[3])};
        *(LAS f32x4*)(RTf + t_ * 64 + c4) = (f32x4){o_r[0], o_r[1], o_r[2], o_r[3]}; *(LAS f32x4*)(SOL + t_ * 128 + c4) = (f32x4){o_kk[0], o_kk[1], o_kk[2], o_kk[3]};
        if (t_ == 31) *(LAS f32x4*)(c31 + c4) = (f32x4){__expf(pt[0]), __expf(pt[1]), __expf(pt[2]), __expf(pt[3])}; }
    __syncthreads(); }
    { const int m = wave >> 1, tt = wave & 1; const LAS bf16* X = (m < 2) ? KKt : Rt; const LAS bf16* Yv = (m & 1) ? Kt : Bt;
#pragma unroll
        for (int st = 0; st < 2; ++st) { f32x4 acc = (f32x4){0.f, 0.f, 0.f, 0.f};
            if (st <= tt) {
#pragma unroll
                for (int ks = 0; ks < 2; ++ks) acc = mfma16(*(const LAS bf16x8*)(X + (16 * tt + fr) * 72 + 32 * ks + 8 * fq), *(const LAS bf16x8*)(Yv + (16 * st + fr) * 72 + 32 * ks + 8 * fq), acc); }
#pragma unroll
            for (int r = 0; r < 4; ++r) { const int t = 16 * tt + 4 * fq + r, s_ = 16 * st + fr; const bool keep = (m < 2) ? (s_ < t) : (s_ <= t); const float val = keep ? acc[r] : 0.f;
                if (m == 0) LB[t * 32 + (s_ & 3) * 8 + (s_ >> 2)] = val; else if (m == 1) Lk[t * 40 + s_] = (bf16)f2bf(val); else if (m == 2) Mb[t * 40 + s_] = (bf16)f2bf(val); else Mk[t * 40 + s_] = (bf16)f2bf(val); } } }
    __syncthreads();
    { const int tt = wave >> 2, ict = wave & 3;
        const f32x4 acc = mfma16(*(const LAS bf16x8*)(Lk + (16 * tt + fr) * 40 + 8 * fq), tr_frag(Vb + (8 * fq + trow) * 72 + 16 * ict + tcol, 4 * 72), (f32x4){0.f, 0.f, 0.f, 0.f});
#pragma unroll
        for (int r = 0; r < 4; ++r) SOL[(16 * tt + 4 * fq + r) * 128 + 64 + 16 * ict + fr] = acc[r]; }
    __syncthreads();
    { const int cidx = tid >> 2, q = tid & 3; float xq[8];
#pragma unroll
        for (int u = 0; u < 8; ++u) xq[u] = 0.f;
#pragma unroll
        for (int t = 0; t < 32; ++t) { float part = 0.f;
            if (t > 0) { const f32x4 la = *(const LAS f32x4*)(LB + t * 32 + q * 8); part = la[0] * xq[0];
                if (t > 4) part += la[1] * xq[1]; if (t > 8) part += la[2] * xq[2]; if (t > 12) part += la[3] * xq[3];
                if (t > 16) { const f32x4 lb = *(const LAS f32x4*)(LB + t * 32 + q * 8 + 4); part += lb[0] * xq[4];
                    if (t > 20) part += lb[1] * xq[5]; if (t > 24) part += lb[2] * xq[6]; if (t > 28) part += lb[3] * xq[7]; }
                part += dppf<0xB1>(part); part += dppf<0x4E>(part); }
            const float xt = SOL[t * 128 + cidx] - part;
            if (q == (t & 3)) { xq[t >> 2] = xt;
                if (cidx < 64) KTb[t * 72 + cidx] = (bf16)f2bf(xt); else UVb[t * 72 + cidx - 64] = (bf16)f2bf(-xt); } } }
    __syncthreads();
    for (int rep9 = 0; rep9 < REP9; ++rep9) { asm volatile("" ::: "memory");
    unsigned char* chk = C_CHK + (size_t)item * CHK_BYTES; bf16* Ag = (bf16*)(chk + CK_A); bf16* RQg = (bf16*)(chk + CK_RQ); float* GTg = (float*)(chk + CK_GT); float* YVTg = (float*)(chk + CK_YVT);
    const f32x4 z4 = (f32x4){0.f, 0.f, 0.f, 0.f};
    { const int jt = wave >> 1;
        const bf16x8 BhT = tr_frag(Bh + (8 * fq + trow) * 72 + 16 * jt + tcol, 4 * 72), KhT = tr_frag(Kh + (8 * fq + trow) * 72 + 16 * jt + tcol, 4 * 72);
#pragma unroll
        for (int cc = 0; cc < 2; ++cc) { const int ct = 2 * (wave & 1) + cc;
            const f32x4 aA = mfma16(BhT, tr_frag(KTb + (8 * fq + trow) * 72 + 16 * ct + tcol, 4 * 72), z4);
            f32x4 aG = mfma16(BhT, tr_frag(UVb + (8 * fq + trow) * 72 + 16 * ct + tcol, 4 * 72), z4); aG = mfma16(KhT, tr_frag(Vb + (8 * fq + trow) * 72 + 16 * ct + tcol, 4 * 72), aG);
#pragma unroll
            for (int r = 0; r < 4; ++r) { const int j = 16 * jt + 4 * fq + r, jp = 16 * ct + fr; Ag[j * 72 + jp] = (bf16)f2bf(((j == jp) ? c31[j] : 0.f) - aA[r]); }
            *(f32x4*)(GTg + (16 * ct + fr) * 68 + 16 * jt + 4 * fq) = aG; } }
    { const int tt = wave >> 2, jt2 = wave & 3; const bf16x8 MbF = *(const LAS bf16x8*)(Mb + (16 * tt + fr) * 40 + 8 * fq);
        const f32x4 a = mfma16(MbF, tr_frag(KTb + (8 * fq + trow) * 72 + 16 * jt2 + tcol, 4 * 72), z4);
#pragma unroll
        for (int r = 0; r < 4; ++r) { const int t = 16 * tt + 4 * fq + r, j = 16 * jt2 + fr; RQg[t * 72 + j] = (bf16)f2bf(RTf[t * 64 + j] - a[r]); }
        f32x4 y = mfma16(MbF, tr_frag(UVb + (8 * fq + trow) * 72 + 16 * jt2 + tcol, 4 * 72), z4);
        y = mfma16(*(const LAS bf16x8*)(Mk + (16 * tt + fr) * 40 + 8 * fq), tr_frag(Vb + (8 * fq + trow) * 72 + 16 * jt2 + tcol, 4 * 72), y);
        *(f32x4*)(YVTg + (16 * jt2 + fr) * 36 + 16 * tt + 4 * fq) = y; }
    __syncthreads(); }
}
__device__ __forceinline__ void rwkv_stream(const Ctx& c, int bh, int it, int e) {
    const int b = bh / 12, h = bh % 12, lane = c.lane, fr = lane & 15, fq = lane >> 4;
    LAS bf16* Sl = (LAS bf16*)c.lds + c.wave * (16 * 72);
    const unsigned char* chk0 = C_CHK + (size_t)bh * 128 * CHK_BYTES;
    float* ya = C_YA + ((size_t)b * SEQ) * 768 + h * 64 + 16 * it + fr;
    f32x4 S[4];
#pragma unroll
    for (int jt = 0; jt < 4; ++jt) S[jt] = (f32x4){0.f, 0.f, 0.f, 0.f};
    bf16x8 A0[4][2], R0f[2][2], A1[4][2], R1f[2][2]; f32x4 G0[4], Y0[2], G1[4], Y1[2];
#define ST_LOAD(AF, RF, GV, YV, n_) do { const unsigned char* base_ = chk0 + (size_t)(n_) * CHK_BYTES; \
        _Pragma("unroll") for (int jt = 0; jt < 4; ++jt) { _Pragma("unroll") for (int ks = 0; ks < 2; ++ks) AF[jt][ks] = *(const bf16x8*)((const bf16*)(base_ + CK_A) + (16 * jt + fr) * 72 + 32 * ks + 8 * fq); \
            GV[jt] = *(const f32x4*)((const float*)(base_ + CK_GT) + (16 * it + fr) * 68 + 16 * jt + 4 * fq); } \
        _Pragma("unroll") for (int tt = 0; tt < 2; ++tt) { _Pragma("unroll") for (int ks = 0; ks < 2; ++ks) RF[tt][ks] = *(const bf16x8*)((const bf16*)(base_ + CK_RQ) + (16 * tt + fr) * 72 + 32 * ks + 8 * fq); \
            YV[tt] = *(const f32x4*)((const float*)(base_ + CK_YVT) + (16 * it + fr) * 36 + 16 * tt + 4 * fq); } } while (0)
#define ST_STEP(AF, RF, GV, YV, n_, tmax_) do { \
        _Pragma("unroll") for (int jt = 0; jt < 4; ++jt) *(LAS u32x2*)(Sl + fr * 72 + 16 * jt + 4 * fq) = (u32x2){pk2(S[jt][0], S[jt][1]), pk2(S[jt][2], S[jt][3])}; \
        asm volatile("s_waitcnt lgkmcnt(0)" ::: "memory"); \
        const bf16x8 Sf0 = *(const LAS bf16x8*)(Sl + fr * 72 + 8 * fq), Sf1 = *(const LAS bf16x8*)(Sl + fr * 72 + 32 + 8 * fq); \
        asm volatile("s_waitcnt lgkmcnt(0)" ::: "memory"); \
        _Pragma("unroll") for (int tt = 0; tt < 2; ++tt) { f32x4 y_ = mfma16(RF[tt][0], Sf0, YV[tt]); y_ = mfma16(RF[tt][1], Sf1, y_); \
            _Pragma("unroll") for (int r = 0; r < 4; ++r) if (16 * tt + 4 * fq + r < (tmax_)) ya[(size_t)(32 * (n_) + 16 * tt + 4 * fq + r) * 768] = y_[r]; } \
        _Pragma("unroll") for (int jt = 0; jt < 4; ++jt) { f32x4 a_ = mfma16(AF[jt][0], Sf0, GV[jt]); S[jt] = mfma16(AF[jt][1], Sf1, a_); } } while (0)
    ST_LOAD(A0, R0f, G0, Y0, 0);
#pragma unroll 1
    for (int n = 0; n < 128; n += 2) {
        ST_LOAD(A1, R1f, G1, Y1, n + 1);
        ST_STEP(A0, R0f, G0, Y0, n, 32);
        if (n + 2 < 128) ST_LOAD(A0, R0f, G0, Y0, n + 2);
        ST_STEP(A1, R1f, G1, Y1, n + 1, 32);
    }
    float* so = C_OUT + O_RWKV_P + (((size_t)e * 2 + b) * 12 + h) * 4096 + (size_t)(16 * it + fr) * 64 + 4 * fq;
#pragma unroll
    for (int jt = 0; jt < 4; ++jt) *(f32x4*)(so + 16 * jt) = S[jt];
}
__device__ __forceinline__ void rwkv_stream_block(const Ctx& c, int bh, int e) {
    const int b = bh / 12, h = bh % 12, tid = c.tid, lane = c.lane, wave = c.wave, fr = lane & 15, fq = lane >> 4, it = wave;
    LAS unsigned char* slots = c.lds;
    LAS bf16* Sl = (LAS bf16*)(c.lds + 2 * CHK_BYTES) + wave * (16 * 72);
    const unsigned char* g0 = C_CHK + (size_t)bh * 128 * CHK_BYTES + tid * 16;
    float* ya = C_YA + ((size_t)b * SEQ) * 768 + h * 64 + 16 * it + fr;
    f32x4 S[4];
#pragma unroll
    for (int jt = 0; jt < 4; ++jt) S[jt] = (f32x4){0.f, 0.f, 0.f, 0.f};
    u32x4 P0[5], P1[5], P2[5], P3[5];
#define SB_GLOAD(P, n_) do { const int nn_ = (n_) < 128 ? (n_) : 127;     \
        _Pragma("unroll") for (int k = 0; k < 5; ++k) P[k] = *(const u32x4*)(g0 + (size_t)nn_ * CHK_BYTES + k * 8192); } while (0)
#define SB_LWRITE(P, s_) do { _Pragma("unroll") for (int k = 0; k < 5; ++k) *(LAS u32x4*)(slots + (s_) * CHK_BYTES + tid * 16 + k * 8192) = P[k]; } while (0)
#define SB_STEP(s_, n_) do { if (wave < 4) { const LAS unsigned char* sb_ = slots + (s_) * CHK_BYTES; \
        bf16x8 af_[4][2], rf_[2][2]; f32x4 gv_[4], yv_[2];         \
        _Pragma("unroll") for (int jt = 0; jt < 4; ++jt) { const LAS bf16* a_ = (const LAS bf16*)(sb_ + CK_A) + (16 * jt + fr) * 72 + 8 * fq; af_[jt][0] = *(const LAS bf16x8*)a_; af_[jt][1] = *(const LAS bf16x8*)(a_ + 32); \
            gv_[jt] = *(const LAS f32x4*)((const LAS float*)(sb_ + CK_GT) + (16 * it + fr) * 68 + 16 * jt + 4 * fq); } \
        _Pragma("unroll") for (int tt = 0; tt < 2; ++tt) { const LAS bf16* rq_ = (const LAS bf16*)(sb_ + CK_RQ) + (16 * tt + fr) * 72 + 8 * fq; rf_[tt][0] = *(const LAS bf16x8*)rq_; rf_[tt][1] = *(const LAS bf16x8*)(rq_ + 32); \
            yv_[tt] = *(const LAS f32x4*)((const LAS float*)(sb_ + CK_YVT) + (16 * it + fr) * 36 + 16 * tt + 4 * fq); } \
        _Pragma("unroll") for (int jt = 0; jt < 4; ++jt) *(LAS u32x2*)(Sl + fr * 72 + 16 * jt + 4 * fq) = (u32x2){pk2(S[jt][0], S[jt][1]), pk2(S[jt][2], S[jt][3])}; \
        asm volatile("s_waitcnt lgkmcnt(0)" ::: "memory"); \
        const bf16x8 Sf0 = *(const LAS bf16x8*)(Sl + fr * 72 + 8 * fq), Sf1 = *(const LAS bf16x8*)(Sl + fr * 72 + 32 + 8 * fq); \
        asm volatile("s_waitcnt lgkmcnt(0)" ::: "memory"); __builtin_amdgcn_sched_barrier(0); \
        _Pragma("unroll") for (int jt = 0; jt < 4; ++jt) { f32x4 t_ = mfma16(af_[jt][0], Sf0, gv_[jt]); S[jt] = mfma16(af_[jt][1], Sf1, t_); } \
        _Pragma("unroll") for (int tt = 0; tt < 2; ++tt) { f32x4 y_ = mfma16(rf_[tt][0], Sf0, yv_[tt]); y_ = mfma16(rf_[tt][1], Sf1, y_); \
            _Pragma("unroll") for (int r = 0; r < 4; ++r) ya[(size_t)(32 * (n_) + 16 * tt + 4 * fq + r) * 768] = y_[r]; } } } while (0)
    SB_GLOAD(P0, 0); SB_GLOAD(P1, 1); SB_GLOAD(P2, 2); SB_GLOAD(P3, 3);
    SB_LWRITE(P0, 0); __syncthreads();
#pragma unroll 1
    for (int n = 0; n < 128; n += 4) {
        SB_LWRITE(P1, 1); SB_GLOAD(P0, n + 4); SB_STEP(0, n); __syncthreads();
        SB_LWRITE(P2, 0); SB_GLOAD(P1, n + 5); SB_STEP(1, n + 1); __syncthreads();
        SB_LWRITE(P3, 1); SB_GLOAD(P2, n + 6); SB_STEP(0, n + 2); __syncthreads();
        SB_LWRITE(P0, 0); SB_GLOAD(P3, n + 7); SB_STEP(1, n + 3); __syncthreads();
    }
#undef SB_GLOAD
#undef SB_LWRITE
#undef SB_STEP
    if (wave < 4) { float* so = C_OUT + O_RWKV_P + (((size_t)e * 2 + b) * 12 + h) * 4096 + (size_t)(16 * it + fr) * 64 + 4 * fq;
#pragma unroll
        for (int jt = 0; jt < 4; ++jt) *(f32x4*)(so + 16 * jt) = S[jt]; }
}
__device__ __forceinline__ void rwkv_stream_sample(const Ctx& c, int sidx, int it, int e) {
    const int ns = sidx / 12, h = sidx % 12, lane = c.lane, fr = lane & 15, fq = lane >> 4;
    LAS bf16* Sl = (LAS bf16*)c.lds + c.wave * (16 * 72);
    const unsigned char* chk0 = C_CHK + (size_t)(3072 + sidx) * CHK_BYTES;
    float* ya = C_YA + ((size_t)(TP + 4 * ns)) * 768 + h * 64 + 16 * it + fr;
    const float* si = C_IN(2) + (((size_t)e * 8 + ns) * 12 + h) * 4096 + (size_t)(16 * it + fr) * 64 + 4 * fq;
    f32x4 S[4];
#pragma unroll
    for (int jt = 0; jt < 4; ++jt) S[jt] = *(const f32x4*)(si + 16 * jt);
    bf16x8 A0[4][2], R0f[2][2]; f32x4 G0[4], Y0[2];
    ST_LOAD(A0, R0f, G0, Y0, 0);
    ST_STEP(A0, R0f, G0, Y0, 0, 4);
    float* so = C_OUT + O_RWKV_S + (((size_t)e * 8 + ns) * 12 + h) * 4096 + (size_t)(16 * it + fr) * 64 + 4 * fq;
#pragma unroll
    for (int jt = 0; jt < 4; ++jt) *(f32x4*)(so + 16 * jt) = S[jt];
}
#undef ST_LOAD
#undef ST_STEP
__device__ __forceinline__ void phase_even_tok_pre(Ctx c, int l) {
    const int e = l >> 1;
    constexpr int NI = 3072 + 96;
    PreIn A; if (c.bid < NI) rwkv_chunk_preload(c, c.bid, e, A);
    for (int it = c.bid; it < NI; it += c.G) { PreIn B; const int nx = (it + c.G < NI) ? it + c.G : it;
        rwkv_chunk_preload(c, nx, e, B); rwkv_chunk_precompute(c, it, e, A); A = B; }
}
__device__ __forceinline__ void phase_even_scan(Ctx c, int l) {
    const int e = l >> 1;
    if (c.G >= 240) {
        if (c.bid < 24) { for (int rp = 0; rp < REPS; ++rp) { rwkv_stream_block(c, c.bid, e); __syncthreads(); LAUNDER_C(c); } }
        else { Ctx h = c; h.bid = c.bid - 24; h.G = c.G - 24; LAUNDER_C(h);
            if (h.bid < 96) { if (h.wave < 4) rwkv_stream_sample(h, h.bid, h.wave, e); __syncthreads(); }
            even_helper_work(h, l); }
    } else {
        for (int it = c.bid; it < 24; it += c.G) { rwkv_stream_block(c, it, e); __syncthreads(); }
        for (int it = c.bid; it < 96; it += c.G) { if (c.wave < 4) rwkv_stream_sample(c, it, c.wave, e); __syncthreads(); }
        LAUNDER_C(c);
        even_helper_work(c, l);
    }
}
__device__ __forceinline__ void phase_even_ubuild(const Ctx& c, int l) {
    const int e = l >> 1; const float* r_k = C_IN(24) + e * 768; const float* lg = C_IN(25) + e * 768; const float* lb = C_IN(26) + e * 768; const float* muv = C_IN(17) + e * 2432 + EC_V;
    for (int R = c.bid * 8 + c.wave; R < TT; R += c.G * 8) {
        const bool hasprev = (R < TP) ? ((R & (SEQ - 1)) != 0) : (((R - TP) & 3) != 0);
        const float* shiftv = C_IN(3) + ((size_t)e * 8 + ((R >= TP) ? ((R - TP) >> 2) : 0)) * 2432 + EC_V;
        const bf16* hrow = C_HB + (size_t)R * LDH;
#pragma unroll 1
        for (int hb = 0; hb < 12; hb += 4) {
            float y[4], gate[4], cvv[4], pvv[4], bon[4], lgv[4], lbv[4], mv[4];
#pragma unroll
            for (int k = 0; k < 4; ++k) { const int col = (hb + k) * 64 + c.lane;
                y[k] = C_YA[(size_t)R * 768 + col]; gate[k] = bf2f(hrow[EC_GA + col]); cvv[k] = bf2f(hrow[EC_V + col]);
                pvv[k] = hasprev ? bf2f(hrow[EC_V + col - LDH]) : ((R < TP) ? 0.f : shiftv[col]);
                bon[k] = C_BONUS[(size_t)R * 12 + hb + k]; lgv[k] = lg[col]; lbv[k] = lb[col]; mv[k] = muv[col]; }
#pragma unroll
            for (int k = 0; k < 4; ++k) { const int col = (hb + k) * 64 + c.lane;
                const float mean = wave_sum(y[k]) * (1.0f / 64.0f); const float dlt = y[k] - mean; const float var = wave_sum(dlt * dlt) * (1.0f / 64.0f);
                const float yn = dlt * rsqrtf(var + 64e-5f) * lgv[k] + lbv[k];
                const float bonus = bon[k] * (cvv[k] + (pvv[k] - cvv[k]) * mv[k]);
                C_U[(size_t)R * EVEN_OUT + col] = (bf16)f2bf((yn + bonus) * siluf_(gate[k])); }
        }
    }
}

__device__ __forceinline__ void even_combine_dil(const Ctx& c) {
    for (int R = c.bid * 8 + c.wave; R < TP; R += c.G * 8) {
        const int hh = c.lane >> 4, d4 = 4 * (c.lane & 15);
        const float l0 = C_LSE[((size_t)0 * TT + R) * 4 + hh], l1 = C_LSE[((size_t)1 * TT + R) * 4 + hh], l2 = C_LSE[((size_t)2 * TT + R) * 4 + hh];
        const float mx = fmaxf(l0, fmaxf(l1, l2)); const float w0 = __expf(l0 - mx), w1 = __expf(l1 - mx), w2 = __expf(l2 - mx); const float inv = 1.0f / (w0 + w1 + w2);
        const f32x4 o0 = *(const f32x4*)(C_OG + ((size_t)0 * TT + R) * 256 + hh * 64 + d4), o1 = *(const f32x4*)(C_OG + ((size_t)1 * TT + R) * 256 + hh * 64 + d4), o2 = *(const f32x4*)(C_OG + ((size_t)2 * TT + R) * 256 + hh * 64 + d4);
        const f32x4 y = (o0 * w0 + o1 * w1 + o2 * w2) * inv;
        float gt[4]; unpk4(*(const u32x2*)(C_HB + (size_t)R * LDH + EC_GB + hh * 64 + d4), gt);
        *(u32x2*)(C_U + (size_t)R * EVEN_OUT + 768 + hh * 64 + d4) = (u32x2){pk2(y.x * siluf_(gt[0]), y.y * siluf_(gt[1])), pk2(y.z * siluf_(gt[2]), y.w * siluf_(gt[3]))};
    }
}
__device__ __forceinline__ void rot8(u32x4 w, const float* tb, float scale, float (&y)[8]) {
    float x[8]; unpk8(w, x); const f32x4 t0 = *(const f32x4*)tb, t1 = *(const f32x4*)(tb + 4);
    const float cs[8] = {t0.x, t0.y, t0.z, t0.w, t1.x, t1.y, t1.z, t1.w};
#pragma unroll
    for (int p = 0; p < 4; ++p) { const float co = cs[2 * p], si = cs[2 * p + 1], x0 = x[2 * p], x1 = x[2 * p + 1]; y[2 * p] = (x0 * co - x1 * si) * scale; y[2 * p + 1] = (x1 * co + x0 * si) * scale; }
}
__device__ __forceinline__ void ret_prompt_unit(const Ctx& c, int unit, int o) {
    const int b = unit / 48, h = (unit >> 3) % 6, es = unit & 7;
    LAS bf16* Qc = (LAS bf16*)c.lds;
    LAS bf16* Kc = Qc + 64 * 264;
    LAS bf16* Vc = Kc + 64 * 264;
    LAS bf16* Vz = Vc + 64 * 40;
    LAS bf16* Sb = Vz + 64 * 40;
    LAS bf16* Rt = Sb + 64 * 72;
    const float lg = LG2G[h];
    const int tid = c.tid, lane = c.lane, wave = c.wave, fr = lane & 15, fq = lane >> 4, it = wave >> 1, jt0 = (wave & 1) * 2, eto = wave & 1;
    f32x4 Racc[2][2];
#pragma unroll
    for (int a = 0; a < 2; ++a)
#pragma unroll
        for (int q = 0; q < 2; ++q) Racc[a][q] = (f32x4){0.f, 0.f, 0.f, 0.f};
    for (int i = tid; i < 32 * 264 / 2; i += 512) ((LAS unsigned*)Rt)[i] = 0u;
    const float g64 = exp2f(lg * 64.f);
    const int sj = tid >> 3, part = tid & 7;
    const int vj = (tid & 255) >> 2, vp = tid & 3; const float zeta = exp2f(lg * (float)(63 - vj));
    const bf16* gq = C_HB + ((size_t)b * SEQ + sj) * LDH + OC_Q + h * 256 + part * 32;
    const bf16* gk = gq + (OC_K - OC_Q); const bf16* gv = C_HB + ((size_t)b * SEQ + vj) * LDH + OC_V + h * 256 + es * 32 + vp * 8;
    u32x4 pq[4], pk[4], pv;
#pragma unroll
    for (int q = 0; q < 4; ++q) { pq[q] = *(const u32x4*)(gq + 8 * q); pk[q] = *(const u32x4*)(gk + 8 * q); }
    pv = *(const u32x4*)gv;
    const int trow = (lane & 15) >> 2, tcol = 4 * (lane & 3);
#pragma unroll 1
    for (int ch = 0; ch < 64; ++ch) {
        const size_t row0 = (size_t)b * SEQ + ch * 64;
#pragma unroll
        for (int q = 0; q < 4; ++q) { *(LAS u32x4*)(Qc + sj * 264 + part * 32 + 8 * q) = pq[q]; *(LAS u32x4*)(Kc + sj * 264 + part * 32 + 8 * q) = pk[q]; }
        if (wave < 4) { *(LAS u32x4*)(Vc + vj * 40 + vp * 8) = pv; float x[8]; unpk8(pv, x);
            *(LAS u32x4*)(Vz + vj * 40 + vp * 8) = (u32x4){pk2(x[0] * zeta, x[1] * zeta), pk2(x[2] * zeta, x[3] * zeta), pk2(x[4] * zeta, x[5] * zeta), pk2(x[6] * zeta, x[7] * zeta)}; }
        { const size_t adv = (size_t)((ch + 1 < 64) ? ch + 1 : 63) * 64 * LDH;
#pragma unroll
            for (int q = 0; q < 4; ++q) { pq[q] = *(const u32x4*)(gq + adv + 8 * q); pk[q] = *(const u32x4*)(gk + adv + 8 * q); }
            pv = *(const u32x4*)(gv + adv); }
        __syncthreads();
        f32x4 accS[2], accQ = (f32x4){0.f, 0.f, 0.f, 0.f};
#pragma unroll
        for (int q = 0; q < 2; ++q) accS[q] = (f32x4){0.f, 0.f, 0.f, 0.f};
#pragma unroll
        for (int kp = 0; kp < 4; ++kp) {
            bf16x8 Qf2[2], Kf2[2][2], Rf2[2];
#pragma unroll
            for (int kk = 0; kk < 2; ++kk) { const int ks = 2 * kp + kk; Qf2[kk] = *(const LAS bf16x8*)(Qc + (16 * it + fr) * 264 + 32 * ks + 8 * fq);
                Rf2[kk] = *(const LAS bf16x8*)(Rt + (16 * eto + fr) * 264 + 32 * ks + 8 * fq);
#pragma unroll
                for (int q = 0; q < 2; ++q) Kf2[kk][q] = *(const LAS bf16x8*)(Kc + (16 * (jt0 + q) + fr) * 264 + 32 * ks + 8 * fq); }
            asm volatile("s_waitcnt lgkmcnt(0)" ::: "memory"); __builtin_amdgcn_sched_barrier(0);
#pragma unroll
            for (int kk = 0; kk < 2; ++kk) { accQ = mfma16(Qf2[kk], Rf2[kk], accQ);
#pragma unroll
                for (int q = 0; q < 2; ++q) accS[q] = mfma16(Qf2[kk], Kf2[kk][q], accS[q]); }
        }
#pragma unroll
        for (int jj = 0; jj < 2; ++jj) { const int jt = jt0 + jj;
#pragma unroll
            for (int r = 0; r < 4; ++r) { const int i = 16 * it + 4 * fq + r, j = 16 * jt + fr; const float val = (i >= j) ? accS[jj][r] * exp2f(lg * (float)(i - j)) : 0.f; Sb[i * 72 + j] = (bf16)f2bf(val); } }
        __syncthreads();
        { bf16x8 Sfr[2], Vfr[2], Kfr[2][2], Zfr[2][2];
#pragma unroll
            for (int k2 = 0; k2 < 2; ++k2) { Sfr[k2] = *(const LAS bf16x8*)(Sb + (16 * it + fr) * 72 + 32 * k2 + 8 * fq);
                Vfr[k2] = tr_frag(Vc + (32 * k2 + 8 * fq + trow) * 40 + 16 * eto + tcol, 4 * 40);
#pragma unroll
                for (int dd = 0; dd < 2; ++dd) Kfr[dd][k2] = tr_frag(Kc + (32 * k2 + 8 * fq + trow) * 264 + 16 * (2 * wave + dd) + tcol, 4 * 264);
#pragma unroll
                for (int et = 0; et < 2; ++et) Zfr[et][k2] = tr_frag(Vz + (32 * k2 + 8 * fq + trow) * 40 + 16 * et + tcol, 4 * 40); }
            asm volatile("s_waitcnt lgkmcnt(0)" ::: "memory"); __builtin_amdgcn_sched_barrier(0);
            { f32x4 a2 = mfma16(Sfr[0], Vfr[0], (f32x4){0.f, 0.f, 0.f, 0.f}); a2 = mfma16(Sfr[1], Vfr[1], a2);
#pragma unroll
                for (int r = 0; r < 4; ++r) { const int i = 16 * it + 4 * fq + r; C_YR[(row0 + i) * 1536 + h * 256 + es * 32 + 16 * eto + fr] = a2[r] + accQ[r] * exp2f(lg * (float)(i + 1)); } }
#pragma unroll
            for (int dd = 0; dd < 2; ++dd)
#pragma unroll
                for (int et = 0; et < 2; ++et) { f32x4 a = Racc[dd][et] * g64; a = mfma16(Kfr[dd][0], Zfr[et][0], a); Racc[dd][et] = mfma16(Kfr[dd][1], Zfr[et][1], a); } }
        __syncthreads();
#pragma unroll
        for (int dd = 0; dd < 2; ++dd)
#pragma unroll
            for (int et = 0; et < 2; ++et) { const f32x4 a = Racc[dd][et]; const int dt = 2 * wave + dd;
                *(LAS u32x2*)(Rt + (16 * et + fr) * 264 + 16 * dt + 4 * fq) = (u32x2){pk2(a[0], a[1]), pk2(a[2], a[3])}; }
    }
    float* ro = C_OUT + O_RET_P + ((((size_t)o * 2 + b) * 6 + h) * 256) * 256 + es * 32;
#pragma unroll
    for (int dd = 0; dd < 2; ++dd)
#pragma unroll
        for (int et = 0; et < 2; ++et)
#pragma unroll
            for (int r = 0; r < 4; ++r) ro[(size_t)(16 * (2 * wave + dd) + 4 * fq + r) * 256 + 16 * et + fr] = Racc[dd][et][r];
    __syncthreads();
}
__device__ __forceinline__ void ret_sample_unit(const Ctx& c, int unit, int o) {
    const int n = unit / 6, h = unit % 6, tid = c.tid;
    LAS float* qs = (LAS float*)c.lds; LAS float* ks = qs + 1024; LAS float* vs = ks + 1024; LAS float* red = vs + 1024; LAS float* sc = red + 2048;
    const float lg = LG2G[h];
    for (int idx = tid; idx < 4 * 256; idx += 512) { const int t = idx >> 8, dd = idx & 255; const bf16* hr = C_HB + (size_t)(TP + n * 4 + t) * LDH + h * 256 + dd; qs[idx] = bf2f(hr[OC_Q]); ks[idx] = bf2f(hr[OC_K]); }
    for (int idx = tid; idx < 4 * 256; idx += 512) { const int t = idx >> 8, ee = idx & 255; vs[idx] = bf2f(C_HB[(size_t)(TP + n * 4 + t) * LDH + OC_V + h * 256 + ee]); }
    __syncthreads();
    if (tid < 16) { const int i = tid >> 2, j = tid & 3; float a = 0.f; for (int d = 0; d < 256; ++d) a += qs[i * 256 + d] * ks[j * 256 + d]; sc[tid] = (j <= i) ? a * exp2f(lg * (float)(i - j)) : 0.f; }
    __syncthreads();
    const int ee = tid & 255, dh = tid >> 8;
    const float* R0 = C_IN(7) + ((((size_t)o * 8 + n) * 6 + h) * 256) * 256; float* Rn = C_OUT + O_RET_S + ((((size_t)o * 8 + n) * 6 + h) * 256) * 256;
    const float g4 = exp2f(lg * 4.f), z0 = exp2f(lg * 3.f), z1 = exp2f(lg * 2.f), z2 = exp2f(lg), z3 = 1.0f;
    const float v0 = vs[ee] * z0, v1 = vs[256 + ee] * z1, v2 = vs[512 + ee] * z2, v3 = vs[768 + ee] * z3;
    float acc[4] = {0.f, 0.f, 0.f, 0.f};
#pragma unroll 4
    for (int d = dh * 128; d < dh * 128 + 128; ++d) { const float r0 = R0[(size_t)d * 256 + ee];
        acc[0] += qs[d] * r0; acc[1] += qs[256 + d] * r0; acc[2] += qs[512 + d] * r0; acc[3] += qs[768 + d] * r0;
        Rn[(size_t)d * 256 + ee] = g4 * r0 + ks[d] * v0 + ks[256 + d] * v1 + ks[512 + d] * v2 + ks[768 + d] * v3; }
#pragma unroll
    for (int i = 0; i < 4; ++i) red[(dh * 4 + i) * 256 + ee] = acc[i];
    __syncthreads();
    if (dh == 0) {
#pragma unroll
        for (int i = 0; i < 4; ++i) { float ov = (red[i * 256 + ee] + red[(4 + i) * 256 + ee]) * exp2f(lg * (float)(i + 1));
            for (int j = 0; j <= i; ++j) ov += sc[i * 4 + j] * vs[j * 256 + ee];
            C_YR[(size_t)(TP + n * 4 + i) * 1536 + h * 256 + ee] = ov; } }
    __syncthreads();
}
__device__ __forceinline__ void odd_helper_work(Ctx c, int l) {
    mem_attn_all(c, l, OC_QM, OC_GM, 1536, ODD_OUT);
    LAUNDER_C(c);
    if (l < 3) convert_layer_weights(c, l + 1);
}
__device__ __forceinline__ void phase_odd_tok(Ctx c, int l) {
    const int o = l >> 1;
    if (c.G >= 200) {
        if (c.bid < 96) ret_prompt_unit(c, c.bid, o);
        else if (c.bid < 144) ret_sample_unit(c, c.bid - 96, o);
        else { Ctx h = c; h.bid = c.bid - 144; h.G = c.G - 144; odd_helper_work(h, l); }
    } else {
        for (int it = c.bid; it < 144; it += c.G) { if (it < 96) ret_prompt_unit(c, it, o); else ret_sample_unit(c, it - 96, o); }
        LAUNDER_C(c);
        odd_helper_work(c, l);
    }
}
__device__ __forceinline__ void phase_odd_ubuild(const Ctx& c) {
    for (int R = c.bid * 8 + c.wave; R < TT; R += c.G * 8) {
#pragma unroll 1
        for (int hb = 0; hb < 6; hb += 3) {
            f32x4 ov[3]; u32x2 gw[3];
#pragma unroll
            for (int k = 0; k < 3; ++k) { const int col = (hb + k) * 256 + 4 * c.lane; ov[k] = *(const f32x4*)(C_YR + (size_t)R * 1536 + col); gw[k] = *(const u32x2*)(C_HB + (size_t)R * LDH + OC_G + col); }
#pragma unroll
            for (int k = 0; k < 3; ++k) { const int col = (hb + k) * 256 + 4 * c.lane; const f32x4 o = ov[k];
                const float ss = wave_sum(o.x * o.x + o.y * o.y + o.z * o.z + o.w * o.w); const float scl = rsqrtf(ss * (1.0f / 256.0f) + 1e-6f);
                float g[4]; unpk4(gw[k], g);
                *(u32x2*)(C_U + (size_t)R * DM + col) = (u32x2){pk2(o.x * scl * siluf_(g[0]), o.y * scl * siluf_(g[1])), pk2(o.z * scl * siluf_(g[2]), o.w * scl * siluf_(g[3]))}; }
        }
    }
}
__device__ __forceinline__ void small_outproj(const Ctx& c, int wt, int K, int l) {
    const int lane = c.lane, r = lane & 31, hl = lane >> 5, nks = K / 128;
    const bf16* ap = C_U + (size_t)(TP + r) * K + 8 * hl + c.wave * nks * 16; const bf16* bp = C_WTOUT_L(l) + (size_t)(32 * wt + r) * K + 8 * hl + c.wave * nks * 16;
    f32x16 acc;
#pragma unroll
    for (int i = 0; i < 16; ++i) acc[i] = 0.f;
    if (nks == 16) {
#pragma unroll
        for (int ks = 0; ks < 16; ++ks) acc = mfma32(*(const bf16x8*)(ap + 16 * ks), *(const bf16x8*)(bp + 16 * ks), acc);
    } else {
#pragma unroll
        for (int ks = 0; ks < 12; ++ks) acc = mfma32(*(const bf16x8*)(ap + 16 * ks), *(const bf16x8*)(bp + 16 * ks), acc);
    }
    LAS float* part = (LAS float*)c.lds;
#pragma unroll
    for (int i = 0; i < 16; ++i) part[(c.wave * 16 + i) * 64 + lane] = acc[i];
    __syncthreads();
    for (int idx = c.tid; idx < 1024; idx += 512) { float sum = 0.f;
#pragma unroll
        for (int w = 0; w < 8; ++w) sum += part[w * 1024 + idx];
        const int i = idx >> 6, ln = idx & 63, row = TP + (i & 3) + 8 * (i >> 2) + 4 * (ln >> 5), col = 32 * wt + (ln & 31);
        C_Z[(size_t)row * DM + col] = C_XZ[(size_t)row * DM + col] * ALPHA + sum; }
    __syncthreads();
}
__device__ __forceinline__ void phase_ln(const Ctx& c, int l) {
    const float* g = C_IN(15) + l * DM; const float* bta = C_IN(16) + l * DM;
    f32x4 gg[8], bb[8];
#pragma unroll
    for (int j = 0; j < 8; ++j) { const int col = 4 * c.lane + 256 * j; gg[j] = *(const f32x4*)(g + col); bb[j] = *(const f32x4*)(bta + col); }
    for (int R0 = c.bid * 8 + c.wave; R0 < TT; R0 += 2 * c.G * 8) {
        const int R1 = R0 + c.G * 8; const bool has1 = R1 < TT; const int R1c = has1 ? R1 : R0;
        f32x4 v0[8], v1[8]; float s0 = 0.f, s1 = 0.f;
        { const f32x4* z0 = (const f32x4*)(C_Z + (size_t)R0 * DM) + c.lane; const f32x4* z1 = (const f32x4*)(C_Z + (size_t)R1c * DM) + c.lane;
#pragma unroll
            for (int j = 0; j < 8; ++j) { v0[j] = z0[64 * j]; v1[j] = z1[64 * j]; } }
#pragma unroll
        for (int j = 0; j < 8; ++j) { s0 += (v0[j].x + v0[j].y) + (v0[j].z + v0[j].w); s1 += (v1[j].x + v1[j].y) + (v1[j].z + v1[j].w); }
        const float m0 = wave_sum(s0) * (1.0f / DM), m1 = wave_sum(s1) * (1.0f / DM); float q0 = 0.f, q1 = 0.f;
#pragma unroll
        for (int j = 0; j < 8; ++j) { v0[j] = v0[j] - m0; v1[j] = v1[j] - m1; q0 += (v0[j].x * v0[j].x + v0[j].y * v0[j].y) + (v0[j].z * v0[j].z + v0[j].w * v0[j].w); q1 += (v1[j].x * v1[j].x + v1[j].y * v1[j].y) + (v1[j].z * v1[j].z + v1[j].w * v1[j].w); }
        const float r0 = rsqrtf(wave_sum(q0) * (1.0f / DM) + LN_EPS), r1 = rsqrtf(wave_sum(q1) * (1.0f / DM) + LN_EPS);
        float* d0 = (l == 3) ? (R0 < TP ? C_OUT + O_YP + (size_t)R0 * DM : C_OUT + O_YS + (size_t)(R0 - TP) * DM) : C_XZ + (size_t)R0 * DM;
        float* d1 = (l == 3) ? (R1c < TP ? C_OUT + O_YP + (size_t)R1c * DM : C_OUT + O_YS + (size_t)(R1c - TP) * DM) : C_XZ + (size_t)R1c * DM;
#pragma unroll
        for (int j = 0; j < 8; ++j) { const int col = 4 * c.lane + 256 * j;
            const f32x4 x0 = v0[j] * r0 * gg[j] + bb[j]; *(f32x4*)(d0 + col) = x0; if (l != 3) *(u32x2*)(C_XB + (size_t)R0 * DM + col) = (u32x2){pk2(x0.x, x0.y), pk2(x0.z, x0.w)};
            if (has1) { const f32x4 x1 = v1[j] * r1 * gg[j] + bb[j]; *(f32x4*)(d1 + col) = x1; if (l != 3) *(u32x2*)(C_XB + (size_t)R1 * DM + col) = (u32x2){pk2(x1.x, x1.y), pk2(x1.z, x1.w)}; } }
    }
}

#define XB_TMO      128
#define XB_XCNT(j)  (256  + 64 * (j))
#define XB_XSUB(j)  (1280 + 64 * (j))
#define XB_XGEN(j)  (2304 + 64 * (j))
#define XB_TOP      3328
#define XB_TOPGEN   3392
#define XCD_BAR_WORDS 3456
#define XB_SPIN_CAP (1u << 18)

__device__ __forceinline__ unsigned xb_ld(unsigned* p)              { return __hip_atomic_load(p, __ATOMIC_RELAXED, __HIP_MEMORY_SCOPE_AGENT); }
__device__ __forceinline__ unsigned xb_add(unsigned* p, unsigned v) { return __hip_atomic_fetch_add(p, v, __ATOMIC_RELAXED, __HIP_MEMORY_SCOPE_AGENT); }
__device__ __forceinline__ unsigned xb_xcc_id() { return (unsigned)__builtin_amdgcn_s_getreg((3 << 11) | 20) & 0xFu; }
#define XB_SPIN(cond, bar) do { unsigned _sp = 0; while (cond) { __builtin_amdgcn_s_sleep(1); \
    if ((++_sp & 255u) == 0u) { if (xb_ld(&(bar)[XB_TMO])) break; if (_sp > XB_SPIN_CAP) { atomicAdd(&(bar)[XB_TMO], 1u); break; } } } } while (0)

struct XcdBarrier {
    unsigned* bar; unsigned x;
    volatile LAS unsigned* st;
};

__device__ __forceinline__ XcdBarrier xcd_barrier_post(unsigned* bar, volatile LAS unsigned* st) {
    XcdBarrier b; b.bar = bar; b.x = xb_xcc_id(); b.st = st;
    if (threadIdx.x == 0) (void)xb_add(&bar[XB_XCNT(b.x)], 1u);
    return b;
}
__device__ __forceinline__ void xcd_barrier_complete(unsigned* bar, unsigned x, unsigned& nloc, unsigned& nx) {
    const unsigned G = gridDim.x * gridDim.y * gridDim.z;
    unsigned sum, cnt, mine, sp = 0u;
    for (;;) {
        sum = 0u; cnt = 0u; mine = 0u;
#pragma unroll
        for (unsigned j = 0; j < 16; ++j) { const unsigned c = xb_ld(&bar[XB_XCNT(j)]); sum += c; cnt += (c > 0u) ? 1u : 0u; mine = (j == x) ? c : mine; }
        if (sum == G) break;
        __builtin_amdgcn_s_sleep(1);
        if ((++sp & 255u) == 0u) { if (xb_ld(&bar[XB_TMO])) break; if (sp > XB_SPIN_CAP) { atomicAdd(&bar[XB_TMO], 1u); break; } }
    }
    nloc = mine > 0u ? mine : 1u; nx = cnt > 0u ? cnt : 1u;
}

__device__ __forceinline__ void xcd_barrier(const XcdBarrier& b) {
    asm volatile("s_waitcnt vmcnt(0)" ::: "memory");
    __syncthreads();
    if (threadIdx.x == 0) {
        unsigned* bar = b.bar;
        __builtin_amdgcn_s_waitcnt(0);
        unsigned nloc = b.st[0], nx = b.st[1];
        if (nloc == 0u) { xcd_barrier_complete(bar, b.x, nloc, nx); b.st[0] = nloc; b.st[1] = nx; }
        const unsigned old = xb_add(&bar[XB_XSUB(b.x)], 1u);
        const unsigned gen = old / nloc;
        if (old + 1u == (gen + 1u) * nloc) {
            __builtin_amdgcn_fence(__ATOMIC_RELEASE, "agent");
            asm volatile("s_waitcnt vmcnt(0)" ::: "memory");
            const unsigned og = xb_add(&bar[XB_TOP], 1u);
            const unsigned tg = og / nx;
            if (og + 1u == (tg + 1u) * nx) xb_add(&bar[XB_TOPGEN], 1u);
            else XB_SPIN(xb_ld(&bar[XB_TOPGEN]) == tg, bar);
            __builtin_amdgcn_fence(__ATOMIC_ACQUIRE, "agent");
            xb_add(&bar[XB_XGEN(b.x)], 1u);
            asm volatile("s_waitcnt vmcnt(0)" ::: "memory");
        } else {
            XB_SPIN(xb_ld(&bar[XB_XGEN(b.x)]) == gen, bar);
            __builtin_amdgcn_fence(__ATOMIC_ACQUIRE, "agent");
            asm volatile("s_waitcnt vmcnt(0)" ::: "memory");
        }
    }
    __syncthreads();
}

constexpr int NPH = 25;
__global__ void __launch_bounds__(512, 2) mk(Args args) {
    extern __shared__ __attribute__((aligned(16))) unsigned char lds_raw[];
    Ctx c;
    c.ap = (ArgsP)__builtin_amdgcn_kernarg_segment_ptr(); c.lds = (LAS unsigned char*)lds_raw;
    c.tid = threadIdx.x; c.lane = c.tid & 63; c.wave = __builtin_amdgcn_readfirstlane(c.tid >> 6); c.bid = blockIdx.x; c.G = gridDim.x;
    for (int u = c.tid; u < 16; u += 512) ((LAS unsigned*)(c.lds + 131072))[u] = 0u;
    __syncthreads();
    XcdBarrier xbar = xcd_barrier_post((unsigned*)(c.ap->ws + WS_CTL) + 4096, (volatile LAS unsigned*)(c.lds + 131072));
#define LAUNDER() do { asm volatile("" : "+s"(c.ap), "+v"(c.tid), "+s"(c.bid), "+s"(c.G)); c.lane = c.tid & 63; c.wave = __builtin_amdgcn_readfirstlane(c.tid >> 6); } while (0)
    const int lo = args.ph_lo, hi = args.ph_hi;
#define IN(k) (lo <= (k) && (k) < hi)
#if USE_CG
#define SEAM(k) do { if (IN(k) && IN((k) + 1)) { cg::this_grid().sync(); } } while (0)
#else
#define SEAM(k) do { if (IN(k) && IN((k) + 1)) { asm volatile("" : "+s"(xbar.bar)); xcd_barrier(xbar); } } while (0)
#endif
    #if !(DIS & 1)
    if (IN(0)) { for (int rep = 0; rep < ((DUP & 128) ? 2 : 1); ++rep) { LAUNDER(); phase_prologue(c); if (DUP & 128) { asm volatile("" : "+s"(xbar.bar)); xcd_barrier(xbar); } } }
#endif
    SEAM(0);
#pragma unroll 1
    for (int l = 0; l < 4; ++l) {
        const int p0 = 1 + 6 * l; const bool even = (l & 1) == 0;
#if !(DIS & 2)
        if (IN(p0)) { for (int rep = 0; rep < ((DUP & 16) ? 2 : 1); ++rep) { LAUNDER();
            if (l == 0) { pg8::Gemm g{C_MEMB, C_WTMEM, 512, 4096, DM}; pg8::StaticOrder S; S.init(512, 4096, c.G, (c.bid + c.G - c.G / 2) % c.G);
                pg8::EpiF32Split E{C_OUT + O_MEM, 1024, 1024, (size_t)512 * 1024, C_MKVB};
                pg8::gemm_phase<pg8::EpiF32Split, pg8::StaticOrder, true, true>(c.lds, g, S, E); }
            const int ngemm = (l == 0) ? 5 : 1;
#pragma unroll 1
            for (int gi = 0; gi < ngemm; ++gi) {
                const int NI = even ? EVEN_INP : ODD_IN;
                const bf16* A = gi ? C_WTMEM + ((size_t)(gi - 1) * 1024 + 512) * DM : C_XB; const bf16* Bt = gi ? C_MEMB : C_WTIN;
                const int Mg = gi ? 512 : MPAD, Ng = gi ? 512 : NI;
                bf16* Og = gi ? C_VT + (size_t)(gi - 1) * 512 * 512 : C_HB; const int ldo = gi ? 512 : LDH;
                pg8::Gemm g{A, Bt, Mg, Ng, DM}; pg8::StaticOrder S; S.init(Mg, Ng, c.G, gi ? (c.bid + 2 * c.G - (5 * c.G) / 8 - 8 * (gi - 1)) % c.G : c.bid); pg8::EpiBf16NP E{Og, ldo, C_TAB, (gi == 0 && !even) ? 3072 : 0, 1536};
                pg8::gemm_phase<pg8::EpiBf16NP, pg8::StaticOrder, true, true>(c.lds, g, S, E);
            }
            if (DUP & 16) { asm volatile("" : "+s"(xbar.bar)); xcd_barrier(xbar); }
        } }
#endif
        SEAM(p0);
#if !(DIS & 4)
        if (IN(p0 + 1)) { for (int rep = 0; rep < ((DUP & 1) ? 2 : 1); ++rep) { LAUNDER(); if (even) phase_even_tok_pre(c, l); if (DUP & 1) { asm volatile("" : "+s"(xbar.bar)); xcd_barrier(xbar); } } }
#endif
#if !(DIS & 8)
        if (IN(p0 + 1)) { for (int rep = 0; rep < ((DUP & 2) ? 2 : 1); ++rep) { LAUNDER(); if (!even) phase_odd_tok(c, l); if (DUP & 2) { asm volatile("" : "+s"(xbar.bar)); xcd_barrier(xbar); } } }
#endif
        SEAM(p0 + 1);
#if !(DIS & 16)
        if (IN(p0 + 2)) { for (int rep = 0; rep < ((DUP & 4) ? 2 : 1); ++rep) { LAUNDER(); if (even) phase_even_scan(c, l); if (DUP & 4) { asm volatile("" : "+s"(xbar.bar)); xcd_barrier(xbar); } } }
#endif
        SEAM(p0 + 2);
#if !(DIS & 32)
        if (IN(p0 + 3)) { for (int rep = 0; rep < ((DUP & 8) ? 2 : 1); ++rep) { LAUNDER(); if (even) { phase_even_ubuild(c, l); LAUNDER(); even_combine_dil(c); } else phase_odd_ubuild(c); if (DUP & 8) { asm volatile("" : "+s"(xbar.bar)); xcd_barrier(xbar); } } }
#endif
        SEAM(p0 + 3);
#if !(DIS & 64)
        if (IN(p0 + 4)) { for (int rep = 0; rep < ((DUP & 32) ? 2 : 1); ++rep) { LAUNDER(); const int K = even ? EVEN_OUT : ODD_OUT;
            pg8::Gemm g{C_U, C_WTOUT_L(l), TP, DM, K}; pg8::StaticOrder S; S.init(TP, DM, c.G, c.bid); pg8::EpiResid E{C_XZ, C_Z, DM, ALPHA};
            pg8::gemm_phase<pg8::EpiResid, pg8::StaticOrder, true, true>(c.lds, g, S, E);
            LAUNDER(); if (c.bid < 64) small_outproj(c, c.bid, K, l); if (DUP & 32) { asm volatile("" : "+s"(xbar.bar)); xcd_barrier(xbar); } } }
#endif
        SEAM(p0 + 4);
#if !(DIS & 128)
        if (IN(p0 + 5)) { for (int rep = 0; rep < ((DUP & 64) ? 2 : 1); ++rep) { LAUNDER(); phase_ln(c, l); if (DUP & 64) { asm volatile("" : "+s"(xbar.bar)); xcd_barrier(xbar); } } }
#endif
        SEAM(p0 + 5);
    }
#undef IN
#undef SEAM
}

extern "C" void kernel_launch(void* const* d_in, const int* in_sizes, int n_in, void* d_out, int out_size, void* d_ws, size_t ws_size, hipStream_t stream) {
    static int grid = 0;
    if (grid == 0) {
        if (n_in != 27 || (size_t)out_size != O_END || ws_size < WS_END) { fprintf(stderr, "kernel_launch: unexpected shapes: n_in %d out %d ws %zu (need %zu)\n", n_in, out_size, ws_size, (size_t)WS_END); grid = -1; return; }
        int dev = 0, cus = 0, per_cu = 0;
        hipGetDevice(&dev); hipDeviceGetAttribute(&cus, hipDeviceAttributeMultiprocessorCount, dev);
        if (hipFuncSetAttribute((const void*)mk, hipFuncAttributeMaxDynamicSharedMemorySize, LDS_BYTES) != hipSuccess) { fprintf(stderr, "kernel_launch: hipFuncSetAttribute failed\n"); grid = -1; return; }
        if (hipOccupancyMaxActiveBlocksPerMultiprocessor(&per_cu, (const void*)mk, 512, LDS_BYTES) != hipSuccess || per_cu < 1) { fprintf(stderr, "kernel_launch: occupancy query says %d\n", per_cu); per_cu = 1; }
        (void)hipGetLastError();
        grid = cus;
        fprintf(stderr, "kernel_launch: grid %d (cus %d, per_cu %d)\n", grid, cus, per_cu);
    }
    if (grid < 0) return;
    if (hipMemsetAsync((char*)d_ws + WS_CTL, 0, 1u << 20, stream) != hipSuccess) { fprintf(stderr, "kernel_launch: memset failed\n"); return; }
    Args a{};
    for (int i = 0; i < 27; ++i) a.in[i] = (const float*)d_in[i];
    a.out = (float*)d_out; a.ws = (unsigned char*)d_ws;
#if ONE_LAUNCH
    a.ph_lo = 0; a.ph_hi = NPH;
    void* kargs[] = {&a};
    hipError_t e = hipLaunchCooperativeKernel((const void*)mk, dim3(grid), dim3(512), kargs, LDS_BYTES, stream);
    if (e != hipSuccess) fprintf(stderr, "kernel_launch: cooperative launch failed: %s\n", hipGetErrorString(e));
#else
    for (int p = 0; p < NPH; ++p) {
        if (p >= 1 && ((p - 1) % 6) == 2 && (((p - 1) / 6) & 1)) continue;
        a.ph_lo = p; a.ph_hi = p + 1;
        hipLaunchKernelGGL(mk, dim3(grid), dim3(512), LDS_BYTES, stream, a);
    }
#endif
}
```

```cpp
#include <hip/hip_runtime.h>
#include <hip/hip_cooperative_groups.h>
#include <cstdio>
#include <cstdint>
namespace cg = cooperative_groups;
#ifndef DIS
#define DIS 0
#endif
#ifndef REPD
#define REPD 1
#endif
#ifndef REPM
#define REPM 1
#endif
#ifndef REPC
#define REPC 1
#endif
#ifndef REPS
#define REPS 1
#endif
#ifndef REP9
#define REP9 1
#endif
#ifndef REP3
#define REP3 1
#endif
#ifndef REP8
#define REP8 1
#endif
#ifndef REP1
#define REP1 1
#endif
#ifndef DUP
#define DUP 0
#endif
#ifndef USE_CG
#define USE_CG 0
#endif
#ifndef ONE_LAUNCH
#define ONE_LAUNCH 1
#endif
namespace pg8 {
#define PG8_LAS __attribute__((address_space(3)))
typedef unsigned short bf16_t;
typedef short bf16x8 __attribute__((ext_vector_type(8)));
typedef float f32x4 __attribute__((ext_vector_type(4)));
typedef unsigned u32x4 __attribute__((ext_vector_type(4)));
constexpr int BM = 256, BK = 64, HALF = 128, HTB = HALF * BK * 2  , STAGE_BYTES = 8 * HTB, NXCD = 8, WGM = 8;

__host__ __device__ __forceinline__ int lds_byte(int r, int c) { const int st = (r >> 4) * 2 + (c >> 5), rr = r & 15, cc = c & 31, ob = rr * 64 + cc * 2; return st * 1024 + (ob ^ (((ob >> 9) & 1) << 5)); }
__host__ __device__ __forceinline__ void stage_rc(int b, int& R, int& C) { const int st = b / 1024, sb = b % 1024, swz = sb ^ (((sb >> 9) & 1) << 5); R = (st >> 1) * 16 + swz / 64; C = (st & 1) * 32 + (swz % 64) / 2; }
__host__ __device__ __forceinline__ int perm32(int rho) { const int n = rho >> 4, i = rho & 15; return 8 * (i >> 2) + 4 * n + (i & 3); }

struct Unit { int pm, pn; };
struct Gemm { const bf16_t* A; const bf16_t* Bt; int M, N, K; };

struct StaticOrder {
    int nM, nN, nwg, G, c;
    __host__ __device__ void init(int M, int N, int G_, int c_) { nM = M / BM; nN = N / BM; nwg = nM * nN; G = G_; c = c_; }
    __host__ __device__ bool next(int i, Unit& u) const {
        const long L = (long)i * G + c; if (L >= nwg) return false;
        int wgid = (int)L; { const int q = nwg / NXCD, r = nwg % NXCD, xcd = wgid % NXCD, off = wgid / NXCD; wgid = (xcd < r ? xcd * (q + 1) : r * (q + 1) + (xcd - r) * q) + off; }
        const int nig = WGM * nN, gid = wgid / nig, fm = gid * WGM, gsz = (nM - fm) < WGM ? (nM - fm) : WGM;
        u.pm = fm + ((wgid % nig) % gsz); u.pn = (wgid % nig) / gsz; return true;
    }
    __device__ __forceinline__ void a_ready(const Unit&) const {}
    __device__ __forceinline__ void done(const Unit&) const {}
};

__device__ __forceinline__ unsigned cvt_pk_bf16(float lo, float hi) { unsigned r; asm volatile("v_cvt_pk_bf16_f32 %0, %1, %2" : "=v"(r) : "v"(lo), "v"(hi)); return r; }
typedef float f32x2 __attribute__((ext_vector_type(2)));
__device__ __forceinline__ f32x2 gelu_pk(f32x2 v) {
    const f32x2 av = __builtin_elementwise_abs(v), d = av * 0.2316418882f + 1.0f;
    f32x2 t; t.x = __builtin_amdgcn_rcpf(d.x); t.y = __builtin_amdgcn_rcpf(d.y);
    f32x2 q = t * 0.5307027145f + (-0.7265760135f); q = q * t + 0.7107068705f; q = q * t + (-0.142248368f); q = q * t + 0.127414796f; q = q * t;
    const f32x2 s = (v * v) * (-0.72134752044f);
    f32x2 e; e.x = __builtin_amdgcn_exp2f(s.x); e.y = __builtin_amdgcn_exp2f(s.y);
    const f32x2 m = v * (q * e), r = v - m;
    f32x2 o; o.x = v.x < 0.f ? m.x : r.x; o.y = v.y < 0.f ? m.y : r.y; return o;
}

template <int ACT  > struct EpiBf16 {
    static constexpr bool PERM = true, AFTER_DRAIN = false; static_assert(ACT == 0 || ACT == 1, "EpiBf16: ACT is 0 (none) or 1 (gelu_pk)");
    bf16_t* O; int ldc; const float* bias; int split_cols; size_t split_stride; float scale0;
    __device__ __forceinline__ void operator()(const f32x4 (&acc)[2][2][4][2], const Unit& u, int wr, int wc, int fr, int fq) const {
        const int row0 = u.pm * BM + wr * 64 + fr; int colt = u.pn * BM; bf16_t* base = O;
        float sc = 1.f; if (split_cols) { const int t = colt / split_cols; base += (size_t)t * split_stride; colt -= t * split_cols; if (t == 0) sc = scale0; }
        const int col0 = colt + wc * 32 + 8 * fq, bcol0 = u.pn * BM + wc * 32 + 8 * fq;
        f32x4 bv[2][2];
#pragma unroll
        for (int bj = 0; bj < 2; ++bj)
#pragma unroll
            for (int n = 0; n < 2; ++n) bv[bj][n] = bias ? *(const f32x4*)(bias + bcol0 + bj * HALF + 4 * n) : (f32x4){0.f, 0.f, 0.f, 0.f};
#pragma unroll
        for (int ai = 0; ai < 2; ++ai)
#pragma unroll
            for (int m = 0; m < 4; ++m) { bf16_t* rowp = base + (size_t)(row0 + ai * HALF + m * 16) * ldc + col0;
#pragma unroll
                for (int bj = 0; bj < 2; ++bj) { f32x4 v0 = acc[ai][bj][m][0] + bv[bj][0], v1 = acc[ai][bj][m][1] + bv[bj][1];
                    if (ACT == 1) { f32x2 a = gelu_pk((f32x2){v0[0], v0[1]}), b = gelu_pk((f32x2){v0[2], v0[3]}), c = gelu_pk((f32x2){v1[0], v1[1]}), d = gelu_pk((f32x2){v1[2], v1[3]});
                        v0 = (f32x4){a.x, a.y, b.x, b.y}; v1 = (f32x4){c.x, c.y, d.x, d.y}; }
                    v0 = v0 * sc; v1 = v1 * sc; u32x4 w; w.x = cvt_pk_bf16(v0[0], v0[1]); w.y = cvt_pk_bf16(v0[2], v0[3]); w.z = cvt_pk_bf16(v1[0], v1[1]); w.w = cvt_pk_bf16(v1[2], v1[3]);
                    *(u32x4*)(rowp + bj * HALF) = w; } }
    }
};
struct EpiF32Split {
    static constexpr bool PERM = false, AFTER_DRAIN = false;
    float* C; int ldc; int split_cols; size_t split_stride; bf16_t* MB;
    __device__ __forceinline__ void operator()(const f32x4 (&acc)[2][2][4][2], const Unit& u, int wr, int wc, int fr, int fq) const {
        typedef unsigned u32x2v __attribute__((ext_vector_type(2)));
        int colt = u.pn * BM; float* base = C; bf16_t* mb = MB;
        if (split_cols) { const int t = colt / split_cols; base += (size_t)t * split_stride; mb += (size_t)t * split_stride; colt -= t * split_cols; }
        const int row0 = u.pm * BM + wr * 64 + fr, col0 = colt + wc * 32 + 4 * fq;
#pragma unroll
        for (int ai = 0; ai < 2; ++ai)
#pragma unroll
            for (int m = 0; m < 4; ++m) { float* rowp = base + (size_t)(row0 + ai * HALF + m * 16) * ldc + col0; bf16_t* rowb = mb + (size_t)(row0 + ai * HALF + m * 16) * ldc + col0;
#pragma unroll
                for (int bj = 0; bj < 2; ++bj)
#pragma unroll
                    for (int n = 0; n < 2; ++n) { const f32x4 v = acc[ai][bj][m][n]; *(f32x4*)(rowp + bj * HALF + n * 16) = v;
                        u32x2v w; w.x = cvt_pk_bf16(v[0], v[1]); w.y = cvt_pk_bf16(v[2], v[3]); *(u32x2v*)(rowb + bj * HALF + n * 16) = w; } }
    }
};
struct EpiBf16NP {
    static constexpr bool PERM = false, AFTER_DRAIN = false;
    bf16_t* O; int ldc; const float* TAB; int rot_cols, kcol0;
    __device__ __forceinline__ void operator()(const f32x4 (&acc)[2][2][4][2], const Unit& u, int wr, int wc, int fr, int fq) const {
        typedef unsigned u32x2v __attribute__((ext_vector_type(2)));
        const int row0 = u.pm * BM + wr * 64 + fr, col0 = u.pn * BM + wc * 32 + 4 * fq;
        const bool rot = u.pn * BM < rot_cols; const float scl = (u.pn * BM >= kcol0) ? 0.0625f : 1.0f;
#pragma unroll
        for (int ai = 0; ai < 2; ++ai)
#pragma unroll
            for (int m = 0; m < 4; ++m) { const int row = row0 + ai * HALF + m * 16; bf16_t* rowp = O + (size_t)row * ldc + col0;
                const int p = row < 8192 ? (row & 4095) : (row < 8224 ? 4096 + ((row - 8192) & 3) : 0);
                const float* tb = TAB + ((size_t)p * 128 + ((col0 & 255) >> 1)) * 2;
#pragma unroll
                for (int bj = 0; bj < 2; ++bj)
#pragma unroll
                    for (int n = 0; n < 2; ++n) { f32x4 v = acc[ai][bj][m][n];
                        if (rot) { const f32x4 cs = *(const f32x4*)(tb + bj * HALF + n * 16);
                            v = (f32x4){(v[0] * cs[0] - v[1] * cs[1]) * scl, (v[1] * cs[0] + v[0] * cs[1]) * scl, (v[2] * cs[2] - v[3] * cs[3]) * scl, (v[3] * cs[2] + v[2] * cs[3]) * scl}; }
                        u32x2v w; w.x = cvt_pk_bf16(v[0], v[1]); w.y = cvt_pk_bf16(v[2], v[3]); *(u32x2v*)(rowp + bj * HALF + n * 16) = w; } }
    }
};
struct EpiResid {
    static constexpr bool PERM = false, AFTER_DRAIN = false;
    const float* __restrict__ X; float* __restrict__ Z; int ldc; float alpha;
    __device__ __forceinline__ void operator()(const f32x4 (&acc)[2][2][4][2], const Unit& u, int wr, int wc, int fr, int fq) const {
        const int row0 = u.pm * BM + wr * 64 + fr, col0 = u.pn * BM + wc * 32 + 4 * fq;
#pragma unroll
        for (int ai = 0; ai < 2; ++ai)
#pragma unroll
            for (int mp = 0; mp < 2; ++mp) { f32x4 xv[2][2][2];
#pragma unroll
                for (int mm = 0; mm < 2; ++mm) { const float* rowp = X + (size_t)(row0 + ai * HALF + (2 * mp + mm) * 16) * ldc + col0;
#pragma unroll
                    for (int bj = 0; bj < 2; ++bj)
#pragma unroll
                        for (int n = 0; n < 2; ++n) xv[mm][bj][n] = *(const f32x4*)(rowp + bj * HALF + n * 16); }
#pragma unroll
                for (int mm = 0; mm < 2; ++mm) { float* rowz = Z + (size_t)(row0 + ai * HALF + (2 * mp + mm) * 16) * ldc + col0;
#pragma unroll
                    for (int bj = 0; bj < 2; ++bj)
#pragma unroll
                        for (int n = 0; n < 2; ++n) *(f32x4*)(rowz + bj * HALF + n * 16) = xv[mm][bj][n] * alpha + acc[ai][bj][2 * mp + mm][n]; } }
    }
};
template <class Epi, class Sched, bool ALIGN_EPI = false, bool SP2 = false>
__device__ __forceinline__ void gemm_phase(PG8_LAS unsigned char* lds, const Gemm g, const Sched& S, const Epi& E) {
    int tid_ = threadIdx.x; asm volatile("" : "+v"(tid_));
    const int tid = tid_, wid = __builtin_amdgcn_readfirstlane(tid >> 6), lane = tid & 63, wr = wid >> 2, wc = wid & 3, fr = lane & 15, fq = lane >> 4;
    const int K = g.K, nt = K / BK;
    unsigned voffA[2], voffB[2];
#pragma unroll
    for (int i = 0; i < 2; ++i) { int R, C; stage_rc(tid * 16 + i * 8192, R, C); const int Rb = Epi::PERM ? ((R & ~31) + perm32(R & 31)) : R;
        voffA[i] = (unsigned)(R * K + C) * 2u; voffB[i] = (unsigned)(Rb * K + C) * 2u; }
    const size_t kstep = (size_t)(BK * 2);
    const size_t hstep = (size_t)HALF * K * 2;
    const size_t tstep = 2 * hstep;
    const unsigned ldsw = (unsigned)wid * 1024u;
    const int aoff = lds_byte(wr * 64 + fr, fq * 8), boff = lds_byte(wc * 32 + fr, fq * 8);
#define PG8_SA(b, h) (((b) * 2 + (h)) * HTB)
#define PG8_SB(b, h) ((4 + (b) * 2 + (h)) * HTB)
#define PG8_STAGE(bufoff, gbase, voff) do { _Pragma("unroll") for (int _i = 0; _i < 2; ++_i) \
        __builtin_amdgcn_global_load_lds((const unsigned*)((const char*)(gbase) + (voff)[_i]), (PG8_LAS unsigned*)(lds + (bufoff) + ldsw + _i * 8192), 16, 0, 0); } while (0)
#define PG8_LDA(dst, b, h) do { _Pragma("unroll") for (int m = 0; m < 4; ++m) _Pragma("unroll") for (int k = 0; k < 2; ++k) dst[m][k] = *(const PG8_LAS bf16x8*)(lds + PG8_SA(b, h) + aoff + m * 2048 + k * 1024); } while (0)
#define PG8_LDB(dst, b, h) do { _Pragma("unroll") for (int n = 0; n < 2; ++n) _Pragma("unroll") for (int k = 0; k < 2; ++k) dst[n][k] = *(const PG8_LAS bf16x8*)(lds + PG8_SB(b, h) + boff + n * 2048 + k * 1024); } while (0)
#define PG8_MMA(ai, bj, At, Bt) do { __builtin_amdgcn_s_setprio(1); _Pragma("unroll") for (int m = 0; m < 4; ++m) _Pragma("unroll") for (int n = 0; n < 2; ++n) _Pragma("unroll") for (int k = 0; k < 2; ++k) \
        acc[ai][bj][m][n] = __builtin_amdgcn_mfma_f32_16x16x32_bf16(Bt[n][k], At[m][k], acc[ai][bj][m][n], 0, 0, 0); __builtin_amdgcn_s_setprio(0); } while (0)
#define PG8_WAIT_V(n) asm volatile("s_waitcnt vmcnt(" #n ")" ::: "memory")
#define PG8_WAIT_L(n) asm volatile("s_waitcnt lgkmcnt(" #n ")" ::: "memory")
#define PG8_BAR __builtin_amdgcn_s_barrier()
#define PG8_SCHED __builtin_amdgcn_sched_barrier(0)
    Unit cur, nxt; int ui = 0;
    if (!S.next(0, cur)) return;
    f32x4 acc[2][2][4][2];
#pragma unroll
    for (int a = 0; a < 2; ++a)
#pragma unroll
        for (int b = 0; b < 2; ++b)
#pragma unroll
            for (int m = 0; m < 4; ++m)
#pragma unroll
                for (int n = 0; n < 2; ++n) acc[a][b][m][n] = (f32x4){0.f, 0.f, 0.f, 0.f};
    bf16x8 At[4][2], B0[2][2], B1[2][2];
    const char* cA = (const char*)g.A + (size_t)cur.pm * tstep; const char* cB = (const char*)g.Bt + (size_t)cur.pn * tstep;
    S.a_ready(cur);
    if constexpr (SP2) {
        PG8_STAGE(PG8_SB(0, 0), cB, voffB); PG8_STAGE(PG8_SB(0, 1), cB + hstep, voffB); PG8_STAGE(PG8_SA(0, 0), cA, voffA); PG8_STAGE(PG8_SA(0, 1), cA + hstep, voffA);
        if (wr == 1) PG8_BAR;
        PG8_WAIT_V(2); PG8_BAR;
        PG8_STAGE(PG8_SB(1, 0), cB + kstep, voffB); PG8_STAGE(PG8_SA(1, 0), cA + kstep, voffA); PG8_STAGE(PG8_SB(1, 1), cB + hstep + kstep, voffB);
        PG8_WAIT_V(6); PG8_BAR;
    } else {
        PG8_STAGE(PG8_SB(0, 0), cB, voffB); PG8_STAGE(PG8_SA(0, 0), cA, voffA); PG8_STAGE(PG8_SB(0, 1), cB + hstep, voffB); PG8_STAGE(PG8_SA(0, 1), cA + hstep, voffA);
        if (wr == 1) PG8_BAR;
        PG8_WAIT_V(4); PG8_BAR;
        PG8_STAGE(PG8_SB(1, 0), cB + kstep, voffB); PG8_STAGE(PG8_SA(1, 0), cA + kstep, voffA); PG8_STAGE(PG8_SB(1, 1), cB + hstep + kstep, voffB);
        PG8_WAIT_V(6); PG8_BAR;
    }
    for (;;) {
        const bool has_next = S.next(ui + 1, nxt);
        const char* nA = has_next ? (const char*)g.A + (size_t)nxt.pm * tstep : cA; const char* nB = has_next ? (const char*)g.Bt + (size_t)nxt.pn * tstep : cB;
        for (int t = 0; t < nt; t += 2) {
            const bool last = (t == nt - 2);
            const char* a1 = cA + (size_t)(t + 1) * kstep;
            const char* a2 = last ? nA : cA + (size_t)(t + 2) * kstep; const char* b2 = last ? nB : cB + (size_t)(t + 2) * kstep;
            const char* a3 = a2 + kstep; const char* b3 = b2 + kstep;
            if (last && has_next) S.a_ready(nxt);
            if constexpr (SP2) {
            PG8_LDB(B0, 0, 0); PG8_LDB(B1, 0, 1); PG8_SCHED; PG8_LDA(At, 0, 0); PG8_STAGE(PG8_SA(1, 1), a1 + hstep, voffA);
            PG8_WAIT_V(8); PG8_WAIT_L(0); PG8_BAR; PG8_MMA(0, 0, At, B0); PG8_MMA(0, 1, At, B1); PG8_BAR; PG8_SCHED;
            PG8_LDA(At, 0, 1); PG8_STAGE(PG8_SB(0, 0), b2, voffB); PG8_STAGE(PG8_SB(0, 1), b2 + hstep, voffB); PG8_STAGE(PG8_SA(0, 0), a2, voffA);
            PG8_WAIT_V(8); PG8_WAIT_L(0); PG8_BAR; PG8_MMA(1, 0, At, B0); PG8_MMA(1, 1, At, B1); PG8_BAR; PG8_SCHED;
            PG8_LDB(B0, 1, 0); PG8_LDB(B1, 1, 1); PG8_SCHED; PG8_LDA(At, 1, 0); PG8_STAGE(PG8_SA(0, 1), a2 + hstep, voffA);
            PG8_WAIT_V(8); PG8_WAIT_L(0); PG8_BAR; PG8_MMA(0, 0, At, B0); PG8_MMA(0, 1, At, B1); PG8_BAR; PG8_SCHED;
            PG8_LDA(At, 1, 1); PG8_STAGE(PG8_SB(1, 0), b3, voffB); PG8_STAGE(PG8_SB(1, 1), b3 + hstep, voffB); PG8_STAGE(PG8_SA(1, 0), a3, voffA);
            PG8_WAIT_V(8); PG8_WAIT_L(0); PG8_BAR; PG8_MMA(1, 0, At, B0); PG8_MMA(1, 1, At, B1); PG8_BAR; PG8_SCHED;
            } else {
            PG8_LDB(B0, 0, 0); PG8_SCHED; PG8_LDA(At, 0, 0); PG8_STAGE(PG8_SA(1, 1), a1 + hstep, voffA);
            PG8_WAIT_L(8); PG8_BAR; PG8_WAIT_L(0); PG8_MMA(0, 0, At, B0); PG8_BAR; PG8_SCHED;
            PG8_LDB(B1, 0, 1); PG8_STAGE(PG8_SB(0, 0), b2, voffB);
            PG8_BAR; PG8_WAIT_L(0); PG8_MMA(0, 1, At, B1); PG8_BAR;
            PG8_LDA(At, 0, 1); PG8_STAGE(PG8_SA(0, 0), a2, voffA);
            PG8_BAR; PG8_WAIT_L(0); PG8_MMA(1, 0, At, B0); PG8_BAR; PG8_SCHED;
            PG8_STAGE(PG8_SB(0, 1), b2 + hstep, voffB);
            PG8_WAIT_V(6); PG8_BAR; PG8_MMA(1, 1, At, B1); PG8_BAR;
            PG8_LDB(B0, 1, 0); PG8_SCHED; PG8_LDA(At, 1, 0); PG8_STAGE(PG8_SA(0, 1), a2 + hstep, voffA);
            PG8_WAIT_L(8); PG8_BAR; PG8_WAIT_L(0); PG8_MMA(0, 0, At, B0); PG8_BAR; PG8_SCHED;
            PG8_LDB(B1, 1, 1); PG8_STAGE(PG8_SB(1, 0), b3, voffB);
            PG8_BAR; PG8_WAIT_L(0); PG8_MMA(0, 1, At, B1); PG8_BAR;
            PG8_LDA(At, 1, 1); PG8_STAGE(PG8_SA(1, 0), a3, voffA);
            PG8_BAR; PG8_WAIT_L(0); PG8_MMA(1, 0, At, B0); PG8_BAR; PG8_SCHED;
            PG8_STAGE(PG8_SB(1, 1), b3 + hstep, voffB);
            PG8_WAIT_V(6); PG8_BAR; PG8_MMA(1, 1, At, B1); PG8_BAR;
            }
        }
        if constexpr (ALIGN_EPI) { if (wr == 0) PG8_BAR; }
        if constexpr (!Epi::AFTER_DRAIN) { E(acc, cur, wr, wc, fr, fq); S.done(cur); }
        if (!has_next) break;
#pragma unroll
        for (int a = 0; a < 2; ++a)
#pragma unroll
            for (int b = 0; b < 2; ++b)
#pragma unroll
                for (int m = 0; m < 4; ++m)
#pragma unroll
                    for (int n = 0; n < 2; ++n) acc[a][b][m][n] = (f32x4){0.f, 0.f, 0.f, 0.f};
        cur = nxt; cA = nA; cB = nB; ++ui;
        if constexpr (ALIGN_EPI) { if (wr == 1) PG8_BAR; }
    }
    PG8_WAIT_V(0);
    if constexpr (!ALIGN_EPI) { if (wr == 0) PG8_BAR; }
    PG8_BAR;
    if constexpr (Epi::AFTER_DRAIN) { E.fused(acc, cur, wr, wc, fr, fq, lds, wid, lane); S.done(cur); }
#undef PG8_SA
#undef PG8_SB
#undef PG8_STAGE
#undef PG8_LDA
#undef PG8_LDB
#undef PG8_MMA
#undef PG8_WAIT_V
#undef PG8_WAIT_L
#undef PG8_BAR
#undef PG8_SCHED
}
}
constexpr int DM = 2048, SEQ = 4096, TP = 8192, TS = 32, TT = TP + TS, MPAD = 8448;
constexpr int EVEN_IN = 6784, EVEN_INP = 6912, ODD_IN = 7168, LDH = 7168;
constexpr int EVEN_OUT = 1536, ODD_OUT = 2048;
constexpr float ALPHA = 1.6817928305074292f;
constexpr float LN_EPS = 1e-5f;
constexpr int EC_R = 0, EC_K = 768, EC_V = 1536, EC_HW = 2304, EC_HA = 2368, EC_GA = 2432, EC_QB = 3200, EC_KB = 3968, EC_VB = 4736, EC_GB = 5504, EC_QM = 5760, EC_GM = 6272;
constexpr int OC_Q = 0, OC_K = 1536, OC_V = 3072, OC_G = 4608, OC_QM = 6144, OC_GM = 6656;
constexpr size_t O_YP = 0, O_YS = 16777216, O_RWKV_P = O_YS + 65536, O_RWKV_S = O_RWKV_P + 196608, O_SH_P = O_RWKV_S + 786432, O_SH_S = O_SH_P + 9728,
    O_G0P = O_SH_S + 38912, O_G0S = O_G0P + 262144, O_G1P = O_G0S + 32768, O_G1S = O_G1P + 1048576, O_G2P = O_G1S + 32768, O_G2S = O_G2P + 4194304,
    O_RET_P = O_G2S + 32768, O_RET_S = O_RET_P + 1572864, O_MEM = O_RET_S + 6291456, O_END = O_MEM + 2097152;
constexpr size_t MiB = 1u << 20;
constexpr size_t WS_CTL = 0, WS_WTIN = 1 * MiB, WS_WTOUT = 29 * MiB, WS_WTMEM = 37 * MiB, WS_MEMB = 53 * MiB, WS_TAB = 55 * MiB, WS_XB = 60 * MiB, WS_XZ = 93 * MiB,
    WS_HB = 159 * MiB, WS_U = 275 * MiB, WS_YA = 308 * MiB, WS_PREP = 333 * MiB, WS_OG = 478 * MiB, WS_LSE = 478 * MiB + 49 * MiB / 2, WS_MKVB = 503 * MiB, WS_VT = 507 * MiB, WS_WTOUT2 = 509 * MiB, WS_END = 517 * MiB;
constexpr int LDS_BYTES = 147456;

#define LAS __attribute__((address_space(3)))
typedef unsigned short bf16;
typedef float f32x4 __attribute__((ext_vector_type(4)));
typedef short bf16x8 __attribute__((ext_vector_type(8)));
typedef unsigned u32x4 __attribute__((ext_vector_type(4)));
typedef unsigned u32x2 __attribute__((ext_vector_type(2)));

__device__ const double ANG[128] = {
1.0, 0.9300449458481392, 0.8649836012976682, 0.8044736266284181, 0.7481966305138833, 0.6958564947100448, 0.6471778159406796, 0.6019044567806663, 0.5597981979123284, 0.5206374846632574, 0.48421626123015066, 0.45034288645458387, 0.41883912544574814, 0.3895392117442728, 0.362288975092429, 0.336945030221216, 0.31337402238589046, 0.29145192568009903, 0.2710633904364836, 0.2521011362799124, 0.23446538763970548, 0.21806334875063282, 0.20280871538024622, 0.18862122071335174, 0.17542621300415914, 0.1631542627737973, 0.15174079748634942, 0.14112576178114528, 0.13125330147352265, 0.12207146966133185, 0.11353195339077617, 0.10558981944335787, 0.09820327790631257, 0.09133346228248625, 0.08494422498263796, 0.07900194712408967, 0.07347536163492155, 0.06833538873292307, 0.06355498291362295, 0.059108990642279875, 0.05497401800103736, 0.05112830759482943, 0.04755162406834012, 0.04422514763163046, 0.04113137503418572, 0.03825402746632876, 0.03557796490339495, 0.03308910644196496, 0.030774356208980617, 0.02862153445389273, 0.026619313461261302, 0.024757157946593413, 0.023025269621793302, 0.02141453563853956, 0.019916480638308563, 0.018523222156741202, 0.017227429147699425, 0.01602228340877477, 0.014901443705277463, 0.013859012403933875, 0.01288950444072537, 0.01198781845958378, 0.011149209970080915, 0.01036926638287344, 0.009643883791544459, 0.008969245378672715, 0.008341801332506338, 0.007758250168566794, 0.007215521357901014, 0.006710759170575141, 0.006241307649397462, 0.00580469663480544, 0.005398628767382501, 0.005020967399614466, 0.004669725353279709, 0.0043430544633167095, 0.0040392358531509045, 0.003756670890311596, 0.0034938727747491297, 0.0032494587155918425, 0.0030221426551783792, 0.002810728502080728, 0.002614103837511492, 0.002431234061999789, 0.002261156951536743, 0.002102977594546134, 0.0019558636830395095, 0.0018190411331788228, 0.0016917900122028363, 0.0015734407502856099, 0.0014633706173946357, 0.0013610004466105522, 0.001265791586667203, 0.001177243067676929, 0.001094888965127687, 0.0010182959482819048, 0.0009470610000772239, 0.0008808092965317064, 0.0008191922344953685, 0.0007618855973704613, 0.0007085878491488872, 0.0006590185477903263, 0.0006129168695925734, 0.0005700402367896359, 0.0005301630411562774, 0.000493075456902875, 0.00045858233661428085, 0.00042650218442334204, 0.0003966662010161199, 0.00036891739544382435, 0.0003431097590679882, 0.0003191074972923552, 0.00029678431503900375, 0.0002760227522090274, 0.00025671356563109924, 0.00023875515424585844, 0.00022205302450155334, 0.00020651929314796272, 0.00019207222481239299, 0.0001786358019245737, 0.00016613932472747905, 0.0001545170392694147, 0.0001437077914199376, 0.00013365470508911156, 0.00012430488295695166, 0.00011560912813835741, 0.00010752168531898921, 0.0001};
__device__ const float LG2G[6] = {-0.04580368961312479f, -0.02272007650008353f, -0.011315313227834146f, -0.005646563141142063f, -0.0028205190623786626f, -0.0014095702546713536f};

__device__ __forceinline__ float bf2f(unsigned b) { return __uint_as_float(b << 16); }
typedef __bf16 bf16x2_t __attribute__((ext_vector_type(2)));
typedef float f32x2_t __attribute__((ext_vector_type(2)));
__device__ __forceinline__ unsigned f2bf(float f) { return (unsigned)__builtin_bit_cast(unsigned short, (__bf16)f); }
__device__ __forceinline__ unsigned pk2(float lo, float hi) { const f32x2_t v = {lo, hi}; return __builtin_bit_cast(unsigned, __builtin_convertvector(v, bf16x2_t)); }
__device__ __forceinline__ void unpk4(u32x2 w, float (&x)[4]) { x[0] = __uint_as_float(w.x << 16); x[1] = __uint_as_float(w.x & 0xffff0000u); x[2] = __uint_as_float(w.y << 16); x[3] = __uint_as_float(w.y & 0xffff0000u); }
__device__ __forceinline__ void unpk8(u32x4 w, float (&x)[8]) {
    x[0] = __uint_as_float(w.x << 16); x[1] = __uint_as_float(w.x & 0xffff0000u); x[2] = __uint_as_float(w.y << 16); x[3] = __uint_as_float(w.y & 0xffff0000u);
    x[4] = __uint_as_float(w.z << 16); x[5] = __uint_as_float(w.z & 0xffff0000u); x[6] = __uint_as_float(w.w << 16); x[7] = __uint_as_float(w.w & 0xffff0000u); }
template <int CTRL> __device__ __forceinline__ float dppf(float x) { return __builtin_bit_cast(float, __builtin_amdgcn_update_dpp(0, __builtin_bit_cast(int, x), CTRL, 0xF, 0xF, true)); }
__device__ __forceinline__ float red16(float x) { x += dppf<0xB1>(x); x += dppf<0x4E>(x); x += dppf<0x141>(x); x += dppf<0x140>(x); return x; }
__device__ __forceinline__ float wave_sum(float x) { x = red16(x); x += __shfl_xor(x, 16); x += __shfl_xor(x, 32); return x; }
__device__ __forceinline__ float sigmoidf_(float x) { return 1.0f / (1.0f + __expf(-x)); }
__device__ __forceinline__ float siluf_(float x) { return x / (1.0f + __expf(-x)); }
#define LDS_WAIT() asm volatile("s_waitcnt lgkmcnt(0)" ::: "memory")

struct Args { const float* in[27]; float* out; unsigned char* ws; int ph_lo, ph_hi; };
typedef const __attribute__((address_space(4))) Args* ArgsP;
struct Ctx {
    ArgsP ap;
    LAS unsigned char* lds;
    int tid, lane, wave, bid, G;
};
#define C_IN(k) (c.ap->in[k])
#define C_OUT (c.ap->out)
#define C_WTIN ((bf16*)(c.ap->ws + WS_WTIN))
#define C_WTOUT_L(l_) ((bf16*)(c.ap->ws + (((l_) & 1) ? WS_WTOUT2 : WS_WTOUT)))
#define C_WTMEM ((bf16*)(c.ap->ws + WS_WTMEM))
#define C_MEMB ((bf16*)(c.ap->ws + WS_MEMB))
#define C_XB ((bf16*)(c.ap->ws + WS_XB))
#define C_HB ((bf16*)(c.ap->ws + WS_HB))
#define C_U ((bf16*)(c.ap->ws + WS_U))
#define C_TAB ((float*)(c.ap->ws + WS_TAB))
#define C_XZ ((float*)(c.ap->ws + WS_XZ))
#define C_YA ((float*)(c.ap->ws + WS_YA))
#define C_PREP ((float*)(c.ap->ws + WS_PREP))
#define C_CHK ((unsigned char*)(c.ap->ws + WS_PREP))
#define C_PREPS ((float*)(c.ap->ws + WS_PREP + 120 * MiB))
#define C_BONUS ((float*)(c.ap->ws + WS_PREP + 125 * MiB))
#define C_WUT ((bf16*)(c.ap->ws + WS_PREP + 126 * MiB))
#define C_AUT ((bf16*)(c.ap->ws + WS_PREP + 126 * MiB) + 2 * 768 * 64)
constexpr int CHK_BYTES = 40960, CK_A = 0, CK_RQ = 9216, CK_GT = 13824, CK_YVT = 31232;
#define C_YR ((float*)(c.ap->ws + WS_PREP))
#define C_Z ((float*)(c.ap->ws + WS_HB))
#define C_OG ((float*)(c.ap->ws + WS_OG))
#define C_LSE ((float*)(c.ap->ws + WS_LSE))
#define C_MKVB ((bf16*)(c.ap->ws + WS_MKVB))
#define C_VT ((bf16*)(c.ap->ws + WS_VT))

__device__ __forceinline__ void transpose_item(const float* W, int K, int N, bf16* WT, int row_off, LAS float* scr, int item, int lane) {
    const int nblk = N / 32, kb = item / nblk, nb = item % nblk, k0 = 64 * kb, n0 = 32 * nb;
    f32x4 wv[8];
#pragma unroll
    for (int i = 0; i < 8; ++i) { const int kk = 8 * i + (lane >> 3), c4 = 4 * (lane & 7); wv[i] = *(const f32x4*)(W + (size_t)(k0 + kk) * N + n0 + c4); }
#pragma unroll
    for (int i = 0; i < 8; ++i) { const int kk = 8 * i + (lane >> 3), c4 = 4 * (lane & 7); const f32x4 w4 = wv[i];
        scr[kk * 33 + c4] = w4.x; scr[kk * 33 + c4 + 1] = w4.y; scr[kk * 33 + c4 + 2] = w4.z; scr[kk * 33 + c4 + 3] = w4.w; }
    LDS_WAIT(); asm volatile("" ::: "memory");
    const int c = lane & 7;
#pragma unroll
    for (int j = 0; j < 4; ++j) { const int n = (lane >> 3) + 8 * j; const LAS float* s = scr + (8 * c) * 33 + n;
        u32x4 o; o.x = pk2(s[0 * 33], s[1 * 33]); o.y = pk2(s[2 * 33], s[3 * 33]); o.z = pk2(s[4 * 33], s[5 * 33]); o.w = pk2(s[6 * 33], s[7 * 33]);
        *(u32x4*)(WT + (size_t)(row_off + n0 + n) * K + k0 + 8 * c) = o; }
    LDS_WAIT(); asm volatile("" ::: "memory");
}
__device__ __forceinline__ void transpose_matrix(const Ctx& c, const float* W, int K, int N, bf16* WT, int row_off) {
    LAS float* scr = (LAS float*)(c.lds + c.wave * 16384);
    const int gw = c.bid * 8 + c.wave, NGW = c.G * 8, nitems = (K / 64) * (N / 32);
    for (int it = gw; it < nitems; it += NGW) transpose_item(W, K, N, WT, row_off, scr, it, c.lane);
}
__device__ __forceinline__ void convert_layer_weights(const Ctx& c, int l) {
    if ((l & 1) == 0) { const int e = l >> 1;
        transpose_matrix(c, C_IN(10) + (size_t)e * DM * EVEN_IN, DM, EVEN_IN, C_WTIN, 0);
        transpose_matrix(c, C_IN(11) + (size_t)e * EVEN_OUT * DM, EVEN_OUT, DM, C_WTOUT_L(l), 0);
        const int n16 = (EVEN_INP - EVEN_IN) * DM * 2 / 16; u32x4* p = (u32x4*)(C_WTIN + (size_t)EVEN_IN * DM);
        for (int i = c.bid * 512 + c.tid; i < n16; i += c.G * 512) p[i] = (u32x4){0u, 0u, 0u, 0u};
    } else { const int o = l >> 1;
        transpose_matrix(c, C_IN(12) + (size_t)o * DM * ODD_IN, DM, ODD_IN, C_WTIN, 0);
        transpose_matrix(c, C_IN(13) + (size_t)o * ODD_OUT * DM, ODD_OUT, DM, C_WTOUT_L(l), 0);
    }
}

__device__ __forceinline__ void phase_prologue(const Ctx& c) {
    for (int l = 0; l < 4; ++l) transpose_matrix(c, C_IN(14) + (size_t)l * DM * 1024, DM, 1024, C_WTMEM, l * 1024);
    convert_layer_weights(c, 0);
    const int gt = c.bid * 512 + c.tid, NT = c.G * 512;
    for (int i = gt; i < 2 * 768 * 64; i += NT) { const int e = i / (768 * 64), rem = i % (768 * 64), col = rem >> 6, k = rem & 63;
        C_WUT[i] = (bf16)f2bf(C_IN(19)[((size_t)e * 64 + k) * 768 + col]); C_AUT[i] = (bf16)f2bf(C_IN(21)[((size_t)e * 64 + k) * 768 + col]); }
    for (int i = gt; i < 512 * DM / 4; i += NT) { const f32x4 v = ((const f32x4*)C_IN(9))[i]; ((u32x2*)C_MEMB)[i] = (u32x2){pk2(v.x, v.y), pk2(v.z, v.w)}; }
    for (int i = gt; i < MPAD * DM / 4; i += NT) {
        const int row = i / (DM / 4);
        f32x4 v = (f32x4){0.f, 0.f, 0.f, 0.f};
        if (row < TP) v = ((const f32x4*)C_IN(0))[i]; else if (row < TT) v = ((const f32x4*)C_IN(1))[i - TP * (DM / 4)];
        ((f32x4*)C_XZ)[i] = v; ((u32x2*)C_XB)[i] = (u32x2){pk2(v.x, v.y), pk2(v.z, v.w)};
    }
    for (int i = gt; i < 4100 * 128; i += NT) {
        const int p = i >> 7, ci = i & 127; const double pos = (double)(p < 4096 ? p : 16384 + (p - 4096));
        double ph = pos * ANG[ci];
        const double k = __builtin_rint(ph * 0.15915494309189535); ph = __builtin_fma(-k, 6.283185307179586, ph); ph = __builtin_fma(-k, 2.4492935982947064e-16, ph);
        const double q = __builtin_rint(ph * 0.6366197723675814); const double y = __builtin_fma(-q, 1.5707963267948966, ph) - q * 6.123233995736766e-17;
        const double y2 = y * y;
        const double sn = y * (1.0 + y2 * (-1.0 / 6 + y2 * (1.0 / 120 + y2 * (-1.0 / 5040 + y2 * (1.0 / 362880 + y2 * (-1.0 / 39916800 + y2 * (1.0 / 6227020800.0)))))));
        const double cs = 1.0 + y2 * (-0.5 + y2 * (1.0 / 24 + y2 * (-1.0 / 720 + y2 * (1.0 / 40320 + y2 * (-1.0 / 3628800 + y2 * (1.0 / 479001600.0 + y2 * (-1.0 / 87178291200.0)))))));
        const int qi = ((int)q) & 3; double co, si;
        if (qi == 0) { co = cs; si = sn; } else if (qi == 1) { co = -sn; si = cs; } else if (qi == 2) { co = -cs; si = -sn; } else { co = sn; si = -cs; }
        C_TAB[2 * i] = (float)co; C_TAB[2 * i + 1] = (float)si;
    }
}

__device__ __forceinline__ void rwkv_prep_item(const Ctx& c, int it, int e) {
    LAS float* lw = (LAS float*)c.lds;
    LAS float* la = lw + 16 * 64;
    const float* mu = C_IN(17) + e * 2432; const float* shift = C_IN(3) + (size_t)e * 8 * 2432;
    const int R0 = it * 16;
    for (int i = c.tid; i < 16 * 128; i += 512) {
        const int tk = i >> 7, cc = i & 127, R = R0 + tk; float val = 0.f;
        if (R < TT) { const int col = EC_HW + cc; const float hcur = bf2f(C_HB[(size_t)R * LDH + col]);
            float hprev;
            if (R < TP) hprev = ((R & (SEQ - 1)) == 0) ? 0.f : bf2f(C_HB[(size_t)(R - 1) * LDH + col]);
            else { const int n = (R - TP) >> 2, t = (R - TP) & 3; hprev = (t == 0) ? shift[n * 2432 + col] : bf2f(C_HB[(size_t)(R - 1) * LDH + col]); }
            const float hs = hcur + (hprev - hcur) * mu[col];
            val = (cc < 64) ? tanhf(hs) : hs; }
        if (cc < 64) lw[tk * 64 + cc] = val; else la[tk * 64 + (cc - 64)] = val;
    }
    __syncthreads();
    const int tl = c.tid & 255, tg = c.tid >> 8;
    const float* w_up = C_IN(19) + (size_t)e * 64 * 768; const float* a_up = C_IN(21) + (size_t)e * 64 * 768;
    const float* w0 = C_IN(18) + e * 768; const float* a0 = C_IN(20) + e * 768; const float* k_k = C_IN(22) + e * 768; const float* k_a = C_IN(23) + e * 768;
#pragma unroll 1
    for (int m = 0; m < 3; ++m) {
        const int col = tl + 256 * m, h = col >> 6, ci = col & 63;
        float xw[8], xa[8];
#pragma unroll
        for (int t = 0; t < 8; ++t) { xw[t] = 0.f; xa[t] = 0.f; }
#pragma unroll 4
        for (int kk = 0; kk < 64; ++kk) { const float wu = w_up[kk * 768 + col], au = a_up[kk * 768 + col];
#pragma unroll
            for (int t = 0; t < 8; ++t) { xw[t] += lw[(tg * 8 + t) * 64 + kk] * wu; xa[t] += la[(tg * 8 + t) * 64 + kk] * au; } }
        const float w0c = w0[col], a0c = a0[col], kkc = k_k[col], kac = k_a[col], mur = mu[EC_R + col], muk = mu[EC_K + col], muv = mu[EC_V + col];
#pragma unroll
        for (int t = 0; t < 8; ++t) {
            const int R = R0 + tg * 8 + t;
            if (R >= TT || R < TP) continue;
            const bf16* hc = C_HB + (size_t)R * LDH; float pr, pk, pv;
            const float cr = bf2f(hc[EC_R + col]), ck = bf2f(hc[EC_K + col]), cv = bf2f(hc[EC_V + col]);
            bool has_prev_row; int n = 0;
            if (R < TP) has_prev_row = (R & (SEQ - 1)) != 0; else { n = (R - TP) >> 2; has_prev_row = ((R - TP) & 3) != 0; }
            if (has_prev_row) { const bf16* hp = hc - LDH; pr = bf2f(hp[EC_R + col]); pk = bf2f(hp[EC_K + col]); pv = bf2f(hp[EC_V + col]); }
            else if (R < TP) { pr = 0.f; pk = 0.f; pv = 0.f; }
            else { const float* sp = shift + n * 2432; pr = sp[EC_R + col]; pk = sp[EC_K + col]; pv = sp[EC_V + col]; }
            const float r = cr + (pr - cr) * mur, k = ck + (pk - ck) * muk, v = cv + (pv - cv) * muv;
            const float decay = __expf(-0.6065306597126334f * sigmoidf_(w0c + xw[t]));
            const float a = sigmoidf_(a0c + xa[t]);
            float kk = k * kkc; const float ss = wave_sum(kk * kk); kk *= rsqrtf(fmaxf(ss, 1e-24f));
            const float k2 = k * (1.0f + (a - 1.0f) * kac);
            float* dst = C_PREPS + ((size_t)(R - TP) * 12 + h) * 384 + ci;
            dst[0] = r; dst[64] = decay; dst[128] = k2; dst[192] = v; dst[256] = -kk; dst[320] = kk * a;
        }
    }
    __syncthreads();
}

__device__ __forceinline__ void dil_attn_item(const Ctx& c, int R, int hh, int e) {
    const int lane = c.lane, kg = lane >> 4, dl = lane & 15;
    float m = -1e30f, l = 0.f, acc[4] = {0.f, 0.f, 0.f, 0.f};
    const bool is_p = R < TP; const int t = is_p ? (R & (SEQ - 1)) : ((R - TP) & 3); const int n = is_p ? 0 : ((R - TP) >> 2);
    const size_t rowbase = is_p ? (size_t)(R - t) : (size_t)(TP + n * 4);
#pragma unroll
    for (int g = 0; g < 3; ++g) {
        const int dil = (g == 0) ? 1 : (g == 1 ? 4 : 16), W = 128 * dil;
        float q[4]; { const u32x2 w = *(const u32x2*)(C_HB + (size_t)R * LDH + EC_QB + g * 256 + hh * 64 + 4 * dl); unpk4(w, q); }
#pragma unroll
        for (int i = 0; i < 4; ++i) q[i] *= 0.125f;
        const float* cache = ((g == 0) ? C_IN(4) : (g == 1 ? C_IN(5) : C_IN(6))) + ((size_t)(e * 8 + n) * W) * 512;
#pragma unroll 1
        for (int j0 = 0; j0 < 129; j0 += 4) {
            const int j = j0 + kg; bool valid = j < 129; float kf[4] = {0.f, 0.f, 0.f, 0.f}, vf[4] = {0.f, 0.f, 0.f, 0.f};
            if (is_p) { const int pos = t - dil * j; valid = valid && pos >= 0;
                if (valid) { const bf16* kp = C_HB + (rowbase + pos) * LDH + g * 256 + hh * 64 + 4 * dl; unpk4(*(const u32x2*)(kp + EC_KB), kf); unpk4(*(const u32x2*)(kp + EC_VB), vf); } }
            else if (valid) { const int idx = W + t - dil * j;
                if (idx >= W) { const bf16* kp = C_HB + (rowbase + (idx - W)) * LDH + g * 256 + hh * 64 + 4 * dl; unpk4(*(const u32x2*)(kp + EC_KB), kf); unpk4(*(const u32x2*)(kp + EC_VB), vf); }
                else { const float* kp = cache + (size_t)idx * 512 + hh * 64 + 4 * dl; const f32x4 k4 = *(const f32x4*)kp, v4 = *(const f32x4*)(kp + 256);
                    kf[0] = k4.x; kf[1] = k4.y; kf[2] = k4.z; kf[3] = k4.w; vf[0] = v4.x; vf[1] = v4.y; vf[2] = v4.z; vf[3] = v4.w; } }
            float s = q[0] * kf[0] + q[1] * kf[1] + q[2] * kf[2] + q[3] * kf[3];
            s = red16(s);
            if (valid) { const float mn = fmaxf(m, s), sc = __expf(m - mn), p = __expf(s - mn);
                l = l * sc + p;
#pragma unroll
                for (int i = 0; i < 4; ++i) acc[i] = acc[i] * sc + p * vf[i];
                m = mn; }
        }
    }
#pragma unroll
    for (int off = 16; off <= 32; off <<= 1) {
        const float m2 = __shfl_xor(m, off), l2 = __shfl_xor(l, off); float a2[4];
#pragma unroll
        for (int i = 0; i < 4; ++i) a2[i] = __shfl_xor(acc[i], off);
        const float mn = fmaxf(m, m2), s1 = __expf(m - mn), s2 = __expf(m2 - mn);
        l = l * s1 + l2 * s2;
#pragma unroll
        for (int i = 0; i < 4; ++i) acc[i] = acc[i] * s1 + a2[i] * s2;
        m = mn;
    }
    if (kg == 0) { float gt[4]; unpk4(*(const u32x2*)(C_HB + (size_t)R * LDH + EC_GB + hh * 64 + 4 * dl), gt);
        const float inv = 1.0f / l; float o[4];
#pragma unroll
        for (int i = 0; i < 4; ++i) o[i] = acc[i] * inv * siluf_(gt[i]);
        *(u32x2*)(C_U + (size_t)R * EVEN_OUT + 768 + hh * 64 + 4 * dl) = (u32x2){pk2(o[0], o[1]), pk2(o[2], o[3])}; }
}

__device__ __forceinline__ void mem_attn_item(const Ctx& c, int R, int mh, int l, int qcol, int gcol, int ucol, int ldu) {
    const int lane = c.lane, kg = lane >> 5, dl = lane & 31;
    const float* mkv;
    if (R < TP) mkv = C_OUT + O_MEM + ((size_t)l * 512 + (R >> 12) * 256) * 1024; else mkv = C_IN(8) + ((size_t)l * 8 + ((R - TP) >> 2)) * 256 * 1024;
    float q[4]; unpk4(*(const u32x2*)(C_HB + (size_t)R * LDH + qcol + mh * 128 + 4 * dl), q);
#pragma unroll
    for (int i = 0; i < 4; ++i) q[i] *= 0.08838834764831845f;
    float m = -1e30f, lsum = 0.f, acc[4] = {0.f, 0.f, 0.f, 0.f};
#pragma unroll 8
    for (int j0 = 0; j0 < 256; j0 += 2) {
        const float* kp = mkv + (size_t)(j0 + kg) * 1024 + mh * 128 + 4 * dl; const f32x4 k4 = *(const f32x4*)kp, v4 = *(const f32x4*)(kp + 512);
        float s = q[0] * k4.x + q[1] * k4.y + q[2] * k4.z + q[3] * k4.w;
        s = red16(s); s += __shfl_xor(s, 16);
        const float mn = fmaxf(m, s), sc = __expf(m - mn), p = __expf(s - mn);
        lsum = lsum * sc + p; acc[0] = acc[0] * sc + p * v4.x; acc[1] = acc[1] * sc + p * v4.y; acc[2] = acc[2] * sc + p * v4.z; acc[3] = acc[3] * sc + p * v4.w; m = mn;
    }
    { const float m2 = __shfl_xor(m, 32), l2 = __shfl_xor(lsum, 32); float a2[4];
#pragma unroll
        for (int i = 0; i < 4; ++i) a2[i] = __shfl_xor(acc[i], 32);
        const float mn = fmaxf(m, m2), s1 = __expf(m - mn), s2 = __expf(m2 - mn);
        lsum = lsum * s1 + l2 * s2;
#pragma unroll
        for (int i = 0; i < 4; ++i) acc[i] = acc[i] * s1 + a2[i] * s2; }
    if (kg == 0) { float gt[4]; unpk4(*(const u32x2*)(C_HB + (size_t)R * LDH + gcol + mh * 128 + 4 * dl), gt);
        const float inv = 1.0f / lsum; float o[4];
#pragma unroll
        for (int i = 0; i < 4; ++i) o[i] = acc[i] * inv * siluf_(gt[i]);
        *(u32x2*)(C_U + (size_t)R * ldu + ucol + mh * 128 + 4 * dl) = (u32x2){pk2(o[0], o[1]), pk2(o[2], o[3])}; }
}


typedef float f32x16 __attribute__((ext_vector_type(16)));
__device__ __forceinline__ f32x16 mfma32(bf16x8 a, bf16x8 b, f32x16 cacc) { return __builtin_amdgcn_mfma_f32_32x32x16_bf16(a, b, cacc, 0, 0, 0); }
__device__ __forceinline__ void mem_attn_mfma_item(const Ctx& c, int item, int l, int qcol, int gcol, int ucol, int ldu) {
    const int blk = item >> 2, mh = item & 3, R0 = blk * 32, b = R0 >> 12;
    const int lane = c.lane, r = lane & 31, hh = lane >> 5;
    const bf16* Kb = C_MKVB + ((size_t)l * 512 + b * 256) * 1024 + mh * 128 + 8 * hh;
    const bf16* Vt = C_VT + ((size_t)l * 512 + mh * 128) * 512 + b * 256 + 4 * hh;
    bf16x8 Qf[8];
    { const bf16* qp = C_HB + (size_t)(R0 + r) * LDH + qcol + mh * 128 + 8 * hh;
#pragma unroll
        for (int ks = 0; ks < 8; ++ks) Qf[ks] = *(const bf16x8*)(qp + 16 * ks); }
    f32x16 O[4];
#pragma unroll
    for (int dt = 0; dt < 4; ++dt)
#pragma unroll
        for (int i = 0; i < 16; ++i) O[dt][i] = 0.f;
    float m = -1e30f, lsum = 0.f;
    const float cs = 0.08838834764831845f * 1.4426950408889634f;
#pragma unroll 1
    for (int half = 0; half < 2; ++half) {
        f32x16 S[4];
#pragma unroll
        for (int kt = 0; kt < 4; ++kt) {
#pragma unroll
            for (int i = 0; i < 16; ++i) S[kt][i] = 0.f;
            const bf16* kp = Kb + (size_t)(128 * half + 32 * kt + r) * 1024;
#pragma unroll
            for (int ks = 0; ks < 8; ++ks) S[kt] = mfma32(*(const bf16x8*)(kp + 16 * ks), Qf[ks], S[kt]);
        }
        float mx = -1e30f;
#pragma unroll
        for (int kt = 0; kt < 4; ++kt)
#pragma unroll
            for (int i = 0; i < 16; ++i) mx = fmaxf(mx, S[kt][i]);
        mx = fmaxf(mx, __shfl_xor(mx, 32));
        const float mn = fmaxf(m, mx), sc = __builtin_amdgcn_exp2f((m - mn) * cs); m = mn;
        lsum *= sc;
#pragma unroll
        for (int dt = 0; dt < 4; ++dt)
#pragma unroll
            for (int i = 0; i < 16; ++i) O[dt][i] *= sc;
        float ps = 0.f;
#pragma unroll
        for (int kt = 0; kt < 4; ++kt)
#pragma unroll
            for (int i = 0; i < 16; ++i) { const float p = __builtin_amdgcn_exp2f((S[kt][i] - mn) * cs); S[kt][i] = p; ps += p; }
        lsum += ps;
#pragma unroll
        for (int kt = 0; kt < 4; ++kt)
#pragma unroll
            for (int s2 = 0; s2 < 2; ++s2) {
                const u32x4 pw = (u32x4){pk2(S[kt][8 * s2 + 0], S[kt][8 * s2 + 1]), pk2(S[kt][8 * s2 + 2], S[kt][8 * s2 + 3]), pk2(S[kt][8 * s2 + 4], S[kt][8 * s2 + 5]), pk2(S[kt][8 * s2 + 6], S[kt][8 * s2 + 7])};
                const bf16x8 Pf = __builtin_bit_cast(bf16x8, pw);
                const int kb = 128 * half + 32 * kt + 16 * s2;
#pragma unroll
                for (int dt = 0; dt < 4; ++dt) { const bf16* vp = Vt + (size_t)(32 * dt + r) * 512 + kb;
                    const u32x2 v0 = *(const u32x2*)vp, v1 = *(const u32x2*)(vp + 8); const u32x4 vw = (u32x4){v0.x, v0.y, v1.x, v1.y};
                    O[dt] = mfma32(__builtin_bit_cast(bf16x8, vw), Pf, O[dt]); }
            }
    }
    lsum += __shfl_xor(lsum, 32); const float inv = 1.0f / lsum;
    const bf16* gp = C_HB + (size_t)(R0 + r) * LDH + gcol + mh * 128 + 4 * hh; bf16* up = C_U + (size_t)(R0 + r) * ldu + ucol + mh * 128 + 4 * hh;
#pragma unroll
    for (int dt = 0; dt < 4; ++dt)
#pragma unroll
        for (int g4 = 0; g4 < 4; ++g4) { float gt[4]; unpk4(*(const u32x2*)(gp + 32 * dt + 8 * g4), gt);
            const float o0 = O[dt][4 * g4 + 0] * inv * siluf_(gt[0]), o1 = O[dt][4 * g4 + 1] * inv * siluf_(gt[1]), o2 = O[dt][4 * g4 + 2] * inv * siluf_(gt[2]), o3 = O[dt][4 * g4 + 3] * inv * siluf_(gt[3]);
            *(u32x2*)(up + 32 * dt + 8 * g4) = (u32x2){pk2(o0, o1), pk2(o2, o3)}; }
}
__device__ __forceinline__ void mem_attn_all(const Ctx& c, int l, int qcol, int gcol, int ucol, int ldu) {
    constexpr int NM = (TP / 32) * 4, NS = TS * 4;
    for (int wi = c.wave * c.G + c.bid; wi < NM + NS; wi += 8 * c.G) {
        if (wi < NM) mem_attn_mfma_item(c, wi, l, qcol, gcol, ucol, ldu);
        else { const int si = wi - NM; mem_attn_item(c, TP + (si >> 2), si & 3, l, qcol, gcol, ucol, ldu); }
    }
}


typedef short s16x4 __attribute__((ext_vector_type(4)));
__device__ __forceinline__ f32x4 mfma16(bf16x8 a, bf16x8 b, f32x4 cacc) { return __builtin_amdgcn_mfma_f32_16x16x32_bf16(a, b, cacc, 0, 0, 0); }
__device__ __forceinline__ bf16x8 tr_frag(const LAS bf16* p, int rowstride4) {
    const s16x4 a0 = __builtin_amdgcn_ds_read_tr16_b64_v4i16((LAS s16x4*)p), a1 = __builtin_amdgcn_ds_read_tr16_b64_v4i16((LAS s16x4*)(p + rowstride4));
    return (bf16x8){a0[0], a0[1], a0[2], a0[3], a1[0], a1[1], a1[2], a1[3]};
}
__device__ __forceinline__ void dil_attn_mfma_item(const Ctx& c, int item) {
    const int bh = item / 48, rem = item % 48, b = bh >> 2, hh = bh & 3, g = rem >> 4, idx16 = rem & 15;
    const int dil = 1 << (2 * g), nub = 16 >> (2 * g), rho = idx16 / nub, ub = idx16 % nub;
    LAS bf16* Kl = (LAS bf16*)c.lds;
    LAS bf16* Vl = Kl + 384 * 72;
    const int tid = c.tid, lane = c.lane, wave = c.wave, r = lane & 31, hl = lane >> 5;
    const int ubase = ub * 256 - 128;
    const bf16* hb = C_HB + (size_t)b * SEQ * LDH + g * 256 + hh * 64;
    u32x4 kwv[6], vwv[6];
#pragma unroll
    for (int pass = 0; pass < 6; ++pass) { const int kl = pass * 64 + (tid >> 3), part = tid & 7; int up = ubase + kl; up = up < 0 ? 0 : up;
        const bf16* src = hb + (size_t)(rho + dil * up) * LDH + 8 * part;
        kwv[pass] = *(const u32x4*)(src + EC_KB); vwv[pass] = *(const u32x4*)(src + EC_VB); }
    const int u0 = ub * 256 + 32 * wave;
    bf16x8 Qf[4];
    { const bf16* qp = hb + (size_t)(rho + dil * (u0 + r)) * LDH + EC_QB + 8 * hl;
#pragma unroll
        for (int ks = 0; ks < 4; ++ks) Qf[ks] = *(const bf16x8*)(qp + 16 * ks); }
#pragma unroll
    for (int pass = 0; pass < 6; ++pass) { const int kl = pass * 64 + (tid >> 3), part = tid & 7; *(LAS u32x4*)(Kl + kl * 72 + 8 * part) = kwv[pass]; *(LAS u32x4*)(Vl + kl * 72 + 8 * part) = vwv[pass]; }
    __syncthreads();
    f32x16 S[5];
#pragma unroll
    for (int kt = 0; kt < 5; ++kt) {
#pragma unroll
        for (int i = 0; i < 16; ++i) S[kt][i] = 0.f;
        const LAS bf16* kp = Kl + (32 * wave + 32 * kt + r) * 72 + 8 * hl;
#pragma unroll
        for (int ks = 0; ks < 4; ++ks) S[kt] = mfma32(*(const LAS bf16x8*)(kp + 16 * ks), Qf[ks], S[kt]);
    }
    float mx = -1e30f;
#pragma unroll
    for (int kt = 0; kt < 5; ++kt)
#pragma unroll
        for (int i = 0; i < 16; ++i) { const int kl = 32 * kt + (i & 3) + 8 * (i >> 2) + 4 * hl;
            const bool valid = (kl >= r) && (kl - 128 <= r) && (u0 - 128 + kl >= 0);
            const float sv = valid ? S[kt][i] : -1e30f; S[kt][i] = sv; mx = fmaxf(mx, sv); }
    mx = fmaxf(mx, __shfl_xor(mx, 32));
    const float cs = 0.125f * 1.4426950408889634f;
    float lsum = 0.f;
#pragma unroll
    for (int kt = 0; kt < 5; ++kt)
#pragma unroll
        for (int i = 0; i < 16; ++i) { const float p = __builtin_amdgcn_exp2f((S[kt][i] - mx) * cs); S[kt][i] = p; lsum += p; }
    lsum += __shfl_xor(lsum, 32);
    f32x16 O[2];
#pragma unroll
    for (int dt = 0; dt < 2; ++dt)
#pragma unroll
        for (int i = 0; i < 16; ++i) O[dt][i] = 0.f;
    const LAS bf16* vbase = Vl + (32 * wave + 4 * hl + ((lane & 15) >> 2)) * 72 + 16 * ((lane >> 4) & 1) + 4 * (lane & 3);
#pragma unroll
    for (int kt = 0; kt < 5; ++kt)
#pragma unroll
        for (int s2 = 0; s2 < 2; ++s2) {
            const u32x4 pw = (u32x4){pk2(S[kt][8 * s2 + 0], S[kt][8 * s2 + 1]), pk2(S[kt][8 * s2 + 2], S[kt][8 * s2 + 3]), pk2(S[kt][8 * s2 + 4], S[kt][8 * s2 + 5]), pk2(S[kt][8 * s2 + 6], S[kt][8 * s2 + 7])};
            const bf16x8 Pf = __builtin_bit_cast(bf16x8, pw);
#pragma unroll
            for (int dt = 0; dt < 2; ++dt) { const LAS bf16* vp = vbase + (32 * kt + 16 * s2) * 72 + 32 * dt;
                const s16x4 a0 = __builtin_amdgcn_ds_read_tr16_b64_v4i16((LAS s16x4*)vp), a1 = __builtin_amdgcn_ds_read_tr16_b64_v4i16((LAS s16x4*)(vp + 8 * 72));
                const bf16x8 Af = (bf16x8){a0[0], a0[1], a0[2], a0[3], a1[0], a1[1], a1[2], a1[3]};
                O[dt] = mfma32(Af, Pf, O[dt]); }
        }
    const float inv = 1.0f / lsum; const size_t R = (size_t)b * SEQ + rho + dil * (u0 + r);
    float* og = C_OG + ((size_t)g * TT + R) * 256 + hh * 64 + 4 * hl;
#pragma unroll
    for (int dt = 0; dt < 2; ++dt)
#pragma unroll
        for (int g4 = 0; g4 < 4; ++g4) *(f32x4*)(og + 32 * dt + 8 * g4) = (f32x4){O[dt][4 * g4 + 0] * inv, O[dt][4 * g4 + 1] * inv, O[dt][4 * g4 + 2] * inv, O[dt][4 * g4 + 3] * inv};
    if (hl == 0) C_LSE[((size_t)g * TT + R) * 4 + hh] = mx * 0.125f + __logf(lsum);
    __syncthreads();
}
__device__ __forceinline__ void dil_attn_sample_item(const Ctx& c, int sr, int hh, int e) {
    const int lane = c.lane, kg = lane >> 4, dl = lane & 15, R = TP + sr, n = sr >> 2, t = sr & 3;
    float m = -1e30f, l = 0.f, acc[4] = {0.f, 0.f, 0.f, 0.f};
#pragma unroll
    for (int g = 0; g < 3; ++g) {
        const int dil = (g == 0) ? 1 : (g == 1 ? 4 : 16), W = 128 * dil, jn = t / dil;
        float q[4]; unpk4(*(const u32x2*)(C_HB + (size_t)R * LDH + EC_QB + g * 256 + hh * 64 + 4 * dl), q);
#pragma unroll
        for (int i = 0; i < 4; ++i) q[i] *= 0.125f;
        { const int j = kg; const bool valid = j <= jn; const int tt = valid ? t - dil * j : t;
            const bf16* kp = C_HB + (size_t)(TP + n * 4 + tt) * LDH + g * 256 + hh * 64 + 4 * dl; float kf[4], vf[4]; unpk4(*(const u32x2*)(kp + EC_KB), kf); unpk4(*(const u32x2*)(kp + EC_VB), vf);
            float s = red16(q[0] * kf[0] + q[1] * kf[1] + q[2] * kf[2] + q[3] * kf[3]);
            if (valid) { const float mn = fmaxf(m, s), sc = __expf(m - mn), p = __expf(s - mn); l = l * sc + p;
#pragma unroll
                for (int i = 0; i < 4; ++i) acc[i] = acc[i] * sc + p * vf[i];
                m = mn; } }
        const float* cache = ((g == 0) ? C_IN(4) : (g == 1 ? C_IN(5) : C_IN(6))) + ((size_t)(e * 8 + n) * W) * 512 + hh * 64 + 4 * dl;
#pragma unroll 11
        for (int j0 = 0; j0 < 132; j0 += 4) { const int j = j0 + kg; const bool valid = (j > jn) && (j <= 128); const int idx = valid ? W + t - dil * j : 0;
            const float* kp = cache + (size_t)idx * 512; const f32x4 k4 = *(const f32x4*)kp, v4 = *(const f32x4*)(kp + 256);
            const float s = red16(q[0] * k4.x + q[1] * k4.y + q[2] * k4.z + q[3] * k4.w);
            if (valid) { const float mn = fmaxf(m, s), sc = __expf(m - mn), p = __expf(s - mn); l = l * sc + p;
                acc[0] = acc[0] * sc + p * v4.x; acc[1] = acc[1] * sc + p * v4.y; acc[2] = acc[2] * sc + p * v4.z; acc[3] = acc[3] * sc + p * v4.w; m = mn; } }
    }
#pragma unroll
    for (int off = 16; off <= 32; off <<= 1) {
        const float m2 = __shfl_xor(m, off), l2 = __shfl_xor(l, off); float a2[4];
#pragma unroll
        for (int i = 0; i < 4; ++i) a2[i] = __shfl_xor(acc[i], off);
        const float mn = fmaxf(m, m2), s1 = __expf(m - mn), s2 = __expf(m2 - mn);
        l = l * s1 + l2 * s2;
#pragma unroll
        for (int i = 0; i < 4; ++i) acc[i] = acc[i] * s1 + a2[i] * s2;
        m = mn;
    }
    if (kg == 0) { float gt[4]; unpk4(*(const u32x2*)(C_HB + (size_t)R * LDH + EC_GB + hh * 64 + 4 * dl), gt);
        const float inv = 1.0f / l; float o[4];
#pragma unroll
        for (int i = 0; i < 4; ++i) o[i] = acc[i] * inv * siluf_(gt[i]);
        *(u32x2*)(C_U + (size_t)R * EVEN_OUT + 768 + hh * 64 + 4 * dl) = (u32x2){pk2(o[0], o[1]), pk2(o[2], o[3])}; }
}

__device__ __forceinline__ void even_copies(const Ctx& c, int e) {
    const int gt = c.bid * 512 + c.tid, NT = c.G * 512;
    for (int i = gt; i < 10 * 304; i += NT) { const int rw = i / 304, c8 = 8 * (i % 304);
        const size_t src = (rw < 2) ? (size_t)(rw * SEQ + SEQ - 1) : (size_t)(TP + (rw - 2) * 4 + 3);
        float x[8]; unpk8(*(const u32x4*)(C_HB + src * LDH + c8), x);
        float* dst = (rw < 2) ? C_OUT + O_SH_P + ((size_t)e * 2 + rw) * 2432 + c8 : C_OUT + O_SH_S + ((size_t)e * 8 + (rw - 2)) * 2432 + c8;
        *(f32x4*)dst = (f32x4){x[0], x[1], x[2], x[3]}; *(f32x4*)(dst + 4) = (f32x4){x[4], x[5], x[6], x[7]}; }
#pragma unroll 1
    for (int g = 0; g < 3; ++g) {
        const int keep = 128 << (2 * g); const size_t op = (g == 0) ? O_G0P : (g == 1 ? O_G1P : O_G2P), os = (g == 0) ? O_G0S : (g == 1 ? O_G1S : O_G2S);
        for (int i = gt; i < 2 * keep * 64; i += NT) { const int pc = i & 63, r = (i >> 6) % keep, b = (i >> 6) / keep;
            const int col = ((pc & 32) ? EC_VB : EC_KB) + g * 256 + 8 * (pc & 31);
            float x[8]; unpk8(*(const u32x4*)(C_HB + (size_t)(b * SEQ + SEQ - keep + r) * LDH + col), x);
            float* dst = C_OUT + op + ((size_t)e * 2 * keep + (size_t)b * keep + r) * 512 + 8 * pc;
            *(f32x4*)dst = (f32x4){x[0], x[1], x[2], x[3]}; *(f32x4*)(dst + 4) = (f32x4){x[4], x[5], x[6], x[7]}; }
        for (int i = gt; i < 8 * 4 * 64; i += NT) { const int pc = i & 63, row = i >> 6;
            const int col = ((pc & 32) ? EC_VB : EC_KB) + g * 256 + 8 * (pc & 31);
            float x[8]; unpk8(*(const u32x4*)(C_HB + (size_t)(TP + row) * LDH + col), x);
            float* dst = C_OUT + os + ((size_t)e * 32 + row) * 512 + 8 * pc;
            *(f32x4*)dst = (f32x4){x[0], x[1], x[2], x[3]}; *(f32x4*)(dst + 4) = (f32x4){x[4], x[5], x[6], x[7]}; }
    }
}

#define LAUNDER_C(c) do { asm volatile("" : "+s"((c).ap), "+v"((c).tid), "+s"((c).bid), "+s"((c).G)); (c).lane = (c).tid & 63; (c).wave = __builtin_amdgcn_readfirstlane((c).tid >> 6); } while (0)
__device__ __forceinline__ void phase_even_tok_pre(Ctx c, int l);
__device__ __forceinline__ void even_helper_work(Ctx c, int l) {
    const int e = l >> 1;
    for (int rp = 0; rp < REPD; ++rp) { for (int it = c.bid; it < 384; it += c.G) dil_attn_mfma_item(c, it);
    LAUNDER_C(c); }
    { const int gw = (c.G - 1 - c.bid) * 8 + c.wave; if (gw < TS * 4) dil_attn_sample_item(c, gw >> 2, gw & 3, e); }
    LAUNDER_C(c);
    for (int rp = 0; rp < REPM; ++rp) { mem_attn_all(c, l, EC_QM, EC_GM, 1024, EVEN_OUT);
    LAUNDER_C(c); }
    even_copies(c, e);
    LAUNDER_C(c);
    for (int rp = 0; rp < REPC; ++rp) { if (l < 3) convert_layer_weights(c, l + 1); LAUNDER_C(c); }
}

__device__ __forceinline__ void rwkv_scan_item(const Ctx& c, int item, int e) {
    constexpr int CH = 32;
    LAS float* buf = (LAS float*)c.lds;
    LAS float* ybuf = buf + 2 * CH * 384;
    const bool is_p = item < 48; const int st = is_p ? (item >> 1) : ((item - 48) >> 1), half = item & 1;
    const int h = st % 12, bn = st / 12; const int T = is_p ? SEQ : 4; const size_t tok0 = is_p ? (size_t)bn * SEQ : (size_t)(TP + bn * 4);
    const int lane = c.lane, rw = lane >> 4, cgp = lane & 15, il = 4 * c.wave + rw, i = 32 * half + il;
    float s[4];
    if (is_p) { s[0] = s[1] = s[2] = s[3] = 0.f; }
    else { const f32x4 v = *(const f32x4*)(C_IN(2) + ((((size_t)e * 8 + bn) * 12 + h) * 64 + i) * 64 + 4 * cgp); s[0] = v.x; s[1] = v.y; s[2] = v.z; s[3] = v.w; }
    const int nch = (T + CH - 1) / CH;
    f32x4 pre[6];
#define SCAN_GLOAD(ch_) do { _Pragma("unroll") for (int k = 0; k < 6; ++k) { const int idx = c.tid + 512 * k, tl_ = idx / 96, f4 = idx % 96; const int tk = (ch_) * CH + tl_; \
            pre[k] = (tk < T) ? *(const f32x4*)(C_PREPS + ((tok0 - TP + tk) * 12 + h) * 384 + 4 * f4) : (f32x4){0.f, 0.f, 0.f, 0.f}; } } while (0)
#define SCAN_LSTORE(bi_) do { _Pragma("unroll") for (int k = 0; k < 6; ++k) { const int idx = c.tid + 512 * k; *(LAS f32x4*)(buf + (bi_) * CH * 384 + 4 * idx) = pre[k]; } } while (0)
    SCAN_GLOAD(0); SCAN_LSTORE(0); __syncthreads();
#pragma unroll 1
    for (int ch = 0; ch < nch; ++ch) {
        if (ch + 1 < nch) SCAN_GLOAD(ch + 1);
        const LAS float* bb = buf + (ch & 1) * CH * 384;
        const int nt = (T - ch * CH) < CH ? (T - ch * CH) : CH;
#pragma unroll 2
        for (int tl = 0; tl < nt; ++tl) {
            const LAS float* p = bb + tl * 384;
            const f32x4 r4 = *(const LAS f32x4*)(p + 4 * cgp), d4 = *(const LAS f32x4*)(p + 64 + 4 * cgp), k4 = *(const LAS f32x4*)(p + 128 + 4 * cgp),
                        kk4 = *(const LAS f32x4*)(p + 256 + 4 * cgp), b4 = *(const LAS f32x4*)(p + 320 + 4 * cgp);
            const float vi = p[192 + i];
            float sa = s[0] * kk4.x + s[1] * kk4.y + s[2] * kk4.z + s[3] * kk4.w;
            sa = red16(sa);
            s[0] = s[0] * d4.x + (sa * b4.x + vi * k4.x); s[1] = s[1] * d4.y + (sa * b4.y + vi * k4.y);
            s[2] = s[2] * d4.z + (sa * b4.z + vi * k4.z); s[3] = s[3] * d4.w + (sa * b4.w + vi * k4.w);
            float y = s[0] * r4.x + s[1] * r4.y + s[2] * r4.z + s[3] * r4.w;
            y = red16(y);
            if (cgp == 0) ybuf[tl * 32 + il] = y;
        }
        __syncthreads();
        if (ch + 1 < nch) SCAN_LSTORE((ch + 1) & 1);
        for (int idx = c.tid; idx < nt * 32; idx += 512) { const int tl = idx >> 5, r = idx & 31; C_YA[(tok0 + ch * CH + tl) * 768 + h * 64 + 32 * half + r] = ybuf[idx]; }
        __syncthreads();
    }
    float* so = C_OUT + (is_p ? O_RWKV_P + (((size_t)e * 2 + bn) * 12 + h) * 4096 : O_RWKV_S + (((size_t)e * 8 + bn) * 12 + h) * 4096) + (size_t)i * 64 + 4 * cgp;
    *(f32x4*)so = (f32x4){s[0], s[1], s[2], s[3]};
}

typedef float f32x2 __attribute__((ext_vector_type(2)));
__device__ __forceinline__ void rwkv_scan_prompt(const Ctx& c, int item, int e) {
    constexpr int CH = 32, NCH = SEQ / CH;
    LAS float* buf = (LAS float*)c.lds;
    LAS float* ybuf = buf + 2 * CH * 384;
    const int st = item >> 1, half = item & 1, h = st % 12, bn = st / 12; const size_t tok0 = (size_t)bn * SEQ;
    const int lane = c.lane, rw = lane >> 4, cgp = lane & 15, il = 4 * c.wave + rw, i = 32 * half + il;
    f32x2 s01 = (f32x2){0.f, 0.f}, s23 = (f32x2){0.f, 0.f};
    const float* src = C_PREP + (tok0 * 12 + h) * 384;
    float* ya = C_YA + tok0 * 768 + h * 64 + 32 * half;
    f32x4 pre[6];
#define SP_GLOAD(ch_) do { _Pragma("unroll") for (int k = 0; k < 6; ++k) { const int idx = c.tid + 512 * k, tl_ = idx / 96, f4 = idx % 96; \
        pre[k] = *(const f32x4*)(src + (size_t)((ch_) * CH + tl_) * (12 * 384) + 4 * f4); } } while (0)
#define SP_LSTORE(bi_) do { _Pragma("unroll") for (int k = 0; k < 6; ++k) { const int idx = c.tid + 512 * k; *(LAS f32x4*)(buf + (bi_) * CH * 384 + 4 * idx) = pre[k]; } } while (0)
#define SP_YOUT(ch_) do { for (int idx = c.tid; idx < CH * 32; idx += 512) { const int tl_ = idx >> 5, r_ = idx & 31; ya[(size_t)((ch_) * CH + tl_) * 768 + r_] = ybuf[((ch_) & 1) * CH * 32 + idx]; } } while (0)
    SP_GLOAD(0); SP_LSTORE(0); SP_GLOAD(1); __syncthreads();
#pragma unroll 1
    for (int ch = 0; ch < NCH; ++ch) {
        if (ch + 1 < NCH) SP_LSTORE((ch + 1) & 1);
        if (ch + 2 < NCH) SP_GLOAD(ch + 2);
        if (ch > 0) SP_YOUT(ch - 1);
        const LAS float* bb = buf + (ch & 1) * CH * 384 + 4 * cgp; const LAS float* vb = buf + (ch & 1) * CH * 384 + 192 + i;
        LAS float* yw = (cgp == 0) ? (ybuf + (ch & 1) * CH * 32 + il) : (ybuf + 2 * CH * 32 + lane);
        f32x4 r4 = *(const LAS f32x4*)bb, d4 = *(const LAS f32x4*)(bb + 64), k4 = *(const LAS f32x4*)(bb + 128), n4 = *(const LAS f32x4*)(bb + 256), b4 = *(const LAS f32x4*)(bb + 320); float vi = vb[0];
        float sa;
        { f32x2 p = s01 * (f32x2){n4.x, n4.y}; p = s23 * (f32x2){n4.z, n4.w} + p; sa = red16(p.x + p.y); }
#pragma unroll 4
        for (int tl = 0; tl < CH; ++tl) {
            const int tn = (tl + 1 < CH) ? tl + 1 : tl;
            const f32x4 r4n = *(const LAS f32x4*)(bb + tn * 384), d4n = *(const LAS f32x4*)(bb + tn * 384 + 64), k4n = *(const LAS f32x4*)(bb + tn * 384 + 128),
                        n4n = *(const LAS f32x4*)(bb + tn * 384 + 256), b4n = *(const LAS f32x4*)(bb + tn * 384 + 320); const float vin = vb[tn * 384];
            const f32x2 vi2 = (f32x2){vi, vi}, sa2 = (f32x2){sa, sa};
            const f32x2 u01 = s01 * (f32x2){d4.x, d4.y} + vi2 * (f32x2){k4.x, k4.y}, u23 = s23 * (f32x2){d4.z, d4.w} + vi2 * (f32x2){k4.z, k4.w};
            s01 = sa2 * (f32x2){b4.x, b4.y} + u01; s23 = sa2 * (f32x2){b4.z, b4.w} + u23;
            f32x2 yp = s01 * (f32x2){r4.x, r4.y}; yp = s23 * (f32x2){r4.z, r4.w} + yp;
            f32x2 pn = s01 * (f32x2){n4n.x, n4n.y}; pn = s23 * (f32x2){n4n.z, n4n.w} + pn;
            float ya_ = yp.x + yp.y, sb_ = pn.x + pn.y;
            sb_ += dppf<0xB1>(sb_); ya_ += dppf<0xB1>(ya_); sb_ += dppf<0x4E>(sb_); ya_ += dppf<0x4E>(ya_);
            sb_ += dppf<0x141>(sb_); ya_ += dppf<0x141>(ya_); sb_ += dppf<0x140>(sb_); ya_ += dppf<0x140>(ya_);
            sa = sb_;
            yw[tl * 32] = ya_;
            r4 = r4n; d4 = d4n; k4 = k4n; n4 = n4n; b4 = b4n; vi = vin;
        }
        __syncthreads();
    }
    SP_YOUT(NCH - 1);
    float* so = C_OUT + O_RWKV_P + (((size_t)e * 2 + bn) * 12 + h) * 4096 + (size_t)i * 64 + 4 * cgp;
    *(f32x4*)so = (f32x4){s01.x, s01.y, s23.x, s23.y};
    __syncthreads();
#undef SP_GLOAD
#undef SP_LSTORE
#undef SP_YOUT
}

struct PreIn { u32x2 cr, ck, cv, pr, pk, pv; float hcur[8], hprv[8]; };
__device__ __forceinline__ void rwkv_chunk_preload(const Ctx& c, int item, int e, PreIn& P) {
    const bool is_s = item >= 3072; const int sidx = item - 3072;
    const int bh = item >> 7, n = is_s ? 1 : (item & 127), b = bh / 12, h = is_s ? (sidx % 12) : (bh % 12), ns = sidx / 12;
    const size_t R0 = is_s ? (size_t)(TP + 4 * ns) : (size_t)b * SEQ + 32 * n;
    const float* shift = C_IN(3) + ((size_t)e * 8 + ns) * 2432;
    const int tid = c.tid, t_ = tid >> 4, c4 = 4 * (tid & 15), col = h * 64 + c4;
    const bf16* hc = C_HB + (R0 + t_) * LDH + col; const bool hasprev = is_s ? (t_ != 0) : ((32 * n + t_) != 0);
    const u32x2 z2 = (u32x2){0u, 0u};
    P.cr = *(const u32x2*)(hc + EC_R); P.ck = *(const u32x2*)(hc + EC_K); P.cv = *(const u32x2*)(hc + EC_V);
    P.pr = hasprev ? *(const u32x2*)(hc - LDH + EC_R) : z2; P.pk = hasprev ? *(const u32x2*)(hc - LDH + EC_K) : z2; P.pv = hasprev ? *(const u32x2*)(hc - LDH + EC_V) : z2;
    const int cc = tid & 127, cl = EC_HW + cc, tb = tid >> 7;
#pragma unroll
    for (int k = 0; k < 8; ++k) { const int t = tb + 4 * k; P.hcur[k] = bf2f(C_HB[(R0 + t) * LDH + cl]);
        P.hprv[k] = is_s ? (t != 0 ? bf2f(C_HB[(R0 + t - 1) * LDH + cl]) : shift[cl]) : (((32 * n + t) != 0) ? bf2f(C_HB[(R0 + t - 1) * LDH + cl]) : 0.f); }
}
__device__ __forceinline__ void rwkv_chunk_precompute(const Ctx& c, int item, int e, const PreIn& P) {
    const bool is_s = item >= 3072; const int sidx = item - 3072;
    const int bh = item >> 7, n = is_s ? 1 : (item & 127), b = bh / 12, h = is_s ? (sidx % 12) : (bh % 12), ns = sidx / 12, ntok = is_s ? 4 : 32;
    const size_t R0 = is_s ? (size_t)(TP + 4 * ns) : (size_t)b * SEQ + 32 * n;
    const float* shift = C_IN(3) + ((size_t)e * 8 + ns) * 2432;
    LAS unsigned char* L = c.lds;
    LAS float* XW = (LAS float*)(L + 0); LAS float* XA = (LAS float*)(L + 8192);
    LAS bf16* LW = (LAS bf16*)(L + 16384); LAS bf16* LA = (LAS bf16*)(L + 20992);
    LAS float* PS = (LAS float*)(L + 25600);
    LAS bf16* KKt = (LAS bf16*)(L + 33792); LAS bf16* Bt = (LAS bf16*)(L + 38400); LAS bf16* Kt = (LAS bf16*)(L + 43008); LAS bf16* Rt = (LAS bf16*)(L + 47616);
    LAS bf16* Bh = (LAS bf16*)(L + 52224); LAS bf16* Kh = (LAS bf16*)(L + 56832); LAS bf16* Vb = (LAS bf16*)(L + 61440);
    LAS float* LB = (LAS float*)(L + 66048);
    LAS bf16* Lk = (LAS bf16*)(L + 70144); LAS bf16* Mb = (LAS bf16*)(L + 72704); LAS bf16* Mk = (LAS bf16*)(L + 75264);
    LAS float* SOL = (LAS float*)(L + 77824);
    LAS bf16* KTb = (LAS bf16*)(L + 94208); LAS bf16* UVb = (LAS bf16*)(L + 98816);
    LAS float* RTf = (LAS float*)(L + 103424); LAS float* c31 = (LAS float*)(L + 111616);
    const int tid = c.tid, lane = c.lane, wave = c.wave, fr = lane & 15, fq = lane >> 4, trow = (lane & 15) >> 2, tcol = 4 * (lane & 3);
    const int t_ = tid >> 4, c4 = 4 * (tid & 15), col = h * 64 + c4;
    const float* mu = C_IN(17) + e * 2432;
    const bf16* hc = C_HB + (R0 + t_) * LDH + col; const bool hasprev = is_s ? (t_ != 0) : ((32 * n + t_) != 0);
    const u32x2 cr = P.cr, ck = P.ck, cv = P.cv, pr = P.pr, pk = P.pk, pv = P.pv;
    f32x4 sh_r = (f32x4){0.f, 0.f, 0.f, 0.f}, sh_k = sh_r, sh_v = sh_r;
    if (is_s && t_ == 0) { sh_r = *(const f32x4*)(shift + EC_R + col); sh_k = *(const f32x4*)(shift + EC_K + col); sh_v = *(const f32x4*)(shift + EC_V + col); }
    { const int cc = tid & 127, cl = EC_HW + cc, tb = tid >> 7; const float muc = mu[cl];
#pragma unroll
        for (int k = 0; k < 8; ++k) { const int t = tb + 4 * k; const float hs = P.hcur[k] + (P.hprv[k] - P.hcur[k]) * muc;
            if (cc < 64) LW[t * 72 + cc] = (bf16)f2bf(1.0f - 2.0f / (1.0f + __expf(2.0f * hs))); else LA[t * 72 + cc - 64] = (bf16)f2bf(hs); } }
    __syncthreads();
    { const int p = wave >> 2, tt = (wave >> 1) & 1; const LAS bf16* As = p ? LA : LW; const bf16* WT = (p ? C_AUT : C_WUT) + ((size_t)e * 768 + h * 64) * 64; LAS float* X = p ? XA : XW;
#pragma unroll
        for (int cc = 0; cc < 2; ++cc) { const int ct = 2 * (wave & 1) + cc; f32x4 acc = (f32x4){0.f, 0.f, 0.f, 0.f};
#pragma unroll
            for (int ks = 0; ks < 2; ++ks) acc = mfma16(*(const LAS bf16x8*)(As + (16 * tt + fr) * 72 + 32 * ks + 8 * fq), *(const bf16x8*)(WT + (size_t)(16 * ct + fr) * 64 + 32 * ks + 8 * fq), acc);
#pragma unroll
            for (int r = 0; r < 4; ++r) X[(16 * tt + 4 * fq + r) * 64 + 16 * ct + fr] = acc[r]; } }
    __syncthreads();
    float rr[4], k2[4], vv[4], kkv[4], bb[4];
    for (int rep3 = 0; rep3 < REP3; ++rep3) { asm volatile("" ::: "memory");
    { const f32x4 xw4 = *(const LAS f32x4*)(XW + t_ * 64 + c4), xa4 = *(const LAS f32x4*)(XA + t_ * 64 + c4);
        const f32x4 w04 = *(const f32x4*)(C_IN(18) + e * 768 + col), a04 = *(const f32x4*)(C_IN(20) + e * 768 + col), kk4 = *(const f32x4*)(C_IN(22) + e * 768 + col), ka4 = *(const f32x4*)(C_IN(23) + e * 768 + col),
                    rk4 = *(const f32x4*)(C_IN(24) + e * 768 + col), mr4 = *(const f32x4*)(mu + EC_R + col), mk4 = *(const f32x4*)(mu + EC_K + col), mv4 = *(const f32x4*)(mu + EC_V + col);
        float crf[4], ckf[4], cvf[4], prf[4], pkf[4], pvf[4]; unpk4(cr, crf); unpk4(ck, ckf); unpk4(cv, cvf); unpk4(pr, prf); unpk4(pk, pkf); unpk4(pv, pvf);
        const bool tok_ok = t_ < ntok;
#pragma unroll
        for (int i = 0; i < 4; ++i) { prf[i] += sh_r[i]; pkf[i] += sh_k[i]; pvf[i] += sh_v[i]; }
        float wl[4], av[4], ssum = 0.f, bsum = 0.f;
#pragma unroll
        for (int i = 0; i < 4; ++i) { const float r = crf[i] + (prf[i] - crf[i]) * mr4[i], k = ckf[i] + (pkf[i] - ckf[i]) * mk4[i], v = cvf[i] + (pvf[i] - cvf[i]) * mv4[i];
            wl[i] = -0.6065306597126334f * sigmoidf_(w04[i] + xw4[i]); av[i] = sigmoidf_(a04[i] + xa4[i]);
            const float kk = tok_ok ? k * kk4[i] : 0.f; ssum += kk * kk; kkv[i] = kk; k2[i] = tok_ok ? k * (1.0f + (av[i] - 1.0f) * ka4[i]) : 0.f; rr[i] = tok_ok ? r : 0.f; vv[i] = tok_ok ? v : 0.f; bsum += rr[i] * k2[i] * rk4[i];
            if (!tok_ok) wl[i] = 0.f; }
        ssum = red16(ssum); bsum = red16(bsum); const float inv = rsqrtf(fmaxf(ssum, 1e-24f));
#pragma unroll
        for (int i = 0; i < 4; ++i) { kkv[i] *= inv; bb[i] = kkv[i] * av[i]; }
        if ((tid & 15) == 0 && tok_ok) C_BONUS[(R0 + t_) * 12 + h] = bsum;
        *(LAS f32x4*)(PS + t_ * 64 + c4) = (f32x4){wl[0], wl[1], wl[2], wl[3]}; }
    __syncthreads();
    if (tid < 64) { float run = 0.f;
#pragma unroll 8
        for (int t = 0; t < 32; ++t) { run += PS[t * 64 + tid]; PS[t * 64 + tid] = run; } }
    __syncthreads();
    { const f32x4 pt = *(const LAS f32x4*)(PS + t_ * 64 + c4), pe = *(const LAS f32x4*)(PS + 31 * 64 + c4); const f32x4 pp = (t_ > 0) ? *(const LAS f32x4*)(PS + (t_ - 1) * 64 + c4) : (f32x4){0.f, 0.f, 0.f, 0.f};
        float o_kk[4], o_b[4], o_k[4], o_r[4], o_bh[4], o_kh[4];
#pragma unroll
        for (int i = 0; i < 4; ++i) { const float ct = __expf(pt[i]), cp = __expf(pp[i]), ci = __expf(-pt[i]), chh = __expf(pe[i] - pt[i]);
            o_kk[i] = kkv[i] * cp; o_b[i] = bb[i] * ci; o_k[i] = k2[i] * ci; o_r[i] = rr[i] * ct; o_bh[i] = bb[i] * chh; o_kh[i] = k2[i] * chh; }
        *(LAS u32x2*)(KKt + t_ * 72 + c4) = (u32x2){pk2(o_kk[0], o_kk[1]), pk2(o_kk[2], o_kk[3])}; *(LAS u32x2*)(Bt + t_ * 72 + c4) = (u32x2){pk2(o_b[0], o_b[1]), pk2(o_b[2], o_b[3])};
        *(LAS u32x2*)(Kt + t_ * 72 + c4) = (u32x2){pk2(o_k[0], o_k[1]), pk2(o_k[2], o_k[3])}; *(LAS u32x2*)(Rt + t_ * 72 + c4) = (u32x2){pk2(o_r[0], o_r[1]), pk2(o_r[2], o_r[3])};
        *(LAS u32x2*)(Bh + t_ * 72 + c4) = (u32x2){pk2(o_bh[0], o_bh[1]), pk2(o_bh[2], o_bh[3])}; *(LAS u32x2*)(Kh + t_ * 72 + c4) = (u32x2){pk2(o_kh[0], o_kh[1]), pk2(o_kh[2], o_kh[3])};
        *(LAS u32x2*)(Vb + t_ * 72 + c4) = (u32x2){pk2(vv[0], vv[1]), pk2(vv[2], vv[3])};
        *(LAS f32x4*)(RTf + t_ * 64 + c4) = (f32x4){o_r[0], o_r[1], o_r[2], o_r[3]}; *(LAS f32x4*)(SOL + t_ * 128 + c4) = (f32x4){o_kk[0], o_kk[1], o_kk[2], o_kk[3]};
        if (t_ == 31) *(LAS f32x4*)(c31 + c4) = (f32x4){__expf(pt[0]), __expf(pt[1]), __expf(pt[2]), __expf(pt[3])}; }
    __syncthreads(); }
    { const int m = wave >> 1, tt = wave & 1; const LAS bf16* X = (m < 2) ? KKt : Rt; const LAS bf16* Yv = (m & 1) ? Kt : Bt;
#pragma unroll
        for (int st = 0; st < 2; ++st) { f32x4 acc = (f32x4){0.f, 0.f, 0.f, 0.f};
            if (st <= tt) {
#pragma unroll
                for (int ks = 0; ks < 2; ++ks) acc = mfma16(*(const LAS bf16x8*)(X + (16 * tt + fr) * 72 + 32 * ks + 8 * fq), *(const LAS bf16x8*)(Yv + (16 * st + fr) * 72 + 32 * ks + 8 * fq), acc); }
#pragma unroll
            for (int r = 0; r < 4; ++r) { const int t = 16 * tt + 4 * fq + r, s_ = 16 * st + fr; const bool keep = (m < 2) ? (s_ < t) : (s_ <= t); const float val = keep ? acc[r] : 0.f;
                if (m == 0) LB[t * 32 + (s_ & 3) * 8 + (s_ >> 2)] = val; else if (m == 1) Lk[t * 40 + s_] = (bf16)f2bf(val); else if (m == 2) Mb[t * 40 + s_] = (bf16)f2bf(val); else Mk[t * 40 + s_] = (bf16)f2bf(val); } } }
    __syncthreads();
    { const int tt = wave >> 2, ict = wave & 3;
        const f32x4 acc = mfma16(*(const LAS bf16x8*)(Lk + (16 * tt + fr) * 40 + 8 * fq), tr_frag(Vb + (8 * fq + trow) * 72 + 16 * ict + tcol, 4 * 72), (f32x4){0.f, 0.f, 0.f, 0.f});
#pragma unroll
        for (int r = 0; r < 4; ++r) SOL[(16 * tt + 4 * fq + r) * 128 + 64 + 16 * ict + fr] = acc[r]; }
    __syncthreads();
    { const int cidx = tid >> 2, q = tid & 3; float xq[8];
#pragma unroll
        for (int u = 0; u < 8; ++u) xq[u] = 0.f;
#pragma unroll
        for (int t = 0; t < 32; ++t) { float part = 0.f;
            if (t > 0) { const f32x4 la = *(const LAS f32x4*)(LB + t * 32 + q * 8); part = la[0] * xq[0];
                if (t > 4) part += la[1] * xq[1]; if (t > 8) part += la[2] * xq[2]; if (t > 12) part += la[3] * xq[3];
                if (t > 16) { const f32x4 lb = *(const LAS f32x4*)(LB + t * 32 + q * 8 + 4); part += lb[0] * xq[4];
                    if (t > 20) part += lb[1] * xq[5]; if (t > 24) part += lb[2] * xq[6]; if (t > 28) part += lb[3] * xq[7]; }
                part += dppf<0xB1>(part); part += dppf<0x4E>(part); }
            const float xt = SOL[t * 128 + cidx] - part;
            if (q == (t & 3)) { xq[t >> 2] = xt;
                if (cidx < 64) KTb[t * 72 + cidx] = (bf16)f2bf(xt); else UVb[t * 72 + cidx - 64] = (bf16)f2bf(-xt); } } }
    __syncthreads();
    for (int rep9 = 0; rep9 < REP9; ++rep9) { asm volatile("" ::: "memory");
    unsigned char* chk = C_CHK + (size_t)item * CHK_BYTES; bf16* Ag = (bf16*)(chk + CK_A); bf16* RQg = (bf16*)(chk + CK_RQ); float* GTg = (float*)(chk + CK_GT); float* YVTg = (float*)(chk + CK_YVT);
    const f32x4 z4 = (f32x4){0.f, 0.f, 0.f, 0.f};
    { const int jt = wave >> 1;
        const bf16x8 BhT = tr_frag(Bh + (8 * fq + trow) * 72 + 16 * jt + tcol, 4 * 72), KhT = tr_frag(Kh + (8 * fq + trow) * 72 + 16 * jt + tcol, 4 * 72);
#pragma unroll
        for (int cc = 0; cc < 2; ++cc) { const int ct = 2 * (wave & 1) + cc;
            const f32x4 aA = mfma16(BhT, tr_frag(KTb + (8 * fq + trow) * 72 + 16 * ct + tcol, 4 * 72), z4);
            f32x4 aG = mfma16(BhT, tr_frag(UVb + (8 * fq + trow) * 72 + 16 * ct + tcol, 4 * 72), z4); aG = mfma16(KhT, tr_frag(Vb + (8 * fq + trow) * 72 + 16 * ct + tcol, 4 * 72), aG);
#pragma unroll
            for (int r = 0; r < 4; ++r) { const int j = 16 * jt + 4 * fq + r, jp = 16 * ct + fr; Ag[j * 72 + jp] = (bf16)f2bf(((j == jp) ? c31[j] : 0.f) - aA[r]); }
            *(f32x4*)(GTg + (16 * ct + fr) * 68 + 16 * jt + 4 * fq) = aG; } }
    { const int tt = wave >> 2, jt2 = wave & 3; const bf16x8 MbF = *(const LAS bf16x8*)(Mb + (16 * tt + fr) * 40 + 8 * fq);
        const f32x4 a = mfma16(MbF, tr_frag(KTb + (8 * fq + trow) * 72 + 16 * jt2 + tcol, 4 * 72), z4);
#pragma unroll
        for (int r = 0; r < 4; ++r) { const int t = 16 * tt + 4 * fq + r, j = 16 * jt2 + fr; RQg[t * 72 + j] = (bf16)f2bf(RTf[t * 64 + j] - a[r]); }
        f32x4 y = mfma16(MbF, tr_frag(UVb + (8 * fq + trow) * 72 + 16 * jt2 + tcol, 4 * 72), z4);
        y = mfma16(*(const LAS bf16x8*)(Mk + (16 * tt + fr) * 40 + 8 * fq), tr_frag(Vb + (8 * fq + trow) * 72 + 16 * jt2 + tcol, 4 * 72), y);
        *(f32x4*)(YVTg + (16 * jt2 + fr) * 36 + 16 * tt + 4 * fq) = y; }
    __syncthreads(); }
}
__device__ __forceinline__ void rwkv_stream(const Ctx& c, int bh, int it, int e) {
    const int b = bh / 12, h = bh % 12, lane = c.lane, fr = lane & 15, fq = lane >> 4;
    LAS bf16* Sl = (LAS bf16*)c.lds + c.wave * (16 * 72);
    const unsigned char* chk0 = C_CHK + (size_t)bh * 128 * CHK_BYTES;
    float* ya = C_YA + ((size_t)b * SEQ) * 768 + h * 64 + 16 * it + fr;
    f32x4 S[4];
#pragma unroll
    for (int jt = 0; jt < 4; ++jt) S[jt] = (f32x4){0.f, 0.f, 0.f, 0.f};
    bf16x8 A0[4][2], R0f[2][2], A1[4][2], R1f[2][2]; f32x4 G0[4], Y0[2], G1[4], Y1[2];
#define ST_LOAD(AF, RF, GV, YV, n_) do { const unsigned char* base_ = chk0 + (size_t)(n_) * CHK_BYTES; \
        _Pragma("unroll") for (int jt = 0; jt < 4; ++jt) { _Pragma("unroll") for (int ks = 0; ks < 2; ++ks) AF[jt][ks] = *(const bf16x8*)((const bf16*)(base_ + CK_A) + (16 * jt + fr) * 72 + 32 * ks + 8 * fq); \
            GV[jt] = *(const f32x4*)((const float*)(base_ + CK_GT) + (16 * it + fr) * 68 + 16 * jt + 4 * fq); } \
        _Pragma("unroll") for (int tt = 0; tt < 2; ++tt) { _Pragma("unroll") for (int ks = 0; ks < 2; ++ks) RF[tt][ks] = *(const bf16x8*)((const bf16*)(base_ + CK_RQ) + (16 * tt + fr) * 72 + 32 * ks + 8 * fq); \
            YV[tt] = *(const f32x4*)((const float*)(base_ + CK_YVT) + (16 * it + fr) * 36 + 16 * tt + 4 * fq); } } while (0)
#define ST_STEP(AF, RF, GV, YV, n_, tmax_) do { \
        _Pragma("unroll") for (int jt = 0; jt < 4; ++jt) *(LAS u32x2*)(Sl + fr * 72 + 16 * jt + 4 * fq) = (u32x2){pk2(S[jt][0], S[jt][1]), pk2(S[jt][2], S[jt][3])}; \
        asm volatile("s_waitcnt lgkmcnt(0)" ::: "memory"); \
        const bf16x8 Sf0 = *(const LAS bf16x8*)(Sl + fr * 72 + 8 * fq), Sf1 = *(const LAS bf16x8*)(Sl + fr * 72 + 32 + 8 * fq); \
        asm volatile("s_waitcnt lgkmcnt(0)" ::: "memory"); \
        _Pragma("unroll") for (int tt = 0; tt < 2; ++tt) { f32x4 y_ = mfma16(RF[tt][0], Sf0, YV[tt]); y_ = mfma16(RF[tt][1], Sf1, y_); \
            _Pragma("unroll") for (int r = 0; r < 4; ++r) if (16 * tt + 4 * fq + r < (tmax_)) ya[(size_t)(32 * (n_) + 16 * tt + 4 * fq + r) * 768] = y_[r]; } \
        _Pragma("unroll") for (int jt = 0; jt < 4; ++jt) { f32x4 a_ = mfma16(AF[jt][0], Sf0, GV[jt]); S[jt] = mfma16(AF[jt][1], Sf1, a_); } } while (0)
    ST_LOAD(A0, R0f, G0, Y0, 0);
#pragma unroll 1
    for (int n = 0; n < 128; n += 2) {
        ST_LOAD(A1, R1f, G1, Y1, n + 1);
        ST_STEP(A0, R0f, G0, Y0, n, 32);
        if (n + 2 < 128) ST_LOAD(A0, R0f, G0, Y0, n + 2);
        ST_STEP(A1, R1f, G1, Y1, n + 1, 32);
    }
    float* so = C_OUT + O_RWKV_P + (((size_t)e * 2 + b) * 12 + h) * 4096 + (size_t)(16 * it + fr) * 64 + 4 * fq;
#pragma unroll
    for (int jt = 0; jt < 4; ++jt) *(f32x4*)(so + 16 * jt) = S[jt];
}
__device__ __forceinline__ void rwkv_stream_block(const Ctx& c, int bh, int e) {
    const int b = bh / 12, h = bh % 12, tid = c.tid, lane = c.lane, wave = c.wave, fr = lane & 15, fq = lane >> 4, it = wave;
    LAS unsigned char* slots = c.lds;
    LAS bf16* Sl = (LAS bf16*)(c.lds + 2 * CHK_BYTES) + wave * (16 * 72);
    const unsigned char* g0 = C_CHK + (size_t)bh * 128 * CHK_BYTES + tid * 16;
    float* ya = C_YA + ((size_t)b * SEQ) * 768 + h * 64 + 16 * it + fr;
    f32x4 S[4];
#pragma unroll
    for (int jt = 0; jt < 4; ++jt) S[jt] = (f32x4){0.f, 0.f, 0.f, 0.f};
    u32x4 P0[5], P1[5], P2[5], P3[5];
#define SB_GLOAD(P, n_) do { const int nn_ = (n_) < 128 ? (n_) : 127;     \
        _Pragma("unroll") for (int k = 0; k < 5; ++k) P[k] = *(const u32x4*)(g0 + (size_t)nn_ * CHK_BYTES + k * 8192); } while (0)
#define SB_LWRITE(P, s_) do { _Pragma("unroll") for (int k = 0; k < 5; ++k) *(LAS u32x4*)(slots + (s_) * CHK_BYTES + tid * 16 + k * 8192) = P[k]; } while (0)
#define SB_STEP(s_, n_) do { if (wave < 4) { const LAS unsigned char* sb_ = slots + (s_) * CHK_BYTES; \
        bf16x8 af_[4][2], rf_[2][2]; f32x4 gv_[4], yv_[2];         \
        _Pragma("unroll") for (int jt = 0; jt < 4; ++jt) { const LAS bf16* a_ = (const LAS bf16*)(sb_ + CK_A) + (16 * jt + fr) * 72 + 8 * fq; af_[jt][0] = *(const LAS bf16x8*)a_; af_[jt][1] = *(const LAS bf16x8*)(a_ + 32); \
            gv_[jt] = *(const LAS f32x4*)((const LAS float*)(sb_ + CK_GT) + (16 * it + fr) * 68 + 16 * jt + 4 * fq); } \
        _Pragma("unroll") for (int tt = 0; tt < 2; ++tt) { const LAS bf16* rq_ = (const LAS bf16*)(sb_ + CK_RQ) + (16 * tt + fr) * 72 + 8 * fq; rf_[tt][0] = *(const LAS bf16x8*)rq_; rf_[tt][1] = *(const LAS bf16x8*)(rq_ + 32); \
            yv_[tt] = *(const LAS f32x4*)((const LAS float*)(sb_ + CK_YVT) + (16 * it + fr) * 36 + 16 * tt + 4 * fq); } \
        _Pragma("unroll") for (int jt = 0; jt < 4; ++jt) *(LAS u32x2*)(Sl + fr * 72 + 16 * jt + 4 * fq) = (u32x2){pk2(S[jt][0], S[jt][1]), pk2(S[jt][2], S[jt][3])}; \
        asm volatile("s_waitcnt lgkmcnt(0)" ::: "memory"); \
        const bf16x8 Sf0 = *(const LAS bf16x8*)(Sl + fr * 72 + 8 * fq), Sf1 = *(const LAS bf16x8*)(Sl + fr * 72 + 32 + 8 * fq); \
        asm volatile("s_waitcnt lgkmcnt(0)" ::: "memory"); __builtin_amdgcn_sched_barrier(0); \
        _Pragma("unroll") for (int jt = 0; jt < 4; ++jt) { f32x4 t_ = mfma16(af_[jt][0], Sf0, gv_[jt]); S[jt] = mfma16(af_[jt][1], Sf1, t_); } \
        _Pragma("unroll") for (int tt = 0; tt < 2; ++tt) { f32x4 y_ = mfma16(rf_[tt][0], Sf0, yv_[tt]); y_ = mfma16(rf_[tt][1], Sf1, y_); \
            _Pragma("unroll") for (int r = 0; r < 4; ++r) ya[(size_t)(32 * (n_) + 16 * tt + 4 * fq + r) * 768] = y_[r]; } } } while (0)
    SB_GLOAD(P0, 0); SB_GLOAD(P1, 1); SB_GLOAD(P2, 2); SB_GLOAD(P3, 3);
    SB_LWRITE(P0, 0); __syncthreads();
#pragma unroll 1
    for (int n = 0; n < 128; n += 4) {
        SB_LWRITE(P1, 1); SB_GLOAD(P0, n + 4); SB_STEP(0, n); __syncthreads();
        SB_LWRITE(P2, 0); SB_GLOAD(P1, n + 5); SB_STEP(1, n + 1); __syncthreads();
        SB_LWRITE(P3, 1); SB_GLOAD(P2, n + 6); SB_STEP(0, n + 2); __syncthreads();
        SB_LWRITE(P0, 0); SB_GLOAD(P3, n + 7); SB_STEP(1, n + 3); __syncthreads();
    }
#undef SB_GLOAD
#undef SB_LWRITE
#undef SB_STEP
    if (wave < 4) { float* so = C_OUT + O_RWKV_P + (((size_t)e * 2 + b) * 12 + h) * 4096 + (size_t)(16 * it + fr) * 64 + 4 * fq;
#pragma unroll
        for (int jt = 0; jt < 4; ++jt) *(f32x4*)(so + 16 * jt) = S[jt]; }
}
__device__ __forceinline__ void rwkv_stream_sample(const Ctx& c, int sidx, int it, int e) {
    const int ns = sidx / 12, h = sidx % 12, lane = c.lane, fr = lane & 15, fq = lane >> 4;
    LAS bf16* Sl = (LAS bf16*)c.lds + c.wave * (16 * 72);
    const unsigned char* chk0 = C_CHK + (size_t)(3072 + sidx) * CHK_BYTES;
    float* ya = C_YA + ((size_t)(TP + 4 * ns)) * 768 + h * 64 + 16 * it + fr;
    const float* si = C_IN(2) + (((size_t)e * 8 + ns) * 12 + h) * 4096 + (size_t)(16 * it + fr) * 64 + 4 * fq;
    f32x4 S[4];
#pragma unroll
    for (int jt = 0; jt < 4; ++jt) S[jt] = *(const f32x4*)(si + 16 * jt);
    bf16x8 A0[4][2], R0f[2][2]; f32x4 G0[4], Y0[2];
    ST_LOAD(A0, R0f, G0, Y0, 0);
    ST_STEP(A0, R0f, G0, Y0, 0, 4);
    float* so = C_OUT + O_RWKV_S + (((size_t)e * 8 + ns) * 12 + h) * 4096 + (size_t)(16 * it + fr) * 64 + 4 * fq;
#pragma unroll
    for (int jt = 0; jt < 4; ++jt) *(f32x4*)(so + 16 * jt) = S[jt];
}
#undef ST_LOAD
#undef ST_STEP
__device__ __forceinline__ void phase_even_tok_pre(Ctx c, int l) {
    const int e = l >> 1;
    constexpr int NI = 3072 + 96;
    PreIn A; if (c.bid < NI) rwkv_chunk_preload(c, c.bid, e, A);
    for (int it = c.bid; it < NI; it += c.G) { PreIn B; const int nx = (it + c.G < NI) ? it + c.G : it;
        rwkv_chunk_preload(c, nx, e, B); rwkv_chunk_precompute(c, it, e, A); A = B; }
}
__device__ __forceinline__ void phase_even_scan(Ctx c, int l) {
    const int e = l >> 1;
    if (c.G >= 240) {
        if (c.bid < 24) { for (int rp = 0; rp < REPS; ++rp) { rwkv_stream_block(c, c.bid, e); __syncthreads(); LAUNDER_C(c); } }
        else { Ctx h = c; h.bid = c.bid - 24; h.G = c.G - 24; LAUNDER_C(h);
            if (h.bid < 96) { if (h.wave < 4) rwkv_stream_sample(h, h.bid, h.wave, e); __syncthreads(); }
            even_helper_work(h, l); }
    } else {
        for (int it = c.bid; it < 24; it += c.G) { rwkv_stream_block(c, it, e); __syncthreads(); }
        for (int it = c.bid; it < 96; it += c.G) { if (c.wave < 4) rwkv_stream_sample(c, it, c.wave, e); __syncthreads(); }
        LAUNDER_C(c);
        even_helper_work(c, l);
    }
}
__device__ __forceinline__ void phase_even_ubuild(const Ctx& c, int l) {
    const int e = l >> 1; const float* r_k = C_IN(24) + e * 768; const float* lg = C_IN(25) + e * 768; const float* lb = C_IN(26) + e * 768; const float* muv = C_IN(17) + e * 2432 + EC_V;
    for (int R = c.bid * 8 + c.wave; R < TT; R += c.G * 8) {
        const bool hasprev = (R < TP) ? ((R & (SEQ - 1)) != 0) : (((R - TP) & 3) != 0);
        const float* shiftv = C_IN(3) + ((size_t)e * 8 + ((R >= TP) ? ((R - TP) >> 2) : 0)) * 2432 + EC_V;
        const bf16* hrow = C_HB + (size_t)R * LDH;
#pragma unroll 1
        for (int hb = 0; hb < 12; hb += 4) {
            float y[4], gate[4], cvv[4], pvv[4], bon[4], lgv[4], lbv[4], mv[4];
#pragma unroll
            for (int k = 0; k < 4; ++k) { const int col = (hb + k) * 64 + c.lane;
                y[k] = C_YA[(size_t)R * 768 + col]; gate[k] = bf2f(hrow[EC_GA + col]); cvv[k] = bf2f(hrow[EC_V + col]);
                pvv[k] = hasprev ? bf2f(hrow[EC_V + col - LDH]) : ((R < TP) ? 0.f : shiftv[col]);
                bon[k] = C_BONUS[(size_t)R * 12 + hb + k]; lgv[k] = lg[col]; lbv[k] = lb[col]; mv[k] = muv[col]; }
#pragma unroll
            for (int k = 0; k < 4; ++k) { const int col = (hb + k) * 64 + c.lane;
                const float mean = wave_sum(y[k]) * (1.0f / 64.0f); const float dlt = y[k] - mean; const float var = wave_sum(dlt * dlt) * (1.0f / 64.0f);
                const float yn = dlt * rsqrtf(var + 64e-5f) * lgv[k] + lbv[k];
                const float bonus = bon[k] * (cvv[k] + (pvv[k] - cvv[k]) * mv[k]);
                C_U[(size_t)R * EVEN_OUT + col] = (bf16)f2bf((yn + bonus) * siluf_(gate[k])); }
        }
    }
}

__device__ __forceinline__ void even_combine_dil(const Ctx& c) {
    const int hh = c.lane >> 4, d4 = 4 * (c.lane & 15);
    for (int R0 = c.bid * 8 + c.wave; R0 < TP; R0 += 2 * c.G * 8) {
        const int R1 = (R0 + c.G * 8 < TP) ? R0 + c.G * 8 : R0;
        float ls[2][3]; f32x4 og[2][3]; u32x2 gw[2];
#pragma unroll
        for (int k = 0; k < 2; ++k) { const int R = k ? R1 : R0;
#pragma unroll
            for (int g = 0; g < 3; ++g) { ls[k][g] = C_LSE[((size_t)g * TT + R) * 4 + hh]; og[k][g] = *(const f32x4*)(C_OG + ((size_t)g * TT + R) * 256 + hh * 64 + d4); }
            gw[k] = *(const u32x2*)(C_HB + (size_t)R * LDH + EC_GB + hh * 64 + d4); }
#pragma unroll
        for (int k = 0; k < 2; ++k) { const int R = k ? R1 : R0;
            const float mx = fmaxf(ls[k][0], fmaxf(ls[k][1], ls[k][2])); const float w0 = __expf(ls[k][0] - mx), w1 = __expf(ls[k][1] - mx), w2 = __expf(ls[k][2] - mx); const float inv = 1.0f / (w0 + w1 + w2);
            const f32x4 y = (og[k][0] * w0 + og[k][1] * w1 + og[k][2] * w2) * inv;
            float gt[4]; unpk4(gw[k], gt);
            *(u32x2*)(C_U + (size_t)R * EVEN_OUT + 768 + hh * 64 + d4) = (u32x2){pk2(y.x * siluf_(gt[0]), y.y * siluf_(gt[1])), pk2(y.z * siluf_(gt[2]), y.w * siluf_(gt[3]))}; }
    }
}
__device__ __forceinline__ void rot8(u32x4 w, const float* tb, float scale, float (&y)[8]) {
    float x[8]; unpk8(w, x); const f32x4 t0 = *(const f32x4*)tb, t1 = *(const f32x4*)(tb + 4);
    const float cs[8] = {t0.x, t0.y, t0.z, t0.w, t1.x, t1.y, t1.z, t1.w};
#pragma unroll
    for (int p = 0; p < 4; ++p) { const float co = cs[2 * p], si = cs[2 * p + 1], x0 = x[2 * p], x1 = x[2 * p + 1]; y[2 * p] = (x0 * co - x1 * si) * scale; y[2 * p + 1] = (x1 * co + x0 * si) * scale; }
}
__device__ __forceinline__ void ret_prompt_unit(const Ctx& c, int unit, int o) {
    const int b = unit / 48, h = (unit >> 3) % 6, es = unit & 7;
    LAS bf16* Qc = (LAS bf16*)c.lds;
    LAS bf16* Kc = Qc + 64 * 264;
    LAS bf16* Vc = Kc + 64 * 264;
    LAS bf16* Vz = Vc + 64 * 40;
    LAS bf16* Sb = Vz + 64 * 40;
    LAS bf16* Rt = Sb + 64 * 72;
    const float lg = LG2G[h];
    const int tid = c.tid, lane = c.lane, wave = c.wave, fr = lane & 15, fq = lane >> 4, it = wave >> 1, jt0 = (wave & 1) * 2, eto = wave & 1;
    f32x4 Racc[2][2];
#pragma unroll
    for (int a = 0; a < 2; ++a)
#pragma unroll
        for (int q = 0; q < 2; ++q) Racc[a][q] = (f32x4){0.f, 0.f, 0.f, 0.f};
    for (int i = tid; i < 32 * 264 / 2; i += 512) ((LAS unsigned*)Rt)[i] = 0u;
    const float g64 = exp2f(lg * 64.f);
    const int sj = tid >> 3, part = tid & 7;
    const int vj = (tid & 255) >> 2, vp = tid & 3; const float zeta = exp2f(lg * (float)(63 - vj));
    const bf16* gq = C_HB + ((size_t)b * SEQ + sj) * LDH + OC_Q + h * 256 + part * 32;
    const bf16* gk = gq + (OC_K - OC_Q); const bf16* gv = C_HB + ((size_t)b * SEQ + vj) * LDH + OC_V + h * 256 + es * 32 + vp * 8;
    u32x4 pq[4], pk[4], pv;
#pragma unroll
    for (int q = 0; q < 4; ++q) { pq[q] = *(const u32x4*)(gq + 8 * q); pk[q] = *(const u32x4*)(gk + 8 * q); }
    pv = *(const u32x4*)gv;
    const int trow = (lane & 15) >> 2, tcol = 4 * (lane & 3);
#pragma unroll 1
    for (int ch = 0; ch < 64; ++ch) {
        const size_t row0 = (size_t)b * SEQ + ch * 64;
#pragma unroll
        for (int q = 0; q < 4; ++q) { *(LAS u32x4*)(Qc + sj * 264 + part * 32 + 8 * q) = pq[q]; *(LAS u32x4*)(Kc + sj * 264 + part * 32 + 8 * q) = pk[q]; }
        if (wave < 4) { *(LAS u32x4*)(Vc + vj * 40 + vp * 8) = pv; float x[8]; unpk8(pv, x);
            *(LAS u32x4*)(Vz + vj * 40 + vp * 8) = (u32x4){pk2(x[0] * zeta, x[1] * zeta), pk2(x[2] * zeta, x[3] * zeta), pk2(x[4] * zeta, x[5] * zeta), pk2(x[6] * zeta, x[7] * zeta)}; }
        { const size_t adv = (size_t)((ch + 1 < 64) ? ch + 1 : 63) * 64 * LDH;
#pragma unroll
            for (int q = 0; q < 4; ++q) { pq[q] = *(const u32x4*)(gq + adv + 8 * q); pk[q] = *(const u32x4*)(gk + adv + 8 * q); }
            pv = *(const u32x4*)(gv + adv); }
        __syncthreads();
        f32x4 accS[2], accQ = (f32x4){0.f, 0.f, 0.f, 0.f};
#pragma unroll
        for (int q = 0; q < 2; ++q) accS[q] = (f32x4){0.f, 0.f, 0.f, 0.f};
#pragma unroll
        for (int kp = 0; kp < 4; ++kp) {
            bf16x8 Qf2[2], Kf2[2][2], Rf2[2];
#pragma unroll
            for (int kk = 0; kk < 2; ++kk) { const int ks = 2 * kp + kk; Qf2[kk] = *(const LAS bf16x8*)(Qc + (16 * it + fr) * 264 + 32 * ks + 8 * fq);
                Rf2[kk] = *(const LAS bf16x8*)(Rt + (16 * eto + fr) * 264 + 32 * ks + 8 * fq);
#pragma unroll
                for (int q = 0; q < 2; ++q) Kf2[kk][q] = *(const LAS bf16x8*)(Kc + (16 * (jt0 + q) + fr) * 264 + 32 * ks + 8 * fq); }
            asm volatile("s_waitcnt lgkmcnt(0)" ::: "memory"); __builtin_amdgcn_sched_barrier(0);
#pragma unroll
            for (int kk = 0; kk < 2; ++kk) { accQ = mfma16(Qf2[kk], Rf2[kk], accQ);
#pragma unroll
                for (int q = 0; q < 2; ++q) accS[q] = mfma16(Qf2[kk], Kf2[kk][q], accS[q]); }
        }
#pragma unroll
        for (int jj = 0; jj < 2; ++jj) { const int jt = jt0 + jj;
#pragma unroll
            for (int r = 0; r < 4; ++r) { const int i = 16 * it + 4 * fq + r, j = 16 * jt + fr; const float val = (i >= j) ? accS[jj][r] * exp2f(lg * (float)(i - j)) : 0.f; Sb[i * 72 + j] = (bf16)f2bf(val); } }
        __syncthreads();
        { bf16x8 Sfr[2], Vfr[2], Kfr[2][2], Zfr[2][2];
#pragma unroll
            for (int k2 = 0; k2 < 2; ++k2) { Sfr[k2] = *(const LAS bf16x8*)(Sb + (16 * it + fr) * 72 + 32 * k2 + 8 * fq);
                Vfr[k2] = tr_frag(Vc + (32 * k2 + 8 * fq + trow) * 40 + 16 * eto + tcol, 4 * 40);
#pragma unroll
                for (int dd = 0; dd < 2; ++dd) Kfr[dd][k2] = tr_frag(Kc + (32 * k2 + 8 * fq + trow) * 264 + 16 * (2 * wave + dd) + tcol, 4 * 264);
#pragma unroll
                for (int et = 0; et < 2; ++et) Zfr[et][k2] = tr_frag(Vz + (32 * k2 + 8 * fq + trow) * 40 + 16 * et + tcol, 4 * 40); }
            asm volatile("s_waitcnt lgkmcnt(0)" ::: "memory"); __builtin_amdgcn_sched_barrier(0);
            { f32x4 a2 = mfma16(Sfr[0], Vfr[0], (f32x4){0.f, 0.f, 0.f, 0.f}); a2 = mfma16(Sfr[1], Vfr[1], a2);
#pragma unroll
                for (int r = 0; r < 4; ++r) { const int i = 16 * it + 4 * fq + r; C_YR[(row0 + i) * 1536 + h * 256 + es * 32 + 16 * eto + fr] = a2[r] + accQ[r] * exp2f(lg * (float)(i + 1)); } }
#pragma unroll
            for (int dd = 0; dd < 2; ++dd)
#pragma unroll
                for (int et = 0; et < 2; ++et) { f32x4 a = Racc[dd][et] * g64; a = mfma16(Kfr[dd][0], Zfr[et][0], a); Racc[dd][et] = mfma16(Kfr[dd][1], Zfr[et][1], a); } }
        __syncthreads();
#pragma unroll
        for (int dd = 0; dd < 2; ++dd)
#pragma unroll
            for (int et = 0; et < 2; ++et) { const f32x4 a = Racc[dd][et]; const int dt = 2 * wave + dd;
                *(LAS u32x2*)(Rt + (16 * et + fr) * 264 + 16 * dt + 4 * fq) = (u32x2){pk2(a[0], a[1]), pk2(a[2], a[3])}; }
    }
    float* ro = C_OUT + O_RET_P + ((((size_t)o * 2 + b) * 6 + h) * 256) * 256 + es * 32;
#pragma unroll
    for (int dd = 0; dd < 2; ++dd)
#pragma unroll
        for (int et = 0; et < 2; ++et)
#pragma unroll
            for (int r = 0; r < 4; ++r) ro[(size_t)(16 * (2 * wave + dd) + 4 * fq + r) * 256 + 16 * et + fr] = Racc[dd][et][r];
    __syncthreads();
}
__device__ __forceinline__ void ret_sample_unit(const Ctx& c, int unit, int o) {
    const int n = unit / 6, h = unit % 6, tid = c.tid;
    LAS float* qs = (LAS float*)c.lds; LAS float* ks = qs + 1024; LAS float* vs = ks + 1024; LAS float* red = vs + 1024; LAS float* sc = red + 2048;
    const float lg = LG2G[h];
    for (int idx = tid; idx < 4 * 256; idx += 512) { const int t = idx >> 8, dd = idx & 255; const bf16* hr = C_HB + (size_t)(TP + n * 4 + t) * LDH + h * 256 + dd; qs[idx] = bf2f(hr[OC_Q]); ks[idx] = bf2f(hr[OC_K]); }
    for (int idx = tid; idx < 4 * 256; idx += 512) { const int t = idx >> 8, ee = idx & 255; vs[idx] = bf2f(C_HB[(size_t)(TP + n * 4 + t) * LDH + OC_V + h * 256 + ee]); }
    __syncthreads();
    if (tid < 16) { const int i = tid >> 2, j = tid & 3; float a = 0.f; for (int d = 0; d < 256; ++d) a += qs[i * 256 + d] * ks[j * 256 + d]; sc[tid] = (j <= i) ? a * exp2f(lg * (float)(i - j)) : 0.f; }
    __syncthreads();
    const int ee = tid & 255, dh = tid >> 8;
    const float* R0 = C_IN(7) + ((((size_t)o * 8 + n) * 6 + h) * 256) * 256; float* Rn = C_OUT + O_RET_S + ((((size_t)o * 8 + n) * 6 + h) * 256) * 256;
    const float g4 = exp2f(lg * 4.f), z0 = exp2f(lg * 3.f), z1 = exp2f(lg * 2.f), z2 = exp2f(lg), z3 = 1.0f;
    const float v0 = vs[ee] * z0, v1 = vs[256 + ee] * z1, v2 = vs[512 + ee] * z2, v3 = vs[768 + ee] * z3;
    float acc[4] = {0.f, 0.f, 0.f, 0.f};
#pragma unroll 4
    for (int d = dh * 128; d < dh * 128 + 128; ++d) { const float r0 = R0[(size_t)d * 256 + ee];
        acc[0] += qs[d] * r0; acc[1] += qs[256 + d] * r0; acc[2] += qs[512 + d] * r0; acc[3] += qs[768 + d] * r0;
        Rn[(size_t)d * 256 + ee] = g4 * r0 + ks[d] * v0 + ks[256 + d] * v1 + ks[512 + d] * v2 + ks[768 + d] * v3; }
#pragma unroll
    for (int i = 0; i < 4; ++i) red[(dh * 4 + i) * 256 + ee] = acc[i];
    __syncthreads();
    if (dh == 0) {
#pragma unroll
        for (int i = 0; i < 4; ++i) { float ov = (red[i * 256 + ee] + red[(4 + i) * 256 + ee]) * exp2f(lg * (float)(i + 1));
            for (int j = 0; j <= i; ++j) ov += sc[i * 4 + j] * vs[j * 256 + ee];
            C_YR[(size_t)(TP + n * 4 + i) * 1536 + h * 256 + ee] = ov; } }
    __syncthreads();
}
__device__ __forceinline__ void odd_helper_work(Ctx c, int l) {
    mem_attn_all(c, l, OC_QM, OC_GM, 1536, ODD_OUT);
    LAUNDER_C(c);
    if (l < 3) convert_layer_weights(c, l + 1);
}
__device__ __forceinline__ void phase_odd_tok(Ctx c, int l) {
    const int o = l >> 1;
    if (c.G >= 200) {
        if (c.bid < 96) ret_prompt_unit(c, c.bid, o);
        else if (c.bid < 144) ret_sample_unit(c, c.bid - 96, o);
        else { Ctx h = c; h.bid = c.bid - 144; h.G = c.G - 144; odd_helper_work(h, l); }
    } else {
        for (int it = c.bid; it < 144; it += c.G) { if (it < 96) ret_prompt_unit(c, it, o); else ret_sample_unit(c, it - 96, o); }
        LAUNDER_C(c);
        odd_helper_work(c, l);
    }
}
__device__ __forceinline__ void phase_odd_ubuild(const Ctx& c) {
    for (int R = c.bid * 8 + c.wave; R < TT; R += c.G * 8) {
#pragma unroll 1
        for (int hb = 0; hb < 6; hb += 3) {
            f32x4 ov[3]; u32x2 gw[3];
#pragma unroll
            for (int k = 0; k < 3; ++k) { const int col = (hb + k) * 256 + 4 * c.lane; ov[k] = *(const f32x4*)(C_YR + (size_t)R * 1536 + col); gw[k] = *(const u32x2*)(C_HB + (size_t)R * LDH + OC_G + col); }
#pragma unroll
            for (int k = 0; k < 3; ++k) { const int col = (hb + k) * 256 + 4 * c.lane; const f32x4 o = ov[k];
                const float ss = wave_sum(o.x * o.x + o.y * o.y + o.z * o.z + o.w * o.w); const float scl = rsqrtf(ss * (1.0f / 256.0f) + 1e-6f);
                float g[4]; unpk4(gw[k], g);
                *(u32x2*)(C_U + (size_t)R * DM + col) = (u32x2){pk2(o.x * scl * siluf_(g[0]), o.y * scl * siluf_(g[1])), pk2(o.z * scl * siluf_(g[2]), o.w * scl * siluf_(g[3]))}; }
        }
    }
}
__device__ __forceinline__ void small_outproj(const Ctx& c, int wt, int K, int l) {
    const int lane = c.lane, r = lane & 31, hl = lane >> 5, nks = K / 128;
    const bf16* ap = C_U + (size_t)(TP + r) * K + 8 * hl + c.wave * nks * 16; const bf16* bp = C_WTOUT_L(l) + (size_t)(32 * wt + r) * K + 8 * hl + c.wave * nks * 16;
    f32x16 acc;
#pragma unroll
    for (int i = 0; i < 16; ++i) acc[i] = 0.f;
    if (nks == 16) {
#pragma unroll
        for (int ks = 0; ks < 16; ++ks) acc = mfma32(*(const bf16x8*)(ap + 16 * ks), *(const bf16x8*)(bp + 16 * ks), acc);
    } else {
#pragma unroll
        for (int ks = 0; ks < 12; ++ks) acc = mfma32(*(const bf16x8*)(ap + 16 * ks), *(const bf16x8*)(bp + 16 * ks), acc);
    }
    LAS float* part = (LAS float*)c.lds;
#pragma unroll
    for (int i = 0; i < 16; ++i) part[(c.wave * 16 + i) * 64 + lane] = acc[i];
    __syncthreads();
    for (int idx = c.tid; idx < 1024; idx += 512) { float sum = 0.f;
#pragma unroll
        for (int w = 0; w < 8; ++w) sum += part[w * 1024 + idx];
        const int i = idx >> 6, ln = idx & 63, row = TP + (i & 3) + 8 * (i >> 2) + 4 * (ln >> 5), col = 32 * wt + (ln & 31);
        C_Z[(size_t)row * DM + col] = C_XZ[(size_t)row * DM + col] * ALPHA + sum; }
    __syncthreads();
}
__device__ __forceinline__ void phase_ln(const Ctx& c, int l) {
    const float* g = C_IN(15) + l * DM; const float* bta = C_IN(16) + l * DM;
    f32x4 gg[8], bb[8];
#pragma unroll
    for (int j = 0; j < 8; ++j) { const int col = 4 * c.lane + 256 * j; gg[j] = *(const f32x4*)(g + col); bb[j] = *(const f32x4*)(bta + col); }
    for (int R0 = c.bid * 8 + c.wave; R0 < TT; R0 += 2 * c.G * 8) {
        const int R1 = R0 + c.G * 8; const bool has1 = R1 < TT; const int R1c = has1 ? R1 : R0;
        f32x4 v0[8], v1[8]; float s0 = 0.f, s1 = 0.f;
        { const f32x4* z0 = (const f32x4*)(C_Z + (size_t)R0 * DM) + c.lane; const f32x4* z1 = (const f32x4*)(C_Z + (size_t)R1c * DM) + c.lane;
#pragma unroll
            for (int j = 0; j < 8; ++j) { v0[j] = z0[64 * j]; v1[j] = z1[64 * j]; } }
#pragma unroll
        for (int j = 0; j < 8; ++j) { s0 += (v0[j].x + v0[j].y) + (v0[j].z + v0[j].w); s1 += (v1[j].x + v1[j].y) + (v1[j].z + v1[j].w); }
        const float m0 = wave_sum(s0) * (1.0f / DM), m1 = wave_sum(s1) * (1.0f / DM); float q0 = 0.f, q1 = 0.f;
#pragma unroll
        for (int j = 0; j < 8; ++j) { v0[j] = v0[j] - m0; v1[j] = v1[j] - m1; q0 += (v0[j].x * v0[j].x + v0[j].y * v0[j].y) + (v0[j].z * v0[j].z + v0[j].w * v0[j].w); q1 += (v1[j].x * v1[j].x + v1[j].y * v1[j].y) + (v1[j].z * v1[j].z + v1[j].w * v1[j].w); }
        const float r0 = rsqrtf(wave_sum(q0) * (1.0f / DM) + LN_EPS), r1 = rsqrtf(wave_sum(q1) * (1.0f / DM) + LN_EPS);
        float* d0 = (l == 3) ? (R0 < TP ? C_OUT + O_YP + (size_t)R0 * DM : C_OUT + O_YS + (size_t)(R0 - TP) * DM) : C_XZ + (size_t)R0 * DM;
        float* d1 = (l == 3) ? (R1c < TP ? C_OUT + O_YP + (size_t)R1c * DM : C_OUT + O_YS + (size_t)(R1c - TP) * DM) : C_XZ + (size_t)R1c * DM;
#pragma unroll
        for (int j = 0; j < 8; ++j) { const int col = 4 * c.lane + 256 * j;
            const f32x4 x0 = v0[j] * r0 * gg[j] + bb[j]; *(f32x4*)(d0 + col) = x0; if (l != 3) *(u32x2*)(C_XB + (size_t)R0 * DM + col) = (u32x2){pk2(x0.x, x0.y), pk2(x0.z, x0.w)};
            if (has1) { const f32x4 x1 = v1[j] * r1 * gg[j] + bb[j]; *(f32x4*)(d1 + col) = x1; if (l != 3) *(u32x2*)(C_XB + (size_t)R1 * DM + col) = (u32x2){pk2(x1.x, x1.y), pk2(x1.z, x1.w)}; } }
    }
}

#define XB_TMO      128
#define XB_XCNT(j)  (256  + 64 * (j))
#define XB_XSUB(j)  (1280 + 64 * (j))
#define XB_XGEN(j)  (2304 + 64 * (j))
#define XB_TOP      3328
#define XB_TOPGEN   3392
#define XCD_BAR_WORDS 3456
#define XB_SPIN_CAP (1u << 18)

__device__ __forceinline__ unsigned xb_ld(unsigned* p)              { return __hip_atomic_load(p, __ATOMIC_RELAXED, __HIP_MEMORY_SCOPE_AGENT); }
__device__ __forceinline__ unsigned xb_add(unsigned* p, unsigned v) { return __hip_atomic_fetch_add(p, v, __ATOMIC_RELAXED, __HIP_MEMORY_SCOPE_AGENT); }
__device__ __forceinline__ unsigned xb_xcc_id() { return (unsigned)__builtin_amdgcn_s_getreg((3 << 11) | 20) & 0xFu; }
#define XB_SPIN(cond, bar) do { unsigned _sp = 0; while (cond) { __builtin_amdgcn_s_sleep(1); \
    if ((++_sp & 255u) == 0u) { if (xb_ld(&(bar)[XB_TMO])) break; if (_sp > XB_SPIN_CAP) { atomicAdd(&(bar)[XB_TMO], 1u); break; } } } } while (0)

struct XcdBarrier {
    unsigned* bar; unsigned x;
    volatile LAS unsigned* st;
};

__device__ __forceinline__ XcdBarrier xcd_barrier_post(unsigned* bar, volatile LAS unsigned* st) {
    XcdBarrier b; b.bar = bar; b.x = xb_xcc_id(); b.st = st;
    if (threadIdx.x == 0) (void)xb_add(&bar[XB_XCNT(b.x)], 1u);
    return b;
}
__device__ __forceinline__ void xcd_barrier_complete(unsigned* bar, unsigned x, unsigned& nloc, unsigned& nx) {
    const unsigned G = gridDim.x * gridDim.y * gridDim.z;
    unsigned sum, cnt, mine, sp = 0u;
    for (;;) {
        sum = 0u; cnt = 0u; mine = 0u;
#pragma unroll
        for (unsigned j = 0; j < 16; ++j) { const unsigned c = xb_ld(&bar[XB_XCNT(j)]); sum += c; cnt += (c > 0u) ? 1u : 0u; mine = (j == x) ? c : mine; }
        if (sum == G) break;
        __builtin_amdgcn_s_sleep(1);
        if ((++sp & 255u) == 0u) { if (xb_ld(&bar[XB_TMO])) break; if (sp > XB_SPIN_CAP) { atomicAdd(&bar[XB_TMO], 1u); break; } }
    }
    nloc = mine > 0u ? mine : 1u; nx = cnt > 0u ? cnt : 1u;
}

__device__ __forceinline__ void xcd_barrier(const XcdBarrier& b) {
    asm volatile("s_waitcnt vmcnt(0)" ::: "memory");
    __syncthreads();
    if (threadIdx.x == 0) {
        unsigned* bar = b.bar;
        __builtin_amdgcn_s_waitcnt(0);
        unsigned nloc = b.st[0], nx = b.st[1];
        if (nloc == 0u) { xcd_barrier_complete(bar, b.x, nloc, nx); b.st[0] = nloc; b.st[1] = nx; }
        const unsigned old = xb_add(&bar[XB_XSUB(b.x)], 1u);
        const unsigned gen = old / nloc;
        if (old + 1u == (gen + 1u) * nloc) {
            __builtin_amdgcn_fence(__ATOMIC_RELEASE, "agent");
            asm volatile("s_waitcnt vmcnt(0)" ::: "memory");
            const unsigned og = xb_add(&bar[XB_TOP], 1u);
            const unsigned tg = og / nx;
            if (og + 1u == (tg + 1u) * nx) xb_add(&bar[XB_TOPGEN], 1u);
            else XB_SPIN(xb_ld(&bar[XB_TOPGEN]) == tg, bar);
            __builtin_amdgcn_fence(__ATOMIC_ACQUIRE, "agent");
            xb_add(&bar[XB_XGEN(b.x)], 1u);
            asm volatile("s_waitcnt vmcnt(0)" ::: "memory");
        } else {
            XB_SPIN(xb_ld(&bar[XB_XGEN(b.x)]) == gen, bar);
            __builtin_amdgcn_fence(__ATOMIC_ACQUIRE, "agent");
            asm volatile("s_waitcnt vmcnt(0)" ::: "memory");
        }
    }
    __syncthreads();
}

constexpr int NPH = 25;
__global__ void __launch_bounds__(512, 2) mk(Args args) {
    extern __shared__ __attribute__((aligned(16))) unsigned char lds_raw[];
    Ctx c;
    c.ap = (ArgsP)__builtin_amdgcn_kernarg_segment_ptr(); c.lds = (LAS unsigned char*)lds_raw;
    c.tid = threadIdx.x; c.lane = c.tid & 63; c.wave = __builtin_amdgcn_readfirstlane(c.tid >> 6); c.bid = blockIdx.x; c.G = gridDim.x;
    for (int u = c.tid; u < 16; u += 512) ((LAS unsigned*)(c.lds + 131072))[u] = 0u;
    __syncthreads();
    XcdBarrier xbar = xcd_barrier_post((unsigned*)(c.ap->ws + WS_CTL) + 4096, (volatile LAS unsigned*)(c.lds + 131072));
#define LAUNDER() do { asm volatile("" : "+s"(c.ap), "+v"(c.tid), "+s"(c.bid), "+s"(c.G)); c.lane = c.tid & 63; c.wave = __builtin_amdgcn_readfirstlane(c.tid >> 6); } while (0)
    const int lo = args.ph_lo, hi = args.ph_hi;
#define IN(k) (lo <= (k) && (k) < hi)
#if USE_CG
#define SEAM(k) do { if (IN(k) && IN((k) + 1)) { cg::this_grid().sync(); } } while (0)
#else
#define SEAM(k) do { if (IN(k) && IN((k) + 1)) { asm volatile("" : "+s"(xbar.bar)); xcd_barrier(xbar); } } while (0)
#endif
    #if !(DIS & 1)
    if (IN(0)) { for (int rep = 0; rep < ((DUP & 128) ? 2 : 1); ++rep) { LAUNDER(); phase_prologue(c); if (DUP & 128) { asm volatile("" : "+s"(xbar.bar)); xcd_barrier(xbar); } } }
#endif
    SEAM(0);
#pragma unroll 1
    for (int l = 0; l < 4; ++l) {
        const int p0 = 1 + 6 * l; const bool even = (l & 1) == 0;
#if !(DIS & 2)
        if (IN(p0)) { for (int rep = 0; rep < ((DUP & 16) ? 2 : 1); ++rep) { LAUNDER();
            if (l == 0) { pg8::Gemm g{C_MEMB, C_WTMEM, 512, 4096, DM}; pg8::StaticOrder S; S.init(512, 4096, c.G, (c.bid + c.G - c.G / 2) % c.G);
                pg8::EpiF32Split E{C_OUT + O_MEM, 1024, 1024, (size_t)512 * 1024, C_MKVB};
                pg8::gemm_phase<pg8::EpiF32Split, pg8::StaticOrder, true, true>(c.lds, g, S, E); }
            const int ngemm = (l == 0) ? 5 : 1;
#pragma unroll 1
            for (int gi = 0; gi < ngemm; ++gi) {
                const int NI = even ? EVEN_INP : ODD_IN;
                const bf16* A = gi ? C_WTMEM + ((size_t)(gi - 1) * 1024 + 512) * DM : C_XB; const bf16* Bt = gi ? C_MEMB : C_WTIN;
                const int Mg = gi ? 512 : MPAD, Ng = gi ? 512 : NI;
                bf16* Og = gi ? C_VT + (size_t)(gi - 1) * 512 * 512 : C_HB; const int ldo = gi ? 512 : LDH;
                pg8::Gemm g{A, Bt, Mg, Ng, DM}; pg8::StaticOrder S; S.init(Mg, Ng, c.G, gi ? (c.bid + 2 * c.G - (5 * c.G) / 8 - 8 * (gi - 1)) % c.G : c.bid); pg8::EpiBf16NP E{Og, ldo, C_TAB, (gi == 0 && !even) ? 3072 : 0, 1536};
                pg8::gemm_phase<pg8::EpiBf16NP, pg8::StaticOrder, true, true>(c.lds, g, S, E);
            }
            if (DUP & 16) { asm volatile("" : "+s"(xbar.bar)); xcd_barrier(xbar); }
        } }
#endif
        SEAM(p0);
#if !(DIS & 4)
        if (IN(p0 + 1)) { for (int rep = 0; rep < ((DUP & 1) ? 2 : 1); ++rep) { LAUNDER(); if (even) phase_even_tok_pre(c, l); if (DUP & 1) { asm volatile("" : "+s"(xbar.bar)); xcd_barrier(xbar); } } }
#endif
#if !(DIS & 8)
        if (IN(p0 + 1)) { for (int rep = 0; rep < ((DUP & 2) ? 2 : 1); ++rep) { LAUNDER(); if (!even) phase_odd_tok(c, l); if (DUP & 2) { asm volatile("" : "+s"(xbar.bar)); xcd_barrier(xbar); } } }
#endif
        SEAM(p0 + 1);
#if !(DIS & 16)
        if (IN(p0 + 2)) { for (int rep = 0; rep < ((DUP & 4) ? 2 : 1); ++rep) { LAUNDER(); if (even) phase_even_scan(c, l); if (DUP & 4) { asm volatile("" : "+s"(xbar.bar)); xcd_barrier(xbar); } } }
#endif
        SEAM(p0 + 2);
#if !(DIS & 32)
        if (IN(p0 + 3)) { for (int rep = 0; rep < ((DUP & 8) ? 2 : 1); ++rep) { LAUNDER(); if (even) { phase_even_ubuild(c, l); LAUNDER(); even_combine_dil(c); } else phase_odd_ubuild(c); if (DUP & 8) { asm volatile("" : "+s"(xbar.bar)); xcd_barrier(xbar); } } }
#endif
        SEAM(p0 + 3);
#if !(DIS & 64)
        if (IN(p0 + 4)) { for (int rep = 0; rep < ((DUP & 32) ? 2 : 1); ++rep) { LAUNDER(); const int K = even ? EVEN_OUT : ODD_OUT;
            pg8::Gemm g{C_U, C_WTOUT_L(l), TP, DM, K}; pg8::StaticOrder S; S.init(TP, DM, c.G, c.bid); pg8::EpiResid E{C_XZ, C_Z, DM, ALPHA};
            pg8::gemm_phase<pg8::EpiResid, pg8::StaticOrder, true, true>(c.lds, g, S, E);
            LAUNDER(); if (c.bid < 64) small_outproj(c, c.bid, K, l); if (DUP & 32) { asm volatile("" : "+s"(xbar.bar)); xcd_barrier(xbar); } } }
#endif
        SEAM(p0 + 4);
#if !(DIS & 128)
        if (IN(p0 + 5)) { for (int rep = 0; rep < ((DUP & 64) ? 2 : 1); ++rep) { LAUNDER(); phase_ln(c, l); if (DUP & 64) { asm volatile("" : "+s"(xbar.bar)); xcd_barrier(xbar); } } }
#endif
        SEAM(p0 + 5);
    }
#undef IN
#undef SEAM
}

extern "C" void kernel_launch(void* const* d_in, const int* in_sizes, int n_in, void* d_out, int out_size, void* d_ws, size_t ws_size, hipStream_t stream) {
    static int grid = 0;
    if (grid == 0) {
        if (n_in != 27 || (size_t)out_size != O_END || ws_size < WS_END) { fprintf(stderr, "kernel_launch: unexpected shapes: n_in %d out %d ws %zu (need %zu)\n", n_in, out_size, ws_size, (size_t)WS_END); grid = -1; return; }
        int dev = 0, cus = 0, per_cu = 0;
        hipGetDevice(&dev); hipDeviceGetAttribute(&cus, hipDeviceAttributeMultiprocessorCount, dev);
        if (hipFuncSetAttribute((const void*)mk, hipFuncAttributeMaxDynamicSharedMemorySize, LDS_BYTES) != hipSuccess) { fprintf(stderr, "kernel_launch: hipFuncSetAttribute failed\n"); grid = -1; return; }
        if (hipOccupancyMaxActiveBlocksPerMultiprocessor(&per_cu, (const void*)mk, 512, LDS_BYTES) != hipSuccess || per_cu < 1) { fprintf(stderr, "kernel_launch: occupancy query says %d\n", per_cu); per_cu = 1; }
        (void)hipGetLastError();
        grid = cus;
        fprintf(stderr, "kernel_launch: grid %d (cus %d, per_cu %d)\n", grid, cus, per_cu);
    }
    if (grid < 0) return;
    if (hipMemsetAsync((char*)d_ws + WS_CTL, 0, 1u << 20, stream) != hipSuccess) { fprintf(stderr, "kernel_launch: memset failed\n"); return; }
    Args a{};
    for (int i = 0; i < 27; ++i) a.in[i] = (const float*)d_in[i];
    a.out = (float*)d_out; a.ws = (unsigned char*)d_ws;
#if ONE_LAUNCH
    a.ph_lo = 0; a.ph_hi = NPH;
    void* kargs[] = {&a};
    hipError_t e = hipLaunchCooperativeKernel((const void*)mk, dim3(grid), dim3(512), kargs, LDS_BYTES, stream);
    if (e != hipSuccess) fprintf(stderr, "kernel_launch: cooperative launch failed: %s\n", hipGetErrorString(e));
#else
    for (int p = 0; p < NPH; ++p) {
        if (p >= 1 && ((p - 1) % 6) == 2 && (((p - 1) / 6) & 1)) continue;
        a.ph_lo = p; a.ph_hi = p + 1;
        hipLaunchKernelGGL(mk, dim3(grid), dim3(512), LDS_BYTES, stream, a);
    }
#endif
}
```

```cpp
#include <hip/hip_runtime.h>
#include <hip/hip_cooperative_groups.h>
#include <cstdio>
#include <cstdint>
namespace cg = cooperative_groups;
#ifndef DIS
#define DIS 0
#endif
#ifndef REPD
#define REPD 1
#endif
#ifndef REPM
#define REPM 1
#endif
#ifndef REPC
#define REPC 1
#endif
#ifndef REPS
#define REPS 1
#endif
#ifndef REP9
#define REP9 1
#endif
#ifndef REP3
#define REP3 1
#endif
#ifndef REP8
#define REP8 1
#endif
#ifndef REP1
#define REP1 1
#endif
#ifndef DUP
#define DUP 0
#endif
#ifndef USE_CG
#define USE_CG 0
#endif
#ifndef ONE_LAUNCH
#define ONE_LAUNCH 1
#endif
namespace pg8 {
#define PG8_LAS __attribute__((address_space(3)))
typedef unsigned short bf16_t;
typedef short bf16x8 __attribute__((ext_vector_type(8)));
typedef float f32x4 __attribute__((ext_vector_type(4)));
typedef unsigned u32x4 __attribute__((ext_vector_type(4)));
constexpr int BM = 256, BK = 64, HALF = 128, HTB = HALF * BK * 2  , STAGE_BYTES = 8 * HTB, NXCD = 8, WGM = 8;

__host__ __device__ __forceinline__ int lds_byte(int r, int c) { const int st = (r >> 4) * 2 + (c >> 5), rr = r & 15, cc = c & 31, ob = rr * 64 + cc * 2; return st * 1024 + (ob ^ (((ob >> 9) & 1) << 5)); }
__host__ __device__ __forceinline__ void stage_rc(int b, int& R, int& C) { const int st = b / 1024, sb = b % 1024, swz = sb ^ (((sb >> 9) & 1) << 5); R = (st >> 1) * 16 + swz / 64; C = (st & 1) * 32 + (swz % 64) / 2; }
__host__ __device__ __forceinline__ int perm32(int rho) { const int n = rho >> 4, i = rho & 15; return 8 * (i >> 2) + 4 * n + (i & 3); }

struct Unit { int pm, pn; };
struct Gemm { const bf16_t* A; const bf16_t* Bt; int M, N, K; };

struct StaticOrder {
    int nM, nN, nwg, G, c;
    __host__ __device__ void init(int M, int N, int G_, int c_) { nM = M / BM; nN = N / BM; nwg = nM * nN; G = G_; c = c_; }
    __host__ __device__ bool next(int i, Unit& u) const {
        const long L = (long)i * G + c; if (L >= nwg) return false;
        int wgid = (int)L; { const int q = nwg / NXCD, r = nwg % NXCD, xcd = wgid % NXCD, off = wgid / NXCD; wgid = (xcd < r ? xcd * (q + 1) : r * (q + 1) + (xcd - r) * q) + off; }
        const int nig = WGM * nN, gid = wgid / nig, fm = gid * WGM, gsz = (nM - fm) < WGM ? (nM - fm) : WGM;
        u.pm = fm + ((wgid % nig) % gsz); u.pn = (wgid % nig) / gsz; return true;
    }
    __device__ __forceinline__ void a_ready(const Unit&) const {}
    __device__ __forceinline__ void done(const Unit&) const {}
};

__device__ __forceinline__ unsigned cvt_pk_bf16(float lo, float hi) { unsigned r; asm volatile("v_cvt_pk_bf16_f32 %0, %1, %2" : "=v"(r) : "v"(lo), "v"(hi)); return r; }
typedef float f32x2 __attribute__((ext_vector_type(2)));
__device__ __forceinline__ f32x2 gelu_pk(f32x2 v) {
    const f32x2 av = __builtin_elementwise_abs(v), d = av * 0.2316418882f + 1.0f;
    f32x2 t; t.x = __builtin_amdgcn_rcpf(d.x); t.y = __builtin_amdgcn_rcpf(d.y);
    f32x2 q = t * 0.5307027145f + (-0.7265760135f); q = q * t + 0.7107068705f; q = q * t + (-0.142248368f); q = q * t + 0.127414796f; q = q * t;
    const f32x2 s = (v * v) * (-0.72134752044f);
    f32x2 e; e.x = __builtin_amdgcn_exp2f(s.x); e.y = __builtin_amdgcn_exp2f(s.y);
    const f32x2 m = v * (q * e), r = v - m;
    f32x2 o; o.x = v.x < 0.f ? m.x : r.x; o.y = v.y < 0.f ? m.y : r.y; return o;
}

template <int ACT  > struct EpiBf16 {
    static constexpr bool PERM = true, AFTER_DRAIN = false; static_assert(ACT == 0 || ACT == 1, "EpiBf16: ACT is 0 (none) or 1 (gelu_pk)");
    bf16_t* O; int ldc; const float* bias; int split_cols; size_t split_stride; float scale0;
    __device__ __forceinline__ void operator()(const f32x4 (&acc)[2][2][4][2], const Unit& u, int wr, int wc, int fr, int fq) const {
        const int row0 = u.pm * BM + wr * 64 + fr; int colt = u.pn * BM; bf16_t* base = O;
        float sc = 1.f; if (split_cols) { const int t = colt / split_cols; base += (size_t)t * split_stride; colt -= t * split_cols; if (t == 0) sc = scale0; }
        const int col0 = colt + wc * 32 + 8 * fq, bcol0 = u.pn * BM + wc * 32 + 8 * fq;
        f32x4 bv[2][2];
#pragma unroll
        for (int bj = 0; bj < 2; ++bj)
#pragma unroll
            for (int n = 0; n < 2; ++n) bv[bj][n] = bias ? *(const f32x4*)(bias + bcol0 + bj * HALF + 4 * n) : (f32x4){0.f, 0.f, 0.f, 0.f};
#pragma unroll
        for (int ai = 0; ai < 2; ++ai)
#pragma unroll
            for (int m = 0; m < 4; ++m) { bf16_t* rowp = base + (size_t)(row0 + ai * HALF + m * 16) * ldc + col0;
#pragma unroll
                for (int bj = 0; bj < 2; ++bj) { f32x4 v0 = acc[ai][bj][m][0] + bv[bj][0], v1 = acc[ai][bj][m][1] + bv[bj][1];
                    if (ACT == 1) { f32x2 a = gelu_pk((f32x2){v0[0], v0[1]}), b = gelu_pk((f32x2){v0[2], v0[3]}), c = gelu_pk((f32x2){v1[0], v1[1]}), d = gelu_pk((f32x2){v1[2], v1[3]});
                        v0 = (f32x4){a.x, a.y, b.x, b.y}; v1 = (f32x4){c.x, c.y, d.x, d.y}; }
                    v0 = v0 * sc; v1 = v1 * sc; u32x4 w; w.x = cvt_pk_bf16(v0[0], v0[1]); w.y = cvt_pk_bf16(v0[2], v0[3]); w.z = cvt_pk_bf16(v1[0], v1[1]); w.w = cvt_pk_bf16(v1[2], v1[3]);
                    *(u32x4*)(rowp + bj * HALF) = w; } }
    }
};
struct EpiF32Split {
    static constexpr bool PERM = false, AFTER_DRAIN = false;
    float* C; int ldc; int split_cols; size_t split_stride; bf16_t* MB;
    __device__ __forceinline__ void operator()(const f32x4 (&acc)[2][2][4][2], const Unit& u, int wr, int wc, int fr, int fq) const {
        typedef unsigned u32x2v __attribute__((ext_vector_type(2)));
        int colt = u.pn * BM; float* base = C; bf16_t* mb = MB;
        if (split_cols) { const int t = colt / split_cols; base += (size_t)t * split_stride; mb += (size_t)t * split_stride; colt -= t * split_cols; }
        const int row0 = u.pm * BM + wr * 64 + fr, col0 = colt + wc * 32 + 4 * fq;
#pragma unroll
        for (int ai = 0; ai < 2; ++ai)
#pragma unroll
            for (int m = 0; m < 4; ++m) { float* rowp = base + (size_t)(row0 + ai * HALF + m * 16) * ldc + col0; bf16_t* rowb = mb + (size_t)(row0 + ai * HALF + m * 16) * ldc + col0;
#pragma unroll
                for (int bj = 0; bj < 2; ++bj)
#pragma unroll
                    for (int n = 0; n < 2; ++n) { const f32x4 v = acc[ai][bj][m][n]; *(f32x4*)(rowp + bj * HALF + n * 16) = v;
                        u32x2v w; w.x = cvt_pk_bf16(v[0], v[1]); w.y = cvt_pk_bf16(v[2], v[3]); *(u32x2v*)(rowb + bj * HALF + n * 16) = w; } }
    }
};
struct EpiBf16NP {
    static constexpr bool PERM = false, AFTER_DRAIN = false;
    bf16_t* O; int ldc; const float* TAB; int rot_cols, kcol0;
    __device__ __forceinline__ void operator()(const f32x4 (&acc)[2][2][4][2], const Unit& u, int wr, int wc, int fr, int fq) const {
        typedef unsigned u32x2v __attribute__((ext_vector_type(2)));
        const int row0 = u.pm * BM + wr * 64 + fr, col0 = u.pn * BM + wc * 32 + 4 * fq;
        const bool rot = u.pn * BM < rot_cols; const float scl = (u.pn * BM >= kcol0) ? 0.0625f : 1.0f;
#pragma unroll
        for (int ai = 0; ai < 2; ++ai)
#pragma unroll
            for (int m = 0; m < 4; ++m) { const int row = row0 + ai * HALF + m * 16; bf16_t* rowp = O + (size_t)row * ldc + col0;
                const int p = row < 8192 ? (row & 4095) : (row < 8224 ? 4096 + ((row - 8192) & 3) : 0);
                const float* tb = TAB + ((size_t)p * 128 + ((col0 & 255) >> 1)) * 2;
#pragma unroll
                for (int bj = 0; bj < 2; ++bj)
#pragma unroll
                    for (int n = 0; n < 2; ++n) { f32x4 v = acc[ai][bj][m][n];
                        if (rot) { const f32x4 cs = *(const f32x4*)(tb + bj * HALF + n * 16);
                            v = (f32x4){(v[0] * cs[0] - v[1] * cs[1]) * scl, (v[1] * cs[0] + v[0] * cs[1]) * scl, (v[2] * cs[2] - v[3] * cs[3]) * scl, (v[3] * cs[2] + v[2] * cs[3]) * scl}; }
                        u32x2v w; w.x = cvt_pk_bf16(v[0], v[1]); w.y = cvt_pk_bf16(v[2], v[3]); *(u32x2v*)(rowp + bj * HALF + n * 16) = w; } }
    }
};
struct EpiResid {
    static constexpr bool PERM = false, AFTER_DRAIN = false;
    const float* __restrict__ X; float* __restrict__ Z; int ldc; float alpha;
    __device__ __forceinline__ void operator()(const f32x4 (&acc)[2][2][4][2], const Unit& u, int wr, int wc, int fr, int fq) const {
        const int row0 = u.pm * BM + wr * 64 + fr, col0 = u.pn * BM + wc * 32 + 4 * fq;
#pragma unroll
        for (int ai = 0; ai < 2; ++ai)
#pragma unroll
            for (int mp = 0; mp < 2; ++mp) { f32x4 xv[2][2][2];
#pragma unroll
                for (int mm = 0; mm < 2; ++mm) { const float* rowp = X + (size_t)(row0 + ai * HALF + (2 * mp + mm) * 16) * ldc + col0;
#pragma unroll
                    for (int bj = 0; bj < 2; ++bj)
#pragma unroll
                        for (int n = 0; n < 2; ++n) xv[mm][bj][n] = *(const f32x4*)(rowp + bj * HALF + n * 16); }
#pragma unroll
                for (int mm = 0; mm < 2; ++mm) { float* rowz = Z + (size_t)(row0 + ai * HALF + (2 * mp + mm) * 16) * ldc + col0;
#pragma unroll
                    for (int bj = 0; bj < 2; ++bj)
#pragma unroll
                        for (int n = 0; n < 2; ++n) *(f32x4*)(rowz + bj * HALF + n * 16) = xv[mm][bj][n] * alpha + acc[ai][bj][2 * mp + mm][n]; } }
    }
};
template <class Epi, class Sched, bool ALIGN_EPI = false, bool SP2 = false>
__device__ __forceinline__ void gemm_phase(PG8_LAS unsigned char* lds, const Gemm g, const Sched& S, const Epi& E) {
    int tid_ = threadIdx.x; asm volatile("" : "+v"(tid_));
    const int tid = tid_, wid = __builtin_amdgcn_readfirstlane(tid >> 6), lane = tid & 63, wr = wid >> 2, wc = wid & 3, fr = lane & 15, fq = lane >> 4;
    const int K = g.K, nt = K / BK;
    unsigned voffA[2], voffB[2];
#pragma unroll
    for (int i = 0; i < 2; ++i) { int R, C; stage_rc(tid * 16 + i * 8192, R, C); const int Rb = Epi::PERM ? ((R & ~31) + perm32(R & 31)) : R;
        voffA[i] = (unsigned)(R * K + C) * 2u; voffB[i] = (unsigned)(Rb * K + C) * 2u; }
    const size_t kstep = (size_t)(BK * 2);
    const size_t hstep = (size_t)HALF * K * 2;
    const size_t tstep = 2 * hstep;
    const unsigned ldsw = (unsigned)wid * 1024u;
    const int aoff = lds_byte(wr * 64 + fr, fq * 8), boff = lds_byte(wc * 32 + fr, fq * 8);
#define PG8_SA(b, h) (((b) * 2 + (h)) * HTB)
#define PG8_SB(b, h) ((4 + (b) * 2 + (h)) * HTB)
#define PG8_STAGE(bufoff, gbase, voff) do { _Pragma("unroll") for (int _i = 0; _i < 2; ++_i) \
        __builtin_amdgcn_global_load_lds((const unsigned*)((const char*)(gbase) + (voff)[_i]), (PG8_LAS unsigned*)(lds + (bufoff) + ldsw + _i * 8192), 16, 0, 0); } while (0)
#define PG8_LDA(dst, b, h) do { _Pragma("unroll") for (int m = 0; m < 4; ++m) _Pragma("unroll") for (int k = 0; k < 2; ++k) dst[m][k] = *(const PG8_LAS bf16x8*)(lds + PG8_SA(b, h) + aoff + m * 2048 + k * 1024); } while (0)
#define PG8_LDB(dst, b, h) do { _Pragma("unroll") for (int n = 0; n < 2; ++n) _Pragma("unroll") for (int k = 0; k < 2; ++k) dst[n][k] = *(const PG8_LAS bf16x8*)(lds + PG8_SB(b, h) + boff + n * 2048 + k * 1024); } while (0)
#define PG8_MMA(ai, bj, At, Bt) do { __builtin_amdgcn_s_setprio(1); _Pragma("unroll") for (int m = 0; m < 4; ++m) _Pragma("unroll") for (int n = 0; n < 2; ++n) _Pragma("unroll") for (int k = 0; k < 2; ++k) \
        acc[ai][bj][m][n] = __builtin_amdgcn_mfma_f32_16x16x32_bf16(Bt[n][k], At[m][k], acc[ai][bj][m][n], 0, 0, 0); __builtin_amdgcn_s_setprio(0); } while (0)
#define PG8_WAIT_V(n) asm volatile("s_waitcnt vmcnt(" #n ")" ::: "memory")
#define PG8_WAIT_L(n) asm volatile("s_waitcnt lgkmcnt(" #n ")" ::: "memory")
#define PG8_BAR __builtin_amdgcn_s_barrier()
#define PG8_SCHED __builtin_amdgcn_sched_barrier(0)
    Unit cur, nxt; int ui = 0;
    if (!S.next(0, cur)) return;
    f32x4 acc[2][2][4][2];
#pragma unroll
    for (int a = 0; a < 2; ++a)
#pragma unroll
        for (int b = 0; b < 2; ++b)
#pragma unroll
            for (int m = 0; m < 4; ++m)
#pragma unroll
                for (int n = 0; n < 2; ++n) acc[a][b][m][n] = (f32x4){0.f, 0.f, 0.f, 0.f};
    bf16x8 At[4][2], B0[2][2], B1[2][2];
    const char* cA = (const char*)g.A + (size_t)cur.pm * tstep; const char* cB = (const char*)g.Bt + (size_t)cur.pn * tstep;
    S.a_ready(cur);
    if constexpr (SP2) {
        PG8_STAGE(PG8_SB(0, 0), cB, voffB); PG8_STAGE(PG8_SB(0, 1), cB + hstep, voffB); PG8_STAGE(PG8_SA(0, 0), cA, voffA); PG8_STAGE(PG8_SA(0, 1), cA + hstep, voffA);
        if (wr == 1) PG8_BAR;
        PG8_WAIT_V(2); PG8_BAR;
        PG8_STAGE(PG8_SB(1, 0), cB + kstep, voffB); PG8_STAGE(PG8_SA(1, 0), cA + kstep, voffA); PG8_STAGE(PG8_SB(1, 1), cB + hstep + kstep, voffB);
        PG8_WAIT_V(6); PG8_BAR;
    } else {
        PG8_STAGE(PG8_SB(0, 0), cB, voffB); PG8_STAGE(PG8_SA(0, 0), cA, voffA); PG8_STAGE(PG8_SB(0, 1), cB + hstep, voffB); PG8_STAGE(PG8_SA(0, 1), cA + hstep, voffA);
        if (wr == 1) PG8_BAR;
        PG8_WAIT_V(4); PG8_BAR;
        PG8_STAGE(PG8_SB(1, 0), cB + kstep, voffB); PG8_STAGE(PG8_SA(1, 0), cA + kstep, voffA); PG8_STAGE(PG8_SB(1, 1), cB + hstep + kstep, voffB);
        PG8_WAIT_V(6); PG8_BAR;
    }
    for (;;) {
        const bool has_next = S.next(ui + 1, nxt);
        const char* nA = has_next ? (const char*)g.A + (size_t)nxt.pm * tstep : cA; const char* nB = has_next ? (const char*)g.Bt + (size_t)nxt.pn * tstep : cB;
        for (int t = 0; t < nt; t += 2) {
            const bool last = (t == nt - 2);
            const char* a1 = cA + (size_t)(t + 1) * kstep;
            const char* a2 = last ? nA : cA + (size_t)(t + 2) * kstep; const char* b2 = last ? nB : cB + (size_t)(t + 2) * kstep;
            const char* a3 = a2 + kstep; const char* b3 = b2 + kstep;
            if (last && has_next) S.a_ready(nxt);
            if constexpr (SP2) {
            PG8_LDB(B0, 0, 0); PG8_LDB(B1, 0, 1); PG8_SCHED; PG8_LDA(At, 0, 0); PG8_STAGE(PG8_SA(1, 1), a1 + hstep, voffA);
            PG8_WAIT_V(8); PG8_WAIT_L(0); PG8_BAR; PG8_MMA(0, 0, At, B0); PG8_MMA(0, 1, At, B1); PG8_BAR; PG8_SCHED;
            PG8_LDA(At, 0, 1); PG8_STAGE(PG8_SB(0, 0), b2, voffB); PG8_STAGE(PG8_SB(0, 1), b2 + hstep, voffB); PG8_STAGE(PG8_SA(0, 0), a2, voffA);
            PG8_WAIT_V(8); PG8_WAIT_L(0); PG8_BAR; PG8_MMA(1, 0, At, B0); PG8_MMA(1, 1, At, B1); PG8_BAR; PG8_SCHED;
            PG8_LDB(B0, 1, 0); PG8_LDB(B1, 1, 1); PG8_SCHED; PG8_LDA(At, 1, 0); PG8_STAGE(PG8_SA(0, 1), a2 + hstep, voffA);
            PG8_WAIT_V(8); PG8_WAIT_L(0); PG8_BAR; PG8_MMA(0, 0, At, B0); PG8_MMA(0, 1, At, B1); PG8_BAR; PG8_SCHED;
            PG8_LDA(At, 1, 1); PG8_STAGE(PG8_SB(1, 0), b3, voffB); PG8_STAGE(PG8_SB(1, 1), b3 + hstep, voffB); PG8_STAGE(PG8_SA(1, 0), a3, voffA);
            PG8_WAIT_V(8); PG8_WAIT_L(0); PG8_BAR; PG8_MMA(1, 0, At, B0); PG8_MMA(1, 1, At, B1); PG8_BAR; PG8_SCHED;
            } else {
            PG8_LDB(B0, 0, 0); PG8_SCHED; PG8_LDA(At, 0, 0); PG8_STAGE(PG8_SA(1, 1), a1 + hstep, voffA);
            PG8_WAIT_L(8); PG8_BAR; PG8_WAIT_L(0); PG8_MMA(0, 0, At, B0); PG8_BAR; PG8_SCHED;
            PG8_LDB(B1, 0, 1); PG8_STAGE(PG8_SB(0, 0), b2, voffB);
            PG8_BAR; PG8_WAIT_L(0); PG8_MMA(0, 1, At, B1); PG8_BAR;
            PG8_LDA(At, 0, 1); PG8_STAGE(PG8_SA(0, 0), a2, voffA);
            PG8_BAR; PG8_WAIT_L(0); PG8_MMA(1, 0, At, B0); PG8_BAR; PG8_SCHED;
            PG8_STAGE(PG8_SB(0, 1), b2 + hstep, voffB);
            PG8_WAIT_V(6); PG8_BAR; PG8_MMA(1, 1, At, B1); PG8_BAR;
            PG8_LDB(B0, 1, 0); PG8_SCHED; PG8_LDA(At, 1, 0); PG8_STAGE(PG8_SA(0, 1), a2 + hstep, voffA);
            PG8_WAIT_L(8); PG8_BAR; PG8_WAIT_L(0); PG8_MMA(0, 0, At, B0); PG8_BAR; PG8_SCHED;
            PG8_LDB(B1, 1, 1); PG8_STAGE(PG8_SB(1, 0), b3, voffB);
            PG8_BAR; PG8_WAIT_L(0); PG8_MMA(0, 1, At, B1); PG8_BAR;
            PG8_LDA(At, 1, 1); PG8_STAGE(PG8_SA(1, 0), a3, voffA);
            PG8_BAR; PG8_WAIT_L(0); PG8_MMA(1, 0, At, B0); PG8_BAR; PG8_SCHED;
            PG8_STAGE(PG8_SB(1, 1), b3 + hstep, voffB);
            PG8_WAIT_V(6); PG8_BAR; PG8_MMA(1, 1, At, B1); PG8_BAR;
            }
        }
        if constexpr (ALIGN_EPI) { if (wr == 0) PG8_BAR; }
        if constexpr (!Epi::AFTER_DRAIN) { E(acc, cur, wr, wc, fr, fq); S.done(cur); }
        if (!has_next) break;
#pragma unroll
        for (int a = 0; a < 2; ++a)
#pragma unroll
            for (int b = 0; b < 2; ++b)
#pragma unroll
                for (int m = 0; m < 4; ++m)
#pragma unroll
                    for (int n = 0; n < 2; ++n) acc[a][b][m][n] = (f32x4){0.f, 0.f, 0.f, 0.f};
        cur = nxt; cA = nA; cB = nB; ++ui;
        if constexpr (ALIGN_EPI) { if (wr == 1) PG8_BAR; }
    }
    PG8_WAIT_V(0);
    if constexpr (!ALIGN_EPI) { if (wr == 0) PG8_BAR; }
    PG8_BAR;
    if constexpr (Epi::AFTER_DRAIN) { E.fused(acc, cur, wr, wc, fr, fq, lds, wid, lane); S.done(cur); }
#undef PG8_SA
#undef PG8_SB
#undef PG8_STAGE
#undef PG8_LDA
#undef PG8_LDB
#undef PG8_MMA
#undef PG8_WAIT_V
#undef PG8_WAIT_L
#undef PG8_BAR
#undef PG8_SCHED
}
}
constexpr int DM = 2048, SEQ = 4096, TP = 8192, TS = 32, TT = TP + TS, MPAD = 8448;
constexpr int EVEN_IN = 6784, EVEN_INP = 6912, ODD_IN = 7168, LDH = 7168;
constexpr int EVEN_OUT = 1536, ODD_OUT = 2048;
constexpr float ALPHA = 1.6817928305074292f;
constexpr float LN_EPS = 1e-5f;
constexpr int EC_R = 0, EC_K = 768, EC_V = 1536, EC_HW = 2304, EC_HA = 2368, EC_GA = 2432, EC_QB = 3200, EC_KB = 3968, EC_VB = 4736, EC_GB = 5504, EC_QM = 5760, EC_GM = 6272;
constexpr int OC_Q = 0, OC_K = 1536, OC_V = 3072, OC_G = 4608, OC_QM = 6144, OC_GM = 6656;
constexpr size_t O_YP = 0, O_YS = 16777216, O_RWKV_P = O_YS + 65536, O_RWKV_S = O_RWKV_P + 196608, O_SH_P = O_RWKV_S + 786432, O_SH_S = O_SH_P + 9728,
    O_G0P = O_SH_S + 38912, O_G0S = O_G0P + 262144, O_G1P = O_G0S + 32768, O_G1S = O_G1P + 1048576, O_G2P = O_G1S + 32768, O_G2S = O_G2P + 4194304,
    O_RET_P = O_G2S + 32768, O_RET_S = O_RET_P + 1572864, O_MEM = O_RET_S + 6291456, O_END = O_MEM + 2097152;
constexpr size_t MiB = 1u << 20;
constexpr size_t WS_CTL = 0, WS_WTIN = 1 * MiB, WS_WTOUT = 29 * MiB, WS_WTMEM = 37 * MiB, WS_MEMB = 53 * MiB, WS_TAB = 55 * MiB, WS_XB = 60 * MiB, WS_XZ = 93 * MiB,
    WS_HB = 159 * MiB, WS_U = 275 * MiB, WS_YA = 308 * MiB, WS_PREP = 333 * MiB, WS_OG = 478 * MiB, WS_LSE = 478 * MiB + 49 * MiB / 2, WS_MKVB = 503 * MiB, WS_VT = 507 * MiB, WS_WTOUT2 = 509 * MiB, WS_END = 517 * MiB;
constexpr int LDS_BYTES = 147456;

#define LAS __attribute__((address_space(3)))
typedef unsigned short bf16;
typedef float f32x4 __attribute__((ext_vector_type(4)));
typedef short bf16x8 __attribute__((ext_vector_type(8)));
typedef unsigned u32x4 __attribute__((ext_vector_type(4)));
typedef unsigned u32x2 __attribute__((ext_vector_type(2)));

__device__ const double ANG[128] = {
1.0, 0.9300449458481392, 0.8649836012976682, 0.8044736266284181, 0.7481966305138833, 0.6958564947100448, 0.6471778159406796, 0.6019044567806663, 0.5597981979123284, 0.5206374846632574, 0.48421626123015066, 0.45034288645458387, 0.41883912544574814, 0.3895392117442728, 0.362288975092429, 0.336945030221216, 0.31337402238589046, 0.29145192568009903, 0.2710633904364836, 0.2521011362799124, 0.23446538763970548, 0.21806334875063282, 0.20280871538024622, 0.18862122071335174, 0.17542621300415914, 0.1631542627737973, 0.15174079748634942, 0.14112576178114528, 0.13125330147352265, 0.12207146966133185, 0.11353195339077617, 0.10558981944335787, 0.09820327790631257, 0.09133346228248625, 0.08494422498263796, 0.07900194712408967, 0.07347536163492155, 0.06833538873292307, 0.06355498291362295, 0.059108990642279875, 0.05497401800103736, 0.05112830759482943, 0.04755162406834012, 0.04422514763163046, 0.04113137503418572, 0.03825402746632876, 0.03557796490339495, 0.03308910644196496, 0.030774356208980617, 0.02862153445389273, 0.026619313461261302, 0.024757157946593413, 0.023025269621793302, 0.02141453563853956, 0.019916480638308563, 0.018523222156741202, 0.017227429147699425, 0.01602228340877477, 0.014901443705277463, 0.013859012403933875, 0.01288950444072537, 0.01198781845958378, 0.011149209970080915, 0.01036926638287344, 0.009643883791544459, 0.008969245378672715, 0.008341801332506338, 0.007758250168566794, 0.007215521357901014, 0.006710759170575141, 0.006241307649397462, 0.00580469663480544, 0.005398628767382501, 0.005020967399614466, 0.004669725353279709, 0.0043430544633167095, 0.0040392358531509045, 0.003756670890311596, 0.0034938727747491297, 0.0032494587155918425, 0.0030221426551783792, 0.002810728502080728, 0.002614103837511492, 0.002431234061999789, 0.002261156951536743, 0.002102977594546134, 0.0019558636830395095, 0.0018190411331788228, 0.0016917900122028363, 0.0015734407502856099, 0.0014633706173946357, 0.0013610004466105522, 0.001265791586667203, 0.001177243067676929, 0.001094888965127687, 0.0010182959482819048, 0.0009470610000772239, 0.0008808092965317064, 0.0008191922344953685, 0.0007618855973704613, 0.0007085878491488872, 0.0006590185477903263, 0.0006129168695925734, 0.0005700402367896359, 0.0005301630411562774, 0.000493075456902875, 0.00045858233661428085, 0.00042650218442334204, 0.0003966662010161199, 0.00036891739544382435, 0.0003431097590679882, 0.0003191074972923552, 0.00029678431503900375, 0.0002760227522090274, 0.00025671356563109924, 0.00023875515424585844, 0.00022205302450155334, 0.00020651929314796272, 0.00019207222481239299, 0.0001786358019245737, 0.00016613932472747905, 0.0001545170392694147, 0.0001437077914199376, 0.00013365470508911156, 0.00012430488295695166, 0.00011560912813835741, 0.00010752168531898921, 0.0001};
__device__ const float LG2G[6] = {-0.04580368961312479f, -0.02272007650008353f, -0.011315313227834146f, -0.005646563141142063f, -0.0028205190623786626f, -0.0014095702546713536f};

__device__ __forceinline__ float bf2f(unsigned b) { return __uint_as_float(b << 16); }
typedef __bf16 bf16x2_t __attribute__((ext_vector_type(2)));
typedef float f32x2_t __attribute__((ext_vector_type(2)));
__device__ __forceinline__ unsigned f2bf(float f) { return (unsigned)__builtin_bit_cast(unsigned short, (__bf16)f); }
__device__ __forceinline__ unsigned pk2(float lo, float hi) { const f32x2_t v = {lo, hi}; return __builtin_bit_cast(unsigned, __builtin_convertvector(v, bf16x2_t)); }
__device__ __forceinline__ void unpk4(u32x2 w, float (&x)[4]) { x[0] = __uint_as_float(w.x << 16); x[1] = __uint_as_float(w.x & 0xffff0000u); x[2] = __uint_as_float(w.y << 16); x[3] = __uint_as_float(w.y & 0xffff0000u); }
__device__ __forceinline__ void unpk8(u32x4 w, float (&x)[8]) {
    x[0] = __uint_as_float(w.x << 16); x[1] = __uint_as_float(w.x & 0xffff0000u); x[2] = __uint_as_float(w.y << 16); x[3] = __uint_as_float(w.y & 0xffff0000u);
    x[4] = __uint_as_float(w.z << 16); x[5] = __uint_as_float(w.z & 0xffff0000u); x[6] = __uint_as_float(w.w << 16); x[7] = __uint_as_float(w.w & 0xffff0000u); }
template <int CTRL> __device__ __forceinline__ float dppf(float x) { return __builtin_bit_cast(float, __builtin_amdgcn_update_dpp(0, __builtin_bit_cast(int, x), CTRL, 0xF, 0xF, true)); }
__device__ __forceinline__ float red16(float x) { x += dppf<0xB1>(x); x += dppf<0x4E>(x); x += dppf<0x141>(x); x += dppf<0x140>(x); return x; }
__device__ __forceinline__ float wave_sum(float x) { x = red16(x); x += __shfl_xor(x, 16); x += __shfl_xor(x, 32); return x; }
__device__ __forceinline__ float sigmoidf_(float x) { return 1.0f / (1.0f + __expf(-x)); }
__device__ __forceinline__ float siluf_(float x) { return x / (1.0f + __expf(-x)); }
#define LDS_WAIT() asm volatile("s_waitcnt lgkmcnt(0)" ::: "memory")

struct Args { const float* in[27]; float* out; unsigned char* ws; int ph_lo, ph_hi; };
typedef const __attribute__((address_space(4))) Args* ArgsP;
struct Ctx {
    ArgsP ap;
    LAS unsigned char* lds;
    int tid, lane, wave, bid, G;
};
#define C_IN(k) (c.ap->in[k])
#define C_OUT (c.ap->out)
#define C_WTIN ((bf16*)(c.ap->ws + WS_WTIN))
#define C_WTOUT_L(l_) ((bf16*)(c.ap->ws + (((l_) & 1) ? WS_WTOUT2 : WS_WTOUT)))
#define C_WTMEM ((bf16*)(c.ap->ws + WS_WTMEM))
#define C_MEMB ((bf16*)(c.ap->ws + WS_MEMB))
#define C_XB ((bf16*)(c.ap->ws + WS_XB))
#define C_HB ((bf16*)(c.ap->ws + WS_HB))
#define C_U ((bf16*)(c.ap->ws + WS_U))
#define C_TAB ((float*)(c.ap->ws + WS_TAB))
#define C_XZ ((float*)(c.ap->ws + WS_XZ))
#define C_YA ((float*)(c.ap->ws + WS_YA))
#define C_PREP ((float*)(c.ap->ws + WS_PREP))
#define C_CHK ((unsigned char*)(c.ap->ws + WS_PREP))
#define C_PREPS ((float*)(c.ap->ws + WS_PREP + 120 * MiB))
#define C_BONUS ((float*)(c.ap->ws + WS_PREP + 125 * MiB))
#define C_WUT ((bf16*)(c.ap->ws + WS_PREP + 126 * MiB))
#define C_AUT ((bf16*)(c.ap->ws + WS_PREP + 126 * MiB) + 2 * 768 * 64)
constexpr int CHK_BYTES = 40960, CK_A = 0, CK_RQ = 9216, CK_GT = 13824, CK_YVT = 31232;
#define C_YR ((float*)(c.ap->ws + WS_PREP))
#define C_Z ((float*)(c.ap->ws + WS_HB))
#define C_OG ((float*)(c.ap->ws + WS_OG))
#define C_LSE ((float*)(c.ap->ws + WS_LSE))
#define C_MKVB ((bf16*)(c.ap->ws + WS_MKVB))
#define C_VT ((bf16*)(c.ap->ws + WS_VT))

__device__ __forceinline__ void transpose_item(const float* W, int K, int N, bf16* WT, int row_off, LAS float* scr, int item, int lane) {
    const int nblk = N / 32, kb = item / nblk, nb = item % nblk, k0 = 64 * kb, n0 = 32 * nb;
    f32x4 wv[8];
#pragma unroll
    for (int i = 0; i < 8; ++i) { const int kk = 8 * i + (lane >> 3), c4 = 4 * (lane & 7); wv[i] = *(const f32x4*)(W + (size_t)(k0 + kk) * N + n0 + c4); }
#pragma unroll
    for (int i = 0; i < 8; ++i) { const int kk = 8 * i + (lane >> 3), c4 = 4 * (lane & 7); const f32x4 w4 = wv[i];
        scr[kk * 33 + c4] = w4.x; scr[kk * 33 + c4 + 1] = w4.y; scr[kk * 33 + c4 + 2] = w4.z; scr[kk * 33 + c4 + 3] = w4.w; }
    LDS_WAIT(); asm volatile("" ::: "memory");
    const int c = lane & 7;
#pragma unroll
    for (int j = 0; j < 4; ++j) { const int n = (lane >> 3) + 8 * j; const LAS float* s = scr + (8 * c) * 33 + n;
        u32x4 o; o.x = pk2(s[0 * 33], s[1 * 33]); o.y = pk2(s[2 * 33], s[3 * 33]); o.z = pk2(s[4 * 33], s[5 * 33]); o.w = pk2(s[6 * 33], s[7 * 33]);
        *(u32x4*)(WT + (size_t)(row_off + n0 + n) * K + k0 + 8 * c) = o; }
    LDS_WAIT(); asm volatile("" ::: "memory");
}
__device__ __forceinline__ void transpose_matrix(const Ctx& c, const float* W, int K, int N, bf16* WT, int row_off) {
    LAS float* scr = (LAS float*)(c.lds + c.wave * 16384);
    const int gw = c.bid * 8 + c.wave, NGW = c.G * 8, nitems = (K / 64) * (N / 32);
    for (int it = gw; it < nitems; it += NGW) transpose_item(W, K, N, WT, row_off, scr, it, c.lane);
}
__device__ __forceinline__ void convert_layer_weights(const Ctx& c, int l) {
    if ((l & 1) == 0) { const int e = l >> 1;
        transpose_matrix(c, C_IN(10) + (size_t)e * DM * EVEN_IN, DM, EVEN_IN, C_WTIN, 0);
        transpose_matrix(c, C_IN(11) + (size_t)e * EVEN_OUT * DM, EVEN_OUT, DM, C_WTOUT_L(l), 0);
        const int n16 = (EVEN_INP - EVEN_IN) * DM * 2 / 16; u32x4* p = (u32x4*)(C_WTIN + (size_t)EVEN_IN * DM);
        for (int i = c.bid * 512 + c.tid; i < n16; i += c.G * 512) p[i] = (u32x4){0u, 0u, 0u, 0u};
    } else { const int o = l >> 1;
        transpose_matrix(c, C_IN(12) + (size_t)o * DM * ODD_IN, DM, ODD_IN, C_WTIN, 0);
        transpose_matrix(c, C_IN(13) + (size_t)o * ODD_OUT * DM, ODD_OUT, DM, C_WTOUT_L(l), 0);
    }
}

__device__ __forceinline__ void phase_prologue(const Ctx& c) {
    for (int l = 0; l < 4; ++l) transpose_matrix(c, C_IN(14) + (size_t)l * DM * 1024, DM, 1024, C_WTMEM, l * 1024);
    convert_layer_weights(c, 0);
    const int gt = c.bid * 512 + c.tid, NT = c.G * 512;
    for (int i = gt; i < 2 * 768 * 64; i += NT) { const int e = i / (768 * 64), rem = i % (768 * 64), col = rem >> 6, k = rem & 63;
        C_WUT[i] = (bf16)f2bf(C_IN(19)[((size_t)e * 64 + k) * 768 + col]); C_AUT[i] = (bf16)f2bf(C_IN(21)[((size_t)e * 64 + k) * 768 + col]); }
    for (int i = gt; i < 512 * DM / 4; i += NT) { const f32x4 v = ((const f32x4*)C_IN(9))[i]; ((u32x2*)C_MEMB)[i] = (u32x2){pk2(v.x, v.y), pk2(v.z, v.w)}; }
    for (int i = gt; i < MPAD * DM / 4; i += NT) {
        const int row = i / (DM / 4);
        f32x4 v = (f32x4){0.f, 0.f, 0.f, 0.f};
        if (row < TP) v = ((const f32x4*)C_IN(0))[i]; else if (row < TT) v = ((const f32x4*)C_IN(1))[i - TP * (DM / 4)];
        ((f32x4*)C_XZ)[i] = v; ((u32x2*)C_XB)[i] = (u32x2){pk2(v.x, v.y), pk2(v.z, v.w)};
    }
    for (int i = gt; i < 4100 * 128; i += NT) {
        const int p = i >> 7, ci = i & 127; const double pos = (double)(p < 4096 ? p : 16384 + (p - 4096));
        double ph = pos * ANG[ci];
        const double k = __builtin_rint(ph * 0.15915494309189535); ph = __builtin_fma(-k, 6.283185307179586, ph); ph = __builtin_fma(-k, 2.4492935982947064e-16, ph);
        const double q = __builtin_rint(ph * 0.6366197723675814); const double y = __builtin_fma(-q, 1.5707963267948966, ph) - q * 6.123233995736766e-17;
        const double y2 = y * y;
        const double sn = y * (1.0 + y2 * (-1.0 / 6 + y2 * (1.0 / 120 + y2 * (-1.0 / 5040 + y2 * (1.0 / 362880 + y2 * (-1.0 / 39916800 + y2 * (1.0 / 6227020800.0)))))));
        const double cs = 1.0 + y2 * (-0.5 + y2 * (1.0 / 24 + y2 * (-1.0 / 720 + y2 * (1.0 / 40320 + y2 * (-1.0 / 3628800 + y2 * (1.0 / 479001600.0 + y2 * (-1.0 / 87178291200.0)))))));
        const int qi = ((int)q) & 3; double co, si;
        if (qi == 0) { co = cs; si = sn; } else if (qi == 1) { co = -sn; si = cs; } else if (qi == 2) { co = -cs; si = -sn; } else { co = sn; si = -cs; }
        C_TAB[2 * i] = (float)co; C_TAB[2 * i + 1] = (float)si;
    }
}

__device__ __forceinline__ void rwkv_prep_item(const Ctx& c, int it, int e) {
    LAS float* lw = (LAS float*)c.lds;
    LAS float* la = lw + 16 * 64;
    const float* mu = C_IN(17) + e * 2432; const float* shift = C_IN(3) + (size_t)e * 8 * 2432;
    const int R0 = it * 16;
    for (int i = c.tid; i < 16 * 128; i += 512) {
        const int tk = i >> 7, cc = i & 127, R = R0 + tk; float val = 0.f;
        if (R < TT) { const int col = EC_HW + cc; const float hcur = bf2f(C_HB[(size_t)R * LDH + col]);
            float hprev;
            if (R < TP) hprev = ((R & (SEQ - 1)) == 0) ? 0.f : bf2f(C_HB[(size_t)(R - 1) * LDH + col]);
            else { const int n = (R - TP) >> 2, t = (R - TP) & 3; hprev = (t == 0) ? shift[n * 2432 + col] : bf2f(C_HB[(size_t)(R - 1) * LDH + col]); }
            const float hs = hcur + (hprev - hcur) * mu[col];
            val = (cc < 64) ? tanhf(hs) : hs; }
        if (cc < 64) lw[tk * 64 + cc] = val; else la[tk * 64 + (cc - 64)] = val;
    }
    __syncthreads();
    const int tl = c.tid & 255, tg = c.tid >> 8;
    const float* w_up = C_IN(19) + (size_t)e * 64 * 768; const float* a_up = C_IN(21) + (size_t)e * 64 * 768;
    const float* w0 = C_IN(18) + e * 768; const float* a0 = C_IN(20) + e * 768; const float* k_k = C_IN(22) + e * 768; const float* k_a = C_IN(23) + e * 768;
#pragma unroll 1
    for (int m = 0; m < 3; ++m) {
        const int col = tl + 256 * m, h = col >> 6, ci = col & 63;
        float xw[8], xa[8];
#pragma unroll
        for (int t = 0; t < 8; ++t) { xw[t] = 0.f; xa[t] = 0.f; }
#pragma unroll 4
        for (int kk = 0; kk < 64; ++kk) { const float wu = w_up[kk * 768 + col], au = a_up[kk * 768 + col];
#pragma unroll
            for (int t = 0; t < 8; ++t) { xw[t] += lw[(tg * 8 + t) * 64 + kk] * wu; xa[t] += la[(tg * 8 + t) * 64 + kk] * au; } }
        const float w0c = w0[col], a0c = a0[col], kkc = k_k[col], kac = k_a[col], mur = mu[EC_R + col], muk = mu[EC_K + col], muv = mu[EC_V + col];
#pragma unroll
        for (int t = 0; t < 8; ++t) {
            const int R = R0 + tg * 8 + t;
            if (R >= TT || R < TP) continue;
            const bf16* hc = C_HB + (size_t)R * LDH; float pr, pk, pv;
            const float cr = bf2f(hc[EC_R + col]), ck = bf2f(hc[EC_K + col]), cv = bf2f(hc[EC_V + col]);
            bool has_prev_row; int n = 0;
            if (R < TP) has_prev_row = (R & (SEQ - 1)) != 0; else { n = (R - TP) >> 2; has_prev_row = ((R - TP) & 3) != 0; }
            if (has_prev_row) { const bf16* hp = hc - LDH; pr = bf2f(hp[EC_R + col]); pk = bf2f(hp[EC_K + col]); pv = bf2f(hp[EC_V + col]); }
            else if (R < TP) { pr = 0.f; pk = 0.f; pv = 0.f; }
            else { const float* sp = shift + n * 2432; pr = sp[EC_R + col]; pk = sp[EC_K + col]; pv = sp[EC_V + col]; }
            const float r = cr + (pr - cr) * mur, k = ck + (pk - ck) * muk, v = cv + (pv - cv) * muv;
            const float decay = __expf(-0.6065306597126334f * sigmoidf_(w0c + xw[t]));
            const float a = sigmoidf_(a0c + xa[t]);
            float kk = k * kkc; const float ss = wave_sum(kk * kk); kk *= rsqrtf(fmaxf(ss, 1e-24f));
            const float k2 = k * (1.0f + (a - 1.0f) * kac);
            float* dst = C_PREPS + ((size_t)(R - TP) * 12 + h) * 384 + ci;
            dst[0] = r; dst[64] = decay; dst[128] = k2; dst[192] = v; dst[256] = -kk; dst[320] = kk * a;
        }
    }
    __syncthreads();
}

__device__ __forceinline__ void dil_attn_item(const Ctx& c, int R, int hh, int e) {
    const int lane = c.lane, kg = lane >> 4, dl = lane & 15;
    float m = -1e30f, l = 0.f, acc[4] = {0.f, 0.f, 0.f, 0.f};
    const bool is_p = R < TP; const int t = is_p ? (R & (SEQ - 1)) : ((R - TP) & 3); const int n = is_p ? 0 : ((R - TP) >> 2);
    const size_t rowbase = is_p ? (size_t)(R - t) : (size_t)(TP + n * 4);
#pragma unroll
    for (int g = 0; g < 3; ++g) {
        const int dil = (g == 0) ? 1 : (g == 1 ? 4 : 16), W = 128 * dil;
        float q[4]; { const u32x2 w = *(const u32x2*)(C_HB + (size_t)R * LDH + EC_QB + g * 256 + hh * 64 + 4 * dl); unpk4(w, q); }
#pragma unroll
        for (int i = 0; i < 4; ++i) q[i] *= 0.125f;
        const float* cache = ((g == 0) ? C_IN(4) : (g == 1 ? C_IN(5) : C_IN(6))) + ((size_t)(e * 8 + n) * W) * 512;
#pragma unroll 1
        for (int j0 = 0; j0 < 129; j0 += 4) {
            const int j = j0 + kg; bool valid = j < 129; float kf[4] = {0.f, 0.f, 0.f, 0.f}, vf[4] = {0.f, 0.f, 0.f, 0.f};
            if (is_p) { const int pos = t - dil * j; valid = valid && pos >= 0;
                if (valid) { const bf16* kp = C_HB + (rowbase + pos) * LDH + g * 256 + hh * 64 + 4 * dl; unpk4(*(const u32x2*)(kp + EC_KB), kf); unpk4(*(const u32x2*)(kp + EC_VB), vf); } }
            else if (valid) { const int idx = W + t - dil * j;
                if (idx >= W) { const bf16* kp = C_HB + (rowbase + (idx - W)) * LDH + g * 256 + hh * 64 + 4 * dl; unpk4(*(const u32x2*)(kp + EC_KB), kf); unpk4(*(const u32x2*)(kp + EC_VB), vf); }
                else { const float* kp = cache + (size_t)idx * 512 + hh * 64 + 4 * dl; const f32x4 k4 = *(const f32x4*)kp, v4 = *(const f32x4*)(kp + 256);
                    kf[0] = k4.x; kf[1] = k4.y; kf[2] = k4.z; kf[3] = k4.w; vf[0] = v4.x; vf[1] = v4.y; vf[2] = v4.z; vf[3] = v4.w; } }
            float s = q[0] * kf[0] + q[1] * kf[1] + q[2] * kf[2] + q[3] * kf[3];
            s = red16(s);
            if (valid) { const float mn = fmaxf(m, s), sc = __expf(m - mn), p = __expf(s - mn);
                l = l * sc + p;
#pragma unroll
                for (int i = 0; i < 4; ++i) acc[i] = acc[i] * sc + p * vf[i];
                m = mn; }
        }
    }
#pragma unroll
    for (int off = 16; off <= 32; off <<= 1) {
        const float m2 = __shfl_xor(m, off), l2 = __shfl_xor(l, off); float a2[4];
#pragma unroll
        for (int i = 0; i < 4; ++i) a2[i] = __shfl_xor(acc[i], off);
        const float mn = fmaxf(m, m2), s1 = __expf(m - mn), s2 = __expf(m2 - mn);
        l = l * s1 + l2 * s2;
#pragma unroll
        for (int i = 0; i < 4; ++i) acc[i] = acc[i] * s1 + a2[i] * s2;
        m = mn;
    }
    if (kg == 0) { float gt[4]; unpk4(*(const u32x2*)(C_HB + (size_t)R * LDH + EC_GB + hh * 64 + 4 * dl), gt);
        const float inv = 1.0f / l; float o[4];
#pragma unroll
        for (int i = 0; i < 4; ++i) o[i] = acc[i] * inv * siluf_(gt[i]);
        *(u32x2*)(C_U + (size_t)R * EVEN_OUT + 768 + hh * 64 + 4 * dl) = (u32x2){pk2(o[0], o[1]), pk2(o[2], o[3])}; }
}

__device__ __forceinline__ void mem_attn_item(const Ctx& c, int R, int mh, int l, int qcol, int gcol, int ucol, int ldu) {
    const int lane = c.lane, kg = lane >> 5, dl = lane & 31;
    const float* mkv;
    if (R < TP) mkv = C_OUT + O_MEM + ((size_t)l * 512 + (R >> 12) * 256) * 1024; else mkv = C_IN(8) + ((size_t)l * 8 + ((R - TP) >> 2)) * 256 * 1024;
    float q[4]; unpk4(*(const u32x2*)(C_HB + (size_t)R * LDH + qcol + mh * 128 + 4 * dl), q);
#pragma unroll
    for (int i = 0; i < 4; ++i) q[i] *= 0.08838834764831845f;
    float m = -1e30f, lsum = 0.f, acc[4] = {0.f, 0.f, 0.f, 0.f};
#pragma unroll 8
    for (int j0 = 0; j0 < 256; j0 += 2) {
        const float* kp = mkv + (size_t)(j0 + kg) * 1024 + mh * 128 + 4 * dl; const f32x4 k4 = *(const f32x4*)kp, v4 = *(const f32x4*)(kp + 512);
        float s = q[0] * k4.x + q[1] * k4.y + q[2] * k4.z + q[3] * k4.w;
        s = red16(s); s += __shfl_xor(s, 16);
        const float mn = fmaxf(m, s), sc = __expf(m - mn), p = __expf(s - mn);
        lsum = lsum * sc + p; acc[0] = acc[0] * sc + p * v4.x; acc[1] = acc[1] * sc + p * v4.y; acc[2] = acc[2] * sc + p * v4.z; acc[3] = acc[3] * sc + p * v4.w; m = mn;
    }
    { const float m2 = __shfl_xor(m, 32), l2 = __shfl_xor(lsum, 32); float a2[4];
#pragma unroll
        for (int i = 0; i < 4; ++i) a2[i] = __shfl_xor(acc[i], 32);
        const float mn = fmaxf(m, m2), s1 = __expf(m - mn), s2 = __expf(m2 - mn);
        lsum = lsum * s1 + l2 * s2;
#pragma unroll
        for (int i = 0; i < 4; ++i) acc[i] = acc[i] * s1 + a2[i] * s2; }
    if (kg == 0) { float gt[4]; unpk4(*(const u32x2*)(C_HB + (size_t)R * LDH + gcol + mh * 128 + 4 * dl), gt);
        const float inv = 1.0f / lsum; float o[4];
#pragma unroll
        for (int i = 0; i < 4; ++i) o[i] = acc[i] * inv * siluf_(gt[i]);
        *(u32x2*)(C_U + (size_t)R * ldu + ucol + mh * 128 + 4 * dl) = (u32x2){pk2(o[0], o[1]), pk2(o[2], o[3])}; }
}


typedef float f32x16 __attribute__((ext_vector_type(16)));
__device__ __forceinline__ f32x16 mfma32(bf16x8 a, bf16x8 b, f32x16 cacc) { return __builtin_amdgcn_mfma_f32_32x32x16_bf16(a, b, cacc, 0, 0, 0); }
__device__ __forceinline__ void mem_attn_mfma_item(const Ctx& c, int item, int l, int qcol, int gcol, int ucol, int ldu) {
    const int blk = item >> 2, mh = item & 3, R0 = blk * 32, b = R0 >> 12;
    const int lane = c.lane, r = lane & 31, hh = lane >> 5;
    const bf16* Kb = C_MKVB + ((size_t)l * 512 + b * 256) * 1024 + mh * 128 + 8 * hh;
    const bf16* Vt = C_VT + ((size_t)l * 512 + mh * 128) * 512 + b * 256 + 4 * hh;
    bf16x8 Qf[8];
    { const bf16* qp = C_HB + (size_t)(R0 + r) * LDH + qcol + mh * 128 + 8 * hh;
#pragma unroll
        for (int ks = 0; ks < 8; ++ks) Qf[ks] = *(const bf16x8*)(qp + 16 * ks); }
    f32x16 O[4];
#pragma unroll
    for (int dt = 0; dt < 4; ++dt)
#pragma unroll
        for (int i = 0; i < 16; ++i) O[dt][i] = 0.f;
    float m = -1e30f, lsum = 0.f;
    const float cs = 0.08838834764831845f * 1.4426950408889634f;
#pragma unroll 1
    for (int half = 0; half < 2; ++half) {
        f32x16 S[4];
#pragma unroll
        for (int kt = 0; kt < 4; ++kt) {
#pragma unroll
            for (int i = 0; i < 16; ++i) S[kt][i] = 0.f;
            const bf16* kp = Kb + (size_t)(128 * half + 32 * kt + r) * 1024;
#pragma unroll
            for (int ks = 0; ks < 8; ++ks) S[kt] = mfma32(*(const bf16x8*)(kp + 16 * ks), Qf[ks], S[kt]);
        }
        float mx = -1e30f;
#pragma unroll
        for (int kt = 0; kt < 4; ++kt)
#pragma unroll
            for (int i = 0; i < 16; ++i) mx = fmaxf(mx, S[kt][i]);
        mx = fmaxf(mx, __shfl_xor(mx, 32));
        const float mn = fmaxf(m, mx), sc = __builtin_amdgcn_exp2f((m - mn) * cs); m = mn;
        lsum *= sc;
#pragma unroll
        for (int dt = 0; dt < 4; ++dt)
#pragma unroll
            for (int i = 0; i < 16; ++i) O[dt][i] *= sc;
        float ps = 0.f;
#pragma unroll
        for (int kt = 0; kt < 4; ++kt)
#pragma unroll
            for (int i = 0; i < 16; ++i) { const float p = __builtin_amdgcn_exp2f((S[kt][i] - mn) * cs); S[kt][i] = p; ps += p; }
        lsum += ps;
#pragma unroll
        for (int kt = 0; kt < 4; ++kt)
#pragma unroll
            for (int s2 = 0; s2 < 2; ++s2) {
                const u32x4 pw = (u32x4){pk2(S[kt][8 * s2 + 0], S[kt][8 * s2 + 1]), pk2(S[kt][8 * s2 + 2], S[kt][8 * s2 + 3]), pk2(S[kt][8 * s2 + 4], S[kt][8 * s2 + 5]), pk2(S[kt][8 * s2 + 6], S[kt][8 * s2 + 7])};
                const bf16x8 Pf = __builtin_bit_cast(bf16x8, pw);
                const int kb = 128 * half + 32 * kt + 16 * s2;
#pragma unroll
                for (int dt = 0; dt < 4; ++dt) { const bf16* vp = Vt + (size_t)(32 * dt + r) * 512 + kb;
                    const u32x2 v0 = *(const u32x2*)vp, v1 = *(const u32x2*)(vp + 8); const u32x4 vw = (u32x4){v0.x, v0.y, v1.x, v1.y};
                    O[dt] = mfma32(__builtin_bit_cast(bf16x8, vw), Pf, O[dt]); }
            }
    }
    lsum += __shfl_xor(lsum, 32); const float inv = 1.0f / lsum;
    const bf16* gp = C_HB + (size_t)(R0 + r) * LDH + gcol + mh * 128 + 4 * hh; bf16* up = C_U + (size_t)(R0 + r) * ldu + ucol + mh * 128 + 4 * hh;
#pragma unroll
    for (int dt = 0; dt < 4; ++dt)
#pragma unroll
        for (int g4 = 0; g4 < 4; ++g4) { float gt[4]; unpk4(*(const u32x2*)(gp + 32 * dt + 8 * g4), gt);
            const float o0 = O[dt][4 * g4 + 0] * inv * siluf_(gt[0]), o1 = O[dt][4 * g4 + 1] * inv * siluf_(gt[1]), o2 = O[dt][4 * g4 + 2] * inv * siluf_(gt[2]), o3 = O[dt][4 * g4 + 3] * inv * siluf_(gt[3]);
            *(u32x2*)(up + 32 * dt + 8 * g4) = (u32x2){pk2(o0, o1), pk2(o2, o3)}; }
}
__device__ __forceinline__ void mem_attn_all(const Ctx& c, int l, int qcol, int gcol, int ucol, int ldu) {
    constexpr int NM = (TP / 32) * 4, NS = TS * 4;
    for (int wi = c.wave * c.G + c.bid; wi < NM + NS; wi += 8 * c.G) {
        if (wi < NM) mem_attn_mfma_item(c, wi, l, qcol, gcol, ucol, ldu);
        else { const int si = wi - NM; mem_attn_item(c, TP + (si >> 2), si & 3, l, qcol, gcol, ucol, ldu); }
    }
}


typedef short s16x4 __attribute__((ext_vector_type(4)));
__device__ __forceinline__ f32x4 mfma16(bf16x8 a, bf16x8 b, f32x4 cacc) { return __builtin_amdgcn_mfma_f32_16x16x32_bf16(a, b, cacc, 0, 0, 0); }
__device__ __forceinline__ bf16x8 tr_frag(const LAS bf16* p, int rowstride4) {
    const s16x4 a0 = __builtin_amdgcn_ds_read_tr16_b64_v4i16((LAS s16x4*)p), a1 = __builtin_amdgcn_ds_read_tr16_b64_v4i16((LAS s16x4*)(p + rowstride4));
    return (bf16x8){a0[0], a0[1], a0[2], a0[3], a1[0], a1[1], a1[2], a1[3]};
}
__device__ __forceinline__ void dil_attn_mfma_item(const Ctx& c, int item) {
    const int bh = item / 48, rem = item % 48, b = bh >> 2, hh = bh & 3, g = rem >> 4, idx16 = rem & 15;
    const int dil = 1 << (2 * g), nub = 16 >> (2 * g), rho = idx16 / nub, ub = idx16 % nub;
    LAS bf16* Kl = (LAS bf16*)c.lds;
    LAS bf16* Vl = Kl + 384 * 72;
    const int tid = c.tid, lane = c.lane, wave = c.wave, r = lane & 31, hl = lane >> 5;
    const int ubase = ub * 256 - 128;
    const bf16* hb = C_HB + (size_t)b * SEQ * LDH + g * 256 + hh * 64;
    u32x4 kwv[6], vwv[6];
#pragma unroll
    for (int pass = 0; pass < 6; ++pass) { const int kl = pass * 64 + (tid >> 3), part = tid & 7; int up = ubase + kl; up = up < 0 ? 0 : up;
        const bf16* src = hb + (size_t)(rho + dil * up) * LDH + 8 * part;
        kwv[pass] = *(const u32x4*)(src + EC_KB); vwv[pass] = *(const u32x4*)(src + EC_VB); }
    const int u0 = ub * 256 + 32 * wave;
    bf16x8 Qf[4];
    { const bf16* qp = hb + (size_t)(rho + dil * (u0 + r)) * LDH + EC_QB + 8 * hl;
#pragma unroll
        for (int ks = 0; ks < 4; ++ks) Qf[ks] = *(const bf16x8*)(qp + 16 * ks); }
#pragma unroll
    for (int pass = 0; pass < 6; ++pass) { const int kl = pass * 64 + (tid >> 3), part = tid & 7; *(LAS u32x4*)(Kl + kl * 72 + 8 * part) = kwv[pass]; *(LAS u32x4*)(Vl + kl * 72 + 8 * part) = vwv[pass]; }
    __syncthreads();
    f32x16 S[5];
#pragma unroll
    for (int kt = 0; kt < 5; ++kt) {
#pragma unroll
        for (int i = 0; i < 16; ++i) S[kt][i] = 0.f;
        const LAS bf16* kp = Kl + (32 * wave + 32 * kt + r) * 72 + 8 * hl;
#pragma unroll
        for (int ks = 0; ks < 4; ++ks) S[kt] = mfma32(*(const LAS bf16x8*)(kp + 16 * ks), Qf[ks], S[kt]);
    }
    float mx = -1e30f;
#pragma unroll
    for (int kt = 0; kt < 5; ++kt)
#pragma unroll
        for (int i = 0; i < 16; ++i) { const int kl = 32 * kt + (i & 3) + 8 * (i >> 2) + 4 * hl;
            const bool valid = (kl >= r) && (kl - 128 <= r) && (u0 - 128 + kl >= 0);
            const float sv = valid ? S[kt][i] : -1e30f; S[kt][i] = sv; mx = fmaxf(mx, sv); }
    mx = fmaxf(mx, __shfl_xor(mx, 32));
    const float cs = 0.125f * 1.4426950408889634f;
    float lsum = 0.f;
#pragma unroll
    for (int kt = 0; kt < 5; ++kt)
#pragma unroll
        for (int i = 0; i < 16; ++i) { const float p = __builtin_amdgcn_exp2f((S[kt][i] - mx) * cs); S[kt][i] = p; lsum += p; }
    lsum += __shfl_xor(lsum, 32);
    f32x16 O[2];
#pragma unroll
    for (int dt = 0; dt < 2; ++dt)
#pragma unroll
        for (int i = 0; i < 16; ++i) O[dt][i] = 0.f;
    const LAS bf16* vbase = Vl + (32 * wave + 4 * hl + ((lane & 15) >> 2)) * 72 + 16 * ((lane >> 4) & 1) + 4 * (lane & 3);
#pragma unroll
    for (int kt = 0; kt < 5; ++kt)
#pragma unroll
        for (int s2 = 0; s2 < 2; ++s2) {
            const u32x4 pw = (u32x4){pk2(S[kt][8 * s2 + 0], S[kt][8 * s2 + 1]), pk2(S[kt][8 * s2 + 2], S[kt][8 * s2 + 3]), pk2(S[kt][8 * s2 + 4], S[kt][8 * s2 + 5]), pk2(S[kt][8 * s2 + 6], S[kt][8 * s2 + 7])};
            const bf16x8 Pf = __builtin_bit_cast(bf16x8, pw);
#pragma unroll
            for (int dt = 0; dt < 2; ++dt) { const LAS bf16* vp = vbase + (32 * kt + 16 * s2) * 72 + 32 * dt;
                const s16x4 a0 = __builtin_amdgcn_ds_read_tr16_b64_v4i16((LAS s16x4*)vp), a1 = __builtin_amdgcn_ds_read_tr16_b64_v4i16((LAS s16x4*)(vp + 8 * 72));
                const bf16x8 Af = (bf16x8){a0[0], a0[1], a0[2], a0[3], a1[0], a1[1], a1[2], a1[3]};
                O[dt] = mfma32(Af, Pf, O[dt]); }
        }
    const float inv = 1.0f / lsum; const size_t R = (size_t)b * SEQ + rho + dil * (u0 + r);
    float* og = C_OG + ((size_t)g * TT + R) * 256 + hh * 64 + 4 * hl;
#pragma unroll
    for (int dt = 0; dt < 2; ++dt)
#pragma unroll
        for (int g4 = 0; g4 < 4; ++g4) *(f32x4*)(og + 32 * dt + 8 * g4) = (f32x4){O[dt][4 * g4 + 0] * inv, O[dt][4 * g4 + 1] * inv, O[dt][4 * g4 + 2] * inv, O[dt][4 * g4 + 3] * inv};
    if (hl == 0) C_LSE[((size_t)g * TT + R) * 4 + hh] = mx * 0.125f + __logf(lsum);
    __syncthreads();
}
__device__ __forceinline__ void dil_attn_sample_item(const Ctx& c, int sr, int hh, int e) {
    const int lane = c.lane, kg = lane >> 4, dl = lane & 15, R = TP + sr, n = sr >> 2, t = sr & 3;
    float m = -1e30f, l = 0.f, acc[4] = {0.f, 0.f, 0.f, 0.f};
#pragma unroll
    for (int g = 0; g < 3; ++g) {
        const int dil = (g == 0) ? 1 : (g == 1 ? 4 : 16), W = 128 * dil, jn = t / dil;
        float q[4]; unpk4(*(const u32x2*)(C_HB + (size_t)R * LDH + EC_QB + g * 256 + hh * 64 + 4 * dl), q);
#pragma unroll
        for (int i = 0; i < 4; ++i) q[i] *= 0.125f;
        { const int j = kg; const bool valid = j <= jn; const int tt = valid ? t - dil * j : t;
            const bf16* kp = C_HB + (size_t)(TP + n * 4 + tt) * LDH + g * 256 + hh * 64 + 4 * dl; float kf[4], vf[4]; unpk4(*(const u32x2*)(kp + EC_KB), kf); unpk4(*(const u32x2*)(kp + EC_VB), vf);
            float s = red16(q[0] * kf[0] + q[1] * kf[1] + q[2] * kf[2] + q[3] * kf[3]);
            if (valid) { const float mn = fmaxf(m, s), sc = __expf(m - mn), p = __expf(s - mn); l = l * sc + p;
#pragma unroll
                for (int i = 0; i < 4; ++i) acc[i] = acc[i] * sc + p * vf[i];
                m = mn; } }
        const float* cache = ((g == 0) ? C_IN(4) : (g == 1 ? C_IN(5) : C_IN(6))) + ((size_t)(e * 8 + n) * W) * 512 + hh * 64 + 4 * dl;
#pragma unroll 11
        for (int j0 = 0; j0 < 132; j0 += 4) { const int j = j0 + kg; const bool valid = (j > jn) && (j <= 128); const int idx = valid ? W + t - dil * j : 0;
            const float* kp = cache + (size_t)idx * 512; const f32x4 k4 = *(const f32x4*)kp, v4 = *(const f32x4*)(kp + 256);
            const float s = red16(q[0] * k4.x + q[1] * k4.y + q[2] * k4.z + q[3] * k4.w);
            if (valid) { const float mn = fmaxf(m, s), sc = __expf(m - mn), p = __expf(s - mn); l = l * sc + p;
                acc[0] = acc[0] * sc + p * v4.x; acc[1] = acc[1] * sc + p * v4.y; acc[2] = acc[2] * sc + p * v4.z; acc[3] = acc[3] * sc + p * v4.w; m = mn; } }
    }
#pragma unroll
    for (int off = 16; off <= 32; off <<= 1) {
        const float m2 = __shfl_xor(m, off), l2 = __shfl_xor(l, off); float a2[4];
#pragma unroll
        for (int i = 0; i < 4; ++i) a2[i] = __shfl_xor(acc[i], off);
        const float mn = fmaxf(m, m2), s1 = __expf(m - mn), s2 = __expf(m2 - mn);
        l = l * s1 + l2 * s2;
#pragma unroll
        for (int i = 0; i < 4; ++i) acc[i] = acc[i] * s1 + a2[i] * s2;
        m = mn;
    }
    if (kg == 0) { float gt[4]; unpk4(*(const u32x2*)(C_HB + (size_t)R * LDH + EC_GB + hh * 64 + 4 * dl), gt);
        const float inv = 1.0f / l; float o[4];
#pragma unroll
        for (int i = 0; i < 4; ++i) o[i] = acc[i] * inv * siluf_(gt[i]);
        *(u32x2*)(C_U + (size_t)R * EVEN_OUT + 768 + hh * 64 + 4 * dl) = (u32x2){pk2(o[0], o[1]), pk2(o[2], o[3])}; }
}

__device__ __forceinline__ void even_copies(const Ctx& c, int e) {
    const int gt = c.bid * 512 + c.tid, NT = c.G * 512;
    for (int i = gt; i < 10 * 304; i += NT) { const int rw = i / 304, c8 = 8 * (i % 304);
        const size_t src = (rw < 2) ? (size_t)(rw * SEQ + SEQ - 1) : (size_t)(TP + (rw - 2) * 4 + 3);
        float x[8]; unpk8(*(const u32x4*)(C_HB + src * LDH + c8), x);
        float* dst = (rw < 2) ? C_OUT + O_SH_P + ((size_t)e * 2 + rw) * 2432 + c8 : C_OUT + O_SH_S + ((size_t)e * 8 + (rw - 2)) * 2432 + c8;
        *(f32x4*)dst = (f32x4){x[0], x[1], x[2], x[3]}; *(f32x4*)(dst + 4) = (f32x4){x[4], x[5], x[6], x[7]}; }
#pragma unroll 1
    for (int g = 0; g < 3; ++g) {
        const int keep = 128 << (2 * g); const size_t op = (g == 0) ? O_G0P : (g == 1 ? O_G1P : O_G2P), os = (g == 0) ? O_G0S : (g == 1 ? O_G1S : O_G2S);
        for (int i = gt; i < 2 * keep * 64; i += NT) { const int pc = i & 63, r = (i >> 6) % keep, b = (i >> 6) / keep;
            const int col = ((pc & 32) ? EC_VB : EC_KB) + g * 256 + 8 * (pc & 31);
            float x[8]; unpk8(*(const u32x4*)(C_HB + (size_t)(b * SEQ + SEQ - keep + r) * LDH + col), x);
            float* dst = C_OUT + op + ((size_t)e * 2 * keep + (size_t)b * keep + r) * 512 + 8 * pc;
            *(f32x4*)dst = (f32x4){x[0], x[1], x[2], x[3]}; *(f32x4*)(dst + 4) = (f32x4){x[4], x[5], x[6], x[7]}; }
        for (int i = gt; i < 8 * 4 * 64; i += NT) { const int pc = i & 63, row = i >> 6;
            const int col = ((pc & 32) ? EC_VB : EC_KB) + g * 256 + 8 * (pc & 31);
            float x[8]; unpk8(*(const u32x4*)(C_HB + (size_t)(TP + row) * LDH + col), x);
            float* dst = C_OUT + os + ((size_t)e * 32 + row) * 512 + 8 * pc;
            *(f32x4*)dst = (f32x4){x[0], x[1], x[2], x[3]}; *(f32x4*)(dst + 4) = (f32x4){x[4], x[5], x[6], x[7]}; }
    }
}

#define LAUNDER_C(c) do { asm volatile("" : "+s"((c).ap), "+v"((c).tid), "+s"((c).bid), "+s"((c).G)); (c).lane = (c).tid & 63; (c).wave = __builtin_amdgcn_readfirstlane((c).tid >> 6); } while (0)
__device__ __forceinline__ void phase_even_tok_pre(Ctx c, int l);
__device__ __forceinline__ void even_helper_work(Ctx c, int l) {
    const int e = l >> 1;
    for (int rp = 0; rp < REPD; ++rp) { for (int it = c.bid; it < 384; it += c.G) dil_attn_mfma_item(c, it);
    LAUNDER_C(c); }
    { const int gw = (c.G - 1 - c.bid) * 8 + c.wave; if (gw < TS * 4) dil_attn_sample_item(c, gw >> 2, gw & 3, e); }
    LAUNDER_C(c);
    for (int rp = 0; rp < REPM; ++rp) { mem_attn_all(c, l, EC_QM, EC_GM, 1024, EVEN_OUT);
    LAUNDER_C(c); }
    even_copies(c, e);
    LAUNDER_C(c);
    for (int rp = 0; rp < REPC; ++rp) { if (l < 3) convert_layer_weights(c, l + 1); LAUNDER_C(c); }
}

__device__ __forceinline__ void rwkv_scan_item(const Ctx& c, int item, int e) {
    constexpr int CH = 32;
    LAS float* buf = (LAS float*)c.lds;
    LAS float* ybuf = buf + 2 * CH * 384;
    const bool is_p = item < 48; const int st = is_p ? (item >> 1) : ((item - 48) >> 1), half = item & 1;
    const int h = st % 12, bn = st / 12; const int T = is_p ? SEQ : 4; const size_t tok0 = is_p ? (size_t)bn * SEQ : (size_t)(TP + bn * 4);
    const int lane = c.lane, rw = lane >> 4, cgp = lane & 15, il = 4 * c.wave + rw, i = 32 * half + il;
    float s[4];
    if (is_p) { s[0] = s[1] = s[2] = s[3] = 0.f; }
    else { const f32x4 v = *(const f32x4*)(C_IN(2) + ((((size_t)e * 8 + bn) * 12 + h) * 64 + i) * 64 + 4 * cgp); s[0] = v.x; s[1] = v.y; s[2] = v.z; s[3] = v.w; }
    const int nch = (T + CH - 1) / CH;
    f32x4 pre[6];
#define SCAN_GLOAD(ch_) do { _Pragma("unroll") for (int k = 0; k < 6; ++k) { const int idx = c.tid + 512 * k, tl_ = idx / 96, f4 = idx % 96; const int tk = (ch_) * CH + tl_; \
            pre[k] = (tk < T) ? *(const f32x4*)(C_PREPS + ((tok0 - TP + tk) * 12 + h) * 384 + 4 * f4) : (f32x4){0.f, 0.f, 0.f, 0.f}; } } while (0)
#define SCAN_LSTORE(bi_) do { _Pragma("unroll") for (int k = 0; k < 6; ++k) { const int idx = c.tid + 512 * k; *(LAS f32x4*)(buf + (bi_) * CH * 384 + 4 * idx) = pre[k]; } } while (0)
    SCAN_GLOAD(0); SCAN_LSTORE(0); __syncthreads();
#pragma unroll 1
    for (int ch = 0; ch < nch; ++ch) {
        if (ch + 1 < nch) SCAN_GLOAD(ch + 1);
        const LAS float* bb = buf + (ch & 1) * CH * 384;
        const int nt = (T - ch * CH) < CH ? (T - ch * CH) : CH;
#pragma unroll 2
        for (int tl = 0; tl < nt; ++tl) {
            const LAS float* p = bb + tl * 384;
            const f32x4 r4 = *(const LAS f32x4*)(p + 4 * cgp), d4 = *(const LAS f32x4*)(p + 64 + 4 * cgp), k4 = *(const LAS f32x4*)(p + 128 + 4 * cgp),
                        kk4 = *(const LAS f32x4*)(p + 256 + 4 * cgp), b4 = *(const LAS f32x4*)(p + 320 + 4 * cgp);
            const float vi = p[192 + i];
            float sa = s[0] * kk4.x + s[1] * kk4.y + s[2] * kk4.z + s[3] * kk4.w;
            sa = red16(sa);
            s[0] = s[0] * d4.x + (sa * b4.x + vi * k4.x); s[1] = s[1] * d4.y + (sa * b4.y + vi * k4.y);
            s[2] = s[2] * d4.z + (sa * b4.z + vi * k4.z); s[3] = s[3] * d4.w + (sa * b4.w + vi * k4.w);
            float y = s[0] * r4.x + s[1] * r4.y + s[2] * r4.z + s[3] * r4.w;
            y = red16(y);
            if (cgp == 0) ybuf[tl * 32 + il] = y;
        }
        __syncthreads();
        if (ch + 1 < nch) SCAN_LSTORE((ch + 1) & 1);
        for (int idx = c.tid; idx < nt * 32; idx += 512) { const int tl = idx >> 5, r = idx & 31; C_YA[(tok0 + ch * CH + tl) * 768 + h * 64 + 32 * half + r] = ybuf[idx]; }
        __syncthreads();
    }
    float* so = C_OUT + (is_p ? O_RWKV_P + (((size_t)e * 2 + bn) * 12 + h) * 4096 : O_RWKV_S + (((size_t)e * 8 + bn) * 12 + h) * 4096) + (size_t)i * 64 + 4 * cgp;
    *(f32x4*)so = (f32x4){s[0], s[1], s[2], s[3]};
}

typedef float f32x2 __attribute__((ext_vector_type(2)));
__device__ __forceinline__ void rwkv_scan_prompt(const Ctx& c, int item, int e) {
    constexpr int CH = 32, NCH = SEQ / CH;
    LAS float* buf = (LAS float*)c.lds;
    LAS float* ybuf = buf + 2 * CH * 384;
    const int st = item >> 1, half = item & 1, h = st % 12, bn = st / 12; const size_t tok0 = (size_t)bn * SEQ;
    const int lane = c.lane, rw = lane >> 4, cgp = lane & 15, il = 4 * c.wave + rw, i = 32 * half + il;
    f32x2 s01 = (f32x2){0.f, 0.f}, s23 = (f32x2){0.f, 0.f};
    const float* src = C_PREP + (tok0 * 12 + h) * 384;
    float* ya = C_YA + tok0 * 768 + h * 64 + 32 * half;
    f32x4 pre[6];
#define SP_GLOAD(ch_) do { _Pragma("unroll") for (int k = 0; k < 6; ++k) { const int idx = c.tid + 512 * k, tl_ = idx / 96, f4 = idx % 96; \
        pre[k] = *(const f32x4*)(src + (size_t)((ch_) * CH + tl_) * (12 * 384) + 4 * f4); } } while (0)
#define SP_LSTORE(bi_) do { _Pragma("unroll") for (int k = 0; k < 6; ++k) { const int idx = c.tid + 512 * k; *(LAS f32x4*)(buf + (bi_) * CH * 384 + 4 * idx) = pre[k]; } } while (0)
#define SP_YOUT(ch_) do { for (int idx = c.tid; idx < CH * 32; idx += 512) { const int tl_ = idx >> 5, r_ = idx & 31; ya[(size_t)((ch_) * CH + tl_) * 768 + r_] = ybuf[((ch_) & 1) * CH * 32 + idx]; } } while (0)
    SP_GLOAD(0); SP_LSTORE(0); SP_GLOAD(1); __syncthreads();
#pragma unroll 1
    for (int ch = 0; ch < NCH; ++ch) {
        if (ch + 1 < NCH) SP_LSTORE((ch + 1) & 1);
        if (ch + 2 < NCH) SP_GLOAD(ch + 2);
        if (ch > 0) SP_YOUT(ch - 1);
        const LAS float* bb = buf + (ch & 1) * CH * 384 + 4 * cgp; const LAS float* vb = buf + (ch & 1) * CH * 384 + 192 + i;
        LAS float* yw = (cgp == 0) ? (ybuf + (ch & 1) * CH * 32 + il) : (ybuf + 2 * CH * 32 + lane);
        f32x4 r4 = *(const LAS f32x4*)bb, d4 = *(const LAS f32x4*)(bb + 64), k4 = *(const LAS f32x4*)(bb + 128), n4 = *(const LAS f32x4*)(bb + 256), b4 = *(const LAS f32x4*)(bb + 320); float vi = vb[0];
        float sa;
        { f32x2 p = s01 * (f32x2){n4.x, n4.y}; p = s23 * (f32x2){n4.z, n4.w} + p; sa = red16(p.x + p.y); }
#pragma unroll 4
        for (int tl = 0; tl < CH; ++tl) {
            const int tn = (tl + 1 < CH) ? tl + 1 : tl;
            const f32x4 r4n = *(const LAS f32x4*)(bb + tn * 384), d4n = *(const LAS f32x4*)(bb + tn * 384 + 64), k4n = *(const LAS f32x4*)(bb + tn * 384 + 128),
                        n4n = *(const LAS f32x4*)(bb + tn * 384 + 256), b4n = *(const LAS f32x4*)(bb + tn * 384 + 320); const float vin = vb[tn * 384];
            const f32x2 vi2 = (f32x2){vi, vi}, sa2 = (f32x2){sa, sa};
            const f32x2 u01 = s01 * (f32x2){d4.x, d4.y} + vi2 * (f32x2){k4.x, k4.y}, u23 = s23 * (f32x2){d4.z, d4.w} + vi2 * (f32x2){k4.z, k4.w};
            s01 = sa2 * (f32x2){b4.x, b4.y} + u01; s23 = sa2 * (f32x2){b4.z, b4.w} + u23;
            f32x2 yp = s01 * (f32x2){r4.x, r4.y}; yp = s23 * (f32x2){r4.z, r4.w} + yp;
            f32x2 pn = s01 * (f32x2){n4n.x, n4n.y}; pn = s23 * (f32x2){n4n.z, n4n.w} + pn;
            float ya_ = yp.x + yp.y, sb_ = pn.x + pn.y;
            sb_ += dppf<0xB1>(sb_); ya_ += dppf<0xB1>(ya_); sb_ += dppf<0x4E>(sb_); ya_ += dppf<0x4E>(ya_);
            sb_ += dppf<0x141>(sb_); ya_ += dppf<0x141>(ya_); sb_ += dppf<0x140>(sb_); ya_ += dppf<0x140>(ya_);
            sa = sb_;
            yw[tl * 32] = ya_;
            r4 = r4n; d4 = d4n; k4 = k4n; n4 = n4n; b4 = b4n; vi = vin;
        }
        __syncthreads();
    }
    SP_YOUT(NCH - 1);
    float* so = C_OUT + O_RWKV_P + (((size_t)e * 2 + bn) * 12 + h) * 4096 + (size_t)i * 64 + 4 * cgp;
    *(f32x4*)so = (f32x4){s01.x, s01.y, s23.x, s23.y};
    __syncthreads();
#undef SP_GLOAD
#undef SP_LSTORE
#undef SP_YOUT
}

struct PreIn { u32x2 cr, ck, cv, pr, pk, pv; float hcur[8], hprv[8]; };
__device__ __forceinline__ void rwkv_chunk_preload(const Ctx& c, int item, int e, PreIn& P) {
    const bool is_s = item >= 3072; const int sidx = item - 3072;
    const int bh = item >> 7, n = is_s ? 1 : (item & 127), b = bh / 12, h = is_s ? (sidx % 12) : (bh % 12), ns = sidx / 12;
    const size_t R0 = is_s ? (size_t)(TP + 4 * ns) : (size_t)b * SEQ + 32 * n;
    const float* shift = C_IN(3) + ((size_t)e * 8 + ns) * 2432;
    const int tid = c.tid, t_ = tid >> 4, c4 = 4 * (tid & 15), col = h * 64 + c4;
    const bf16* hc = C_HB + (R0 + t_) * LDH + col; const bool hasprev = is_s ? (t_ != 0) : ((32 * n + t_) != 0);
    const u32x2 z2 = (u32x2){0u, 0u};
    P.cr = *(const u32x2*)(hc + EC_R); P.ck = *(const u32x2*)(hc + EC_K); P.cv = *(const u32x2*)(hc + EC_V);
    P.pr = hasprev ? *(const u32x2*)(hc - LDH + EC_R) : z2; P.pk = hasprev ? *(const u32x2*)(hc - LDH + EC_K) : z2; P.pv = hasprev ? *(const u32x2*)(hc - LDH + EC_V) : z2;
    const int cc = tid & 127, cl = EC_HW + cc, tb = tid >> 7;
#pragma unroll
    for (int k = 0; k < 8; ++k) { const int t = tb + 4 * k; P.hcur[k] = bf2f(C_HB[(R0 + t) * LDH + cl]);
        P.hprv[k] = is_s ? (t != 0 ? bf2f(C_HB[(R0 + t - 1) * LDH + cl]) : shift[cl]) : (((32 * n + t) != 0) ? bf2f(C_HB[(R0 + t - 1) * LDH + cl]) : 0.f); }
}
__device__ __forceinline__ void rwkv_chunk_precompute(const Ctx& c, int item, int e, const PreIn& P) {
    const bool is_s = item >= 3072; const int sidx = item - 3072;
    const int bh = item >> 7, n = is_s ? 1 : (item & 127), b = bh / 12, h = is_s ? (sidx % 12) : (bh % 12), ns = sidx / 12, ntok = is_s ? 4 : 32;
    const size_t R0 = is_s ? (size_t)(TP + 4 * ns) : (size_t)b * SEQ + 32 * n;
    const float* shift = C_IN(3) + ((size_t)e * 8 + ns) * 2432;
    LAS unsigned char* L = c.lds;
    LAS float* XW = (LAS float*)(L + 0); LAS float* XA = (LAS float*)(L + 8192);
    LAS bf16* LW = (LAS bf16*)(L + 16384); LAS bf16* LA = (LAS bf16*)(L + 20992);
    LAS float* PS = (LAS float*)(L + 25600);
    LAS bf16* KKt = (LAS bf16*)(L + 33792); LAS bf16* Bt = (LAS bf16*)(L + 38400); LAS bf16* Kt = (LAS bf16*)(L + 43008); LAS bf16* Rt = (LAS bf16*)(L + 47616);
    LAS bf16* Bh = (LAS bf16*)(L + 52224); LAS bf16* Kh = (LAS bf16*)(L + 56832); LAS bf16* Vb = (LAS bf16*)(L + 61440);
    LAS float* LB = (LAS float*)(L + 66048);
    LAS bf16* Lk = (LAS bf16*)(L + 70144); LAS bf16* Mb = (LAS bf16*)(L + 72704); LAS bf16* Mk = (LAS bf16*)(L + 75264);
    LAS float* SOL = (LAS float*)(L + 77824);
    LAS bf16* KTb = (LAS bf16*)(L + 94208); LAS bf16* UVb = (LAS bf16*)(L + 98816);
    LAS float* RTf = (LAS float*)(L + 103424); LAS float* c31 = (LAS float*)(L + 111616);
    const int tid = c.tid, lane = c.lane, wave = c.wave, fr = lane & 15, fq = lane >> 4, trow = (lane & 15) >> 2, tcol = 4 * (lane & 3);
    const int t_ = tid >> 4, c4 = 4 * (tid & 15), col = h * 64 + c4;
    const float* mu = C_IN(17) + e * 2432;
    const bf16* hc = C_HB + (R0 + t_) * LDH + col; const bool hasprev = is_s ? (t_ != 0) : ((32 * n + t_) != 0);
    const u32x2 cr = P.cr, ck = P.ck, cv = P.cv, pr = P.pr, pk = P.pk, pv = P.pv;
    f32x4 sh_r = (f32x4){0.f, 0.f, 0.f, 0.f}, sh_k = sh_r, sh_v = sh_r;
    if (is_s && t_ == 0) { sh_r = *(const f32x4*)(shift + EC_R + col); sh_k = *(const f32x4*)(shift + EC_K + col); sh_v = *(const f32x4*)(shift + EC_V + col); }
    { const int cc = tid & 127, cl = EC_HW + cc, tb = tid >> 7; const float muc = mu[cl];
#pragma unroll
        for (int k = 0; k < 8; ++k) { const int t = tb + 4 * k; const float hs = P.hcur[k] + (P.hprv[k] - P.hcur[k]) * muc;
            if (cc < 64) LW[t * 72 + cc] = (bf16)f2bf(1.0f - 2.0f / (1.0f + __expf(2.0f * hs))); else LA[t * 72 + cc - 64] = (bf16)f2bf(hs); } }
    __syncthreads();
    { const int p = wave >> 2, tt = (wave >> 1) & 1; const LAS bf16* As = p ? LA : LW; const bf16* WT = (p ? C_AUT : C_WUT) + ((size_t)e * 768 + h * 64) * 64; LAS float* X = p ? XA : XW;
#pragma unroll
        for (int cc = 0; cc < 2; ++cc) { const int ct = 2 * (wave & 1) + cc; f32x4 acc = (f32x4){0.f, 0.f, 0.f, 0.f};
#pragma unroll
            for (int ks = 0; ks < 2; ++ks) acc = mfma16(*(const LAS bf16x8*)(As + (16 * tt + fr) * 72 + 32 * ks + 8 * fq), *(const bf16x8*)(WT + (size_t)(16 * ct + fr) * 64 + 32 * ks + 8 * fq), acc);
#pragma unroll
            for (int r = 0; r < 4; ++r) X[(16 * tt + 4 * fq + r) * 64 + 16 * ct + fr] = acc[r]; } }
    __syncthreads();
    float rr[4], k2[4], vv[4], kkv[4], bb[4];
    for (int rep3 = 0; rep3 < REP3; ++rep3) { asm volatile("" ::: "memory");
    { const f32x4 xw4 = *(const LAS f32x4*)(XW + t_ * 64 + c4), xa4 = *(const LAS f32x4*)(XA + t_ * 64 + c4);
        const f32x4 w04 = *(const f32x4*)(C_IN(18) + e * 768 + col), a04 = *(const f32x4*)(C_IN(20) + e * 768 + col), kk4 = *(const f32x4*)(C_IN(22) + e * 768 + col), ka4 = *(const f32x4*)(C_IN(23) + e * 768 + col),
                    rk4 = *(const f32x4*)(C_IN(24) + e * 768 + col), mr4 = *(const f32x4*)(mu + EC_R + col), mk4 = *(const f32x4*)(mu + EC_K + col), mv4 = *(const f32x4*)(mu + EC_V + col);
        float crf[4], ckf[4], cvf[4], prf[4], pkf[4], pvf[4]; unpk4(cr, crf); unpk4(ck, ckf); unpk4(cv, cvf); unpk4(pr, prf); unpk4(pk, pkf); unpk4(pv, pvf);
        const bool tok_ok = t_ < ntok;
#pragma unroll
        for (int i = 0; i < 4; ++i) { prf[i] += sh_r[i]; pkf[i] += sh_k[i]; pvf[i] += sh_v[i]; }
        float wl[4], av[4], ssum = 0.f, bsum = 0.f;
#pragma unroll
        for (int i = 0; i < 4; ++i) { const float r = crf[i] + (prf[i] - crf[i]) * mr4[i], k = ckf[i] + (pkf[i] - ckf[i]) * mk4[i], v = cvf[i] + (pvf[i] - cvf[i]) * mv4[i];
            wl[i] = -0.6065306597126334f * sigmoidf_(w04[i] + xw4[i]); av[i] = sigmoidf_(a04[i] + xa4[i]);
            const float kk = tok_ok ? k * kk4[i] : 0.f; ssum += kk * kk; kkv[i] = kk; k2[i] = tok_ok ? k * (1.0f + (av[i] - 1.0f) * ka4[i]) : 0.f; rr[i] = tok_ok ? r : 0.f; vv[i] = tok_ok ? v : 0.f; bsum += rr[i] * k2[i] * rk4[i];
            if (!tok_ok) wl[i] = 0.f; }
        ssum = red16(ssum); bsum = red16(bsum); const float inv = rsqrtf(fmaxf(ssum, 1e-24f));
#pragma unroll
        for (int i = 0; i < 4; ++i) { kkv[i] *= inv; bb[i] = kkv[i] * av[i]; }
        if ((tid & 15) == 0 && tok_ok) C_BONUS[(R0 + t_) * 12 + h] = bsum;
        *(LAS f32x4*)(PS + t_ * 64 + c4) = (f32x4){wl[0], wl[1], wl[2], wl[3]}; }
    __syncthreads();
    if (tid < 64) { float run = 0.f;
#pragma unroll 8
        for (int t = 0; t < 32; ++t) { run += PS[t * 64 + tid]; PS[t * 64 + tid] = run; } }
    __syncthreads();
    { const f32x4 pt = *(const LAS f32x4*)(PS + t_ * 64 + c4), pe = *(const LAS f32x4*)(PS + 31 * 64 + c4); const f32x4 pp = (t_ > 0) ? *(const LAS f32x4*)(PS + (t_ - 1) * 64 + c4) : (f32x4){0.f, 0.f, 0.f, 0.f};
        float o_kk[4], o_b[4], o_k[4], o_r[4], o_bh[4], o_kh[4];
#pragma unroll
        for (int i = 0; i < 4; ++i) { const float ct = __expf(pt[i]), cp = __expf(pp[i]), ci = __expf(-pt[i]), chh = __expf(pe[i] - pt[i]);
            o_kk[i] = kkv[i] * cp; o_b[i] = bb[i] * ci; o_k[i] = k2[i] * ci; o_r[i] = rr[i] * ct; o_bh[i] = bb[i] * chh; o_kh[i] = k2[i] * chh; }
        *(LAS u32x2*)(KKt + t_ * 72 + c4) = (u32x2){pk2(o_kk[0], o_kk[1]), pk2(o_kk[2], o_kk[3])}; *(LAS u32x2*)(Bt + t_ * 72 + c4) = (u32x2){pk2(o_b[0], o_b[1]), pk2(o_b[2], o_b[3])};
        *(LAS u32x2*)(Kt + t_ * 72 + c4) = (u32x2){pk2(o_k[0], o_k[1]), pk2(o_k[2], o_k[3])}; *(LAS u32x2*)(Rt + t_ * 72 + c4) = (u32x2){pk2(o_r[0], o_r[1]), pk2(o_r[2], o_r[3])};
        *(LAS u32x2*)(Bh + t_ * 72 + c4) = (u32x2){pk2(o_bh[0], o_bh[1]), pk2(o_bh[2], o_bh[3])}; *(LAS u32x2*)(Kh + t_ * 72 + c4) = (u32x2){pk2(o_kh[0], o_kh[1]), pk2(o_kh[2], o_kh[3])};
        *(LAS u32x2*)(Vb + t_ * 72 + c4) = (u32x2){pk2(vv[0], vv[1]), pk2(vv[2], vv[3])};
        *(LAS f32x4*)(RTf + t_ * 64 + c4) = (f32x4){o_r[0], o_r[1], o_r[2], o_r[3]}; *(LAS f32x4*)(SOL + t_ * 128 + c4) = (f32x4){o_kk[0], o_kk[1], o_kk[2], o_kk[3]};
        if (t_ == 31) *(LAS f32x4*)(c31 + c4) = (f32x4){__expf(pt[0]), __expf(pt[1]), __expf(pt[2]), __expf(pt[3])}; }
    __syncthreads(); }
    { const int m = wave >> 1, tt = wave & 1; const LAS bf16* X = (m < 2) ? KKt : Rt; const LAS bf16* Yv = (m & 1) ? Kt : Bt;
#pragma unroll
        for (int st = 0; st < 2; ++st) { f32x4 acc = (f32x4){0.f, 0.f, 0.f, 0.f};
            if (st <= tt) {
#pragma unroll
                for (int ks = 0; ks < 2; ++ks) acc = mfma16(*(const LAS bf16x8*)(X + (16 * tt + fr) * 72 + 32 * ks + 8 * fq), *(const LAS bf16x8*)(Yv + (16 * st + fr) * 72 + 32 * ks + 8 * fq), acc); }
#pragma unroll
            for (int r = 0; r < 4; ++r) { const int t = 16 * tt + 4 * fq + r, s_ = 16 * st + fr; const bool keep = (m < 2) ? (s_ < t) : (s_ <= t); const float val = keep ? acc[r] : 0.f;
                if (m == 0) LB[t * 32 + (s_ & 3) * 8 + (s_ >> 2)] = val; else if (m == 1) Lk[t * 40 + s_] = (bf16)f2bf(val); else if (m == 2) Mb[t * 40 + s_] = (bf16)f2bf(val); else Mk[t * 40 + s_] = (bf16)f2bf(val); } } }
    __syncthreads();
    { const int tt = wave >> 2, ict = wave & 3;
        const f32x4 acc = mfma16(*(const LAS bf16x8*)(Lk + (16 * tt + fr) * 40 + 8 * fq), tr_frag(Vb + (8 * fq + trow) * 72 + 16 * ict + tcol, 4 * 72), (f32x4){0.f, 0.f, 0.f, 0.f});
#pragma unroll
        for (int r = 0; r < 4; ++r) SOL[(16 * tt + 4 * fq + r) * 128 + 64 + 16 * ict + fr] = acc[r]; }
    __syncthreads();
    { const int cidx = tid >> 2, q = tid & 3; float xq[8];
#pragma unroll
        for (int u = 0; u < 8; ++u) xq[u] = 0.f;
#pragma unroll
        for (int t = 0; t < 32; ++t) { float part = 0.f;
            if (t > 0) { const f32x4 la = *(const LAS f32x4*)(LB + t * 32 + q * 8); part = la[0] * xq[0];
                if (t > 4) part += la[1] * xq[1]; if (t > 8) part += la[2] * xq[2]; if (t > 12) part += la[3] * xq[3];
                if (t > 16) { const f32x4 lb = *(const LAS f32x4*)(LB + t * 32 + q * 8 + 4); part += lb[0] * xq[4];
                    if (t > 20) part += lb[1] * xq[5]; if (t > 24) part += lb[2] * xq[6]; if (t > 28) part += lb[3] * xq[7]; }
                part += dppf<0xB1>(part); part += dppf<0x4E>(part); }
            const float xt = SOL[t * 128 + cidx] - part;
            if (q == (t & 3)) { xq[t >> 2] = xt;
                if (cidx < 64) KTb[t * 72 + cidx] = (bf16)f2bf(xt); else UVb[t * 72 + cidx - 64] = (bf16)f2bf(-xt); } } }
    __syncthreads();
    for (int rep9 = 0; rep9 < REP9; ++rep9) { asm volatile("" ::: "memory");
    unsigned char* chk = C_CHK + (size_t)item * CHK_BYTES; bf16* Ag = (bf16*)(chk + CK_A); bf16* RQg = (bf16*)(chk + CK_RQ); float* GTg = (float*)(chk + CK_GT); float* YVTg = (float*)(chk + CK_YVT);
    const f32x4 z4 = (f32x4){0.f, 0.f, 0.f, 0.f};
    { const int jt = wave >> 1;
        const bf16x8 BhT = tr_frag(Bh + (8 * fq + trow) * 72 + 16 * jt + tcol, 4 * 72), KhT = tr_frag(Kh + (8 * fq + trow) * 72 + 16 * jt + tcol, 4 * 72);
#pragma unroll
        for (int cc = 0; cc < 2; ++cc) { const int ct = 2 * (wave & 1) + cc;
            const f32x4 aA = mfma16(BhT, tr_frag(KTb + (8 * fq + trow) * 72 + 16 * ct + tcol, 4 * 72), z4);
            f32x4 aG = mfma16(BhT, tr_frag(UVb + (8 * fq + trow) * 72 + 16 * ct + tcol, 4 * 72), z4); aG = mfma16(KhT, tr_frag(Vb + (8 * fq + trow) * 72 + 16 * ct + tcol, 4 * 72), aG);
#pragma unroll
            for (int r = 0; r < 4; ++r) { const int j = 16 * jt + 4 * fq + r, jp = 16 * ct + fr; Ag[j * 72 + jp] = (bf16)f2bf(((j == jp) ? c31[j] : 0.f) - aA[r]); }
            *(f32x4*)(GTg + (16 * ct + fr) * 68 + 16 * jt + 4 * fq) = aG; } }
    { const int tt = wave >> 2, jt2 = wave & 3; const bf16x8 MbF = *(const LAS bf16x8*)(Mb + (16 * tt + fr) * 40 + 8 * fq);
        const f32x4 a = mfma16(MbF, tr_frag(KTb + (8 * fq + trow) * 72 + 16 * jt2 + tcol, 4 * 72), z4);
#pragma unroll
        for (int r = 0; r < 4; ++r) { const int t = 16 * tt + 4 * fq + r, j = 16 * jt2 + fr; RQg[t * 72 + j] = (bf16)f2bf(RTf[t * 64 + j] - a[r]); }
        f32x4 y = mfma16(MbF, tr_frag(UVb + (8 * fq + trow) * 72 + 16 * jt2 + tcol, 4 * 72), z4);
        y = mfma16(*(const LAS bf16x8*)(Mk + (16 * tt + fr) * 40 + 8 * fq), tr_frag(Vb + (8 * fq + trow) * 72 + 16 * jt2 + tcol, 4 * 72), y);
        *(f32x4*)(YVTg + (16 * jt2 + fr) * 36 + 16 * tt + 4 * fq) = y; }
    __syncthreads(); }
}
__device__ __forceinline__ void rwkv_stream(const Ctx& c, int bh, int it, int e) {
    const int b = bh / 12, h = bh % 12, lane = c.lane, fr = lane & 15, fq = lane >> 4;
    LAS bf16* Sl = (LAS bf16*)c.lds + c.wave * (16 * 72);
    const unsigned char* chk0 = C_CHK + (size_t)bh * 128 * CHK_BYTES;
    float* ya = C_YA + ((size_t)b * SEQ) * 768 + h * 64 + 16 * it + fr;
    f32x4 S[4];
#pragma unroll
    for (int jt = 0; jt < 4; ++jt) S[jt] = (f32x4){0.f, 0.f, 0.f, 0.f};
    bf16x8 A0[4][2], R0f[2][2], A1[4][2], R1f[2][2]; f32x4 G0[4], Y0[2], G1[4], Y1[2];
#define ST_LOAD(AF, RF, GV, YV, n_) do { const unsigned char* base_ = chk0 + (size_t)(n_) * CHK_BYTES; \
        _Pragma("unroll") for (int jt = 0; jt < 4; ++jt) { _Pragma("unroll") for (int ks = 0; ks < 2; ++ks) AF[jt][ks] = *(const bf16x8*)((const bf16*)(base_ + CK_A) + (16 * jt + fr) * 72 + 32 * ks + 8 * fq); \
            GV[jt] = *(const f32x4*)((const float*)(base_ + CK_GT) + (16 * it + fr) * 68 + 16 * jt + 4 * fq); } \
        _Pragma("unroll") for (int tt = 0; tt < 2; ++tt) { _Pragma("unroll") for (int ks = 0; ks < 2; ++ks) RF[tt][ks] = *(const bf16x8*)((const bf16*)(base_ + CK_RQ) + (16 * tt + fr) * 72 + 32 * ks + 8 * fq); \
            YV[tt] = *(const f32x4*)((const float*)(base_ + CK_YVT) + (16 * it + fr) * 36 + 16 * tt + 4 * fq); } } while (0)
#define ST_STEP(AF, RF, GV, YV, n_, tmax_) do { \
        _Pragma("unroll") for (int jt = 0; jt < 4; ++jt) *(LAS u32x2*)(Sl + fr * 72 + 16 * jt + 4 * fq) = (u32x2){pk2(S[jt][0], S[jt][1]), pk2(S[jt][2], S[jt][3])}; \
        asm volatile("s_waitcnt lgkmcnt(0)" ::: "memory"); \
        const bf16x8 Sf0 = *(const LAS bf16x8*)(Sl + fr * 72 + 8 * fq), Sf1 = *(const LAS bf16x8*)(Sl + fr * 72 + 32 + 8 * fq); \
        asm volatile("s_waitcnt lgkmcnt(0)" ::: "memory"); \
        _Pragma("unroll") for (int tt = 0; tt < 2; ++tt) { f32x4 y_ = mfma16(RF[tt][0], Sf0, YV[tt]); y_ = mfma16(RF[tt][1], Sf1, y_); \
            _Pragma("unroll") for (int r = 0; r < 4; ++r) if (16 * tt + 4 * fq + r < (tmax_)) ya[(size_t)(32 * (n_) + 16 * tt + 4 * fq + r) * 768] = y_[r]; } \
        _Pragma("unroll") for (int jt = 0; jt < 4; ++jt) { f32x4 a_ = mfma16(AF[jt][0], Sf0, GV[jt]); S[jt] = mfma16(AF[jt][1], Sf1, a_); } } while (0)
    ST_LOAD(A0, R0f, G0, Y0, 0);
#pragma unroll 1
    for (int n = 0; n < 128; n += 2) {
        ST_LOAD(A1, R1f, G1, Y1, n + 1);
        ST_STEP(A0, R0f, G0, Y0, n, 32);
        if (n + 2 < 128) ST_LOAD(A0, R0f, G0, Y0, n + 2);
        ST_STEP(A1, R1f, G1, Y1, n + 1, 32);
    }
    float* so = C_OUT + O_RWKV_P + (((size_t)e * 2 + b) * 12 + h) * 4096 + (size_t)(16 * it + fr) * 64 + 4 * fq;
#pragma unroll
    for (int jt = 0; jt < 4; ++jt) *(f32x4*)(so + 16 * jt) = S[jt];
}
__device__ __forceinline__ void rwkv_stream_block(const Ctx& c, int bh, int e) {
    const int b = bh / 12, h = bh % 12, tid = c.tid, lane = c.lane, wave = c.wave, fr = lane & 15, fq = lane >> 4, it = wave;
    LAS unsigned char* slots = c.lds;
    LAS bf16* Sl = (LAS bf16*)(c.lds + 2 * CHK_BYTES) + wave * (16 * 72);
    const unsigned char* g0 = C_CHK + (size_t)bh * 128 * CHK_BYTES + tid * 16;
    float* ya = C_YA + ((size_t)b * SEQ) * 768 + h * 64 + 16 * it + fr;
    f32x4 S[4];
#pragma unroll
    for (int jt = 0; jt < 4; ++jt) S[jt] = (f32x4){0.f, 0.f, 0.f, 0.f};
    u32x4 P0[5], P1[5], P2[5], P3[5];
#define SB_GLOAD(P, n_) do { const int nn_ = (n_) < 128 ? (n_) : 127;     \
        _Pragma("unroll") for (int k = 0; k < 5; ++k) P[k] = *(const u32x4*)(g0 + (size_t)nn_ * CHK_BYTES + k * 8192); } while (0)
#define SB_LWRITE(P, s_) do { _Pragma("unroll") for (int k = 0; k < 5; ++k) *(LAS u32x4*)(slots + (s_) * CHK_BYTES + tid * 16 + k * 8192) = P[k]; } while (0)
#define SB_STEP(s_, n_) do { if (wave < 4) { const LAS unsigned char* sb_ = slots + (s_) * CHK_BYTES; \
        bf16x8 af_[4][2], rf_[2][2]; f32x4 gv_[4], yv_[2];         \
        _Pragma("unroll") for (int jt = 0; jt < 4; ++jt) { const LAS bf16* a_ = (const LAS bf16*)(sb_ + CK_A) + (16 * jt + fr) * 72 + 8 * fq; af_[jt][0] = *(const LAS bf16x8*)a_; af_[jt][1] = *(const LAS bf16x8*)(a_ + 32); \
            gv_[jt] = *(const LAS f32x4*)((const LAS float*)(sb_ + CK_GT) + (16 * it + fr) * 68 + 16 * jt + 4 * fq); } \
        _Pragma("unroll") for (int tt = 0; tt < 2; ++tt) { const LAS bf16* rq_ = (const LAS bf16*)(sb_ + CK_RQ) + (16 * tt + fr) * 72 + 8 * fq; rf_[tt][0] = *(const LAS bf16x8*)rq_; rf_[tt][1] = *(const LAS bf16x8*)(rq_ + 32); \
            yv_[tt] = *(const LAS f32x4*)((const LAS float*)(sb_ + CK_YVT) + (16 * it + fr) * 36 + 16 * tt + 4 * fq); } \
        _Pragma("unroll") for (int jt = 0; jt < 4; ++jt) *(LAS u32x2*)(Sl + fr * 72 + 16 * jt + 4 * fq) = (u32x2){pk2(S[jt][0], S[jt][1]), pk2(S[jt][2], S[jt][3])}; \
        asm volatile("s_waitcnt lgkmcnt(0)" ::: "memory"); \
        const bf16x8 Sf0 = *(const LAS bf16x8*)(Sl + fr * 72 + 8 * fq), Sf1 = *(const LAS bf16x8*)(Sl + fr * 72 + 32 + 8 * fq); \
        asm volatile("s_waitcnt lgkmcnt(0)" ::: "memory"); __builtin_amdgcn_sched_barrier(0); \
        _Pragma("unroll") for (int jt = 0; jt < 4; ++jt) { f32x4 t_ = mfma16(af_[jt][0], Sf0, gv_[jt]); S[jt] = mfma16(af_[jt][1], Sf1, t_); } \
        _Pragma("unroll") for (int tt = 0; tt < 2; ++tt) { f32x4 y_ = mfma16(rf_[tt][0], Sf0, yv_[tt]); y_ = mfma16(rf_[tt][1], Sf1, y_); \
            _Pragma("unroll") for (int r = 0; r < 4; ++r) ya[(size_t)(32 * (n_) + 16 * tt + 4 * fq + r) * 768] = y_[r]; } } } while (0)
    SB_GLOAD(P0, 0); SB_GLOAD(P1, 1); SB_GLOAD(P2, 2); SB_GLOAD(P3, 3);
    SB_LWRITE(P0, 0); __syncthreads();
#pragma unroll 1
    for (int n = 0; n < 128; n += 4) {
        SB_LWRITE(P1, 1); SB_GLOAD(P0, n + 4); SB_STEP(0, n); __syncthreads();
        SB_LWRITE(P2, 0); SB_GLOAD(P1, n + 5); SB_STEP(1, n + 1); __syncthreads();
        SB_LWRITE(P3, 1); SB_GLOAD(P2, n + 6); SB_STEP(0, n + 2); __syncthreads();
        SB_LWRITE(P0, 0); SB_GLOAD(P3, n + 7); SB_STEP(1, n + 3); __syncthreads();
    }
#undef SB_GLOAD
#undef SB_LWRITE
#undef SB_STEP
    if (wave < 4) { float* so = C_OUT + O_RWKV_P + (((size_t)e * 2 + b) * 12 + h) * 4096 + (size_t)(16 * it + fr) * 64 + 4 * fq;
#pragma unroll
        for (int jt = 0; jt < 4; ++jt) *(f32x4*)(so + 16 * jt) = S[jt]; }
}
__device__ __forceinline__ void rwkv_stream_sample(const Ctx& c, int sidx, int it, int e) {
    const int ns = sidx / 12, h = sidx % 12, lane = c.lane, fr = lane & 15, fq = lane >> 4;
    LAS bf16* Sl = (LAS bf16*)c.lds + c.wave * (16 * 72);
    const unsigned char* chk0 = C_CHK + (size_t)(3072 + sidx) * CHK_BYTES;
    float* ya = C_YA + ((size_t)(TP + 4 * ns)) * 768 + h * 64 + 16 * it + fr;
    const float* si = C_IN(2) + (((size_t)e * 8 + ns) * 12 + h) * 4096 + (size_t)(16 * it + fr) * 64 + 4 * fq;
    f32x4 S[4];
#pragma unroll
    for (int jt = 0; jt < 4; ++jt) S[jt] = *(const f32x4*)(si + 16 * jt);
    bf16x8 A0[4][2], R0f[2][2]; f32x4 G0[4], Y0[2];
    ST_LOAD(A0, R0f, G0, Y0, 0);
    ST_STEP(A0, R0f, G0, Y0, 0, 4);
    float* so = C_OUT + O_RWKV_S + (((size_t)e * 8 + ns) * 12 + h) * 4096 + (size_t)(16 * it + fr) * 64 + 4 * fq;
#pragma unroll
    for (int jt = 0; jt < 4; ++jt) *(f32x4*)(so + 16 * jt) = S[jt];
}
#undef ST_LOAD
#undef ST_STEP
__device__ __forceinline__ void phase_even_tok_pre(Ctx c, int l) {
    const int e = l >> 1;
    constexpr int NI = 3072 + 96;
    PreIn A; if (c.bid < NI) rwkv_chunk_preload(c, c.bid, e, A);
    for (int it = c.bid; it < NI; it += c.G) { PreIn B; const int nx = (it + c.G < NI) ? it + c.G : it;
        rwkv_chunk_preload(c, nx, e, B); rwkv_chunk_precompute(c, it, e, A); A = B; }
}
__device__ __forceinline__ void phase_even_scan(Ctx c, int l) {
    const int e = l >> 1;
    if (c.G >= 240) {
        if (c.bid < 24) { for (int rp = 0; rp < REPS; ++rp) { rwkv_stream_block(c, c.bid, e); __syncthreads(); LAUNDER_C(c); } }
        else { Ctx h = c; h.bid = c.bid - 24; h.G = c.G - 24; LAUNDER_C(h);
            if (h.bid < 96) { if (h.wave < 4) rwkv_stream_sample(h, h.bid, h.wave, e); __syncthreads(); }
            even_helper_work(h, l); }
    } else {
        for (int it = c.bid; it < 24; it += c.G) { rwkv_stream_block(c, it, e); __syncthreads(); }
        for (int it = c.bid; it < 96; it += c.G) { if (c.wave < 4) rwkv_stream_sample(c, it, c.wave, e); __syncthreads(); }
        LAUNDER_C(c);
        even_helper_work(c, l);
    }
}
__device__ __forceinline__ void phase_even_ubuild(const Ctx& c, int l) {
    const int e = l >> 1; const float* r_k = C_IN(24) + e * 768; const float* lg = C_IN(25) + e * 768; const float* lb = C_IN(26) + e * 768; const float* muv = C_IN(17) + e * 2432 + EC_V;
    for (int R = c.bid * 8 + c.wave; R < TT; R += c.G * 8) {
        const bool hasprev = (R < TP) ? ((R & (SEQ - 1)) != 0) : (((R - TP) & 3) != 0);
        const float* shiftv = C_IN(3) + ((size_t)e * 8 + ((R >= TP) ? ((R - TP) >> 2) : 0)) * 2432 + EC_V;
        const bf16* hrow = C_HB + (size_t)R * LDH;
#pragma unroll 1
        for (int hb = 0; hb < 12; hb += 4) {
            float y[4], gate[4], cvv[4], pvv[4], bon[4], lgv[4], lbv[4], mv[4];
#pragma unroll
            for (int k = 0; k < 4; ++k) { const int col = (hb + k) * 64 + c.lane;
                y[k] = C_YA[(size_t)R * 768 + col]; gate[k] = bf2f(hrow[EC_GA + col]); cvv[k] = bf2f(hrow[EC_V + col]);
                pvv[k] = hasprev ? bf2f(hrow[EC_V + col - LDH]) : ((R < TP) ? 0.f : shiftv[col]);
                bon[k] = C_BONUS[(size_t)R * 12 + hb + k]; lgv[k] = lg[col]; lbv[k] = lb[col]; mv[k] = muv[col]; }
#pragma unroll
            for (int k = 0; k < 4; ++k) { const int col = (hb + k) * 64 + c.lane;
                const float mean = wave_sum(y[k]) * (1.0f / 64.0f); const float dlt = y[k] - mean; const float var = wave_sum(dlt * dlt) * (1.0f / 64.0f);
                const float yn = dlt * rsqrtf(var + 64e-5f) * lgv[k] + lbv[k];
                const float bonus = bon[k] * (cvv[k] + (pvv[k] - cvv[k]) * mv[k]);
                C_U[(size_t)R * EVEN_OUT + col] = (bf16)f2bf((yn + bonus) * siluf_(gate[k])); }
        }
    }
}

__device__ __forceinline__ void even_combine_dil(const Ctx& c) {
    const int hh = c.lane >> 4, d4 = 4 * (c.lane & 15);
    for (int R0 = c.bid * 8 + c.wave; R0 < TP; R0 += 2 * c.G * 8) {
        const int R1 = (R0 + c.G * 8 < TP) ? R0 + c.G * 8 : R0;
        float ls[2][3]; f32x4 og[2][3]; u32x2 gw[2];
#pragma unroll
        for (int k = 0; k < 2; ++k) { const int R = k ? R1 : R0;
#pragma unroll
            for (int g = 0; g < 3; ++g) { ls[k][g] = C_LSE[((size_t)g * TT + R) * 4 + hh]; og[k][g] = *(const f32x4*)(C_OG + ((size_t)g * TT + R) * 256 + hh * 64 + d4); }
            gw[k] = *(const u32x2*)(C_HB + (size_t)R * LDH + EC_GB + hh * 64 + d4); }
#pragma unroll
        for (int k = 0; k < 2; ++k) { const int R = k ? R1 : R0;
            const float mx = fmaxf(ls[k][0], fmaxf(ls[k][1], ls[k][2])); const float w0 = __expf(ls[k][0] - mx), w1 = __expf(ls[k][1] - mx), w2 = __expf(ls[k][2] - mx); const float inv = 1.0f / (w0 + w1 + w2);
            const f32x4 y = (og[k][0] * w0 + og[k][1] * w1 + og[k][2] * w2) * inv;
            float gt[4]; unpk4(gw[k], gt);
            *(u32x2*)(C_U + (size_t)R * EVEN_OUT + 768 + hh * 64 + d4) = (u32x2){pk2(y.x * siluf_(gt[0]), y.y * siluf_(gt[1])), pk2(y.z * siluf_(gt[2]), y.w * siluf_(gt[3]))}; }
    }
}
__device__ __forceinline__ void rot8(u32x4 w, const float* tb, float scale, float (&y)[8]) {
    float x[8]; unpk8(w, x); const f32x4 t0 = *(const f32x4*)tb, t1 = *(const f32x4*)(tb + 4);
    const float cs[8] = {t0.x, t0.y, t0.z, t0.w, t1.x, t1.y, t1.z, t1.w};
#pragma unroll
    for (int p = 0; p < 4; ++p) { const float co = cs[2 * p], si = cs[2 * p + 1], x0 = x[2 * p], x1 = x[2 * p + 1]; y[2 * p] = (x0 * co - x1 * si) * scale; y[2 * p + 1] = (x1 * co + x0 * si) * scale; }
}
#define C_SB ((bf16*)(c.ap->ws + WS_OG))
__device__ __forceinline__ void ret_s_prepass_item(const Ctx& c, int item) {
    const int bh = item >> 6, ch = item & 63, b = bh / 6, h = bh % 6;
    LAS bf16* Qc = (LAS bf16*)c.lds;
    LAS bf16* Kc = Qc + 64 * 264;
    const float lg = LG2G[h];
    const int tid = c.tid, lane = c.lane, wave = c.wave, fr = lane & 15, fq = lane >> 4, it = wave >> 1, jt0 = (wave & 1) * 2;
    const bf16* g0 = C_HB + ((size_t)b * SEQ + ch * 64) * LDH + h * 256;
    u32x4 tq[4], tk[4];
#pragma unroll
    for (int q = 0; q < 4; ++q) { const int p = tid + 512 * q, row = p >> 5, c8 = (p & 31) * 8; tq[q] = *(const u32x4*)(g0 + (size_t)row * LDH + OC_Q + c8); tk[q] = *(const u32x4*)(g0 + (size_t)row * LDH + OC_K + c8); }
#pragma unroll
    for (int q = 0; q < 4; ++q) { const int p = tid + 512 * q, row = p >> 5, c8 = (p & 31) * 8; *(LAS u32x4*)(Qc + row * 264 + c8) = tq[q]; *(LAS u32x4*)(Kc + row * 264 + c8) = tk[q]; }
    __syncthreads();
    f32x4 accS[2];
#pragma unroll
    for (int q = 0; q < 2; ++q) accS[q] = (f32x4){0.f, 0.f, 0.f, 0.f};
#pragma unroll
    for (int kp = 0; kp < 4; ++kp) { bf16x8 Qf2[2], Kf2[2][2];
#pragma unroll
        for (int kk = 0; kk < 2; ++kk) { const int ks = 2 * kp + kk; Qf2[kk] = *(const LAS bf16x8*)(Qc + (16 * it + fr) * 264 + 32 * ks + 8 * fq);
#pragma unroll
            for (int q = 0; q < 2; ++q) Kf2[kk][q] = *(const LAS bf16x8*)(Kc + (16 * (jt0 + q) + fr) * 264 + 32 * ks + 8 * fq); }
        asm volatile("s_waitcnt lgkmcnt(0)" ::: "memory"); __builtin_amdgcn_sched_barrier(0);
#pragma unroll
        for (int kk = 0; kk < 2; ++kk)
#pragma unroll
            for (int q = 0; q < 2; ++q) accS[q] = mfma16(Qf2[kk], Kf2[kk][q], accS[q]); }
    bf16* sb = C_SB + (size_t)item * 4096;
#pragma unroll
    for (int jj = 0; jj < 2; ++jj) { const int jt = jt0 + jj;
#pragma unroll
        for (int r = 0; r < 4; ++r) { const int i = 16 * it + 4 * fq + r, j = 16 * jt + fr; const float val = (i >= j) ? accS[jj][r] * exp2f(lg * (float)(i - j)) : 0.f; sb[i * 64 + j] = (bf16)f2bf(val); } }
    __syncthreads();
}
__device__ __forceinline__ void ret_prompt_unit(const Ctx& c, int unit, int o) {
    const int b = unit / 48, h = (unit >> 3) % 6, es = unit & 7;
    LAS bf16* Qc = (LAS bf16*)c.lds;
    LAS bf16* Kc = Qc + 64 * 264;
    LAS bf16* Vc = Kc + 64 * 264;
    LAS bf16* Vz = Vc + 64 * 40;
    LAS bf16* Rt = Vz + 64 * 40;
    const float lg = LG2G[h];
    const int tid = c.tid, lane = c.lane, wave = c.wave, fr = lane & 15, fq = lane >> 4, it = wave >> 1, eto = wave & 1;
    f32x4 Racc[2][2];
#pragma unroll
    for (int a = 0; a < 2; ++a)
#pragma unroll
        for (int q = 0; q < 2; ++q) Racc[a][q] = (f32x4){0.f, 0.f, 0.f, 0.f};
    for (int i = tid; i < 32 * 264 / 2; i += 512) ((LAS unsigned*)Rt)[i] = 0u;
    const float g64 = exp2f(lg * 64.f);
    const int vj = (tid & 255) >> 2, vp = tid & 3; const float zeta = exp2f(lg * (float)(63 - vj));
    const bf16* g0 = C_HB + ((size_t)b * SEQ) * LDH + h * 256;
    const bf16* gv = C_HB + ((size_t)b * SEQ + vj) * LDH + OC_V + h * 256 + es * 32 + vp * 8;
    const bf16* gs = C_SB + (size_t)((b * 6 + h) * 64) * 4096 + (16 * it + fr) * 64 + 8 * fq;
    u32x4 pq[4], pk[4], pv; bf16x8 sfn[2];
#pragma unroll
    for (int q = 0; q < 4; ++q) { const int p = tid + 512 * q, row = p >> 5, c8 = (p & 31) * 8; pq[q] = *(const u32x4*)(g0 + (size_t)row * LDH + OC_Q + c8); pk[q] = *(const u32x4*)(g0 + (size_t)row * LDH + OC_K + c8); }
    pv = *(const u32x4*)gv; sfn[0] = *(const bf16x8*)gs; sfn[1] = *(const bf16x8*)(gs + 32);
    const int trow = (lane & 15) >> 2, tcol = 4 * (lane & 3);
#pragma unroll 1
    for (int ch = 0; ch < 64; ++ch) {
        const size_t row0 = (size_t)b * SEQ + ch * 64;
#pragma unroll
        for (int q = 0; q < 4; ++q) { const int p = tid + 512 * q, row = p >> 5, c8 = (p & 31) * 8; *(LAS u32x4*)(Qc + row * 264 + c8) = pq[q]; *(LAS u32x4*)(Kc + row * 264 + c8) = pk[q]; }
        if (wave < 4) { *(LAS u32x4*)(Vc + vj * 40 + vp * 8) = pv; float x[8]; unpk8(pv, x);
            *(LAS u32x4*)(Vz + vj * 40 + vp * 8) = (u32x4){pk2(x[0] * zeta, x[1] * zeta), pk2(x[2] * zeta, x[3] * zeta), pk2(x[4] * zeta, x[5] * zeta), pk2(x[6] * zeta, x[7] * zeta)}; }
        const bf16x8 Sf0 = sfn[0], Sf1 = sfn[1];
        { const int cn = (ch + 1 < 64) ? ch + 1 : 63; const size_t adv = (size_t)cn * 64 * LDH;
#pragma unroll
            for (int q = 0; q < 4; ++q) { const int p = tid + 512 * q, row = p >> 5, c8 = (p & 31) * 8; pq[q] = *(const u32x4*)(g0 + adv + (size_t)row * LDH + OC_Q + c8); pk[q] = *(const u32x4*)(g0 + adv + (size_t)row * LDH + OC_K + c8); }
            pv = *(const u32x4*)(gv + adv); sfn[0] = *(const bf16x8*)(gs + (size_t)cn * 4096); sfn[1] = *(const bf16x8*)(gs + (size_t)cn * 4096 + 32); }
        __syncthreads();
        f32x4 accQ = (f32x4){0.f, 0.f, 0.f, 0.f};
        { bf16x8 Qf[8], Rf[8];
#pragma unroll
            for (int ks = 0; ks < 8; ++ks) { Qf[ks] = *(const LAS bf16x8*)(Qc + (16 * it + fr) * 264 + 32 * ks + 8 * fq); Rf[ks] = *(const LAS bf16x8*)(Rt + (16 * eto + fr) * 264 + 32 * ks + 8 * fq); }
            asm volatile("s_waitcnt lgkmcnt(0)" ::: "memory"); __builtin_amdgcn_sched_barrier(0);
#pragma unroll
            for (int ks = 0; ks < 8; ++ks) accQ = mfma16(Qf[ks], Rf[ks], accQ); }
        { bf16x8 Vfr[2], Kfr[2][2], Zfr[2][2];
#pragma unroll
            for (int k2 = 0; k2 < 2; ++k2) { Vfr[k2] = tr_frag(Vc + (32 * k2 + 8 * fq + trow) * 40 + 16 * eto + tcol, 4 * 40);
#pragma unroll
                for (int dd = 0; dd < 2; ++dd) Kfr[dd][k2] = tr_frag(Kc + (32 * k2 + 8 * fq + trow) * 264 + 16 * (2 * wave + dd) + tcol, 4 * 264);
#pragma unroll
                for (int et = 0; et < 2; ++et) Zfr[et][k2] = tr_frag(Vz + (32 * k2 + 8 * fq + trow) * 40 + 16 * et + tcol, 4 * 40); }
            asm volatile("s_waitcnt lgkmcnt(0)" ::: "memory"); __builtin_amdgcn_sched_barrier(0);
            { f32x4 a2 = mfma16(Sf0, Vfr[0], (f32x4){0.f, 0.f, 0.f, 0.f}); a2 = mfma16(Sf1, Vfr[1], a2);
#pragma unroll
                for (int r = 0; r < 4; ++r) { const int i = 16 * it + 4 * fq + r; C_YR[(row0 + i) * 1536 + h * 256 + es * 32 + 16 * eto + fr] = a2[r] + accQ[r] * exp2f(lg * (float)(i + 1)); } }
#pragma unroll
            for (int dd = 0; dd < 2; ++dd)
#pragma unroll
                for (int et = 0; et < 2; ++et) { f32x4 a = Racc[dd][et] * g64; a = mfma16(Kfr[dd][0], Zfr[et][0], a); Racc[dd][et] = mfma16(Kfr[dd][1], Zfr[et][1], a); } }
        __syncthreads();
#pragma unroll
        for (int dd = 0; dd < 2; ++dd)
#pragma unroll
            for (int et = 0; et < 2; ++et) { const f32x4 a = Racc[dd][et]; const int dt = 2 * wave + dd;
                *(LAS u32x2*)(Rt + (16 * et + fr) * 264 + 16 * dt + 4 * fq) = (u32x2){pk2(a[0], a[1]), pk2(a[2], a[3])}; }
    }
    int fq_l = fq; asm volatile("" : "+v"(fq_l));
    float* ro = C_OUT + O_RET_P + ((((size_t)o * 2 + b) * 6 + h) * 256) * 256 + es * 32;
#pragma unroll
    for (int dd = 0; dd < 2; ++dd)
#pragma unroll
        for (int et = 0; et < 2; ++et)
#pragma unroll
            for (int r = 0; r < 4; ++r) ro[(size_t)(16 * (2 * wave + dd) + 4 * fq_l + r) * 256 + 16 * et + fr] = Racc[dd][et][r];
    __syncthreads();
}
__device__ __forceinline__ void ret_sample_unit(const Ctx& c, int unit, int o) {
    const int n = unit / 6, h = unit % 6, tid = c.tid;
    LAS float* qs = (LAS float*)c.lds; LAS float* ks = qs + 1024; LAS float* vs = ks + 1024; LAS float* red = vs + 1024; LAS float* sc = red + 2048;
    const float lg = LG2G[h];
    for (int idx = tid; idx < 4 * 256; idx += 512) { const int t = idx >> 8, dd = idx & 255; const bf16* hr = C_HB + (size_t)(TP + n * 4 + t) * LDH + h * 256 + dd; qs[idx] = bf2f(hr[OC_Q]); ks[idx] = bf2f(hr[OC_K]); }
    for (int idx = tid; idx < 4 * 256; idx += 512) { const int t = idx >> 8, ee = idx & 255; vs[idx] = bf2f(C_HB[(size_t)(TP + n * 4 + t) * LDH + OC_V + h * 256 + ee]); }
    __syncthreads();
    if (tid < 16) { const int i = tid >> 2, j = tid & 3; float a = 0.f; for (int d = 0; d < 256; ++d) a += qs[i * 256 + d] * ks[j * 256 + d]; sc[tid] = (j <= i) ? a * exp2f(lg * (float)(i - j)) : 0.f; }
    __syncthreads();
    const int ee = tid & 255, dh = tid >> 8;
    const float* R0 = C_IN(7) + ((((size_t)o * 8 + n) * 6 + h) * 256) * 256; float* Rn = C_OUT + O_RET_S + ((((size_t)o * 8 + n) * 6 + h) * 256) * 256;
    const float g4 = exp2f(lg * 4.f), z0 = exp2f(lg * 3.f), z1 = exp2f(lg * 2.f), z2 = exp2f(lg), z3 = 1.0f;
    const float v0 = vs[ee] * z0, v1 = vs[256 + ee] * z1, v2 = vs[512 + ee] * z2, v3 = vs[768 + ee] * z3;
    float acc[4] = {0.f, 0.f, 0.f, 0.f};
#pragma unroll 4
    for (int d = dh * 128; d < dh * 128 + 128; ++d) { const float r0 = R0[(size_t)d * 256 + ee];
        acc[0] += qs[d] * r0; acc[1] += qs[256 + d] * r0; acc[2] += qs[512 + d] * r0; acc[3] += qs[768 + d] * r0;
        Rn[(size_t)d * 256 + ee] = g4 * r0 + ks[d] * v0 + ks[256 + d] * v1 + ks[512 + d] * v2 + ks[768 + d] * v3; }
#pragma unroll
    for (int i = 0; i < 4; ++i) red[(dh * 4 + i) * 256 + ee] = acc[i];
    __syncthreads();
    if (dh == 0) {
#pragma unroll
        for (int i = 0; i < 4; ++i) { float ov = (red[i * 256 + ee] + red[(4 + i) * 256 + ee]) * exp2f(lg * (float)(i + 1));
            for (int j = 0; j <= i; ++j) ov += sc[i * 4 + j] * vs[j * 256 + ee];
            C_YR[(size_t)(TP + n * 4 + i) * 1536 + h * 256 + ee] = ov; } }
    __syncthreads();
}
__device__ __forceinline__ void odd_helper_work(Ctx c, int l) {
    mem_attn_all(c, l, OC_QM, OC_GM, 1536, ODD_OUT);
    LAUNDER_C(c);
    if (l < 3) convert_layer_weights(c, l + 1);
}
__device__ __forceinline__ void phase_odd_tok(Ctx c, int l) {
    const int o = l >> 1;
    if (c.G >= 200) {
        if (c.bid < 96) ret_prompt_unit(c, c.bid, o);
        else if (c.bid < 144) ret_sample_unit(c, c.bid - 96, o);
        else { Ctx h = c; h.bid = c.bid - 144; h.G = c.G - 144; odd_helper_work(h, l); }
    } else {
        for (int it = c.bid; it < 144; it += c.G) { if (it < 96) ret_prompt_unit(c, it, o); else ret_sample_unit(c, it - 96, o); }
        LAUNDER_C(c);
        odd_helper_work(c, l);
    }
}
__device__ __forceinline__ void phase_odd_ubuild(const Ctx& c) {
    for (int R = c.bid * 8 + c.wave; R < TT; R += c.G * 8) {
#pragma unroll 1
        for (int hb = 0; hb < 6; hb += 3) {
            f32x4 ov[3]; u32x2 gw[3];
#pragma unroll
            for (int k = 0; k < 3; ++k) { const int col = (hb + k) * 256 + 4 * c.lane; ov[k] = *(const f32x4*)(C_YR + (size_t)R * 1536 + col); gw[k] = *(const u32x2*)(C_HB + (size_t)R * LDH + OC_G + col); }
#pragma unroll
            for (int k = 0; k < 3; ++k) { const int col = (hb + k) * 256 + 4 * c.lane; const f32x4 o = ov[k];
                const float ss = wave_sum(o.x * o.x + o.y * o.y + o.z * o.z + o.w * o.w); const float scl = rsqrtf(ss * (1.0f / 256.0f) + 1e-6f);
                float g[4]; unpk4(gw[k], g);
                *(u32x2*)(C_U + (size_t)R * DM + col) = (u32x2){pk2(o.x * scl * siluf_(g[0]), o.y * scl * siluf_(g[1])), pk2(o.z * scl * siluf_(g[2]), o.w * scl * siluf_(g[3]))}; }
        }
    }
}
__device__ __forceinline__ void small_outproj(const Ctx& c, int wt, int K, int l) {
    const int lane = c.lane, r = lane & 31, hl = lane >> 5, nks = K / 128;
    const bf16* ap = C_U + (size_t)(TP + r) * K + 8 * hl + c.wave * nks * 16; const bf16* bp = C_WTOUT_L(l) + (size_t)(32 * wt + r) * K + 8 * hl + c.wave * nks * 16;
    f32x16 acc;
#pragma unroll
    for (int i = 0; i < 16; ++i) acc[i] = 0.f;
    if (nks == 16) {
#pragma unroll
        for (int ks = 0; ks < 16; ++ks) acc = mfma32(*(const bf16x8*)(ap + 16 * ks), *(const bf16x8*)(bp + 16 * ks), acc);
    } else {
#pragma unroll
        for (int ks = 0; ks < 12; ++ks) acc = mfma32(*(const bf16x8*)(ap + 16 * ks), *(const bf16x8*)(bp + 16 * ks), acc);
    }
    LAS float* part = (LAS float*)c.lds;
#pragma unroll
    for (int i = 0; i < 16; ++i) part[(c.wave * 16 + i) * 64 + lane] = acc[i];
    __syncthreads();
    for (int idx = c.tid; idx < 1024; idx += 512) { float sum = 0.f;
#pragma unroll
        for (int w = 0; w < 8; ++w) sum += part[w * 1024 + idx];
        const int i = idx >> 6, ln = idx & 63, row = TP + (i & 3) + 8 * (i >> 2) + 4 * (ln >> 5), col = 32 * wt + (ln & 31);
        C_Z[(size_t)row * DM + col] = C_XZ[(size_t)row * DM + col] * ALPHA + sum; }
    __syncthreads();
}
__device__ __forceinline__ void phase_ln(const Ctx& c, int l) {
    const float* g = C_IN(15) + l * DM; const float* bta = C_IN(16) + l * DM;
    f32x4 gg[8], bb[8];
#pragma unroll
    for (int j = 0; j < 8; ++j) { const int col = 4 * c.lane + 256 * j; gg[j] = *(const f32x4*)(g + col); bb[j] = *(const f32x4*)(bta + col); }
    for (int R0 = c.bid * 8 + c.wave; R0 < TT; R0 += 2 * c.G * 8) {
        const int R1 = R0 + c.G * 8; const bool has1 = R1 < TT; const int R1c = has1 ? R1 : R0;
        f32x4 v0[8], v1[8]; float s0 = 0.f, s1 = 0.f;
        { const f32x4* z0 = (const f32x4*)(C_Z + (size_t)R0 * DM) + c.lane; const f32x4* z1 = (const f32x4*)(C_Z + (size_t)R1c * DM) + c.lane;
#pragma unroll
            for (int j = 0; j < 8; ++j) { v0[j] = z0[64 * j]; v1[j] = z1[64 * j]; } }
#pragma unroll
        for (int j = 0; j < 8; ++j) { s0 += (v0[j].x + v0[j].y) + (v0[j].z + v0[j].w); s1 += (v1[j].x + v1[j].y) + (v1[j].z + v1[j].w); }
        const float m0 = wave_sum(s0) * (1.0f / DM), m1 = wave_sum(s1) * (1.0f / DM); float q0 = 0.f, q1 = 0.f;
#pragma unroll
        for (int j = 0; j < 8; ++j) { v0[j] = v0[j] - m0; v1[j] = v1[j] - m1; q0 += (v0[j].x * v0[j].x + v0[j].y * v0[j].y) + (v0[j].z * v0[j].z + v0[j].w * v0[j].w); q1 += (v1[j].x * v1[j].x + v1[j].y * v1[j].y) + (v1[j].z * v1[j].z + v1[j].w * v1[j].w); }
        const float r0 = rsqrtf(wave_sum(q0) * (1.0f / DM) + LN_EPS), r1 = rsqrtf(wave_sum(q1) * (1.0f / DM) + LN_EPS);
        float* d0 = (l == 3) ? (R0 < TP ? C_OUT + O_YP + (size_t)R0 * DM : C_OUT + O_YS + (size_t)(R0 - TP) * DM) : C_XZ + (size_t)R0 * DM;
        float* d1 = (l == 3) ? (R1c < TP ? C_OUT + O_YP + (size_t)R1c * DM : C_OUT + O_YS + (size_t)(R1c - TP) * DM) : C_XZ + (size_t)R1c * DM;
#pragma unroll
        for (int j = 0; j < 8; ++j) { const int col = 4 * c.lane + 256 * j;
            const f32x4 x0 = v0[j] * r0 * gg[j] + bb[j]; *(f32x4*)(d0 + col) = x0; if (l != 3) *(u32x2*)(C_XB + (size_t)R0 * DM + col) = (u32x2){pk2(x0.x, x0.y), pk2(x0.z, x0.w)};
            if (has1) { const f32x4 x1 = v1[j] * r1 * gg[j] + bb[j]; *(f32x4*)(d1 + col) = x1; if (l != 3) *(u32x2*)(C_XB + (size_t)R1 * DM + col) = (u32x2){pk2(x1.x, x1.y), pk2(x1.z, x1.w)}; } }
    }
}

#define XB_TMO      128
#define XB_XCNT(j)  (256  + 64 * (j))
#define XB_XSUB(j)  (1280 + 64 * (j))
#define XB_XGEN(j)  (2304 + 64 * (j))
#define XB_TOP      3328
#define XB_TOPGEN   3392
#define XCD_BAR_WORDS 3456
#define XB_SPIN_CAP (1u << 18)

__device__ __forceinline__ unsigned xb_ld(unsigned* p)              { return __hip_atomic_load(p, __ATOMIC_RELAXED, __HIP_MEMORY_SCOPE_AGENT); }
__device__ __forceinline__ unsigned xb_add(unsigned* p, unsigned v) { return __hip_atomic_fetch_add(p, v, __ATOMIC_RELAXED, __HIP_MEMORY_SCOPE_AGENT); }
__device__ __forceinline__ unsigned xb_xcc_id() { return (unsigned)__builtin_amdgcn_s_getreg((3 << 11) | 20) & 0xFu; }
#define XB_SPIN(cond, bar) do { unsigned _sp = 0; while (cond) { __builtin_amdgcn_s_sleep(1); \
    if ((++_sp & 255u) == 0u) { if (xb_ld(&(bar)[XB_TMO])) break; if (_sp > XB_SPIN_CAP) { atomicAdd(&(bar)[XB_TMO], 1u); break; } } } } while (0)

struct XcdBarrier {
    unsigned* bar; unsigned x;
    volatile LAS unsigned* st;
};

__device__ __forceinline__ XcdBarrier xcd_barrier_post(unsigned* bar, volatile LAS unsigned* st) {
    XcdBarrier b; b.bar = bar; b.x = xb_xcc_id(); b.st = st;
    if (threadIdx.x == 0) (void)xb_add(&bar[XB_XCNT(b.x)], 1u);
    return b;
}
__device__ __forceinline__ void xcd_barrier_complete(unsigned* bar, unsigned x, unsigned& nloc, unsigned& nx) {
    const unsigned G = gridDim.x * gridDim.y * gridDim.z;
    unsigned sum, cnt, mine, sp = 0u;
    for (;;) {
        sum = 0u; cnt = 0u; mine = 0u;
#pragma unroll
        for (unsigned j = 0; j < 16; ++j) { const unsigned c = xb_ld(&bar[XB_XCNT(j)]); sum += c; cnt += (c > 0u) ? 1u : 0u; mine = (j == x) ? c : mine; }
        if (sum == G) break;
        __builtin_amdgcn_s_sleep(1);
        if ((++sp & 255u) == 0u) { if (xb_ld(&bar[XB_TMO])) break; if (sp > XB_SPIN_CAP) { atomicAdd(&bar[XB_TMO], 1u); break; } }
    }
    nloc = mine > 0u ? mine : 1u; nx = cnt > 0u ? cnt : 1u;
}

__device__ __forceinline__ void xcd_barrier(const XcdBarrier& b) {
    asm volatile("s_waitcnt vmcnt(0)" ::: "memory");
    __syncthreads();
    if (threadIdx.x == 0) {
        unsigned* bar = b.bar;
        __builtin_amdgcn_s_waitcnt(0);
        unsigned nloc = b.st[0], nx = b.st[1];
        if (nloc == 0u) { xcd_barrier_complete(bar, b.x, nloc, nx); b.st[0] = nloc; b.st[1] = nx; }
        const unsigned old = xb_add(&bar[XB_XSUB(b.x)], 1u);
        const unsigned gen = old / nloc;
        if (old + 1u == (gen + 1u) * nloc) {
            __builtin_amdgcn_fence(__ATOMIC_RELEASE, "agent");
            asm volatile("s_waitcnt vmcnt(0)" ::: "memory");
            const unsigned og = xb_add(&bar[XB_TOP], 1u);
            const unsigned tg = og / nx;
            if (og + 1u == (tg + 1u) * nx) xb_add(&bar[XB_TOPGEN], 1u);
            else XB_SPIN(xb_ld(&bar[XB_TOPGEN]) == tg, bar);
            __builtin_amdgcn_fence(__ATOMIC_ACQUIRE, "agent");
            xb_add(&bar[XB_XGEN(b.x)], 1u);
            asm volatile("s_waitcnt vmcnt(0)" ::: "memory");
        } else {
            XB_SPIN(xb_ld(&bar[XB_XGEN(b.x)]) == gen, bar);
            __builtin_amdgcn_fence(__ATOMIC_ACQUIRE, "agent");
            asm volatile("s_waitcnt vmcnt(0)" ::: "memory");
        }
    }
    __syncthreads();
}

constexpr int NPH = 25;
__global__ void __launch_bounds__(512, 2) mk(Args args) {
    extern __shared__ __attribute__((aligned(16))) unsigned char lds_raw[];
    Ctx c;
    c.ap = (ArgsP)__builtin_amdgcn_kernarg_segment_ptr(); c.lds = (LAS unsigned char*)lds_raw;
    c.tid = threadIdx.x; c.lane = c.tid & 63; c.wave = __builtin_amdgcn_readfirstlane(c.tid >> 6); c.bid = blockIdx.x; c.G = gridDim.x;
    for (int u = c.tid; u < 16; u += 512) ((LAS unsigned*)(c.lds + 131072))[u] = 0u;
    __syncthreads();
    XcdBarrier xbar = xcd_barrier_post((unsigned*)(c.ap->ws + WS_CTL) + 4096, (volatile LAS unsigned*)(c.lds + 131072));
#define LAUNDER() do { asm volatile("" : "+s"(c.ap), "+v"(c.tid), "+s"(c.bid), "+s"(c.G)); c.lane = c.tid & 63; c.wave = __builtin_amdgcn_readfirstlane(c.tid >> 6); } while (0)
    const int lo = args.ph_lo, hi = args.ph_hi;
#define IN(k) (lo <= (k) && (k) < hi)
#if USE_CG
#define SEAM(k) do { if (IN(k) && IN((k) + 1)) { cg::this_grid().sync(); } } while (0)
#else
#define SEAM(k) do { if (IN(k) && IN((k) + 1)) { asm volatile("" : "+s"(xbar.bar)); xcd_barrier(xbar); } } while (0)
#endif
    #if !(DIS & 1)
    if (IN(0)) { for (int rep = 0; rep < ((DUP & 128) ? 2 : 1); ++rep) { LAUNDER(); phase_prologue(c); if (DUP & 128) { asm volatile("" : "+s"(xbar.bar)); xcd_barrier(xbar); } } }
#endif
    SEAM(0);
#pragma unroll 1
    for (int l = 0; l < 4; ++l) {
        const int p0 = 1 + 6 * l; const bool even = (l & 1) == 0;
#if !(DIS & 2)
        if (IN(p0)) { for (int rep = 0; rep < ((DUP & 16) ? 2 : 1); ++rep) { LAUNDER();
            if (l == 0) { pg8::Gemm g{C_MEMB, C_WTMEM, 512, 4096, DM}; pg8::StaticOrder S; S.init(512, 4096, c.G, (c.bid + c.G - c.G / 2) % c.G);
                pg8::EpiF32Split E{C_OUT + O_MEM, 1024, 1024, (size_t)512 * 1024, C_MKVB};
                pg8::gemm_phase<pg8::EpiF32Split, pg8::StaticOrder, true, true>(c.lds, g, S, E); }
            const int ngemm = (l == 0) ? 5 : 1;
#pragma unroll 1
            for (int gi = 0; gi < ngemm; ++gi) {
                const int NI = even ? EVEN_INP : ODD_IN;
                const bf16* A = gi ? C_WTMEM + ((size_t)(gi - 1) * 1024 + 512) * DM : C_XB; const bf16* Bt = gi ? C_MEMB : C_WTIN;
                const int Mg = gi ? 512 : MPAD, Ng = gi ? 512 : NI;
                bf16* Og = gi ? C_VT + (size_t)(gi - 1) * 512 * 512 : C_HB; const int ldo = gi ? 512 : LDH;
                pg8::Gemm g{A, Bt, Mg, Ng, DM}; pg8::StaticOrder S; S.init(Mg, Ng, c.G, gi ? (c.bid + 2 * c.G - (5 * c.G) / 8 - 8 * (gi - 1)) % c.G : c.bid); pg8::EpiBf16NP E{Og, ldo, C_TAB, (gi == 0 && !even) ? 3072 : 0, 1536};
                pg8::gemm_phase<pg8::EpiBf16NP, pg8::StaticOrder, true, true>(c.lds, g, S, E);
            }
            if (DUP & 16) { asm volatile("" : "+s"(xbar.bar)); xcd_barrier(xbar); }
        } }
#endif
        SEAM(p0);
#if !(DIS & 4)
        if (IN(p0 + 1)) { for (int rep = 0; rep < ((DUP & 1) ? 2 : 1); ++rep) { LAUNDER(); if (even) phase_even_tok_pre(c, l); if (DUP & 1) { asm volatile("" : "+s"(xbar.bar)); xcd_barrier(xbar); } } }
#endif
#if !(DIS & 8)
        if (IN(p0 + 1)) { LAUNDER(); if (!even) { for (int it = c.bid; it < 768; it += c.G) ret_s_prepass_item(c, it); } }
#endif
        SEAM(p0 + 1);
#if !(DIS & 16)
        if (IN(p0 + 2)) { for (int rep = 0; rep < ((DUP & 4) ? 2 : 1); ++rep) { LAUNDER(); if (even) phase_even_scan(c, l); if (DUP & 4) { asm volatile("" : "+s"(xbar.bar)); xcd_barrier(xbar); } } }
#if !(DIS & 8)
        if (IN(p0 + 2)) { for (int rep = 0; rep < ((DUP & 2) ? 2 : 1); ++rep) { LAUNDER(); if (!even) phase_odd_tok(c, l); if (DUP & 2) { asm volatile("" : "+s"(xbar.bar)); xcd_barrier(xbar); } } }
#endif
#endif
        SEAM(p0 + 2);
#if !(DIS & 32)
        if (IN(p0 + 3)) { for (int rep = 0; rep < ((DUP & 8) ? 2 : 1); ++rep) { LAUNDER(); if (even) { phase_even_ubuild(c, l); LAUNDER(); even_combine_dil(c); } else phase_odd_ubuild(c); if (DUP & 8) { asm volatile("" : "+s"(xbar.bar)); xcd_barrier(xbar); } } }
#endif
        SEAM(p0 + 3);
#if !(DIS & 64)
        if (IN(p0 + 4)) { for (int rep = 0; rep < ((DUP & 32) ? 2 : 1); ++rep) { LAUNDER(); const int K = even ? EVEN_OUT : ODD_OUT;
            pg8::Gemm g{C_U, C_WTOUT_L(l), TP, DM, K}; pg8::StaticOrder S; S.init(TP, DM, c.G, c.bid); pg8::EpiResid E{C_XZ, C_Z, DM, ALPHA};
            pg8::gemm_phase<pg8::EpiResid, pg8::StaticOrder, true, true>(c.lds, g, S, E);
            LAUNDER(); if (c.bid < 64) small_outproj(c, c.bid, K, l); if (DUP & 32) { asm volatile("" : "+s"(xbar.bar)); xcd_barrier(xbar); } } }
#endif
        SEAM(p0 + 4);
#if !(DIS & 128)
        if (IN(p0 + 5)) { for (int rep = 0; rep < ((DUP & 64) ? 2 : 1); ++rep) { LAUNDER(); phase_ln(c, l); if (DUP & 64) { asm volatile("" : "+s"(xbar.bar)); xcd_barrier(xbar); } } }
#endif
        SEAM(p0 + 5);
    }
#undef IN
#undef SEAM
}

extern "C" void kernel_launch(void* const* d_in, const int* in_sizes, int n_in, void* d_out, int out_size, void* d_ws, size_t ws_size, hipStream_t stream) {
    static int grid = 0;
    if (grid == 0) {
        if (n_in != 27 || (size_t)out_size != O_END || ws_size < WS_END) { fprintf(stderr, "kernel_launch: unexpected shapes: n_in %d out %d ws %zu (need %zu)\n", n_in, out_size, ws_size, (size_t)WS_END); grid = -1; return; }
        int dev = 0, cus = 0, per_cu = 0;
        hipGetDevice(&dev); hipDeviceGetAttribute(&cus, hipDeviceAttributeMultiprocessorCount, dev);
        if (hipFuncSetAttribute((const void*)mk, hipFuncAttributeMaxDynamicSharedMemorySize, LDS_BYTES) != hipSuccess) { fprintf(stderr, "kernel_launch: hipFuncSetAttribute failed\n"); grid = -1; return; }
        if (hipOccupancyMaxActiveBlocksPerMultiprocessor(&per_cu, (const void*)mk, 512, LDS_BYTES) != hipSuccess || per_cu < 1) { fprintf(stderr, "kernel_launch: occupancy query says %d\n", per_cu); per_cu = 1; }
        (void)hipGetLastError();
        grid = cus;
        fprintf(stderr, "kernel_launch: grid %d (cus %d, per_cu %d)\n", grid, cus, per_cu);
    }
    if (grid < 0) return;
    if (hipMemsetAsync((char*)d_ws + WS_CTL, 0, 1u << 20, stream) != hipSuccess) { fprintf(stderr, "kernel_launch: memset failed\n"); return; }
    Args a{};
    for (int i = 0; i < 27; ++i) a.in[i] = (const float*)d_in[i];
    a.out = (float*)d_out; a.ws = (unsigned char*)d_ws;
#if ONE_LAUNCH
    a.ph_lo = 0; a.ph_hi = NPH;
    void* kargs[] = {&a};
    hipError_t e = hipLaunchCooperativeKernel((const void*)mk, dim3(grid), dim3(512), kargs, LDS_BYTES, stream);
    if (e != hipSuccess) fprintf(stderr, "kernel_launch: cooperative launch failed: %s\n", hipGetErrorString(e));
#else
    for (int p = 0; p < NPH; ++p) {
        if (p >= 1 && ((p - 1) % 6) == 2 && (((p - 1) / 6) & 1)) continue;
        a.ph_lo = p; a.ph_hi = p + 1;
        hipLaunchKernelGGL(mk, dim3(grid), dim3(512), LDS_BYTES, stream, a);
    }
#endif
}
```

```cpp
#include <hip/hip_runtime.h>
#include <hip/hip_cooperative_groups.h>
#include <cstdio>
#include <cstdint>
namespace cg = cooperative_groups;
#ifndef DIS
#define DIS 0
#endif
#ifndef REPD
#define REPD 1
#endif
#ifndef REPM
#define REPM 1
#endif
#ifndef REPC
#define REPC 1
#endif
#ifndef REPS
#define REPS 1
#endif
#ifndef REP9
#define REP9 1
#endif
#ifndef REP3
#define REP3 1
#endif
#ifndef REP8
#define REP8 1
#endif
#ifndef REP1
#define REP1 1
#endif
#ifndef DUP
#define DUP 0
#endif
#ifndef USE_CG
#define USE_CG 0
#endif
#ifndef ONE_LAUNCH
#define ONE_LAUNCH 1
#endif
namespace pg8 {
#define PG8_LAS __attribute__((address_space(3)))
typedef unsigned short bf16_t;
typedef short bf16x8 __attribute__((ext_vector_type(8)));
typedef float f32x4 __attribute__((ext_vector_type(4)));
typedef unsigned u32x4 __attribute__((ext_vector_type(4)));
constexpr int BM = 256, BK = 64, HALF = 128, HTB = HALF * BK * 2  , STAGE_BYTES = 8 * HTB, NXCD = 8, WGM = 8;

__host__ __device__ __forceinline__ int lds_byte(int r, int c) { const int st = (r >> 4) * 2 + (c >> 5), rr = r & 15, cc = c & 31, ob = rr * 64 + cc * 2; return st * 1024 + (ob ^ (((ob >> 9) & 1) << 5)); }
__host__ __device__ __forceinline__ void stage_rc(int b, int& R, int& C) { const int st = b / 1024, sb = b % 1024, swz = sb ^ (((sb >> 9) & 1) << 5); R = (st >> 1) * 16 + swz / 64; C = (st & 1) * 32 + (swz % 64) / 2; }
__host__ __device__ __forceinline__ int perm32(int rho) { const int n = rho >> 4, i = rho & 15; return 8 * (i >> 2) + 4 * n + (i & 3); }

struct Unit { int pm, pn; };
struct Gemm { const bf16_t* A; const bf16_t* Bt; int M, N, K; };

struct StaticOrder {
    int nM, nN, nwg, G, c;
    __host__ __device__ void init(int M, int N, int G_, int c_) { nM = M / BM; nN = N / BM; nwg = nM * nN; G = G_; c = c_; }
    __host__ __device__ bool next(int i, Unit& u) const {
        const long L = (long)i * G + c; if (L >= nwg) return false;
        int wgid = (int)L; { const int q = nwg / NXCD, r = nwg % NXCD, xcd = wgid % NXCD, off = wgid / NXCD; wgid = (xcd < r ? xcd * (q + 1) : r * (q + 1) + (xcd - r) * q) + off; }
        const int nig = WGM * nN, gid = wgid / nig, fm = gid * WGM, gsz = (nM - fm) < WGM ? (nM - fm) : WGM;
        u.pm = fm + ((wgid % nig) % gsz); u.pn = (wgid % nig) / gsz; return true;
    }
    __device__ __forceinline__ void a_ready(const Unit&) const {}
    __device__ __forceinline__ void done(const Unit&) const {}
};

__device__ __forceinline__ unsigned cvt_pk_bf16(float lo, float hi) { unsigned r; asm volatile("v_cvt_pk_bf16_f32 %0, %1, %2" : "=v"(r) : "v"(lo), "v"(hi)); return r; }
typedef float f32x2 __attribute__((ext_vector_type(2)));
__device__ __forceinline__ f32x2 gelu_pk(f32x2 v) {
    const f32x2 av = __builtin_elementwise_abs(v), d = av * 0.2316418882f + 1.0f;
    f32x2 t; t.x = __builtin_amdgcn_rcpf(d.x); t.y = __builtin_amdgcn_rcpf(d.y);
    f32x2 q = t * 0.5307027145f + (-0.7265760135f); q = q * t + 0.7107068705f; q = q * t + (-0.142248368f); q = q * t + 0.127414796f; q = q * t;
    const f32x2 s = (v * v) * (-0.72134752044f);
    f32x2 e; e.x = __builtin_amdgcn_exp2f(s.x); e.y = __builtin_amdgcn_exp2f(s.y);
    const f32x2 m = v * (q * e), r = v - m;
    f32x2 o; o.x = v.x < 0.f ? m.x : r.x; o.y = v.y < 0.f ? m.y : r.y; return o;
}

template <int ACT  > struct EpiBf16 {
    static constexpr bool PERM = true, AFTER_DRAIN = false; static_assert(ACT == 0 || ACT == 1, "EpiBf16: ACT is 0 (none) or 1 (gelu_pk)");
    bf16_t* O; int ldc; const float* bias; int split_cols; size_t split_stride; float scale0;
    __device__ __forceinline__ void operator()(const f32x4 (&acc)[2][2][4][2], const Unit& u, int wr, int wc, int fr, int fq) const {
        const int row0 = u.pm * BM + wr * 64 + fr; int colt = u.pn * BM; bf16_t* base = O;
        float sc = 1.f; if (split_cols) { const int t = colt / split_cols; base += (size_t)t * split_stride; colt -= t * split_cols; if (t == 0) sc = scale0; }
        const int col0 = colt + wc * 32 + 8 * fq, bcol0 = u.pn * BM + wc * 32 + 8 * fq;
        f32x4 bv[2][2];
#pragma unroll
        for (int bj = 0; bj < 2; ++bj)
#pragma unroll
            for (int n = 0; n < 2; ++n) bv[bj][n] = bias ? *(const f32x4*)(bias + bcol0 + bj * HALF + 4 * n) : (f32x4){0.f, 0.f, 0.f, 0.f};
#pragma unroll
        for (int ai = 0; ai < 2; ++ai)
#pragma unroll
            for (int m = 0; m < 4; ++m) { bf16_t* rowp = base + (size_t)(row0 + ai * HALF + m * 16) * ldc + col0;
#pragma unroll
                for (int bj = 0; bj < 2; ++bj) { f32x4 v0 = acc[ai][bj][m][0] + bv[bj][0], v1 = acc[ai][bj][m][1] + bv[bj][1];
                    if (ACT == 1) { f32x2 a = gelu_pk((f32x2){v0[0], v0[1]}), b = gelu_pk((f32x2){v0[2], v0[3]}), c = gelu_pk((f32x2){v1[0], v1[1]}), d = gelu_pk((f32x2){v1[2], v1[3]});
                        v0 = (f32x4){a.x, a.y, b.x, b.y}; v1 = (f32x4){c.x, c.y, d.x, d.y}; }
                    v0 = v0 * sc; v1 = v1 * sc; u32x4 w; w.x = cvt_pk_bf16(v0[0], v0[1]); w.y = cvt_pk_bf16(v0[2], v0[3]); w.z = cvt_pk_bf16(v1[0], v1[1]); w.w = cvt_pk_bf16(v1[2], v1[3]);
                    *(u32x4*)(rowp + bj * HALF) = w; } }
    }
};
struct EpiF32Split {
    static constexpr bool PERM = false, AFTER_DRAIN = false;
    float* C; int ldc; int split_cols; size_t split_stride; bf16_t* MB;
    __device__ __forceinline__ void operator()(const f32x4 (&acc)[2][2][4][2], const Unit& u, int wr, int wc, int fr, int fq) const {
        typedef unsigned u32x2v __attribute__((ext_vector_type(2)));
        int colt = u.pn * BM; float* base = C; bf16_t* mb = MB;
        if (split_cols) { const int t = colt / split_cols; base += (size_t)t * split_stride; mb += (size_t)t * split_stride; colt -= t * split_cols; }
        const int row0 = u.pm * BM + wr * 64 + fr, col0 = colt + wc * 32 + 4 * fq;
#pragma unroll
        for (int ai = 0; ai < 2; ++ai)
#pragma unroll
            for (int m = 0; m < 4; ++m) { float* rowp = base + (size_t)(row0 + ai * HALF + m * 16) * ldc + col0; bf16_t* rowb = mb + (size_t)(row0 + ai * HALF + m * 16) * ldc + col0;
#pragma unroll
                for (int bj = 0; bj < 2; ++bj)
#pragma unroll
                    for (int n = 0; n < 2; ++n) { const f32x4 v = acc[ai][bj][m][n]; *(f32x4*)(rowp + bj * HALF + n * 16) = v;
                        u32x2v w; w.x = cvt_pk_bf16(v[0], v[1]); w.y = cvt_pk_bf16(v[2], v[3]); *(u32x2v*)(rowb + bj * HALF + n * 16) = w; } }
    }
};
struct EpiBf16NP {
    static constexpr bool PERM = false, AFTER_DRAIN = false;
    bf16_t* O; int ldc; const float* TAB; int rot_cols, kcol0;
    __device__ __forceinline__ void operator()(const f32x4 (&acc)[2][2][4][2], const Unit& u, int wr, int wc, int fr, int fq) const {
        typedef unsigned u32x2v __attribute__((ext_vector_type(2)));
        const int row0 = u.pm * BM + wr * 64 + fr, col0 = u.pn * BM + wc * 32 + 4 * fq;
        const bool rot = u.pn * BM < rot_cols; const float scl = (u.pn * BM >= kcol0) ? 0.0625f : 1.0f;
#pragma unroll
        for (int ai = 0; ai < 2; ++ai)
#pragma unroll
            for (int m = 0; m < 4; ++m) { const int row = row0 + ai * HALF + m * 16; bf16_t* rowp = O + (size_t)row * ldc + col0;
                const int p = row < 8192 ? (row & 4095) : (row < 8224 ? 4096 + ((row - 8192) & 3) : 0);
                const float* tb = TAB + ((size_t)p * 128 + ((col0 & 255) >> 1)) * 2;
#pragma unroll
                for (int bj = 0; bj < 2; ++bj)
#pragma unroll
                    for (int n = 0; n < 2; ++n) { f32x4 v = acc[ai][bj][m][n];
                        if (rot) { const f32x4 cs = *(const f32x4*)(tb + bj * HALF + n * 16);
                            v = (f32x4){(v[0] * cs[0] - v[1] * cs[1]) * scl, (v[1] * cs[0] + v[0] * cs[1]) * scl, (v[2] * cs[2] - v[3] * cs[3]) * scl, (v[3] * cs[2] + v[2] * cs[3]) * scl}; }
                        u32x2v w; w.x = cvt_pk_bf16(v[0], v[1]); w.y = cvt_pk_bf16(v[2], v[3]); *(u32x2v*)(rowp + bj * HALF + n * 16) = w; } }
    }
};
struct EpiResid {
    static constexpr bool PERM = false, AFTER_DRAIN = false;
    const float* __restrict__ X; float* __restrict__ Z; int ldc; float alpha;
    __device__ __forceinline__ void operator()(const f32x4 (&acc)[2][2][4][2], const Unit& u, int wr, int wc, int fr, int fq) const {
        const int row0 = u.pm * BM + wr * 64 + fr, col0 = u.pn * BM + wc * 32 + 4 * fq;
#pragma unroll
        for (int ai = 0; ai < 2; ++ai)
#pragma unroll
            for (int mp = 0; mp < 2; ++mp) { f32x4 xv[2][2][2];
#pragma unroll
                for (int mm = 0; mm < 2; ++mm) { const float* rowp = X + (size_t)(row0 + ai * HALF + (2 * mp + mm) * 16) * ldc + col0;
#pragma unroll
                    for (int bj = 0; bj < 2; ++bj)
#pragma unroll
                        for (int n = 0; n < 2; ++n) xv[mm][bj][n] = *(const f32x4*)(rowp + bj * HALF + n * 16); }
#pragma unroll
                for (int mm = 0; mm < 2; ++mm) { float* rowz = Z + (size_t)(row0 + ai * HALF + (2 * mp + mm) * 16) * ldc + col0;
#pragma unroll
                    for (int bj = 0; bj < 2; ++bj)
#pragma unroll
                        for (int n = 0; n < 2; ++n) *(f32x4*)(rowz + bj * HALF + n * 16) = xv[mm][bj][n] * alpha + acc[ai][bj][2 * mp + mm][n]; } }
    }
};
template <class Epi, class Sched, bool ALIGN_EPI = false, bool SP2 = false>
__device__ __forceinline__ void gemm_phase(PG8_LAS unsigned char* lds, const Gemm g, const Sched& S, const Epi& E) {
    int tid_ = threadIdx.x; asm volatile("" : "+v"(tid_));
    const int tid = tid_, wid = __builtin_amdgcn_readfirstlane(tid >> 6), lane = tid & 63, wr = wid >> 2, wc = wid & 3, fr = lane & 15, fq = lane >> 4;
    const int K = g.K, nt = K / BK;
    unsigned voffA[2], voffB[2];
#pragma unroll
    for (int i = 0; i < 2; ++i) { int R, C; stage_rc(tid * 16 + i * 8192, R, C); const int Rb = Epi::PERM ? ((R & ~31) + perm32(R & 31)) : R;
        voffA[i] = (unsigned)(R * K + C) * 2u; voffB[i] = (unsigned)(Rb * K + C) * 2u; }
    const size_t kstep = (size_t)(BK * 2);
    const size_t hstep = (size_t)HALF * K * 2;
    const size_t tstep = 2 * hstep;
    const unsigned ldsw = (unsigned)wid * 1024u;
    const int aoff = lds_byte(wr * 64 + fr, fq * 8), boff = lds_byte(wc * 32 + fr, fq * 8);
#define PG8_SA(b, h) (((b) * 2 + (h)) * HTB)
#define PG8_SB(b, h) ((4 + (b) * 2 + (h)) * HTB)
#define PG8_STAGE(bufoff, gbase, voff) do { _Pragma("unroll") for (int _i = 0; _i < 2; ++_i) \
        __builtin_amdgcn_global_load_lds((const unsigned*)((const char*)(gbase) + (voff)[_i]), (PG8_LAS unsigned*)(lds + (bufoff) + ldsw + _i * 8192), 16, 0, 0); } while (0)
#define PG8_LDA(dst, b, h) do { _Pragma("unroll") for (int m = 0; m < 4; ++m) _Pragma("unroll") for (int k = 0; k < 2; ++k) dst[m][k] = *(const PG8_LAS bf16x8*)(lds + PG8_SA(b, h) + aoff + m * 2048 + k * 1024); } while (0)
#define PG8_LDB(dst, b, h) do { _Pragma("unroll") for (int n = 0; n < 2; ++n) _Pragma("unroll") for (int k = 0; k < 2; ++k) dst[n][k] = *(const PG8_LAS bf16x8*)(lds + PG8_SB(b, h) + boff + n * 2048 + k * 1024); } while (0)
#define PG8_MMA(ai, bj, At, Bt) do { __builtin_amdgcn_s_setprio(1); _Pragma("unroll") for (int m = 0; m < 4; ++m) _Pragma("unroll") for (int n = 0; n < 2; ++n) _Pragma("unroll") for (int k = 0; k < 2; ++k) \
        acc[ai][bj][m][n] = __builtin_amdgcn_mfma_f32_16x16x32_bf16(Bt[n][k], At[m][k], acc[ai][bj][m][n], 0, 0, 0); __builtin_amdgcn_s_setprio(0); } while (0)
#define PG8_WAIT_V(n) asm volatile("s_waitcnt vmcnt(" #n ")" ::: "memory")
#define PG8_WAIT_L(n) asm volatile("s_waitcnt lgkmcnt(" #n ")" ::: "memory")
#define PG8_BAR __builtin_amdgcn_s_barrier()
#define PG8_SCHED __builtin_amdgcn_sched_barrier(0)
    Unit cur, nxt; int ui = 0;
    if (!S.next(0, cur)) return;
    f32x4 acc[2][2][4][2];
#pragma unroll
    for (int a = 0; a < 2; ++a)
#pragma unroll
        for (int b = 0; b < 2; ++b)
#pragma unroll
            for (int m = 0; m < 4; ++m)
#pragma unroll
                for (int n = 0; n < 2; ++n) acc[a][b][m][n] = (f32x4){0.f, 0.f, 0.f, 0.f};
    bf16x8 At[4][2], B0[2][2], B1[2][2];
    const char* cA = (const char*)g.A + (size_t)cur.pm * tstep; const char* cB = (const char*)g.Bt + (size_t)cur.pn * tstep;
    S.a_ready(cur);
    if constexpr (SP2) {
        PG8_STAGE(PG8_SB(0, 0), cB, voffB); PG8_STAGE(PG8_SB(0, 1), cB + hstep, voffB); PG8_STAGE(PG8_SA(0, 0), cA, voffA); PG8_STAGE(PG8_SA(0, 1), cA + hstep, voffA);
        if (wr == 1) PG8_BAR;
        PG8_WAIT_V(2); PG8_BAR;
        PG8_STAGE(PG8_SB(1, 0), cB + kstep, voffB); PG8_STAGE(PG8_SA(1, 0), cA + kstep, voffA); PG8_STAGE(PG8_SB(1, 1), cB + hstep + kstep, voffB);
        PG8_WAIT_V(6); PG8_BAR;
    } else {
        PG8_STAGE(PG8_SB(0, 0), cB, voffB); PG8_STAGE(PG8_SA(0, 0), cA, voffA); PG8_STAGE(PG8_SB(0, 1), cB + hstep, voffB); PG8_STAGE(PG8_SA(0, 1), cA + hstep, voffA);
        if (wr == 1) PG8_BAR;
        PG8_WAIT_V(4); PG8_BAR;
        PG8_STAGE(PG8_SB(1, 0), cB + kstep, voffB); PG8_STAGE(PG8_SA(1, 0), cA + kstep, voffA); PG8_STAGE(PG8_SB(1, 1), cB + hstep + kstep, voffB);
        PG8_WAIT_V(6); PG8_BAR;
    }
    for (;;) {
        const bool has_next = S.next(ui + 1, nxt);
        const char* nA = has_next ? (const char*)g.A + (size_t)nxt.pm * tstep : cA; const char* nB = has_next ? (const char*)g.Bt + (size_t)nxt.pn * tstep : cB;
        for (int t = 0; t < nt; t += 2) {
            const bool last = (t == nt - 2);
            const char* a1 = cA + (size_t)(t + 1) * kstep;
            const char* a2 = last ? nA : cA + (size_t)(t + 2) * kstep; const char* b2 = last ? nB : cB + (size_t)(t + 2) * kstep;
            const char* a3 = a2 + kstep; const char* b3 = b2 + kstep;
            if (last && has_next) S.a_ready(nxt);
            if constexpr (SP2) {
            PG8_LDB(B0, 0, 0); PG8_LDB(B1, 0, 1); PG8_SCHED; PG8_LDA(At, 0, 0); PG8_STAGE(PG8_SA(1, 1), a1 + hstep, voffA);
            PG8_WAIT_V(8); PG8_WAIT_L(0); PG8_BAR; PG8_MMA(0, 0, At, B0); PG8_MMA(0, 1, At, B1); PG8_BAR; PG8_SCHED;
            PG8_LDA(At, 0, 1); PG8_STAGE(PG8_SB(0, 0), b2, voffB); PG8_STAGE(PG8_SB(0, 1), b2 + hstep, voffB); PG8_STAGE(PG8_SA(0, 0), a2, voffA);
            PG8_WAIT_V(8); PG8_WAIT_L(0); PG8_BAR; PG8_MMA(1, 0, At, B0); PG8_MMA(1, 1, At, B1); PG8_BAR; PG8_SCHED;
            PG8_LDB(B0, 1, 0); PG8_LDB(B1, 1, 1); PG8_SCHED; PG8_LDA(At, 1, 0); PG8_STAGE(PG8_SA(0, 1), a2 + hstep, voffA);
            PG8_WAIT_V(8); PG8_WAIT_L(0); PG8_BAR; PG8_MMA(0, 0, At, B0); PG8_MMA(0, 1, At, B1); PG8_BAR; PG8_SCHED;
            PG8_LDA(At, 1, 1); PG8_STAGE(PG8_SB(1, 0), b3, voffB); PG8_STAGE(PG8_SB(1, 1), b3 + hstep, voffB); PG8_STAGE(PG8_SA(1, 0), a3, voffA);
            PG8_WAIT_V(8); PG8_WAIT_L(0); PG8_BAR; PG8_MMA(1, 0, At, B0); PG8_MMA(1, 1, At, B1); PG8_BAR; PG8_SCHED;
            } else {
            PG8_LDB(B0, 0, 0); PG8_SCHED; PG8_LDA(At, 0, 0); PG8_STAGE(PG8_SA(1, 1), a1 + hstep, voffA);
            PG8_WAIT_L(8); PG8_BAR; PG8_WAIT_L(0); PG8_MMA(0, 0, At, B0); PG8_BAR; PG8_SCHED;
            PG8_LDB(B1, 0, 1); PG8_STAGE(PG8_SB(0, 0), b2, voffB);
            PG8_BAR; PG8_WAIT_L(0); PG8_MMA(0, 1, At, B1); PG8_BAR;
            PG8_LDA(At, 0, 1); PG8_STAGE(PG8_SA(0, 0), a2, voffA);
            PG8_BAR; PG8_WAIT_L(0); PG8_MMA(1, 0, At, B0); PG8_BAR; PG8_SCHED;
            PG8_STAGE(PG8_SB(0, 1), b2 + hstep, voffB);
            PG8_WAIT_V(6); PG8_BAR; PG8_MMA(1, 1, At, B1); PG8_BAR;
            PG8_LDB(B0, 1, 0); PG8_SCHED; PG8_LDA(At, 1, 0); PG8_STAGE(PG8_SA(0, 1), a2 + hstep, voffA);
            PG8_WAIT_L(8); PG8_BAR; PG8_WAIT_L(0); PG8_MMA(0, 0, At, B0); PG8_BAR; PG8_SCHED;
            PG8_LDB(B1, 1, 1); PG8_STAGE(PG8_SB(1, 0), b3, voffB);
            PG8_BAR; PG8_WAIT_L(0); PG8_MMA(0, 1, At, B1); PG8_BAR;
            PG8_LDA(At, 1, 1); PG8_STAGE(PG8_SA(1, 0), a3, voffA);
            PG8_BAR; PG8_WAIT_L(0); PG8_MMA(1, 0, At, B0); PG8_BAR; PG8_SCHED;
            PG8_STAGE(PG8_SB(1, 1), b3 + hstep, voffB);
            PG8_WAIT_V(6); PG8_BAR; PG8_MMA(1, 1, At, B1); PG8_BAR;
            }
        }
        if constexpr (ALIGN_EPI) { if (wr == 0) PG8_BAR; }
        if constexpr (!Epi::AFTER_DRAIN) { E(acc, cur, wr, wc, fr, fq); S.done(cur); }
        if (!has_next) break;
#pragma unroll
        for (int a = 0; a < 2; ++a)
#pragma unroll
            for (int b = 0; b < 2; ++b)
#pragma unroll
                for (int m = 0; m < 4; ++m)
#pragma unroll
                    for (int n = 0; n < 2; ++n) acc[a][b][m][n] = (f32x4){0.f, 0.f, 0.f, 0.f};
        cur = nxt; cA = nA; cB = nB; ++ui;
        if constexpr (ALIGN_EPI) { if (wr == 1) PG8_BAR; }
    }
    PG8_WAIT_V(0);
    if constexpr (!ALIGN_EPI) { if (wr == 0) PG8_BAR; }
    PG8_BAR;
    if constexpr (Epi::AFTER_DRAIN) { E.fused(acc, cur, wr, wc, fr, fq, lds, wid, lane); S.done(cur); }
#undef PG8_SA
#undef PG8_SB
#undef PG8_STAGE
#undef PG8_LDA
#undef PG8_LDB
#undef PG8_MMA
#undef PG8_WAIT_V
#undef PG8_WAIT_L
#undef PG8_BAR
#undef PG8_SCHED
}
}
constexpr int DM = 2048, SEQ = 4096, TP = 8192, TS = 32, TT = TP + TS, MPAD = 8448;
constexpr int EVEN_IN = 6784, EVEN_INP = 6912, ODD_IN = 7168, LDH = 7168;
constexpr int EVEN_OUT = 1536, ODD_OUT = 2048;
constexpr float ALPHA = 1.6817928305074292f;
constexpr float LN_EPS = 1e-5f;
constexpr int EC_R = 0, EC_K = 768, EC_V = 1536, EC_HW = 2304, EC_HA = 2368, EC_GA = 2432, EC_QB = 3200, EC_KB = 3968, EC_VB = 4736, EC_GB = 5504, EC_QM = 5760, EC_GM = 6272;
constexpr int OC_Q = 0, OC_K = 1536, OC_V = 3072, OC_G = 4608, OC_QM = 6144, OC_GM = 6656;
constexpr size_t O_YP = 0, O_YS = 16777216, O_RWKV_P = O_YS + 65536, O_RWKV_S = O_RWKV_P + 196608, O_SH_P = O_RWKV_S + 786432, O_SH_S = O_SH_P + 9728,
    O_G0P = O_SH_S + 38912, O_G0S = O_G0P + 262144, O_G1P = O_G0S + 32768, O_G1S = O_G1P + 1048576, O_G2P = O_G1S + 32768, O_G2S = O_G2P + 4194304,
    O_RET_P = O_G2S + 32768, O_RET_S = O_RET_P + 1572864, O_MEM = O_RET_S + 6291456, O_END = O_MEM + 2097152;
constexpr size_t MiB = 1u << 20;
constexpr size_t WS_CTL = 0, WS_WTIN = 1 * MiB, WS_WTOUT = 29 * MiB, WS_WTMEM = 37 * MiB, WS_MEMB = 53 * MiB, WS_TAB = 55 * MiB, WS_XB = 60 * MiB, WS_XZ = 93 * MiB,
    WS_HB = 159 * MiB, WS_U = 275 * MiB, WS_YA = 308 * MiB, WS_PREP = 333 * MiB, WS_OG = 478 * MiB, WS_LSE = 478 * MiB + 49 * MiB / 2, WS_MKVB = 503 * MiB, WS_VT = 507 * MiB, WS_WTOUT2 = 509 * MiB, WS_END = 517 * MiB;
constexpr int LDS_BYTES = 147456;

#define LAS __attribute__((address_space(3)))
typedef unsigned short bf16;
typedef float f32x4 __attribute__((ext_vector_type(4)));
typedef short bf16x8 __attribute__((ext_vector_type(8)));
typedef unsigned u32x4 __attribute__((ext_vector_type(4)));
typedef unsigned u32x2 __attribute__((ext_vector_type(2)));

__device__ const double ANG[128] = {
1.0, 0.9300449458481392, 0.8649836012976682, 0.8044736266284181, 0.7481966305138833, 0.6958564947100448, 0.6471778159406796, 0.6019044567806663, 0.5597981979123284, 0.5206374846632574, 0.48421626123015066, 0.45034288645458387, 0.41883912544574814, 0.3895392117442728, 0.362288975092429, 0.336945030221216, 0.31337402238589046, 0.29145192568009903, 0.2710633904364836, 0.2521011362799124, 0.23446538763970548, 0.21806334875063282, 0.20280871538024622, 0.18862122071335174, 0.17542621300415914, 0.1631542627737973, 0.15174079748634942, 0.14112576178114528, 0.13125330147352265, 0.12207146966133185, 0.11353195339077617, 0.10558981944335787, 0.09820327790631257, 0.09133346228248625, 0.08494422498263796, 0.07900194712408967, 0.07347536163492155, 0.06833538873292307, 0.06355498291362295, 0.059108990642279875, 0.05497401800103736, 0.05112830759482943, 0.04755162406834012, 0.04422514763163046, 0.04113137503418572, 0.03825402746632876, 0.03557796490339495, 0.03308910644196496, 0.030774356208980617, 0.02862153445389273, 0.026619313461261302, 0.024757157946593413, 0.023025269621793302, 0.02141453563853956, 0.019916480638308563, 0.018523222156741202, 0.017227429147699425, 0.01602228340877477, 0.014901443705277463, 0.013859012403933875, 0.01288950444072537, 0.01198781845958378, 0.011149209970080915, 0.01036926638287344, 0.009643883791544459, 0.008969245378672715, 0.008341801332506338, 0.007758250168566794, 0.007215521357901014, 0.006710759170575141, 0.006241307649397462, 0.00580469663480544, 0.005398628767382501, 0.005020967399614466, 0.004669725353279709, 0.0043430544633167095, 0.0040392358531509045, 0.003756670890311596, 0.0034938727747491297, 0.0032494587155918425, 0.0030221426551783792, 0.002810728502080728, 0.002614103837511492, 0.002431234061999789, 0.002261156951536743, 0.002102977594546134, 0.0019558636830395095, 0.0018190411331788228, 0.0016917900122028363, 0.0015734407502856099, 0.0014633706173946357, 0.0013610004466105522, 0.001265791586667203, 0.001177243067676929, 0.001094888965127687, 0.0010182959482819048, 0.0009470610000772239, 0.0008808092965317064, 0.0008191922344953685, 0.0007618855973704613, 0.0007085878491488872, 0.0006590185477903263, 0.0006129168695925734, 0.0005700402367896359, 0.0005301630411562774, 0.000493075456902875, 0.00045858233661428085, 0.00042650218442334204, 0.0003966662010161199, 0.00036891739544382435, 0.0003431097590679882, 0.0003191074972923552, 0.00029678431503900375, 0.0002760227522090274, 0.00025671356563109924, 0.00023875515424585844, 0.00022205302450155334, 0.00020651929314796272, 0.00019207222481239299, 0.0001786358019245737, 0.00016613932472747905, 0.0001545170392694147, 0.0001437077914199376, 0.00013365470508911156, 0.00012430488295695166, 0.00011560912813835741, 0.00010752168531898921, 0.0001};
__device__ const float LG2G[6] = {-0.04580368961312479f, -0.02272007650008353f, -0.011315313227834146f, -0.005646563141142063f, -0.0028205190623786626f, -0.0014095702546713536f};

__device__ __forceinline__ float bf2f(unsigned b) { return __uint_as_float(b << 16); }
typedef __bf16 bf16x2_t __attribute__((ext_vector_type(2)));
typedef float f32x2_t __attribute__((ext_vector_type(2)));
__device__ __forceinline__ unsigned f2bf(float f) { return (unsigned)__builtin_bit_cast(unsigned short, (__bf16)f); }
__device__ __forceinline__ unsigned pk2(float lo, float hi) { const f32x2_t v = {lo, hi}; return __builtin_bit_cast(unsigned, __builtin_convertvector(v, bf16x2_t)); }
__device__ __forceinline__ void unpk4(u32x2 w, float (&x)[4]) { x[0] = __uint_as_float(w.x << 16); x[1] = __uint_as_float(w.x & 0xffff0000u); x[2] = __uint_as_float(w.y << 16); x[3] = __uint_as_float(w.y & 0xffff0000u); }
__device__ __forceinline__ void unpk8(u32x4 w, float (&x)[8]) {
    x[0] = __uint_as_float(w.x << 16); x[1] = __uint_as_float(w.x & 0xffff0000u); x[2] = __uint_as_float(w.y << 16); x[3] = __uint_as_float(w.y & 0xffff0000u);
    x[4] = __uint_as_float(w.z << 16); x[5] = __uint_as_float(w.z & 0xffff0000u); x[6] = __uint_as_float(w.w << 16); x[7] = __uint_as_float(w.w & 0xffff0000u); }
template <int CTRL> __device__ __forceinline__ float dppf(float x) { return __builtin_bit_cast(float, __builtin_amdgcn_update_dpp(0, __builtin_bit_cast(int, x), CTRL, 0xF, 0xF, true)); }
__device__ __forceinline__ float red16(float x) { x += dppf<0xB1>(x); x += dppf<0x4E>(x); x += dppf<0x141>(x); x += dppf<0x140>(x); return x; }
__device__ __forceinline__ float wave_sum(float x) { x = red16(x); x += __shfl_xor(x, 16); x += __shfl_xor(x, 32); return x; }
__device__ __forceinline__ float sigmoidf_(float x) { return 1.0f / (1.0f + __expf(-x)); }
__device__ __forceinline__ float siluf_(float x) { return x / (1.0f + __expf(-x)); }
#define LDS_WAIT() asm volatile("s_waitcnt lgkmcnt(0)" ::: "memory")

struct Args { const float* in[27]; float* out; unsigned char* ws; int ph_lo, ph_hi; };
typedef const __attribute__((address_space(4))) Args* ArgsP;
struct Ctx {
    ArgsP ap;
    LAS unsigned char* lds;
    int tid, lane, wave, bid, G;
};
#define C_IN(k) (c.ap->in[k])
#define C_OUT (c.ap->out)
#define C_WTIN ((bf16*)(c.ap->ws + WS_WTIN))
#define C_WTOUT_L(l_) ((bf16*)(c.ap->ws + (((l_) & 1) ? WS_WTOUT2 : WS_WTOUT)))
#define C_WTMEM ((bf16*)(c.ap->ws + WS_WTMEM))
#define C_MEMB ((bf16*)(c.ap->ws + WS_MEMB))
#define C_XB ((bf16*)(c.ap->ws + WS_XB))
#define C_HB ((bf16*)(c.ap->ws + WS_HB))
#define C_U ((bf16*)(c.ap->ws + WS_U))
#define C_TAB ((float*)(c.ap->ws + WS_TAB))
#define C_XZ ((float*)(c.ap->ws + WS_XZ))
#define C_YA ((float*)(c.ap->ws + WS_YA))
#define C_PREP ((float*)(c.ap->ws + WS_PREP))
#define C_CHK ((unsigned char*)(c.ap->ws + WS_PREP))
#define C_PREPS ((float*)(c.ap->ws + WS_PREP + 120 * MiB))
#define C_BONUS ((float*)(c.ap->ws + WS_PREP + 125 * MiB))
#define C_WUT ((bf16*)(c.ap->ws + WS_PREP + 126 * MiB))
#define C_AUT ((bf16*)(c.ap->ws + WS_PREP + 126 * MiB) + 2 * 768 * 64)
constexpr int CHK_BYTES = 40960, CK_A = 0, CK_RQ = 9216, CK_GT = 13824, CK_YVT = 31232;
#define C_YR ((float*)(c.ap->ws + WS_PREP))
#define C_Z ((float*)(c.ap->ws + WS_HB))
#define C_OG ((float*)(c.ap->ws + WS_OG))
#define C_LSE ((float*)(c.ap->ws + WS_LSE))
#define C_MKVB ((bf16*)(c.ap->ws + WS_MKVB))
#define C_VT ((bf16*)(c.ap->ws + WS_VT))

__device__ __forceinline__ void transpose_item(const float* W, int K, int N, bf16* WT, int row_off, LAS float* scr, int item, int lane) {
    const int nblk = N / 32, kb = item / nblk, nb = item % nblk, k0 = 64 * kb, n0 = 32 * nb;
    f32x4 wv[8];
#pragma unroll
    for (int i = 0; i < 8; ++i) { const int kk = 8 * i + (lane >> 3), c4 = 4 * (lane & 7); wv[i] = *(const f32x4*)(W + (size_t)(k0 + kk) * N + n0 + c4); }
#pragma unroll
    for (int i = 0; i < 8; ++i) { const int kk = 8 * i + (lane >> 3), c4 = 4 * (lane & 7); const f32x4 w4 = wv[i];
        scr[kk * 33 + c4] = w4.x; scr[kk * 33 + c4 + 1] = w4.y; scr[kk * 33 + c4 + 2] = w4.z; scr[kk * 33 + c4 + 3] = w4.w; }
    LDS_WAIT(); asm volatile("" ::: "memory");
    const int c = lane & 7;
#pragma unroll
    for (int j = 0; j < 4; ++j) { const int n = (lane >> 3) + 8 * j; const LAS float* s = scr + (8 * c) * 33 + n;
        u32x4 o; o.x = pk2(s[0 * 33], s[1 * 33]); o.y = pk2(s[2 * 33], s[3 * 33]); o.z = pk2(s[4 * 33], s[5 * 33]); o.w = pk2(s[6 * 33], s[7 * 33]);
        *(u32x4*)(WT + (size_t)(row_off + n0 + n) * K + k0 + 8 * c) = o; }
    LDS_WAIT(); asm volatile("" ::: "memory");
}
__device__ __forceinline__ void transpose_matrix(const Ctx& c, const float* W, int K, int N, bf16* WT, int row_off) {
    LAS float* scr = (LAS float*)(c.lds + c.wave * 16384);
    const int gw = c.bid * 8 + c.wave, NGW = c.G * 8, nitems = (K / 64) * (N / 32);
    for (int it = gw; it < nitems; it += NGW) transpose_item(W, K, N, WT, row_off, scr, it, c.lane);
}
__device__ __forceinline__ void convert_layer_weights(const Ctx& c, int l) {
    if ((l & 1) == 0) { const int e = l >> 1;
        transpose_matrix(c, C_IN(10) + (size_t)e * DM * EVEN_IN, DM, EVEN_IN, C_WTIN, 0);
        transpose_matrix(c, C_IN(11) + (size_t)e * EVEN_OUT * DM, EVEN_OUT, DM, C_WTOUT_L(l), 0);
        const int n16 = (EVEN_INP - EVEN_IN) * DM * 2 / 16; u32x4* p = (u32x4*)(C_WTIN + (size_t)EVEN_IN * DM);
        for (int i = c.bid * 512 + c.tid; i < n16; i += c.G * 512) p[i] = (u32x4){0u, 0u, 0u, 0u};
    } else { const int o = l >> 1;
        transpose_matrix(c, C_IN(12) + (size_t)o * DM * ODD_IN, DM, ODD_IN, C_WTIN, 0);
        transpose_matrix(c, C_IN(13) + (size_t)o * ODD_OUT * DM, ODD_OUT, DM, C_WTOUT_L(l), 0);
    }
}

__device__ __forceinline__ void phase_prologue(const Ctx& c) {
    for (int l = 0; l < 4; ++l) transpose_matrix(c, C_IN(14) + (size_t)l * DM * 1024, DM, 1024, C_WTMEM, l * 1024);
    convert_layer_weights(c, 0);
    const int gt = c.bid * 512 + c.tid, NT = c.G * 512;
    for (int i = gt; i < 2 * 768 * 64; i += NT) { const int e = i / (768 * 64), rem = i % (768 * 64), col = rem >> 6, k = rem & 63;
        C_WUT[i] = (bf16)f2bf(C_IN(19)[((size_t)e * 64 + k) * 768 + col]); C_AUT[i] = (bf16)f2bf(C_IN(21)[((size_t)e * 64 + k) * 768 + col]); }
    for (int i = gt; i < 512 * DM / 4; i += NT) { const f32x4 v = ((const f32x4*)C_IN(9))[i]; ((u32x2*)C_MEMB)[i] = (u32x2){pk2(v.x, v.y), pk2(v.z, v.w)}; }
    for (int i = gt; i < MPAD * DM / 4; i += NT) {
        const int row = i / (DM / 4);
        f32x4 v = (f32x4){0.f, 0.f, 0.f, 0.f};
        if (row < TP) v = ((const f32x4*)C_IN(0))[i]; else if (row < TT) v = ((const f32x4*)C_IN(1))[i - TP * (DM / 4)];
        ((f32x4*)C_XZ)[i] = v; ((u32x2*)C_XB)[i] = (u32x2){pk2(v.x, v.y), pk2(v.z, v.w)};
    }
    for (int i = gt; i < 4100 * 128; i += NT) {
        const int p = i >> 7, ci = i & 127; const double pos = (double)(p < 4096 ? p : 16384 + (p - 4096));
        double ph = pos * ANG[ci];
        const double k = __builtin_rint(ph * 0.15915494309189535); ph = __builtin_fma(-k, 6.283185307179586, ph); ph = __builtin_fma(-k, 2.4492935982947064e-16, ph);
        const double q = __builtin_rint(ph * 0.6366197723675814); const double y = __builtin_fma(-q, 1.5707963267948966, ph) - q * 6.123233995736766e-17;
        const double y2 = y * y;
        const double sn = y * (1.0 + y2 * (-1.0 / 6 + y2 * (1.0 / 120 + y2 * (-1.0 / 5040 + y2 * (1.0 / 362880 + y2 * (-1.0 / 39916800 + y2 * (1.0 / 6227020800.0)))))));
        const double cs = 1.0 + y2 * (-0.5 + y2 * (1.0 / 24 + y2 * (-1.0 / 720 + y2 * (1.0 / 40320 + y2 * (-1.0 / 3628800 + y2 * (1.0 / 479001600.0 + y2 * (-1.0 / 87178291200.0)))))));
        const int qi = ((int)q) & 3; double co, si;
        if (qi == 0) { co = cs; si = sn; } else if (qi == 1) { co = -sn; si = cs; } else if (qi == 2) { co = -cs; si = -sn; } else { co = sn; si = -cs; }
        C_TAB[2 * i] = (float)co; C_TAB[2 * i + 1] = (float)si;
    }
}

__device__ __forceinline__ void rwkv_prep_item(const Ctx& c, int it, int e) {
    LAS float* lw = (LAS float*)c.lds;
    LAS float* la = lw + 16 * 64;
    const float* mu = C_IN(17) + e * 2432; const float* shift = C_IN(3) + (size_t)e * 8 * 2432;
    const int R0 = it * 16;
    for (int i = c.tid; i < 16 * 128; i += 512) {
        const int tk = i >> 7, cc = i & 127, R = R0 + tk; float val = 0.f;
        if (R < TT) { const int col = EC_HW + cc; const float hcur = bf2f(C_HB[(size_t)R * LDH + col]);
            float hprev;
            if (R < TP) hprev = ((R & (SEQ - 1)) == 0) ? 0.f : bf2f(C_HB[(size_t)(R - 1) * LDH + col]);
            else { const int n = (R - TP) >> 2, t = (R - TP) & 3; hprev = (t == 0) ? shift[n * 2432 + col] : bf2f(C_HB[(size_t)(R - 1) * LDH + col]); }
            const float hs = hcur + (hprev - hcur) * mu[col];
            val = (cc < 64) ? tanhf(hs) : hs; }
        if (cc < 64) lw[tk * 64 + cc] = val; else la[tk * 64 + (cc - 64)] = val;
    }
    __syncthreads();
    const int tl = c.tid & 255, tg = c.tid >> 8;
    const float* w_up = C_IN(19) + (size_t)e * 64 * 768; const float* a_up = C_IN(21) + (size_t)e * 64 * 768;
    const float* w0 = C_IN(18) + e * 768; const float* a0 = C_IN(20) + e * 768; const float* k_k = C_IN(22) + e * 768; const float* k_a = C_IN(23) + e * 768;
#pragma unroll 1
    for (int m = 0; m < 3; ++m) {
        const int col = tl + 256 * m, h = col >> 6, ci = col & 63;
        float xw[8], xa[8];
#pragma unroll
        for (int t = 0; t < 8; ++t) { xw[t] = 0.f; xa[t] = 0.f; }
#pragma unroll 4
        for (int kk = 0; kk < 64; ++kk) { const float wu = w_up[kk * 768 + col], au = a_up[kk * 768 + col];
#pragma unroll
            for (int t = 0; t < 8; ++t) { xw[t] += lw[(tg * 8 + t) * 64 + kk] * wu; xa[t] += la[(tg * 8 + t) * 64 + kk] * au; } }
        const float w0c = w0[col], a0c = a0[col], kkc = k_k[col], kac = k_a[col], mur = mu[EC_R + col], muk = mu[EC_K + col], muv = mu[EC_V + col];
#pragma unroll
        for (int t = 0; t < 8; ++t) {
            const int R = R0 + tg * 8 + t;
            if (R >= TT || R < TP) continue;
            const bf16* hc = C_HB + (size_t)R * LDH; float pr, pk, pv;
            const float cr = bf2f(hc[EC_R + col]), ck = bf2f(hc[EC_K + col]), cv = bf2f(hc[EC_V + col]);
            bool has_prev_row; int n = 0;
            if (R < TP) has_prev_row = (R & (SEQ - 1)) != 0; else { n = (R - TP) >> 2; has_prev_row = ((R - TP) & 3) != 0; }
            if (has_prev_row) { const bf16* hp = hc - LDH; pr = bf2f(hp[EC_R + col]); pk = bf2f(hp[EC_K + col]); pv = bf2f(hp[EC_V + col]); }
            else if (R < TP) { pr = 0.f; pk = 0.f; pv = 0.f; }
            else { const float* sp = shift + n * 2432; pr = sp[EC_R + col]; pk = sp[EC_K + col]; pv = sp[EC_V + col]; }
            const float r = cr + (pr - cr) * mur, k = ck + (pk - ck) * muk, v = cv + (pv - cv) * muv;
            const float decay = __expf(-0.6065306597126334f * sigmoidf_(w0c + xw[t]));
            const float a = sigmoidf_(a0c + xa[t]);
            float kk = k * kkc; const float ss = wave_sum(kk * kk); kk *= rsqrtf(fmaxf(ss, 1e-24f));
            const float k2 = k * (1.0f + (a - 1.0f) * kac);
            float* dst = C_PREPS + ((size_t)(R - TP) * 12 + h) * 384 + ci;
            dst[0] = r; dst[64] = decay; dst[128] = k2; dst[192] = v; dst[256] = -kk; dst[320] = kk * a;
        }
    }
    __syncthreads();
}

__device__ __forceinline__ void dil_attn_item(const Ctx& c, int R, int hh, int e) {
    const int lane = c.lane, kg = lane >> 4, dl = lane & 15;
    float m = -1e30f, l = 0.f, acc[4] = {0.f, 0.f, 0.f, 0.f};
    const bool is_p = R < TP; const int t = is_p ? (R & (SEQ - 1)) : ((R - TP) & 3); const int n = is_p ? 0 : ((R - TP) >> 2);
    const size_t rowbase = is_p ? (size_t)(R - t) : (size_t)(TP + n * 4);
#pragma unroll
    for (int g = 0; g < 3; ++g) {
        const int dil = (g == 0) ? 1 : (g == 1 ? 4 : 16), W = 128 * dil;
        float q[4]; { const u32x2 w = *(const u32x2*)(C_HB + (size_t)R * LDH + EC_QB + g * 256 + hh * 64 + 4 * dl); unpk4(w, q); }
#pragma unroll
        for (int i = 0; i < 4; ++i) q[i] *= 0.125f;
        const float* cache = ((g == 0) ? C_IN(4) : (g == 1 ? C_IN(5) : C_IN(6))) + ((size_t)(e * 8 + n) * W) * 512;
#pragma unroll 1
        for (int j0 = 0; j0 < 129; j0 += 4) {
            const int j = j0 + kg; bool valid = j < 129; float kf[4] = {0.f, 0.f, 0.f, 0.f}, vf[4] = {0.f, 0.f, 0.f, 0.f};
            if (is_p) { const int pos = t - dil * j; valid = valid && pos >= 0;
                if (valid) { const bf16* kp = C_HB + (rowbase + pos) * LDH + g * 256 + hh * 64 + 4 * dl; unpk4(*(const u32x2*)(kp + EC_KB), kf); unpk4(*(const u32x2*)(kp + EC_VB), vf); } }
            else if (valid) { const int idx = W + t - dil * j;
                if (idx >= W) { const bf16* kp = C_HB + (rowbase + (idx - W)) * LDH + g * 256 + hh * 64 + 4 * dl; unpk4(*(const u32x2*)(kp + EC_KB), kf); unpk4(*(const u32x2*)(kp + EC_VB), vf); }
                else { const float* kp = cache + (size_t)idx * 512 + hh * 64 + 4 * dl; const f32x4 k4 = *(const f32x4*)kp, v4 = *(const f32x4*)(kp + 256);
                    kf[0] = k4.x; kf[1] = k4.y; kf[2] = k4.z; kf[3] = k4.w; vf[0] = v4.x; vf[1] = v4.y; vf[2] = v4.z; vf[3] = v4.w; } }
            float s = q[0] * kf[0] + q[1] * kf[1] + q[2] * kf[2] + q[3] * kf[3];
            s = red16(s);
            if (valid) { const float mn = fmaxf(m, s), sc = __expf(m - mn), p = __expf(s - mn);
                l = l * sc + p;
#pragma unroll
                for (int i = 0; i < 4; ++i) acc[i] = acc[i] * sc + p * vf[i];
                m = mn; }
        }
    }
#pragma unroll
    for (int off = 16; off <= 32; off <<= 1) {
        const float m2 = __shfl_xor(m, off), l2 = __shfl_xor(l, off); float a2[4];
#pragma unroll
        for (int i = 0; i < 4; ++i) a2[i] = __shfl_xor(acc[i], off);
        const float mn = fmaxf(m, m2), s1 = __expf(m - mn), s2 = __expf(m2 - mn);
        l = l * s1 + l2 * s2;
#pragma unroll
        for (int i = 0; i < 4; ++i) acc[i] = acc[i] * s1 + a2[i] * s2;
        m = mn;
    }
    if (kg == 0) { float gt[4]; unpk4(*(const u32x2*)(C_HB + (size_t)R * LDH + EC_GB + hh * 64 + 4 * dl), gt);
        const float inv = 1.0f / l; float o[4];
#pragma unroll
        for (int i = 0; i < 4; ++i) o[i] = acc[i] * inv * siluf_(gt[i]);
        *(u32x2*)(C_U + (size_t)R * EVEN_OUT + 768 + hh * 64 + 4 * dl) = (u32x2){pk2(o[0], o[1]), pk2(o[2], o[3])}; }
}

__device__ __forceinline__ void mem_attn_item(const Ctx& c, int R, int mh, int l, int qcol, int gcol, int ucol, int ldu) {
    const int lane = c.lane, kg = lane >> 5, dl = lane & 31;
    const float* mkv;
    if (R < TP) mkv = C_OUT + O_MEM + ((size_t)l * 512 + (R >> 12) * 256) * 1024; else mkv = C_IN(8) + ((size_t)l * 8 + ((R - TP) >> 2)) * 256 * 1024;
    float q[4]; unpk4(*(const u32x2*)(C_HB + (size_t)R * LDH + qcol + mh * 128 + 4 * dl), q);
#pragma unroll
    for (int i = 0; i < 4; ++i) q[i] *= 0.08838834764831845f;
    float m = -1e30f, lsum = 0.f, acc[4] = {0.f, 0.f, 0.f, 0.f};
#pragma unroll 8
    for (int j0 = 0; j0 < 256; j0 += 2) {
        const float* kp = mkv + (size_t)(j0 + kg) * 1024 + mh * 128 + 4 * dl; const f32x4 k4 = *(const f32x4*)kp, v4 = *(const f32x4*)(kp + 512);
        float s = q[0] * k4.x + q[1] * k4.y + q[2] * k4.z + q[3] * k4.w;
        s = red16(s); s += __shfl_xor(s, 16);
        const float mn = fmaxf(m, s), sc = __expf(m - mn), p = __expf(s - mn);
        lsum = lsum * sc + p; acc[0] = acc[0] * sc + p * v4.x; acc[1] = acc[1] * sc + p * v4.y; acc[2] = acc[2] * sc + p * v4.z; acc[3] = acc[3] * sc + p * v4.w; m = mn;
    }
    { const float m2 = __shfl_xor(m, 32), l2 = __shfl_xor(lsum, 32); float a2[4];
#pragma unroll
        for (int i = 0; i < 4; ++i) a2[i] = __shfl_xor(acc[i], 32);
        const float mn = fmaxf(m, m2), s1 = __expf(m - mn), s2 = __expf(m2 - mn);
        lsum = lsum * s1 + l2 * s2;
#pragma unroll
        for (int i = 0; i < 4; ++i) acc[i] = acc[i] * s1 + a2[i] * s2; }
    if (kg == 0) { float gt[4]; unpk4(*(const u32x2*)(C_HB + (size_t)R * LDH + gcol + mh * 128 + 4 * dl), gt);
        const float inv = 1.0f / lsum; float o[4];
#pragma unroll
        for (int i = 0; i < 4; ++i) o[i] = acc[i] * inv * siluf_(gt[i]);
        *(u32x2*)(C_U + (size_t)R * ldu + ucol + mh * 128 + 4 * dl) = (u32x2){pk2(o[0], o[1]), pk2(o[2], o[3])}; }
}


typedef float f32x16 __attribute__((ext_vector_type(16)));
__device__ __forceinline__ f32x16 mfma32(bf16x8 a, bf16x8 b, f32x16 cacc) { return __builtin_amdgcn_mfma_f32_32x32x16_bf16(a, b, cacc, 0, 0, 0); }
__device__ __forceinline__ void mem_attn_mfma_item(const Ctx& c, int item, int l, int qcol, int gcol, int ucol, int ldu) {
    const int blk = item >> 2, mh = item & 3, R0 = blk * 32, b = R0 >> 12;
    const int lane = c.lane, r = lane & 31, hh = lane >> 5;
    const bf16* Kb = C_MKVB + ((size_t)l * 512 + b * 256) * 1024 + mh * 128 + 8 * hh;
    const bf16* Vt = C_VT + ((size_t)l * 512 + mh * 128) * 512 + b * 256 + 4 * hh;
    bf16x8 Qf[8];
    { const bf16* qp = C_HB + (size_t)(R0 + r) * LDH + qcol + mh * 128 + 8 * hh;
#pragma unroll
        for (int ks = 0; ks < 8; ++ks) Qf[ks] = *(const bf16x8*)(qp + 16 * ks); }
    f32x16 O[4];
#pragma unroll
    for (int dt = 0; dt < 4; ++dt)
#pragma unroll
        for (int i = 0; i < 16; ++i) O[dt][i] = 0.f;
    float m = -1e30f, lsum = 0.f;
    const float cs = 0.08838834764831845f * 1.4426950408889634f;
#pragma unroll 1
    for (int half = 0; half < 2; ++half) {
        f32x16 S[4];
#pragma unroll
        for (int kt = 0; kt < 4; ++kt) {
#pragma unroll
            for (int i = 0; i < 16; ++i) S[kt][i] = 0.f;
            const bf16* kp = Kb + (size_t)(128 * half + 32 * kt + r) * 1024;
#pragma unroll
            for (int ks = 0; ks < 8; ++ks) S[kt] = mfma32(*(const bf16x8*)(kp + 16 * ks), Qf[ks], S[kt]);
        }
        float mx = -1e30f;
#pragma unroll
        for (int kt = 0; kt < 4; ++kt)
#pragma unroll
            for (int i = 0; i < 16; ++i) mx = fmaxf(mx, S[kt][i]);
        mx = fmaxf(mx, __shfl_xor(mx, 32));
        const float mn = fmaxf(m, mx), sc = __builtin_amdgcn_exp2f((m - mn) * cs); m = mn;
        lsum *= sc;
#pragma unroll
        for (int dt = 0; dt < 4; ++dt)
#pragma unroll
            for (int i = 0; i < 16; ++i) O[dt][i] *= sc;
        float ps = 0.f;
#pragma unroll
        for (int kt = 0; kt < 4; ++kt)
#pragma unroll
            for (int i = 0; i < 16; ++i) { const float p = __builtin_amdgcn_exp2f((S[kt][i] - mn) * cs); S[kt][i] = p; ps += p; }
        lsum += ps;
#pragma unroll
        for (int kt = 0; kt < 4; ++kt)
#pragma unroll
            for (int s2 = 0; s2 < 2; ++s2) {
                const u32x4 pw = (u32x4){pk2(S[kt][8 * s2 + 0], S[kt][8 * s2 + 1]), pk2(S[kt][8 * s2 + 2], S[kt][8 * s2 + 3]), pk2(S[kt][8 * s2 + 4], S[kt][8 * s2 + 5]), pk2(S[kt][8 * s2 + 6], S[kt][8 * s2 + 7])};
                const bf16x8 Pf = __builtin_bit_cast(bf16x8, pw);
                const int kb = 128 * half + 32 * kt + 16 * s2;
#pragma unroll
                for (int dt = 0; dt < 4; ++dt) { const bf16* vp = Vt + (size_t)(32 * dt + r) * 512 + kb;
                    const u32x2 v0 = *(const u32x2*)vp, v1 = *(const u32x2*)(vp + 8); const u32x4 vw = (u32x4){v0.x, v0.y, v1.x, v1.y};
                    O[dt] = mfma32(__builtin_bit_cast(bf16x8, vw), Pf, O[dt]); }
            }
    }
    lsum += __shfl_xor(lsum, 32); const float inv = 1.0f / lsum;
    const bf16* gp = C_HB + (size_t)(R0 + r) * LDH + gcol + mh * 128 + 4 * hh; bf16* up = C_U + (size_t)(R0 + r) * ldu + ucol + mh * 128 + 4 * hh;
#pragma unroll
    for (int dt = 0; dt < 4; ++dt)
#pragma unroll
        for (int g4 = 0; g4 < 4; ++g4) { float gt[4]; unpk4(*(const u32x2*)(gp + 32 * dt + 8 * g4), gt);
            const float o0 = O[dt][4 * g4 + 0] * inv * siluf_(gt[0]), o1 = O[dt][4 * g4 + 1] * inv * siluf_(gt[1]), o2 = O[dt][4 * g4 + 2] * inv * siluf_(gt[2]), o3 = O[dt][4 * g4 + 3] * inv * siluf_(gt[3]);
            *(u32x2*)(up + 32 * dt + 8 * g4) = (u32x2){pk2(o0, o1), pk2(o2, o3)}; }
}
__device__ __forceinline__ void mem_attn_sample_block(const Ctx& c, int item, int l, int qcol, int gcol, int ucol, int ldu);
__device__ __forceinline__ void mem_attn_all(const Ctx& c, int l, int qcol, int gcol, int ucol, int ldu) {
    constexpr int NM = (TP / 32) * 4;
    for (int wi = c.wave * c.G + c.bid; wi < NM; wi += 8 * c.G) mem_attn_mfma_item(c, wi, l, qcol, gcol, ucol, ldu);
    for (int it = c.bid; it < TS * 4; it += c.G) mem_attn_sample_block(c, it, l, qcol, gcol, ucol, ldu);
}

typedef short s16x4 __attribute__((ext_vector_type(4)));
__device__ __forceinline__ f32x4 mfma16(bf16x8 a, bf16x8 b, f32x4 cacc) { return __builtin_amdgcn_mfma_f32_16x16x32_bf16(a, b, cacc, 0, 0, 0); }
__device__ __forceinline__ bf16x8 tr_frag(const LAS bf16* p, int rowstride4) {
    const s16x4 a0 = __builtin_amdgcn_ds_read_tr16_b64_v4i16((LAS s16x4*)p), a1 = __builtin_amdgcn_ds_read_tr16_b64_v4i16((LAS s16x4*)(p + rowstride4));
    return (bf16x8){a0[0], a0[1], a0[2], a0[3], a1[0], a1[1], a1[2], a1[3]};
}
__device__ __forceinline__ void dil_attn_mfma_item(const Ctx& c, int item) {
    const int bh = item / 48, rem = item % 48, b = bh >> 2, hh = bh & 3, g = rem >> 4, idx16 = rem & 15;
    const int dil = 1 << (2 * g), nub = 16 >> (2 * g), rho = idx16 / nub, ub = idx16 % nub;
    LAS bf16* Kl = (LAS bf16*)c.lds;
    LAS bf16* Vl = Kl + 384 * 72;
    const int tid = c.tid, lane = c.lane, wave = c.wave, r = lane & 31, hl = lane >> 5;
    const int ubase = ub * 256 - 128;
    const bf16* hb = C_HB + (size_t)b * SEQ * LDH + g * 256 + hh * 64;
    u32x4 kwv[6], vwv[6];
#pragma unroll
    for (int pass = 0; pass < 6; ++pass) { const int kl = pass * 64 + (tid >> 3), part = tid & 7; int up = ubase + kl; up = up < 0 ? 0 : up;
        const bf16* src = hb + (size_t)(rho + dil * up) * LDH + 8 * part;
        kwv[pass] = *(const u32x4*)(src + EC_KB); vwv[pass] = *(const u32x4*)(src + EC_VB); }
    const int u0 = ub * 256 + 32 * wave;
    bf16x8 Qf[4];
    { const bf16* qp = hb + (size_t)(rho + dil * (u0 + r)) * LDH + EC_QB + 8 * hl;
#pragma unroll
        for (int ks = 0; ks < 4; ++ks) Qf[ks] = *(const bf16x8*)(qp + 16 * ks); }
#pragma unroll
    for (int pass = 0; pass < 6; ++pass) { const int kl = pass * 64 + (tid >> 3), part = tid & 7; *(LAS u32x4*)(Kl + kl * 72 + 8 * part) = kwv[pass]; *(LAS u32x4*)(Vl + kl * 72 + 8 * part) = vwv[pass]; }
    __syncthreads();
    f32x16 S[5];
#pragma unroll
    for (int kt = 0; kt < 5; ++kt) {
#pragma unroll
        for (int i = 0; i < 16; ++i) S[kt][i] = 0.f;
        const LAS bf16* kp = Kl + (32 * wave + 32 * kt + r) * 72 + 8 * hl;
#pragma unroll
        for (int ks = 0; ks < 4; ++ks) S[kt] = mfma32(*(const LAS bf16x8*)(kp + 16 * ks), Qf[ks], S[kt]);
    }
    float mx = -1e30f;
#pragma unroll
    for (int kt = 0; kt < 5; ++kt)
#pragma unroll
        for (int i = 0; i < 16; ++i) { const int kl = 32 * kt + (i & 3) + 8 * (i >> 2) + 4 * hl;
            const bool valid = (kl >= r) && (kl - 128 <= r) && (u0 - 128 + kl >= 0);
            const float sv = valid ? S[kt][i] : -1e30f; S[kt][i] = sv; mx = fmaxf(mx, sv); }
    mx = fmaxf(mx, __shfl_xor(mx, 32));
    const float cs = 0.125f * 1.4426950408889634f;
    float lsum = 0.f;
#pragma unroll
    for (int kt = 0; kt < 5; ++kt)
#pragma unroll
        for (int i = 0; i < 16; ++i) { const float p = __builtin_amdgcn_exp2f((S[kt][i] - mx) * cs); S[kt][i] = p; lsum += p; }
    lsum += __shfl_xor(lsum, 32);
    f32x16 O[2];
#pragma unroll
    for (int dt = 0; dt < 2; ++dt)
#pragma unroll
        for (int i = 0; i < 16; ++i) O[dt][i] = 0.f;
    const LAS bf16* vbase = Vl + (32 * wave + 4 * hl + ((lane & 15) >> 2)) * 72 + 16 * ((lane >> 4) & 1) + 4 * (lane & 3);
#pragma unroll
    for (int kt = 0; kt < 5; ++kt)
#pragma unroll
        for (int s2 = 0; s2 < 2; ++s2) {
            const u32x4 pw = (u32x4){pk2(S[kt][8 * s2 + 0], S[kt][8 * s2 + 1]), pk2(S[kt][8 * s2 + 2], S[kt][8 * s2 + 3]), pk2(S[kt][8 * s2 + 4], S[kt][8 * s2 + 5]), pk2(S[kt][8 * s2 + 6], S[kt][8 * s2 + 7])};
            const bf16x8 Pf = __builtin_bit_cast(bf16x8, pw);
#pragma unroll
            for (int dt = 0; dt < 2; ++dt) { const LAS bf16* vp = vbase + (32 * kt + 16 * s2) * 72 + 32 * dt;
                const s16x4 a0 = __builtin_amdgcn_ds_read_tr16_b64_v4i16((LAS s16x4*)vp), a1 = __builtin_amdgcn_ds_read_tr16_b64_v4i16((LAS s16x4*)(vp + 8 * 72));
                const bf16x8 Af = (bf16x8){a0[0], a0[1], a0[2], a0[3], a1[0], a1[1], a1[2], a1[3]};
                O[dt] = mfma32(Af, Pf, O[dt]); }
        }
    const float inv = 1.0f / lsum; const size_t R = (size_t)b * SEQ + rho + dil * (u0 + r);
    float* og = C_OG + ((size_t)g * TT + R) * 256 + hh * 64 + 4 * hl;
#pragma unroll
    for (int dt = 0; dt < 2; ++dt)
#pragma unroll
        for (int g4 = 0; g4 < 4; ++g4) *(f32x4*)(og + 32 * dt + 8 * g4) = (f32x4){O[dt][4 * g4 + 0] * inv, O[dt][4 * g4 + 1] * inv, O[dt][4 * g4 + 2] * inv, O[dt][4 * g4 + 3] * inv};
    if (hl == 0) C_LSE[((size_t)g * TT + R) * 4 + hh] = mx * 0.125f + __logf(lsum);
    __syncthreads();
}
__device__ __forceinline__ void dil_attn_sample_item(const Ctx& c, int sr, int hh, int e) {
    const int lane = c.lane, kg = lane >> 4, dl = lane & 15, R = TP + sr, n = sr >> 2, t = sr & 3;
    float m = -1e30f, l = 0.f, acc[4] = {0.f, 0.f, 0.f, 0.f};
#pragma unroll
    for (int g = 0; g < 3; ++g) {
        const int dil = (g == 0) ? 1 : (g == 1 ? 4 : 16), W = 128 * dil, jn = t / dil;
        float q[4]; unpk4(*(const u32x2*)(C_HB + (size_t)R * LDH + EC_QB + g * 256 + hh * 64 + 4 * dl), q);
#pragma unroll
        for (int i = 0; i < 4; ++i) q[i] *= 0.125f;
        { const int j = kg; const bool valid = j <= jn; const int tt = valid ? t - dil * j : t;
            const bf16* kp = C_HB + (size_t)(TP + n * 4 + tt) * LDH + g * 256 + hh * 64 + 4 * dl; float kf[4], vf[4]; unpk4(*(const u32x2*)(kp + EC_KB), kf); unpk4(*(const u32x2*)(kp + EC_VB), vf);
            float s = red16(q[0] * kf[0] + q[1] * kf[1] + q[2] * kf[2] + q[3] * kf[3]);
            if (valid) { const float mn = fmaxf(m, s), sc = __expf(m - mn), p = __expf(s - mn); l = l * sc + p;
#pragma unroll
                for (int i = 0; i < 4; ++i) acc[i] = acc[i] * sc + p * vf[i];
                m = mn; } }
        const float* cache = ((g == 0) ? C_IN(4) : (g == 1 ? C_IN(5) : C_IN(6))) + ((size_t)(e * 8 + n) * W) * 512 + hh * 64 + 4 * dl;
#pragma unroll 11
        for (int j0 = 0; j0 < 132; j0 += 4) { const int j = j0 + kg; const bool valid = (j > jn) && (j <= 128); const int idx = valid ? W + t - dil * j : 0;
            const float* kp = cache + (size_t)idx * 512; const f32x4 k4 = *(const f32x4*)kp, v4 = *(const f32x4*)(kp + 256);
            const float s = red16(q[0] * k4.x + q[1] * k4.y + q[2] * k4.z + q[3] * k4.w);
            if (valid) { const float mn = fmaxf(m, s), sc = __expf(m - mn), p = __expf(s - mn); l = l * sc + p;
                acc[0] = acc[0] * sc + p * v4.x; acc[1] = acc[1] * sc + p * v4.y; acc[2] = acc[2] * sc + p * v4.z; acc[3] = acc[3] * sc + p * v4.w; m = mn; } }
    }
#pragma unroll
    for (int off = 16; off <= 32; off <<= 1) {
        const float m2 = __shfl_xor(m, off), l2 = __shfl_xor(l, off); float a2[4];
#pragma unroll
        for (int i = 0; i < 4; ++i) a2[i] = __shfl_xor(acc[i], off);
        const float mn = fmaxf(m, m2), s1 = __expf(m - mn), s2 = __expf(m2 - mn);
        l = l * s1 + l2 * s2;
#pragma unroll
        for (int i = 0; i < 4; ++i) acc[i] = acc[i] * s1 + a2[i] * s2;
        m = mn;
    }
    if (kg == 0) { float gt[4]; unpk4(*(const u32x2*)(C_HB + (size_t)R * LDH + EC_GB + hh * 64 + 4 * dl), gt);
        const float inv = 1.0f / l; float o[4];
#pragma unroll
        for (int i = 0; i < 4; ++i) o[i] = acc[i] * inv * siluf_(gt[i]);
        *(u32x2*)(C_U + (size_t)R * EVEN_OUT + 768 + hh * 64 + 4 * dl) = (u32x2){pk2(o[0], o[1]), pk2(o[2], o[3])}; }
}


__device__ __forceinline__ void mem_attn_sample_block(const Ctx& c, int item, int l, int qcol, int gcol, int ucol, int ldu) {
    const int sr = item >> 2, mh = item & 3, R = TP + sr, lane = c.lane, kg = lane >> 5, dl = lane & 31, wave = c.wave;
    const float* mkv = C_IN(8) + ((size_t)l * 8 + (sr >> 2)) * 256 * 1024 + mh * 128 + 4 * dl;
    float q[4]; unpk4(*(const u32x2*)(C_HB + (size_t)R * LDH + qcol + mh * 128 + 4 * dl), q);
#pragma unroll
    for (int i = 0; i < 4; ++i) q[i] *= 0.08838834764831845f;
    float m = -1e30f, lsum = 0.f, acc[4] = {0.f, 0.f, 0.f, 0.f};
    f32x4 kv[16], vv[16];
#pragma unroll
    for (int jr = 0; jr < 16; ++jr) { const float* kp = mkv + (size_t)(32 * wave + 2 * jr + kg) * 1024; kv[jr] = *(const f32x4*)kp; vv[jr] = *(const f32x4*)(kp + 512); }
#pragma unroll
    for (int jr = 0; jr < 16; ++jr) { const f32x4 k4 = kv[jr], v4 = vv[jr];
        float s = q[0] * k4.x + q[1] * k4.y + q[2] * k4.z + q[3] * k4.w;
        s = red16(s); s += __shfl_xor(s, 16);
        const float mn = fmaxf(m, s), sc = __expf(m - mn), p = __expf(s - mn);
        lsum = lsum * sc + p; acc[0] = acc[0] * sc + p * v4.x; acc[1] = acc[1] * sc + p * v4.y; acc[2] = acc[2] * sc + p * v4.z; acc[3] = acc[3] * sc + p * v4.w; m = mn; }
    { const float m2 = __shfl_xor(m, 32), l2 = __shfl_xor(lsum, 32); float a2[4];
#pragma unroll
        for (int i = 0; i < 4; ++i) a2[i] = __shfl_xor(acc[i], 32);
        const float mn = fmaxf(m, m2), s1 = __expf(m - mn), s2 = __expf(m2 - mn);
        lsum = lsum * s1 + l2 * s2; m = mn;
#pragma unroll
        for (int i = 0; i < 4; ++i) acc[i] = acc[i] * s1 + a2[i] * s2; }
    LAS float* part = (LAS float*)c.lds;
    if (kg == 0) { LAS float* pp = part + (wave * 32 + dl) * 6; pp[0] = m; pp[1] = lsum; pp[2] = acc[0]; pp[3] = acc[1]; pp[4] = acc[2]; pp[5] = acc[3]; }
    __syncthreads();
    if (wave == 0 && kg == 0) {
        float M = -1e30f, Lr = 0.f, A[4] = {0.f, 0.f, 0.f, 0.f};
#pragma unroll
        for (int w = 0; w < 8; ++w) { const LAS float* pp = part + (w * 32 + dl) * 6; const float m2 = pp[0], mn = fmaxf(M, m2), s1 = __expf(M - mn), s2 = __expf(m2 - mn);
            Lr = Lr * s1 + pp[1] * s2; A[0] = A[0] * s1 + pp[2] * s2; A[1] = A[1] * s1 + pp[3] * s2; A[2] = A[2] * s1 + pp[4] * s2; A[3] = A[3] * s1 + pp[5] * s2; M = mn; }
        float gt[4]; unpk4(*(const u32x2*)(C_HB + (size_t)R * LDH + gcol + mh * 128 + 4 * dl), gt);
        const float inv = 1.0f / Lr;
        *(u32x2*)(C_U + (size_t)R * ldu + ucol + mh * 128 + 4 * dl) = (u32x2){pk2(A[0] * inv * siluf_(gt[0]), A[1] * inv * siluf_(gt[1])), pk2(A[2] * inv * siluf_(gt[2]), A[3] * inv * siluf_(gt[3]))}; }
    __syncthreads();
}
__device__ __forceinline__ void dil_attn_sample_block(const Ctx& c, int item, int e) {
    const int sr = item >> 2, hh = item & 3, lane = c.lane, kg = lane >> 4, dl = lane & 15, wave = c.wave, R = TP + sr, n = sr >> 2, t = sr & 3;
    float m = -1e30f, l = 0.f, acc[4] = {0.f, 0.f, 0.f, 0.f};
#pragma unroll
    for (int g = 0; g < 3; ++g) {
        const int dil = (g == 0) ? 1 : (g == 1 ? 4 : 16), W = 128 * dil, jn = t / dil;
        float q[4]; unpk4(*(const u32x2*)(C_HB + (size_t)R * LDH + EC_QB + g * 256 + hh * 64 + 4 * dl), q);
#pragma unroll
        for (int i = 0; i < 4; ++i) q[i] *= 0.125f;
        if (wave == 0) { const int j = kg; const bool valid = j <= jn; const int tt = valid ? t - dil * j : t;
            const bf16* kp = C_HB + (size_t)(TP + n * 4 + tt) * LDH + g * 256 + hh * 64 + 4 * dl; float kf[4], vf[4]; unpk4(*(const u32x2*)(kp + EC_KB), kf); unpk4(*(const u32x2*)(kp + EC_VB), vf);
            float s = red16(q[0] * kf[0] + q[1] * kf[1] + q[2] * kf[2] + q[3] * kf[3]);
            if (valid) { const float mn = fmaxf(m, s), sc = __expf(m - mn), p = __expf(s - mn); l = l * sc + p;
#pragma unroll
                for (int i = 0; i < 4; ++i) acc[i] = acc[i] * sc + p * vf[i];
                m = mn; } }
        const float* cache = ((g == 0) ? C_IN(4) : (g == 1 ? C_IN(5) : C_IN(6))) + ((size_t)(e * 8 + n) * W) * 512 + hh * 64 + 4 * dl;
        f32x4 kv[5], vv[5]; bool ok[5];
#pragma unroll
        for (int jr = 0; jr < 5; ++jr) { const int jo = 4 * jr + kg, j = 17 * wave + jo; ok[jr] = (jo < 17) && (j > jn) && (j <= 128); const int idx = ok[jr] ? W + t - dil * j : 0;
            const float* kp = cache + (size_t)idx * 512; kv[jr] = *(const f32x4*)kp; vv[jr] = *(const f32x4*)(kp + 256); }
#pragma unroll
        for (int jr = 0; jr < 5; ++jr) { const f32x4 k4 = kv[jr], v4 = vv[jr];
            const float s = red16(q[0] * k4.x + q[1] * k4.y + q[2] * k4.z + q[3] * k4.w);
            if (ok[jr]) { const float mn = fmaxf(m, s), sc = __expf(m - mn), p = __expf(s - mn); l = l * sc + p;
                acc[0] = acc[0] * sc + p * v4.x; acc[1] = acc[1] * sc + p * v4.y; acc[2] = acc[2] * sc + p * v4.z; acc[3] = acc[3] * sc + p * v4.w; m = mn; } }
    }
#pragma unroll
    for (int off = 16; off <= 32; off <<= 1) {
        const float m2 = __shfl_xor(m, off), l2 = __shfl_xor(l, off); float a2[4];
#pragma unroll
        for (int i = 0; i < 4; ++i) a2[i] = __shfl_xor(acc[i], off);
        const float mn = fmaxf(m, m2), s1 = __expf(m - mn), s2 = __expf(m2 - mn);
        l = l * s1 + l2 * s2;
#pragma unroll
        for (int i = 0; i < 4; ++i) acc[i] = acc[i] * s1 + a2[i] * s2;
        m = mn;
    }
    LAS float* part = (LAS float*)c.lds;
    if (kg == 0) { LAS float* pp = part + (wave * 16 + dl) * 6; pp[0] = m; pp[1] = l; pp[2] = acc[0]; pp[3] = acc[1]; pp[4] = acc[2]; pp[5] = acc[3]; }
    __syncthreads();
    if (wave == 0 && kg == 0) {
        float M = -1e30f, Lr = 0.f, A[4] = {0.f, 0.f, 0.f, 0.f};
#pragma unroll
        for (int w = 0; w < 8; ++w) { const LAS float* pp = part + (w * 16 + dl) * 6; const float m2 = pp[0], mn = fmaxf(M, m2), s1 = __expf(M - mn), s2 = __expf(m2 - mn);
            Lr = Lr * s1 + pp[1] * s2; A[0] = A[0] * s1 + pp[2] * s2; A[1] = A[1] * s1 + pp[3] * s2; A[2] = A[2] * s1 + pp[4] * s2; A[3] = A[3] * s1 + pp[5] * s2; M = mn; }
        float gt[4]; unpk4(*(const u32x2*)(C_HB + (size_t)R * LDH + EC_GB + hh * 64 + 4 * dl), gt);
        const float inv = 1.0f / Lr;
        *(u32x2*)(C_U + (size_t)R * EVEN_OUT + 768 + hh * 64 + 4 * dl) = (u32x2){pk2(A[0] * inv * siluf_(gt[0]), A[1] * inv * siluf_(gt[1])), pk2(A[2] * inv * siluf_(gt[2]), A[3] * inv * siluf_(gt[3]))}; }
    __syncthreads();
}

__device__ __forceinline__ void even_copies(const Ctx& c, int e) {
    const int gt = c.bid * 512 + c.tid, NT = c.G * 512;
    for (int i = gt; i < 10 * 304; i += NT) { const int rw = i / 304, c8 = 8 * (i % 304);
        const size_t src = (rw < 2) ? (size_t)(rw * SEQ + SEQ - 1) : (size_t)(TP + (rw - 2) * 4 + 3);
        float x[8]; unpk8(*(const u32x4*)(C_HB + src * LDH + c8), x);
        float* dst = (rw < 2) ? C_OUT + O_SH_P + ((size_t)e * 2 + rw) * 2432 + c8 : C_OUT + O_SH_S + ((size_t)e * 8 + (rw - 2)) * 2432 + c8;
        *(f32x4*)dst = (f32x4){x[0], x[1], x[2], x[3]}; *(f32x4*)(dst + 4) = (f32x4){x[4], x[5], x[6], x[7]}; }
#pragma unroll 1
    for (int g = 0; g < 3; ++g) {
        const int keep = 128 << (2 * g); const size_t op = (g == 0) ? O_G0P : (g == 1 ? O_G1P : O_G2P), os = (g == 0) ? O_G0S : (g == 1 ? O_G1S : O_G2S);
        for (int i = gt; i < 2 * keep * 64; i += NT) { const int pc = i & 63, r = (i >> 6) % keep, b = (i >> 6) / keep;
            const int col = ((pc & 32) ? EC_VB : EC_KB) + g * 256 + 8 * (pc & 31);
            float x[8]; unpk8(*(const u32x4*)(C_HB + (size_t)(b * SEQ + SEQ - keep + r) * LDH + col), x);
            float* dst = C_OUT + op + ((size_t)e * 2 * keep + (size_t)b * keep + r) * 512 + 8 * pc;
            *(f32x4*)dst = (f32x4){x[0], x[1], x[2], x[3]}; *(f32x4*)(dst + 4) = (f32x4){x[4], x[5], x[6], x[7]}; }
        for (int i = gt; i < 8 * 4 * 64; i += NT) { const int pc = i & 63, row = i >> 6;
            const int col = ((pc & 32) ? EC_VB : EC_KB) + g * 256 + 8 * (pc & 31);
            float x[8]; unpk8(*(const u32x4*)(C_HB + (size_t)(TP + row) * LDH + col), x);
            float* dst = C_OUT + os + ((size_t)e * 32 + row) * 512 + 8 * pc;
            *(f32x4*)dst = (f32x4){x[0], x[1], x[2], x[3]}; *(f32x4*)(dst + 4) = (f32x4){x[4], x[5], x[6], x[7]}; }
    }
}

#define LAUNDER_C(c) do { asm volatile("" : "+s"((c).ap), "+v"((c).tid), "+s"((c).bid), "+s"((c).G)); (c).lane = (c).tid & 63; (c).wave = __builtin_amdgcn_readfirstlane((c).tid >> 6); } while (0)
__device__ __forceinline__ void phase_even_tok_pre(Ctx c, int l);
__device__ __forceinline__ void even_helper_work(Ctx c, int l) {
    const int e = l >> 1;
    for (int rp = 0; rp < REPD; ++rp) { for (int it = c.bid; it < 384; it += c.G) dil_attn_mfma_item(c, it);
    LAUNDER_C(c); }
    for (int it = c.G - 1 - c.bid; it < TS * 4; it += c.G) dil_attn_sample_block(c, it, e);
    LAUNDER_C(c);
    for (int rp = 0; rp < REPM; ++rp) { mem_attn_all(c, l, EC_QM, EC_GM, 1024, EVEN_OUT);
    LAUNDER_C(c); }
    even_copies(c, e);
    LAUNDER_C(c);
    for (int rp = 0; rp < REPC; ++rp) { if (l < 3) convert_layer_weights(c, l + 1); LAUNDER_C(c); }
}

__device__ __forceinline__ void rwkv_scan_item(const Ctx& c, int item, int e) {
    constexpr int CH = 32;
    LAS float* buf = (LAS float*)c.lds;
    LAS float* ybuf = buf + 2 * CH * 384;
    const bool is_p = item < 48; const int st = is_p ? (item >> 1) : ((item - 48) >> 1), half = item & 1;
    const int h = st % 12, bn = st / 12; const int T = is_p ? SEQ : 4; const size_t tok0 = is_p ? (size_t)bn * SEQ : (size_t)(TP + bn * 4);
    const int lane = c.lane, rw = lane >> 4, cgp = lane & 15, il = 4 * c.wave + rw, i = 32 * half + il;
    float s[4];
    if (is_p) { s[0] = s[1] = s[2] = s[3] = 0.f; }
    else { const f32x4 v = *(const f32x4*)(C_IN(2) + ((((size_t)e * 8 + bn) * 12 + h) * 64 + i) * 64 + 4 * cgp); s[0] = v.x; s[1] = v.y; s[2] = v.z; s[3] = v.w; }
    const int nch = (T + CH - 1) / CH;
    f32x4 pre[6];
#define SCAN_GLOAD(ch_) do { _Pragma("unroll") for (int k = 0; k < 6; ++k) { const int idx = c.tid + 512 * k, tl_ = idx / 96, f4 = idx % 96; const int tk = (ch_) * CH + tl_; \
            pre[k] = (tk < T) ? *(const f32x4*)(C_PREPS + ((tok0 - TP + tk) * 12 + h) * 384 + 4 * f4) : (f32x4){0.f, 0.f, 0.f, 0.f}; } } while (0)
#define SCAN_LSTORE(bi_) do { _Pragma("unroll") for (int k = 0; k < 6; ++k) { const int idx = c.tid + 512 * k; *(LAS f32x4*)(buf + (bi_) * CH * 384 + 4 * idx) = pre[k]; } } while (0)
    SCAN_GLOAD(0); SCAN_LSTORE(0); __syncthreads();
#pragma unroll 1
    for (int ch = 0; ch < nch; ++ch) {
        if (ch + 1 < nch) SCAN_GLOAD(ch + 1);
        const LAS float* bb = buf + (ch & 1) * CH * 384;
        const int nt = (T - ch * CH) < CH ? (T - ch * CH) : CH;
#pragma unroll 2
        for (int tl = 0; tl < nt; ++tl) {
            const LAS float* p = bb + tl * 384;
            const f32x4 r4 = *(const LAS f32x4*)(p + 4 * cgp), d4 = *(const LAS f32x4*)(p + 64 + 4 * cgp), k4 = *(const LAS f32x4*)(p + 128 + 4 * cgp),
                        kk4 = *(const LAS f32x4*)(p + 256 + 4 * cgp), b4 = *(const LAS f32x4*)(p + 320 + 4 * cgp);
            const float vi = p[192 + i];
            float sa = s[0] * kk4.x + s[1] * kk4.y + s[2] * kk4.z + s[3] * kk4.w;
            sa = red16(sa);
            s[0] = s[0] * d4.x + (sa * b4.x + vi * k4.x); s[1] = s[1] * d4.y + (sa * b4.y + vi * k4.y);
            s[2] = s[2] * d4.z + (sa * b4.z + vi * k4.z); s[3] = s[3] * d4.w + (sa * b4.w + vi * k4.w);
            float y = s[0] * r4.x + s[1] * r4.y + s[2] * r4.z + s[3] * r4.w;
            y = red16(y);
            if (cgp == 0) ybuf[tl * 32 + il] = y;
        }
        __syncthreads();
        if (ch + 1 < nch) SCAN_LSTORE((ch + 1) & 1);
        for (int idx = c.tid; idx < nt * 32; idx += 512) { const int tl = idx >> 5, r = idx & 31; C_YA[(tok0 + ch * CH + tl) * 768 + h * 64 + 32 * half + r] = ybuf[idx]; }
        __syncthreads();
    }
    float* so = C_OUT + (is_p ? O_RWKV_P + (((size_t)e * 2 + bn) * 12 + h) * 4096 : O_RWKV_S + (((size_t)e * 8 + bn) * 12 + h) * 4096) + (size_t)i * 64 + 4 * cgp;
    *(f32x4*)so = (f32x4){s[0], s[1], s[2], s[3]};
}

typedef float f32x2 __attribute__((ext_vector_type(2)));
__device__ __forceinline__ void rwkv_scan_prompt(const Ctx& c, int item, int e) {
    constexpr int CH = 32, NCH = SEQ / CH;
    LAS float* buf = (LAS float*)c.lds;
    LAS float* ybuf = buf + 2 * CH * 384;
    const int st = item >> 1, half = item & 1, h = st % 12, bn = st / 12; const size_t tok0 = (size_t)bn * SEQ;
    const int lane = c.lane, rw = lane >> 4, cgp = lane & 15, il = 4 * c.wave + rw, i = 32 * half + il;
    f32x2 s01 = (f32x2){0.f, 0.f}, s23 = (f32x2){0.f, 0.f};
    const float* src = C_PREP + (tok0 * 12 + h) * 384;
    float* ya = C_YA + tok0 * 768 + h * 64 + 32 * half;
    f32x4 pre[6];
#define SP_GLOAD(ch_) do { _Pragma("unroll") for (int k = 0; k < 6; ++k) { const int idx = c.tid + 512 * k, tl_ = idx / 96, f4 = idx % 96; \
        pre[k] = *(const f32x4*)(src + (size_t)((ch_) * CH + tl_) * (12 * 384) + 4 * f4); } } while (0)
#define SP_LSTORE(bi_) do { _Pragma("unroll") for (int k = 0; k < 6; ++k) { const int idx = c.tid + 512 * k; *(LAS f32x4*)(buf + (bi_) * CH * 384 + 4 * idx) = pre[k]; } } while (0)
#define SP_YOUT(ch_) do { for (int idx = c.tid; idx < CH * 32; idx += 512) { const int tl_ = idx >> 5, r_ = idx & 31; ya[(size_t)((ch_) * CH + tl_) * 768 + r_] = ybuf[((ch_) & 1) * CH * 32 + idx]; } } while (0)
    SP_GLOAD(0); SP_LSTORE(0); SP_GLOAD(1); __syncthreads();
#pragma unroll 1
    for (int ch = 0; ch < NCH; ++ch) {
        if (ch + 1 < NCH) SP_LSTORE((ch + 1) & 1);
        if (ch + 2 < NCH) SP_GLOAD(ch + 2);
        if (ch > 0) SP_YOUT(ch - 1);
        const LAS float* bb = buf + (ch & 1) * CH * 384 + 4 * cgp; const LAS float* vb = buf + (ch & 1) * CH * 384 + 192 + i;
        LAS float* yw = (cgp == 0) ? (ybuf + (ch & 1) * CH * 32 + il) : (ybuf + 2 * CH * 32 + lane);
        f32x4 r4 = *(const LAS f32x4*)bb, d4 = *(const LAS f32x4*)(bb + 64), k4 = *(const LAS f32x4*)(bb + 128), n4 = *(const LAS f32x4*)(bb + 256), b4 = *(const LAS f32x4*)(bb + 320); float vi = vb[0];
        float sa;
        { f32x2 p = s01 * (f32x2){n4.x, n4.y}; p = s23 * (f32x2){n4.z, n4.w} + p; sa = red16(p.x + p.y); }
#pragma unroll 4
        for (int tl = 0; tl < CH; ++tl) {
            const int tn = (tl + 1 < CH) ? tl + 1 : tl;
            const f32x4 r4n = *(const LAS f32x4*)(bb + tn * 384), d4n = *(const LAS f32x4*)(bb + tn * 384 + 64), k4n = *(const LAS f32x4*)(bb + tn * 384 + 128),
                        n4n = *(const LAS f32x4*)(bb + tn * 384 + 256), b4n = *(const LAS f32x4*)(bb + tn * 384 + 320); const float vin = vb[tn * 384];
            const f32x2 vi2 = (f32x2){vi, vi}, sa2 = (f32x2){sa, sa};
            const f32x2 u01 = s01 * (f32x2){d4.x, d4.y} + vi2 * (f32x2){k4.x, k4.y}, u23 = s23 * (f32x2){d4.z, d4.w} + vi2 * (f32x2){k4.z, k4.w};
            s01 = sa2 * (f32x2){b4.x, b4.y} + u01; s23 = sa2 * (f32x2){b4.z, b4.w} + u23;
            f32x2 yp = s01 * (f32x2){r4.x, r4.y}; yp = s23 * (f32x2){r4.z, r4.w} + yp;
            f32x2 pn = s01 * (f32x2){n4n.x, n4n.y}; pn = s23 * (f32x2){n4n.z, n4n.w} + pn;
            float ya_ = yp.x + yp.y, sb_ = pn.x + pn.y;
            sb_ += dppf<0xB1>(sb_); ya_ += dppf<0xB1>(ya_); sb_ += dppf<0x4E>(sb_); ya_ += dppf<0x4E>(ya_);
            sb_ += dppf<0x141>(sb_); ya_ += dppf<0x141>(ya_); sb_ += dppf<0x140>(sb_); ya_ += dppf<0x140>(ya_);
            sa = sb_;
            yw[tl * 32] = ya_;
            r4 = r4n; d4 = d4n; k4 = k4n; n4 = n4n; b4 = b4n; vi = vin;
        }
        __syncthreads();
    }
    SP_YOUT(NCH - 1);
    float* so = C_OUT + O_RWKV_P + (((size_t)e * 2 + bn) * 12 + h) * 4096 + (size_t)i * 64 + 4 * cgp;
    *(f32x4*)so = (f32x4){s01.x, s01.y, s23.x, s23.y};
    __syncthreads();
#undef SP_GLOAD
#undef SP_LSTORE
#undef SP_YOUT
}

struct PreIn { u32x2 cr, ck, cv, pr, pk, pv; float hcur[8], hprv[8]; };
__device__ __forceinline__ void rwkv_chunk_preload(const Ctx& c, int item, int e, PreIn& P) {
    const bool is_s = item >= 3072; const int sidx = item - 3072;
    const int bh = item >> 7, n = is_s ? 1 : (item & 127), b = bh / 12, h = is_s ? (sidx % 12) : (bh % 12), ns = sidx / 12;
    const size_t R0 = is_s ? (size_t)(TP + 4 * ns) : (size_t)b * SEQ + 32 * n;
    const float* shift = C_IN(3) + ((size_t)e * 8 + ns) * 2432;
    const int tid = c.tid, t_ = tid >> 4, c4 = 4 * (tid & 15), col = h * 64 + c4;
    const bf16* hc = C_HB + (R0 + t_) * LDH + col; const bool hasprev = is_s ? (t_ != 0) : ((32 * n + t_) != 0);
    const u32x2 z2 = (u32x2){0u, 0u};
    P.cr = *(const u32x2*)(hc + EC_R); P.ck = *(const u32x2*)(hc + EC_K); P.cv = *(const u32x2*)(hc + EC_V);
    P.pr = hasprev ? *(const u32x2*)(hc - LDH + EC_R) : z2; P.pk = hasprev ? *(const u32x2*)(hc - LDH + EC_K) : z2; P.pv = hasprev ? *(const u32x2*)(hc - LDH + EC_V) : z2;
    const int cc = tid & 127, cl = EC_HW + cc, tb = tid >> 7;
#pragma unroll
    for (int k = 0; k < 8; ++k) { const int t = tb + 4 * k; P.hcur[k] = bf2f(C_HB[(R0 + t) * LDH + cl]);
        P.hprv[k] = is_s ? (t != 0 ? bf2f(C_HB[(R0 + t - 1) * LDH + cl]) : shift[cl]) : (((32 * n + t) != 0) ? bf2f(C_HB[(R0 + t - 1) * LDH + cl]) : 0.f); }
}
__device__ __forceinline__ void rwkv_chunk_precompute(const Ctx& c, int item, int e, const PreIn& P) {
    const bool is_s = item >= 3072; const int sidx = item - 3072;
    const int bh = item >> 7, n = is_s ? 1 : (item & 127), b = bh / 12, h = is_s ? (sidx % 12) : (bh % 12), ns = sidx / 12, ntok = is_s ? 4 : 32;
    const size_t R0 = is_s ? (size_t)(TP + 4 * ns) : (size_t)b * SEQ + 32 * n;
    const float* shift = C_IN(3) + ((size_t)e * 8 + ns) * 2432;
    LAS unsigned char* L = c.lds;
    LAS float* XW = (LAS float*)(L + 0); LAS float* XA = (LAS float*)(L + 8192);
    LAS bf16* LW = (LAS bf16*)(L + 16384); LAS bf16* LA = (LAS bf16*)(L + 20992);
    LAS float* PS = (LAS float*)(L + 25600);
    LAS bf16* KKt = (LAS bf16*)(L + 33792); LAS bf16* Bt = (LAS bf16*)(L + 38400); LAS bf16* Kt = (LAS bf16*)(L + 43008); LAS bf16* Rt = (LAS bf16*)(L + 47616);
    LAS bf16* Bh = (LAS bf16*)(L + 52224); LAS bf16* Kh = (LAS bf16*)(L + 56832); LAS bf16* Vb = (LAS bf16*)(L + 61440);
    LAS float* LB = (LAS float*)(L + 66048);
    LAS bf16* Lk = (LAS bf16*)(L + 70144); LAS bf16* Mb = (LAS bf16*)(L + 72704); LAS bf16* Mk = (LAS bf16*)(L + 75264);
    LAS float* SOL = (LAS float*)(L + 77824);
    LAS bf16* KTb = (LAS bf16*)(L + 94208); LAS bf16* UVb = (LAS bf16*)(L + 98816);
    LAS float* RTf = (LAS float*)(L + 103424); LAS float* c31 = (LAS float*)(L + 111616);
    const int tid = c.tid, lane = c.lane, wave = c.wave, fr = lane & 15, fq = lane >> 4, trow = (lane & 15) >> 2, tcol = 4 * (lane & 3);
    const int t_ = tid >> 4, c4 = 4 * (tid & 15), col = h * 64 + c4;
    const float* mu = C_IN(17) + e * 2432;
    const bf16* hc = C_HB + (R0 + t_) * LDH + col; const bool hasprev = is_s ? (t_ != 0) : ((32 * n + t_) != 0);
    const u32x2 cr = P.cr, ck = P.ck, cv = P.cv, pr = P.pr, pk = P.pk, pv = P.pv;
    f32x4 sh_r = (f32x4){0.f, 0.f, 0.f, 0.f}, sh_k = sh_r, sh_v = sh_r;
    if (is_s && t_ == 0) { sh_r = *(const f32x4*)(shift + EC_R + col); sh_k = *(const f32x4*)(shift + EC_K + col); sh_v = *(const f32x4*)(shift + EC_V + col); }
    { const int cc = tid & 127, cl = EC_HW + cc, tb = tid >> 7; const float muc = mu[cl];
#pragma unroll
        for (int k = 0; k < 8; ++k) { const int t = tb + 4 * k; const float hs = P.hcur[k] + (P.hprv[k] - P.hcur[k]) * muc;
            if (cc < 64) LW[t * 72 + cc] = (bf16)f2bf(1.0f - 2.0f / (1.0f + __expf(2.0f * hs))); else LA[t * 72 + cc - 64] = (bf16)f2bf(hs); } }
    __syncthreads();
    { const int p = wave >> 2, tt = (wave >> 1) & 1; const LAS bf16* As = p ? LA : LW; const bf16* WT = (p ? C_AUT : C_WUT) + ((size_t)e * 768 + h * 64) * 64; LAS float* X = p ? XA : XW;
#pragma unroll
        for (int cc = 0; cc < 2; ++cc) { const int ct = 2 * (wave & 1) + cc; f32x4 acc = (f32x4){0.f, 0.f, 0.f, 0.f};
#pragma unroll
            for (int ks = 0; ks < 2; ++ks) acc = mfma16(*(const LAS bf16x8*)(As + (16 * tt + fr) * 72 + 32 * ks + 8 * fq), *(const bf16x8*)(WT + (size_t)(16 * ct + fr) * 64 + 32 * ks + 8 * fq), acc);
#pragma unroll
            for (int r = 0; r < 4; ++r) X[(16 * tt + 4 * fq + r) * 64 + 16 * ct + fr] = acc[r]; } }
    __syncthreads();
    float rr[4], k2[4], vv[4], kkv[4], bb[4];
    for (int rep3 = 0; rep3 < REP3; ++rep3) { asm volatile("" ::: "memory");
    { const f32x4 xw4 = *(const LAS f32x4*)(XW + t_ * 64 + c4), xa4 = *(const LAS f32x4*)(XA + t_ * 64 + c4);
        const f32x4 w04 = *(const f32x4*)(C_IN(18) + e * 768 + col), a04 = *(const f32x4*)(C_IN(20) + e * 768 + col), kk4 = *(const f32x4*)(C_IN(22) + e * 768 + col), ka4 = *(const f32x4*)(C_IN(23) + e * 768 + col),
                    rk4 = *(const f32x4*)(C_IN(24) + e * 768 + col), mr4 = *(const f32x4*)(mu + EC_R + col), mk4 = *(const f32x4*)(mu + EC_K + col), mv4 = *(const f32x4*)(mu + EC_V + col);
        float crf[4], ckf[4], cvf[4], prf[4], pkf[4], pvf[4]; unpk4(cr, crf); unpk4(ck, ckf); unpk4(cv, cvf); unpk4(pr, prf); unpk4(pk, pkf); unpk4(pv, pvf);
        const bool tok_ok = t_ < ntok;
#pragma unroll
        for (int i = 0; i < 4; ++i) { prf[i] += sh_r[i]; pkf[i] += sh_k[i]; pvf[i] += sh_v[i]; }
        float wl[4], av[4], ssum = 0.f, bsum = 0.f;
#pragma unroll
        for (int i = 0; i < 4; ++i) { const float r = crf[i] + (prf[i] - crf[i]) * mr4[i], k = ckf[i] + (pkf[i] - ckf[i]) * mk4[i], v = cvf[i] + (pvf[i] - cvf[i]) * mv4[i];
            wl[i] = -0.6065306597126334f * sigmoidf_(w04[i] + xw4[i]); av[i] = sigmoidf_(a04[i] + xa4[i]);
            const float kk = tok_ok ? k * kk4[i] : 0.f; ssum += kk * kk; kkv[i] = kk; k2[i] = tok_ok ? k * (1.0f + (av[i] - 1.0f) * ka4[i]) : 0.f; rr[i] = tok_ok ? r : 0.f; vv[i] = tok_ok ? v : 0.f; bsum += rr[i] * k2[i] * rk4[i];
            if (!tok_ok) wl[i] = 0.f; }
        ssum = red16(ssum); bsum = red16(bsum); const float inv = rsqrtf(fmaxf(ssum, 1e-24f));
#pragma unroll
        for (int i = 0; i < 4; ++i) { kkv[i] *= inv; bb[i] = kkv[i] * av[i]; }
        if ((tid & 15) == 0 && tok_ok) C_BONUS[(R0 + t_) * 12 + h] = bsum;
        *(LAS f32x4*)(PS + t_ * 64 + c4) = (f32x4){wl[0], wl[1], wl[2], wl[3]}; }
    __syncthreads();
    if (tid < 64) { float run = 0.f;
#pragma unroll 8
        for (int t = 0; t < 32; ++t) { run += PS[t * 64 + tid]; PS[t * 64 + tid] = run; } }
    __syncthreads();
    { const f32x4 pt = *(const LAS f32x4*)(PS + t_ * 64 + c4), pe = *(const LAS f32x4*)(PS + 31 * 64 + c4); const f32x4 pp = (t_ > 0) ? *(const LAS f32x4*)(PS + (t_ - 1) * 64 + c4) : (f32x4){0.f, 0.f, 0.f, 0.f};
        float o_kk[4], o_b[4], o_k[4], o_r[4], o_bh[4], o_kh[4];
#pragma unroll
        for (int i = 0; i < 4; ++i) { const float ct = __expf(pt[i]), cp = __expf(pp[i]), ci = __expf(-pt[i]), chh = __expf(pe[i] - pt[i]);
            o_kk[i] = kkv[i] * cp; o_b[i] = bb[i] * ci; o_k[i] = k2[i] * ci; o_r[i] = rr[i] * ct; o_bh[i] = bb[i] * chh; o_kh[i] = k2[i] * chh; }
        *(LAS u32x2*)(KKt + t_ * 72 + c4) = (u32x2){pk2(o_kk[0], o_kk[1]), pk2(o_kk[2], o_kk[3])}; *(LAS u32x2*)(Bt + t_ * 72 + c4) = (u32x2){pk2(o_b[0], o_b[1]), pk2(o_b[2], o_b[3])};
        *(LAS u32x2*)(Kt + t_ * 72 + c4) = (u32x2){pk2(o_k[0], o_k[1]), pk2(o_k[2], o_k[3])}; *(LAS u32x2*)(Rt + t_ * 72 + c4) = (u32x2){pk2(o_r[0], o_r[1]), pk2(o_r[2], o_r[3])};
        *(LAS u32x2*)(Bh + t_ * 72 + c4) = (u32x2){pk2(o_bh[0], o_bh[1]), pk2(o_bh[2], o_bh[3])}; *(LAS u32x2*)(Kh + t_ * 72 + c4) = (u32x2){pk2(o_kh[0], o_kh[1]), pk2(o_kh[2], o_kh[3])};
        *(LAS u32x2*)(Vb + t_ * 72 + c4) = (u32x2){pk2(vv[0], vv[1]), pk2(vv[2], vv[3])};
        *(LAS f32x4*)(RTf + t_ * 64 + c4) = (f32x4){o_r[0], o_r[1], o_r[2], o_r[3]}; *(LAS f32x4*)(SOL + t_ * 128 + c4) = (f32x4){o_kk[0], o_kk[1], o_kk[2], o_kk[3]};
        if (t_ == 31) *(LAS f32x4*)(c31 + c4) = (f32x4){__expf(pt[0]), __expf(pt[1]), __expf(pt[2]), __expf(pt[3])}; }
    __syncthreads(); }
    { const int m = wave >> 1, tt = wave & 1; const LAS bf16* X = (m < 2) ? KKt : Rt; const LAS bf16* Yv = (m & 1) ? Kt : Bt;
#pragma unroll
        for (int st = 0; st < 2; ++st) { f32x4 acc = (f32x4){0.f, 0.f, 0.f, 0.f};
            if (st <= tt) {
#pragma unroll
                for (int ks = 0; ks < 2; ++ks) acc = mfma16(*(const LAS bf16x8*)(X + (16 * tt + fr) * 72 + 32 * ks + 8 * fq), *(const LAS bf16x8*)(Yv + (16 * st + fr) * 72 + 32 * ks + 8 * fq), acc); }
#pragma unroll
            for (int r = 0; r < 4; ++r) { const int t = 16 * tt + 4 * fq + r, s_ = 16 * st + fr; const bool keep = (m < 2) ? (s_ < t) : (s_ <= t); const float val = keep ? acc[r] : 0.f;
                if (m == 0) LB[t * 32 + (s_ & 3) * 8 + (s_ >> 2)] = val; else if (m == 1) Lk[t * 40 + s_] = (bf16)f2bf(val); else if (m == 2) Mb[t * 40 + s_] = (bf16)f2bf(val); else Mk[t * 40 + s_] = (bf16)f2bf(val); } } }
    __syncthreads();
    { const int tt = wave >> 2, ict = wave & 3;
        const f32x4 acc = mfma16(*(const LAS bf16x8*)(Lk + (16 * tt + fr) * 40 + 8 * fq), tr_frag(Vb + (8 * fq + trow) * 72 + 16 * ict + tcol, 4 * 72), (f32x4){0.f, 0.f, 0.f, 0.f});
#pragma unroll
        for (int r = 0; r < 4; ++r) SOL[(16 * tt + 4 * fq + r) * 128 + 64 + 16 * ict + fr] = acc[r]; }
    __syncthreads();
    { const int cidx = tid >> 2, q = tid & 3; float xq[8];
#pragma unroll
        for (int u = 0; u < 8; ++u) xq[u] = 0.f;
#pragma unroll
        for (int t = 0; t < 32; ++t) { float part = 0.f;
            if (t > 0) { const f32x4 la = *(const LAS f32x4*)(LB + t * 32 + q * 8); part = la[0] * xq[0];
                if (t > 4) part += la[1] * xq[1]; if (t > 8) part += la[2] * xq[2]; if (t > 12) part += la[3] * xq[3];
                if (t > 16) { const f32x4 lb = *(const LAS f32x4*)(LB + t * 32 + q * 8 + 4); part += lb[0] * xq[4];
                    if (t > 20) part += lb[1] * xq[5]; if (t > 24) part += lb[2] * xq[6]; if (t > 28) part += lb[3] * xq[7]; }
                part += dppf<0xB1>(part); part += dppf<0x4E>(part); }
            const float xt = SOL[t * 128 + cidx] - part;
            if (q == (t & 3)) { xq[t >> 2] = xt;
                if (cidx < 64) KTb[t * 72 + cidx] = (bf16)f2bf(xt); else UVb[t * 72 + cidx - 64] = (bf16)f2bf(-xt); } } }
    __syncthreads();
    for (int rep9 = 0; rep9 < REP9; ++rep9) { asm volatile("" ::: "memory");
    unsigned char* chk = C_CHK + (size_t)item * CHK_BYTES; bf16* Ag = (bf16*)(chk + CK_A); bf16* RQg = (bf16*)(chk + CK_RQ); float* GTg = (float*)(chk + CK_GT); float* YVTg = (float*)(chk + CK_YVT);
    const f32x4 z4 = (f32x4){0.f, 0.f, 0.f, 0.f};
    { const int jt = wave >> 1;
        const bf16x8 BhT = tr_frag(Bh + (8 * fq + trow) * 72 + 16 * jt + tcol, 4 * 72), KhT = tr_frag(Kh + (8 * fq + trow) * 72 + 16 * jt + tcol, 4 * 72);
#pragma unroll
        for (int cc = 0; cc < 2; ++cc) { const int ct = 2 * (wave & 1) + cc;
            const f32x4 aA = mfma16(BhT, tr_frag(KTb + (8 * fq + trow) * 72 + 16 * ct + tcol, 4 * 72), z4);
            f32x4 aG = mfma16(BhT, tr_frag(UVb + (8 * fq + trow) * 72 + 16 * ct + tcol, 4 * 72), z4); aG = mfma16(KhT, tr_frag(Vb + (8 * fq + trow) * 72 + 16 * ct + tcol, 4 * 72), aG);
#pragma unroll
            for (int r = 0; r < 4; ++r) { const int j = 16 * jt + 4 * fq + r, jp = 16 * ct + fr; Ag[j * 72 + jp] = (bf16)f2bf(((j == jp) ? c31[j] : 0.f) - aA[r]); }
            *(f32x4*)(GTg + (16 * ct + fr) * 68 + 16 * jt + 4 * fq) = aG; } }
    { const int tt = wave >> 2, jt2 = wave & 3; const bf16x8 MbF = *(const LAS bf16x8*)(Mb + (16 * tt + fr) * 40 + 8 * fq);
        const f32x4 a = mfma16(MbF, tr_frag(KTb + (8 * fq + trow) * 72 + 16 * jt2 + tcol, 4 * 72), z4);
#pragma unroll
        for (int r = 0; r < 4; ++r) { const int t = 16 * tt + 4 * fq + r, j = 16 * jt2 + fr; RQg[t * 72 + j] = (bf16)f2bf(RTf[t * 64 + j] - a[r]); }
        f32x4 y = mfma16(MbF, tr_frag(UVb + (8 * fq + trow) * 72 + 16 * jt2 + tcol, 4 * 72), z4);
        y = mfma16(*(const LAS bf16x8*)(Mk + (16 * tt + fr) * 40 + 8 * fq), tr_frag(Vb + (8 * fq + trow) * 72 + 16 * jt2 + tcol, 4 * 72), y);
        *(f32x4*)(YVTg + (16 * jt2 + fr) * 36 + 16 * tt + 4 * fq) = y; }
    __syncthreads(); }
}
__device__ __forceinline__ void rwkv_stream(const Ctx& c, int bh, int it, int e) {
    const int b = bh / 12, h = bh % 12, lane = c.lane, fr = lane & 15, fq = lane >> 4;
    LAS bf16* Sl = (LAS bf16*)c.lds + c.wave * (16 * 72);
    const unsigned char* chk0 = C_CHK + (size_t)bh * 128 * CHK_BYTES;
    float* ya = C_YA + ((size_t)b * SEQ) * 768 + h * 64 + 16 * it + fr;
    f32x4 S[4];
#pragma unroll
    for (int jt = 0; jt < 4; ++jt) S[jt] = (f32x4){0.f, 0.f, 0.f, 0.f};
    bf16x8 A0[4][2], R0f[2][2], A1[4][2], R1f[2][2]; f32x4 G0[4], Y0[2], G1[4], Y1[2];
#define ST_LOAD(AF, RF, GV, YV, n_) do { const unsigned char* base_ = chk0 + (size_t)(n_) * CHK_BYTES; \
        _Pragma("unroll") for (int jt = 0; jt < 4; ++jt) { _Pragma("unroll") for (int ks = 0; ks < 2; ++ks) AF[jt][ks] = *(const bf16x8*)((const bf16*)(base_ + CK_A) + (16 * jt + fr) * 72 + 32 * ks + 8 * fq); \
            GV[jt] = *(const f32x4*)((const float*)(base_ + CK_GT) + (16 * it + fr) * 68 + 16 * jt + 4 * fq); } \
        _Pragma("unroll") for (int tt = 0; tt < 2; ++tt) { _Pragma("unroll") for (int ks = 0; ks < 2; ++ks) RF[tt][ks] = *(const bf16x8*)((const bf16*)(base_ + CK_RQ) + (16 * tt + fr) * 72 + 32 * ks + 8 * fq); \
            YV[tt] = *(const f32x4*)((const float*)(base_ + CK_YVT) + (16 * it + fr) * 36 + 16 * tt + 4 * fq); } } while (0)
#define ST_STEP(AF, RF, GV, YV, n_, tmax_) do { \
        _Pragma("unroll") for (int jt = 0; jt < 4; ++jt) *(LAS u32x2*)(Sl + fr * 72 + 16 * jt + 4 * fq) = (u32x2){pk2(S[jt][0], S[jt][1]), pk2(S[jt][2], S[jt][3])}; \
        asm volatile("s_waitcnt lgkmcnt(0)" ::: "memory"); \
        const bf16x8 Sf0 = *(const LAS bf16x8*)(Sl + fr * 72 + 8 * fq), Sf1 = *(const LAS bf16x8*)(Sl + fr * 72 + 32 + 8 * fq); \
        asm volatile("s_waitcnt lgkmcnt(0)" ::: "memory"); \
        _Pragma("unroll") for (int tt = 0; tt < 2; ++tt) { f32x4 y_ = mfma16(RF[tt][0], Sf0, YV[tt]); y_ = mfma16(RF[tt][1], Sf1, y_); \
            _Pragma("unroll") for (int r = 0; r < 4; ++r) if (16 * tt + 4 * fq + r < (tmax_)) ya[(size_t)(32 * (n_) + 16 * tt + 4 * fq + r) * 768] = y_[r]; } \
        _Pragma("unroll") for (int jt = 0; jt < 4; ++jt) { f32x4 a_ = mfma16(AF[jt][0], Sf0, GV[jt]); S[jt] = mfma16(AF[jt][1], Sf1, a_); } } while (0)
    ST_LOAD(A0, R0f, G0, Y0, 0);
#pragma unroll 1
    for (int n = 0; n < 128; n += 2) {
        ST_LOAD(A1, R1f, G1, Y1, n + 1);
        ST_STEP(A0, R0f, G0, Y0, n, 32);
        if (n + 2 < 128) ST_LOAD(A0, R0f, G0, Y0, n + 2);
        ST_STEP(A1, R1f, G1, Y1, n + 1, 32);
    }
    float* so = C_OUT + O_RWKV_P + (((size_t)e * 2 + b) * 12 + h) * 4096 + (size_t)(16 * it + fr) * 64 + 4 * fq;
#pragma unroll
    for (int jt = 0; jt < 4; ++jt) *(f32x4*)(so + 16 * jt) = S[jt];
}
__device__ __forceinline__ void rwkv_stream_block(const Ctx& c, int bh, int e) {
    const int b = bh / 12, h = bh % 12, tid = c.tid, lane = c.lane, wave = c.wave, fr = lane & 15, fq = lane >> 4, it = wave;
    LAS unsigned char* slots = c.lds;
    LAS bf16* Sl = (LAS bf16*)(c.lds + 2 * CHK_BYTES) + wave * (16 * 72);
    const unsigned char* g0 = C_CHK + (size_t)bh * 128 * CHK_BYTES + tid * 16;
    float* ya = C_YA + ((size_t)b * SEQ) * 768 + h * 64 + 16 * it + fr;
    f32x4 S[4];
#pragma unroll
    for (int jt = 0; jt < 4; ++jt) S[jt] = (f32x4){0.f, 0.f, 0.f, 0.f};
    u32x4 P0[5], P1[5], P2[5], P3[5];
#define SB_GLOAD(P, n_) do { const int nn_ = (n_) < 128 ? (n_) : 127;     \
        _Pragma("unroll") for (int k = 0; k < 5; ++k) P[k] = *(const u32x4*)(g0 + (size_t)nn_ * CHK_BYTES + k * 8192); } while (0)
#define SB_LWRITE(P, s_) do { _Pragma("unroll") for (int k = 0; k < 5; ++k) *(LAS u32x4*)(slots + (s_) * CHK_BYTES + tid * 16 + k * 8192) = P[k]; } while (0)
#define SB_STEP(s_, n_) do { if (wave < 4) { const LAS unsigned char* sb_ = slots + (s_) * CHK_BYTES; \
        bf16x8 af_[4][2], rf_[2][2]; f32x4 gv_[4], yv_[2];         \
        _Pragma("unroll") for (int jt = 0; jt < 4; ++jt) { const LAS bf16* a_ = (const LAS bf16*)(sb_ + CK_A) + (16 * jt + fr) * 72 + 8 * fq; af_[jt][0] = *(const LAS bf16x8*)a_; af_[jt][1] = *(const LAS bf16x8*)(a_ + 32); \
            gv_[jt] = *(const LAS f32x4*)((const LAS float*)(sb_ + CK_GT) + (16 * it + fr) * 68 + 16 * jt + 4 * fq); } \
        _Pragma("unroll") for (int tt = 0; tt < 2; ++tt) { const LAS bf16* rq_ = (const LAS bf16*)(sb_ + CK_RQ) + (16 * tt + fr) * 72 + 8 * fq; rf_[tt][0] = *(const LAS bf16x8*)rq_; rf_[tt][1] = *(const LAS bf16x8*)(rq_ + 32); \
            yv_[tt] = *(const LAS f32x4*)((const LAS float*)(sb_ + CK_YVT) + (16 * it + fr) * 36 + 16 * tt + 4 * fq); } \
        _Pragma("unroll") for (int jt = 0; jt < 4; ++jt) *(LAS u32x2*)(Sl + fr * 72 + 16 * jt + 4 * fq) = (u32x2){pk2(S[jt][0], S[jt][1]), pk2(S[jt][2], S[jt][3])}; \
        asm volatile("s_waitcnt lgkmcnt(0)" ::: "memory"); \
        const bf16x8 Sf0 = *(const LAS bf16x8*)(Sl + fr * 72 + 8 * fq), Sf1 = *(const LAS bf16x8*)(Sl + fr * 72 + 32 + 8 * fq); \
        asm volatile("s_waitcnt lgkmcnt(0)" ::: "memory"); __builtin_amdgcn_sched_barrier(0); \
        _Pragma("unroll") for (int jt = 0; jt < 4; ++jt) { f32x4 t_ = mfma16(af_[jt][0], Sf0, gv_[jt]); S[jt] = mfma16(af_[jt][1], Sf1, t_); } \
        _Pragma("unroll") for (int tt = 0; tt < 2; ++tt) { f32x4 y_ = mfma16(rf_[tt][0], Sf0, yv_[tt]); y_ = mfma16(rf_[tt][1], Sf1, y_); \
            _Pragma("unroll") for (int r = 0; r < 4; ++r) ya[(size_t)(32 * (n_) + 16 * tt + 4 * fq + r) * 768] = y_[r]; } } } while (0)
    SB_GLOAD(P0, 0); SB_GLOAD(P1, 1); SB_GLOAD(P2, 2); SB_GLOAD(P3, 3);
    SB_LWRITE(P0, 0); __syncthreads();
#pragma unroll 1
    for (int n = 0; n < 128; n += 4) {
        SB_LWRITE(P1, 1); SB_GLOAD(P0, n + 4); SB_STEP(0, n); __syncthreads();
        SB_LWRITE(P2, 0); SB_GLOAD(P1, n + 5); SB_STEP(1, n + 1); __syncthreads();
        SB_LWRITE(P3, 1); SB_GLOAD(P2, n + 6); SB_STEP(0, n + 2); __syncthreads();
        SB_LWRITE(P0, 0); SB_GLOAD(P3, n + 7); SB_STEP(1, n + 3); __syncthreads();
    }
#undef SB_GLOAD
#undef SB_LWRITE
#undef SB_STEP
    if (wave < 4) { float* so = C_OUT + O_RWKV_P + (((size_t)e * 2 + b) * 12 + h) * 4096 + (size_t)(16 * it + fr) * 64 + 4 * fq;
#pragma unroll
        for (int jt = 0; jt < 4; ++jt) *(f32x4*)(so + 16 * jt) = S[jt]; }
}
__device__ __forceinline__ void rwkv_stream_sample(const Ctx& c, int sidx, int it, int e) {
    const int ns = sidx / 12, h = sidx % 12, lane = c.lane, fr = lane & 15, fq = lane >> 4;
    LAS bf16* Sl = (LAS bf16*)c.lds + c.wave * (16 * 72);
    const unsigned char* chk0 = C_CHK + (size_t)(3072 + sidx) * CHK_BYTES;
    float* ya = C_YA + ((size_t)(TP + 4 * ns)) * 768 + h * 64 + 16 * it + fr;
    const float* si = C_IN(2) + (((size_t)e * 8 + ns) * 12 + h) * 4096 + (size_t)(16 * it + fr) * 64 + 4 * fq;
    f32x4 S[4];
#pragma unroll
    for (int jt = 0; jt < 4; ++jt) S[jt] = *(const f32x4*)(si + 16 * jt);
    bf16x8 A0[4][2], R0f[2][2]; f32x4 G0[4], Y0[2];
    ST_LOAD(A0, R0f, G0, Y0, 0);
    ST_STEP(A0, R0f, G0, Y0, 0, 4);
    float* so = C_OUT + O_RWKV_S + (((size_t)e * 8 + ns) * 12 + h) * 4096 + (size_t)(16 * it + fr) * 64 + 4 * fq;
#pragma unroll
    for (int jt = 0; jt < 4; ++jt) *(f32x4*)(so + 16 * jt) = S[jt];
}
#undef ST_LOAD
#undef ST_STEP
__device__ __forceinline__ void phase_even_tok_pre(Ctx c, int l) {
    const int e = l >> 1;
    constexpr int NI = 3072 + 96;
    PreIn A; if (c.bid < NI) rwkv_chunk_preload(c, c.bid, e, A);
    for (int it = c.bid; it < NI; it += c.G) { PreIn B; const int nx = (it + c.G < NI) ? it + c.G : it;
        rwkv_chunk_preload(c, nx, e, B); rwkv_chunk_precompute(c, it, e, A); A = B; }
}
__device__ __forceinline__ void phase_even_scan(Ctx c, int l) {
    const int e = l >> 1;
    if (c.G >= 240) {
        if (c.bid < 24) { for (int rp = 0; rp < REPS; ++rp) { rwkv_stream_block(c, c.bid, e); __syncthreads(); LAUNDER_C(c); } }
        else { Ctx h = c; h.bid = c.bid - 24; h.G = c.G - 24; LAUNDER_C(h);
            if (h.bid < 96) { if (h.wave < 4) rwkv_stream_sample(h, h.bid, h.wave, e); __syncthreads(); }
            even_helper_work(h, l); }
    } else {
        for (int it = c.bid; it < 24; it += c.G) { rwkv_stream_block(c, it, e); __syncthreads(); }
        for (int it = c.bid; it < 96; it += c.G) { if (c.wave < 4) rwkv_stream_sample(c, it, c.wave, e); __syncthreads(); }
        LAUNDER_C(c);
        even_helper_work(c, l);
    }
}
__device__ __forceinline__ void phase_even_ubuild(const Ctx& c, int l) {
    const int e = l >> 1; const float* r_k = C_IN(24) + e * 768; const float* lg = C_IN(25) + e * 768; const float* lb = C_IN(26) + e * 768; const float* muv = C_IN(17) + e * 2432 + EC_V;
    for (int R = c.bid * 8 + c.wave; R < TT; R += c.G * 8) {
        const bool hasprev = (R < TP) ? ((R & (SEQ - 1)) != 0) : (((R - TP) & 3) != 0);
        const float* shiftv = C_IN(3) + ((size_t)e * 8 + ((R >= TP) ? ((R - TP) >> 2) : 0)) * 2432 + EC_V;
        const bf16* hrow = C_HB + (size_t)R * LDH;
#pragma unroll 1
        for (int hb = 0; hb < 12; hb += 4) {
            float y[4], gate[4], cvv[4], pvv[4], bon[4], lgv[4], lbv[4], mv[4];
#pragma unroll
            for (int k = 0; k < 4; ++k) { const int col = (hb + k) * 64 + c.lane;
                y[k] = C_YA[(size_t)R * 768 + col]; gate[k] = bf2f(hrow[EC_GA + col]); cvv[k] = bf2f(hrow[EC_V + col]);
                pvv[k] = hasprev ? bf2f(hrow[EC_V + col - LDH]) : ((R < TP) ? 0.f : shiftv[col]);
                bon[k] = C_BONUS[(size_t)R * 12 + hb + k]; lgv[k] = lg[col]; lbv[k] = lb[col]; mv[k] = muv[col]; }
#pragma unroll
            for (int k = 0; k < 4; ++k) { const int col = (hb + k) * 64 + c.lane;
                const float mean = wave_sum(y[k]) * (1.0f / 64.0f); const float dlt = y[k] - mean; const float var = wave_sum(dlt * dlt) * (1.0f / 64.0f);
                const float yn = dlt * rsqrtf(var + 64e-5f) * lgv[k] + lbv[k];
                const float bonus = bon[k] * (cvv[k] + (pvv[k] - cvv[k]) * mv[k]);
                C_U[(size_t)R * EVEN_OUT + col] = (bf16)f2bf((yn + bonus) * siluf_(gate[k])); }
        }
    }
}

__device__ __forceinline__ void even_combine_dil(const Ctx& c) {
    const int hh = c.lane >> 4, d4 = 4 * (c.lane & 15);
    for (int R0 = c.bid * 8 + c.wave; R0 < TP; R0 += 2 * c.G * 8) {
        const int R1 = (R0 + c.G * 8 < TP) ? R0 + c.G * 8 : R0;
        float ls[2][3]; f32x4 og[2][3]; u32x2 gw[2];
#pragma unroll
        for (int k = 0; k < 2; ++k) { const int R = k ? R1 : R0;
#pragma unroll
            for (int g = 0; g < 3; ++g) { ls[k][g] = C_LSE[((size_t)g * TT + R) * 4 + hh]; og[k][g] = *(const f32x4*)(C_OG + ((size_t)g * TT + R) * 256 + hh * 64 + d4); }
            gw[k] = *(const u32x2*)(C_HB + (size_t)R * LDH + EC_GB + hh * 64 + d4); }
#pragma unroll
        for (int k = 0; k < 2; ++k) { const int R = k ? R1 : R0;
            const float mx = fmaxf(ls[k][0], fmaxf(ls[k][1], ls[k][2])); const float w0 = __expf(ls[k][0] - mx), w1 = __expf(ls[k][1] - mx), w2 = __expf(ls[k][2] - mx); const float inv = 1.0f / (w0 + w1 + w2);
            const f32x4 y = (og[k][0] * w0 + og[k][1] * w1 + og[k][2] * w2) * inv;
            float gt[4]; unpk4(gw[k], gt);
            *(u32x2*)(C_U + (size_t)R * EVEN_OUT + 768 + hh * 64 + d4) = (u32x2){pk2(y.x * siluf_(gt[0]), y.y * siluf_(gt[1])), pk2(y.z * siluf_(gt[2]), y.w * siluf_(gt[3]))}; }
    }
}
__device__ __forceinline__ void rot8(u32x4 w, const float* tb, float scale, float (&y)[8]) {
    float x[8]; unpk8(w, x); const f32x4 t0 = *(const f32x4*)tb, t1 = *(const f32x4*)(tb + 4);
    const float cs[8] = {t0.x, t0.y, t0.z, t0.w, t1.x, t1.y, t1.z, t1.w};
#pragma unroll
    for (int p = 0; p < 4; ++p) { const float co = cs[2 * p], si = cs[2 * p + 1], x0 = x[2 * p], x1 = x[2 * p + 1]; y[2 * p] = (x0 * co - x1 * si) * scale; y[2 * p + 1] = (x1 * co + x0 * si) * scale; }
}
#define C_SB ((bf16*)(c.ap->ws + WS_OG))
__device__ __forceinline__ void ret_s_prepass_item(const Ctx& c, int item) {
    const int bh = item >> 6, ch = item & 63, b = bh / 6, h = bh % 6;
    LAS bf16* Qc = (LAS bf16*)c.lds;
    LAS bf16* Kc = Qc + 64 * 264;
    const float lg = LG2G[h];
    const int tid = c.tid, lane = c.lane, wave = c.wave, fr = lane & 15, fq = lane >> 4, it = wave >> 1, jt0 = (wave & 1) * 2;
    const bf16* g0 = C_HB + ((size_t)b * SEQ + ch * 64) * LDH + h * 256;
    u32x4 tq[4], tk[4];
#pragma unroll
    for (int q = 0; q < 4; ++q) { const int p = tid + 512 * q, row = p >> 5, c8 = (p & 31) * 8; tq[q] = *(const u32x4*)(g0 + (size_t)row * LDH + OC_Q + c8); tk[q] = *(const u32x4*)(g0 + (size_t)row * LDH + OC_K + c8); }
#pragma unroll
    for (int q = 0; q < 4; ++q) { const int p = tid + 512 * q, row = p >> 5, c8 = (p & 31) * 8; *(LAS u32x4*)(Qc + row * 264 + c8) = tq[q]; *(LAS u32x4*)(Kc + row * 264 + c8) = tk[q]; }
    __syncthreads();
    f32x4 accS[2];
#pragma unroll
    for (int q = 0; q < 2; ++q) accS[q] = (f32x4){0.f, 0.f, 0.f, 0.f};
#pragma unroll
    for (int kp = 0; kp < 4; ++kp) { bf16x8 Qf2[2], Kf2[2][2];
#pragma unroll
        for (int kk = 0; kk < 2; ++kk) { const int ks = 2 * kp + kk; Qf2[kk] = *(const LAS bf16x8*)(Qc + (16 * it + fr) * 264 + 32 * ks + 8 * fq);
#pragma unroll
            for (int q = 0; q < 2; ++q) Kf2[kk][q] = *(const LAS bf16x8*)(Kc + (16 * (jt0 + q) + fr) * 264 + 32 * ks + 8 * fq); }
        asm volatile("s_waitcnt lgkmcnt(0)" ::: "memory"); __builtin_amdgcn_sched_barrier(0);
#pragma unroll
        for (int kk = 0; kk < 2; ++kk)
#pragma unroll
            for (int q = 0; q < 2; ++q) accS[q] = mfma16(Qf2[kk], Kf2[kk][q], accS[q]); }
    bf16* sb = C_SB + (size_t)item * 4096;
#pragma unroll
    for (int jj = 0; jj < 2; ++jj) { const int jt = jt0 + jj;
#pragma unroll
        for (int r = 0; r < 4; ++r) { const int i = 16 * it + 4 * fq + r, j = 16 * jt + fr; const float val = (i >= j) ? accS[jj][r] * exp2f(lg * (float)(i - j)) : 0.f; sb[i * 64 + j] = (bf16)f2bf(val); } }
    __syncthreads();
}
__device__ __forceinline__ void ret_prompt_unit(const Ctx& c, int unit, int o) {
    const int b = unit / 48, h = (unit >> 3) % 6, es = unit & 7;
    LAS bf16* Qc = (LAS bf16*)c.lds;
    LAS bf16* Kc = Qc + 64 * 264;
    LAS bf16* Vc = Kc + 64 * 264;
    LAS bf16* Vz = Vc + 64 * 40;
    LAS bf16* Rt = Vz + 64 * 40;
    const float lg = LG2G[h];
    const int tid = c.tid, lane = c.lane, wave = c.wave, fr = lane & 15, fq = lane >> 4, it = wave >> 1, eto = wave & 1;
    f32x4 Racc[2][2];
#pragma unroll
    for (int a = 0; a < 2; ++a)
#pragma unroll
        for (int q = 0; q < 2; ++q) Racc[a][q] = (f32x4){0.f, 0.f, 0.f, 0.f};
    for (int i = tid; i < 32 * 264 / 2; i += 512) ((LAS unsigned*)Rt)[i] = 0u;
    const float g64 = exp2f(lg * 64.f);
    const int vj = (tid & 255) >> 2, vp = tid & 3; const float zeta = exp2f(lg * (float)(63 - vj));
    const bf16* g0 = C_HB + ((size_t)b * SEQ) * LDH + h * 256;
    const bf16* gv = C_HB + ((size_t)b * SEQ + vj) * LDH + OC_V + h * 256 + es * 32 + vp * 8;
    const bf16* gs = C_SB + (size_t)((b * 6 + h) * 64) * 4096 + (16 * it + fr) * 64 + 8 * fq;
    u32x4 pq[4], pk[4], pv; bf16x8 sfn[2];
#pragma unroll
    for (int q = 0; q < 4; ++q) { const int p = tid + 512 * q, row = p >> 5, c8 = (p & 31) * 8; pq[q] = *(const u32x4*)(g0 + (size_t)row * LDH + OC_Q + c8); pk[q] = *(const u32x4*)(g0 + (size_t)row * LDH + OC_K + c8); }
    pv = *(const u32x4*)gv; sfn[0] = *(const bf16x8*)gs; sfn[1] = *(const bf16x8*)(gs + 32);
    const int trow = (lane & 15) >> 2, tcol = 4 * (lane & 3);
#pragma unroll 1
    for (int ch = 0; ch < 64; ++ch) {
        const size_t row0 = (size_t)b * SEQ + ch * 64;
#pragma unroll
        for (int q = 0; q < 4; ++q) { const int p = tid + 512 * q, row = p >> 5, c8 = (p & 31) * 8; *(LAS u32x4*)(Qc + row * 264 + c8) = pq[q]; *(LAS u32x4*)(Kc + row * 264 + c8) = pk[q]; }
        if (wave < 4) { *(LAS u32x4*)(Vc + vj * 40 + vp * 8) = pv; float x[8]; unpk8(pv, x);
            *(LAS u32x4*)(Vz + vj * 40 + vp * 8) = (u32x4){pk2(x[0] * zeta, x[1] * zeta), pk2(x[2] * zeta, x[3] * zeta), pk2(x[4] * zeta, x[5] * zeta), pk2(x[6] * zeta, x[7] * zeta)}; }
        const bf16x8 Sf0 = sfn[0], Sf1 = sfn[1];
        { const int cn = (ch + 1 < 64) ? ch + 1 : 63; const size_t adv = (size_t)cn * 64 * LDH;
#pragma unroll
            for (int q = 0; q < 4; ++q) { const int p = tid + 512 * q, row = p >> 5, c8 = (p & 31) * 8; pq[q] = *(const u32x4*)(g0 + adv + (size_t)row * LDH + OC_Q + c8); pk[q] = *(const u32x4*)(g0 + adv + (size_t)row * LDH + OC_K + c8); }
            pv = *(const u32x4*)(gv + adv); sfn[0] = *(const bf16x8*)(gs + (size_t)cn * 4096); sfn[1] = *(const bf16x8*)(gs + (size_t)cn * 4096 + 32); }
        __syncthreads();
        f32x4 accQ = (f32x4){0.f, 0.f, 0.f, 0.f};
        { bf16x8 Qf[8], Rf[8];
#pragma unroll
            for (int ks = 0; ks < 8; ++ks) { Qf[ks] = *(const LAS bf16x8*)(Qc + (16 * it + fr) * 264 + 32 * ks + 8 * fq); Rf[ks] = *(const LAS bf16x8*)(Rt + (16 * eto + fr) * 264 + 32 * ks + 8 * fq); }
            asm volatile("s_waitcnt lgkmcnt(0)" ::: "memory"); __builtin_amdgcn_sched_barrier(0);
#pragma unroll
            for (int ks = 0; ks < 8; ++ks) accQ = mfma16(Qf[ks], Rf[ks], accQ); }
        { bf16x8 Vfr[2], Kfr[2][2], Zfr[2][2];
#pragma unroll
            for (int k2 = 0; k2 < 2; ++k2) { Vfr[k2] = tr_frag(Vc + (32 * k2 + 8 * fq + trow) * 40 + 16 * eto + tcol, 4 * 40);
#pragma unroll
                for (int dd = 0; dd < 2; ++dd) Kfr[dd][k2] = tr_frag(Kc + (32 * k2 + 8 * fq + trow) * 264 + 16 * (2 * wave + dd) + tcol, 4 * 264);
#pragma unroll
                for (int et = 0; et < 2; ++et) Zfr[et][k2] = tr_frag(Vz + (32 * k2 + 8 * fq + trow) * 40 + 16 * et + tcol, 4 * 40); }
            asm volatile("s_waitcnt lgkmcnt(0)" ::: "memory"); __builtin_amdgcn_sched_barrier(0);
            { f32x4 a2 = mfma16(Sf0, Vfr[0], (f32x4){0.f, 0.f, 0.f, 0.f}); a2 = mfma16(Sf1, Vfr[1], a2);
#pragma unroll
                for (int r = 0; r < 4; ++r) { const int i = 16 * it + 4 * fq + r; C_YR[(row0 + i) * 1536 + h * 256 + es * 32 + 16 * eto + fr] = a2[r] + accQ[r] * exp2f(lg * (float)(i + 1)); } }
#pragma unroll
            for (int dd = 0; dd < 2; ++dd)
#pragma unroll
                for (int et = 0; et < 2; ++et) { f32x4 a = Racc[dd][et] * g64; a = mfma16(Kfr[dd][0], Zfr[et][0], a); Racc[dd][et] = mfma16(Kfr[dd][1], Zfr[et][1], a); } }
        __syncthreads();
#pragma unroll
        for (int dd = 0; dd < 2; ++dd)
#pragma unroll
            for (int et = 0; et < 2; ++et) { const f32x4 a = Racc[dd][et]; const int dt = 2 * wave + dd;
                *(LAS u32x2*)(Rt + (16 * et + fr) * 264 + 16 * dt + 4 * fq) = (u32x2){pk2(a[0], a[1]), pk2(a[2], a[3])}; }
    }
    int fq_l = fq; asm volatile("" : "+v"(fq_l));
    float* ro = C_OUT + O_RET_P + ((((size_t)o * 2 + b) * 6 + h) * 256) * 256 + es * 32;
#pragma unroll
    for (int dd = 0; dd < 2; ++dd)
#pragma unroll
        for (int et = 0; et < 2; ++et)
#pragma unroll
            for (int r = 0; r < 4; ++r) ro[(size_t)(16 * (2 * wave + dd) + 4 * fq_l + r) * 256 + 16 * et + fr] = Racc[dd][et][r];
    __syncthreads();
}
__device__ __forceinline__ void ret_sample_unit(const Ctx& c, int unit, int o) {
    const int n = unit / 6, h = unit % 6, tid = c.tid;
    LAS float* qs = (LAS float*)c.lds; LAS float* ks = qs + 1024; LAS float* vs = ks + 1024; LAS float* red = vs + 1024; LAS float* sc = red + 2048;
    const float lg = LG2G[h];
    for (int idx = tid; idx < 4 * 256; idx += 512) { const int t = idx >> 8, dd = idx & 255; const bf16* hr = C_HB + (size_t)(TP + n * 4 + t) * LDH + h * 256 + dd; qs[idx] = bf2f(hr[OC_Q]); ks[idx] = bf2f(hr[OC_K]); }
    for (int idx = tid; idx < 4 * 256; idx += 512) { const int t = idx >> 8, ee = idx & 255; vs[idx] = bf2f(C_HB[(size_t)(TP + n * 4 + t) * LDH + OC_V + h * 256 + ee]); }
    __syncthreads();
    if (tid < 16) { const int i = tid >> 2, j = tid & 3; float a = 0.f; for (int d = 0; d < 256; ++d) a += qs[i * 256 + d] * ks[j * 256 + d]; sc[tid] = (j <= i) ? a * exp2f(lg * (float)(i - j)) : 0.f; }
    __syncthreads();
    const int ee = tid & 255, dh = tid >> 8;
    const float* R0 = C_IN(7) + ((((size_t)o * 8 + n) * 6 + h) * 256) * 256; float* Rn = C_OUT + O_RET_S + ((((size_t)o * 8 + n) * 6 + h) * 256) * 256;
    const float g4 = exp2f(lg * 4.f), z0 = exp2f(lg * 3.f), z1 = exp2f(lg * 2.f), z2 = exp2f(lg), z3 = 1.0f;
    const float v0 = vs[ee] * z0, v1 = vs[256 + ee] * z1, v2 = vs[512 + ee] * z2, v3 = vs[768 + ee] * z3;
    float acc[4] = {0.f, 0.f, 0.f, 0.f};
#pragma unroll 4
    for (int d = dh * 128; d < dh * 128 + 128; ++d) { const float r0 = R0[(size_t)d * 256 + ee];
        acc[0] += qs[d] * r0; acc[1] += qs[256 + d] * r0; acc[2] += qs[512 + d] * r0; acc[3] += qs[768 + d] * r0;
        Rn[(size_t)d * 256 + ee] = g4 * r0 + ks[d] * v0 + ks[256 + d] * v1 + ks[512 + d] * v2 + ks[768 + d] * v3; }
#pragma unroll
    for (int i = 0; i < 4; ++i) red[(dh * 4 + i) * 256 + ee] = acc[i];
    __syncthreads();
    if (dh == 0) {
#pragma unroll
        for (int i = 0; i < 4; ++i) { float ov = (red[i * 256 + ee] + red[(4 + i) * 256 + ee]) * exp2f(lg * (float)(i + 1));
            for (int j = 0; j <= i; ++j) ov += sc[i * 4 + j] * vs[j * 256 + ee];
            C_YR[(size_t)(TP + n * 4 + i) * 1536 + h * 256 + ee] = ov; } }
    __syncthreads();
}
__device__ __forceinline__ void odd_helper_work(Ctx c, int l) {
    mem_attn_all(c, l, OC_QM, OC_GM, 1536, ODD_OUT);
    LAUNDER_C(c);
    if (l < 3) convert_layer_weights(c, l + 1);
}
__device__ __forceinline__ void phase_odd_tok(Ctx c, int l) {
    const int o = l >> 1;
    if (c.G >= 200) {
        if (c.bid < 96) ret_prompt_unit(c, c.bid, o);
        else if (c.bid < 144) ret_sample_unit(c, c.bid - 96, o);
        else { Ctx h = c; h.bid = c.bid - 144; h.G = c.G - 144; odd_helper_work(h, l); }
    } else {
        for (int it = c.bid; it < 144; it += c.G) { if (it < 96) ret_prompt_unit(c, it, o); else ret_sample_unit(c, it - 96, o); }
        LAUNDER_C(c);
        odd_helper_work(c, l);
    }
}
__device__ __forceinline__ void phase_odd_ubuild(const Ctx& c) {
    for (int R = c.bid * 8 + c.wave; R < TT; R += c.G * 8) {
#pragma unroll 1
        for (int hb = 0; hb < 6; hb += 3) {
            f32x4 ov[3]; u32x2 gw[3];
#pragma unroll
            for (int k = 0; k < 3; ++k) { const int col = (hb + k) * 256 + 4 * c.lane; ov[k] = *(const f32x4*)(C_YR + (size_t)R * 1536 + col); gw[k] = *(const u32x2*)(C_HB + (size_t)R * LDH + OC_G + col); }
#pragma unroll
            for (int k = 0; k < 3; ++k) { const int col = (hb + k) * 256 + 4 * c.lane; const f32x4 o = ov[k];
                const float ss = wave_sum(o.x * o.x + o.y * o.y + o.z * o.z + o.w * o.w); const float scl = rsqrtf(ss * (1.0f / 256.0f) + 1e-6f);
                float g[4]; unpk4(gw[k], g);
                *(u32x2*)(C_U + (size_t)R * DM + col) = (u32x2){pk2(o.x * scl * siluf_(g[0]), o.y * scl * siluf_(g[1])), pk2(o.z * scl * siluf_(g[2]), o.w * scl * siluf_(g[3]))}; }
        }
    }
}
__device__ __forceinline__ void small_outproj(const Ctx& c, int wt, int K, int l) {
    const int lane = c.lane, r = lane & 31, hl = lane >> 5, nks = K / 128;
    const bf16* ap = C_U + (size_t)(TP + r) * K + 8 * hl + c.wave * nks * 16; const bf16* bp = C_WTOUT_L(l) + (size_t)(32 * wt + r) * K + 8 * hl + c.wave * nks * 16;
    f32x16 acc;
#pragma unroll
    for (int i = 0; i < 16; ++i) acc[i] = 0.f;
    if (nks == 16) {
#pragma unroll
        for (int ks = 0; ks < 16; ++ks) acc = mfma32(*(const bf16x8*)(ap + 16 * ks), *(const bf16x8*)(bp + 16 * ks), acc);
    } else {
#pragma unroll
        for (int ks = 0; ks < 12; ++ks) acc = mfma32(*(const bf16x8*)(ap + 16 * ks), *(const bf16x8*)(bp + 16 * ks), acc);
    }
    LAS float* part = (LAS float*)c.lds;
#pragma unroll
    for (int i = 0; i < 16; ++i) part[(c.wave * 16 + i) * 64 + lane] = acc[i];
    __syncthreads();
    for (int idx = c.tid; idx < 1024; idx += 512) { float sum = 0.f;
#pragma unroll
        for (int w = 0; w < 8; ++w) sum += part[w * 1024 + idx];
        const int i = idx >> 6, ln = idx & 63, row = TP + (i & 3) + 8 * (i >> 2) + 4 * (ln >> 5), col = 32 * wt + (ln & 31);
        C_Z[(size_t)row * DM + col] = C_XZ[(size_t)row * DM + col] * ALPHA + sum; }
    __syncthreads();
}
__device__ __forceinline__ void phase_ln(const Ctx& c, int l) {
    const float* g = C_IN(15) + l * DM; const float* bta = C_IN(16) + l * DM;
    f32x4 gg[8], bb[8];
#pragma unroll
    for (int j = 0; j < 8; ++j) { const int col = 4 * c.lane + 256 * j; gg[j] = *(const f32x4*)(g + col); bb[j] = *(const f32x4*)(bta + col); }
    for (int R0 = c.bid * 8 + c.wave; R0 < TT; R0 += 2 * c.G * 8) {
        const int R1 = R0 + c.G * 8; const bool has1 = R1 < TT; const int R1c = has1 ? R1 : R0;
        f32x4 v0[8], v1[8]; float s0 = 0.f, s1 = 0.f;
        { const f32x4* z0 = (const f32x4*)(C_Z + (size_t)R0 * DM) + c.lane; const f32x4* z1 = (const f32x4*)(C_Z + (size_t)R1c * DM) + c.lane;
#pragma unroll
            for (int j = 0; j < 8; ++j) { v0[j] = z0[64 * j]; v1[j] = z1[64 * j]; } }
#pragma unroll
        for (int j = 0; j < 8; ++j) { s0 += (v0[j].x + v0[j].y) + (v0[j].z + v0[j].w); s1 += (v1[j].x + v1[j].y) + (v1[j].z + v1[j].w); }
        const float m0 = wave_sum(s0) * (1.0f / DM), m1 = wave_sum(s1) * (1.0f / DM); float q0 = 0.f, q1 = 0.f;
#pragma unroll
        for (int j = 0; j < 8; ++j) { v0[j] = v0[j] - m0; v1[j] = v1[j] - m1; q0 += (v0[j].x * v0[j].x + v0[j].y * v0[j].y) + (v0[j].z * v0[j].z + v0[j].w * v0[j].w); q1 += (v1[j].x * v1[j].x + v1[j].y * v1[j].y) + (v1[j].z * v1[j].z + v1[j].w * v1[j].w); }
        const float r0 = rsqrtf(wave_sum(q0) * (1.0f / DM) + LN_EPS), r1 = rsqrtf(wave_sum(q1) * (1.0f / DM) + LN_EPS);
        float* d0 = (l == 3) ? (R0 < TP ? C_OUT + O_YP + (size_t)R0 * DM : C_OUT + O_YS + (size_t)(R0 - TP) * DM) : C_XZ + (size_t)R0 * DM;
        float* d1 = (l == 3) ? (R1c < TP ? C_OUT + O_YP + (size_t)R1c * DM : C_OUT + O_YS + (size_t)(R1c - TP) * DM) : C_XZ + (size_t)R1c * DM;
#pragma unroll
        for (int j = 0; j < 8; ++j) { const int col = 4 * c.lane + 256 * j;
            const f32x4 x0 = v0[j] * r0 * gg[j] + bb[j]; *(f32x4*)(d0 + col) = x0; if (l != 3) *(u32x2*)(C_XB + (size_t)R0 * DM + col) = (u32x2){pk2(x0.x, x0.y), pk2(x0.z, x0.w)};
            if (has1) { const f32x4 x1 = v1[j] * r1 * gg[j] + bb[j]; *(f32x4*)(d1 + col) = x1; if (l != 3) *(u32x2*)(C_XB + (size_t)R1 * DM + col) = (u32x2){pk2(x1.x, x1.y), pk2(x1.z, x1.w)}; } }
    }
}

#define XB_TMO      128
#define XB_XCNT(j)  (256  + 64 * (j))
#define XB_XSUB(j)  (1280 + 64 * (j))
#define XB_XGEN(j)  (2304 + 64 * (j))
#define XB_TOP      3328
#define XB_TOPGEN   3392
#define XCD_BAR_WORDS 3456
#define XB_SPIN_CAP (1u << 18)

__device__ __forceinline__ unsigned xb_ld(unsigned* p)              { return __hip_atomic_load(p, __ATOMIC_RELAXED, __HIP_MEMORY_SCOPE_AGENT); }
__device__ __forceinline__ unsigned xb_add(unsigned* p, unsigned v) { return __hip_atomic_fetch_add(p, v, __ATOMIC_RELAXED, __HIP_MEMORY_SCOPE_AGENT); }
__device__ __forceinline__ unsigned xb_xcc_id() { return (unsigned)__builtin_amdgcn_s_getreg((3 << 11) | 20) & 0xFu; }
#define XB_SPIN(cond, bar) do { unsigned _sp = 0; while (cond) { __builtin_amdgcn_s_sleep(1); \
    if ((++_sp & 255u) == 0u) { if (xb_ld(&(bar)[XB_TMO])) break; if (_sp > XB_SPIN_CAP) { atomicAdd(&(bar)[XB_TMO], 1u); break; } } } } while (0)

struct XcdBarrier {
    unsigned* bar; unsigned x;
    volatile LAS unsigned* st;
};

__device__ __forceinline__ XcdBarrier xcd_barrier_post(unsigned* bar, volatile LAS unsigned* st) {
    XcdBarrier b; b.bar = bar; b.x = xb_xcc_id(); b.st = st;
    if (threadIdx.x == 0) (void)xb_add(&bar[XB_XCNT(b.x)], 1u);
    return b;
}
__device__ __forceinline__ void xcd_barrier_complete(unsigned* bar, unsigned x, unsigned& nloc, unsigned& nx) {
    const unsigned G = gridDim.x * gridDim.y * gridDim.z;
    unsigned sum, cnt, mine, sp = 0u;
    for (;;) {
        sum = 0u; cnt = 0u; mine = 0u;
#pragma unroll
        for (unsigned j = 0; j < 16; ++j) { const unsigned c = xb_ld(&bar[XB_XCNT(j)]); sum += c; cnt += (c > 0u) ? 1u : 0u; mine = (j == x) ? c : mine; }
        if (sum == G) break;
        __builtin_amdgcn_s_sleep(1);
        if ((++sp & 255u) == 0u) { if (xb_ld(&bar[XB_TMO])) break; if (sp > XB_SPIN_CAP) { atomicAdd(&bar[XB_TMO], 1u); break; } }
    }
    nloc = mine > 0u ? mine : 1u; nx = cnt > 0u ? cnt : 1u;
}

__device__ __forceinline__ void xcd_barrier(const XcdBarrier& b) {
    asm volatile("s_waitcnt vmcnt(0)" ::: "memory");
    __syncthreads();
    if (threadIdx.x == 0) {
        unsigned* bar = b.bar;
        __builtin_amdgcn_s_waitcnt(0);
        unsigned nloc = b.st[0], nx = b.st[1];
        if (nloc == 0u) { xcd_barrier_complete(bar, b.x, nloc, nx); b.st[0] = nloc; b.st[1] = nx; }
        const unsigned old = xb_add(&bar[XB_XSUB(b.x)], 1u);
        const unsigned gen = old / nloc;
        if (old + 1u == (gen + 1u) * nloc) {
            __builtin_amdgcn_fence(__ATOMIC_RELEASE, "agent");
            asm volatile("s_waitcnt vmcnt(0)" ::: "memory");
            const unsigned og = xb_add(&bar[XB_TOP], 1u);
            const unsigned tg = og / nx;
            if (og + 1u == (tg + 1u) * nx) xb_add(&bar[XB_TOPGEN], 1u);
            else XB_SPIN(xb_ld(&bar[XB_TOPGEN]) == tg, bar);
            __builtin_amdgcn_fence(__ATOMIC_ACQUIRE, "agent");
            xb_add(&bar[XB_XGEN(b.x)], 1u);
            asm volatile("s_waitcnt vmcnt(0)" ::: "memory");
        } else {
            XB_SPIN(xb_ld(&bar[XB_XGEN(b.x)]) == gen, bar);
            __builtin_amdgcn_fence(__ATOMIC_ACQUIRE, "agent");
            asm volatile("s_waitcnt vmcnt(0)" ::: "memory");
        }
    }
    __syncthreads();
}

constexpr int NPH = 25;
__global__ void __launch_bounds__(512, 2) mk(Args args) {
    extern __shared__ __attribute__((aligned(16))) unsigned char lds_raw[];
    Ctx c;
    c.ap = (ArgsP)__builtin_amdgcn_kernarg_segment_ptr(); c.lds = (LAS unsigned char*)lds_raw;
    c.tid = threadIdx.x; c.lane = c.tid & 63; c.wave = __builtin_amdgcn_readfirstlane(c.tid >> 6); c.bid = blockIdx.x; c.G = gridDim.x;
    for (int u = c.tid; u < 16; u += 512) ((LAS unsigned*)(c.lds + 131072))[u] = 0u;
    __syncthreads();
    XcdBarrier xbar = xcd_barrier_post((unsigned*)(c.ap->ws + WS_CTL) + 4096, (volatile LAS unsigned*)(c.lds + 131072));
#define LAUNDER() do { asm volatile("" : "+s"(c.ap), "+v"(c.tid), "+s"(c.bid), "+s"(c.G)); c.lane = c.tid & 63; c.wave = __builtin_amdgcn_readfirstlane(c.tid >> 6); } while (0)
    const int lo = args.ph_lo, hi = args.ph_hi;
#define IN(k) (lo <= (k) && (k) < hi)
#if USE_CG
#define SEAM(k) do { if (IN(k) && IN((k) + 1)) { cg::this_grid().sync(); } } while (0)
#else
#define SEAM(k) do { if (IN(k) && IN((k) + 1)) { asm volatile("" : "+s"(xbar.bar)); xcd_barrier(xbar); } } while (0)
#endif
    #if !(DIS & 1)
    if (IN(0)) { for (int rep = 0; rep < ((DUP & 128) ? 2 : 1); ++rep) { LAUNDER(); phase_prologue(c); if (DUP & 128) { asm volatile("" : "+s"(xbar.bar)); xcd_barrier(xbar); } } }
#endif
    SEAM(0);
#pragma unroll 1
    for (int l = 0; l < 4; ++l) {
        const int p0 = 1 + 6 * l; const bool even = (l & 1) == 0;
#if !(DIS & 2)
        if (IN(p0)) { for (int rep = 0; rep < ((DUP & 16) ? 2 : 1); ++rep) { LAUNDER();
            if (l == 0) { pg8::Gemm g{C_MEMB, C_WTMEM, 512, 4096, DM}; pg8::StaticOrder S; S.init(512, 4096, c.G, (c.bid + c.G - c.G / 2) % c.G);
                pg8::EpiF32Split E{C_OUT + O_MEM, 1024, 1024, (size_t)512 * 1024, C_MKVB};
                pg8::gemm_phase<pg8::EpiF32Split, pg8::StaticOrder, true, true>(c.lds, g, S, E); }
            const int ngemm = (l == 0) ? 5 : 1;
#pragma unroll 1
            for (int gi = 0; gi < ngemm; ++gi) {
                const int NI = even ? EVEN_INP : ODD_IN;
                const bf16* A = gi ? C_WTMEM + ((size_t)(gi - 1) * 1024 + 512) * DM : C_XB; const bf16* Bt = gi ? C_MEMB : C_WTIN;
                const int Mg = gi ? 512 : MPAD, Ng = gi ? 512 : NI;
                bf16* Og = gi ? C_VT + (size_t)(gi - 1) * 512 * 512 : C_HB; const int ldo = gi ? 512 : LDH;
                pg8::Gemm g{A, Bt, Mg, Ng, DM}; pg8::StaticOrder S; S.init(Mg, Ng, c.G, gi ? (c.bid + 2 * c.G - (5 * c.G) / 8 - 8 * (gi - 1)) % c.G : c.bid); pg8::EpiBf16NP E{Og, ldo, C_TAB, (gi == 0 && !even) ? 3072 : 0, 1536};
                pg8::gemm_phase<pg8::EpiBf16NP, pg8::StaticOrder, true, true>(c.lds, g, S, E);
            }
            if (DUP & 16) { asm volatile("" : "+s"(xbar.bar)); xcd_barrier(xbar); }
        } }
#endif
        SEAM(p0);
#if !(DIS & 4)
        if (IN(p0 + 1)) { for (int rep = 0; rep < ((DUP & 1) ? 2 : 1); ++rep) { LAUNDER(); if (even) phase_even_tok_pre(c, l); if (DUP & 1) { asm volatile("" : "+s"(xbar.bar)); xcd_barrier(xbar); } } }
#endif
#if !(DIS & 8)
        if (IN(p0 + 1)) { LAUNDER(); if (!even) { for (int it = c.bid; it < 768; it += c.G) ret_s_prepass_item(c, it); } }
#endif
        SEAM(p0 + 1);
#if !(DIS & 16)
        if (IN(p0 + 2)) { for (int rep = 0; rep < ((DUP & 4) ? 2 : 1); ++rep) { LAUNDER(); if (even) phase_even_scan(c, l); if (DUP & 4) { asm volatile("" : "+s"(xbar.bar)); xcd_barrier(xbar); } } }
#if !(DIS & 8)
        if (IN(p0 + 2)) { for (int rep = 0; rep < ((DUP & 2) ? 2 : 1); ++rep) { LAUNDER(); if (!even) phase_odd_tok(c, l); if (DUP & 2) { asm volatile("" : "+s"(xbar.bar)); xcd_barrier(xbar); } } }
#endif
#endif
        SEAM(p0 + 2);
#if !(DIS & 32)
        if (IN(p0 + 3)) { for (int rep = 0; rep < ((DUP & 8) ? 2 : 1); ++rep) { LAUNDER(); if (even) { phase_even_ubuild(c, l); LAUNDER(); even_combine_dil(c); } else phase_odd_ubuild(c); if (DUP & 8) { asm volatile("" : "+s"(xbar.bar)); xcd_barrier(xbar); } } }
#endif
        SEAM(p0 + 3);
#if !(DIS & 64)
        if (IN(p0 + 4)) { for (int rep = 0; rep < ((DUP & 32) ? 2 : 1); ++rep) { LAUNDER(); const int K = even ? EVEN_OUT : ODD_OUT;
            pg8::Gemm g{C_U, C_WTOUT_L(l), TP, DM, K}; pg8::StaticOrder S; S.init(TP, DM, c.G, c.bid); pg8::EpiResid E{C_XZ, C_Z, DM, ALPHA};
            pg8::gemm_phase<pg8::EpiResid, pg8::StaticOrder, true, true>(c.lds, g, S, E);
            LAUNDER(); if (c.bid < 64) small_outproj(c, c.bid, K, l); if (DUP & 32) { asm volatile("" : "+s"(xbar.bar)); xcd_barrier(xbar); } } }
#endif
        SEAM(p0 + 4);
#if !(DIS & 128)
        if (IN(p0 + 5)) { for (int rep = 0; rep < ((DUP & 64) ? 2 : 1); ++rep) { LAUNDER(); phase_ln(c, l); if (DUP & 64) { asm volatile("" : "+s"(xbar.bar)); xcd_barrier(xbar); } } }
#endif
        SEAM(p0 + 5);
    }
#undef IN
#undef SEAM
}

extern "C" void kernel_launch(void* const* d_in, const int* in_sizes, int n_in, void* d_out, int out_size, void* d_ws, size_t ws_size, hipStream_t stream) {
    static int grid = 0;
    if (grid == 0) {
        if (n_in != 27 || (size_t)out_size != O_END || ws_size < WS_END) { fprintf(stderr, "kernel_launch: unexpected shapes: n_in %d out %d ws %zu (need %zu)\n", n_in, out_size, ws_size, (size_t)WS_END); grid = -1; return; }
        int dev = 0, cus = 0, per_cu = 0;
        hipGetDevice(&dev); hipDeviceGetAttribute(&cus, hipDeviceAttributeMultiprocessorCount, dev);
        if (hipFuncSetAttribute((const void*)mk, hipFuncAttributeMaxDynamicSharedMemorySize, LDS_BYTES) != hipSuccess) { fprintf(stderr, "kernel_launch: hipFuncSetAttribute failed\n"); grid = -1; return; }
        if (hipOccupancyMaxActiveBlocksPerMultiprocessor(&per_cu, (const void*)mk, 512, LDS_BYTES) != hipSuccess || per_cu < 1) { fprintf(stderr, "kernel_launch: occupancy query says %d\n", per_cu); per_cu = 1; }
        (void)hipGetLastError();
        grid = cus;
        fprintf(stderr, "kernel_launch: grid %d (cus %d, per_cu %d)\n", grid, cus, per_cu);
    }
    if (grid < 0) return;
    if (hipMemsetAsync((char*)d_ws + WS_CTL, 0, 1u << 20, stream) != hipSuccess) { fprintf(stderr, "kernel_launch: memset failed\n"); return; }
    Args a{};
    for (int i = 0; i < 27; ++i) a.in[i] = (const float*)d_in[i];
    a.out = (float*)d_out; a.ws = (unsigned char*)d_ws;
#if ONE_LAUNCH
    a.ph_lo = 0; a.ph_hi = NPH;
    void* kargs[] = {&a};
    hipError_t e = hipLaunchCooperativeKernel((const void*)mk, dim3(grid), dim3(512), kargs, LDS_BYTES, stream);
    if (e != hipSuccess) fprintf(stderr, "kernel_launch: cooperative launch failed: %s\n", hipGetErrorString(e));
#else
    for (int p = 0; p < NPH; ++p) {
        if (p >= 1 && ((p - 1) % 6) == 2 && (((p - 1) / 6) & 1)) continue;
        a.ph_lo = p; a.ph_hi = p + 1;
        hipLaunchKernelGGL(mk, dim3(grid), dim3(512), LDS_BYTES, stream, a);
    }
#endif
}
```

```cpp
#include <hip/hip_runtime.h>
#include <hip/hip_cooperative_groups.h>
#include <cstdio>
#include <cstdint>
namespace cg = cooperative_groups;
#ifndef DIS
#define DIS 0
#endif
#ifndef REPE
#define REPE 1
#endif
#ifndef REPD
#define REPD 1
#endif
#ifndef REPM
#define REPM 1
#endif
#ifndef REPC
#define REPC 1
#endif
#ifndef REPS
#define REPS 1
#endif
#ifndef REP9
#define REP9 1
#endif
#ifndef REP3
#define REP3 1
#endif
#ifndef REP8
#define REP8 1
#endif
#ifndef REP1
#define REP1 1
#endif
#ifndef DUP
#define DUP 0
#endif
#ifndef USE_CG
#define USE_CG 0
#endif
#ifndef ONE_LAUNCH
#define ONE_LAUNCH 1
#endif
namespace pg8 {
#define PG8_LAS __attribute__((address_space(3)))
typedef unsigned short bf16_t;
typedef short bf16x8 __attribute__((ext_vector_type(8)));
typedef float f32x4 __attribute__((ext_vector_type(4)));
typedef unsigned u32x4 __attribute__((ext_vector_type(4)));
constexpr int BM = 256, BK = 64, HALF = 128, HTB = HALF * BK * 2  , STAGE_BYTES = 8 * HTB, NXCD = 8, WGM = 8;

__host__ __device__ __forceinline__ int lds_byte(int r, int c) { const int st = (r >> 4) * 2 + (c >> 5), rr = r & 15, cc = c & 31, ob = rr * 64 + cc * 2; return st * 1024 + (ob ^ (((ob >> 9) & 1) << 5)); }
__host__ __device__ __forceinline__ void stage_rc(int b, int& R, int& C) { const int st = b / 1024, sb = b % 1024, swz = sb ^ (((sb >> 9) & 1) << 5); R = (st >> 1) * 16 + swz / 64; C = (st & 1) * 32 + (swz % 64) / 2; }
__host__ __device__ __forceinline__ int perm32(int rho) { const int n = rho >> 4, i = rho & 15; return 8 * (i >> 2) + 4 * n + (i & 3); }

struct Unit { int pm, pn; };
struct Gemm { const bf16_t* A; const bf16_t* Bt; int M, N, K; };

struct StaticOrder {
    int nM, nN, nwg, G, c;
    __host__ __device__ void init(int M, int N, int G_, int c_) { nM = M / BM; nN = N / BM; nwg = nM * nN; G = G_; c = c_; }
    __host__ __device__ bool next(int i, Unit& u) const {
        const long L = (long)i * G + c; if (L >= nwg) return false;
        int wgid = (int)L; { const int q = nwg / NXCD, r = nwg % NXCD, xcd = wgid % NXCD, off = wgid / NXCD; wgid = (xcd < r ? xcd * (q + 1) : r * (q + 1) + (xcd - r) * q) + off; }
        const int nig = WGM * nN, gid = wgid / nig, fm = gid * WGM, gsz = (nM - fm) < WGM ? (nM - fm) : WGM;
        u.pm = fm + ((wgid % nig) % gsz); u.pn = (wgid % nig) / gsz; return true;
    }
    __device__ __forceinline__ void a_ready(const Unit&) const {}
    __device__ __forceinline__ void done(const Unit&) const {}
};

__device__ __forceinline__ unsigned cvt_pk_bf16(float lo, float hi) { unsigned r; asm volatile("v_cvt_pk_bf16_f32 %0, %1, %2" : "=v"(r) : "v"(lo), "v"(hi)); return r; }
typedef float f32x2 __attribute__((ext_vector_type(2)));
__device__ __forceinline__ f32x2 gelu_pk(f32x2 v) {
    const f32x2 av = __builtin_elementwise_abs(v), d = av * 0.2316418882f + 1.0f;
    f32x2 t; t.x = __builtin_amdgcn_rcpf(d.x); t.y = __builtin_amdgcn_rcpf(d.y);
    f32x2 q = t * 0.5307027145f + (-0.7265760135f); q = q * t + 0.7107068705f; q = q * t + (-0.142248368f); q = q * t + 0.127414796f; q = q * t;
    const f32x2 s = (v * v) * (-0.72134752044f);
    f32x2 e; e.x = __builtin_amdgcn_exp2f(s.x); e.y = __builtin_amdgcn_exp2f(s.y);
    const f32x2 m = v * (q * e), r = v - m;
    f32x2 o; o.x = v.x < 0.f ? m.x : r.x; o.y = v.y < 0.f ? m.y : r.y; return o;
}

template <int ACT  > struct EpiBf16 {
    static constexpr bool PERM = true, AFTER_DRAIN = false; static_assert(ACT == 0 || ACT == 1, "EpiBf16: ACT is 0 (none) or 1 (gelu_pk)");
    bf16_t* O; int ldc; const float* bias; int split_cols; size_t split_stride; float scale0;
    __device__ __forceinline__ void operator()(const f32x4 (&acc)[2][2][4][2], const Unit& u, int wr, int wc, int fr, int fq) const {
        const int row0 = u.pm * BM + wr * 64 + fr; int colt = u.pn * BM; bf16_t* base = O;
        float sc = 1.f; if (split_cols) { const int t = colt / split_cols; base += (size_t)t * split_stride; colt -= t * split_cols; if (t == 0) sc = scale0; }
        const int col0 = colt + wc * 32 + 8 * fq, bcol0 = u.pn * BM + wc * 32 + 8 * fq;
        f32x4 bv[2][2];
#pragma unroll
        for (int bj = 0; bj < 2; ++bj)
#pragma unroll
            for (int n = 0; n < 2; ++n) bv[bj][n] = bias ? *(const f32x4*)(bias + bcol0 + bj * HALF + 4 * n) : (f32x4){0.f, 0.f, 0.f, 0.f};
#pragma unroll
        for (int ai = 0; ai < 2; ++ai)
#pragma unroll
            for (int m = 0; m < 4; ++m) { bf16_t* rowp = base + (size_t)(row0 + ai * HALF + m * 16) * ldc + col0;
#pragma unroll
                for (int bj = 0; bj < 2; ++bj) { f32x4 v0 = acc[ai][bj][m][0] + bv[bj][0], v1 = acc[ai][bj][m][1] + bv[bj][1];
                    if (ACT == 1) { f32x2 a = gelu_pk((f32x2){v0[0], v0[1]}), b = gelu_pk((f32x2){v0[2], v0[3]}), c = gelu_pk((f32x2){v1[0], v1[1]}), d = gelu_pk((f32x2){v1[2], v1[3]});
                        v0 = (f32x4){a.x, a.y, b.x, b.y}; v1 = (f32x4){c.x, c.y, d.x, d.y}; }
                    v0 = v0 * sc; v1 = v1 * sc; u32x4 w; w.x = cvt_pk_bf16(v0[0], v0[1]); w.y = cvt_pk_bf16(v0[2], v0[3]); w.z = cvt_pk_bf16(v1[0], v1[1]); w.w = cvt_pk_bf16(v1[2], v1[3]);
                    *(u32x4*)(rowp + bj * HALF) = w; } }
    }
};
struct EpiF32Split {
    static constexpr bool PERM = false, AFTER_DRAIN = false;
    float* C; int ldc; int split_cols; size_t split_stride; bf16_t* MB;
    __device__ __forceinline__ void operator()(const f32x4 (&acc)[2][2][4][2], const Unit& u, int wr, int wc, int fr, int fq) const {
        typedef unsigned u32x2v __attribute__((ext_vector_type(2)));
        int colt = u.pn * BM; float* base = C; bf16_t* mb = MB;
        if (split_cols) { const int t = colt / split_cols; base += (size_t)t * split_stride; mb += (size_t)t * split_stride; colt -= t * split_cols; }
        const int row0 = u.pm * BM + wr * 64 + fr, col0 = colt + wc * 32 + 4 * fq;
#pragma unroll
        for (int ai = 0; ai < 2; ++ai)
#pragma unroll
            for (int m = 0; m < 4; ++m) { float* rowp = base + (size_t)(row0 + ai * HALF + m * 16) * ldc + col0; bf16_t* rowb = mb + (size_t)(row0 + ai * HALF + m * 16) * ldc + col0;
#pragma unroll
                for (int bj = 0; bj < 2; ++bj)
#pragma unroll
                    for (int n = 0; n < 2; ++n) { const f32x4 v = acc[ai][bj][m][n]; *(f32x4*)(rowp + bj * HALF + n * 16) = v;
                        u32x2v w; w.x = cvt_pk_bf16(v[0], v[1]); w.y = cvt_pk_bf16(v[2], v[3]); *(u32x2v*)(rowb + bj * HALF + n * 16) = w; } }
    }
};
struct EpiBf16NP {
    static constexpr bool PERM = true, AFTER_DRAIN = false;
    bf16_t* O; int ldc; const float* TAB; int rot_cols, kcol0;
    __device__ __forceinline__ void operator()(const f32x4 (&acc)[2][2][4][2], const Unit& u, int wr, int wc, int fr, int fq) const {
        const int row0 = u.pm * BM + wr * 64 + fr, col0 = u.pn * BM + wc * 32 + 8 * fq;
        const bool rot = u.pn * BM < rot_cols; const float scl = (u.pn * BM >= kcol0) ? 0.0625f : 1.0f;
#pragma unroll
        for (int ai = 0; ai < 2; ++ai)
#pragma unroll
            for (int m = 0; m < 4; ++m) { const int row = row0 + ai * HALF + m * 16; bf16_t* rowp = O + (size_t)row * ldc + col0;
                const int p = row < 8192 ? (row & 4095) : (row < 8224 ? 4096 + ((row - 8192) & 3) : 0);
                const float* tb = TAB + ((size_t)p * 128 + ((col0 & 255) >> 1)) * 2;
#pragma unroll
                for (int bj = 0; bj < 2; ++bj) { f32x4 v0 = acc[ai][bj][m][0], v1 = acc[ai][bj][m][1];
                    if (rot) { const f32x4 c0 = *(const f32x4*)(tb + bj * HALF), c1 = *(const f32x4*)(tb + bj * HALF + 4);
                        v0 = (f32x4){(v0[0] * c0[0] - v0[1] * c0[1]) * scl, (v0[1] * c0[0] + v0[0] * c0[1]) * scl, (v0[2] * c0[2] - v0[3] * c0[3]) * scl, (v0[3] * c0[2] + v0[2] * c0[3]) * scl};
                        v1 = (f32x4){(v1[0] * c1[0] - v1[1] * c1[1]) * scl, (v1[1] * c1[0] + v1[0] * c1[1]) * scl, (v1[2] * c1[2] - v1[3] * c1[3]) * scl, (v1[3] * c1[2] + v1[2] * c1[3]) * scl}; }
                    u32x4 w; w.x = cvt_pk_bf16(v0[0], v0[1]); w.y = cvt_pk_bf16(v0[2], v0[3]); w.z = cvt_pk_bf16(v1[0], v1[1]); w.w = cvt_pk_bf16(v1[2], v1[3]);
                    *(u32x4*)(rowp + bj * HALF) = w; } }
    }
};
struct EpiResid {
    static constexpr bool PERM = false, AFTER_DRAIN = false;
    const float* __restrict__ X; float* __restrict__ Z; int ldc; float alpha;
    __device__ __forceinline__ void operator()(const f32x4 (&acc)[2][2][4][2], const Unit& u, int wr, int wc, int fr, int fq) const {
        const int row0 = u.pm * BM + wr * 64 + fr, col0 = u.pn * BM + wc * 32 + 4 * fq;
#pragma unroll
        for (int ai = 0; ai < 2; ++ai)
#pragma unroll
            for (int mp = 0; mp < 2; ++mp) { f32x4 xv[2][2][2];
#pragma unroll
                for (int mm = 0; mm < 2; ++mm) { const float* rowp = X + (size_t)(row0 + ai * HALF + (2 * mp + mm) * 16) * ldc + col0;
#pragma unroll
                    for (int bj = 0; bj < 2; ++bj)
#pragma unroll
                        for (int n = 0; n < 2; ++n) xv[mm][bj][n] = *(const f32x4*)(rowp + bj * HALF + n * 16); }
#pragma unroll
                for (int mm = 0; mm < 2; ++mm) { float* rowz = Z + (size_t)(row0 + ai * HALF + (2 * mp + mm) * 16) * ldc + col0;
#pragma unroll
                    for (int bj = 0; bj < 2; ++bj)
#pragma unroll
                        for (int n = 0; n < 2; ++n) *(f32x4*)(rowz + bj * HALF + n * 16) = xv[mm][bj][n] * alpha + acc[ai][bj][2 * mp + mm][n]; } }
    }
};
template <class Epi, class Sched, bool ALIGN_EPI = false, bool SP2 = false>
__device__ __forceinline__ void gemm_phase(PG8_LAS unsigned char* lds, const Gemm g, const Sched& S, const Epi& E) {
    int tid_ = threadIdx.x; asm volatile("" : "+v"(tid_));
    const int tid = tid_, wid = __builtin_amdgcn_readfirstlane(tid >> 6), lane = tid & 63, wr = wid >> 2, wc = wid & 3, fr = lane & 15, fq = lane >> 4;
    const int K = g.K, nt = K / BK;
    unsigned voffA[2], voffB[2];
#pragma unroll
    for (int i = 0; i < 2; ++i) { int R, C; stage_rc(tid * 16 + i * 8192, R, C); const int Rb = Epi::PERM ? ((R & ~31) + perm32(R & 31)) : R;
        voffA[i] = (unsigned)(R * K + C) * 2u; voffB[i] = (unsigned)(Rb * K + C) * 2u; }
    const size_t kstep = (size_t)(BK * 2);
    const size_t hstep = (size_t)HALF * K * 2;
    const size_t tstep = 2 * hstep;
    const unsigned ldsw = (unsigned)wid * 1024u;
    const int aoff = lds_byte(wr * 64 + fr, fq * 8), boff = lds_byte(wc * 32 + fr, fq * 8);
#define PG8_SA(b, h) (((b) * 2 + (h)) * HTB)
#define PG8_SB(b, h) ((4 + (b) * 2 + (h)) * HTB)
#define PG8_STAGE(bufoff, gbase, voff) do { _Pragma("unroll") for (int _i = 0; _i < 2; ++_i) \
        __builtin_amdgcn_global_load_lds((const unsigned*)((const char*)(gbase) + (voff)[_i]), (PG8_LAS unsigned*)(lds + (bufoff) + ldsw + _i * 8192), 16, 0, 0); } while (0)
#define PG8_LDA(dst, b, h) do { _Pragma("unroll") for (int m = 0; m < 4; ++m) _Pragma("unroll") for (int k = 0; k < 2; ++k) dst[m][k] = *(const PG8_LAS bf16x8*)(lds + PG8_SA(b, h) + aoff + m * 2048 + k * 1024); } while (0)
#define PG8_LDB(dst, b, h) do { _Pragma("unroll") for (int n = 0; n < 2; ++n) _Pragma("unroll") for (int k = 0; k < 2; ++k) dst[n][k] = *(const PG8_LAS bf16x8*)(lds + PG8_SB(b, h) + boff + n * 2048 + k * 1024); } while (0)
#define PG8_MMA(ai, bj, At, Bt) do { __builtin_amdgcn_s_setprio(1); _Pragma("unroll") for (int m = 0; m < 4; ++m) _Pragma("unroll") for (int n = 0; n < 2; ++n) _Pragma("unroll") for (int k = 0; k < 2; ++k) \
        acc[ai][bj][m][n] = __builtin_amdgcn_mfma_f32_16x16x32_bf16(Bt[n][k], At[m][k], acc[ai][bj][m][n], 0, 0, 0); __builtin_amdgcn_s_setprio(0); } while (0)
#define PG8_WAIT_V(n) asm volatile("s_waitcnt vmcnt(" #n ")" ::: "memory")
#define PG8_WAIT_L(n) asm volatile("s_waitcnt lgkmcnt(" #n ")" ::: "memory")
#define PG8_BAR __builtin_amdgcn_s_barrier()
#define PG8_SCHED __builtin_amdgcn_sched_barrier(0)
    Unit cur, nxt; int ui = 0;
    if (!S.next(0, cur)) return;
    f32x4 acc[2][2][4][2];
#pragma unroll
    for (int a = 0; a < 2; ++a)
#pragma unroll
        for (int b = 0; b < 2; ++b)
#pragma unroll
            for (int m = 0; m < 4; ++m)
#pragma unroll
                for (int n = 0; n < 2; ++n) acc[a][b][m][n] = (f32x4){0.f, 0.f, 0.f, 0.f};
    bf16x8 At[4][2], B0[2][2], B1[2][2];
    const char* cA = (const char*)g.A + (size_t)cur.pm * tstep; const char* cB = (const char*)g.Bt + (size_t)cur.pn * tstep;
    S.a_ready(cur);
    if constexpr (SP2) {
        PG8_STAGE(PG8_SB(0, 0), cB, voffB); PG8_STAGE(PG8_SB(0, 1), cB + hstep, voffB); PG8_STAGE(PG8_SA(0, 0), cA, voffA); PG8_STAGE(PG8_SA(0, 1), cA + hstep, voffA);
        if (wr == 1) PG8_BAR;
        PG8_WAIT_V(2); PG8_BAR;
        PG8_STAGE(PG8_SB(1, 0), cB + kstep, voffB); PG8_STAGE(PG8_SA(1, 0), cA + kstep, voffA); PG8_STAGE(PG8_SB(1, 1), cB + hstep + kstep, voffB);
        PG8_WAIT_V(6); PG8_BAR;
    } else {
        PG8_STAGE(PG8_SB(0, 0), cB, voffB); PG8_STAGE(PG8_SA(0, 0), cA, voffA); PG8_STAGE(PG8_SB(0, 1), cB + hstep, voffB); PG8_STAGE(PG8_SA(0, 1), cA + hstep, voffA);
        if (wr == 1) PG8_BAR;
        PG8_WAIT_V(4); PG8_BAR;
        PG8_STAGE(PG8_SB(1, 0), cB + kstep, voffB); PG8_STAGE(PG8_SA(1, 0), cA + kstep, voffA); PG8_STAGE(PG8_SB(1, 1), cB + hstep + kstep, voffB);
        PG8_WAIT_V(6); PG8_BAR;
    }
    for (;;) {
        const bool has_next = S.next(ui + 1, nxt);
        const char* nA = has_next ? (const char*)g.A + (size_t)nxt.pm * tstep : cA; const char* nB = has_next ? (const char*)g.Bt + (size_t)nxt.pn * tstep : cB;
        for (int t = 0; t < nt; t += 2) {
            const bool last = (t == nt - 2);
            const char* a1 = cA + (size_t)(t + 1) * kstep;
            const char* a2 = last ? nA : cA + (size_t)(t + 2) * kstep; const char* b2 = last ? nB : cB + (size_t)(t + 2) * kstep;
            const char* a3 = a2 + kstep; const char* b3 = b2 + kstep;
            if (last && has_next) S.a_ready(nxt);
            if constexpr (SP2) {
            PG8_LDB(B0, 0, 0); PG8_LDB(B1, 0, 1); PG8_SCHED; PG8_LDA(At, 0, 0); PG8_STAGE(PG8_SA(1, 1), a1 + hstep, voffA);
            PG8_WAIT_V(8); PG8_WAIT_L(0); PG8_BAR; PG8_MMA(0, 0, At, B0); PG8_MMA(0, 1, At, B1); PG8_BAR; PG8_SCHED;
            PG8_LDA(At, 0, 1); PG8_STAGE(PG8_SB(0, 0), b2, voffB); PG8_STAGE(PG8_SB(0, 1), b2 + hstep, voffB); PG8_STAGE(PG8_SA(0, 0), a2, voffA);
            PG8_WAIT_V(8); PG8_WAIT_L(0); PG8_BAR; PG8_MMA(1, 0, At, B0); PG8_MMA(1, 1, At, B1); PG8_BAR; PG8_SCHED;
            PG8_LDB(B0, 1, 0); PG8_LDB(B1, 1, 1); PG8_SCHED; PG8_LDA(At, 1, 0); PG8_STAGE(PG8_SA(0, 1), a2 + hstep, voffA);
            PG8_WAIT_V(8); PG8_WAIT_L(0); PG8_BAR; PG8_MMA(0, 0, At, B0); PG8_MMA(0, 1, At, B1); PG8_BAR; PG8_SCHED;
            PG8_LDA(At, 1, 1); PG8_STAGE(PG8_SB(1, 0), b3, voffB); PG8_STAGE(PG8_SB(1, 1), b3 + hstep, voffB); PG8_STAGE(PG8_SA(1, 0), a3, voffA);
            PG8_WAIT_V(8); PG8_WAIT_L(0); PG8_BAR; PG8_MMA(1, 0, At, B0); PG8_MMA(1, 1, At, B1); PG8_BAR; PG8_SCHED;
            } else {
            PG8_LDB(B0, 0, 0); PG8_SCHED; PG8_LDA(At, 0, 0); PG8_STAGE(PG8_SA(1, 1), a1 + hstep, voffA);
            PG8_WAIT_L(8); PG8_BAR; PG8_WAIT_L(0); PG8_MMA(0, 0, At, B0); PG8_BAR; PG8_SCHED;
            PG8_LDB(B1, 0, 1); PG8_STAGE(PG8_SB(0, 0), b2, voffB);
            PG8_BAR; PG8_WAIT_L(0); PG8_MMA(0, 1, At, B1); PG8_BAR;
            PG8_LDA(At, 0, 1); PG8_STAGE(PG8_SA(0, 0), a2, voffA);
            PG8_BAR; PG8_WAIT_L(0); PG8_MMA(1, 0, At, B0); PG8_BAR; PG8_SCHED;
            PG8_STAGE(PG8_SB(0, 1), b2 + hstep, voffB);
            PG8_WAIT_V(6); PG8_BAR; PG8_MMA(1, 1, At, B1); PG8_BAR;
            PG8_LDB(B0, 1, 0); PG8_SCHED; PG8_LDA(At, 1, 0); PG8_STAGE(PG8_SA(0, 1), a2 + hstep, voffA);
            PG8_WAIT_L(8); PG8_BAR; PG8_WAIT_L(0); PG8_MMA(0, 0, At, B0); PG8_BAR; PG8_SCHED;
            PG8_LDB(B1, 1, 1); PG8_STAGE(PG8_SB(1, 0), b3, voffB);
            PG8_BAR; PG8_WAIT_L(0); PG8_MMA(0, 1, At, B1); PG8_BAR;
            PG8_LDA(At, 1, 1); PG8_STAGE(PG8_SA(1, 0), a3, voffA);
            PG8_BAR; PG8_WAIT_L(0); PG8_MMA(1, 0, At, B0); PG8_BAR; PG8_SCHED;
            PG8_STAGE(PG8_SB(1, 1), b3 + hstep, voffB);
            PG8_WAIT_V(6); PG8_BAR; PG8_MMA(1, 1, At, B1); PG8_BAR;
            }
        }
        if constexpr (ALIGN_EPI) { if (wr == 0) PG8_BAR; }
        if constexpr (!Epi::AFTER_DRAIN) { for (int rpe_ = 0; rpe_ < REPE; ++rpe_) { E(acc, cur, wr, wc, fr, fq); asm volatile("" ::: "memory"); } S.done(cur); }
        if (!has_next) break;
#pragma unroll
        for (int a = 0; a < 2; ++a)
#pragma unroll
            for (int b = 0; b < 2; ++b)
#pragma unroll
                for (int m = 0; m < 4; ++m)
#pragma unroll
                    for (int n = 0; n < 2; ++n) acc[a][b][m][n] = (f32x4){0.f, 0.f, 0.f, 0.f};
        cur = nxt; cA = nA; cB = nB; ++ui;
        if constexpr (ALIGN_EPI) { if (wr == 1) PG8_BAR; }
    }
    PG8_WAIT_V(0);
    if constexpr (!ALIGN_EPI) { if (wr == 0) PG8_BAR; }
    PG8_BAR;
    if constexpr (Epi::AFTER_DRAIN) { E.fused(acc, cur, wr, wc, fr, fq, lds, wid, lane); S.done(cur); }
#undef PG8_SA
#undef PG8_SB
#undef PG8_STAGE
#undef PG8_LDA
#undef PG8_LDB
#undef PG8_MMA
#undef PG8_WAIT_V
#undef PG8_WAIT_L
#undef PG8_BAR
#undef PG8_SCHED
}
}
constexpr int DM = 2048, SEQ = 4096, TP = 8192, TS = 32, TT = TP + TS, MPAD = 8448;
constexpr int EVEN_IN = 6784, EVEN_INP = 6912, ODD_IN = 7168, LDH = 7168;
constexpr int EVEN_OUT = 1536, ODD_OUT = 2048;
constexpr float ALPHA = 1.6817928305074292f;
constexpr float LN_EPS = 1e-5f;
constexpr int EC_R = 0, EC_K = 768, EC_V = 1536, EC_HW = 2304, EC_HA = 2368, EC_GA = 2432, EC_QB = 3200, EC_KB = 3968, EC_VB = 4736, EC_GB = 5504, EC_QM = 5760, EC_GM = 6272;
constexpr int OC_Q = 0, OC_K = 1536, OC_V = 3072, OC_G = 4608, OC_QM = 6144, OC_GM = 6656;
constexpr size_t O_YP = 0, O_YS = 16777216, O_RWKV_P = O_YS + 65536, O_RWKV_S = O_RWKV_P + 196608, O_SH_P = O_RWKV_S + 786432, O_SH_S = O_SH_P + 9728,
    O_G0P = O_SH_S + 38912, O_G0S = O_G0P + 262144, O_G1P = O_G0S + 32768, O_G1S = O_G1P + 1048576, O_G2P = O_G1S + 32768, O_G2S = O_G2P + 4194304,
    O_RET_P = O_G2S + 32768, O_RET_S = O_RET_P + 1572864, O_MEM = O_RET_S + 6291456, O_END = O_MEM + 2097152;
constexpr size_t MiB = 1u << 20;
constexpr size_t WS_CTL = 0, WS_WTIN = 1 * MiB, WS_WTOUT = 29 * MiB, WS_WTMEM = 37 * MiB, WS_MEMB = 53 * MiB, WS_TAB = 55 * MiB, WS_XB = 60 * MiB, WS_XZ = 93 * MiB,
    WS_HB = 159 * MiB, WS_U = 275 * MiB, WS_YA = 308 * MiB, WS_PREP = 333 * MiB, WS_OG = 478 * MiB, WS_LSE = 478 * MiB + 49 * MiB / 2, WS_MKVB = 503 * MiB, WS_VT = 507 * MiB, WS_WTOUT2 = 509 * MiB, WS_END = 517 * MiB;
constexpr int LDS_BYTES = 147456;

#define LAS __attribute__((address_space(3)))
typedef unsigned short bf16;
typedef float f32x4 __attribute__((ext_vector_type(4)));
typedef short bf16x8 __attribute__((ext_vector_type(8)));
typedef unsigned u32x4 __attribute__((ext_vector_type(4)));
typedef unsigned u32x2 __attribute__((ext_vector_type(2)));

__device__ const double ANG[128] = {
1.0, 0.9300449458481392, 0.8649836012976682, 0.8044736266284181, 0.7481966305138833, 0.6958564947100448, 0.6471778159406796, 0.6019044567806663, 0.5597981979123284, 0.5206374846632574, 0.48421626123015066, 0.45034288645458387, 0.41883912544574814, 0.3895392117442728, 0.362288975092429, 0.336945030221216, 0.31337402238589046, 0.29145192568009903, 0.2710633904364836, 0.2521011362799124, 0.23446538763970548, 0.21806334875063282, 0.20280871538024622, 0.18862122071335174, 0.17542621300415914, 0.1631542627737973, 0.15174079748634942, 0.14112576178114528, 0.13125330147352265, 0.12207146966133185, 0.11353195339077617, 0.10558981944335787, 0.09820327790631257, 0.09133346228248625, 0.08494422498263796, 0.07900194712408967, 0.07347536163492155, 0.06833538873292307, 0.06355498291362295, 0.059108990642279875, 0.05497401800103736, 0.05112830759482943, 0.04755162406834012, 0.04422514763163046, 0.04113137503418572, 0.03825402746632876, 0.03557796490339495, 0.03308910644196496, 0.030774356208980617, 0.02862153445389273, 0.026619313461261302, 0.024757157946593413, 0.023025269621793302, 0.02141453563853956, 0.019916480638308563, 0.018523222156741202, 0.017227429147699425, 0.01602228340877477, 0.014901443705277463, 0.013859012403933875, 0.01288950444072537, 0.01198781845958378, 0.011149209970080915, 0.01036926638287344, 0.009643883791544459, 0.008969245378672715, 0.008341801332506338, 0.007758250168566794, 0.007215521357901014, 0.006710759170575141, 0.006241307649397462, 0.00580469663480544, 0.005398628767382501, 0.005020967399614466, 0.004669725353279709, 0.0043430544633167095, 0.0040392358531509045, 0.003756670890311596, 0.0034938727747491297, 0.0032494587155918425, 0.0030221426551783792, 0.002810728502080728, 0.002614103837511492, 0.002431234061999789, 0.002261156951536743, 0.002102977594546134, 0.0019558636830395095, 0.0018190411331788228, 0.0016917900122028363, 0.0015734407502856099, 0.0014633706173946357, 0.0013610004466105522, 0.001265791586667203, 0.001177243067676929, 0.001094888965127687, 0.0010182959482819048, 0.0009470610000772239, 0.0008808092965317064, 0.0008191922344953685, 0.0007618855973704613, 0.0007085878491488872, 0.0006590185477903263, 0.0006129168695925734, 0.0005700402367896359, 0.0005301630411562774, 0.000493075456902875, 0.00045858233661428085, 0.00042650218442334204, 0.0003966662010161199, 0.00036891739544382435, 0.0003431097590679882, 0.0003191074972923552, 0.00029678431503900375, 0.0002760227522090274, 0.00025671356563109924, 0.00023875515424585844, 0.00022205302450155334, 0.00020651929314796272, 0.00019207222481239299, 0.0001786358019245737, 0.00016613932472747905, 0.0001545170392694147, 0.0001437077914199376, 0.00013365470508911156, 0.00012430488295695166, 0.00011560912813835741, 0.00010752168531898921, 0.0001};
__device__ const float LG2G[6] = {-0.04580368961312479f, -0.02272007650008353f, -0.011315313227834146f, -0.005646563141142063f, -0.0028205190623786626f, -0.0014095702546713536f};

__device__ __forceinline__ float bf2f(unsigned b) { return __uint_as_float(b << 16); }
typedef __bf16 bf16x2_t __attribute__((ext_vector_type(2)));
typedef float f32x2_t __attribute__((ext_vector_type(2)));
__device__ __forceinline__ unsigned f2bf(float f) { return (unsigned)__builtin_bit_cast(unsigned short, (__bf16)f); }
__device__ __forceinline__ unsigned pk2(float lo, float hi) { const f32x2_t v = {lo, hi}; return __builtin_bit_cast(unsigned, __builtin_convertvector(v, bf16x2_t)); }
__device__ __forceinline__ void unpk4(u32x2 w, float (&x)[4]) { x[0] = __uint_as_float(w.x << 16); x[1] = __uint_as_float(w.x & 0xffff0000u); x[2] = __uint_as_float(w.y << 16); x[3] = __uint_as_float(w.y & 0xffff0000u); }
__device__ __forceinline__ void unpk8(u32x4 w, float (&x)[8]) {
    x[0] = __uint_as_float(w.x << 16); x[1] = __uint_as_float(w.x & 0xffff0000u); x[2] = __uint_as_float(w.y << 16); x[3] = __uint_as_float(w.y & 0xffff0000u);
    x[4] = __uint_as_float(w.z << 16); x[5] = __uint_as_float(w.z & 0xffff0000u); x[6] = __uint_as_float(w.w << 16); x[7] = __uint_as_float(w.w & 0xffff0000u); }
template <int CTRL> __device__ __forceinline__ float dppf(float x) { return __builtin_bit_cast(float, __builtin_amdgcn_update_dpp(0, __builtin_bit_cast(int, x), CTRL, 0xF, 0xF, true)); }
__device__ __forceinline__ float red16(float x) { x += dppf<0xB1>(x); x += dppf<0x4E>(x); x += dppf<0x141>(x); x += dppf<0x140>(x); return x; }
__device__ __forceinline__ float wave_sum(float x) { x = red16(x); x += __shfl_xor(x, 16); x += __shfl_xor(x, 32); return x; }
__device__ __forceinline__ float sigmoidf_(float x) { return 1.0f / (1.0f + __expf(-x)); }
__device__ __forceinline__ float siluf_(float x) { return x / (1.0f + __expf(-x)); }
#define LDS_WAIT() asm volatile("s_waitcnt lgkmcnt(0)" ::: "memory")

struct Args { const float* in[27]; float* out; unsigned char* ws; int ph_lo, ph_hi; };
typedef const __attribute__((address_space(4))) Args* ArgsP;
struct Ctx {
    ArgsP ap;
    LAS unsigned char* lds;
    int tid, lane, wave, bid, G;
};
#define C_IN(k) (c.ap->in[k])
#define C_OUT (c.ap->out)
#define C_WTIN ((bf16*)(c.ap->ws + WS_WTIN))
#define C_WTOUT_L(l_) ((bf16*)(c.ap->ws + (((l_) & 1) ? WS_WTOUT2 : WS_WTOUT)))
#define C_WTMEM ((bf16*)(c.ap->ws + WS_WTMEM))
#define C_MEMB ((bf16*)(c.ap->ws + WS_MEMB))
#define C_XB ((bf16*)(c.ap->ws + WS_XB))
#define C_HB ((bf16*)(c.ap->ws + WS_HB))
#define C_U ((bf16*)(c.ap->ws + WS_U))
#define C_TAB ((float*)(c.ap->ws + WS_TAB))
#define C_XZ ((float*)(c.ap->ws + WS_XZ))
#define C_YA ((float*)(c.ap->ws + WS_YA))
#define C_PREP ((float*)(c.ap->ws + WS_PREP))
#define C_CHK ((unsigned char*)(c.ap->ws + WS_PREP))
#define C_PREPS ((float*)(c.ap->ws + WS_PREP + 120 * MiB))
#define C_BONUS ((float*)(c.ap->ws + WS_PREP + 125 * MiB))
#define C_WUT ((bf16*)(c.ap->ws + WS_PREP + 126 * MiB))
#define C_AUT ((bf16*)(c.ap->ws + WS_PREP + 126 * MiB) + 2 * 768 * 64)
constexpr int CHK_BYTES = 40960, CK_A = 0, CK_RQ = 9216, CK_GT = 13824, CK_YVT = 31232;
#define C_YR ((float*)(c.ap->ws + WS_PREP))
#define C_Z ((float*)(c.ap->ws + WS_HB))
#define C_OG ((float*)(c.ap->ws + WS_OG))
#define C_LSE ((float*)(c.ap->ws + WS_LSE))
#define C_MKVB ((bf16*)(c.ap->ws + WS_MKVB))
#define C_VT ((bf16*)(c.ap->ws + WS_VT))

__device__ __forceinline__ void transpose_item(const float* W, int K, int N, bf16* WT, int row_off, LAS float* scr, int item, int lane) {
    const int nblk = N / 32, kb = item / nblk, nb = item % nblk, k0 = 64 * kb, n0 = 32 * nb;
    f32x4 wv[8];
#pragma unroll
    for (int i = 0; i < 8; ++i) { const int kk = 8 * i + (lane >> 3), c4 = 4 * (lane & 7); wv[i] = *(const f32x4*)(W + (size_t)(k0 + kk) * N + n0 + c4); }
#pragma unroll
    for (int i = 0; i < 8; ++i) { const int kk = 8 * i + (lane >> 3), c4 = 4 * (lane & 7); const f32x4 w4 = wv[i];
        scr[kk * 33 + c4] = w4.x; scr[kk * 33 + c4 + 1] = w4.y; scr[kk * 33 + c4 + 2] = w4.z; scr[kk * 33 + c4 + 3] = w4.w; }
    LDS_WAIT(); asm volatile("" ::: "memory");
    const int c = lane & 7;
#pragma unroll
    for (int j = 0; j < 4; ++j) { const int n = (lane >> 3) + 8 * j; const LAS float* s = scr + (8 * c) * 33 + n;
        u32x4 o; o.x = pk2(s[0 * 33], s[1 * 33]); o.y = pk2(s[2 * 33], s[3 * 33]); o.z = pk2(s[4 * 33], s[5 * 33]); o.w = pk2(s[6 * 33], s[7 * 33]);
        *(u32x4*)(WT + (size_t)(row_off + n0 + n) * K + k0 + 8 * c) = o; }
    LDS_WAIT(); asm volatile("" ::: "memory");
}
__device__ __forceinline__ void transpose_matrix(const Ctx& c, const float* W, int K, int N, bf16* WT, int row_off) {
    LAS float* scr = (LAS float*)(c.lds + c.wave * 16384);
    const int gw = c.bid * 8 + c.wave, NGW = c.G * 8, nitems = (K / 64) * (N / 32);
    for (int it = gw; it < nitems; it += NGW) transpose_item(W, K, N, WT, row_off, scr, it, c.lane);
}
__device__ __forceinline__ void convert_layer_weights(const Ctx& c, int l) {
    if ((l & 1) == 0) { const int e = l >> 1;
        transpose_matrix(c, C_IN(10) + (size_t)e * DM * EVEN_IN, DM, EVEN_IN, C_WTIN, 0);
        transpose_matrix(c, C_IN(11) + (size_t)e * EVEN_OUT * DM, EVEN_OUT, DM, C_WTOUT_L(l), 0);
        const int n16 = (EVEN_INP - EVEN_IN) * DM * 2 / 16; u32x4* p = (u32x4*)(C_WTIN + (size_t)EVEN_IN * DM);
        for (int i = c.bid * 512 + c.tid; i < n16; i += c.G * 512) p[i] = (u32x4){0u, 0u, 0u, 0u};
    } else { const int o = l >> 1;
        transpose_matrix(c, C_IN(12) + (size_t)o * DM * ODD_IN, DM, ODD_IN, C_WTIN, 0);
        transpose_matrix(c, C_IN(13) + (size_t)o * ODD_OUT * DM, ODD_OUT, DM, C_WTOUT_L(l), 0);
    }
}

__device__ __forceinline__ void phase_prologue(const Ctx& c) {
    for (int l = 0; l < 4; ++l) transpose_matrix(c, C_IN(14) + (size_t)l * DM * 1024, DM, 1024, C_WTMEM, l * 1024);
    convert_layer_weights(c, 0);
    const int gt = c.bid * 512 + c.tid, NT = c.G * 512;
    for (int i = gt; i < 2 * 768 * 64; i += NT) { const int e = i / (768 * 64), rem = i % (768 * 64), col = rem >> 6, k = rem & 63;
        C_WUT[i] = (bf16)f2bf(C_IN(19)[((size_t)e * 64 + k) * 768 + col]); C_AUT[i] = (bf16)f2bf(C_IN(21)[((size_t)e * 64 + k) * 768 + col]); }
    for (int i = gt; i < 512 * DM / 4; i += NT) { const f32x4 v = ((const f32x4*)C_IN(9))[i]; ((u32x2*)C_MEMB)[i] = (u32x2){pk2(v.x, v.y), pk2(v.z, v.w)}; }
    for (int i = gt; i < MPAD * DM / 4; i += NT) {
        const int row = i / (DM / 4);
        f32x4 v = (f32x4){0.f, 0.f, 0.f, 0.f};
        if (row < TP) v = ((const f32x4*)C_IN(0))[i]; else if (row < TT) v = ((const f32x4*)C_IN(1))[i - TP * (DM / 4)];
        ((u32x2*)C_XB)[i] = (u32x2){pk2(v.x, v.y), pk2(v.z, v.w)};
    }
    for (int i = gt; i < 4100 * 128; i += NT) {
        const int p = i >> 7, ci = i & 127; const double pos = (double)(p < 4096 ? p : 16384 + (p - 4096));
        double ph = pos * ANG[ci];
        const double k = __builtin_rint(ph * 0.15915494309189535); ph = __builtin_fma(-k, 6.283185307179586, ph); ph = __builtin_fma(-k, 2.4492935982947064e-16, ph);
        const double q = __builtin_rint(ph * 0.6366197723675814); const double y = __builtin_fma(-q, 1.5707963267948966, ph) - q * 6.123233995736766e-17;
        const double y2 = y * y;
        const double sn = y * (1.0 + y2 * (-1.0 / 6 + y2 * (1.0 / 120 + y2 * (-1.0 / 5040 + y2 * (1.0 / 362880 + y2 * (-1.0 / 39916800 + y2 * (1.0 / 6227020800.0)))))));
        const double cs = 1.0 + y2 * (-0.5 + y2 * (1.0 / 24 + y2 * (-1.0 / 720 + y2 * (1.0 / 40320 + y2 * (-1.0 / 3628800 + y2 * (1.0 / 479001600.0 + y2 * (-1.0 / 87178291200.0)))))));
        const int qi = ((int)q) & 3; double co, si;
        if (qi == 0) { co = cs; si = sn; } else if (qi == 1) { co = -sn; si = cs; } else if (qi == 2) { co = -cs; si = -sn; } else { co = sn; si = -cs; }
        C_TAB[2 * i] = (float)co; C_TAB[2 * i + 1] = (float)si;
    }
}

__device__ __forceinline__ void rwkv_prep_item(const Ctx& c, int it, int e) {
    LAS float* lw = (LAS float*)c.lds;
    LAS float* la = lw + 16 * 64;
    const float* mu = C_IN(17) + e * 2432; const float* shift = C_IN(3) + (size_t)e * 8 * 2432;
    const int R0 = it * 16;
    for (int i = c.tid; i < 16 * 128; i += 512) {
        const int tk = i >> 7, cc = i & 127, R = R0 + tk; float val = 0.f;
        if (R < TT) { const int col = EC_HW + cc; const float hcur = bf2f(C_HB[(size_t)R * LDH + col]);
            float hprev;
            if (R < TP) hprev = ((R & (SEQ - 1)) == 0) ? 0.f : bf2f(C_HB[(size_t)(R - 1) * LDH + col]);
            else { const int n = (R - TP) >> 2, t = (R - TP) & 3; hprev = (t == 0) ? shift[n * 2432 + col] : bf2f(C_HB[(size_t)(R - 1) * LDH + col]); }
            const float hs = hcur + (hprev - hcur) * mu[col];
            val = (cc < 64) ? tanhf(hs) : hs; }
        if (cc < 64) lw[tk * 64 + cc] = val; else la[tk * 64 + (cc - 64)] = val;
    }
    __syncthreads();
    const int tl = c.tid & 255, tg = c.tid >> 8;
    const float* w_up = C_IN(19) + (size_t)e * 64 * 768; const float* a_up = C_IN(21) + (size_t)e * 64 * 768;
    const float* w0 = C_IN(18) + e * 768; const float* a0 = C_IN(20) + e * 768; const float* k_k = C_IN(22) + e * 768; const float* k_a = C_IN(23) + e * 768;
#pragma unroll 1
    for (int m = 0; m < 3; ++m) {
        const int col = tl + 256 * m, h = col >> 6, ci = col & 63;
        float xw[8], xa[8];
#pragma unroll
        for (int t = 0; t < 8; ++t) { xw[t] = 0.f; xa[t] = 0.f; }
#pragma unroll 4
        for (int kk = 0; kk < 64; ++kk) { const float wu = w_up[kk * 768 + col], au = a_up[kk * 768 + col];
#pragma unroll
            for (int t = 0; t < 8; ++t) { xw[t] += lw[(tg * 8 + t) * 64 + kk] * wu; xa[t] += la[(tg * 8 + t) * 64 + kk] * au; } }
        const float w0c = w0[col], a0c = a0[col], kkc = k_k[col], kac = k_a[col], mur = mu[EC_R + col], muk = mu[EC_K + col], muv = mu[EC_V + col];
#pragma unroll
        for (int t = 0; t < 8; ++t) {
            const int R = R0 + tg * 8 + t;
            if (R >= TT || R < TP) continue;
            const bf16* hc = C_HB + (size_t)R * LDH; float pr, pk, pv;
            const float cr = bf2f(hc[EC_R + col]), ck = bf2f(hc[EC_K + col]), cv = bf2f(hc[EC_V + col]);
            bool has_prev_row; int n = 0;
            if (R < TP) has_prev_row = (R & (SEQ - 1)) != 0; else { n = (R - TP) >> 2; has_prev_row = ((R - TP) & 3) != 0; }
            if (has_prev_row) { const bf16* hp = hc - LDH; pr = bf2f(hp[EC_R + col]); pk = bf2f(hp[EC_K + col]); pv = bf2f(hp[EC_V + col]); }
            else if (R < TP) { pr = 0.f; pk = 0.f; pv = 0.f; }
            else { const float* sp = shift + n * 2432; pr = sp[EC_R + col]; pk = sp[EC_K + col]; pv = sp[EC_V + col]; }
            const float r = cr + (pr - cr) * mur, k = ck + (pk - ck) * muk, v = cv + (pv - cv) * muv;
            const float decay = __expf(-0.6065306597126334f * sigmoidf_(w0c + xw[t]));
            const float a = sigmoidf_(a0c + xa[t]);
            float kk = k * kkc; const float ss = wave_sum(kk * kk); kk *= rsqrtf(fmaxf(ss, 1e-24f));
            const float k2 = k * (1.0f + (a - 1.0f) * kac);
            float* dst = C_PREPS + ((size_t)(R - TP) * 12 + h) * 384 + ci;
            dst[0] = r; dst[64] = decay; dst[128] = k2; dst[192] = v; dst[256] = -kk; dst[320] = kk * a;
        }
    }
    __syncthreads();
}

__device__ __forceinline__ void dil_attn_item(const Ctx& c, int R, int hh, int e) {
    const int lane = c.lane, kg = lane >> 4, dl = lane & 15;
    float m = -1e30f, l = 0.f, acc[4] = {0.f, 0.f, 0.f, 0.f};
    const bool is_p = R < TP; const int t = is_p ? (R & (SEQ - 1)) : ((R - TP) & 3); const int n = is_p ? 0 : ((R - TP) >> 2);
    const size_t rowbase = is_p ? (size_t)(R - t) : (size_t)(TP + n * 4);
#pragma unroll
    for (int g = 0; g < 3; ++g) {
        const int dil = (g == 0) ? 1 : (g == 1 ? 4 : 16), W = 128 * dil;
        float q[4]; { const u32x2 w = *(const u32x2*)(C_HB + (size_t)R * LDH + EC_QB + g * 256 + hh * 64 + 4 * dl); unpk4(w, q); }
#pragma unroll
        for (int i = 0; i < 4; ++i) q[i] *= 0.125f;
        const float* cache = ((g == 0) ? C_IN(4) : (g == 1 ? C_IN(5) : C_IN(6))) + ((size_t)(e * 8 + n) * W) * 512;
#pragma unroll 1
        for (int j0 = 0; j0 < 129; j0 += 4) {
            const int j = j0 + kg; bool valid = j < 129; float kf[4] = {0.f, 0.f, 0.f, 0.f}, vf[4] = {0.f, 0.f, 0.f, 0.f};
            if (is_p) { const int pos = t - dil * j; valid = valid && pos >= 0;
                if (valid) { const bf16* kp = C_HB + (rowbase + pos) * LDH + g * 256 + hh * 64 + 4 * dl; unpk4(*(const u32x2*)(kp + EC_KB), kf); unpk4(*(const u32x2*)(kp + EC_VB), vf); } }
            else if (valid) { const int idx = W + t - dil * j;
                if (idx >= W) { const bf16* kp = C_HB + (rowbase + (idx - W)) * LDH + g * 256 + hh * 64 + 4 * dl; unpk4(*(const u32x2*)(kp + EC_KB), kf); unpk4(*(const u32x2*)(kp + EC_VB), vf); }
                else { const float* kp = cache + (size_t)idx * 512 + hh * 64 + 4 * dl; const f32x4 k4 = *(const f32x4*)kp, v4 = *(const f32x4*)(kp + 256);
                    kf[0] = k4.x; kf[1] = k4.y; kf[2] = k4.z; kf[3] = k4.w; vf[0] = v4.x; vf[1] = v4.y; vf[2] = v4.z; vf[3] = v4.w; } }
            float s = q[0] * kf[0] + q[1] * kf[1] + q[2] * kf[2] + q[3] * kf[3];
            s = red16(s);
            if (valid) { const float mn = fmaxf(m, s), sc = __expf(m - mn), p = __expf(s - mn);
                l = l * sc + p;
#pragma unroll
                for (int i = 0; i < 4; ++i) acc[i] = acc[i] * sc + p * vf[i];
                m = mn; }
        }
    }
#pragma unroll
    for (int off = 16; off <= 32; off <<= 1) {
        const float m2 = __shfl_xor(m, off), l2 = __shfl_xor(l, off); float a2[4];
#pragma unroll
        for (int i = 0; i < 4; ++i) a2[i] = __shfl_xor(acc[i], off);
        const float mn = fmaxf(m, m2), s1 = __expf(m - mn), s2 = __expf(m2 - mn);
        l = l * s1 + l2 * s2;
#pragma unroll
        for (int i = 0; i < 4; ++i) acc[i] = acc[i] * s1 + a2[i] * s2;
        m = mn;
    }
    if (kg == 0) { float gt[4]; unpk4(*(const u32x2*)(C_HB + (size_t)R * LDH + EC_GB + hh * 64 + 4 * dl), gt);
        const float inv = 1.0f / l; float o[4];
#pragma unroll
        for (int i = 0; i < 4; ++i) o[i] = acc[i] * inv * siluf_(gt[i]);
        *(u32x2*)(C_U + (size_t)R * EVEN_OUT + 768 + hh * 64 + 4 * dl) = (u32x2){pk2(o[0], o[1]), pk2(o[2], o[3])}; }
}

__device__ __forceinline__ void mem_attn_item(const Ctx& c, int R, int mh, int l, int qcol, int gcol, int ucol, int ldu) {
    const int lane = c.lane, kg = lane >> 5, dl = lane & 31;
    const float* mkv;
    if (R < TP) mkv = C_OUT + O_MEM + ((size_t)l * 512 + (R >> 12) * 256) * 1024; else mkv = C_IN(8) + ((size_t)l * 8 + ((R - TP) >> 2)) * 256 * 1024;
    float q[4]; unpk4(*(const u32x2*)(C_HB + (size_t)R * LDH + qcol + mh * 128 + 4 * dl), q);
#pragma unroll
    for (int i = 0; i < 4; ++i) q[i] *= 0.08838834764831845f;
    float m = -1e30f, lsum = 0.f, acc[4] = {0.f, 0.f, 0.f, 0.f};
#pragma unroll 8
    for (int j0 = 0; j0 < 256; j0 += 2) {
        const float* kp = mkv + (size_t)(j0 + kg) * 1024 + mh * 128 + 4 * dl; const f32x4 k4 = *(const f32x4*)kp, v4 = *(const f32x4*)(kp + 512);
        float s = q[0] * k4.x + q[1] * k4.y + q[2] * k4.z + q[3] * k4.w;
        s = red16(s); s += __shfl_xor(s, 16);
        const float mn = fmaxf(m, s), sc = __expf(m - mn), p = __expf(s - mn);
        lsum = lsum * sc + p; acc[0] = acc[0] * sc + p * v4.x; acc[1] = acc[1] * sc + p * v4.y; acc[2] = acc[2] * sc + p * v4.z; acc[3] = acc[3] * sc + p * v4.w; m = mn;
    }
    { const float m2 = __shfl_xor(m, 32), l2 = __shfl_xor(lsum, 32); float a2[4];
#pragma unroll
        for (int i = 0; i < 4; ++i) a2[i] = __shfl_xor(acc[i], 32);
        const float mn = fmaxf(m, m2), s1 = __expf(m - mn), s2 = __expf(m2 - mn);
        lsum = lsum * s1 + l2 * s2;
#pragma unroll
        for (int i = 0; i < 4; ++i) acc[i] = acc[i] * s1 + a2[i] * s2; }
    if (kg == 0) { float gt[4]; unpk4(*(const u32x2*)(C_HB + (size_t)R * LDH + gcol + mh * 128 + 4 * dl), gt);
        const float inv = 1.0f / lsum; float o[4];
#pragma unroll
        for (int i = 0; i < 4; ++i) o[i] = acc[i] * inv * siluf_(gt[i]);
        *(u32x2*)(C_U + (size_t)R * ldu + ucol + mh * 128 + 4 * dl) = (u32x2){pk2(o[0], o[1]), pk2(o[2], o[3])}; }
}


typedef float f32x16 __attribute__((ext_vector_type(16)));
__device__ __forceinline__ f32x16 mfma32(bf16x8 a, bf16x8 b, f32x16 cacc) { return __builtin_amdgcn_mfma_f32_32x32x16_bf16(a, b, cacc, 0, 0, 0); }
__device__ __forceinline__ void mem_attn_mfma_item(const Ctx& c, int item, int l, int qcol, int gcol, int ucol, int ldu) {
    const int blk = item >> 2, mh = item & 3, R0 = blk * 32, b = R0 >> 12;
    const int lane = c.lane, r = lane & 31, hh = lane >> 5;
    const bf16* Kb = C_MKVB + ((size_t)l * 512 + b * 256) * 1024 + mh * 128 + 8 * hh;
    const bf16* Vt = C_VT + ((size_t)l * 512 + mh * 128) * 512 + b * 256 + 4 * hh;
    bf16x8 Qf[8];
    { const bf16* qp = C_HB + (size_t)(R0 + r) * LDH + qcol + mh * 128 + 8 * hh;
#pragma unroll
        for (int ks = 0; ks < 8; ++ks) Qf[ks] = *(const bf16x8*)(qp + 16 * ks); }
    f32x16 O[4];
#pragma unroll
    for (int dt = 0; dt < 4; ++dt)
#pragma unroll
        for (int i = 0; i < 16; ++i) O[dt][i] = 0.f;
    float m = -1e30f, lsum = 0.f;
    const float cs = 0.08838834764831845f * 1.4426950408889634f;
#pragma unroll 1
    for (int half = 0; half < 2; ++half) {
        f32x16 S[4];
#pragma unroll
        for (int kt = 0; kt < 4; ++kt) {
#pragma unroll
            for (int i = 0; i < 16; ++i) S[kt][i] = 0.f;
            const bf16* kp = Kb + (size_t)(128 * half + 32 * kt + r) * 1024;
#pragma unroll
            for (int ks = 0; ks < 8; ++ks) S[kt] = mfma32(*(const bf16x8*)(kp + 16 * ks), Qf[ks], S[kt]);
        }
        float mx = -1e30f;
#pragma unroll
        for (int kt = 0; kt < 4; ++kt)
#pragma unroll
            for (int i = 0; i < 16; ++i) mx = fmaxf(mx, S[kt][i]);
        mx = fmaxf(mx, __shfl_xor(mx, 32));
        const float mn = fmaxf(m, mx), sc = __builtin_amdgcn_exp2f((m - mn) * cs); m = mn;
        lsum *= sc;
#pragma unroll
        for (int dt = 0; dt < 4; ++dt)
#pragma unroll
            for (int i = 0; i < 16; ++i) O[dt][i] *= sc;
        float ps = 0.f;
#pragma unroll
        for (int kt = 0; kt < 4; ++kt)
#pragma unroll
            for (int i = 0; i < 16; ++i) { const float p = __builtin_amdgcn_exp2f((S[kt][i] - mn) * cs); S[kt][i] = p; ps += p; }
        lsum += ps;
#pragma unroll
        for (int kt = 0; kt < 4; ++kt)
#pragma unroll
            for (int s2 = 0; s2 < 2; ++s2) {
                const u32x4 pw = (u32x4){pk2(S[kt][8 * s2 + 0], S[kt][8 * s2 + 1]), pk2(S[kt][8 * s2 + 2], S[kt][8 * s2 + 3]), pk2(S[kt][8 * s2 + 4], S[kt][8 * s2 + 5]), pk2(S[kt][8 * s2 + 6], S[kt][8 * s2 + 7])};
                const bf16x8 Pf = __builtin_bit_cast(bf16x8, pw);
                const int kb = 128 * half + 32 * kt + 16 * s2;
#pragma unroll
                for (int dt = 0; dt < 4; ++dt) { const bf16* vp = Vt + (size_t)(32 * dt + r) * 512 + kb;
                    const u32x2 v0 = *(const u32x2*)vp, v1 = *(const u32x2*)(vp + 8); const u32x4 vw = (u32x4){v0.x, v0.y, v1.x, v1.y};
                    O[dt] = mfma32(__builtin_bit_cast(bf16x8, vw), Pf, O[dt]); }
            }
    }
    lsum += __shfl_xor(lsum, 32); const float inv = 1.0f / lsum;
    const bf16* gp = C_HB + (size_t)(R0 + r) * LDH + gcol + mh * 128 + 4 * hh; bf16* up = C_U + (size_t)(R0 + r) * ldu + ucol + mh * 128 + 4 * hh;
#pragma unroll
    for (int dt = 0; dt < 4; ++dt)
#pragma unroll
        for (int g4 = 0; g4 < 4; ++g4) { float gt[4]; unpk4(*(const u32x2*)(gp + 32 * dt + 8 * g4), gt);
            const float o0 = O[dt][4 * g4 + 0] * inv * siluf_(gt[0]), o1 = O[dt][4 * g4 + 1] * inv * siluf_(gt[1]), o2 = O[dt][4 * g4 + 2] * inv * siluf_(gt[2]), o3 = O[dt][4 * g4 + 3] * inv * siluf_(gt[3]);
            *(u32x2*)(up + 32 * dt + 8 * g4) = (u32x2){pk2(o0, o1), pk2(o2, o3)}; }
}
__device__ __forceinline__ void mem_attn_sample_block(const Ctx& c, int item, int l, int qcol, int gcol, int ucol, int ldu);
__device__ __forceinline__ void mem_attn_all(const Ctx& c, int l, int qcol, int gcol, int ucol, int ldu) {
    constexpr int NM = (TP / 32) * 4;
    { const int x = c.bid & 7, nbx = (c.G + 7 - x) >> 3, lb = c.bid >> 3, bb = x >> 2, mh = x & 3;
        for (int r = lb * 8 + c.wave; r < 128; r += nbx * 8) mem_attn_mfma_item(c, ((bb * 128 + r) << 2) | mh, l, qcol, gcol, ucol, ldu); }
    for (int it = c.bid; it < TS * 4; it += c.G) mem_attn_sample_block(c, it, l, qcol, gcol, ucol, ldu);
}

typedef short s16x4 __attribute__((ext_vector_type(4)));
__device__ __forceinline__ f32x4 mfma16(bf16x8 a, bf16x8 b, f32x4 cacc) { return __builtin_amdgcn_mfma_f32_16x16x32_bf16(a, b, cacc, 0, 0, 0); }
__device__ __forceinline__ bf16x8 tr_frag(const LAS bf16* p, int rowstride4) {
    const s16x4 a0 = __builtin_amdgcn_ds_read_tr16_b64_v4i16((LAS s16x4*)p), a1 = __builtin_amdgcn_ds_read_tr16_b64_v4i16((LAS s16x4*)(p + rowstride4));
    return (bf16x8){a0[0], a0[1], a0[2], a0[3], a1[0], a1[1], a1[2], a1[3]};
}
__device__ __forceinline__ void dil_attn_mfma_item(const Ctx& c, int item) {
    const int bh = item / 48, rem = item % 48, b = bh >> 2, hh = bh & 3, g = rem >> 4, idx16 = rem & 15;
    const int dil = 1 << (2 * g), nub = 16 >> (2 * g), rho = idx16 / nub, ub = idx16 % nub;
    LAS bf16* Kl = (LAS bf16*)c.lds;
    LAS bf16* Vl = Kl + 384 * 72;
    const int tid = c.tid, lane = c.lane, wave = c.wave, r = lane & 31, hl = lane >> 5;
    const int ubase = ub * 256 - 128;
    const bf16* hb = C_HB + (size_t)b * SEQ * LDH + g * 256 + hh * 64;
    u32x4 kwv[6], vwv[6];
#pragma unroll
    for (int pass = 0; pass < 6; ++pass) { const int kl = pass * 64 + (tid >> 3), part = tid & 7; int up = ubase + kl; up = up < 0 ? 0 : up;
        const bf16* src = hb + (size_t)(rho + dil * up) * LDH + 8 * part;
        kwv[pass] = *(const u32x4*)(src + EC_KB); vwv[pass] = *(const u32x4*)(src + EC_VB); }
    const int u0 = ub * 256 + 32 * wave;
    bf16x8 Qf[4];
    { const bf16* qp = hb + (size_t)(rho + dil * (u0 + r)) * LDH + EC_QB + 8 * hl;
#pragma unroll
        for (int ks = 0; ks < 4; ++ks) Qf[ks] = *(const bf16x8*)(qp + 16 * ks); }
#pragma unroll
    for (int pass = 0; pass < 6; ++pass) { const int kl = pass * 64 + (tid >> 3), part = tid & 7; *(LAS u32x4*)(Kl + kl * 72 + 8 * part) = kwv[pass]; *(LAS u32x4*)(Vl + kl * 72 + 8 * part) = vwv[pass]; }
    __syncthreads();
    f32x16 S[5];
#pragma unroll
    for (int kt = 0; kt < 5; ++kt) {
#pragma unroll
        for (int i = 0; i < 16; ++i) S[kt][i] = 0.f;
        const LAS bf16* kp = Kl + (32 * wave + 32 * kt + r) * 72 + 8 * hl;
#pragma unroll
        for (int ks = 0; ks < 4; ++ks) S[kt] = mfma32(*(const LAS bf16x8*)(kp + 16 * ks), Qf[ks], S[kt]);
    }
    float mx = -1e30f;
#pragma unroll
    for (int kt = 0; kt < 5; ++kt)
#pragma unroll
        for (int i = 0; i < 16; ++i) { const int kl = 32 * kt + (i & 3) + 8 * (i >> 2) + 4 * hl;
            const bool valid = (kl >= r) && (kl - 128 <= r) && (u0 - 128 + kl >= 0);
            const float sv = valid ? S[kt][i] : -1e30f; S[kt][i] = sv; mx = fmaxf(mx, sv); }
    mx = fmaxf(mx, __shfl_xor(mx, 32));
    const float cs = 0.125f * 1.4426950408889634f;
    float lsum = 0.f;
#pragma unroll
    for (int kt = 0; kt < 5; ++kt)
#pragma unroll
        for (int i = 0; i < 16; ++i) { const float p = __builtin_amdgcn_exp2f((S[kt][i] - mx) * cs); S[kt][i] = p; lsum += p; }
    lsum += __shfl_xor(lsum, 32);
    f32x16 O[2];
#pragma unroll
    for (int dt = 0; dt < 2; ++dt)
#pragma unroll
        for (int i = 0; i < 16; ++i) O[dt][i] = 0.f;
    const LAS bf16* vbase = Vl + (32 * wave + 4 * hl + ((lane & 15) >> 2)) * 72 + 16 * ((lane >> 4) & 1) + 4 * (lane & 3);
#pragma unroll
    for (int kt = 0; kt < 5; ++kt)
#pragma unroll
        for (int s2 = 0; s2 < 2; ++s2) {
            const u32x4 pw = (u32x4){pk2(S[kt][8 * s2 + 0], S[kt][8 * s2 + 1]), pk2(S[kt][8 * s2 + 2], S[kt][8 * s2 + 3]), pk2(S[kt][8 * s2 + 4], S[kt][8 * s2 + 5]), pk2(S[kt][8 * s2 + 6], S[kt][8 * s2 + 7])};
            const bf16x8 Pf = __builtin_bit_cast(bf16x8, pw);
#pragma unroll
            for (int dt = 0; dt < 2; ++dt) { const LAS bf16* vp = vbase + (32 * kt + 16 * s2) * 72 + 32 * dt;
                const s16x4 a0 = __builtin_amdgcn_ds_read_tr16_b64_v4i16((LAS s16x4*)vp), a1 = __builtin_amdgcn_ds_read_tr16_b64_v4i16((LAS s16x4*)(vp + 8 * 72));
                const bf16x8 Af = (bf16x8){a0[0], a0[1], a0[2], a0[3], a1[0], a1[1], a1[2], a1[3]};
                O[dt] = mfma32(Af, Pf, O[dt]); }
        }
    const float inv = 1.0f / lsum; const size_t R = (size_t)b * SEQ + rho + dil * (u0 + r);
    float* og = C_OG + ((size_t)g * TT + R) * 256 + hh * 64 + 4 * hl;
#pragma unroll
    for (int dt = 0; dt < 2; ++dt)
#pragma unroll
        for (int g4 = 0; g4 < 4; ++g4) *(f32x4*)(og + 32 * dt + 8 * g4) = (f32x4){O[dt][4 * g4 + 0] * inv, O[dt][4 * g4 + 1] * inv, O[dt][4 * g4 + 2] * inv, O[dt][4 * g4 + 3] * inv};
    if (hl == 0) C_LSE[((size_t)g * TT + R) * 4 + hh] = mx * 0.125f + __logf(lsum);
    __syncthreads();
}
__device__ __forceinline__ void dil_attn_sample_item(const Ctx& c, int sr, int hh, int e) {
    const int lane = c.lane, kg = lane >> 4, dl = lane & 15, R = TP + sr, n = sr >> 2, t = sr & 3;
    float m = -1e30f, l = 0.f, acc[4] = {0.f, 0.f, 0.f, 0.f};
#pragma unroll
    for (int g = 0; g < 3; ++g) {
        const int dil = (g == 0) ? 1 : (g == 1 ? 4 : 16), W = 128 * dil, jn = t / dil;
        float q[4]; unpk4(*(const u32x2*)(C_HB + (size_t)R * LDH + EC_QB + g * 256 + hh * 64 + 4 * dl), q);
#pragma unroll
        for (int i = 0; i < 4; ++i) q[i] *= 0.125f;
        { const int j = kg; const bool valid = j <= jn; const int tt = valid ? t - dil * j : t;
            const bf16* kp = C_HB + (size_t)(TP + n * 4 + tt) * LDH + g * 256 + hh * 64 + 4 * dl; float kf[4], vf[4]; unpk4(*(const u32x2*)(kp + EC_KB), kf); unpk4(*(const u32x2*)(kp + EC_VB), vf);
            float s = red16(q[0] * kf[0] + q[1] * kf[1] + q[2] * kf[2] + q[3] * kf[3]);
            if (valid) { const float mn = fmaxf(m, s), sc = __expf(m - mn), p = __expf(s - mn); l = l * sc + p;
#pragma unroll
                for (int i = 0; i < 4; ++i) acc[i] = acc[i] * sc + p * vf[i];
                m = mn; } }
        const float* cache = ((g == 0) ? C_IN(4) : (g == 1 ? C_IN(5) : C_IN(6))) + ((size_t)(e * 8 + n) * W) * 512 + hh * 64 + 4 * dl;
#pragma unroll 11
        for (int j0 = 0; j0 < 132; j0 += 4) { const int j = j0 + kg; const bool valid = (j > jn) && (j <= 128); const int idx = valid ? W + t - dil * j : 0;
            const float* kp = cache + (size_t)idx * 512; const f32x4 k4 = *(const f32x4*)kp, v4 = *(const f32x4*)(kp + 256);
            const float s = red16(q[0] * k4.x + q[1] * k4.y + q[2] * k4.z + q[3] * k4.w);
            if (valid) { const float mn = fmaxf(m, s), sc = __expf(m - mn), p = __expf(s - mn); l = l * sc + p;
                acc[0] = acc[0] * sc + p * v4.x; acc[1] = acc[1] * sc + p * v4.y; acc[2] = acc[2] * sc + p * v4.z; acc[3] = acc[3] * sc + p * v4.w; m = mn; } }
    }
#pragma unroll
    for (int off = 16; off <= 32; off <<= 1) {
        const float m2 = __shfl_xor(m, off), l2 = __shfl_xor(l, off); float a2[4];
#pragma unroll
        for (int i = 0; i < 4; ++i) a2[i] = __shfl_xor(acc[i], off);
        const float mn = fmaxf(m, m2), s1 = __expf(m - mn), s2 = __expf(m2 - mn);
        l = l * s1 + l2 * s2;
#pragma unroll
        for (int i = 0; i < 4; ++i) acc[i] = acc[i] * s1 + a2[i] * s2;
        m = mn;
    }
    if (kg == 0) { float gt[4]; unpk4(*(const u32x2*)(C_HB + (size_t)R * LDH + EC_GB + hh * 64 + 4 * dl), gt);
        const float inv = 1.0f / l; float o[4];
#pragma unroll
        for (int i = 0; i < 4; ++i) o[i] = acc[i] * inv * siluf_(gt[i]);
        *(u32x2*)(C_U + (size_t)R * EVEN_OUT + 768 + hh * 64 + 4 * dl) = (u32x2){pk2(o[0], o[1]), pk2(o[2], o[3])}; }
}


__device__ __forceinline__ void mem_attn_sample_block(const Ctx& c, int item, int l, int qcol, int gcol, int ucol, int ldu) {
    const int sr = item >> 2, mh = item & 3, R = TP + sr, lane = c.lane, kg = lane >> 5, dl = lane & 31, wave = c.wave;
    const float* mkv = C_IN(8) + ((size_t)l * 8 + (sr >> 2)) * 256 * 1024 + mh * 128 + 4 * dl;
    float q[4]; unpk4(*(const u32x2*)(C_HB + (size_t)R * LDH + qcol + mh * 128 + 4 * dl), q);
#pragma unroll
    for (int i = 0; i < 4; ++i) q[i] *= 0.08838834764831845f;
    float m = -1e30f, lsum = 0.f, acc[4] = {0.f, 0.f, 0.f, 0.f};
    f32x4 kv[16], vv[16];
#pragma unroll
    for (int jr = 0; jr < 16; ++jr) { const float* kp = mkv + (size_t)(32 * wave + 2 * jr + kg) * 1024; kv[jr] = *(const f32x4*)kp; vv[jr] = *(const f32x4*)(kp + 512); }
#pragma unroll
    for (int jr = 0; jr < 16; ++jr) { const f32x4 k4 = kv[jr], v4 = vv[jr];
        float s = q[0] * k4.x + q[1] * k4.y + q[2] * k4.z + q[3] * k4.w;
        s = red16(s); s += __shfl_xor(s, 16);
        const float mn = fmaxf(m, s), sc = __expf(m - mn), p = __expf(s - mn);
        lsum = lsum * sc + p; acc[0] = acc[0] * sc + p * v4.x; acc[1] = acc[1] * sc + p * v4.y; acc[2] = acc[2] * sc + p * v4.z; acc[3] = acc[3] * sc + p * v4.w; m = mn; }
    { const float m2 = __shfl_xor(m, 32), l2 = __shfl_xor(lsum, 32); float a2[4];
#pragma unroll
        for (int i = 0; i < 4; ++i) a2[i] = __shfl_xor(acc[i], 32);
        const float mn = fmaxf(m, m2), s1 = __expf(m - mn), s2 = __expf(m2 - mn);
        lsum = lsum * s1 + l2 * s2; m = mn;
#pragma unroll
        for (int i = 0; i < 4; ++i) acc[i] = acc[i] * s1 + a2[i] * s2; }
    LAS float* part = (LAS float*)c.lds;
    if (kg == 0) { LAS float* pp = part + (wave * 32 + dl) * 6; pp[0] = m; pp[1] = lsum; pp[2] = acc[0]; pp[3] = acc[1]; pp[4] = acc[2]; pp[5] = acc[3]; }
    __syncthreads();
    if (wave == 0 && kg == 0) {
        float M = -1e30f, Lr = 0.f, A[4] = {0.f, 0.f, 0.f, 0.f};
#pragma unroll
        for (int w = 0; w < 8; ++w) { const LAS float* pp = part + (w * 32 + dl) * 6; const float m2 = pp[0], mn = fmaxf(M, m2), s1 = __expf(M - mn), s2 = __expf(m2 - mn);
            Lr = Lr * s1 + pp[1] * s2; A[0] = A[0] * s1 + pp[2] * s2; A[1] = A[1] * s1 + pp[3] * s2; A[2] = A[2] * s1 + pp[4] * s2; A[3] = A[3] * s1 + pp[5] * s2; M = mn; }
        float gt[4]; unpk4(*(const u32x2*)(C_HB + (size_t)R * LDH + gcol + mh * 128 + 4 * dl), gt);
        const float inv = 1.0f / Lr;
        *(u32x2*)(C_U + (size_t)R * ldu + ucol + mh * 128 + 4 * dl) = (u32x2){pk2(A[0] * inv * siluf_(gt[0]), A[1] * inv * siluf_(gt[1])), pk2(A[2] * inv * siluf_(gt[2]), A[3] * inv * siluf_(gt[3]))}; }
    __syncthreads();
}
__device__ __forceinline__ void dil_attn_sample_block(const Ctx& c, int item, int e) {
    const int sr = item >> 2, hh = item & 3, lane = c.lane, kg = lane >> 4, dl = lane & 15, wave = c.wave, R = TP + sr, n = sr >> 2, t = sr & 3;
    float m = -1e30f, l = 0.f, acc[4] = {0.f, 0.f, 0.f, 0.f};
#pragma unroll
    for (int g = 0; g < 3; ++g) {
        const int dil = (g == 0) ? 1 : (g == 1 ? 4 : 16), W = 128 * dil, jn = t / dil;
        float q[4]; unpk4(*(const u32x2*)(C_HB + (size_t)R * LDH + EC_QB + g * 256 + hh * 64 + 4 * dl), q);
#pragma unroll
        for (int i = 0; i < 4; ++i) q[i] *= 0.125f;
        if (wave == 0) { const int j = kg; const bool valid = j <= jn; const int tt = valid ? t - dil * j : t;
            const bf16* kp = C_HB + (size_t)(TP + n * 4 + tt) * LDH + g * 256 + hh * 64 + 4 * dl; float kf[4], vf[4]; unpk4(*(const u32x2*)(kp + EC_KB), kf); unpk4(*(const u32x2*)(kp + EC_VB), vf);
            float s = red16(q[0] * kf[0] + q[1] * kf[1] + q[2] * kf[2] + q[3] * kf[3]);
            if (valid) { const float mn = fmaxf(m, s), sc = __expf(m - mn), p = __expf(s - mn); l = l * sc + p;
#pragma unroll
                for (int i = 0; i < 4; ++i) acc[i] = acc[i] * sc + p * vf[i];
                m = mn; } }
        const float* cache = ((g == 0) ? C_IN(4) : (g == 1 ? C_IN(5) : C_IN(6))) + ((size_t)(e * 8 + n) * W) * 512 + hh * 64 + 4 * dl;
        f32x4 kv[5], vv[5]; bool ok[5];
#pragma unroll
        for (int jr = 0; jr < 5; ++jr) { const int jo = 4 * jr + kg, j = 17 * wave + jo; ok[jr] = (jo < 17) && (j > jn) && (j <= 128); const int idx = ok[jr] ? W + t - dil * j : 0;
            const float* kp = cache + (size_t)idx * 512; kv[jr] = *(const f32x4*)kp; vv[jr] = *(const f32x4*)(kp + 256); }
#pragma unroll
        for (int jr = 0; jr < 5; ++jr) { const f32x4 k4 = kv[jr], v4 = vv[jr];
            const float s = red16(q[0] * k4.x + q[1] * k4.y + q[2] * k4.z + q[3] * k4.w);
            if (ok[jr]) { const float mn = fmaxf(m, s), sc = __expf(m - mn), p = __expf(s - mn); l = l * sc + p;
                acc[0] = acc[0] * sc + p * v4.x; acc[1] = acc[1] * sc + p * v4.y; acc[2] = acc[2] * sc + p * v4.z; acc[3] = acc[3] * sc + p * v4.w; m = mn; } }
    }
#pragma unroll
    for (int off = 16; off <= 32; off <<= 1) {
        const float m2 = __shfl_xor(m, off), l2 = __shfl_xor(l, off); float a2[4];
#pragma unroll
        for (int i = 0; i < 4; ++i) a2[i] = __shfl_xor(acc[i], off);
        const float mn = fmaxf(m, m2), s1 = __expf(m - mn), s2 = __expf(m2 - mn);
        l = l * s1 + l2 * s2;
#pragma unroll
        for (int i = 0; i < 4; ++i) acc[i] = acc[i] * s1 + a2[i] * s2;
        m = mn;
    }
    LAS float* part = (LAS float*)c.lds;
    if (kg == 0) { LAS float* pp = part + (wave * 16 + dl) * 6; pp[0] = m; pp[1] = l; pp[2] = acc[0]; pp[3] = acc[1]; pp[4] = acc[2]; pp[5] = acc[3]; }
    __syncthreads();
    if (wave == 0 && kg == 0) {
        float M = -1e30f, Lr = 0.f, A[4] = {0.f, 0.f, 0.f, 0.f};
#pragma unroll
        for (int w = 0; w < 8; ++w) { const LAS float* pp = part + (w * 16 + dl) * 6; const float m2 = pp[0], mn = fmaxf(M, m2), s1 = __expf(M - mn), s2 = __expf(m2 - mn);
            Lr = Lr * s1 + pp[1] * s2; A[0] = A[0] * s1 + pp[2] * s2; A[1] = A[1] * s1 + pp[3] * s2; A[2] = A[2] * s1 + pp[4] * s2; A[3] = A[3] * s1 + pp[5] * s2; M = mn; }
        float gt[4]; unpk4(*(const u32x2*)(C_HB + (size_t)R * LDH + EC_GB + hh * 64 + 4 * dl), gt);
        const float inv = 1.0f / Lr;
        *(u32x2*)(C_U + (size_t)R * EVEN_OUT + 768 + hh * 64 + 4 * dl) = (u32x2){pk2(A[0] * inv * siluf_(gt[0]), A[1] * inv * siluf_(gt[1])), pk2(A[2] * inv * siluf_(gt[2]), A[3] * inv * siluf_(gt[3]))}; }
    __syncthreads();
}

__device__ __forceinline__ void even_copies(const Ctx& c, int e) {
    const int gt = c.bid * 512 + c.tid, NT = c.G * 512;
    for (int i = gt; i < 10 * 304; i += NT) { const int rw = i / 304, c8 = 8 * (i % 304);
        const size_t src = (rw < 2) ? (size_t)(rw * SEQ + SEQ - 1) : (size_t)(TP + (rw - 2) * 4 + 3);
        float x[8]; unpk8(*(const u32x4*)(C_HB + src * LDH + c8), x);
        float* dst = (rw < 2) ? C_OUT + O_SH_P + ((size_t)e * 2 + rw) * 2432 + c8 : C_OUT + O_SH_S + ((size_t)e * 8 + (rw - 2)) * 2432 + c8;
        *(f32x4*)dst = (f32x4){x[0], x[1], x[2], x[3]}; *(f32x4*)(dst + 4) = (f32x4){x[4], x[5], x[6], x[7]}; }
#pragma unroll 1
    for (int g = 0; g < 3; ++g) {
        const int keep = 128 << (2 * g); const size_t op = (g == 0) ? O_G0P : (g == 1 ? O_G1P : O_G2P), os = (g == 0) ? O_G0S : (g == 1 ? O_G1S : O_G2S);
        for (int i = gt; i < 2 * keep * 64; i += NT) { const int pc = i & 63, r = (i >> 6) % keep, b = (i >> 6) / keep;
            const int col = ((pc & 32) ? EC_VB : EC_KB) + g * 256 + 8 * (pc & 31);
            float x[8]; unpk8(*(const u32x4*)(C_HB + (size_t)(b * SEQ + SEQ - keep + r) * LDH + col), x);
            float* dst = C_OUT + op + ((size_t)e * 2 * keep + (size_t)b * keep + r) * 512 + 8 * pc;
            *(f32x4*)dst = (f32x4){x[0], x[1], x[2], x[3]}; *(f32x4*)(dst + 4) = (f32x4){x[4], x[5], x[6], x[7]}; }
        for (int i = gt; i < 8 * 4 * 64; i += NT) { const int pc = i & 63, row = i >> 6;
            const int col = ((pc & 32) ? EC_VB : EC_KB) + g * 256 + 8 * (pc & 31);
            float x[8]; unpk8(*(const u32x4*)(C_HB + (size_t)(TP + row) * LDH + col), x);
            float* dst = C_OUT + os + ((size_t)e * 32 + row) * 512 + 8 * pc;
            *(f32x4*)dst = (f32x4){x[0], x[1], x[2], x[3]}; *(f32x4*)(dst + 4) = (f32x4){x[4], x[5], x[6], x[7]}; }
    }
}

#define LAUNDER_C(c) do { asm volatile("" : "+s"((c).ap), "+v"((c).tid), "+s"((c).bid), "+s"((c).G)); (c).lane = (c).tid & 63; (c).wave = __builtin_amdgcn_readfirstlane((c).tid >> 6); } while (0)
__device__ __forceinline__ void phase_even_tok_pre(Ctx c, int l);
__device__ __forceinline__ void even_helper_work(Ctx c, int l) {
    const int e = l >> 1;
    for (int rp = 0; rp < REPD; ++rp) { for (int it = c.bid; it < 384; it += c.G) dil_attn_mfma_item(c, it);
    LAUNDER_C(c); }
    for (int it = c.G - 1 - c.bid; it < TS * 4; it += c.G) dil_attn_sample_block(c, it, e);
    LAUNDER_C(c);
    for (int rp = 0; rp < REPM; ++rp) { mem_attn_all(c, l, EC_QM, EC_GM, 1024, EVEN_OUT);
    LAUNDER_C(c); }
    even_copies(c, e);
    LAUNDER_C(c);
    for (int rp = 0; rp < REPC; ++rp) { if (l < 3) convert_layer_weights(c, l + 1); LAUNDER_C(c); }
}

__device__ __forceinline__ void rwkv_scan_item(const Ctx& c, int item, int e) {
    constexpr int CH = 32;
    LAS float* buf = (LAS float*)c.lds;
    LAS float* ybuf = buf + 2 * CH * 384;
    const bool is_p = item < 48; const int st = is_p ? (item >> 1) : ((item - 48) >> 1), half = item & 1;
    const int h = st % 12, bn = st / 12; const int T = is_p ? SEQ : 4; const size_t tok0 = is_p ? (size_t)bn * SEQ : (size_t)(TP + bn * 4);
    const int lane = c.lane, rw = lane >> 4, cgp = lane & 15, il = 4 * c.wave + rw, i = 32 * half + il;
    float s[4];
    if (is_p) { s[0] = s[1] = s[2] = s[3] = 0.f; }
    else { const f32x4 v = *(const f32x4*)(C_IN(2) + ((((size_t)e * 8 + bn) * 12 + h) * 64 + i) * 64 + 4 * cgp); s[0] = v.x; s[1] = v.y; s[2] = v.z; s[3] = v.w; }
    const int nch = (T + CH - 1) / CH;
    f32x4 pre[6];
#define SCAN_GLOAD(ch_) do { _Pragma("unroll") for (int k = 0; k < 6; ++k) { const int idx = c.tid + 512 * k, tl_ = idx / 96, f4 = idx % 96; const int tk = (ch_) * CH + tl_; \
            pre[k] = (tk < T) ? *(const f32x4*)(C_PREPS + ((tok0 - TP + tk) * 12 + h) * 384 + 4 * f4) : (f32x4){0.f, 0.f, 0.f, 0.f}; } } while (0)
#define SCAN_LSTORE(bi_) do { _Pragma("unroll") for (int k = 0; k < 6; ++k) { const int idx = c.tid + 512 * k; *(LAS f32x4*)(buf + (bi_) * CH * 384 + 4 * idx) = pre[k]; } } while (0)
    SCAN_GLOAD(0); SCAN_LSTORE(0); __syncthreads();
#pragma unroll 1
    for (int ch = 0; ch < nch; ++ch) {
        if (ch + 1 < nch) SCAN_GLOAD(ch + 1);
        const LAS float* bb = buf + (ch & 1) * CH * 384;
        const int nt = (T - ch * CH) < CH ? (T - ch * CH) : CH;
#pragma unroll 2
        for (int tl = 0; tl < nt; ++tl) {
            const LAS float* p = bb + tl * 384;
            const f32x4 r4 = *(const LAS f32x4*)(p + 4 * cgp), d4 = *(const LAS f32x4*)(p + 64 + 4 * cgp), k4 = *(const LAS f32x4*)(p + 128 + 4 * cgp),
                        kk4 = *(const LAS f32x4*)(p + 256 + 4 * cgp), b4 = *(const LAS f32x4*)(p + 320 + 4 * cgp);
            const float vi = p[192 + i];
            float sa = s[0] * kk4.x + s[1] * kk4.y + s[2] * kk4.z + s[3] * kk4.w;
            sa = red16(sa);
            s[0] = s[0] * d4.x + (sa * b4.x + vi * k4.x); s[1] = s[1] * d4.y + (sa * b4.y + vi * k4.y);
            s[2] = s[2] * d4.z + (sa * b4.z + vi * k4.z); s[3] = s[3] * d4.w + (sa * b4.w + vi * k4.w);
            float y = s[0] * r4.x + s[1] * r4.y + s[2] * r4.z + s[3] * r4.w;
            y = red16(y);
            if (cgp == 0) ybuf[tl * 32 + il] = y;
        }
        __syncthreads();
        if (ch + 1 < nch) SCAN_LSTORE((ch + 1) & 1);
        for (int idx = c.tid; idx < nt * 32; idx += 512) { const int tl = idx >> 5, r = idx & 31; C_YA[(tok0 + ch * CH + tl) * 768 + h * 64 + 32 * half + r] = ybuf[idx]; }
        __syncthreads();
    }
    float* so = C_OUT + (is_p ? O_RWKV_P + (((size_t)e * 2 + bn) * 12 + h) * 4096 : O_RWKV_S + (((size_t)e * 8 + bn) * 12 + h) * 4096) + (size_t)i * 64 + 4 * cgp;
    *(f32x4*)so = (f32x4){s[0], s[1], s[2], s[3]};
}

typedef float f32x2 __attribute__((ext_vector_type(2)));
__device__ __forceinline__ void rwkv_scan_prompt(const Ctx& c, int item, int e) {
    constexpr int CH = 32, NCH = SEQ / CH;
    LAS float* buf = (LAS float*)c.lds;
    LAS float* ybuf = buf + 2 * CH * 384;
    const int st = item >> 1, half = item & 1, h = st % 12, bn = st / 12; const size_t tok0 = (size_t)bn * SEQ;
    const int lane = c.lane, rw = lane >> 4, cgp = lane & 15, il = 4 * c.wave + rw, i = 32 * half + il;
    f32x2 s01 = (f32x2){0.f, 0.f}, s23 = (f32x2){0.f, 0.f};
    const float* src = C_PREP + (tok0 * 12 + h) * 384;
    float* ya = C_YA + tok0 * 768 + h * 64 + 32 * half;
    f32x4 pre[6];
#define SP_GLOAD(ch_) do { _Pragma("unroll") for (int k = 0; k < 6; ++k) { const int idx = c.tid + 512 * k, tl_ = idx / 96, f4 = idx % 96; \
        pre[k] = *(const f32x4*)(src + (size_t)((ch_) * CH + tl_) * (12 * 384) + 4 * f4); } } while (0)
#define SP_LSTORE(bi_) do { _Pragma("unroll") for (int k = 0; k < 6; ++k) { const int idx = c.tid + 512 * k; *(LAS f32x4*)(buf + (bi_) * CH * 384 + 4 * idx) = pre[k]; } } while (0)
#define SP_YOUT(ch_) do { for (int idx = c.tid; idx < CH * 32; idx += 512) { const int tl_ = idx >> 5, r_ = idx & 31; ya[(size_t)((ch_) * CH + tl_) * 768 + r_] = ybuf[((ch_) & 1) * CH * 32 + idx]; } } while (0)
    SP_GLOAD(0); SP_LSTORE(0); SP_GLOAD(1); __syncthreads();
#pragma unroll 1
    for (int ch = 0; ch < NCH; ++ch) {
        if (ch + 1 < NCH) SP_LSTORE((ch + 1) & 1);
        if (ch + 2 < NCH) SP_GLOAD(ch + 2);
        if (ch > 0) SP_YOUT(ch - 1);
        const LAS float* bb = buf + (ch & 1) * CH * 384 + 4 * cgp; const LAS float* vb = buf + (ch & 1) * CH * 384 + 192 + i;
        LAS float* yw = (cgp == 0) ? (ybuf + (ch & 1) * CH * 32 + il) : (ybuf + 2 * CH * 32 + lane);
        f32x4 r4 = *(const LAS f32x4*)bb, d4 = *(const LAS f32x4*)(bb + 64), k4 = *(const LAS f32x4*)(bb + 128), n4 = *(const LAS f32x4*)(bb + 256), b4 = *(const LAS f32x4*)(bb + 320); float vi = vb[0];
        float sa;
        { f32x2 p = s01 * (f32x2){n4.x, n4.y}; p = s23 * (f32x2){n4.z, n4.w} + p; sa = red16(p.x + p.y); }
#pragma unroll 4
        for (int tl = 0; tl < CH; ++tl) {
            const int tn = (tl + 1 < CH) ? tl + 1 : tl;
            const f32x4 r4n = *(const LAS f32x4*)(bb + tn * 384), d4n = *(const LAS f32x4*)(bb + tn * 384 + 64), k4n = *(const LAS f32x4*)(bb + tn * 384 + 128),
                        n4n = *(const LAS f32x4*)(bb + tn * 384 + 256), b4n = *(const LAS f32x4*)(bb + tn * 384 + 320); const float vin = vb[tn * 384];
            const f32x2 vi2 = (f32x2){vi, vi}, sa2 = (f32x2){sa, sa};
            const f32x2 u01 = s01 * (f32x2){d4.x, d4.y} + vi2 * (f32x2){k4.x, k4.y}, u23 = s23 * (f32x2){d4.z, d4.w} + vi2 * (f32x2){k4.z, k4.w};
            s01 = sa2 * (f32x2){b4.x, b4.y} + u01; s23 = sa2 * (f32x2){b4.z, b4.w} + u23;
            f32x2 yp = s01 * (f32x2){r4.x, r4.y}; yp = s23 * (f32x2){r4.z, r4.w} + yp;
            f32x2 pn = s01 * (f32x2){n4n.x, n4n.y}; pn = s23 * (f32x2){n4n.z, n4n.w} + pn;
            float ya_ = yp.x + yp.y, sb_ = pn.x + pn.y;
            sb_ += dppf<0xB1>(sb_); ya_ += dppf<0xB1>(ya_); sb_ += dppf<0x4E>(sb_); ya_ += dppf<0x4E>(ya_);
            sb_ += dppf<0x141>(sb_); ya_ += dppf<0x141>(ya_); sb_ += dppf<0x140>(sb_); ya_ += dppf<0x140>(ya_);
            sa = sb_;
            yw[tl * 32] = ya_;
            r4 = r4n; d4 = d4n; k4 = k4n; n4 = n4n; b4 = b4n; vi = vin;
        }
        __syncthreads();
    }
    SP_YOUT(NCH - 1);
    float* so = C_OUT + O_RWKV_P + (((size_t)e * 2 + bn) * 12 + h) * 4096 + (size_t)i * 64 + 4 * cgp;
    *(f32x4*)so = (f32x4){s01.x, s01.y, s23.x, s23.y};
    __syncthreads();
#undef SP_GLOAD
#undef SP_LSTORE
#undef SP_YOUT
}

struct PreIn { u32x2 cr, ck, cv, pr, pk, pv; float hcur[8], hprv[8]; };
__device__ __forceinline__ void rwkv_chunk_preload(const Ctx& c, int item, int e, PreIn& P) {
    const bool is_s = item >= 3072; const int sidx = item - 3072;
    const int bh = item >> 7, n = is_s ? 1 : (item & 127), b = bh / 12, h = is_s ? (sidx % 12) : (bh % 12), ns = sidx / 12;
    const size_t R0 = is_s ? (size_t)(TP + 4 * ns) : (size_t)b * SEQ + 32 * n;
    const float* shift = C_IN(3) + ((size_t)e * 8 + ns) * 2432;
    const int tid = c.tid, t_ = tid >> 4, c4 = 4 * (tid & 15), col = h * 64 + c4;
    const bf16* hc = C_HB + (R0 + t_) * LDH + col; const bool hasprev = is_s ? (t_ != 0) : ((32 * n + t_) != 0);
    const u32x2 z2 = (u32x2){0u, 0u};
    P.cr = *(const u32x2*)(hc + EC_R); P.ck = *(const u32x2*)(hc + EC_K); P.cv = *(const u32x2*)(hc + EC_V);
    P.pr = hasprev ? *(const u32x2*)(hc - LDH + EC_R) : z2; P.pk = hasprev ? *(const u32x2*)(hc - LDH + EC_K) : z2; P.pv = hasprev ? *(const u32x2*)(hc - LDH + EC_V) : z2;
    const int cc = tid & 127, cl = EC_HW + cc, tb = tid >> 7;
#pragma unroll
    for (int k = 0; k < 8; ++k) { const int t = tb + 4 * k; P.hcur[k] = bf2f(C_HB[(R0 + t) * LDH + cl]);
        P.hprv[k] = is_s ? (t != 0 ? bf2f(C_HB[(R0 + t - 1) * LDH + cl]) : shift[cl]) : (((32 * n + t) != 0) ? bf2f(C_HB[(R0 + t - 1) * LDH + cl]) : 0.f); }
}
__device__ __forceinline__ void rwkv_chunk_precompute(const Ctx& c, int item, int e, const PreIn& P) {
    const bool is_s = item >= 3072; const int sidx = item - 3072;
    const int bh = item >> 7, n = is_s ? 1 : (item & 127), b = bh / 12, h = is_s ? (sidx % 12) : (bh % 12), ns = sidx / 12, ntok = is_s ? 4 : 32;
    const size_t R0 = is_s ? (size_t)(TP + 4 * ns) : (size_t)b * SEQ + 32 * n;
    const float* shift = C_IN(3) + ((size_t)e * 8 + ns) * 2432;
    LAS unsigned char* L = c.lds;
    LAS float* XW = (LAS float*)(L + 0); LAS float* XA = (LAS float*)(L + 8192);
    LAS bf16* LW = (LAS bf16*)(L + 16384); LAS bf16* LA = (LAS bf16*)(L + 20992);
    LAS float* PS = (LAS float*)(L + 25600);
    LAS bf16* KKt = (LAS bf16*)(L + 33792); LAS bf16* Bt = (LAS bf16*)(L + 38400); LAS bf16* Kt = (LAS bf16*)(L + 43008); LAS bf16* Rt = (LAS bf16*)(L + 47616);
    LAS bf16* Bh = (LAS bf16*)(L + 52224); LAS bf16* Kh = (LAS bf16*)(L + 56832); LAS bf16* Vb = (LAS bf16*)(L + 61440);
    LAS float* LB = (LAS float*)(L + 66048);
    LAS bf16* Lk = (LAS bf16*)(L + 70144); LAS bf16* Mb = (LAS bf16*)(L + 72704); LAS bf16* Mk = (LAS bf16*)(L + 75264);
    LAS float* SOL = (LAS float*)(L + 77824);
    LAS bf16* KTb = (LAS bf16*)(L + 94208); LAS bf16* UVb = (LAS bf16*)(L + 98816);
    LAS float* RTf = (LAS float*)(L + 103424); LAS float* c31 = (LAS float*)(L + 111616);
    const int tid = c.tid, lane = c.lane, wave = c.wave, fr = lane & 15, fq = lane >> 4, trow = (lane & 15) >> 2, tcol = 4 * (lane & 3);
    const int t_ = tid >> 4, c4 = 4 * (tid & 15), col = h * 64 + c4;
    const float* mu = C_IN(17) + e * 2432;
    const bf16* hc = C_HB + (R0 + t_) * LDH + col; const bool hasprev = is_s ? (t_ != 0) : ((32 * n + t_) != 0);
    const u32x2 cr = P.cr, ck = P.ck, cv = P.cv, pr = P.pr, pk = P.pk, pv = P.pv;
    f32x4 sh_r = (f32x4){0.f, 0.f, 0.f, 0.f}, sh_k = sh_r, sh_v = sh_r;
    if (is_s && t_ == 0) { sh_r = *(const f32x4*)(shift + EC_R + col); sh_k = *(const f32x4*)(shift + EC_K + col); sh_v = *(const f32x4*)(shift + EC_V + col); }
    { const int cc = tid & 127, cl = EC_HW + cc, tb = tid >> 7; const float muc = mu[cl];
#pragma unroll
        for (int k = 0; k < 8; ++k) { const int t = tb + 4 * k; const float hs = P.hcur[k] + (P.hprv[k] - P.hcur[k]) * muc;
            if (cc < 64) LW[t * 72 + cc] = (bf16)f2bf(1.0f - 2.0f / (1.0f + __expf(2.0f * hs))); else LA[t * 72 + cc - 64] = (bf16)f2bf(hs); } }
    __syncthreads();
    { const int p = wave >> 2, tt = (wave >> 1) & 1; const LAS bf16* As = p ? LA : LW; const bf16* WT = (p ? C_AUT : C_WUT) + ((size_t)e * 768 + h * 64) * 64; LAS float* X = p ? XA : XW;
#pragma unroll
        for (int cc = 0; cc < 2; ++cc) { const int ct = 2 * (wave & 1) + cc; f32x4 acc = (f32x4){0.f, 0.f, 0.f, 0.f};
#pragma unroll
            for (int ks = 0; ks < 2; ++ks) acc = mfma16(*(const LAS bf16x8*)(As + (16 * tt + fr) * 72 + 32 * ks + 8 * fq), *(const bf16x8*)(WT + (size_t)(16 * ct + fr) * 64 + 32 * ks + 8 * fq), acc);
#pragma unroll
            for (int r = 0; r < 4; ++r) X[(16 * tt + 4 * fq + r) * 64 + 16 * ct + fr] = acc[r]; } }
    __syncthreads();
    float rr[4], k2[4], vv[4], kkv[4], bb[4];
    for (int rep3 = 0; rep3 < REP3; ++rep3) { asm volatile("" ::: "memory");
    { const f32x4 xw4 = *(const LAS f32x4*)(XW + t_ * 64 + c4), xa4 = *(const LAS f32x4*)(XA + t_ * 64 + c4);
        const f32x4 w04 = *(const f32x4*)(C_IN(18) + e * 768 + col), a04 = *(const f32x4*)(C_IN(20) + e * 768 + col), kk4 = *(const f32x4*)(C_IN(22) + e * 768 + col), ka4 = *(const f32x4*)(C_IN(23) + e * 768 + col),
                    rk4 = *(const f32x4*)(C_IN(24) + e * 768 + col), mr4 = *(const f32x4*)(mu + EC_R + col), mk4 = *(const f32x4*)(mu + EC_K + col), mv4 = *(const f32x4*)(mu + EC_V + col);
        float crf[4], ckf[4], cvf[4], prf[4], pkf[4], pvf[4]; unpk4(cr, crf); unpk4(ck, ckf); unpk4(cv, cvf); unpk4(pr, prf); unpk4(pk, pkf); unpk4(pv, pvf);
        const bool tok_ok = t_ < ntok;
#pragma unroll
        for (int i = 0; i < 4; ++i) { prf[i] += sh_r[i]; pkf[i] += sh_k[i]; pvf[i] += sh_v[i]; }
        float wl[4], av[4], ssum = 0.f, bsum = 0.f;
#pragma unroll
        for (int i = 0; i < 4; ++i) { const float r = crf[i] + (prf[i] - crf[i]) * mr4[i], k = ckf[i] + (pkf[i] - ckf[i]) * mk4[i], v = cvf[i] + (pvf[i] - cvf[i]) * mv4[i];
            wl[i] = -0.6065306597126334f * sigmoidf_(w04[i] + xw4[i]); av[i] = sigmoidf_(a04[i] + xa4[i]);
            const float kk = tok_ok ? k * kk4[i] : 0.f; ssum += kk * kk; kkv[i] = kk; k2[i] = tok_ok ? k * (1.0f + (av[i] - 1.0f) * ka4[i]) : 0.f; rr[i] = tok_ok ? r : 0.f; vv[i] = tok_ok ? v : 0.f; bsum += rr[i] * k2[i] * rk4[i];
            if (!tok_ok) wl[i] = 0.f; }
        ssum = red16(ssum); bsum = red16(bsum); const float inv = rsqrtf(fmaxf(ssum, 1e-24f));
#pragma unroll
        for (int i = 0; i < 4; ++i) { kkv[i] *= inv; bb[i] = kkv[i] * av[i]; }
        if ((tid & 15) == 0 && tok_ok) C_BONUS[(R0 + t_) * 12 + h] = bsum;
        *(LAS f32x4*)(PS + t_ * 64 + c4) = (f32x4){wl[0], wl[1], wl[2], wl[3]}; }
    __syncthreads();
    if (tid < 64) { float run = 0.f;
#pragma unroll 8
        for (int t = 0; t < 32; ++t) { run += PS[t * 64 + tid]; PS[t * 64 + tid] = run; } }
    __syncthreads();
    { const f32x4 pt = *(const LAS f32x4*)(PS + t_ * 64 + c4), pe = *(const LAS f32x4*)(PS + 31 * 64 + c4); const f32x4 pp = (t_ > 0) ? *(const LAS f32x4*)(PS + (t_ - 1) * 64 + c4) : (f32x4){0.f, 0.f, 0.f, 0.f};
        float o_kk[4], o_b[4], o_k[4], o_r[4], o_bh[4], o_kh[4];
#pragma unroll
        for (int i = 0; i < 4; ++i) { const float ct = __expf(pt[i]), cp = __expf(pp[i]), ci = __expf(-pt[i]), chh = __expf(pe[i] - pt[i]);
            o_kk[i] = kkv[i] * cp; o_b[i] = bb[i] * ci; o_k[i] = k2[i] * ci; o_r[i] = rr[i] * ct; o_bh[i] = bb[i] * chh; o_kh[i] = k2[i] * chh; }
        *(LAS u32x2*)(KKt + t_ * 72 + c4) = (u32x2){pk2(o_kk[0], o_kk[1]), pk2(o_kk[2], o_kk[3])}; *(LAS u32x2*)(Bt + t_ * 72 + c4) = (u32x2){pk2(o_b[0], o_b[1]), pk2(o_b[2], o_b[3])};
        *(LAS u32x2*)(Kt + t_ * 72 + c4) = (u32x2){pk2(o_k[0], o_k[1]), pk2(o_k[2], o_k[3])}; *(LAS u32x2*)(Rt + t_ * 72 + c4) = (u32x2){pk2(o_r[0], o_r[1]), pk2(o_r[2], o_r[3])};
        *(LAS u32x2*)(Bh + t_ * 72 + c4) = (u32x2){pk2(o_bh[0], o_bh[1]), pk2(o_bh[2], o_bh[3])}; *(LAS u32x2*)(Kh + t_ * 72 + c4) = (u32x2){pk2(o_kh[0], o_kh[1]), pk2(o_kh[2], o_kh[3])};
        *(LAS u32x2*)(Vb + t_ * 72 + c4) = (u32x2){pk2(vv[0], vv[1]), pk2(vv[2], vv[3])};
        *(LAS f32x4*)(RTf + t_ * 64 + c4) = (f32x4){o_r[0], o_r[1], o_r[2], o_r[3]}; *(LAS f32x4*)(SOL + t_ * 128 + c4) = (f32x4){o_kk[0], o_kk[1], o_kk[2], o_kk[3]};
        if (t_ == 31) *(LAS f32x4*)(c31 + c4) = (f32x4){__expf(pt[0]), __expf(pt[1]), __expf(pt[2]), __expf(pt[3])}; }
    __syncthreads(); }
    { const int m = wave >> 1, tt = wave & 1; const LAS bf16* X = (m < 2) ? KKt : Rt; const LAS bf16* Yv = (m & 1) ? Kt : Bt;
#pragma unroll
        for (int st = 0; st < 2; ++st) { f32x4 acc = (f32x4){0.f, 0.f, 0.f, 0.f};
            if (st <= tt) {
#pragma unroll
                for (int ks = 0; ks < 2; ++ks) acc = mfma16(*(const LAS bf16x8*)(X + (16 * tt + fr) * 72 + 32 * ks + 8 * fq), *(const LAS bf16x8*)(Yv + (16 * st + fr) * 72 + 32 * ks + 8 * fq), acc); }
#pragma unroll
            for (int r = 0; r < 4; ++r) { const int t = 16 * tt + 4 * fq + r, s_ = 16 * st + fr; const bool keep = (m < 2) ? (s_ < t) : (s_ <= t); const float val = keep ? acc[r] : 0.f;
                if (m == 0) LB[t * 32 + (s_ & 3) * 8 + (s_ >> 2)] = val; else if (m == 1) Lk[t * 40 + s_] = (bf16)f2bf(val); else if (m == 2) Mb[t * 40 + s_] = (bf16)f2bf(val); else Mk[t * 40 + s_] = (bf16)f2bf(val); } } }
    __syncthreads();
    { const int tt = wave >> 2, ict = wave & 3;
        const f32x4 acc = mfma16(*(const LAS bf16x8*)(Lk + (16 * tt + fr) * 40 + 8 * fq), tr_frag(Vb + (8 * fq + trow) * 72 + 16 * ict + tcol, 4 * 72), (f32x4){0.f, 0.f, 0.f, 0.f});
#pragma unroll
        for (int r = 0; r < 4; ++r) SOL[(16 * tt + 4 * fq + r) * 128 + 64 + 16 * ict + fr] = acc[r]; }
    __syncthreads();
    { const int cidx = tid >> 2, q = tid & 3; float xq[8];
#pragma unroll
        for (int u = 0; u < 8; ++u) xq[u] = 0.f;
#pragma unroll
        for (int t = 0; t < 32; ++t) { float part = 0.f;
            if (t > 0) { const f32x4 la = *(const LAS f32x4*)(LB + t * 32 + q * 8); part = la[0] * xq[0];
                if (t > 4) part += la[1] * xq[1]; if (t > 8) part += la[2] * xq[2]; if (t > 12) part += la[3] * xq[3];
                if (t > 16) { const f32x4 lb = *(const LAS f32x4*)(LB + t * 32 + q * 8 + 4); part += lb[0] * xq[4];
                    if (t > 20) part += lb[1] * xq[5]; if (t > 24) part += lb[2] * xq[6]; if (t > 28) part += lb[3] * xq[7]; }
                part += dppf<0xB1>(part); part += dppf<0x4E>(part); }
            const float xt = SOL[t * 128 + cidx] - part;
            if (q == (t & 3)) { xq[t >> 2] = xt;
                if (cidx < 64) KTb[t * 72 + cidx] = (bf16)f2bf(xt); else UVb[t * 72 + cidx - 64] = (bf16)f2bf(-xt); } } }
    __syncthreads();
    for (int rep9 = 0; rep9 < REP9; ++rep9) { asm volatile("" ::: "memory");
    unsigned char* chk = C_CHK + (size_t)item * CHK_BYTES; bf16* Ag = (bf16*)(chk + CK_A); bf16* RQg = (bf16*)(chk + CK_RQ); float* GTg = (float*)(chk + CK_GT); float* YVTg = (float*)(chk + CK_YVT);
    const f32x4 z4 = (f32x4){0.f, 0.f, 0.f, 0.f};
    { const int jt = wave >> 1;
        const bf16x8 BhT = tr_frag(Bh + (8 * fq + trow) * 72 + 16 * jt + tcol, 4 * 72), KhT = tr_frag(Kh + (8 * fq + trow) * 72 + 16 * jt + tcol, 4 * 72);
#pragma unroll
        for (int cc = 0; cc < 2; ++cc) { const int ct = 2 * (wave & 1) + cc;
            const f32x4 aA = mfma16(BhT, tr_frag(KTb + (8 * fq + trow) * 72 + 16 * ct + tcol, 4 * 72), z4);
            f32x4 aG = mfma16(BhT, tr_frag(UVb + (8 * fq + trow) * 72 + 16 * ct + tcol, 4 * 72), z4); aG = mfma16(KhT, tr_frag(Vb + (8 * fq + trow) * 72 + 16 * ct + tcol, 4 * 72), aG);
#pragma unroll
            for (int r = 0; r < 4; ++r) { const int j = 16 * jt + 4 * fq + r, jp = 16 * ct + fr; Ag[j * 72 + jp] = (bf16)f2bf(((j == jp) ? c31[j] : 0.f) - aA[r]); }
            *(f32x4*)(GTg + (16 * ct + fr) * 68 + 16 * jt + 4 * fq) = aG; } }
    { const int tt = wave >> 2, jt2 = wave & 3; const bf16x8 MbF = *(const LAS bf16x8*)(Mb + (16 * tt + fr) * 40 + 8 * fq);
        const f32x4 a = mfma16(MbF, tr_frag(KTb + (8 * fq + trow) * 72 + 16 * jt2 + tcol, 4 * 72), z4);
#pragma unroll
        for (int r = 0; r < 4; ++r) { const int t = 16 * tt + 4 * fq + r, j = 16 * jt2 + fr; RQg[t * 72 + j] = (bf16)f2bf(RTf[t * 64 + j] - a[r]); }
        f32x4 y = mfma16(MbF, tr_frag(UVb + (8 * fq + trow) * 72 + 16 * jt2 + tcol, 4 * 72), z4);
        y = mfma16(*(const LAS bf16x8*)(Mk + (16 * tt + fr) * 40 + 8 * fq), tr_frag(Vb + (8 * fq + trow) * 72 + 16 * jt2 + tcol, 4 * 72), y);
        *(f32x4*)(YVTg + (16 * jt2 + fr) * 36 + 16 * tt + 4 * fq) = y; }
    __syncthreads(); }
}
__device__ __forceinline__ void rwkv_stream(const Ctx& c, int bh, int it, int e) {
    const int b = bh / 12, h = bh % 12, lane = c.lane, fr = lane & 15, fq = lane >> 4;
    LAS bf16* Sl = (LAS bf16*)c.lds + c.wave * (16 * 72);
    const unsigned char* chk0 = C_CHK + (size_t)bh * 128 * CHK_BYTES;
    float* ya = C_YA + ((size_t)b * SEQ) * 768 + h * 64 + 16 * it + fr;
    f32x4 S[4];
#pragma unroll
    for (int jt = 0; jt < 4; ++jt) S[jt] = (f32x4){0.f, 0.f, 0.f, 0.f};
    bf16x8 A0[4][2], R0f[2][2], A1[4][2], R1f[2][2]; f32x4 G0[4], Y0[2], G1[4], Y1[2];
#define ST_LOAD(AF, RF, GV, YV, n_) do { const unsigned char* base_ = chk0 + (size_t)(n_) * CHK_BYTES; \
        _Pragma("unroll") for (int jt = 0; jt < 4; ++jt) { _Pragma("unroll") for (int ks = 0; ks < 2; ++ks) AF[jt][ks] = *(const bf16x8*)((const bf16*)(base_ + CK_A) + (16 * jt + fr) * 72 + 32 * ks + 8 * fq); \
            GV[jt] = *(const f32x4*)((const float*)(base_ + CK_GT) + (16 * it + fr) * 68 + 16 * jt + 4 * fq); } \
        _Pragma("unroll") for (int tt = 0; tt < 2; ++tt) { _Pragma("unroll") for (int ks = 0; ks < 2; ++ks) RF[tt][ks] = *(const bf16x8*)((const bf16*)(base_ + CK_RQ) + (16 * tt + fr) * 72 + 32 * ks + 8 * fq); \
            YV[tt] = *(const f32x4*)((const float*)(base_ + CK_YVT) + (16 * it + fr) * 36 + 16 * tt + 4 * fq); } } while (0)
#define ST_STEP(AF, RF, GV, YV, n_, tmax_) do { \
        _Pragma("unroll") for (int jt = 0; jt < 4; ++jt) *(LAS u32x2*)(Sl + fr * 72 + 16 * jt + 4 * fq) = (u32x2){pk2(S[jt][0], S[jt][1]), pk2(S[jt][2], S[jt][3])}; \
        asm volatile("s_waitcnt lgkmcnt(0)" ::: "memory"); \
        const bf16x8 Sf0 = *(const LAS bf16x8*)(Sl + fr * 72 + 8 * fq), Sf1 = *(const LAS bf16x8*)(Sl + fr * 72 + 32 + 8 * fq); \
        asm volatile("s_waitcnt lgkmcnt(0)" ::: "memory"); \
        _Pragma("unroll") for (int tt = 0; tt < 2; ++tt) { f32x4 y_ = mfma16(RF[tt][0], Sf0, YV[tt]); y_ = mfma16(RF[tt][1], Sf1, y_); \
            _Pragma("unroll") for (int r = 0; r < 4; ++r) if (16 * tt + 4 * fq + r < (tmax_)) ya[(size_t)(32 * (n_) + 16 * tt + 4 * fq + r) * 768] = y_[r]; } \
        _Pragma("unroll") for (int jt = 0; jt < 4; ++jt) { f32x4 a_ = mfma16(AF[jt][0], Sf0, GV[jt]); S[jt] = mfma16(AF[jt][1], Sf1, a_); } } while (0)
    ST_LOAD(A0, R0f, G0, Y0, 0);
#pragma unroll 1
    for (int n = 0; n < 128; n += 2) {
        ST_LOAD(A1, R1f, G1, Y1, n + 1);
        ST_STEP(A0, R0f, G0, Y0, n, 32);
        if (n + 2 < 128) ST_LOAD(A0, R0f, G0, Y0, n + 2);
        ST_STEP(A1, R1f, G1, Y1, n + 1, 32);
    }
    float* so = C_OUT + O_RWKV_P + (((size_t)e * 2 + b) * 12 + h) * 4096 + (size_t)(16 * it + fr) * 64 + 4 * fq;
#pragma unroll
    for (int jt = 0; jt < 4; ++jt) *(f32x4*)(so + 16 * jt) = S[jt];
}
__device__ __forceinline__ void rwkv_stream_block(const Ctx& c, int sb, int e) {
    const int bh = sb >> 1, ih = sb & 1, b = bh / 12, h = bh % 12, tid = c.tid, lane = c.lane, wave = c.wave, fr = lane & 15, fq = lane >> 4, il = wave >> 2, jt = wave & 3, it = 2 * ih + il;
    constexpr int SLOT = 13824 + 2 * 4352 + 2 * 2304;
    LAS unsigned char* slots = c.lds;
    LAS bf16* Sl = (LAS bf16*)(c.lds + 2 * SLOT) + il * (2 * 16 * 72);
    const unsigned char* rec0 = C_CHK + (size_t)bh * 128 * CHK_BYTES;
    int soff[4];
#pragma unroll
    for (int k = 0; k < 4; ++k) { const int p = tid + 512 * k; soff[k] = (p < 864) ? 16 * p : (p < 864 + 544) ? CK_GT + ih * 8704 + 16 * (p - 864) : CK_YVT + ih * 4608 + 16 * (p - 1408); }
    const bool has3 = (tid + 1536) < SLOT / 16;
    float* ya = C_YA + ((size_t)b * SEQ + 16 * jt + 4 * fq) * 768 + h * 64 + 16 * it + fr;
    f32x4 S1 = (f32x4){0.f, 0.f, 0.f, 0.f};
    *(LAS u32x2*)(Sl + fr * 72 + 16 * jt + 4 * fq) = (u32x2){0u, 0u};
    u32x4 P0[4], P1[4], P2[4], P3[4];
#define SB_GLOAD(P, n_) do { const int nn_ = (n_) < 128 ? (n_) : 127; const unsigned char* r_ = rec0 + (size_t)nn_ * CHK_BYTES; \
        _Pragma("unroll") for (int k = 0; k < 3; ++k) P[k] = *(const u32x4*)(r_ + soff[k]); P[3] = *(const u32x4*)(r_ + (has3 ? soff[3] : soff[0])); } while (0)
#define SB_LWRITE(P, s_) do { _Pragma("unroll") for (int k = 0; k < 3; ++k) *(LAS u32x4*)(slots + (s_) * SLOT + tid * 16 + k * 8192) = P[k]; if (has3) *(LAS u32x4*)(slots + (s_) * SLOT + tid * 16 + 3 * 8192) = P[3]; } while (0)
#define SB_STEP(s_, n_) do { const LAS unsigned char* sb_ = slots + (s_) * SLOT; const LAS bf16* si_ = Sl + (s_) * (16 * 72) + fr * 72 + 8 * fq; \
        const LAS bf16* a_ = (const LAS bf16*)sb_ + (16 * jt + fr) * 72 + 8 * fq; const bf16x8 af0 = *(const LAS bf16x8*)a_, af1 = *(const LAS bf16x8*)(a_ + 32); \
        const f32x4 gv_ = *(const LAS f32x4*)((const LAS float*)(sb_ + 13824) + (16 * il + fr) * 68 + 16 * jt + 4 * fq); \
        const LAS bf16* rq_ = (const LAS bf16*)(sb_ + CK_RQ) + (16 * (jt & 1) + fr) * 72 + 8 * fq; const bf16x8 rf0 = *(const LAS bf16x8*)rq_, rf1 = *(const LAS bf16x8*)(rq_ + 32); \
        const f32x4 yv_ = *(const LAS f32x4*)((const LAS float*)(sb_ + 13824 + 8704) + (16 * il + fr) * 36 + 16 * (jt & 1) + 4 * fq); \
        const bf16x8 Sf0 = *(const LAS bf16x8*)si_, Sf1 = *(const LAS bf16x8*)(si_ + 32); \
        asm volatile("s_waitcnt lgkmcnt(0)" ::: "memory"); __builtin_amdgcn_sched_barrier(0); \
        { f32x4 t_ = mfma16(af0, Sf0, gv_); S1 = mfma16(af1, Sf1, t_); } \
        if (jt < 2) { f32x4 y_ = mfma16(rf0, Sf0, yv_); y_ = mfma16(rf1, Sf1, y_); \
            _Pragma("unroll") for (int r = 0; r < 4; ++r) ya[(size_t)(32 * (n_) + r) * 768] = y_[r]; } \
        *(LAS u32x2*)(Sl + ((s_) ^ 1) * (16 * 72) + fr * 72 + 16 * jt + 4 * fq) = (u32x2){pk2(S1[0], S1[1]), pk2(S1[2], S1[3])}; \
        } while (0)
    SB_GLOAD(P0, 0); SB_GLOAD(P1, 1); SB_GLOAD(P2, 2); SB_GLOAD(P3, 3);
    SB_LWRITE(P0, 0); __syncthreads();
#pragma unroll 1
    for (int n = 0; n < 128; n += 4) {
        SB_LWRITE(P1, 1); SB_GLOAD(P0, n + 4); SB_STEP(0, n); __syncthreads();
        SB_LWRITE(P2, 0); SB_GLOAD(P1, n + 5); SB_STEP(1, n + 1); __syncthreads();
        SB_LWRITE(P3, 1); SB_GLOAD(P2, n + 6); SB_STEP(0, n + 2); __syncthreads();
        SB_LWRITE(P0, 0); SB_GLOAD(P3, n + 7); SB_STEP(1, n + 3); __syncthreads();
    }
#undef SB_GLOAD
#undef SB_LWRITE
#undef SB_STEP
    *(f32x4*)(C_OUT + O_RWKV_P + (((size_t)e * 2 + b) * 12 + h) * 4096 + (size_t)(16 * it + fr) * 64 + 16 * jt + 4 * fq) = S1;
}
__device__ __forceinline__ void rwkv_stream_sample(const Ctx& c, int sidx, int it, int e) {
    const int ns = sidx / 12, h = sidx % 12, lane = c.lane, fr = lane & 15, fq = lane >> 4;
    LAS bf16* Sl = (LAS bf16*)c.lds + c.wave * (16 * 72);
    const unsigned char* chk0 = C_CHK + (size_t)(3072 + sidx) * CHK_BYTES;
    float* ya = C_YA + ((size_t)(TP + 4 * ns)) * 768 + h * 64 + 16 * it + fr;
    const float* si = C_IN(2) + (((size_t)e * 8 + ns) * 12 + h) * 4096 + (size_t)(16 * it + fr) * 64 + 4 * fq;
    f32x4 S[4];
#pragma unroll
    for (int jt = 0; jt < 4; ++jt) S[jt] = *(const f32x4*)(si + 16 * jt);
    bf16x8 A0[4][2], R0f[2][2]; f32x4 G0[4], Y0[2];
    ST_LOAD(A0, R0f, G0, Y0, 0);
    ST_STEP(A0, R0f, G0, Y0, 0, 4);
    float* so = C_OUT + O_RWKV_S + (((size_t)e * 8 + ns) * 12 + h) * 4096 + (size_t)(16 * it + fr) * 64 + 4 * fq;
#pragma unroll
    for (int jt = 0; jt < 4; ++jt) *(f32x4*)(so + 16 * jt) = S[jt];
}
#undef ST_LOAD
#undef ST_STEP
__device__ __forceinline__ void phase_even_tok_pre(Ctx c, int l) {
    const int e = l >> 1;
    constexpr int NI = 3072 + 96;
    PreIn A; if (c.bid < NI) rwkv_chunk_preload(c, c.bid, e, A);
    for (int it = c.bid; it < NI; it += c.G) { PreIn B; const int nx = (it + c.G < NI) ? it + c.G : it;
        rwkv_chunk_preload(c, nx, e, B); rwkv_chunk_precompute(c, it, e, A); A = B; }
}
__device__ __forceinline__ void phase_even_scan(Ctx c, int l) {
    const int e = l >> 1;
    if (c.G >= 240) {
        if (c.bid < 48) { for (int rp = 0; rp < REPS; ++rp) { rwkv_stream_block(c, 6 * (c.bid & 7) + (c.bid >> 3), e); __syncthreads(); LAUNDER_C(c); } }
        else { Ctx h = c; h.bid = c.bid - 48; h.G = c.G - 48; LAUNDER_C(h);
            if (h.bid < 96) { if (h.wave < 4) rwkv_stream_sample(h, h.bid, h.wave, e); __syncthreads(); }
            even_helper_work(h, l); }
    } else {
        for (int it = c.bid; it < 48; it += c.G) { rwkv_stream_block(c, it, e); __syncthreads(); }
        for (int it = c.bid; it < 96; it += c.G) { if (c.wave < 4) rwkv_stream_sample(c, it, c.wave, e); __syncthreads(); }
        LAUNDER_C(c);
        even_helper_work(c, l);
    }
}
__device__ __forceinline__ void phase_even_ubuild(const Ctx& c, int l) {
    const int e = l >> 1; const float* r_k = C_IN(24) + e * 768; const float* lg = C_IN(25) + e * 768; const float* lb = C_IN(26) + e * 768; const float* muv = C_IN(17) + e * 2432 + EC_V;
    for (int R = c.bid * 8 + c.wave; R < TT; R += c.G * 8) {
        const bool hasprev = (R < TP) ? ((R & (SEQ - 1)) != 0) : (((R - TP) & 3) != 0);
        const float* shiftv = C_IN(3) + ((size_t)e * 8 + ((R >= TP) ? ((R - TP) >> 2) : 0)) * 2432 + EC_V;
        const bf16* hrow = C_HB + (size_t)R * LDH;
#pragma unroll 1
        for (int hb = 0; hb < 12; hb += 4) {
            float y[4], gate[4], cvv[4], pvv[4], bon[4], lgv[4], lbv[4], mv[4];
#pragma unroll
            for (int k = 0; k < 4; ++k) { const int col = (hb + k) * 64 + c.lane;
                y[k] = C_YA[(size_t)R * 768 + col]; gate[k] = bf2f(hrow[EC_GA + col]); cvv[k] = bf2f(hrow[EC_V + col]);
                pvv[k] = hasprev ? bf2f(hrow[EC_V + col - LDH]) : ((R < TP) ? 0.f : shiftv[col]);
                bon[k] = C_BONUS[(size_t)R * 12 + hb + k]; lgv[k] = lg[col]; lbv[k] = lb[col]; mv[k] = muv[col]; }
#pragma unroll
            for (int k = 0; k < 4; ++k) { const int col = (hb + k) * 64 + c.lane;
                const float mean = wave_sum(y[k]) * (1.0f / 64.0f); const float dlt = y[k] - mean; const float var = wave_sum(dlt * dlt) * (1.0f / 64.0f);
                const float yn = dlt * rsqrtf(var + 64e-5f) * lgv[k] + lbv[k];
                const float bonus = bon[k] * (cvv[k] + (pvv[k] - cvv[k]) * mv[k]);
                C_U[(size_t)R * EVEN_OUT + col] = (bf16)f2bf((yn + bonus) * siluf_(gate[k])); }
        }
    }
}

__device__ __forceinline__ void even_combine_dil(const Ctx& c) {
    const int hh = c.lane >> 4, d4 = 4 * (c.lane & 15);
    for (int R0 = c.bid * 8 + c.wave; R0 < TP; R0 += 2 * c.G * 8) {
        const int R1 = (R0 + c.G * 8 < TP) ? R0 + c.G * 8 : R0;
        float ls[2][3]; f32x4 og[2][3]; u32x2 gw[2];
#pragma unroll
        for (int k = 0; k < 2; ++k) { const int R = k ? R1 : R0;
#pragma unroll
            for (int g = 0; g < 3; ++g) { ls[k][g] = C_LSE[((size_t)g * TT + R) * 4 + hh]; og[k][g] = *(const f32x4*)(C_OG + ((size_t)g * TT + R) * 256 + hh * 64 + d4); }
            gw[k] = *(const u32x2*)(C_HB + (size_t)R * LDH + EC_GB + hh * 64 + d4); }
#pragma unroll
        for (int k = 0; k < 2; ++k) { const int R = k ? R1 : R0;
            const float mx = fmaxf(ls[k][0], fmaxf(ls[k][1], ls[k][2])); const float w0 = __expf(ls[k][0] - mx), w1 = __expf(ls[k][1] - mx), w2 = __expf(ls[k][2] - mx); const float inv = 1.0f / (w0 + w1 + w2);
            const f32x4 y = (og[k][0] * w0 + og[k][1] * w1 + og[k][2] * w2) * inv;
            float gt[4]; unpk4(gw[k], gt);
            *(u32x2*)(C_U + (size_t)R * EVEN_OUT + 768 + hh * 64 + d4) = (u32x2){pk2(y.x * siluf_(gt[0]), y.y * siluf_(gt[1])), pk2(y.z * siluf_(gt[2]), y.w * siluf_(gt[3]))}; }
    }
}
__device__ __forceinline__ void rot8(u32x4 w, const float* tb, float scale, float (&y)[8]) {
    float x[8]; unpk8(w, x); const f32x4 t0 = *(const f32x4*)tb, t1 = *(const f32x4*)(tb + 4);
    const float cs[8] = {t0.x, t0.y, t0.z, t0.w, t1.x, t1.y, t1.z, t1.w};
#pragma unroll
    for (int p = 0; p < 4; ++p) { const float co = cs[2 * p], si = cs[2 * p + 1], x0 = x[2 * p], x1 = x[2 * p + 1]; y[2 * p] = (x0 * co - x1 * si) * scale; y[2 * p + 1] = (x1 * co + x0 * si) * scale; }
}
#define C_SB ((bf16*)(c.ap->ws + WS_OG))
__device__ __forceinline__ void ret_s_prepass_item(const Ctx& c, int item) {
    const int bh = item >> 6, ch = item & 63, b = bh / 6, h = bh % 6;
    LAS bf16* Qc = (LAS bf16*)c.lds;
    LAS bf16* Kc = Qc + 64 * 264;
    const float lg = LG2G[h];
    const int tid = c.tid, lane = c.lane, wave = c.wave, fr = lane & 15, fq = lane >> 4, it = wave >> 1, jt0 = (wave & 1) * 2;
    const bf16* g0 = C_HB + ((size_t)b * SEQ + ch * 64) * LDH + h * 256;
    u32x4 tq[4], tk[4];
#pragma unroll
    for (int q = 0; q < 4; ++q) { const int p = tid + 512 * q, row = p >> 5, c8 = (p & 31) * 8; tq[q] = *(const u32x4*)(g0 + (size_t)row * LDH + OC_Q + c8); tk[q] = *(const u32x4*)(g0 + (size_t)row * LDH + OC_K + c8); }
#pragma unroll
    for (int q = 0; q < 4; ++q) { const int p = tid + 512 * q, row = p >> 5, c8 = (p & 31) * 8; *(LAS u32x4*)(Qc + row * 264 + c8) = tq[q]; *(LAS u32x4*)(Kc + row * 264 + c8) = tk[q]; }
    __syncthreads();
    f32x4 accS[2];
#pragma unroll
    for (int q = 0; q < 2; ++q) accS[q] = (f32x4){0.f, 0.f, 0.f, 0.f};
#pragma unroll
    for (int kp = 0; kp < 4; ++kp) { bf16x8 Qf2[2], Kf2[2][2];
#pragma unroll
        for (int kk = 0; kk < 2; ++kk) { const int ks = 2 * kp + kk; Qf2[kk] = *(const LAS bf16x8*)(Qc + (16 * it + fr) * 264 + 32 * ks + 8 * fq);
#pragma unroll
            for (int q = 0; q < 2; ++q) Kf2[kk][q] = *(const LAS bf16x8*)(Kc + (16 * (jt0 + q) + fr) * 264 + 32 * ks + 8 * fq); }
        asm volatile("s_waitcnt lgkmcnt(0)" ::: "memory"); __builtin_amdgcn_sched_barrier(0);
#pragma unroll
        for (int kk = 0; kk < 2; ++kk)
#pragma unroll
            for (int q = 0; q < 2; ++q) accS[q] = mfma16(Qf2[kk], Kf2[kk][q], accS[q]); }
    bf16* sb = C_SB + (size_t)item * 4096;
#pragma unroll
    for (int jj = 0; jj < 2; ++jj) { const int jt = jt0 + jj;
#pragma unroll
        for (int r = 0; r < 4; ++r) { const int i = 16 * it + 4 * fq + r, j = 16 * jt + fr; const float val = (i >= j) ? accS[jj][r] * exp2f(lg * (float)(i - j)) : 0.f; sb[i * 64 + j] = (bf16)f2bf(val); } }
    __syncthreads();
}
__device__ __forceinline__ void ret_prompt_unit(const Ctx& c, int unit, int o) {
    const int b = unit / 48, h = (unit >> 3) % 6, es = unit & 7;
    LAS bf16* Qc = (LAS bf16*)c.lds;
    LAS bf16* Kc = Qc + 64 * 264;
    LAS bf16* Vc = Kc + 64 * 264;
    LAS bf16* Vz = Vc + 64 * 40;
    LAS bf16* Rt = Vz + 64 * 40;
    const float lg = LG2G[h];
    const int tid = c.tid, lane = c.lane, wave = c.wave, fr = lane & 15, fq = lane >> 4, it = wave >> 1, eto = wave & 1;
    f32x4 Racc[2][2];
#pragma unroll
    for (int a = 0; a < 2; ++a)
#pragma unroll
        for (int q = 0; q < 2; ++q) Racc[a][q] = (f32x4){0.f, 0.f, 0.f, 0.f};
    for (int i = tid; i < 32 * 264 / 2; i += 512) ((LAS unsigned*)Rt)[i] = 0u;
    const float g64 = exp2f(lg * 64.f);
    const int vj = (tid & 255) >> 2, vp = tid & 3; const float zeta = exp2f(lg * (float)(63 - vj));
    const bf16* g0 = C_HB + ((size_t)b * SEQ) * LDH + h * 256;
    const bf16* gv = C_HB + ((size_t)b * SEQ + vj) * LDH + OC_V + h * 256 + es * 32 + vp * 8;
    const bf16* gs = C_SB + (size_t)((b * 6 + h) * 64) * 4096 + (16 * it + fr) * 64 + 8 * fq;
    u32x4 pq[4], pk[4], pv; bf16x8 sfn[2];
#pragma unroll
    for (int q = 0; q < 4; ++q) { const int p = tid + 512 * q, row = p >> 5, c8 = (p & 31) * 8; pq[q] = *(const u32x4*)(g0 + (size_t)row * LDH + OC_Q + c8); pk[q] = *(const u32x4*)(g0 + (size_t)row * LDH + OC_K + c8); }
    pv = *(const u32x4*)gv; sfn[0] = *(const bf16x8*)gs; sfn[1] = *(const bf16x8*)(gs + 32);
    const int trow = (lane & 15) >> 2, tcol = 4 * (lane & 3);
#pragma unroll 1
    for (int ch = 0; ch < 64; ++ch) {
        const size_t row0 = (size_t)b * SEQ + ch * 64;
#pragma unroll
        for (int q = 0; q < 4; ++q) { const int p = tid + 512 * q, row = p >> 5, c8 = (p & 31) * 8; *(LAS u32x4*)(Qc + row * 264 + c8) = pq[q]; *(LAS u32x4*)(Kc + row * 264 + c8) = pk[q]; }
        if (wave < 4) { *(LAS u32x4*)(Vc + vj * 40 + vp * 8) = pv; float x[8]; unpk8(pv, x);
            *(LAS u32x4*)(Vz + vj * 40 + vp * 8) = (u32x4){pk2(x[0] * zeta, x[1] * zeta), pk2(x[2] * zeta, x[3] * zeta), pk2(x[4] * zeta, x[5] * zeta), pk2(x[6] * zeta, x[7] * zeta)}; }
        const bf16x8 Sf0 = sfn[0], Sf1 = sfn[1];
        { const int cn = (ch + 1 < 64) ? ch + 1 : 63; const size_t adv = (size_t)cn * 64 * LDH;
#pragma unroll
            for (int q = 0; q < 4; ++q) { const int p = tid + 512 * q, row = p >> 5, c8 = (p & 31) * 8; pq[q] = *(const u32x4*)(g0 + adv + (size_t)row * LDH + OC_Q + c8); pk[q] = *(const u32x4*)(g0 + adv + (size_t)row * LDH + OC_K + c8); }
            pv = *(const u32x4*)(gv + adv); sfn[0] = *(const bf16x8*)(gs + (size_t)cn * 4096); sfn[1] = *(const bf16x8*)(gs + (size_t)cn * 4096 + 32); }
        __syncthreads();
        f32x4 accQ = (f32x4){0.f, 0.f, 0.f, 0.f};
        { bf16x8 Qf[8], Rf[8];
#pragma unroll
            for (int ks = 0; ks < 8; ++ks) { Qf[ks] = *(const LAS bf16x8*)(Qc + (16 * it + fr) * 264 + 32 * ks + 8 * fq); Rf[ks] = *(const LAS bf16x8*)(Rt + (16 * eto + fr) * 264 + 32 * ks + 8 * fq); }
            asm volatile("s_waitcnt lgkmcnt(0)" ::: "memory"); __builtin_amdgcn_sched_barrier(0);
#pragma unroll
            for (int ks = 0; ks < 8; ++ks) accQ = mfma16(Qf[ks], Rf[ks], accQ); }
        { bf16x8 Vfr[2], Kfr[2][2], Zfr[2][2];
#pragma unroll
            for (int k2 = 0; k2 < 2; ++k2) { Vfr[k2] = tr_frag(Vc + (32 * k2 + 8 * fq + trow) * 40 + 16 * eto + tcol, 4 * 40);
#pragma unroll
                for (int dd = 0; dd < 2; ++dd) Kfr[dd][k2] = tr_frag(Kc + (32 * k2 + 8 * fq + trow) * 264 + 16 * (2 * wave + dd) + tcol, 4 * 264);
#pragma unroll
                for (int et = 0; et < 2; ++et) Zfr[et][k2] = tr_frag(Vz + (32 * k2 + 8 * fq + trow) * 40 + 16 * et + tcol, 4 * 40); }
            asm volatile("s_waitcnt lgkmcnt(0)" ::: "memory"); __builtin_amdgcn_sched_barrier(0);
            { f32x4 a2 = mfma16(Sf0, Vfr[0], (f32x4){0.f, 0.f, 0.f, 0.f}); a2 = mfma16(Sf1, Vfr[1], a2);
#pragma unroll
                for (int r = 0; r < 4; ++r) { const int i = 16 * it + 4 * fq + r; C_YR[(row0 + i) * 1536 + h * 256 + es * 32 + 16 * eto + fr] = a2[r] + accQ[r] * exp2f(lg * (float)(i + 1)); } }
#pragma unroll
            for (int dd = 0; dd < 2; ++dd)
#pragma unroll
                for (int et = 0; et < 2; ++et) { f32x4 a = Racc[dd][et] * g64; a = mfma16(Kfr[dd][0], Zfr[et][0], a); Racc[dd][et] = mfma16(Kfr[dd][1], Zfr[et][1], a); } }
        __syncthreads();
#pragma unroll
        for (int dd = 0; dd < 2; ++dd)
#pragma unroll
            for (int et = 0; et < 2; ++et) { const f32x4 a = Racc[dd][et]; const int dt = 2 * wave + dd;
                *(LAS u32x2*)(Rt + (16 * et + fr) * 264 + 16 * dt + 4 * fq) = (u32x2){pk2(a[0], a[1]), pk2(a[2], a[3])}; }
    }
    int fq_l = fq; asm volatile("" : "+v"(fq_l));
    float* ro = C_OUT + O_RET_P + ((((size_t)o * 2 + b) * 6 + h) * 256) * 256 + es * 32;
#pragma unroll
    for (int dd = 0; dd < 2; ++dd)
#pragma unroll
        for (int et = 0; et < 2; ++et)
#pragma unroll
            for (int r = 0; r < 4; ++r) ro[(size_t)(16 * (2 * wave + dd) + 4 * fq_l + r) * 256 + 16 * et + fr] = Racc[dd][et][r];
    __syncthreads();
}
__device__ __forceinline__ void ret_sample_unit(const Ctx& c, int unit, int o) {
    const int n = unit / 6, h = unit % 6, tid = c.tid;
    LAS float* qs = (LAS float*)c.lds; LAS float* ks = qs + 1024; LAS float* vs = ks + 1024; LAS float* red = vs + 1024; LAS float* sc = red + 2048;
    const float lg = LG2G[h];
    for (int idx = tid; idx < 4 * 256; idx += 512) { const int t = idx >> 8, dd = idx & 255; const bf16* hr = C_HB + (size_t)(TP + n * 4 + t) * LDH + h * 256 + dd; qs[idx] = bf2f(hr[OC_Q]); ks[idx] = bf2f(hr[OC_K]); }
    for (int idx = tid; idx < 4 * 256; idx += 512) { const int t = idx >> 8, ee = idx & 255; vs[idx] = bf2f(C_HB[(size_t)(TP + n * 4 + t) * LDH + OC_V + h * 256 + ee]); }
    __syncthreads();
    if (tid < 16) { const int i = tid >> 2, j = tid & 3; float a = 0.f; for (int d = 0; d < 256; ++d) a += qs[i * 256 + d] * ks[j * 256 + d]; sc[tid] = (j <= i) ? a * exp2f(lg * (float)(i - j)) : 0.f; }
    __syncthreads();
    const int ee = tid & 255, dh = tid >> 8;
    const float* R0 = C_IN(7) + ((((size_t)o * 8 + n) * 6 + h) * 256) * 256; float* Rn = C_OUT + O_RET_S + ((((size_t)o * 8 + n) * 6 + h) * 256) * 256;
    const float g4 = exp2f(lg * 4.f), z0 = exp2f(lg * 3.f), z1 = exp2f(lg * 2.f), z2 = exp2f(lg), z3 = 1.0f;
    const float v0 = vs[ee] * z0, v1 = vs[256 + ee] * z1, v2 = vs[512 + ee] * z2, v3 = vs[768 + ee] * z3;
    float acc[4] = {0.f, 0.f, 0.f, 0.f};
#pragma unroll 4
    for (int d = dh * 128; d < dh * 128 + 128; ++d) { const float r0 = R0[(size_t)d * 256 + ee];
        acc[0] += qs[d] * r0; acc[1] += qs[256 + d] * r0; acc[2] += qs[512 + d] * r0; acc[3] += qs[768 + d] * r0;
        Rn[(size_t)d * 256 + ee] = g4 * r0 + ks[d] * v0 + ks[256 + d] * v1 + ks[512 + d] * v2 + ks[768 + d] * v3; }
#pragma unroll
    for (int i = 0; i < 4; ++i) red[(dh * 4 + i) * 256 + ee] = acc[i];
    __syncthreads();
    if (dh == 0) {
#pragma unroll
        for (int i = 0; i < 4; ++i) { float ov = (red[i * 256 + ee] + red[(4 + i) * 256 + ee]) * exp2f(lg * (float)(i + 1));
            for (int j = 0; j <= i; ++j) ov += sc[i * 4 + j] * vs[j * 256 + ee];
            C_YR[(size_t)(TP + n * 4 + i) * 1536 + h * 256 + ee] = ov; } }
    __syncthreads();
}
__device__ __forceinline__ void odd_helper_work(Ctx c, int l) {
    mem_attn_all(c, l, OC_QM, OC_GM, 1536, ODD_OUT);
    LAUNDER_C(c);
    if (l < 3) convert_layer_weights(c, l + 1);
}
__device__ __forceinline__ void phase_odd_tok(Ctx c, int l) {
    const int o = l >> 1;
    if (c.G >= 200) {
        if (c.bid < 96) ret_prompt_unit(c, 12 * (c.bid & 7) + (c.bid >> 3), o);
        else if (c.bid < 144) ret_sample_unit(c, c.bid - 96, o);
        else { Ctx h = c; h.bid = c.bid - 144; h.G = c.G - 144; odd_helper_work(h, l); }
    } else {
        for (int it = c.bid; it < 144; it += c.G) { if (it < 96) ret_prompt_unit(c, it, o); else ret_sample_unit(c, it - 96, o); }
        LAUNDER_C(c);
        odd_helper_work(c, l);
    }
}
__device__ __forceinline__ void phase_odd_ubuild(const Ctx& c) {
    for (int R = c.bid * 8 + c.wave; R < TT; R += c.G * 8) {
#pragma unroll 1
        for (int hb = 0; hb < 6; hb += 3) {
            f32x4 ov[3]; u32x2 gw[3];
#pragma unroll
            for (int k = 0; k < 3; ++k) { const int col = (hb + k) * 256 + 4 * c.lane; ov[k] = *(const f32x4*)(C_YR + (size_t)R * 1536 + col); gw[k] = *(const u32x2*)(C_HB + (size_t)R * LDH + OC_G + col); }
#pragma unroll
            for (int k = 0; k < 3; ++k) { const int col = (hb + k) * 256 + 4 * c.lane; const f32x4 o = ov[k];
                const float ss = wave_sum(o.x * o.x + o.y * o.y + o.z * o.z + o.w * o.w); const float scl = rsqrtf(ss * (1.0f / 256.0f) + 1e-6f);
                float g[4]; unpk4(gw[k], g);
                *(u32x2*)(C_U + (size_t)R * DM + col) = (u32x2){pk2(o.x * scl * siluf_(g[0]), o.y * scl * siluf_(g[1])), pk2(o.z * scl * siluf_(g[2]), o.w * scl * siluf_(g[3]))}; }
        }
    }
}
__device__ __forceinline__ void small_outproj(const Ctx& c, int wt, int K, int l) {
    const int lane = c.lane, r = lane & 31, hl = lane >> 5, nks = K / 128;
    const bf16* ap = C_U + (size_t)(TP + r) * K + 8 * hl + c.wave * nks * 16; const bf16* bp = C_WTOUT_L(l) + (size_t)(32 * wt + r) * K + 8 * hl + c.wave * nks * 16;
    f32x16 acc;
#pragma unroll
    for (int i = 0; i < 16; ++i) acc[i] = 0.f;
    if (nks == 16) {
#pragma unroll
        for (int ks = 0; ks < 16; ++ks) acc = mfma32(*(const bf16x8*)(ap + 16 * ks), *(const bf16x8*)(bp + 16 * ks), acc);
    } else {
#pragma unroll
        for (int ks = 0; ks < 12; ++ks) acc = mfma32(*(const bf16x8*)(ap + 16 * ks), *(const bf16x8*)(bp + 16 * ks), acc);
    }
    LAS float* part = (LAS float*)c.lds;
#pragma unroll
    for (int i = 0; i < 16; ++i) part[(c.wave * 16 + i) * 64 + lane] = acc[i];
    __syncthreads();
    for (int idx = c.tid; idx < 1024; idx += 512) { float sum = 0.f;
#pragma unroll
        for (int w = 0; w < 8; ++w) sum += part[w * 1024 + idx];
        const int i = idx >> 6, ln = idx & 63, row = TP + (i & 3) + 8 * (i >> 2) + 4 * (ln >> 5), col = 32 * wt + (ln & 31);
        const float xres = (l == 0) ? C_IN(1)[(size_t)(row - TP) * DM + col] : C_XZ[(size_t)row * DM + col];
        C_Z[(size_t)row * DM + col] = xres * ALPHA + sum; }
    __syncthreads();
}
__device__ __forceinline__ void phase_ln(const Ctx& c, int l) {
    const float* g = C_IN(15) + l * DM; const float* bta = C_IN(16) + l * DM;
    f32x4 gg[8], bb[8];
#pragma unroll
    for (int j = 0; j < 8; ++j) { const int col = 4 * c.lane + 256 * j; gg[j] = *(const f32x4*)(g + col); bb[j] = *(const f32x4*)(bta + col); }
    for (int R0 = c.bid * 8 + c.wave; R0 < TT; R0 += 2 * c.G * 8) {
        const int R1 = R0 + c.G * 8; const bool has1 = R1 < TT; const int R1c = has1 ? R1 : R0;
        f32x4 v0[8], v1[8]; float s0 = 0.f, s1 = 0.f;
        { const f32x4* z0 = (const f32x4*)(C_Z + (size_t)R0 * DM) + c.lane; const f32x4* z1 = (const f32x4*)(C_Z + (size_t)R1c * DM) + c.lane;
#pragma unroll
            for (int j = 0; j < 8; ++j) { v0[j] = z0[64 * j]; v1[j] = z1[64 * j]; } }
#pragma unroll
        for (int j = 0; j < 8; ++j) { s0 += (v0[j].x + v0[j].y) + (v0[j].z + v0[j].w); s1 += (v1[j].x + v1[j].y) + (v1[j].z + v1[j].w); }
        const float m0 = wave_sum(s0) * (1.0f / DM), m1 = wave_sum(s1) * (1.0f / DM); float q0 = 0.f, q1 = 0.f;
#pragma unroll
        for (int j = 0; j < 8; ++j) { v0[j] = v0[j] - m0; v1[j] = v1[j] - m1; q0 += (v0[j].x * v0[j].x + v0[j].y * v0[j].y) + (v0[j].z * v0[j].z + v0[j].w * v0[j].w); q1 += (v1[j].x * v1[j].x + v1[j].y * v1[j].y) + (v1[j].z * v1[j].z + v1[j].w * v1[j].w); }
        const float r0 = rsqrtf(wave_sum(q0) * (1.0f / DM) + LN_EPS), r1 = rsqrtf(wave_sum(q1) * (1.0f / DM) + LN_EPS);
        float* d0 = (l == 3) ? (R0 < TP ? C_OUT + O_YP + (size_t)R0 * DM : C_OUT + O_YS + (size_t)(R0 - TP) * DM) : C_XZ + (size_t)R0 * DM;
        float* d1 = (l == 3) ? (R1c < TP ? C_OUT + O_YP + (size_t)R1c * DM : C_OUT + O_YS + (size_t)(R1c - TP) * DM) : C_XZ + (size_t)R1c * DM;
#pragma unroll
        for (int j = 0; j < 8; ++j) { const int col = 4 * c.lane + 256 * j;
            const f32x4 x0 = v0[j] * r0 * gg[j] + bb[j]; *(f32x4*)(d0 + col) = x0; if (l != 3) *(u32x2*)(C_XB + (size_t)R0 * DM + col) = (u32x2){pk2(x0.x, x0.y), pk2(x0.z, x0.w)};
            if (has1) { const f32x4 x1 = v1[j] * r1 * gg[j] + bb[j]; *(f32x4*)(d1 + col) = x1; if (l != 3) *(u32x2*)(C_XB + (size_t)R1 * DM + col) = (u32x2){pk2(x1.x, x1.y), pk2(x1.z, x1.w)}; } }
    }
}

#define XB_TMO      128
#define XB_XCNT(j)  (256  + 64 * (j))
#define XB_XSUB(j)  (1280 + 64 * (j))
#define XB_XGEN(j)  (2304 + 64 * (j))
#define XB_TOP      3328
#define XB_TOPGEN   3392
#define XCD_BAR_WORDS 3456
#define XB_SPIN_CAP (1u << 18)

__device__ __forceinline__ unsigned xb_ld(unsigned* p)              { return __hip_atomic_load(p, __ATOMIC_RELAXED, __HIP_MEMORY_SCOPE_AGENT); }
__device__ __forceinline__ unsigned xb_add(unsigned* p, unsigned v) { return __hip_atomic_fetch_add(p, v, __ATOMIC_RELAXED, __HIP_MEMORY_SCOPE_AGENT); }
__device__ __forceinline__ unsigned xb_xcc_id() { return (unsigned)__builtin_amdgcn_s_getreg((3 << 11) | 20) & 0xFu; }
#define XB_SPIN(cond, bar) do { unsigned _sp = 0; while (cond) { __builtin_amdgcn_s_sleep(1); \
    if ((++_sp & 255u) == 0u) { if (xb_ld(&(bar)[XB_TMO])) break; if (_sp > XB_SPIN_CAP) { atomicAdd(&(bar)[XB_TMO], 1u); break; } } } } while (0)

struct XcdBarrier {
    unsigned* bar; unsigned x;
    volatile LAS unsigned* st;
};

__device__ __forceinline__ XcdBarrier xcd_barrier_post(unsigned* bar, volatile LAS unsigned* st) {
    XcdBarrier b; b.bar = bar; b.x = xb_xcc_id(); b.st = st;
    if (threadIdx.x == 0) (void)xb_add(&bar[XB_XCNT(b.x)], 1u);
    return b;
}
__device__ __forceinline__ void xcd_barrier_complete(unsigned* bar, unsigned x, unsigned& nloc, unsigned& nx) {
    const unsigned G = gridDim.x * gridDim.y * gridDim.z;
    unsigned sum, cnt, mine, sp = 0u;
    for (;;) {
        sum = 0u; cnt = 0u; mine = 0u;
#pragma unroll
        for (unsigned j = 0; j < 16; ++j) { const unsigned c = xb_ld(&bar[XB_XCNT(j)]); sum += c; cnt += (c > 0u) ? 1u : 0u; mine = (j == x) ? c : mine; }
        if (sum == G) break;
        __builtin_amdgcn_s_sleep(1);
        if ((++sp & 255u) == 0u) { if (xb_ld(&bar[XB_TMO])) break; if (sp > XB_SPIN_CAP) { atomicAdd(&bar[XB_TMO], 1u); break; } }
    }
    nloc = mine > 0u ? mine : 1u; nx = cnt > 0u ? cnt : 1u;
}

__device__ __forceinline__ void xcd_barrier(const XcdBarrier& b) {
    asm volatile("s_waitcnt vmcnt(0)" ::: "memory");
    __syncthreads();
    if (threadIdx.x == 0) {
        unsigned* bar = b.bar;
        __builtin_amdgcn_s_waitcnt(0);
        unsigned nloc = b.st[0], nx = b.st[1];
        if (nloc == 0u) { xcd_barrier_complete(bar, b.x, nloc, nx); b.st[0] = nloc; b.st[1] = nx; }
        const unsigned old = xb_add(&bar[XB_XSUB(b.x)], 1u);
        const unsigned gen = old / nloc;
        if (old + 1u == (gen + 1u) * nloc) {
            __builtin_amdgcn_fence(__ATOMIC_RELEASE, "agent");
            asm volatile("s_waitcnt vmcnt(0)" ::: "memory");
            const unsigned og = xb_add(&bar[XB_TOP], 1u);
            const unsigned tg = og / nx;
            if (og + 1u == (tg + 1u) * nx) xb_add(&bar[XB_TOPGEN], 1u);
            else XB_SPIN(xb_ld(&bar[XB_TOPGEN]) == tg, bar);
            __builtin_amdgcn_fence(__ATOMIC_ACQUIRE, "agent");
            xb_add(&bar[XB_XGEN(b.x)], 1u);
            asm volatile("s_waitcnt vmcnt(0)" ::: "memory");
        } else {
            XB_SPIN(xb_ld(&bar[XB_XGEN(b.x)]) == gen, bar);
            __builtin_amdgcn_fence(__ATOMIC_ACQUIRE, "agent");
            asm volatile("s_waitcnt vmcnt(0)" ::: "memory");
        }
    }
    __syncthreads();
}

constexpr int NPH = 25;
__global__ void __launch_bounds__(512, 2) mk(Args args) {
    extern __shared__ __attribute__((aligned(16))) unsigned char lds_raw[];
    Ctx c;
    c.ap = (ArgsP)__builtin_amdgcn_kernarg_segment_ptr(); c.lds = (LAS unsigned char*)lds_raw;
    c.tid = threadIdx.x; c.lane = c.tid & 63; c.wave = __builtin_amdgcn_readfirstlane(c.tid >> 6); c.bid = blockIdx.x; c.G = gridDim.x;
    for (int u = c.tid; u < 16; u += 512) ((LAS unsigned*)(c.lds + 131072))[u] = 0u;
    __syncthreads();
    XcdBarrier xbar = xcd_barrier_post((unsigned*)(c.ap->ws + WS_CTL) + 4096, (volatile LAS unsigned*)(c.lds + 131072));
#define LAUNDER() do { asm volatile("" : "+s"(c.ap), "+v"(c.tid), "+s"(c.bid), "+s"(c.G)); c.lane = c.tid & 63; c.wave = __builtin_amdgcn_readfirstlane(c.tid >> 6); } while (0)
    const int lo = args.ph_lo, hi = args.ph_hi;
#define IN(k) (lo <= (k) && (k) < hi)
#if USE_CG
#define SEAM(k) do { if (IN(k) && IN((k) + 1)) { cg::this_grid().sync(); } } while (0)
#else
#define SEAM(k) do { if (IN(k) && IN((k) + 1)) { asm volatile("" : "+s"(xbar.bar)); xcd_barrier(xbar); } } while (0)
#endif
    #if !(DIS & 1)
    if (IN(0)) { for (int rep = 0; rep < ((DUP & 128) ? 2 : 1); ++rep) { LAUNDER(); phase_prologue(c); if (DUP & 128) { asm volatile("" : "+s"(xbar.bar)); xcd_barrier(xbar); } } }
#endif
    SEAM(0);
#pragma unroll 1
    for (int l = 0; l < 4; ++l) {
        const int p0 = 1 + 6 * l; const bool even = (l & 1) == 0;
#if !(DIS & 2)
        if (IN(p0)) { for (int rep = 0; rep < ((DUP & 16) ? 2 : 1); ++rep) { LAUNDER();
            if (l == 0) { pg8::Gemm g{C_MEMB, C_WTMEM, 512, 4096, DM}; pg8::StaticOrder S; S.init(512, 4096, c.G, (c.bid + c.G - c.G / 2) % c.G);
                pg8::EpiF32Split E{C_OUT + O_MEM, 1024, 1024, (size_t)512 * 1024, C_MKVB};
                pg8::gemm_phase<pg8::EpiF32Split, pg8::StaticOrder, true, true>(c.lds, g, S, E); }
            const int ngemm = (l == 0) ? 5 : 1;
#pragma unroll 1
            for (int gi = 0; gi < ngemm; ++gi) {
                const int NI = even ? EVEN_INP : ODD_IN;
                const bf16* A = gi ? C_WTMEM + ((size_t)(gi - 1) * 1024 + 512) * DM : C_XB; const bf16* Bt = gi ? C_MEMB : C_WTIN;
                const int Mg = gi ? 512 : MPAD, Ng = gi ? 512 : NI;
                bf16* Og = gi ? C_VT + (size_t)(gi - 1) * 512 * 512 : C_HB; const int ldo = gi ? 512 : LDH;
                pg8::Gemm g{A, Bt, Mg, Ng, DM}; pg8::StaticOrder S; S.init(Mg, Ng, c.G, gi ? (c.bid + 2 * c.G - (5 * c.G) / 8 - 8 * (gi - 1)) % c.G : c.bid); pg8::EpiBf16NP E{Og, ldo, C_TAB, (gi == 0 && !even) ? 3072 : 0, 1536};
                pg8::gemm_phase<pg8::EpiBf16NP, pg8::StaticOrder, true, true>(c.lds, g, S, E);
            }
            if (DUP & 16) { asm volatile("" : "+s"(xbar.bar)); xcd_barrier(xbar); }
        } }
#endif
        SEAM(p0);
#if !(DIS & 4)
        if (IN(p0 + 1)) { for (int rep = 0; rep < ((DUP & 1) ? 2 : 1); ++rep) { LAUNDER(); if (even) phase_even_tok_pre(c, l); if (DUP & 1) { asm volatile("" : "+s"(xbar.bar)); xcd_barrier(xbar); } } }
#endif
#if !(DIS & 8)
        if (IN(p0 + 1)) { LAUNDER(); if (!even) { for (int it = c.bid; it < 768; it += c.G) ret_s_prepass_item(c, it); } }
#endif
        SEAM(p0 + 1);
#if !(DIS & 16)
        if (IN(p0 + 2)) { for (int rep = 0; rep < ((DUP & 4) ? 2 : 1); ++rep) { LAUNDER(); if (even) phase_even_scan(c, l); if (DUP & 4) { asm volatile("" : "+s"(xbar.bar)); xcd_barrier(xbar); } } }
#if !(DIS & 8)
        if (IN(p0 + 2)) { for (int rep = 0; rep < ((DUP & 2) ? 2 : 1); ++rep) { LAUNDER(); if (!even) phase_odd_tok(c, l); if (DUP & 2) { asm volatile("" : "+s"(xbar.bar)); xcd_barrier(xbar); } } }
#endif
#endif
        SEAM(p0 + 2);
#if !(DIS & 32)
        if (IN(p0 + 3)) { for (int rep = 0; rep < ((DUP & 8) ? 2 : 1); ++rep) { LAUNDER(); if (even) { phase_even_ubuild(c, l); LAUNDER(); even_combine_dil(c); } else phase_odd_ubuild(c); if (DUP & 8) { asm volatile("" : "+s"(xbar.bar)); xcd_barrier(xbar); } } }
#endif
        SEAM(p0 + 3);
#if !(DIS & 64)
        if (IN(p0 + 4)) { for (int rep = 0; rep < ((DUP & 32) ? 2 : 1); ++rep) { LAUNDER(); const int K = even ? EVEN_OUT : ODD_OUT;
            pg8::Gemm g{C_U, C_WTOUT_L(l), TP, DM, K}; pg8::StaticOrder S; S.init(TP, DM, c.G, c.bid); pg8::EpiResid E{(l == 0) ? C_IN(0) : C_XZ, C_Z, DM, ALPHA};
            pg8::gemm_phase<pg8::EpiResid, pg8::StaticOrder, true, true>(c.lds, g, S, E);
            LAUNDER(); if (c.bid < 64) small_outproj(c, c.bid, K, l); if (DUP & 32) { asm volatile("" : "+s"(xbar.bar)); xcd_barrier(xbar); } } }
#endif
        SEAM(p0 + 4);
#if !(DIS & 128)
        if (IN(p0 + 5)) { for (int rep = 0; rep < ((DUP & 64) ? 2 : 1); ++rep) { LAUNDER(); phase_ln(c, l); if (DUP & 64) { asm volatile("" : "+s"(xbar.bar)); xcd_barrier(xbar); } } }
#endif
        SEAM(p0 + 5);
    }
#undef IN
#undef SEAM
}

extern "C" void kernel_launch(void* const* d_in, const int* in_sizes, int n_in, void* d_out, int out_size, void* d_ws, size_t ws_size, hipStream_t stream) {
    static int grid = 0;
    if (grid == 0) {
        if (n_in != 27 || (size_t)out_size != O_END || ws_size < WS_END) { fprintf(stderr, "kernel_launch: unexpected shapes: n_in %d out %d ws %zu (need %zu)\n", n_in, out_size, ws_size, (size_t)WS_END); grid = -1; return; }
        int dev = 0, cus = 0, per_cu = 0;
        hipGetDevice(&dev); hipDeviceGetAttribute(&cus, hipDeviceAttributeMultiprocessorCount, dev);
        if (hipFuncSetAttribute((const void*)mk, hipFuncAttributeMaxDynamicSharedMemorySize, LDS_BYTES) != hipSuccess) { fprintf(stderr, "kernel_launch: hipFuncSetAttribute failed\n"); grid = -1; return; }
        if (hipOccupancyMaxActiveBlocksPerMultiprocessor(&per_cu, (const void*)mk, 512, LDS_BYTES) != hipSuccess || per_cu < 1) { fprintf(stderr, "kernel_launch: occupancy query says %d\n", per_cu); per_cu = 1; }
        (void)hipGetLastError();
        grid = cus;
        fprintf(stderr, "kernel_launch: grid %d (cus %d, per_cu %d)\n", grid, cus, per_cu);
    }
    if (grid < 0) return;
    if (hipMemsetAsync((char*)d_ws + WS_CTL, 0, 1u << 20, stream) != hipSuccess) { fprintf(stderr, "kernel_launch: memset failed\n"); return; }
    Args a{};
    for (int i = 0; i < 27; ++i) a.in[i] = (const float*)d_in[i];
    a.out = (float*)d_out; a.ws = (unsigned char*)d_ws;
#if ONE_LAUNCH
    a.ph_lo = 0; a.ph_hi = NPH;
    void* kargs[] = {&a};
    hipError_t e = hipLaunchCooperativeKernel((const void*)mk, dim3(grid), dim3(512), kargs, LDS_BYTES, stream);
    if (e != hipSuccess) fprintf(stderr, "kernel_launch: cooperative launch failed: %s\n", hipGetErrorString(e));
#else
    for (int p = 0; p < NPH; ++p) {
        if (p >= 1 && ((p - 1) % 6) == 2 && (((p - 1) / 6) & 1)) continue;
        a.ph_lo = p; a.ph_hi = p + 1;
        hipLaunchKernelGGL(mk, dim3(grid), dim3(512), LDS_BYTES, stream, a);
    }
#endif
}
```

```cpp
#include <hip/hip_runtime.h>
#include <hip/hip_cooperative_groups.h>
#include <cstdio>
#include <cstdint>
namespace cg = cooperative_groups;
#ifndef DIS
#define DIS 0
#endif
#ifndef REPE
#define REPE 1
#endif
#ifndef REPD
#define REPD 1
#endif
#ifndef REPM
#define REPM 1
#endif
#ifndef REPC
#define REPC 1
#endif
#ifndef REPS
#define REPS 1
#endif
#ifndef REP9
#define REP9 1
#endif
#ifndef REP3
#define REP3 1
#endif
#ifndef REP8
#define REP8 1
#endif
#ifndef REP1
#define REP1 1
#endif
#ifndef DUP
#define DUP 0
#endif
#ifndef USE_CG
#define USE_CG 0
#endif
#ifndef ONE_LAUNCH
#define ONE_LAUNCH 1
#endif
namespace pg8 {
#define PG8_LAS __attribute__((address_space(3)))
typedef unsigned short bf16_t;
typedef short bf16x8 __attribute__((ext_vector_type(8)));
typedef float f32x4 __attribute__((ext_vector_type(4)));
typedef unsigned u32x4 __attribute__((ext_vector_type(4)));
constexpr int BM = 256, BK = 64, HALF = 128, HTB = HALF * BK * 2  , STAGE_BYTES = 8 * HTB, NXCD = 8, WGM = 8;

__host__ __device__ __forceinline__ int lds_byte(int r, int c) { const int st = (r >> 4) * 2 + (c >> 5), rr = r & 15, cc = c & 31, ob = rr * 64 + cc * 2; return st * 1024 + (ob ^ (((ob >> 9) & 1) << 5)); }
__host__ __device__ __forceinline__ void stage_rc(int b, int& R, int& C) { const int st = b / 1024, sb = b % 1024, swz = sb ^ (((sb >> 9) & 1) << 5); R = (st >> 1) * 16 + swz / 64; C = (st & 1) * 32 + (swz % 64) / 2; }
__host__ __device__ __forceinline__ int perm32(int rho) { const int n = rho >> 4, i = rho & 15; return 8 * (i >> 2) + 4 * n + (i & 3); }

struct Unit { int pm, pn; };
struct Gemm { const bf16_t* A; const bf16_t* Bt; int M, N, K; };

struct StaticOrder {
    int nM, nN, nwg, G, c, skip_from, skip_n, ex_n, ex_pm0, ex_pn;
    __host__ __device__ void init(int M, int N, int G_, int c_, int sf = 1 << 30, int sn = 0) { nM = M / BM; nN = N / BM; nwg = nM * nN; G = G_; c = c_; skip_from = sf; skip_n = sn; ex_n = 0; ex_pm0 = 0; ex_pn = 0; }
    __host__ __device__ bool next(int i, Unit& u) const {
        const long L = (long)i * G + c; if (L >= nwg + ex_n) return false;
        if (L >= nwg) { u.pm = ex_pm0 + (int)(L - nwg); u.pn = ex_pn; return true; }
        int wgid = (int)L; { const int q = nwg / NXCD, r = nwg % NXCD, xcd = wgid % NXCD, off = wgid / NXCD; wgid = (xcd < r ? xcd * (q + 1) : r * (q + 1) + (xcd - r) * q) + off; }
        const int nig = WGM * nN, gid = wgid / nig, fm = gid * WGM, gsz = (nM - fm) < WGM ? (nM - fm) : WGM;
        u.pm = fm + ((wgid % nig) % gsz); u.pn = (wgid % nig) / gsz; if (u.pn >= skip_from) u.pn += skip_n; return true;
    }
    __device__ __forceinline__ void a_ready(const Unit&) const {}
    __device__ __forceinline__ void done(const Unit&) const {}
};

__device__ __forceinline__ unsigned cvt_pk_bf16(float lo, float hi) { unsigned r; asm volatile("v_cvt_pk_bf16_f32 %0, %1, %2" : "=v"(r) : "v"(lo), "v"(hi)); return r; }
typedef float f32x2 __attribute__((ext_vector_type(2)));
__device__ __forceinline__ f32x2 gelu_pk(f32x2 v) {
    const f32x2 av = __builtin_elementwise_abs(v), d = av * 0.2316418882f + 1.0f;
    f32x2 t; t.x = __builtin_amdgcn_rcpf(d.x); t.y = __builtin_amdgcn_rcpf(d.y);
    f32x2 q = t * 0.5307027145f + (-0.7265760135f); q = q * t + 0.7107068705f; q = q * t + (-0.142248368f); q = q * t + 0.127414796f; q = q * t;
    const f32x2 s = (v * v) * (-0.72134752044f);
    f32x2 e; e.x = __builtin_amdgcn_exp2f(s.x); e.y = __builtin_amdgcn_exp2f(s.y);
    const f32x2 m = v * (q * e), r = v - m;
    f32x2 o; o.x = v.x < 0.f ? m.x : r.x; o.y = v.y < 0.f ? m.y : r.y; return o;
}

template <int ACT  > struct EpiBf16 {
    static constexpr bool PERM = true, AFTER_DRAIN = false; static_assert(ACT == 0 || ACT == 1, "EpiBf16: ACT is 0 (none) or 1 (gelu_pk)");
    bf16_t* O; int ldc; const float* bias; int split_cols; size_t split_stride; float scale0;
    __device__ __forceinline__ void operator()(const f32x4 (&acc)[2][2][4][2], const Unit& u, int wr, int wc, int fr, int fq) const {
        const int row0 = u.pm * BM + wr * 64 + fr; int colt = u.pn * BM; bf16_t* base = O;
        float sc = 1.f; if (split_cols) { const int t = colt / split_cols; base += (size_t)t * split_stride; colt -= t * split_cols; if (t == 0) sc = scale0; }
        const int col0 = colt + wc * 32 + 8 * fq, bcol0 = u.pn * BM + wc * 32 + 8 * fq;
        f32x4 bv[2][2];
#pragma unroll
        for (int bj = 0; bj < 2; ++bj)
#pragma unroll
            for (int n = 0; n < 2; ++n) bv[bj][n] = bias ? *(const f32x4*)(bias + bcol0 + bj * HALF + 4 * n) : (f32x4){0.f, 0.f, 0.f, 0.f};
#pragma unroll
        for (int ai = 0; ai < 2; ++ai)
#pragma unroll
            for (int m = 0; m < 4; ++m) { bf16_t* rowp = base + (size_t)(row0 + ai * HALF + m * 16) * ldc + col0;
#pragma unroll
                for (int bj = 0; bj < 2; ++bj) { f32x4 v0 = acc[ai][bj][m][0] + bv[bj][0], v1 = acc[ai][bj][m][1] + bv[bj][1];
                    if (ACT == 1) { f32x2 a = gelu_pk((f32x2){v0[0], v0[1]}), b = gelu_pk((f32x2){v0[2], v0[3]}), c = gelu_pk((f32x2){v1[0], v1[1]}), d = gelu_pk((f32x2){v1[2], v1[3]});
                        v0 = (f32x4){a.x, a.y, b.x, b.y}; v1 = (f32x4){c.x, c.y, d.x, d.y}; }
                    v0 = v0 * sc; v1 = v1 * sc; u32x4 w; w.x = cvt_pk_bf16(v0[0], v0[1]); w.y = cvt_pk_bf16(v0[2], v0[3]); w.z = cvt_pk_bf16(v1[0], v1[1]); w.w = cvt_pk_bf16(v1[2], v1[3]);
                    *(u32x4*)(rowp + bj * HALF) = w; } }
    }
};
struct EpiF32Split {
    static constexpr bool PERM = false, AFTER_DRAIN = false;
    float* C; int ldc; int split_cols; size_t split_stride; bf16_t* MB;
    __device__ __forceinline__ void operator()(const f32x4 (&acc)[2][2][4][2], const Unit& u, int wr, int wc, int fr, int fq) const {
        typedef unsigned u32x2v __attribute__((ext_vector_type(2)));
        int colt = u.pn * BM; float* base = C; bf16_t* mb = MB;
        if (split_cols) { const int t = colt / split_cols; base += (size_t)t * split_stride; mb += (size_t)t * split_stride; colt -= t * split_cols; }
        const int row0 = u.pm * BM + wr * 64 + fr, col0 = colt + wc * 32 + 4 * fq;
#pragma unroll
        for (int ai = 0; ai < 2; ++ai)
#pragma unroll
            for (int m = 0; m < 4; ++m) { float* rowp = base + (size_t)(row0 + ai * HALF + m * 16) * ldc + col0; bf16_t* rowb = mb + (size_t)(row0 + ai * HALF + m * 16) * ldc + col0;
#pragma unroll
                for (int bj = 0; bj < 2; ++bj)
#pragma unroll
                    for (int n = 0; n < 2; ++n) { const f32x4 v = acc[ai][bj][m][n]; *(f32x4*)(rowp + bj * HALF + n * 16) = v;
                        u32x2v w; w.x = cvt_pk_bf16(v[0], v[1]); w.y = cvt_pk_bf16(v[2], v[3]); *(u32x2v*)(rowb + bj * HALF + n * 16) = w; } }
    }
};
struct EpiBf16NP {
    static constexpr bool PERM = true, AFTER_DRAIN = false;
    bf16_t* O; int ldc; const float* TAB; int rot_cols, kcol0;
    __device__ __forceinline__ void operator()(const f32x4 (&acc)[2][2][4][2], const Unit& u, int wr, int wc, int fr, int fq) const {
        const int row0 = u.pm * BM + wr * 64 + fr, col0 = u.pn * BM + wc * 32 + 8 * fq;
        const bool rot = u.pn * BM < rot_cols; const float scl = (u.pn * BM >= kcol0) ? 0.0625f : 1.0f;
#pragma unroll
        for (int ai = 0; ai < 2; ++ai)
#pragma unroll
            for (int m = 0; m < 4; ++m) { const int row = row0 + ai * HALF + m * 16; bf16_t* rowp = O + (size_t)row * ldc + col0;
                const int p = row < 8192 ? (row & 4095) : (row < 8224 ? 4096 + ((row - 8192) & 3) : 0);
                const float* tb = TAB + ((size_t)p * 128 + ((col0 & 255) >> 1)) * 2;
#pragma unroll
                for (int bj = 0; bj < 2; ++bj) { f32x4 v0 = acc[ai][bj][m][0], v1 = acc[ai][bj][m][1];
                    if (rot) { const f32x4 c0 = *(const f32x4*)(tb + bj * HALF), c1 = *(const f32x4*)(tb + bj * HALF + 4);
                        v0 = (f32x4){(v0[0] * c0[0] - v0[1] * c0[1]) * scl, (v0[1] * c0[0] + v0[0] * c0[1]) * scl, (v0[2] * c0[2] - v0[3] * c0[3]) * scl, (v0[3] * c0[2] + v0[2] * c0[3]) * scl};
                        v1 = (f32x4){(v1[0] * c1[0] - v1[1] * c1[1]) * scl, (v1[1] * c1[0] + v1[0] * c1[1]) * scl, (v1[2] * c1[2] - v1[3] * c1[3]) * scl, (v1[3] * c1[2] + v1[2] * c1[3]) * scl}; }
                    u32x4 w; w.x = cvt_pk_bf16(v0[0], v0[1]); w.y = cvt_pk_bf16(v0[2], v0[3]); w.z = cvt_pk_bf16(v1[0], v1[1]); w.w = cvt_pk_bf16(v1[2], v1[3]);
                    *(u32x4*)(rowp + bj * HALF) = w; } }
    }
};
struct EpiResid {
    static constexpr bool PERM = false, AFTER_DRAIN = false;
    const float* __restrict__ X; float* __restrict__ Z; int ldc; float alpha;
    __device__ __forceinline__ void operator()(const f32x4 (&acc)[2][2][4][2], const Unit& u, int wr, int wc, int fr, int fq) const {
        const int row0 = u.pm * BM + wr * 64 + fr, col0 = u.pn * BM + wc * 32 + 4 * fq;
#pragma unroll
        for (int ai = 0; ai < 2; ++ai)
#pragma unroll
            for (int mp = 0; mp < 2; ++mp) { f32x4 xv[2][2][2];
#pragma unroll
                for (int mm = 0; mm < 2; ++mm) { const float* rowp = X + (size_t)(row0 + ai * HALF + (2 * mp + mm) * 16) * ldc + col0;
#pragma unroll
                    for (int bj = 0; bj < 2; ++bj)
#pragma unroll
                        for (int n = 0; n < 2; ++n) xv[mm][bj][n] = *(const f32x4*)(rowp + bj * HALF + n * 16); }
#pragma unroll
                for (int mm = 0; mm < 2; ++mm) { float* rowz = Z + (size_t)(row0 + ai * HALF + (2 * mp + mm) * 16) * ldc + col0;
#pragma unroll
                    for (int bj = 0; bj < 2; ++bj)
#pragma unroll
                        for (int n = 0; n < 2; ++n) *(f32x4*)(rowz + bj * HALF + n * 16) = xv[mm][bj][n] * alpha + acc[ai][bj][2 * mp + mm][n]; } }
    }
};
template <class Epi, class Sched, bool ALIGN_EPI = false, bool SP2 = false>
__device__ __forceinline__ void gemm_phase(PG8_LAS unsigned char* lds, const Gemm g, const Sched& S, const Epi& E) {
    int tid_ = threadIdx.x; asm volatile("" : "+v"(tid_));
    const int tid = tid_, wid = __builtin_amdgcn_readfirstlane(tid >> 6), lane = tid & 63, wr = wid >> 2, wc = wid & 3, fr = lane & 15, fq = lane >> 4;
    const int K = g.K, nt = K / BK;
    unsigned voffA[2], voffB[2];
#pragma unroll
    for (int i = 0; i < 2; ++i) { int R, C; stage_rc(tid * 16 + i * 8192, R, C); const int Rb = Epi::PERM ? ((R & ~31) + perm32(R & 31)) : R;
        voffA[i] = (unsigned)(R * K + C) * 2u; voffB[i] = (unsigned)(Rb * K + C) * 2u; }
    const size_t kstep = (size_t)(BK * 2);
    const size_t hstep = (size_t)HALF * K * 2;
    const size_t tstep = 2 * hstep;
    const unsigned ldsw = (unsigned)wid * 1024u;
    const int aoff = lds_byte(wr * 64 + fr, fq * 8), boff = lds_byte(wc * 32 + fr, fq * 8);
#define PG8_SA(b, h) (((b) * 2 + (h)) * HTB)
#define PG8_SB(b, h) ((4 + (b) * 2 + (h)) * HTB)
#define PG8_STAGE(bufoff, gbase, voff) do { _Pragma("unroll") for (int _i = 0; _i < 2; ++_i) \
        __builtin_amdgcn_global_load_lds((const unsigned*)((const char*)(gbase) + (voff)[_i]), (PG8_LAS unsigned*)(lds + (bufoff) + ldsw + _i * 8192), 16, 0, 0); } while (0)
#define PG8_LDA(dst, b, h) do { _Pragma("unroll") for (int m = 0; m < 4; ++m) _Pragma("unroll") for (int k = 0; k < 2; ++k) dst[m][k] = *(const PG8_LAS bf16x8*)(lds + PG8_SA(b, h) + aoff + m * 2048 + k * 1024); } while (0)
#define PG8_LDB(dst, b, h) do { _Pragma("unroll") for (int n = 0; n < 2; ++n) _Pragma("unroll") for (int k = 0; k < 2; ++k) dst[n][k] = *(const PG8_LAS bf16x8*)(lds + PG8_SB(b, h) + boff + n * 2048 + k * 1024); } while (0)
#define PG8_MMA(ai, bj, At, Bt) do { __builtin_amdgcn_s_setprio(1); _Pragma("unroll") for (int m = 0; m < 4; ++m) _Pragma("unroll") for (int n = 0; n < 2; ++n) _Pragma("unroll") for (int k = 0; k < 2; ++k) \
        acc[ai][bj][m][n] = __builtin_amdgcn_mfma_f32_16x16x32_bf16(Bt[n][k], At[m][k], acc[ai][bj][m][n], 0, 0, 0); __builtin_amdgcn_s_setprio(0); } while (0)
#define PG8_WAIT_V(n) asm volatile("s_waitcnt vmcnt(" #n ")" ::: "memory")
#define PG8_WAIT_L(n) asm volatile("s_waitcnt lgkmcnt(" #n ")" ::: "memory")
#define PG8_BAR __builtin_amdgcn_s_barrier()
#define PG8_SCHED __builtin_amdgcn_sched_barrier(0)
    Unit cur, nxt; int ui = 0;
    if (!S.next(0, cur)) return;
    f32x4 acc[2][2][4][2];
#pragma unroll
    for (int a = 0; a < 2; ++a)
#pragma unroll
        for (int b = 0; b < 2; ++b)
#pragma unroll
            for (int m = 0; m < 4; ++m)
#pragma unroll
                for (int n = 0; n < 2; ++n) acc[a][b][m][n] = (f32x4){0.f, 0.f, 0.f, 0.f};
    bf16x8 At[4][2], B0[2][2], B1[2][2];
    const char* cA = (const char*)g.A + (size_t)cur.pm * tstep; const char* cB = (const char*)g.Bt + (size_t)cur.pn * tstep;
    S.a_ready(cur);
    if constexpr (SP2) {
        PG8_STAGE(PG8_SB(0, 0), cB, voffB); PG8_STAGE(PG8_SB(0, 1), cB + hstep, voffB); PG8_STAGE(PG8_SA(0, 0), cA, voffA); PG8_STAGE(PG8_SA(0, 1), cA + hstep, voffA);
        if (wr == 1) PG8_BAR;
        PG8_WAIT_V(2); PG8_BAR;
        PG8_STAGE(PG8_SB(1, 0), cB + kstep, voffB); PG8_STAGE(PG8_SA(1, 0), cA + kstep, voffA); PG8_STAGE(PG8_SB(1, 1), cB + hstep + kstep, voffB);
        PG8_WAIT_V(6); PG8_BAR;
    } else {
        PG8_STAGE(PG8_SB(0, 0), cB, voffB); PG8_STAGE(PG8_SA(0, 0), cA, voffA); PG8_STAGE(PG8_SB(0, 1), cB + hstep, voffB); PG8_STAGE(PG8_SA(0, 1), cA + hstep, voffA);
        if (wr == 1) PG8_BAR;
        PG8_WAIT_V(4); PG8_BAR;
        PG8_STAGE(PG8_SB(1, 0), cB + kstep, voffB); PG8_STAGE(PG8_SA(1, 0), cA + kstep, voffA); PG8_STAGE(PG8_SB(1, 1), cB + hstep + kstep, voffB);
        PG8_WAIT_V(6); PG8_BAR;
    }
    for (;;) {
        const bool has_next = S.next(ui + 1, nxt);
        const char* nA = has_next ? (const char*)g.A + (size_t)nxt.pm * tstep : cA; const char* nB = has_next ? (const char*)g.Bt + (size_t)nxt.pn * tstep : cB;
        for (int t = 0; t < nt; t += 2) {
            const bool last = (t == nt - 2);
            const char* a1 = cA + (size_t)(t + 1) * kstep;
            const char* a2 = last ? nA : cA + (size_t)(t + 2) * kstep; const char* b2 = last ? nB : cB + (size_t)(t + 2) * kstep;
            const char* a3 = a2 + kstep; const char* b3 = b2 + kstep;
            if (last && has_next) S.a_ready(nxt);
            if constexpr (SP2) {
            PG8_LDB(B0, 0, 0); PG8_LDB(B1, 0, 1); PG8_SCHED; PG8_LDA(At, 0, 0); PG8_STAGE(PG8_SA(1, 1), a1 + hstep, voffA);
            PG8_WAIT_V(8); PG8_WAIT_L(0); PG8_BAR; PG8_MMA(0, 0, At, B0); PG8_MMA(0, 1, At, B1); PG8_BAR; PG8_SCHED;
            PG8_LDA(At, 0, 1); PG8_STAGE(PG8_SB(0, 0), b2, voffB); PG8_STAGE(PG8_SB(0, 1), b2 + hstep, voffB); PG8_STAGE(PG8_SA(0, 0), a2, voffA);
            PG8_WAIT_V(8); PG8_WAIT_L(0); PG8_BAR; PG8_MMA(1, 0, At, B0); PG8_MMA(1, 1, At, B1); PG8_BAR; PG8_SCHED;
            PG8_LDB(B0, 1, 0); PG8_LDB(B1, 1, 1); PG8_SCHED; PG8_LDA(At, 1, 0); PG8_STAGE(PG8_SA(0, 1), a2 + hstep, voffA);
            PG8_WAIT_V(8); PG8_WAIT_L(0); PG8_BAR; PG8_MMA(0, 0, At, B0); PG8_MMA(0, 1, At, B1); PG8_BAR; PG8_SCHED;
            PG8_LDA(At, 1, 1); PG8_STAGE(PG8_SB(1, 0), b3, voffB); PG8_STAGE(PG8_SB(1, 1), b3 + hstep, voffB); PG8_STAGE(PG8_SA(1, 0), a3, voffA);
            PG8_WAIT_V(8); PG8_WAIT_L(0); PG8_BAR; PG8_MMA(1, 0, At, B0); PG8_MMA(1, 1, At, B1); PG8_BAR; PG8_SCHED;
            } else {
            PG8_LDB(B0, 0, 0); PG8_SCHED; PG8_LDA(At, 0, 0); PG8_STAGE(PG8_SA(1, 1), a1 + hstep, voffA);
            PG8_WAIT_L(8); PG8_BAR; PG8_WAIT_L(0); PG8_MMA(0, 0, At, B0); PG8_BAR; PG8_SCHED;
            PG8_LDB(B1, 0, 1); PG8_STAGE(PG8_SB(0, 0), b2, voffB);
            PG8_BAR; PG8_WAIT_L(0); PG8_MMA(0, 1, At, B1); PG8_BAR;
            PG8_LDA(At, 0, 1); PG8_STAGE(PG8_SA(0, 0), a2, voffA);
            PG8_BAR; PG8_WAIT_L(0); PG8_MMA(1, 0, At, B0); PG8_BAR; PG8_SCHED;
            PG8_STAGE(PG8_SB(0, 1), b2 + hstep, voffB);
            PG8_WAIT_V(6); PG8_BAR; PG8_MMA(1, 1, At, B1); PG8_BAR;
            PG8_LDB(B0, 1, 0); PG8_SCHED; PG8_LDA(At, 1, 0); PG8_STAGE(PG8_SA(0, 1), a2 + hstep, voffA);
            PG8_WAIT_L(8); PG8_BAR; PG8_WAIT_L(0); PG8_MMA(0, 0, At, B0); PG8_BAR; PG8_SCHED;
            PG8_LDB(B1, 1, 1); PG8_STAGE(PG8_SB(1, 0), b3, voffB);
            PG8_BAR; PG8_WAIT_L(0); PG8_MMA(0, 1, At, B1); PG8_BAR;
            PG8_LDA(At, 1, 1); PG8_STAGE(PG8_SA(1, 0), a3, voffA);
            PG8_BAR; PG8_WAIT_L(0); PG8_MMA(1, 0, At, B0); PG8_BAR; PG8_SCHED;
            PG8_STAGE(PG8_SB(1, 1), b3 + hstep, voffB);
            PG8_WAIT_V(6); PG8_BAR; PG8_MMA(1, 1, At, B1); PG8_BAR;
            }
        }
        if constexpr (ALIGN_EPI) { if (wr == 0) PG8_BAR; }
        if constexpr (!Epi::AFTER_DRAIN) { for (int rpe_ = 0; rpe_ < REPE; ++rpe_) { E(acc, cur, wr, wc, fr, fq); asm volatile("" ::: "memory"); } S.done(cur); }
        if (!has_next) break;
#pragma unroll
        for (int a = 0; a < 2; ++a)
#pragma unroll
            for (int b = 0; b < 2; ++b)
#pragma unroll
                for (int m = 0; m < 4; ++m)
#pragma unroll
                    for (int n = 0; n < 2; ++n) acc[a][b][m][n] = (f32x4){0.f, 0.f, 0.f, 0.f};
        cur = nxt; cA = nA; cB = nB; ++ui;
        if constexpr (ALIGN_EPI) { if (wr == 1) PG8_BAR; }
    }
    PG8_WAIT_V(0);
    if constexpr (!ALIGN_EPI) { if (wr == 0) PG8_BAR; }
    PG8_BAR;
    if constexpr (Epi::AFTER_DRAIN) { E.fused(acc, cur, wr, wc, fr, fq, lds, wid, lane); S.done(cur); }
#undef PG8_SA
#undef PG8_SB
#undef PG8_STAGE
#undef PG8_LDA
#undef PG8_LDB
#undef PG8_MMA
#undef PG8_WAIT_V
#undef PG8_WAIT_L
#undef PG8_BAR
#undef PG8_SCHED
}
}
constexpr int DM = 2048, SEQ = 4096, TP = 8192, TS = 32, TT = TP + TS, MPAD = 8448;
constexpr int EVEN_IN = 6784, EVEN_INP = 6912, ODD_IN = 7168, LDH = 7168;
constexpr int EVEN_OUT = 1536, ODD_OUT = 2048;
constexpr float ALPHA = 1.6817928305074292f;
constexpr float LN_EPS = 1e-5f;
constexpr int EC_R = 0, EC_K = 768, EC_V = 1536, EC_HW = 2304, EC_HA = 2368, EC_GA = 2432, EC_QB = 3200, EC_KB = 3968, EC_VB = 4736, EC_GB = 5504, EC_QM = 5760, EC_GM = 6272;
constexpr int OC_Q = 0, OC_K = 1536, OC_V = 3072, OC_G = 4608, OC_QM = 6144, OC_GM = 6656;
constexpr size_t O_YP = 0, O_YS = 16777216, O_RWKV_P = O_YS + 65536, O_RWKV_S = O_RWKV_P + 196608, O_SH_P = O_RWKV_S + 786432, O_SH_S = O_SH_P + 9728,
    O_G0P = O_SH_S + 38912, O_G0S = O_G0P + 262144, O_G1P = O_G0S + 32768, O_G1S = O_G1P + 1048576, O_G2P = O_G1S + 32768, O_G2S = O_G2P + 4194304,
    O_RET_P = O_G2S + 32768, O_RET_S = O_RET_P + 1572864, O_MEM = O_RET_S + 6291456, O_END = O_MEM + 2097152;
constexpr size_t MiB = 1u << 20;
constexpr size_t WS_CTL = 0, WS_WTIN = 1 * MiB, WS_WTOUT = 29 * MiB, WS_WTMEM = 37 * MiB, WS_MEMB = 53 * MiB, WS_TAB = 55 * MiB, WS_XB = 60 * MiB, WS_XZ = 93 * MiB,
    WS_HB = 159 * MiB, WS_U = 275 * MiB, WS_YA = 308 * MiB, WS_PREP = 333 * MiB, WS_OG = 478 * MiB, WS_LSE = 478 * MiB + 49 * MiB / 2, WS_MKVB = 503 * MiB, WS_VT = 507 * MiB, WS_WTOUT2 = 509 * MiB, WS_END = 517 * MiB;
constexpr int LDS_BYTES = 147456;

#define LAS __attribute__((address_space(3)))
typedef unsigned short bf16;
typedef float f32x4 __attribute__((ext_vector_type(4)));
typedef short bf16x8 __attribute__((ext_vector_type(8)));
typedef unsigned u32x4 __attribute__((ext_vector_type(4)));
typedef unsigned u32x2 __attribute__((ext_vector_type(2)));

__device__ const double ANG[128] = {
1.0, 0.9300449458481392, 0.8649836012976682, 0.8044736266284181, 0.7481966305138833, 0.6958564947100448, 0.6471778159406796, 0.6019044567806663, 0.5597981979123284, 0.5206374846632574, 0.48421626123015066, 0.45034288645458387, 0.41883912544574814, 0.3895392117442728, 0.362288975092429, 0.336945030221216, 0.31337402238589046, 0.29145192568009903, 0.2710633904364836, 0.2521011362799124, 0.23446538763970548, 0.21806334875063282, 0.20280871538024622, 0.18862122071335174, 0.17542621300415914, 0.1631542627737973, 0.15174079748634942, 0.14112576178114528, 0.13125330147352265, 0.12207146966133185, 0.11353195339077617, 0.10558981944335787, 0.09820327790631257, 0.09133346228248625, 0.08494422498263796, 0.07900194712408967, 0.07347536163492155, 0.06833538873292307, 0.06355498291362295, 0.059108990642279875, 0.05497401800103736, 0.05112830759482943, 0.04755162406834012, 0.04422514763163046, 0.04113137503418572, 0.03825402746632876, 0.03557796490339495, 0.03308910644196496, 0.030774356208980617, 0.02862153445389273, 0.026619313461261302, 0.024757157946593413, 0.023025269621793302, 0.02141453563853956, 0.019916480638308563, 0.018523222156741202, 0.017227429147699425, 0.01602228340877477, 0.014901443705277463, 0.013859012403933875, 0.01288950444072537, 0.01198781845958378, 0.011149209970080915, 0.01036926638287344, 0.009643883791544459, 0.008969245378672715, 0.008341801332506338, 0.007758250168566794, 0.007215521357901014, 0.006710759170575141, 0.006241307649397462, 0.00580469663480544, 0.005398628767382501, 0.005020967399614466, 0.004669725353279709, 0.0043430544633167095, 0.0040392358531509045, 0.003756670890311596, 0.0034938727747491297, 0.0032494587155918425, 0.0030221426551783792, 0.002810728502080728, 0.002614103837511492, 0.002431234061999789, 0.002261156951536743, 0.002102977594546134, 0.0019558636830395095, 0.0018190411331788228, 0.0016917900122028363, 0.0015734407502856099, 0.0014633706173946357, 0.0013610004466105522, 0.001265791586667203, 0.001177243067676929, 0.001094888965127687, 0.0010182959482819048, 0.0009470610000772239, 0.0008808092965317064, 0.0008191922344953685, 0.0007618855973704613, 0.0007085878491488872, 0.0006590185477903263, 0.0006129168695925734, 0.0005700402367896359, 0.0005301630411562774, 0.000493075456902875, 0.00045858233661428085, 0.00042650218442334204, 0.0003966662010161199, 0.00036891739544382435, 0.0003431097590679882, 0.0003191074972923552, 0.00029678431503900375, 0.0002760227522090274, 0.00025671356563109924, 0.00023875515424585844, 0.00022205302450155334, 0.00020651929314796272, 0.00019207222481239299, 0.0001786358019245737, 0.00016613932472747905, 0.0001545170392694147, 0.0001437077914199376, 0.00013365470508911156, 0.00012430488295695166, 0.00011560912813835741, 0.00010752168531898921, 0.0001};
__device__ const float LG2G[6] = {-0.04580368961312479f, -0.02272007650008353f, -0.011315313227834146f, -0.005646563141142063f, -0.0028205190623786626f, -0.0014095702546713536f};

__device__ __forceinline__ float bf2f(unsigned b) { return __uint_as_float(b << 16); }
typedef __bf16 bf16x2_t __attribute__((ext_vector_type(2)));
typedef float f32x2_t __attribute__((ext_vector_type(2)));
__device__ __forceinline__ unsigned f2bf(float f) { return (unsigned)__builtin_bit_cast(unsigned short, (__bf16)f); }
__device__ __forceinline__ unsigned pk2(float lo, float hi) { const f32x2_t v = {lo, hi}; return __builtin_bit_cast(unsigned, __builtin_convertvector(v, bf16x2_t)); }
__device__ __forceinline__ void unpk4(u32x2 w, float (&x)[4]) { x[0] = __uint_as_float(w.x << 16); x[1] = __uint_as_float(w.x & 0xffff0000u); x[2] = __uint_as_float(w.y << 16); x[3] = __uint_as_float(w.y & 0xffff0000u); }
__device__ __forceinline__ void unpk8(u32x4 w, float (&x)[8]) {
    x[0] = __uint_as_float(w.x << 16); x[1] = __uint_as_float(w.x & 0xffff0000u); x[2] = __uint_as_float(w.y << 16); x[3] = __uint_as_float(w.y & 0xffff0000u);
    x[4] = __uint_as_float(w.z << 16); x[5] = __uint_as_float(w.z & 0xffff0000u); x[6] = __uint_as_float(w.w << 16); x[7] = __uint_as_float(w.w & 0xffff0000u); }
template <int CTRL> __device__ __forceinline__ float dppf(float x) { return __builtin_bit_cast(float, __builtin_amdgcn_update_dpp(0, __builtin_bit_cast(int, x), CTRL, 0xF, 0xF, true)); }
__device__ __forceinline__ float red16(float x) { x += dppf<0xB1>(x); x += dppf<0x4E>(x); x += dppf<0x141>(x); x += dppf<0x140>(x); return x; }
__device__ __forceinline__ float wave_sum(float x) { x = red16(x); x += __shfl_xor(x, 16); x += __shfl_xor(x, 32); return x; }
__device__ __forceinline__ float sigmoidf_(float x) { return 1.0f / (1.0f + __expf(-x)); }
__device__ __forceinline__ float siluf_(float x) { return x / (1.0f + __expf(-x)); }
#define LDS_WAIT() asm volatile("s_waitcnt lgkmcnt(0)" ::: "memory")

struct Args { const float* in[27]; float* out; unsigned char* ws; int ph_lo, ph_hi; };
typedef const __attribute__((address_space(4))) Args* ArgsP;
struct Ctx {
    ArgsP ap;
    LAS unsigned char* lds;
    int tid, lane, wave, bid, G;
};
#define C_IN(k) (c.ap->in[k])
#define C_OUT (c.ap->out)
#define C_WTIN_L(l_) (((l_) & 1) ? (bf16*)(c.ap->out + O_YP) : (bf16*)(c.ap->ws + WS_WTIN))
#define C_WTOUT_L(l_) ((bf16*)(c.ap->ws + (((l_) & 1) ? WS_WTOUT2 : WS_WTOUT)))
#define C_WTMEM ((bf16*)(c.ap->ws + WS_WTMEM))
#define C_MEMB ((bf16*)(c.ap->ws + WS_MEMB))
#define C_XB ((bf16*)(c.ap->ws + WS_XB))
#define C_HB ((bf16*)(c.ap->ws + WS_HB))
#define C_U ((bf16*)(c.ap->ws + WS_U))
#define C_TAB ((float*)(c.ap->ws + WS_TAB))
#define C_XZ ((float*)(c.ap->ws + WS_XZ))
#define C_YA ((float*)(c.ap->ws + WS_YA))
#define C_PREP ((float*)(c.ap->ws + WS_PREP))
#define C_CHK ((unsigned char*)(c.ap->ws + WS_PREP))
#define C_PREPS ((float*)(c.ap->ws + WS_PREP + 120 * MiB))
#define C_BONUS ((float*)(c.ap->ws + WS_PREP + 125 * MiB))
#define C_WUT ((bf16*)(c.ap->ws + WS_PREP + 126 * MiB))
#define C_AUT ((bf16*)(c.ap->ws + WS_PREP + 126 * MiB) + 2 * 768 * 64)
constexpr int CHK_BYTES = 40960, CK_A = 0, CK_RQ = 9216, CK_GT = 13824, CK_YVT = 31232;
#define C_YR ((float*)(c.ap->ws + WS_PREP))
#define C_Z ((float*)(c.ap->ws + WS_HB))
#define C_OG ((float*)(c.ap->ws + WS_OG))
#define C_LSE ((float*)(c.ap->ws + WS_LSE))
#define C_MKVB ((bf16*)(c.ap->ws + WS_MKVB))
#define C_VT ((bf16*)(c.ap->ws + WS_VT))

__device__ __forceinline__ void transpose_item(const float* W, int K, int N, bf16* WT, int row_off, LAS float* scr, int item, int lane) {
    const int nblk = N / 32, kb = item / nblk, nb = item % nblk, k0 = 64 * kb, n0 = 32 * nb;
    f32x4 wv[8];
#pragma unroll
    for (int i = 0; i < 8; ++i) { const int kk = 8 * i + (lane >> 3), c4 = 4 * (lane & 7); wv[i] = *(const f32x4*)(W + (size_t)(k0 + kk) * N + n0 + c4); }
#pragma unroll
    for (int i = 0; i < 8; ++i) { const int kk = 8 * i + (lane >> 3), c4 = 4 * (lane & 7); const f32x4 w4 = wv[i];
        scr[kk * 33 + c4] = w4.x; scr[kk * 33 + c4 + 1] = w4.y; scr[kk * 33 + c4 + 2] = w4.z; scr[kk * 33 + c4 + 3] = w4.w; }
    LDS_WAIT(); asm volatile("" ::: "memory");
    const int c = lane & 7;
#pragma unroll
    for (int j = 0; j < 4; ++j) { const int n = (lane >> 3) + 8 * j; const LAS float* s = scr + (8 * c) * 33 + n;
        u32x4 o; o.x = pk2(s[0 * 33], s[1 * 33]); o.y = pk2(s[2 * 33], s[3 * 33]); o.z = pk2(s[4 * 33], s[5 * 33]); o.w = pk2(s[6 * 33], s[7 * 33]);
        *(u32x4*)(WT + (size_t)(row_off + n0 + n) * K + k0 + 8 * c) = o; }
    LDS_WAIT(); asm volatile("" ::: "memory");
}
__device__ __forceinline__ void transpose_matrix(const Ctx& c, const float* W, int K, int N, bf16* WT, int row_off) {
    LAS float* scr = (LAS float*)(c.lds + c.wave * 16384);
    const int gw = c.bid * 8 + c.wave, NGW = c.G * 8, nitems = (K / 64) * (N / 32);
    for (int it = gw; it < nitems; it += NGW) transpose_item(W, K, N, WT, row_off, scr, it, c.lane);
}
__device__ __forceinline__ void convert_layer_weights(const Ctx& c, int l) {
    if ((l & 1) == 0) { const int e = l >> 1;
        transpose_matrix(c, C_IN(10) + (size_t)e * DM * EVEN_IN, DM, EVEN_IN, C_WTIN_L(l), 0);
        transpose_matrix(c, C_IN(11) + (size_t)e * EVEN_OUT * DM, EVEN_OUT, DM, C_WTOUT_L(l), 0);
        const int n16 = (EVEN_INP - EVEN_IN) * DM * 2 / 16; u32x4* p = (u32x4*)(C_WTIN_L(l) + (size_t)EVEN_IN * DM);
        for (int i = c.bid * 512 + c.tid; i < n16; i += c.G * 512) p[i] = (u32x4){0u, 0u, 0u, 0u};
    } else { const int o = l >> 1;
        transpose_matrix(c, C_IN(12) + (size_t)o * DM * ODD_IN, DM, ODD_IN, C_WTIN_L(l), 0);
        transpose_matrix(c, C_IN(13) + (size_t)o * ODD_OUT * DM, ODD_OUT, DM, C_WTOUT_L(l), 0);
    }
}

__device__ __forceinline__ void phase_prologue(const Ctx& c) {
    for (int l = 0; l < 4; ++l) transpose_matrix(c, C_IN(14) + (size_t)l * DM * 1024, DM, 1024, C_WTMEM, l * 1024);
    convert_layer_weights(c, 0);
    const int gt = c.bid * 512 + c.tid, NT = c.G * 512;
    for (int i = gt; i < 2 * 768 * 64; i += NT) { const int e = i / (768 * 64), rem = i % (768 * 64), col = rem >> 6, k = rem & 63;
        C_WUT[i] = (bf16)f2bf(C_IN(19)[((size_t)e * 64 + k) * 768 + col]); C_AUT[i] = (bf16)f2bf(C_IN(21)[((size_t)e * 64 + k) * 768 + col]); }
    for (int i = gt; i < 512 * DM / 4; i += NT) { const f32x4 v = ((const f32x4*)C_IN(9))[i]; ((u32x2*)C_MEMB)[i] = (u32x2){pk2(v.x, v.y), pk2(v.z, v.w)}; }
    for (int i = gt; i < MPAD * DM / 4; i += NT) {
        const int row = i / (DM / 4);
        f32x4 v = (f32x4){0.f, 0.f, 0.f, 0.f};
        if (row < TP) v = ((const f32x4*)C_IN(0))[i]; else if (row < TT) v = ((const f32x4*)C_IN(1))[i - TP * (DM / 4)];
        ((u32x2*)C_XB)[i] = (u32x2){pk2(v.x, v.y), pk2(v.z, v.w)};
    }
    for (int i = gt; i < 4100 * 128; i += NT) {
        const int p = i >> 7, ci = i & 127; const double pos = (double)(p < 4096 ? p : 16384 + (p - 4096));
        double ph = pos * ANG[ci];
        const double k = __builtin_rint(ph * 0.15915494309189535); ph = __builtin_fma(-k, 6.283185307179586, ph); ph = __builtin_fma(-k, 2.4492935982947064e-16, ph);
        const double q = __builtin_rint(ph * 0.6366197723675814); const double y = __builtin_fma(-q, 1.5707963267948966, ph) - q * 6.123233995736766e-17;
        const double y2 = y * y;
        const double sn = y * (1.0 + y2 * (-1.0 / 6 + y2 * (1.0 / 120 + y2 * (-1.0 / 5040 + y2 * (1.0 / 362880 + y2 * (-1.0 / 39916800 + y2 * (1.0 / 6227020800.0)))))));
        const double cs = 1.0 + y2 * (-0.5 + y2 * (1.0 / 24 + y2 * (-1.0 / 720 + y2 * (1.0 / 40320 + y2 * (-1.0 / 3628800 + y2 * (1.0 / 479001600.0 + y2 * (-1.0 / 87178291200.0)))))));
        const int qi = ((int)q) & 3; double co, si;
        if (qi == 0) { co = cs; si = sn; } else if (qi == 1) { co = -sn; si = cs; } else if (qi == 2) { co = -cs; si = -sn; } else { co = sn; si = -cs; }
        C_TAB[2 * i] = (float)co; C_TAB[2 * i + 1] = (float)si;
    }
}

__device__ __forceinline__ void rwkv_prep_item(const Ctx& c, int it, int e) {
    LAS float* lw = (LAS float*)c.lds;
    LAS float* la = lw + 16 * 64;
    const float* mu = C_IN(17) + e * 2432; const float* shift = C_IN(3) + (size_t)e * 8 * 2432;
    const int R0 = it * 16;
    for (int i = c.tid; i < 16 * 128; i += 512) {
        const int tk = i >> 7, cc = i & 127, R = R0 + tk; float val = 0.f;
        if (R < TT) { const int col = EC_HW + cc; const float hcur = bf2f(C_HB[(size_t)R * LDH + col]);
            float hprev;
            if (R < TP) hprev = ((R & (SEQ - 1)) == 0) ? 0.f : bf2f(C_HB[(size_t)(R - 1) * LDH + col]);
            else { const int n = (R - TP) >> 2, t = (R - TP) & 3; hprev = (t == 0) ? shift[n * 2432 + col] : bf2f(C_HB[(size_t)(R - 1) * LDH + col]); }
            const float hs = hcur + (hprev - hcur) * mu[col];
            val = (cc < 64) ? tanhf(hs) : hs; }
        if (cc < 64) lw[tk * 64 + cc] = val; else la[tk * 64 + (cc - 64)] = val;
    }
    __syncthreads();
    const int tl = c.tid & 255, tg = c.tid >> 8;
    const float* w_up = C_IN(19) + (size_t)e * 64 * 768; const float* a_up = C_IN(21) + (size_t)e * 64 * 768;
    const float* w0 = C_IN(18) + e * 768; const float* a0 = C_IN(20) + e * 768; const float* k_k = C_IN(22) + e * 768; const float* k_a = C_IN(23) + e * 768;
#pragma unroll 1
    for (int m = 0; m < 3; ++m) {
        const int col = tl + 256 * m, h = col >> 6, ci = col & 63;
        float xw[8], xa[8];
#pragma unroll
        for (int t = 0; t < 8; ++t) { xw[t] = 0.f; xa[t] = 0.f; }
#pragma unroll 4
        for (int kk = 0; kk < 64; ++kk) { const float wu = w_up[kk * 768 + col], au = a_up[kk * 768 + col];
#pragma unroll
            for (int t = 0; t < 8; ++t) { xw[t] += lw[(tg * 8 + t) * 64 + kk] * wu; xa[t] += la[(tg * 8 + t) * 64 + kk] * au; } }
        const float w0c = w0[col], a0c = a0[col], kkc = k_k[col], kac = k_a[col], mur = mu[EC_R + col], muk = mu[EC_K + col], muv = mu[EC_V + col];
#pragma unroll
        for (int t = 0; t < 8; ++t) {
            const int R = R0 + tg * 8 + t;
            if (R >= TT || R < TP) continue;
            const bf16* hc = C_HB + (size_t)R * LDH; float pr, pk, pv;
            const float cr = bf2f(hc[EC_R + col]), ck = bf2f(hc[EC_K + col]), cv = bf2f(hc[EC_V + col]);
            bool has_prev_row; int n = 0;
            if (R < TP) has_prev_row = (R & (SEQ - 1)) != 0; else { n = (R - TP) >> 2; has_prev_row = ((R - TP) & 3) != 0; }
            if (has_prev_row) { const bf16* hp = hc - LDH; pr = bf2f(hp[EC_R + col]); pk = bf2f(hp[EC_K + col]); pv = bf2f(hp[EC_V + col]); }
            else if (R < TP) { pr = 0.f; pk = 0.f; pv = 0.f; }
            else { const float* sp = shift + n * 2432; pr = sp[EC_R + col]; pk = sp[EC_K + col]; pv = sp[EC_V + col]; }
            const float r = cr + (pr - cr) * mur, k = ck + (pk - ck) * muk, v = cv + (pv - cv) * muv;
            const float decay = __expf(-0.6065306597126334f * sigmoidf_(w0c + xw[t]));
            const float a = sigmoidf_(a0c + xa[t]);
            float kk = k * kkc; const float ss = wave_sum(kk * kk); kk *= rsqrtf(fmaxf(ss, 1e-24f));
            const float k2 = k * (1.0f + (a - 1.0f) * kac);
            float* dst = C_PREPS + ((size_t)(R - TP) * 12 + h) * 384 + ci;
            dst[0] = r; dst[64] = decay; dst[128] = k2; dst[192] = v; dst[256] = -kk; dst[320] = kk * a;
        }
    }
    __syncthreads();
}

__device__ __forceinline__ void dil_attn_item(const Ctx& c, int R, int hh, int e) {
    const int lane = c.lane, kg = lane >> 4, dl = lane & 15;
    float m = -1e30f, l = 0.f, acc[4] = {0.f, 0.f, 0.f, 0.f};
    const bool is_p = R < TP; const int t = is_p ? (R & (SEQ - 1)) : ((R - TP) & 3); const int n = is_p ? 0 : ((R - TP) >> 2);
    const size_t rowbase = is_p ? (size_t)(R - t) : (size_t)(TP + n * 4);
#pragma unroll
    for (int g = 0; g < 3; ++g) {
        const int dil = (g == 0) ? 1 : (g == 1 ? 4 : 16), W = 128 * dil;
        float q[4]; { const u32x2 w = *(const u32x2*)(C_HB + (size_t)R * LDH + EC_QB + g * 256 + hh * 64 + 4 * dl); unpk4(w, q); }
#pragma unroll
        for (int i = 0; i < 4; ++i) q[i] *= 0.125f;
        const float* cache = ((g == 0) ? C_IN(4) : (g == 1 ? C_IN(5) : C_IN(6))) + ((size_t)(e * 8 + n) * W) * 512;
#pragma unroll 1
        for (int j0 = 0; j0 < 129; j0 += 4) {
            const int j = j0 + kg; bool valid = j < 129; float kf[4] = {0.f, 0.f, 0.f, 0.f}, vf[4] = {0.f, 0.f, 0.f, 0.f};
            if (is_p) { const int pos = t - dil * j; valid = valid && pos >= 0;
                if (valid) { const bf16* kp = C_HB + (rowbase + pos) * LDH + g * 256 + hh * 64 + 4 * dl; unpk4(*(const u32x2*)(kp + EC_KB), kf); unpk4(*(const u32x2*)(kp + EC_VB), vf); } }
            else if (valid) { const int idx = W + t - dil * j;
                if (idx >= W) { const bf16* kp = C_HB + (rowbase + (idx - W)) * LDH + g * 256 + hh * 64 + 4 * dl; unpk4(*(const u32x2*)(kp + EC_KB), kf); unpk4(*(const u32x2*)(kp + EC_VB), vf); }
                else { const float* kp = cache + (size_t)idx * 512 + hh * 64 + 4 * dl; const f32x4 k4 = *(const f32x4*)kp, v4 = *(const f32x4*)(kp + 256);
                    kf[0] = k4.x; kf[1] = k4.y; kf[2] = k4.z; kf[3] = k4.w; vf[0] = v4.x; vf[1] = v4.y; vf[2] = v4.z; vf[3] = v4.w; } }
            float s = q[0] * kf[0] + q[1] * kf[1] + q[2] * kf[2] + q[3] * kf[3];
            s = red16(s);
            if (valid) { const float mn = fmaxf(m, s), sc = __expf(m - mn), p = __expf(s - mn);
                l = l * sc + p;
#pragma unroll
                for (int i = 0; i < 4; ++i) acc[i] = acc[i] * sc + p * vf[i];
                m = mn; }
        }
    }
#pragma unroll
    for (int off = 16; off <= 32; off <<= 1) {
        const float m2 = __shfl_xor(m, off), l2 = __shfl_xor(l, off); float a2[4];
#pragma unroll
        for (int i = 0; i < 4; ++i) a2[i] = __shfl_xor(acc[i], off);
        const float mn = fmaxf(m, m2), s1 = __expf(m - mn), s2 = __expf(m2 - mn);
        l = l * s1 + l2 * s2;
#pragma unroll
        for (int i = 0; i < 4; ++i) acc[i] = acc[i] * s1 + a2[i] * s2;
        m = mn;
    }
    if (kg == 0) { float gt[4]; unpk4(*(const u32x2*)(C_HB + (size_t)R * LDH + EC_GB + hh * 64 + 4 * dl), gt);
        const float inv = 1.0f / l; float o[4];
#pragma unroll
        for (int i = 0; i < 4; ++i) o[i] = acc[i] * inv * siluf_(gt[i]);
        *(u32x2*)(C_U + (size_t)R * EVEN_OUT + 768 + hh * 64 + 4 * dl) = (u32x2){pk2(o[0], o[1]), pk2(o[2], o[3])}; }
}

__device__ __forceinline__ void mem_attn_item(const Ctx& c, int R, int mh, int l, int qcol, int gcol, int ucol, int ldu) {
    const int lane = c.lane, kg = lane >> 5, dl = lane & 31;
    const float* mkv;
    if (R < TP) mkv = C_OUT + O_MEM + ((size_t)l * 512 + (R >> 12) * 256) * 1024; else mkv = C_IN(8) + ((size_t)l * 8 + ((R - TP) >> 2)) * 256 * 1024;
    float q[4]; unpk4(*(const u32x2*)(C_HB + (size_t)R * LDH + qcol + mh * 128 + 4 * dl), q);
#pragma unroll
    for (int i = 0; i < 4; ++i) q[i] *= 0.08838834764831845f;
    float m = -1e30f, lsum = 0.f, acc[4] = {0.f, 0.f, 0.f, 0.f};
#pragma unroll 8
    for (int j0 = 0; j0 < 256; j0 += 2) {
        const float* kp = mkv + (size_t)(j0 + kg) * 1024 + mh * 128 + 4 * dl; const f32x4 k4 = *(const f32x4*)kp, v4 = *(const f32x4*)(kp + 512);
        float s = q[0] * k4.x + q[1] * k4.y + q[2] * k4.z + q[3] * k4.w;
        s = red16(s); s += __shfl_xor(s, 16);
        const float mn = fmaxf(m, s), sc = __expf(m - mn), p = __expf(s - mn);
        lsum = lsum * sc + p; acc[0] = acc[0] * sc + p * v4.x; acc[1] = acc[1] * sc + p * v4.y; acc[2] = acc[2] * sc + p * v4.z; acc[3] = acc[3] * sc + p * v4.w; m = mn;
    }
    { const float m2 = __shfl_xor(m, 32), l2 = __shfl_xor(lsum, 32); float a2[4];
#pragma unroll
        for (int i = 0; i < 4; ++i) a2[i] = __shfl_xor(acc[i], 32);
        const float mn = fmaxf(m, m2), s1 = __expf(m - mn), s2 = __expf(m2 - mn);
        lsum = lsum * s1 + l2 * s2;
#pragma unroll
        for (int i = 0; i < 4; ++i) acc[i] = acc[i] * s1 + a2[i] * s2; }
    if (kg == 0) { float gt[4]; unpk4(*(const u32x2*)(C_HB + (size_t)R * LDH + gcol + mh * 128 + 4 * dl), gt);
        const float inv = 1.0f / lsum; float o[4];
#pragma unroll
        for (int i = 0; i < 4; ++i) o[i] = acc[i] * inv * siluf_(gt[i]);
        *(u32x2*)(C_U + (size_t)R * ldu + ucol + mh * 128 + 4 * dl) = (u32x2){pk2(o[0], o[1]), pk2(o[2], o[3])}; }
}


typedef float f32x16 __attribute__((ext_vector_type(16)));
__device__ __forceinline__ f32x16 mfma32(bf16x8 a, bf16x8 b, f32x16 cacc) { return __builtin_amdgcn_mfma_f32_32x32x16_bf16(a, b, cacc, 0, 0, 0); }
__device__ __forceinline__ void mem_attn_mfma_item(const Ctx& c, int item, int l, int qcol, int gcol, int ucol, int ldu) {
    const int blk = item >> 2, mh = item & 3, R0 = blk * 32, b = R0 >> 12;
    const int lane = c.lane, r = lane & 31, hh = lane >> 5;
    const bf16* Kb = C_MKVB + ((size_t)l * 512 + b * 256) * 1024 + mh * 128 + 8 * hh;
    const bf16* Vt = C_VT + ((size_t)l * 512 + mh * 128) * 512 + b * 256 + 4 * hh;
    bf16x8 Qf[8];
    { const bf16* qp = C_HB + (size_t)(R0 + r) * LDH + qcol + mh * 128 + 8 * hh;
#pragma unroll
        for (int ks = 0; ks < 8; ++ks) Qf[ks] = *(const bf16x8*)(qp + 16 * ks); }
    f32x16 O[4];
#pragma unroll
    for (int dt = 0; dt < 4; ++dt)
#pragma unroll
        for (int i = 0; i < 16; ++i) O[dt][i] = 0.f;
    float m = -1e30f, lsum = 0.f;
    const float cs = 0.08838834764831845f * 1.4426950408889634f;
#pragma unroll 1
    for (int half = 0; half < 2; ++half) {
        f32x16 S[4];
#pragma unroll
        for (int kt = 0; kt < 4; ++kt) {
#pragma unroll
            for (int i = 0; i < 16; ++i) S[kt][i] = 0.f;
            const bf16* kp = Kb + (size_t)(128 * half + 32 * kt + r) * 1024;
#pragma unroll
            for (int ks = 0; ks < 8; ++ks) S[kt] = mfma32(*(const bf16x8*)(kp + 16 * ks), Qf[ks], S[kt]);
        }
        float mx = -1e30f;
#pragma unroll
        for (int kt = 0; kt < 4; ++kt)
#pragma unroll
            for (int i = 0; i < 16; ++i) mx = fmaxf(mx, S[kt][i]);
        mx = fmaxf(mx, __shfl_xor(mx, 32));
        const float mn = fmaxf(m, mx), sc = __builtin_amdgcn_exp2f((m - mn) * cs); m = mn;
        lsum *= sc;
#pragma unroll
        for (int dt = 0; dt < 4; ++dt)
#pragma unroll
            for (int i = 0; i < 16; ++i) O[dt][i] *= sc;
        float ps = 0.f;
#pragma unroll
        for (int kt = 0; kt < 4; ++kt)
#pragma unroll
            for (int i = 0; i < 16; ++i) { const float p = __builtin_amdgcn_exp2f((S[kt][i] - mn) * cs); S[kt][i] = p; ps += p; }
        lsum += ps;
#pragma unroll
        for (int kt = 0; kt < 4; ++kt)
#pragma unroll
            for (int s2 = 0; s2 < 2; ++s2) {
                const u32x4 pw = (u32x4){pk2(S[kt][8 * s2 + 0], S[kt][8 * s2 + 1]), pk2(S[kt][8 * s2 + 2], S[kt][8 * s2 + 3]), pk2(S[kt][8 * s2 + 4], S[kt][8 * s2 + 5]), pk2(S[kt][8 * s2 + 6], S[kt][8 * s2 + 7])};
                const bf16x8 Pf = __builtin_bit_cast(bf16x8, pw);
                const int kb = 128 * half + 32 * kt + 16 * s2;
#pragma unroll
                for (int dt = 0; dt < 4; ++dt) { const bf16* vp = Vt + (size_t)(32 * dt + r) * 512 + kb;
                    const u32x2 v0 = *(const u32x2*)vp, v1 = *(const u32x2*)(vp + 8); const u32x4 vw = (u32x4){v0.x, v0.y, v1.x, v1.y};
                    O[dt] = mfma32(__builtin_bit_cast(bf16x8, vw), Pf, O[dt]); }
            }
    }
    lsum += __shfl_xor(lsum, 32); const float inv = 1.0f / lsum;
    const bf16* gp = C_HB + (size_t)(R0 + r) * LDH + gcol + mh * 128 + 4 * hh; bf16* up = C_U + (size_t)(R0 + r) * ldu + ucol + mh * 128 + 4 * hh;
#pragma unroll
    for (int dt = 0; dt < 4; ++dt)
#pragma unroll
        for (int g4 = 0; g4 < 4; ++g4) { float gt[4]; unpk4(*(const u32x2*)(gp + 32 * dt + 8 * g4), gt);
            const float o0 = O[dt][4 * g4 + 0] * inv * siluf_(gt[0]), o1 = O[dt][4 * g4 + 1] * inv * siluf_(gt[1]), o2 = O[dt][4 * g4 + 2] * inv * siluf_(gt[2]), o3 = O[dt][4 * g4 + 3] * inv * siluf_(gt[3]);
            *(u32x2*)(up + 32 * dt + 8 * g4) = (u32x2){pk2(o0, o1), pk2(o2, o3)}; }
}
__device__ __forceinline__ void mem_attn_sample_block(const Ctx& c, int item, int l, int qcol, int gcol, int ucol, int ldu);
__device__ __forceinline__ void mem_attn_all(const Ctx& c, int l, int qcol, int gcol, int ucol, int ldu) {
    constexpr int NM = (TP / 32) * 4;
    { const int x = c.bid & 7, nbx = (c.G + 7 - x) >> 3, lb = c.bid >> 3, bb = x >> 2, mh = x & 3;
        for (int r = lb * 8 + c.wave; r < 128; r += nbx * 8) mem_attn_mfma_item(c, ((bb * 128 + r) << 2) | mh, l, qcol, gcol, ucol, ldu); }
    for (int it = c.bid; it < TS * 4; it += c.G) mem_attn_sample_block(c, it, l, qcol, gcol, ucol, ldu);
}

typedef short s16x4 __attribute__((ext_vector_type(4)));
__device__ __forceinline__ f32x4 mfma16(bf16x8 a, bf16x8 b, f32x4 cacc) { return __builtin_amdgcn_mfma_f32_16x16x32_bf16(a, b, cacc, 0, 0, 0); }
__device__ __forceinline__ bf16x8 tr_frag(const LAS bf16* p, int rowstride4) {
    const s16x4 a0 = __builtin_amdgcn_ds_read_tr16_b64_v4i16((LAS s16x4*)p), a1 = __builtin_amdgcn_ds_read_tr16_b64_v4i16((LAS s16x4*)(p + rowstride4));
    return (bf16x8){a0[0], a0[1], a0[2], a0[3], a1[0], a1[1], a1[2], a1[3]};
}
__device__ __forceinline__ void dil_attn_mfma_item(const Ctx& c, int item) {
    const int bh = item / 48, rem = item % 48, b = bh >> 2, hh = bh & 3, g = rem >> 4, idx16 = rem & 15;
    const int dil = 1 << (2 * g), nub = 16 >> (2 * g), rho = idx16 / nub, ub = idx16 % nub;
    LAS bf16* Kl = (LAS bf16*)c.lds;
    LAS bf16* Vl = Kl + 384 * 72;
    const int tid = c.tid, lane = c.lane, wave = c.wave, r = lane & 31, hl = lane >> 5;
    const int ubase = ub * 256 - 128;
    const bf16* hb = C_HB + (size_t)b * SEQ * LDH + g * 256 + hh * 64;
    u32x4 kwv[6], vwv[6];
#pragma unroll
    for (int pass = 0; pass < 6; ++pass) { const int kl = pass * 64 + (tid >> 3), part = tid & 7; int up = ubase + kl; up = up < 0 ? 0 : up;
        const bf16* src = hb + (size_t)(rho + dil * up) * LDH + 8 * part;
        kwv[pass] = *(const u32x4*)(src + EC_KB); vwv[pass] = *(const u32x4*)(src + EC_VB); }
    const int u0 = ub * 256 + 32 * wave;
    bf16x8 Qf[4];
    { const bf16* qp = hb + (size_t)(rho + dil * (u0 + r)) * LDH + EC_QB + 8 * hl;
#pragma unroll
        for (int ks = 0; ks < 4; ++ks) Qf[ks] = *(const bf16x8*)(qp + 16 * ks); }
#pragma unroll
    for (int pass = 0; pass < 6; ++pass) { const int kl = pass * 64 + (tid >> 3), part = tid & 7; *(LAS u32x4*)(Kl + kl * 72 + 8 * part) = kwv[pass]; *(LAS u32x4*)(Vl + kl * 72 + 8 * part) = vwv[pass]; }
    __syncthreads();
    f32x16 S[5];
#pragma unroll
    for (int kt = 0; kt < 5; ++kt) {
#pragma unroll
        for (int i = 0; i < 16; ++i) S[kt][i] = 0.f;
        const LAS bf16* kp = Kl + (32 * wave + 32 * kt + r) * 72 + 8 * hl;
#pragma unroll
        for (int ks = 0; ks < 4; ++ks) S[kt] = mfma32(*(const LAS bf16x8*)(kp + 16 * ks), Qf[ks], S[kt]);
    }
    float mx = -1e30f;
#pragma unroll
    for (int kt = 0; kt < 5; ++kt)
#pragma unroll
        for (int i = 0; i < 16; ++i) { const int kl = 32 * kt + (i & 3) + 8 * (i >> 2) + 4 * hl;
            const bool valid = (kl >= r) && (kl - 128 <= r) && (u0 - 128 + kl >= 0);
            const float sv = valid ? S[kt][i] : -1e30f; S[kt][i] = sv; mx = fmaxf(mx, sv); }
    mx = fmaxf(mx, __shfl_xor(mx, 32));
    const float cs = 0.125f * 1.4426950408889634f;
    float lsum = 0.f;
#pragma unroll
    for (int kt = 0; kt < 5; ++kt)
#pragma unroll
        for (int i = 0; i < 16; ++i) { const float p = __builtin_amdgcn_exp2f((S[kt][i] - mx) * cs); S[kt][i] = p; lsum += p; }
    lsum += __shfl_xor(lsum, 32);
    f32x16 O[2];
#pragma unroll
    for (int dt = 0; dt < 2; ++dt)
#pragma unroll
        for (int i = 0; i < 16; ++i) O[dt][i] = 0.f;
    const LAS bf16* vbase = Vl + (32 * wave + 4 * hl + ((lane & 15) >> 2)) * 72 + 16 * ((lane >> 4) & 1) + 4 * (lane & 3);
#pragma unroll
    for (int kt = 0; kt < 5; ++kt)
#pragma unroll
        for (int s2 = 0; s2 < 2; ++s2) {
            const u32x4 pw = (u32x4){pk2(S[kt][8 * s2 + 0], S[kt][8 * s2 + 1]), pk2(S[kt][8 * s2 + 2], S[kt][8 * s2 + 3]), pk2(S[kt][8 * s2 + 4], S[kt][8 * s2 + 5]), pk2(S[kt][8 * s2 + 6], S[kt][8 * s2 + 7])};
            const bf16x8 Pf = __builtin_bit_cast(bf16x8, pw);
#pragma unroll
            for (int dt = 0; dt < 2; ++dt) { const LAS bf16* vp = vbase + (32 * kt + 16 * s2) * 72 + 32 * dt;
                const s16x4 a0 = __builtin_amdgcn_ds_read_tr16_b64_v4i16((LAS s16x4*)vp), a1 = __builtin_amdgcn_ds_read_tr16_b64_v4i16((LAS s16x4*)(vp + 8 * 72));
                const bf16x8 Af = (bf16x8){a0[0], a0[1], a0[2], a0[3], a1[0], a1[1], a1[2], a1[3]};
                O[dt] = mfma32(Af, Pf, O[dt]); }
        }
    const float inv = 1.0f / lsum; const size_t R = (size_t)b * SEQ + rho + dil * (u0 + r);
    float* og = C_OG + ((size_t)g * TT + R) * 256 + hh * 64 + 4 * hl;
#pragma unroll
    for (int dt = 0; dt < 2; ++dt)
#pragma unroll
        for (int g4 = 0; g4 < 4; ++g4) *(f32x4*)(og + 32 * dt + 8 * g4) = (f32x4){O[dt][4 * g4 + 0] * inv, O[dt][4 * g4 + 1] * inv, O[dt][4 * g4 + 2] * inv, O[dt][4 * g4 + 3] * inv};
    if (hl == 0) C_LSE[((size_t)g * TT + R) * 4 + hh] = mx * 0.125f + __logf(lsum);
    __syncthreads();
}
__device__ __forceinline__ void dil_attn_sample_item(const Ctx& c, int sr, int hh, int e) {
    const int lane = c.lane, kg = lane >> 4, dl = lane & 15, R = TP + sr, n = sr >> 2, t = sr & 3;
    float m = -1e30f, l = 0.f, acc[4] = {0.f, 0.f, 0.f, 0.f};
#pragma unroll
    for (int g = 0; g < 3; ++g) {
        const int dil = (g == 0) ? 1 : (g == 1 ? 4 : 16), W = 128 * dil, jn = t / dil;
        float q[4]; unpk4(*(const u32x2*)(C_HB + (size_t)R * LDH + EC_QB + g * 256 + hh * 64 + 4 * dl), q);
#pragma unroll
        for (int i = 0; i < 4; ++i) q[i] *= 0.125f;
        { const int j = kg; const bool valid = j <= jn; const int tt = valid ? t - dil * j : t;
            const bf16* kp = C_HB + (size_t)(TP + n * 4 + tt) * LDH + g * 256 + hh * 64 + 4 * dl; float kf[4], vf[4]; unpk4(*(const u32x2*)(kp + EC_KB), kf); unpk4(*(const u32x2*)(kp + EC_VB), vf);
            float s = red16(q[0] * kf[0] + q[1] * kf[1] + q[2] * kf[2] + q[3] * kf[3]);
            if (valid) { const float mn = fmaxf(m, s), sc = __expf(m - mn), p = __expf(s - mn); l = l * sc + p;
#pragma unroll
                for (int i = 0; i < 4; ++i) acc[i] = acc[i] * sc + p * vf[i];
                m = mn; } }
        const float* cache = ((g == 0) ? C_IN(4) : (g == 1 ? C_IN(5) : C_IN(6))) + ((size_t)(e * 8 + n) * W) * 512 + hh * 64 + 4 * dl;
#pragma unroll 11
        for (int j0 = 0; j0 < 132; j0 += 4) { const int j = j0 + kg; const bool valid = (j > jn) && (j <= 128); const int idx = valid ? W + t - dil * j : 0;
            const float* kp = cache + (size_t)idx * 512; const f32x4 k4 = *(const f32x4*)kp, v4 = *(const f32x4*)(kp + 256);
            const float s = red16(q[0] * k4.x + q[1] * k4.y + q[2] * k4.z + q[3] * k4.w);
            if (valid) { const float mn = fmaxf(m, s), sc = __expf(m - mn), p = __expf(s - mn); l = l * sc + p;
                acc[0] = acc[0] * sc + p * v4.x; acc[1] = acc[1] * sc + p * v4.y; acc[2] = acc[2] * sc + p * v4.z; acc[3] = acc[3] * sc + p * v4.w; m = mn; } }
    }
#pragma unroll
    for (int off = 16; off <= 32; off <<= 1) {
        const float m2 = __shfl_xor(m, off), l2 = __shfl_xor(l, off); float a2[4];
#pragma unroll
        for (int i = 0; i < 4; ++i) a2[i] = __shfl_xor(acc[i], off);
        const float mn = fmaxf(m, m2), s1 = __expf(m - mn), s2 = __expf(m2 - mn);
        l = l * s1 + l2 * s2;
#pragma unroll
        for (int i = 0; i < 4; ++i) acc[i] = acc[i] * s1 + a2[i] * s2;
        m = mn;
    }
    if (kg == 0) { float gt[4]; unpk4(*(const u32x2*)(C_HB + (size_t)R * LDH + EC_GB + hh * 64 + 4 * dl), gt);
        const float inv = 1.0f / l; float o[4];
#pragma unroll
        for (int i = 0; i < 4; ++i) o[i] = acc[i] * inv * siluf_(gt[i]);
        *(u32x2*)(C_U + (size_t)R * EVEN_OUT + 768 + hh * 64 + 4 * dl) = (u32x2){pk2(o[0], o[1]), pk2(o[2], o[3])}; }
}


__device__ __forceinline__ void mem_attn_sample_block(const Ctx& c, int item, int l, int qcol, int gcol, int ucol, int ldu) {
    const int sr = item >> 2, mh = item & 3, R = TP + sr, lane = c.lane, kg = lane >> 5, dl = lane & 31, wave = c.wave;
    const float* mkv = C_IN(8) + ((size_t)l * 8 + (sr >> 2)) * 256 * 1024 + mh * 128 + 4 * dl;
    float q[4]; unpk4(*(const u32x2*)(C_HB + (size_t)R * LDH + qcol + mh * 128 + 4 * dl), q);
#pragma unroll
    for (int i = 0; i < 4; ++i) q[i] *= 0.08838834764831845f;
    float m = -1e30f, lsum = 0.f, acc[4] = {0.f, 0.f, 0.f, 0.f};
    f32x4 kv[16], vv[16];
#pragma unroll
    for (int jr = 0; jr < 16; ++jr) { const float* kp = mkv + (size_t)(32 * wave + 2 * jr + kg) * 1024; kv[jr] = *(const f32x4*)kp; vv[jr] = *(const f32x4*)(kp + 512); }
#pragma unroll
    for (int jr = 0; jr < 16; ++jr) { const f32x4 k4 = kv[jr], v4 = vv[jr];
        float s = q[0] * k4.x + q[1] * k4.y + q[2] * k4.z + q[3] * k4.w;
        s = red16(s); s += __shfl_xor(s, 16);
        const float mn = fmaxf(m, s), sc = __expf(m - mn), p = __expf(s - mn);
        lsum = lsum * sc + p; acc[0] = acc[0] * sc + p * v4.x; acc[1] = acc[1] * sc + p * v4.y; acc[2] = acc[2] * sc + p * v4.z; acc[3] = acc[3] * sc + p * v4.w; m = mn; }
    { const float m2 = __shfl_xor(m, 32), l2 = __shfl_xor(lsum, 32); float a2[4];
#pragma unroll
        for (int i = 0; i < 4; ++i) a2[i] = __shfl_xor(acc[i], 32);
        const float mn = fmaxf(m, m2), s1 = __expf(m - mn), s2 = __expf(m2 - mn);
        lsum = lsum * s1 + l2 * s2; m = mn;
#pragma unroll
        for (int i = 0; i < 4; ++i) acc[i] = acc[i] * s1 + a2[i] * s2; }
    LAS float* part = (LAS float*)c.lds;
    if (kg == 0) { LAS float* pp = part + (wave * 32 + dl) * 6; pp[0] = m; pp[1] = lsum; pp[2] = acc[0]; pp[3] = acc[1]; pp[4] = acc[2]; pp[5] = acc[3]; }
    __syncthreads();
    if (wave == 0 && kg == 0) {
        float M = -1e30f, Lr = 0.f, A[4] = {0.f, 0.f, 0.f, 0.f};
#pragma unroll
        for (int w = 0; w < 8; ++w) { const LAS float* pp = part + (w * 32 + dl) * 6; const float m2 = pp[0], mn = fmaxf(M, m2), s1 = __expf(M - mn), s2 = __expf(m2 - mn);
            Lr = Lr * s1 + pp[1] * s2; A[0] = A[0] * s1 + pp[2] * s2; A[1] = A[1] * s1 + pp[3] * s2; A[2] = A[2] * s1 + pp[4] * s2; A[3] = A[3] * s1 + pp[5] * s2; M = mn; }
        float gt[4]; unpk4(*(const u32x2*)(C_HB + (size_t)R * LDH + gcol + mh * 128 + 4 * dl), gt);
        const float inv = 1.0f / Lr;
        *(u32x2*)(C_U + (size_t)R * ldu + ucol + mh * 128 + 4 * dl) = (u32x2){pk2(A[0] * inv * siluf_(gt[0]), A[1] * inv * siluf_(gt[1])), pk2(A[2] * inv * siluf_(gt[2]), A[3] * inv * siluf_(gt[3]))}; }
    __syncthreads();
}
__device__ __forceinline__ void dil_attn_sample_block(const Ctx& c, int item, int e) {
    const int sr = item >> 2, hh = item & 3, lane = c.lane, kg = lane >> 4, dl = lane & 15, wave = c.wave, R = TP + sr, n = sr >> 2, t = sr & 3;
    float m = -1e30f, l = 0.f, acc[4] = {0.f, 0.f, 0.f, 0.f};
#pragma unroll
    for (int g = 0; g < 3; ++g) {
        const int dil = (g == 0) ? 1 : (g == 1 ? 4 : 16), W = 128 * dil, jn = t / dil;
        float q[4]; unpk4(*(const u32x2*)(C_HB + (size_t)R * LDH + EC_QB + g * 256 + hh * 64 + 4 * dl), q);
#pragma unroll
        for (int i = 0; i < 4; ++i) q[i] *= 0.125f;
        if (wave == 0) { const int j = kg; const bool valid = j <= jn; const int tt = valid ? t - dil * j : t;
            const bf16* kp = C_HB + (size_t)(TP + n * 4 + tt) * LDH + g * 256 + hh * 64 + 4 * dl; float kf[4], vf[4]; unpk4(*(const u32x2*)(kp + EC_KB), kf); unpk4(*(const u32x2*)(kp + EC_VB), vf);
            float s = red16(q[0] * kf[0] + q[1] * kf[1] + q[2] * kf[2] + q[3] * kf[3]);
            if (valid) { const float mn = fmaxf(m, s), sc = __expf(m - mn), p = __expf(s - mn); l = l * sc + p;
#pragma unroll
                for (int i = 0; i < 4; ++i) acc[i] = acc[i] * sc + p * vf[i];
                m = mn; } }
        const float* cache = ((g == 0) ? C_IN(4) : (g == 1 ? C_IN(5) : C_IN(6))) + ((size_t)(e * 8 + n) * W) * 512 + hh * 64 + 4 * dl;
        f32x4 kv[5], vv[5]; bool ok[5];
#pragma unroll
        for (int jr = 0; jr < 5; ++jr) { const int jo = 4 * jr + kg, j = 17 * wave + jo; ok[jr] = (jo < 17) && (j > jn) && (j <= 128); const int idx = ok[jr] ? W + t - dil * j : 0;
            const float* kp = cache + (size_t)idx * 512; kv[jr] = *(const f32x4*)kp; vv[jr] = *(const f32x4*)(kp + 256); }
#pragma unroll
        for (int jr = 0; jr < 5; ++jr) { const f32x4 k4 = kv[jr], v4 = vv[jr];
            const float s = red16(q[0] * k4.x + q[1] * k4.y + q[2] * k4.z + q[3] * k4.w);
            if (ok[jr]) { const float mn = fmaxf(m, s), sc = __expf(m - mn), p = __expf(s - mn); l = l * sc + p;
                acc[0] = acc[0] * sc + p * v4.x; acc[1] = acc[1] * sc + p * v4.y; acc[2] = acc[2] * sc + p * v4.z; acc[3] = acc[3] * sc + p * v4.w; m = mn; } }
    }
#pragma unroll
    for (int off = 16; off <= 32; off <<= 1) {
        const float m2 = __shfl_xor(m, off), l2 = __shfl_xor(l, off); float a2[4];
#pragma unroll
        for (int i = 0; i < 4; ++i) a2[i] = __shfl_xor(acc[i], off);
        const float mn = fmaxf(m, m2), s1 = __expf(m - mn), s2 = __expf(m2 - mn);
        l = l * s1 + l2 * s2;
#pragma unroll
        for (int i = 0; i < 4; ++i) acc[i] = acc[i] * s1 + a2[i] * s2;
        m = mn;
    }
    LAS float* part = (LAS float*)c.lds;
    if (kg == 0) { LAS float* pp = part + (wave * 16 + dl) * 6; pp[0] = m; pp[1] = l; pp[2] = acc[0]; pp[3] = acc[1]; pp[4] = acc[2]; pp[5] = acc[3]; }
    __syncthreads();
    if (wave == 0 && kg == 0) {
        float M = -1e30f, Lr = 0.f, A[4] = {0.f, 0.f, 0.f, 0.f};
#pragma unroll
        for (int w = 0; w < 8; ++w) { const LAS float* pp = part + (w * 16 + dl) * 6; const float m2 = pp[0], mn = fmaxf(M, m2), s1 = __expf(M - mn), s2 = __expf(m2 - mn);
            Lr = Lr * s1 + pp[1] * s2; A[0] = A[0] * s1 + pp[2] * s2; A[1] = A[1] * s1 + pp[3] * s2; A[2] = A[2] * s1 + pp[4] * s2; A[3] = A[3] * s1 + pp[5] * s2; M = mn; }
        float gt[4]; unpk4(*(const u32x2*)(C_HB + (size_t)R * LDH + EC_GB + hh * 64 + 4 * dl), gt);
        const float inv = 1.0f / Lr;
        *(u32x2*)(C_U + (size_t)R * EVEN_OUT + 768 + hh * 64 + 4 * dl) = (u32x2){pk2(A[0] * inv * siluf_(gt[0]), A[1] * inv * siluf_(gt[1])), pk2(A[2] * inv * siluf_(gt[2]), A[3] * inv * siluf_(gt[3]))}; }
    __syncthreads();
}

__device__ __forceinline__ void even_copies(const Ctx& c, int e) {
    const int gt = c.bid * 512 + c.tid, NT = c.G * 512;
    for (int i = gt; i < 10 * 304; i += NT) { const int rw = i / 304, c8 = 8 * (i % 304);
        const size_t src = (rw < 2) ? (size_t)(rw * SEQ + SEQ - 1) : (size_t)(TP + (rw - 2) * 4 + 3);
        float x[8]; unpk8(*(const u32x4*)(C_HB + src * LDH + c8), x);
        float* dst = (rw < 2) ? C_OUT + O_SH_P + ((size_t)e * 2 + rw) * 2432 + c8 : C_OUT + O_SH_S + ((size_t)e * 8 + (rw - 2)) * 2432 + c8;
        *(f32x4*)dst = (f32x4){x[0], x[1], x[2], x[3]}; *(f32x4*)(dst + 4) = (f32x4){x[4], x[5], x[6], x[7]}; }
#pragma unroll 1
    for (int g = 0; g < 3; ++g) {
        const int keep = 128 << (2 * g); const size_t op = (g == 0) ? O_G0P : (g == 1 ? O_G1P : O_G2P), os = (g == 0) ? O_G0S : (g == 1 ? O_G1S : O_G2S);
        for (int i = gt; i < 2 * keep * 64; i += NT) { const int pc = i & 63, r = (i >> 6) % keep, b = (i >> 6) / keep;
            const int col = ((pc & 32) ? EC_VB : EC_KB) + g * 256 + 8 * (pc & 31);
            float x[8]; unpk8(*(const u32x4*)(C_HB + (size_t)(b * SEQ + SEQ - keep + r) * LDH + col), x);
            float* dst = C_OUT + op + ((size_t)e * 2 * keep + (size_t)b * keep + r) * 512 + 8 * pc;
            *(f32x4*)dst = (f32x4){x[0], x[1], x[2], x[3]}; *(f32x4*)(dst + 4) = (f32x4){x[4], x[5], x[6], x[7]}; }
        for (int i = gt; i < 8 * 4 * 64; i += NT) { const int pc = i & 63, row = i >> 6;
            const int col = ((pc & 32) ? EC_VB : EC_KB) + g * 256 + 8 * (pc & 31);
            float x[8]; unpk8(*(const u32x4*)(C_HB + (size_t)(TP + row) * LDH + col), x);
            float* dst = C_OUT + os + ((size_t)e * 32 + row) * 512 + 8 * pc;
            *(f32x4*)dst = (f32x4){x[0], x[1], x[2], x[3]}; *(f32x4*)(dst + 4) = (f32x4){x[4], x[5], x[6], x[7]}; }
    }
}

#define LAUNDER_C(c) do { asm volatile("" : "+s"((c).ap), "+v"((c).tid), "+s"((c).bid), "+s"((c).G)); (c).lane = (c).tid & 63; (c).wave = __builtin_amdgcn_readfirstlane((c).tid >> 6); } while (0)
__device__ __forceinline__ void phase_even_tok_pre(Ctx c, int l);
__device__ __forceinline__ void even_helper_work(Ctx c, int l) {
    const int e = l >> 1;
    for (int rp = 0; rp < REPD; ++rp) { for (int it = c.bid; it < 384; it += c.G) dil_attn_mfma_item(c, it);
    LAUNDER_C(c); }
    for (int it = c.G - 1 - c.bid; it < TS * 4; it += c.G) dil_attn_sample_block(c, it, e);
    LAUNDER_C(c);
    for (int rp = 0; rp < REPM; ++rp) { mem_attn_all(c, l, EC_QM, EC_GM, 1024, EVEN_OUT);
    LAUNDER_C(c); }
    even_copies(c, e);
    LAUNDER_C(c);
    for (int rp = 0; rp < REPC; ++rp) { if (l < 3) convert_layer_weights(c, l + 1); LAUNDER_C(c); }
}

__device__ __forceinline__ void rwkv_scan_item(const Ctx& c, int item, int e) {
    constexpr int CH = 32;
    LAS float* buf = (LAS float*)c.lds;
    LAS float* ybuf = buf + 2 * CH * 384;
    const bool is_p = item < 48; const int st = is_p ? (item >> 1) : ((item - 48) >> 1), half = item & 1;
    const int h = st % 12, bn = st / 12; const int T = is_p ? SEQ : 4; const size_t tok0 = is_p ? (size_t)bn * SEQ : (size_t)(TP + bn * 4);
    const int lane = c.lane, rw = lane >> 4, cgp = lane & 15, il = 4 * c.wave + rw, i = 32 * half + il;
    float s[4];
    if (is_p) { s[0] = s[1] = s[2] = s[3] = 0.f; }
    else { const f32x4 v = *(const f32x4*)(C_IN(2) + ((((size_t)e * 8 + bn) * 12 + h) * 64 + i) * 64 + 4 * cgp); s[0] = v.x; s[1] = v.y; s[2] = v.z; s[3] = v.w; }
    const int nch = (T + CH - 1) / CH;
    f32x4 pre[6];
#define SCAN_GLOAD(ch_) do { _Pragma("unroll") for (int k = 0; k < 6; ++k) { const int idx = c.tid + 512 * k, tl_ = idx / 96, f4 = idx % 96; const int tk = (ch_) * CH + tl_; \
            pre[k] = (tk < T) ? *(const f32x4*)(C_PREPS + ((tok0 - TP + tk) * 12 + h) * 384 + 4 * f4) : (f32x4){0.f, 0.f, 0.f, 0.f}; } } while (0)
#define SCAN_LSTORE(bi_) do { _Pragma("unroll") for (int k = 0; k < 6; ++k) { const int idx = c.tid + 512 * k; *(LAS f32x4*)(buf + (bi_) * CH * 384 + 4 * idx) = pre[k]; } } while (0)
    SCAN_GLOAD(0); SCAN_LSTORE(0); __syncthreads();
#pragma unroll 1
    for (int ch = 0; ch < nch; ++ch) {
        if (ch + 1 < nch) SCAN_GLOAD(ch + 1);
        const LAS float* bb = buf + (ch & 1) * CH * 384;
        const int nt = (T - ch * CH) < CH ? (T - ch * CH) : CH;
#pragma unroll 2
        for (int tl = 0; tl < nt; ++tl) {
            const LAS float* p = bb + tl * 384;
            const f32x4 r4 = *(const LAS f32x4*)(p + 4 * cgp), d4 = *(const LAS f32x4*)(p + 64 + 4 * cgp), k4 = *(const LAS f32x4*)(p + 128 + 4 * cgp),
                        kk4 = *(const LAS f32x4*)(p + 256 + 4 * cgp), b4 = *(const LAS f32x4*)(p + 320 + 4 * cgp);
            const float vi = p[192 + i];
            float sa = s[0] * kk4.x + s[1] * kk4.y + s[2] * kk4.z + s[3] * kk4.w;
            sa = red16(sa);
            s[0] = s[0] * d4.x + (sa * b4.x + vi * k4.x); s[1] = s[1] * d4.y + (sa * b4.y + vi * k4.y);
            s[2] = s[2] * d4.z + (sa * b4.z + vi * k4.z); s[3] = s[3] * d4.w + (sa * b4.w + vi * k4.w);
            float y = s[0] * r4.x + s[1] * r4.y + s[2] * r4.z + s[3] * r4.w;
            y = red16(y);
            if (cgp == 0) ybuf[tl * 32 + il] = y;
        }
        __syncthreads();
        if (ch + 1 < nch) SCAN_LSTORE((ch + 1) & 1);
        for (int idx = c.tid; idx < nt * 32; idx += 512) { const int tl = idx >> 5, r = idx & 31; C_YA[(tok0 + ch * CH + tl) * 768 + h * 64 + 32 * half + r] = ybuf[idx]; }
        __syncthreads();
    }
    float* so = C_OUT + (is_p ? O_RWKV_P + (((size_t)e * 2 + bn) * 12 + h) * 4096 : O_RWKV_S + (((size_t)e * 8 + bn) * 12 + h) * 4096) + (size_t)i * 64 + 4 * cgp;
    *(f32x4*)so = (f32x4){s[0], s[1], s[2], s[3]};
}

typedef float f32x2 __attribute__((ext_vector_type(2)));
__device__ __forceinline__ void rwkv_scan_prompt(const Ctx& c, int item, int e) {
    constexpr int CH = 32, NCH = SEQ / CH;
    LAS float* buf = (LAS float*)c.lds;
    LAS float* ybuf = buf + 2 * CH * 384;
    const int st = item >> 1, half = item & 1, h = st % 12, bn = st / 12; const size_t tok0 = (size_t)bn * SEQ;
    const int lane = c.lane, rw = lane >> 4, cgp = lane & 15, il = 4 * c.wave + rw, i = 32 * half + il;
    f32x2 s01 = (f32x2){0.f, 0.f}, s23 = (f32x2){0.f, 0.f};
    const float* src = C_PREP + (tok0 * 12 + h) * 384;
    float* ya = C_YA + tok0 * 768 + h * 64 + 32 * half;
    f32x4 pre[6];
#define SP_GLOAD(ch_) do { _Pragma("unroll") for (int k = 0; k < 6; ++k) { const int idx = c.tid + 512 * k, tl_ = idx / 96, f4 = idx % 96; \
        pre[k] = *(const f32x4*)(src + (size_t)((ch_) * CH + tl_) * (12 * 384) + 4 * f4); } } while (0)
#define SP_LSTORE(bi_) do { _Pragma("unroll") for (int k = 0; k < 6; ++k) { const int idx = c.tid + 512 * k; *(LAS f32x4*)(buf + (bi_) * CH * 384 + 4 * idx) = pre[k]; } } while (0)
#define SP_YOUT(ch_) do { for (int idx = c.tid; idx < CH * 32; idx += 512) { const int tl_ = idx >> 5, r_ = idx & 31; ya[(size_t)((ch_) * CH + tl_) * 768 + r_] = ybuf[((ch_) & 1) * CH * 32 + idx]; } } while (0)
    SP_GLOAD(0); SP_LSTORE(0); SP_GLOAD(1); __syncthreads();
#pragma unroll 1
    for (int ch = 0; ch < NCH; ++ch) {
        if (ch + 1 < NCH) SP_LSTORE((ch + 1) & 1);
        if (ch + 2 < NCH) SP_GLOAD(ch + 2);
        if (ch > 0) SP_YOUT(ch - 1);
        const LAS float* bb = buf + (ch & 1) * CH * 384 + 4 * cgp; const LAS float* vb = buf + (ch & 1) * CH * 384 + 192 + i;
        LAS float* yw = (cgp == 0) ? (ybuf + (ch & 1) * CH * 32 + il) : (ybuf + 2 * CH * 32 + lane);
        f32x4 r4 = *(const LAS f32x4*)bb, d4 = *(const LAS f32x4*)(bb + 64), k4 = *(const LAS f32x4*)(bb + 128), n4 = *(const LAS f32x4*)(bb + 256), b4 = *(const LAS f32x4*)(bb + 320); float vi = vb[0];
        float sa;
        { f32x2 p = s01 * (f32x2){n4.x, n4.y}; p = s23 * (f32x2){n4.z, n4.w} + p; sa = red16(p.x + p.y); }
#pragma unroll 4
        for (int tl = 0; tl < CH; ++tl) {
            const int tn = (tl + 1 < CH) ? tl + 1 : tl;
            const f32x4 r4n = *(const LAS f32x4*)(bb + tn * 384), d4n = *(const LAS f32x4*)(bb + tn * 384 + 64), k4n = *(const LAS f32x4*)(bb + tn * 384 + 128),
                        n4n = *(const LAS f32x4*)(bb + tn * 384 + 256), b4n = *(const LAS f32x4*)(bb + tn * 384 + 320); const float vin = vb[tn * 384];
            const f32x2 vi2 = (f32x2){vi, vi}, sa2 = (f32x2){sa, sa};
            const f32x2 u01 = s01 * (f32x2){d4.x, d4.y} + vi2 * (f32x2){k4.x, k4.y}, u23 = s23 * (f32x2){d4.z, d4.w} + vi2 * (f32x2){k4.z, k4.w};
            s01 = sa2 * (f32x2){b4.x, b4.y} + u01; s23 = sa2 * (f32x2){b4.z, b4.w} + u23;
            f32x2 yp = s01 * (f32x2){r4.x, r4.y}; yp = s23 * (f32x2){r4.z, r4.w} + yp;
            f32x2 pn = s01 * (f32x2){n4n.x, n4n.y}; pn = s23 * (f32x2){n4n.z, n4n.w} + pn;
            float ya_ = yp.x + yp.y, sb_ = pn.x + pn.y;
            sb_ += dppf<0xB1>(sb_); ya_ += dppf<0xB1>(ya_); sb_ += dppf<0x4E>(sb_); ya_ += dppf<0x4E>(ya_);
            sb_ += dppf<0x141>(sb_); ya_ += dppf<0x141>(ya_); sb_ += dppf<0x140>(sb_); ya_ += dppf<0x140>(ya_);
            sa = sb_;
            yw[tl * 32] = ya_;
            r4 = r4n; d4 = d4n; k4 = k4n; n4 = n4n; b4 = b4n; vi = vin;
        }
        __syncthreads();
    }
    SP_YOUT(NCH - 1);
    float* so = C_OUT + O_RWKV_P + (((size_t)e * 2 + bn) * 12 + h) * 4096 + (size_t)i * 64 + 4 * cgp;
    *(f32x4*)so = (f32x4){s01.x, s01.y, s23.x, s23.y};
    __syncthreads();
#undef SP_GLOAD
#undef SP_LSTORE
#undef SP_YOUT
}

struct PreIn { u32x2 cr, ck, cv, pr, pk, pv; float hcur[8], hprv[8]; };
__device__ __forceinline__ void rwkv_chunk_preload(const Ctx& c, int item, int e, PreIn& P) {
    const bool is_s = item >= 3072; const int sidx = item - 3072;
    const int bh = item >> 7, n = is_s ? 1 : (item & 127), b = bh / 12, h = is_s ? (sidx % 12) : (bh % 12), ns = sidx / 12;
    const size_t R0 = is_s ? (size_t)(TP + 4 * ns) : (size_t)b * SEQ + 32 * n;
    const float* shift = C_IN(3) + ((size_t)e * 8 + ns) * 2432;
    const int tid = c.tid, t_ = tid >> 4, c4 = 4 * (tid & 15), col = h * 64 + c4;
    const bf16* hc = C_HB + (R0 + t_) * LDH + col; const bool hasprev = is_s ? (t_ != 0) : ((32 * n + t_) != 0);
    const u32x2 z2 = (u32x2){0u, 0u};
    P.cr = *(const u32x2*)(hc + EC_R); P.ck = *(const u32x2*)(hc + EC_K); P.cv = *(const u32x2*)(hc + EC_V);
    P.pr = hasprev ? *(const u32x2*)(hc - LDH + EC_R) : z2; P.pk = hasprev ? *(const u32x2*)(hc - LDH + EC_K) : z2; P.pv = hasprev ? *(const u32x2*)(hc - LDH + EC_V) : z2;
    const int cc = tid & 127, cl = EC_HW + cc, tb = tid >> 7;
#pragma unroll
    for (int k = 0; k < 8; ++k) { const int t = tb + 4 * k; P.hcur[k] = bf2f(C_HB[(R0 + t) * LDH + cl]);
        P.hprv[k] = is_s ? (t != 0 ? bf2f(C_HB[(R0 + t - 1) * LDH + cl]) : shift[cl]) : (((32 * n + t) != 0) ? bf2f(C_HB[(R0 + t - 1) * LDH + cl]) : 0.f); }
}
__device__ __forceinline__ void rwkv_chunk_precompute(const Ctx& c, int item, int e, const PreIn& P) {
    const bool is_s = item >= 3072; const int sidx = item - 3072;
    const int bh = item >> 7, n = is_s ? 1 : (item & 127), b = bh / 12, h = is_s ? (sidx % 12) : (bh % 12), ns = sidx / 12, ntok = is_s ? 4 : 32;
    const size_t R0 = is_s ? (size_t)(TP + 4 * ns) : (size_t)b * SEQ + 32 * n;
    const float* shift = C_IN(3) + ((size_t)e * 8 + ns) * 2432;
    LAS unsigned char* L = c.lds;
    LAS float* XW = (LAS float*)(L + 0); LAS float* XA = (LAS float*)(L + 8192);
    LAS bf16* LW = (LAS bf16*)(L + 16384); LAS bf16* LA = (LAS bf16*)(L + 20992);
    LAS float* PS = (LAS float*)(L + 25600);
    LAS bf16* KKt = (LAS bf16*)(L + 33792); LAS bf16* Bt = (LAS bf16*)(L + 38400); LAS bf16* Kt = (LAS bf16*)(L + 43008); LAS bf16* Rt = (LAS bf16*)(L + 47616);
    LAS bf16* Bh = (LAS bf16*)(L + 52224); LAS bf16* Kh = (LAS bf16*)(L + 56832); LAS bf16* Vb = (LAS bf16*)(L + 61440);
    LAS float* LB = (LAS float*)(L + 66048);
    LAS bf16* Lk = (LAS bf16*)(L + 70144); LAS bf16* Mb = (LAS bf16*)(L + 72704); LAS bf16* Mk = (LAS bf16*)(L + 75264);
    LAS float* SOL = (LAS float*)(L + 77824);
    LAS bf16* KTb = (LAS bf16*)(L + 94208); LAS bf16* UVb = (LAS bf16*)(L + 98816);
    LAS float* RTf = (LAS float*)(L + 103424); LAS float* c31 = (LAS float*)(L + 111616);
    const int tid = c.tid, lane = c.lane, wave = c.wave, fr = lane & 15, fq = lane >> 4, trow = (lane & 15) >> 2, tcol = 4 * (lane & 3);
    const int t_ = tid >> 4, c4 = 4 * (tid & 15), col = h * 64 + c4;
    const float* mu = C_IN(17) + e * 2432;
    const bf16* hc = C_HB + (R0 + t_) * LDH + col; const bool hasprev = is_s ? (t_ != 0) : ((32 * n + t_) != 0);
    const u32x2 cr = P.cr, ck = P.ck, cv = P.cv, pr = P.pr, pk = P.pk, pv = P.pv;
    f32x4 sh_r = (f32x4){0.f, 0.f, 0.f, 0.f}, sh_k = sh_r, sh_v = sh_r;
    if (is_s && t_ == 0) { sh_r = *(const f32x4*)(shift + EC_R + col); sh_k = *(const f32x4*)(shift + EC_K + col); sh_v = *(const f32x4*)(shift + EC_V + col); }
    { const int cc = tid & 127, cl = EC_HW + cc, tb = tid >> 7; const float muc = mu[cl];
#pragma unroll
        for (int k = 0; k < 8; ++k) { const int t = tb + 4 * k; const float hs = P.hcur[k] + (P.hprv[k] - P.hcur[k]) * muc;
            if (cc < 64) LW[t * 72 + cc] = (bf16)f2bf(1.0f - 2.0f / (1.0f + __expf(2.0f * hs))); else LA[t * 72 + cc - 64] = (bf16)f2bf(hs); } }
    __syncthreads();
    { const int p = wave >> 2, tt = (wave >> 1) & 1; const LAS bf16* As = p ? LA : LW; const bf16* WT = (p ? C_AUT : C_WUT) + ((size_t)e * 768 + h * 64) * 64; LAS float* X = p ? XA : XW;
#pragma unroll
        for (int cc = 0; cc < 2; ++cc) { const int ct = 2 * (wave & 1) + cc; f32x4 acc = (f32x4){0.f, 0.f, 0.f, 0.f};
#pragma unroll
            for (int ks = 0; ks < 2; ++ks) acc = mfma16(*(const LAS bf16x8*)(As + (16 * tt + fr) * 72 + 32 * ks + 8 * fq), *(const bf16x8*)(WT + (size_t)(16 * ct + fr) * 64 + 32 * ks + 8 * fq), acc);
#pragma unroll
            for (int r = 0; r < 4; ++r) X[(16 * tt + 4 * fq + r) * 64 + 16 * ct + fr] = acc[r]; } }
    __syncthreads();
    float rr[4], k2[4], vv[4], kkv[4], bb[4];
    for (int rep3 = 0; rep3 < REP3; ++rep3) { asm volatile("" ::: "memory");
    { const f32x4 xw4 = *(const LAS f32x4*)(XW + t_ * 64 + c4), xa4 = *(const LAS f32x4*)(XA + t_ * 64 + c4);
        const f32x4 w04 = *(const f32x4*)(C_IN(18) + e * 768 + col), a04 = *(const f32x4*)(C_IN(20) + e * 768 + col), kk4 = *(const f32x4*)(C_IN(22) + e * 768 + col), ka4 = *(const f32x4*)(C_IN(23) + e * 768 + col),
                    rk4 = *(const f32x4*)(C_IN(24) + e * 768 + col), mr4 = *(const f32x4*)(mu + EC_R + col), mk4 = *(const f32x4*)(mu + EC_K + col), mv4 = *(const f32x4*)(mu + EC_V + col);
        float crf[4], ckf[4], cvf[4], prf[4], pkf[4], pvf[4]; unpk4(cr, crf); unpk4(ck, ckf); unpk4(cv, cvf); unpk4(pr, prf); unpk4(pk, pkf); unpk4(pv, pvf);
        const bool tok_ok = t_ < ntok;
#pragma unroll
        for (int i = 0; i < 4; ++i) { prf[i] += sh_r[i]; pkf[i] += sh_k[i]; pvf[i] += sh_v[i]; }
        float wl[4], av[4], ssum = 0.f, bsum = 0.f;
#pragma unroll
        for (int i = 0; i < 4; ++i) { const float r = crf[i] + (prf[i] - crf[i]) * mr4[i], k = ckf[i] + (pkf[i] - ckf[i]) * mk4[i], v = cvf[i] + (pvf[i] - cvf[i]) * mv4[i];
            wl[i] = -0.6065306597126334f * sigmoidf_(w04[i] + xw4[i]); av[i] = sigmoidf_(a04[i] + xa4[i]);
            const float kk = tok_ok ? k * kk4[i] : 0.f; ssum += kk * kk; kkv[i] = kk; k2[i] = tok_ok ? k * (1.0f + (av[i] - 1.0f) * ka4[i]) : 0.f; rr[i] = tok_ok ? r : 0.f; vv[i] = tok_ok ? v : 0.f; bsum += rr[i] * k2[i] * rk4[i];
            if (!tok_ok) wl[i] = 0.f; }
        ssum = red16(ssum); bsum = red16(bsum); const float inv = rsqrtf(fmaxf(ssum, 1e-24f));
#pragma unroll
        for (int i = 0; i < 4; ++i) { kkv[i] *= inv; bb[i] = kkv[i] * av[i]; }
        if ((tid & 15) == 0 && tok_ok) C_BONUS[(R0 + t_) * 12 + h] = bsum;
        *(LAS f32x4*)(PS + t_ * 64 + c4) = (f32x4){wl[0], wl[1], wl[2], wl[3]}; }
    __syncthreads();
    if (tid < 64) { float run = 0.f;
#pragma unroll 8
        for (int t = 0; t < 32; ++t) { run += PS[t * 64 + tid]; PS[t * 64 + tid] = run; } }
    __syncthreads();
    { const f32x4 pt = *(const LAS f32x4*)(PS + t_ * 64 + c4), pe = *(const LAS f32x4*)(PS + 31 * 64 + c4); const f32x4 pp = (t_ > 0) ? *(const LAS f32x4*)(PS + (t_ - 1) * 64 + c4) : (f32x4){0.f, 0.f, 0.f, 0.f};
        float o_kk[4], o_b[4], o_k[4], o_r[4], o_bh[4], o_kh[4];
#pragma unroll
        for (int i = 0; i < 4; ++i) { const float ct = __expf(pt[i]), cp = __expf(pp[i]), ci = __expf(-pt[i]), chh = __expf(pe[i] - pt[i]);
            o_kk[i] = kkv[i] * cp; o_b[i] = bb[i] * ci; o_k[i] = k2[i] * ci; o_r[i] = rr[i] * ct; o_bh[i] = bb[i] * chh; o_kh[i] = k2[i] * chh; }
        *(LAS u32x2*)(KKt + t_ * 72 + c4) = (u32x2){pk2(o_kk[0], o_kk[1]), pk2(o_kk[2], o_kk[3])}; *(LAS u32x2*)(Bt + t_ * 72 + c4) = (u32x2){pk2(o_b[0], o_b[1]), pk2(o_b[2], o_b[3])};
        *(LAS u32x2*)(Kt + t_ * 72 + c4) = (u32x2){pk2(o_k[0], o_k[1]), pk2(o_k[2], o_k[3])}; *(LAS u32x2*)(Rt + t_ * 72 + c4) = (u32x2){pk2(o_r[0], o_r[1]), pk2(o_r[2], o_r[3])};
        *(LAS u32x2*)(Bh + t_ * 72 + c4) = (u32x2){pk2(o_bh[0], o_bh[1]), pk2(o_bh[2], o_bh[3])}; *(LAS u32x2*)(Kh + t_ * 72 + c4) = (u32x2){pk2(o_kh[0], o_kh[1]), pk2(o_kh[2], o_kh[3])};
        *(LAS u32x2*)(Vb + t_ * 72 + c4) = (u32x2){pk2(vv[0], vv[1]), pk2(vv[2], vv[3])};
        *(LAS f32x4*)(RTf + t_ * 64 + c4) = (f32x4){o_r[0], o_r[1], o_r[2], o_r[3]}; *(LAS f32x4*)(SOL + t_ * 128 + c4) = (f32x4){o_kk[0], o_kk[1], o_kk[2], o_kk[3]};
        if (t_ == 31) *(LAS f32x4*)(c31 + c4) = (f32x4){__expf(pt[0]), __expf(pt[1]), __expf(pt[2]), __expf(pt[3])}; }
    __syncthreads(); }
    { const int m = wave >> 1, tt = wave & 1; const LAS bf16* X = (m < 2) ? KKt : Rt; const LAS bf16* Yv = (m & 1) ? Kt : Bt;
#pragma unroll
        for (int st = 0; st < 2; ++st) { f32x4 acc = (f32x4){0.f, 0.f, 0.f, 0.f};
            if (st <= tt) {
#pragma unroll
                for (int ks = 0; ks < 2; ++ks) acc = mfma16(*(const LAS bf16x8*)(X + (16 * tt + fr) * 72 + 32 * ks + 8 * fq), *(const LAS bf16x8*)(Yv + (16 * st + fr) * 72 + 32 * ks + 8 * fq), acc); }
#pragma unroll
            for (int r = 0; r < 4; ++r) { const int t = 16 * tt + 4 * fq + r, s_ = 16 * st + fr; const bool keep = (m < 2) ? (s_ < t) : (s_ <= t); const float val = keep ? acc[r] : 0.f;
                if (m == 0) LB[t * 32 + (s_ & 3) * 8 + (s_ >> 2)] = val; else if (m == 1) Lk[t * 40 + s_] = (bf16)f2bf(val); else if (m == 2) Mb[t * 40 + s_] = (bf16)f2bf(val); else Mk[t * 40 + s_] = (bf16)f2bf(val); } } }
    __syncthreads();
    { const int tt = wave >> 2, ict = wave & 3;
        const f32x4 acc = mfma16(*(const LAS bf16x8*)(Lk + (16 * tt + fr) * 40 + 8 * fq), tr_frag(Vb + (8 * fq + trow) * 72 + 16 * ict + tcol, 4 * 72), (f32x4){0.f, 0.f, 0.f, 0.f});
#pragma unroll
        for (int r = 0; r < 4; ++r) SOL[(16 * tt + 4 * fq + r) * 128 + 64 + 16 * ict + fr] = acc[r]; }
    __syncthreads();
    { const int cidx = tid >> 2, q = tid & 3; float xq[8];
#pragma unroll
        for (int u = 0; u < 8; ++u) xq[u] = 0.f;
#pragma unroll
        for (int t = 0; t < 32; ++t) { float part = 0.f;
            if (t > 0) { const f32x4 la = *(const LAS f32x4*)(LB + t * 32 + q * 8); part = la[0] * xq[0];
                if (t > 4) part += la[1] * xq[1]; if (t > 8) part += la[2] * xq[2]; if (t > 12) part += la[3] * xq[3];
                if (t > 16) { const f32x4 lb = *(const LAS f32x4*)(LB + t * 32 + q * 8 + 4); part += lb[0] * xq[4];
                    if (t > 20) part += lb[1] * xq[5]; if (t > 24) part += lb[2] * xq[6]; if (t > 28) part += lb[3] * xq[7]; }
                part += dppf<0xB1>(part); part += dppf<0x4E>(part); }
            const float xt = SOL[t * 128 + cidx] - part;
            if (q == (t & 3)) { xq[t >> 2] = xt;
                if (cidx < 64) KTb[t * 72 + cidx] = (bf16)f2bf(xt); else UVb[t * 72 + cidx - 64] = (bf16)f2bf(-xt); } } }
    __syncthreads();
    for (int rep9 = 0; rep9 < REP9; ++rep9) { asm volatile("" ::: "memory");
    unsigned char* chk = C_CHK + (size_t)item * CHK_BYTES; bf16* Ag = (bf16*)(chk + CK_A); bf16* RQg = (bf16*)(chk + CK_RQ); float* GTg = (float*)(chk + CK_GT); float* YVTg = (float*)(chk + CK_YVT);
    const f32x4 z4 = (f32x4){0.f, 0.f, 0.f, 0.f};
    { const int jt = wave >> 1;
        const bf16x8 BhT = tr_frag(Bh + (8 * fq + trow) * 72 + 16 * jt + tcol, 4 * 72), KhT = tr_frag(Kh + (8 * fq + trow) * 72 + 16 * jt + tcol, 4 * 72);
#pragma unroll
        for (int cc = 0; cc < 2; ++cc) { const int ct = 2 * (wave & 1) + cc;
            const f32x4 aA = mfma16(BhT, tr_frag(KTb + (8 * fq + trow) * 72 + 16 * ct + tcol, 4 * 72), z4);
            f32x4 aG = mfma16(BhT, tr_frag(UVb + (8 * fq + trow) * 72 + 16 * ct + tcol, 4 * 72), z4); aG = mfma16(KhT, tr_frag(Vb + (8 * fq + trow) * 72 + 16 * ct + tcol, 4 * 72), aG);
#pragma unroll
            for (int r = 0; r < 4; ++r) { const int j = 16 * jt + 4 * fq + r, jp = 16 * ct + fr; Ag[j * 72 + jp] = (bf16)f2bf(((j == jp) ? c31[j] : 0.f) - aA[r]); }
            *(f32x4*)(GTg + (16 * ct + fr) * 68 + 16 * jt + 4 * fq) = aG; } }
    { const int tt = wave >> 2, jt2 = wave & 3; const bf16x8 MbF = *(const LAS bf16x8*)(Mb + (16 * tt + fr) * 40 + 8 * fq);
        const f32x4 a = mfma16(MbF, tr_frag(KTb + (8 * fq + trow) * 72 + 16 * jt2 + tcol, 4 * 72), z4);
#pragma unroll
        for (int r = 0; r < 4; ++r) { const int t = 16 * tt + 4 * fq + r, j = 16 * jt2 + fr; RQg[t * 72 + j] = (bf16)f2bf(RTf[t * 64 + j] - a[r]); }
        f32x4 y = mfma16(MbF, tr_frag(UVb + (8 * fq + trow) * 72 + 16 * jt2 + tcol, 4 * 72), z4);
        y = mfma16(*(const LAS bf16x8*)(Mk + (16 * tt + fr) * 40 + 8 * fq), tr_frag(Vb + (8 * fq + trow) * 72 + 16 * jt2 + tcol, 4 * 72), y);
        *(f32x4*)(YVTg + (16 * jt2 + fr) * 36 + 16 * tt + 4 * fq) = y; }
    __syncthreads(); }
}
__device__ __forceinline__ void rwkv_stream(const Ctx& c, int bh, int it, int e) {
    const int b = bh / 12, h = bh % 12, lane = c.lane, fr = lane & 15, fq = lane >> 4;
    LAS bf16* Sl = (LAS bf16*)c.lds + c.wave * (16 * 72);
    const unsigned char* chk0 = C_CHK + (size_t)bh * 128 * CHK_BYTES;
    float* ya = C_YA + ((size_t)b * SEQ) * 768 + h * 64 + 16 * it + fr;
    f32x4 S[4];
#pragma unroll
    for (int jt = 0; jt < 4; ++jt) S[jt] = (f32x4){0.f, 0.f, 0.f, 0.f};
    bf16x8 A0[4][2], R0f[2][2], A1[4][2], R1f[2][2]; f32x4 G0[4], Y0[2], G1[4], Y1[2];
#define ST_LOAD(AF, RF, GV, YV, n_) do { const unsigned char* base_ = chk0 + (size_t)(n_) * CHK_BYTES; \
        _Pragma("unroll") for (int jt = 0; jt < 4; ++jt) { _Pragma("unroll") for (int ks = 0; ks < 2; ++ks) AF[jt][ks] = *(const bf16x8*)((const bf16*)(base_ + CK_A) + (16 * jt + fr) * 72 + 32 * ks + 8 * fq); \
            GV[jt] = *(const f32x4*)((const float*)(base_ + CK_GT) + (16 * it + fr) * 68 + 16 * jt + 4 * fq); } \
        _Pragma("unroll") for (int tt = 0; tt < 2; ++tt) { _Pragma("unroll") for (int ks = 0; ks < 2; ++ks) RF[tt][ks] = *(const bf16x8*)((const bf16*)(base_ + CK_RQ) + (16 * tt + fr) * 72 + 32 * ks + 8 * fq); \
            YV[tt] = *(const f32x4*)((const float*)(base_ + CK_YVT) + (16 * it + fr) * 36 + 16 * tt + 4 * fq); } } while (0)
#define ST_STEP(AF, RF, GV, YV, n_, tmax_) do { \
        _Pragma("unroll") for (int jt = 0; jt < 4; ++jt) *(LAS u32x2*)(Sl + fr * 72 + 16 * jt + 4 * fq) = (u32x2){pk2(S[jt][0], S[jt][1]), pk2(S[jt][2], S[jt][3])}; \
        asm volatile("s_waitcnt lgkmcnt(0)" ::: "memory"); \
        const bf16x8 Sf0 = *(const LAS bf16x8*)(Sl + fr * 72 + 8 * fq), Sf1 = *(const LAS bf16x8*)(Sl + fr * 72 + 32 + 8 * fq); \
        asm volatile("s_waitcnt lgkmcnt(0)" ::: "memory"); \
        _Pragma("unroll") for (int tt = 0; tt < 2; ++tt) { f32x4 y_ = mfma16(RF[tt][0], Sf0, YV[tt]); y_ = mfma16(RF[tt][1], Sf1, y_); \
            _Pragma("unroll") for (int r = 0; r < 4; ++r) if (16 * tt + 4 * fq + r < (tmax_)) ya[(size_t)(32 * (n_) + 16 * tt + 4 * fq + r) * 768] = y_[r]; } \
        _Pragma("unroll") for (int jt = 0; jt < 4; ++jt) { f32x4 a_ = mfma16(AF[jt][0], Sf0, GV[jt]); S[jt] = mfma16(AF[jt][1], Sf1, a_); } } while (0)
    ST_LOAD(A0, R0f, G0, Y0, 0);
#pragma unroll 1
    for (int n = 0; n < 128; n += 2) {
        ST_LOAD(A1, R1f, G1, Y1, n + 1);
        ST_STEP(A0, R0f, G0, Y0, n, 32);
        if (n + 2 < 128) ST_LOAD(A0, R0f, G0, Y0, n + 2);
        ST_STEP(A1, R1f, G1, Y1, n + 1, 32);
    }
    float* so = C_OUT + O_RWKV_P + (((size_t)e * 2 + b) * 12 + h) * 4096 + (size_t)(16 * it + fr) * 64 + 4 * fq;
#pragma unroll
    for (int jt = 0; jt < 4; ++jt) *(f32x4*)(so + 16 * jt) = S[jt];
}
__device__ __forceinline__ void rwkv_stream_block(const Ctx& c, int sb, int e) {
    const int bh = sb >> 1, ih = sb & 1, b = bh / 12, h = bh % 12, tid = c.tid, lane = c.lane, wave = c.wave, fr = lane & 15, fq = lane >> 4, il = wave >> 2, jt = wave & 3, it = 2 * ih + il;
    constexpr int SLOT = 13824 + 2 * 4352 + 2 * 2304;
    LAS unsigned char* slots = c.lds;
    LAS bf16* Sl = (LAS bf16*)(c.lds + 2 * SLOT) + il * (2 * 16 * 72);
    const unsigned char* rec0 = C_CHK + (size_t)bh * 128 * CHK_BYTES;
    int soff[4];
#pragma unroll
    for (int k = 0; k < 4; ++k) { const int p = tid + 512 * k; soff[k] = (p < 864) ? 16 * p : (p < 864 + 544) ? CK_GT + ih * 8704 + 16 * (p - 864) : CK_YVT + ih * 4608 + 16 * (p - 1408); }
    const bool has3 = (tid + 1536) < SLOT / 16;
    float* ya = C_YA + ((size_t)b * SEQ + 16 * jt + 4 * fq) * 768 + h * 64 + 16 * it + fr;
    f32x4 S1 = (f32x4){0.f, 0.f, 0.f, 0.f};
    *(LAS u32x2*)(Sl + fr * 72 + 16 * jt + 4 * fq) = (u32x2){0u, 0u};
    u32x4 P0[4], P1[4], P2[4], P3[4];
#define SB_GLOAD(P, n_) do { const int nn_ = (n_) < 128 ? (n_) : 127; const unsigned char* r_ = rec0 + (size_t)nn_ * CHK_BYTES; \
        _Pragma("unroll") for (int k = 0; k < 3; ++k) P[k] = *(const u32x4*)(r_ + soff[k]); P[3] = *(const u32x4*)(r_ + (has3 ? soff[3] : soff[0])); } while (0)
#define SB_LWRITE(P, s_) do { _Pragma("unroll") for (int k = 0; k < 3; ++k) *(LAS u32x4*)(slots + (s_) * SLOT + tid * 16 + k * 8192) = P[k]; if (has3) *(LAS u32x4*)(slots + (s_) * SLOT + tid * 16 + 3 * 8192) = P[3]; } while (0)
#define SB_STEP(s_, n_) do { const LAS unsigned char* sb_ = slots + (s_) * SLOT; const LAS bf16* si_ = Sl + (s_) * (16 * 72) + fr * 72 + 8 * fq; \
        const LAS bf16* a_ = (const LAS bf16*)sb_ + (16 * jt + fr) * 72 + 8 * fq; const bf16x8 af0 = *(const LAS bf16x8*)a_, af1 = *(const LAS bf16x8*)(a_ + 32); \
        const f32x4 gv_ = *(const LAS f32x4*)((const LAS float*)(sb_ + 13824) + (16 * il + fr) * 68 + 16 * jt + 4 * fq); \
        const LAS bf16* rq_ = (const LAS bf16*)(sb_ + CK_RQ) + (16 * (jt & 1) + fr) * 72 + 8 * fq; const bf16x8 rf0 = *(const LAS bf16x8*)rq_, rf1 = *(const LAS bf16x8*)(rq_ + 32); \
        const f32x4 yv_ = *(const LAS f32x4*)((const LAS float*)(sb_ + 13824 + 8704) + (16 * il + fr) * 36 + 16 * (jt & 1) + 4 * fq); \
        const bf16x8 Sf0 = *(const LAS bf16x8*)si_, Sf1 = *(const LAS bf16x8*)(si_ + 32); \
        asm volatile("s_waitcnt lgkmcnt(0)" ::: "memory"); __builtin_amdgcn_sched_barrier(0); \
        { f32x4 t_ = mfma16(af0, Sf0, gv_); S1 = mfma16(af1, Sf1, t_); } \
        if (jt < 2) { f32x4 y_ = mfma16(rf0, Sf0, yv_); y_ = mfma16(rf1, Sf1, y_); \
            _Pragma("unroll") for (int r = 0; r < 4; ++r) ya[(size_t)(32 * (n_) + r) * 768] = y_[r]; } \
        *(LAS u32x2*)(Sl + ((s_) ^ 1) * (16 * 72) + fr * 72 + 16 * jt + 4 * fq) = (u32x2){pk2(S1[0], S1[1]), pk2(S1[2], S1[3])}; \
        } while (0)
    SB_GLOAD(P0, 0); SB_GLOAD(P1, 1); SB_GLOAD(P2, 2); SB_GLOAD(P3, 3);
    SB_LWRITE(P0, 0); __syncthreads();
#pragma unroll 1
    for (int n = 0; n < 128; n += 4) {
        SB_LWRITE(P1, 1); SB_GLOAD(P0, n + 4); SB_STEP(0, n); __syncthreads();
        SB_LWRITE(P2, 0); SB_GLOAD(P1, n + 5); SB_STEP(1, n + 1); __syncthreads();
        SB_LWRITE(P3, 1); SB_GLOAD(P2, n + 6); SB_STEP(0, n + 2); __syncthreads();
        SB_LWRITE(P0, 0); SB_GLOAD(P3, n + 7); SB_STEP(1, n + 3); __syncthreads();
    }
#undef SB_GLOAD
#undef SB_LWRITE
#undef SB_STEP
    *(f32x4*)(C_OUT + O_RWKV_P + (((size_t)e * 2 + b) * 12 + h) * 4096 + (size_t)(16 * it + fr) * 64 + 16 * jt + 4 * fq) = S1;
}
__device__ __forceinline__ void rwkv_stream_sample(const Ctx& c, int sidx, int it, int e) {
    const int ns = sidx / 12, h = sidx % 12, lane = c.lane, fr = lane & 15, fq = lane >> 4;
    LAS bf16* Sl = (LAS bf16*)c.lds + c.wave * (16 * 72);
    const unsigned char* chk0 = C_CHK + (size_t)(3072 + sidx) * CHK_BYTES;
    float* ya = C_YA + ((size_t)(TP + 4 * ns)) * 768 + h * 64 + 16 * it + fr;
    const float* si = C_IN(2) + (((size_t)e * 8 + ns) * 12 + h) * 4096 + (size_t)(16 * it + fr) * 64 + 4 * fq;
    f32x4 S[4];
#pragma unroll
    for (int jt = 0; jt < 4; ++jt) S[jt] = *(const f32x4*)(si + 16 * jt);
    bf16x8 A0[4][2], R0f[2][2]; f32x4 G0[4], Y0[2];
    ST_LOAD(A0, R0f, G0, Y0, 0);
    ST_STEP(A0, R0f, G0, Y0, 0, 4);
    float* so = C_OUT + O_RWKV_S + (((size_t)e * 8 + ns) * 12 + h) * 4096 + (size_t)(16 * it + fr) * 64 + 4 * fq;
#pragma unroll
    for (int jt = 0; jt < 4; ++jt) *(f32x4*)(so + 16 * jt) = S[jt];
}
#undef ST_LOAD
#undef ST_STEP
__device__ __forceinline__ void phase_even_tok_pre(Ctx c, int l) {
    const int e = l >> 1;
    constexpr int NI = 3072 + 96;
    PreIn A; if (c.bid < NI) rwkv_chunk_preload(c, c.bid, e, A);
    for (int it = c.bid; it < NI; it += c.G) { PreIn B; const int nx = (it + c.G < NI) ? it + c.G : it;
        rwkv_chunk_preload(c, nx, e, B); rwkv_chunk_precompute(c, it, e, A); A = B; }
}
__device__ __forceinline__ void phase_even_scan(Ctx c, int l) {
    const int e = l >> 1;
    if (c.G >= 240) {
        if (c.bid < 48) { for (int rp = 0; rp < REPS; ++rp) { rwkv_stream_block(c, 6 * (c.bid & 7) + (c.bid >> 3), e); __syncthreads(); LAUNDER_C(c); } }
        else { Ctx h = c; h.bid = c.bid - 48; h.G = c.G - 48; LAUNDER_C(h);
            if (h.bid < 96) { if (h.wave < 4) rwkv_stream_sample(h, h.bid, h.wave, e); __syncthreads(); }
            even_helper_work(h, l); }
    } else {
        for (int it = c.bid; it < 48; it += c.G) { rwkv_stream_block(c, it, e); __syncthreads(); }
        for (int it = c.bid; it < 96; it += c.G) { if (c.wave < 4) rwkv_stream_sample(c, it, c.wave, e); __syncthreads(); }
        LAUNDER_C(c);
        even_helper_work(c, l);
    }
}
__device__ __forceinline__ void phase_even_ubuild(const Ctx& c, int l) {
    const int e = l >> 1; const float* r_k = C_IN(24) + e * 768; const float* lg = C_IN(25) + e * 768; const float* lb = C_IN(26) + e * 768; const float* muv = C_IN(17) + e * 2432 + EC_V;
    for (int R = c.bid * 8 + c.wave; R < TT; R += c.G * 8) {
        const bool hasprev = (R < TP) ? ((R & (SEQ - 1)) != 0) : (((R - TP) & 3) != 0);
        const float* shiftv = C_IN(3) + ((size_t)e * 8 + ((R >= TP) ? ((R - TP) >> 2) : 0)) * 2432 + EC_V;
        const bf16* hrow = C_HB + (size_t)R * LDH;
#pragma unroll 1
        for (int hb = 0; hb < 12; hb += 4) {
            float y[4], gate[4], cvv[4], pvv[4], bon[4], lgv[4], lbv[4], mv[4];
#pragma unroll
            for (int k = 0; k < 4; ++k) { const int col = (hb + k) * 64 + c.lane;
                y[k] = C_YA[(size_t)R * 768 + col]; gate[k] = bf2f(hrow[EC_GA + col]); cvv[k] = bf2f(hrow[EC_V + col]);
                pvv[k] = hasprev ? bf2f(hrow[EC_V + col - LDH]) : ((R < TP) ? 0.f : shiftv[col]);
                bon[k] = C_BONUS[(size_t)R * 12 + hb + k]; lgv[k] = lg[col]; lbv[k] = lb[col]; mv[k] = muv[col]; }
#pragma unroll
            for (int k = 0; k < 4; ++k) { const int col = (hb + k) * 64 + c.lane;
                const float mean = wave_sum(y[k]) * (1.0f / 64.0f); const float dlt = y[k] - mean; const float var = wave_sum(dlt * dlt) * (1.0f / 64.0f);
                const float yn = dlt * rsqrtf(var + 64e-5f) * lgv[k] + lbv[k];
                const float bonus = bon[k] * (cvv[k] + (pvv[k] - cvv[k]) * mv[k]);
                C_U[(size_t)R * EVEN_OUT + col] = (bf16)f2bf((yn + bonus) * siluf_(gate[k])); }
        }
    }
}

__device__ __forceinline__ void even_combine_dil(const Ctx& c) {
    const int hh = c.lane >> 4, d4 = 4 * (c.lane & 15);
    for (int R0 = c.bid * 8 + c.wave; R0 < TP; R0 += 2 * c.G * 8) {
        const int R1 = (R0 + c.G * 8 < TP) ? R0 + c.G * 8 : R0;
        float ls[2][3]; f32x4 og[2][3]; u32x2 gw[2];
#pragma unroll
        for (int k = 0; k < 2; ++k) { const int R = k ? R1 : R0;
#pragma unroll
            for (int g = 0; g < 3; ++g) { ls[k][g] = C_LSE[((size_t)g * TT + R) * 4 + hh]; og[k][g] = *(const f32x4*)(C_OG + ((size_t)g * TT + R) * 256 + hh * 64 + d4); }
            gw[k] = *(const u32x2*)(C_HB + (size_t)R * LDH + EC_GB + hh * 64 + d4); }
#pragma unroll
        for (int k = 0; k < 2; ++k) { const int R = k ? R1 : R0;
            const float mx = fmaxf(ls[k][0], fmaxf(ls[k][1], ls[k][2])); const float w0 = __expf(ls[k][0] - mx), w1 = __expf(ls[k][1] - mx), w2 = __expf(ls[k][2] - mx); const float inv = 1.0f / (w0 + w1 + w2);
            const f32x4 y = (og[k][0] * w0 + og[k][1] * w1 + og[k][2] * w2) * inv;
            float gt[4]; unpk4(gw[k], gt);
            *(u32x2*)(C_U + (size_t)R * EVEN_OUT + 768 + hh * 64 + d4) = (u32x2){pk2(y.x * siluf_(gt[0]), y.y * siluf_(gt[1])), pk2(y.z * siluf_(gt[2]), y.w * siluf_(gt[3]))}; }
    }
}
__device__ __forceinline__ void rot8(u32x4 w, const float* tb, float scale, float (&y)[8]) {
    float x[8]; unpk8(w, x); const f32x4 t0 = *(const f32x4*)tb, t1 = *(const f32x4*)(tb + 4);
    const float cs[8] = {t0.x, t0.y, t0.z, t0.w, t1.x, t1.y, t1.z, t1.w};
#pragma unroll
    for (int p = 0; p < 4; ++p) { const float co = cs[2 * p], si = cs[2 * p + 1], x0 = x[2 * p], x1 = x[2 * p + 1]; y[2 * p] = (x0 * co - x1 * si) * scale; y[2 * p + 1] = (x1 * co + x0 * si) * scale; }
}
#define C_SB ((bf16*)(c.ap->ws + WS_OG))
__device__ __forceinline__ void ret_s_prepass_item(const Ctx& c, int item) {
    const int bh = item >> 6, ch = item & 63, b = bh / 6, h = bh % 6;
    LAS bf16* Qc = (LAS bf16*)c.lds;
    LAS bf16* Kc = Qc + 64 * 264;
    const float lg = LG2G[h];
    const int tid = c.tid, lane = c.lane, wave = c.wave, fr = lane & 15, fq = lane >> 4, it = wave >> 1, jt0 = (wave & 1) * 2;
    const bf16* g0 = C_HB + ((size_t)b * SEQ + ch * 64) * LDH + h * 256;
    u32x4 tq[4], tk[4];
#pragma unroll
    for (int q = 0; q < 4; ++q) { const int p = tid + 512 * q, row = p >> 5, c8 = (p & 31) * 8; tq[q] = *(const u32x4*)(g0 + (size_t)row * LDH + OC_Q + c8); tk[q] = *(const u32x4*)(g0 + (size_t)row * LDH + OC_K + c8); }
#pragma unroll
    for (int q = 0; q < 4; ++q) { const int p = tid + 512 * q, row = p >> 5, c8 = (p & 31) * 8; *(LAS u32x4*)(Qc + row * 264 + c8) = tq[q]; *(LAS u32x4*)(Kc + row * 264 + c8) = tk[q]; }
    __syncthreads();
    f32x4 accS[2];
#pragma unroll
    for (int q = 0; q < 2; ++q) accS[q] = (f32x4){0.f, 0.f, 0.f, 0.f};
#pragma unroll
    for (int kp = 0; kp < 4; ++kp) { bf16x8 Qf2[2], Kf2[2][2];
#pragma unroll
        for (int kk = 0; kk < 2; ++kk) { const int ks = 2 * kp + kk; Qf2[kk] = *(const LAS bf16x8*)(Qc + (16 * it + fr) * 264 + 32 * ks + 8 * fq);
#pragma unroll
            for (int q = 0; q < 2; ++q) Kf2[kk][q] = *(const LAS bf16x8*)(Kc + (16 * (jt0 + q) + fr) * 264 + 32 * ks + 8 * fq); }
        asm volatile("s_waitcnt lgkmcnt(0)" ::: "memory"); __builtin_amdgcn_sched_barrier(0);
#pragma unroll
        for (int kk = 0; kk < 2; ++kk)
#pragma unroll
            for (int q = 0; q < 2; ++q) accS[q] = mfma16(Qf2[kk], Kf2[kk][q], accS[q]); }
    bf16* sb = C_SB + (size_t)item * 4096;
#pragma unroll
    for (int jj = 0; jj < 2; ++jj) { const int jt = jt0 + jj;
#pragma unroll
        for (int r = 0; r < 4; ++r) { const int i = 16 * it + 4 * fq + r, j = 16 * jt + fr; const float val = (i >= j) ? accS[jj][r] * exp2f(lg * (float)(i - j)) : 0.f; sb[i * 64 + j] = (bf16)f2bf(val); } }
    __syncthreads();
}
__device__ __forceinline__ void ret_prompt_unit(const Ctx& c, int unit, int o) {
    const int b = unit / 48, h = (unit >> 3) % 6, es = unit & 7;
    LAS bf16* Qc = (LAS bf16*)c.lds;
    LAS bf16* Kc = Qc + 64 * 264;
    LAS bf16* Vc = Kc + 64 * 264;
    LAS bf16* Vz = Vc + 64 * 40;
    LAS bf16* Rt = Vz + 64 * 40;
    const float lg = LG2G[h];
    const int tid = c.tid, lane = c.lane, wave = c.wave, fr = lane & 15, fq = lane >> 4, it = wave >> 1, eto = wave & 1;
    f32x4 Racc[2][2];
#pragma unroll
    for (int a = 0; a < 2; ++a)
#pragma unroll
        for (int q = 0; q < 2; ++q) Racc[a][q] = (f32x4){0.f, 0.f, 0.f, 0.f};
    for (int i = tid; i < 32 * 264 / 2; i += 512) ((LAS unsigned*)Rt)[i] = 0u;
    const float g64 = exp2f(lg * 64.f);
    const int vj = (tid & 255) >> 2, vp = tid & 3; const float zeta = exp2f(lg * (float)(63 - vj));
    const bf16* g0 = C_HB + ((size_t)b * SEQ) * LDH + h * 256;
    const bf16* gv = C_HB + ((size_t)b * SEQ + vj) * LDH + OC_V + h * 256 + es * 32 + vp * 8;
    const bf16* gs = C_SB + (size_t)((b * 6 + h) * 64) * 4096 + (16 * it + fr) * 64 + 8 * fq;
    u32x4 pq[4], pk[4], pv; bf16x8 sfn[2];
#pragma unroll
    for (int q = 0; q < 4; ++q) { const int p = tid + 512 * q, row = p >> 5, c8 = (p & 31) * 8; pq[q] = *(const u32x4*)(g0 + (size_t)row * LDH + OC_Q + c8); pk[q] = *(const u32x4*)(g0 + (size_t)row * LDH + OC_K + c8); }
    pv = *(const u32x4*)gv; sfn[0] = *(const bf16x8*)gs; sfn[1] = *(const bf16x8*)(gs + 32);
    const int trow = (lane & 15) >> 2, tcol = 4 * (lane & 3);
#pragma unroll 1
    for (int ch = 0; ch < 64; ++ch) {
        const size_t row0 = (size_t)b * SEQ + ch * 64;
#pragma unroll
        for (int q = 0; q < 4; ++q) { const int p = tid + 512 * q, row = p >> 5, c8 = (p & 31) * 8; *(LAS u32x4*)(Qc + row * 264 + c8) = pq[q]; *(LAS u32x4*)(Kc + row * 264 + c8) = pk[q]; }
        if (wave < 4) { *(LAS u32x4*)(Vc + vj * 40 + vp * 8) = pv; float x[8]; unpk8(pv, x);
            *(LAS u32x4*)(Vz + vj * 40 + vp * 8) = (u32x4){pk2(x[0] * zeta, x[1] * zeta), pk2(x[2] * zeta, x[3] * zeta), pk2(x[4] * zeta, x[5] * zeta), pk2(x[6] * zeta, x[7] * zeta)}; }
        const bf16x8 Sf0 = sfn[0], Sf1 = sfn[1];
        { const int cn = (ch + 1 < 64) ? ch + 1 : 63; const size_t adv = (size_t)cn * 64 * LDH;
#pragma unroll
            for (int q = 0; q < 4; ++q) { const int p = tid + 512 * q, row = p >> 5, c8 = (p & 31) * 8; pq[q] = *(const u32x4*)(g0 + adv + (size_t)row * LDH + OC_Q + c8); pk[q] = *(const u32x4*)(g0 + adv + (size_t)row * LDH + OC_K + c8); }
            pv = *(const u32x4*)(gv + adv); sfn[0] = *(const bf16x8*)(gs + (size_t)cn * 4096); sfn[1] = *(const bf16x8*)(gs + (size_t)cn * 4096 + 32); }
        __syncthreads();
        f32x4 accQ = (f32x4){0.f, 0.f, 0.f, 0.f};
        { bf16x8 Qf[8], Rf[8];
#pragma unroll
            for (int ks = 0; ks < 8; ++ks) { Qf[ks] = *(const LAS bf16x8*)(Qc + (16 * it + fr) * 264 + 32 * ks + 8 * fq); Rf[ks] = *(const LAS bf16x8*)(Rt + (16 * eto + fr) * 264 + 32 * ks + 8 * fq); }
            asm volatile("s_waitcnt lgkmcnt(0)" ::: "memory"); __builtin_amdgcn_sched_barrier(0);
#pragma unroll
            for (int ks = 0; ks < 8; ++ks) accQ = mfma16(Qf[ks], Rf[ks], accQ); }
        { bf16x8 Vfr[2], Kfr[2][2], Zfr[2][2];
#pragma unroll
            for (int k2 = 0; k2 < 2; ++k2) { Vfr[k2] = tr_frag(Vc + (32 * k2 + 8 * fq + trow) * 40 + 16 * eto + tcol, 4 * 40);
#pragma unroll
                for (int dd = 0; dd < 2; ++dd) Kfr[dd][k2] = tr_frag(Kc + (32 * k2 + 8 * fq + trow) * 264 + 16 * (2 * wave + dd) + tcol, 4 * 264);
#pragma unroll
                for (int et = 0; et < 2; ++et) Zfr[et][k2] = tr_frag(Vz + (32 * k2 + 8 * fq + trow) * 40 + 16 * et + tcol, 4 * 40); }
            asm volatile("s_waitcnt lgkmcnt(0)" ::: "memory"); __builtin_amdgcn_sched_barrier(0);
            { f32x4 a2 = mfma16(Sf0, Vfr[0], (f32x4){0.f, 0.f, 0.f, 0.f}); a2 = mfma16(Sf1, Vfr[1], a2);
#pragma unroll
                for (int r = 0; r < 4; ++r) { const int i = 16 * it + 4 * fq + r; C_YR[(row0 + i) * 1536 + h * 256 + es * 32 + 16 * eto + fr] = a2[r] + accQ[r] * exp2f(lg * (float)(i + 1)); } }
#pragma unroll
            for (int dd = 0; dd < 2; ++dd)
#pragma unroll
                for (int et = 0; et < 2; ++et) { f32x4 a = Racc[dd][et] * g64; a = mfma16(Kfr[dd][0], Zfr[et][0], a); Racc[dd][et] = mfma16(Kfr[dd][1], Zfr[et][1], a); } }
        __syncthreads();
#pragma unroll
        for (int dd = 0; dd < 2; ++dd)
#pragma unroll
            for (int et = 0; et < 2; ++et) { const f32x4 a = Racc[dd][et]; const int dt = 2 * wave + dd;
                *(LAS u32x2*)(Rt + (16 * et + fr) * 264 + 16 * dt + 4 * fq) = (u32x2){pk2(a[0], a[1]), pk2(a[2], a[3])}; }
    }
    int fq_l = fq; asm volatile("" : "+v"(fq_l));
    float* ro = C_OUT + O_RET_P + ((((size_t)o * 2 + b) * 6 + h) * 256) * 256 + es * 32;
#pragma unroll
    for (int dd = 0; dd < 2; ++dd)
#pragma unroll
        for (int et = 0; et < 2; ++et)
#pragma unroll
            for (int r = 0; r < 4; ++r) ro[(size_t)(16 * (2 * wave + dd) + 4 * fq_l + r) * 256 + 16 * et + fr] = Racc[dd][et][r];
    __syncthreads();
}
__device__ __forceinline__ void ret_sample_unit(const Ctx& c, int unit, int o) {
    const int n = unit / 6, h = unit % 6, tid = c.tid;
    LAS float* qs = (LAS float*)c.lds; LAS float* ks = qs + 1024; LAS float* vs = ks + 1024; LAS float* red = vs + 1024; LAS float* sc = red + 2048;
    const float lg = LG2G[h];
    for (int idx = tid; idx < 4 * 256; idx += 512) { const int t = idx >> 8, dd = idx & 255; const bf16* hr = C_HB + (size_t)(TP + n * 4 + t) * LDH + h * 256 + dd; qs[idx] = bf2f(hr[OC_Q]); ks[idx] = bf2f(hr[OC_K]); }
    for (int idx = tid; idx < 4 * 256; idx += 512) { const int t = idx >> 8, ee = idx & 255; vs[idx] = bf2f(C_HB[(size_t)(TP + n * 4 + t) * LDH + OC_V + h * 256 + ee]); }
    __syncthreads();
    if (tid < 16) { const int i = tid >> 2, j = tid & 3; float a = 0.f; for (int d = 0; d < 256; ++d) a += qs[i * 256 + d] * ks[j * 256 + d]; sc[tid] = (j <= i) ? a * exp2f(lg * (float)(i - j)) : 0.f; }
    __syncthreads();
    const int ee = tid & 255, dh = tid >> 8;
    const float* R0 = C_IN(7) + ((((size_t)o * 8 + n) * 6 + h) * 256) * 256; float* Rn = C_OUT + O_RET_S + ((((size_t)o * 8 + n) * 6 + h) * 256) * 256;
    const float g4 = exp2f(lg * 4.f), z0 = exp2f(lg * 3.f), z1 = exp2f(lg * 2.f), z2 = exp2f(lg), z3 = 1.0f;
    const float v0 = vs[ee] * z0, v1 = vs[256 + ee] * z1, v2 = vs[512 + ee] * z2, v3 = vs[768 + ee] * z3;
    float acc[4] = {0.f, 0.f, 0.f, 0.f};
#pragma unroll 4
    for (int d = dh * 128; d < dh * 128 + 128; ++d) { const float r0 = R0[(size_t)d * 256 + ee];
        acc[0] += qs[d] * r0; acc[1] += qs[256 + d] * r0; acc[2] += qs[512 + d] * r0; acc[3] += qs[768 + d] * r0;
        Rn[(size_t)d * 256 + ee] = g4 * r0 + ks[d] * v0 + ks[256 + d] * v1 + ks[512 + d] * v2 + ks[768 + d] * v3; }
#pragma unroll
    for (int i = 0; i < 4; ++i) red[(dh * 4 + i) * 256 + ee] = acc[i];
    __syncthreads();
    if (dh == 0) {
#pragma unroll
        for (int i = 0; i < 4; ++i) { float ov = (red[i * 256 + ee] + red[(4 + i) * 256 + ee]) * exp2f(lg * (float)(i + 1));
            for (int j = 0; j <= i; ++j) ov += sc[i * 4 + j] * vs[j * 256 + ee];
            C_YR[(size_t)(TP + n * 4 + i) * 1536 + h * 256 + ee] = ov; } }
    __syncthreads();
}
__device__ __forceinline__ void odd_helper_work(Ctx c, int l) {
    { pg8::Gemm g{C_XB, C_WTIN_L(l), MPAD, 4 * 256, DM}; pg8::StaticOrder S; S.init(MPAD, 4 * 256, c.G, c.bid, 0, 18); S.ex_n = 24; S.ex_pm0 = 0; S.ex_pn = 22;
        pg8::EpiBf16NP E{C_HB, LDH, C_TAB, 0, 1536};
        pg8::gemm_phase<pg8::EpiBf16NP, pg8::StaticOrder, true, true>(c.lds, g, S, E); }
    LAUNDER_C(c);
    mem_attn_all(c, l, OC_QM, OC_GM, 1536, ODD_OUT);
    LAUNDER_C(c);
    if (l < 3) convert_layer_weights(c, l + 1);
}
__device__ __forceinline__ void phase_odd_tok(Ctx c, int l) {
    const int o = l >> 1;
    if (c.G >= 256) {
        if (c.bid < 96) ret_prompt_unit(c, 12 * (c.bid & 7) + (c.bid >> 3), o);
        else { if (c.bid < 144) ret_sample_unit(c, c.bid - 96, o);
            Ctx h = c; h.bid = c.bid - 96; h.G = c.G - 96; LAUNDER_C(h); odd_helper_work(h, l); }
    } else {
        for (int it = c.bid; it < 144; it += c.G) { if (it < 96) ret_prompt_unit(c, it, o); else ret_sample_unit(c, it - 96, o); }
        LAUNDER_C(c);
        odd_helper_work(c, l);
    }
}
__device__ __forceinline__ void phase_odd_ubuild(const Ctx& c) {
    for (int R = c.bid * 8 + c.wave; R < TT; R += c.G * 8) {
#pragma unroll 1
        for (int hb = 0; hb < 6; hb += 3) {
            f32x4 ov[3]; u32x2 gw[3];
#pragma unroll
            for (int k = 0; k < 3; ++k) { const int col = (hb + k) * 256 + 4 * c.lane; ov[k] = *(const f32x4*)(C_YR + (size_t)R * 1536 + col); gw[k] = *(const u32x2*)(C_HB + (size_t)R * LDH + OC_G + col); }
#pragma unroll
            for (int k = 0; k < 3; ++k) { const int col = (hb + k) * 256 + 4 * c.lane; const f32x4 o = ov[k];
                const float ss = wave_sum(o.x * o.x + o.y * o.y + o.z * o.z + o.w * o.w); const float scl = rsqrtf(ss * (1.0f / 256.0f) + 1e-6f);
                float g[4]; unpk4(gw[k], g);
                *(u32x2*)(C_U + (size_t)R * DM + col) = (u32x2){pk2(o.x * scl * siluf_(g[0]), o.y * scl * siluf_(g[1])), pk2(o.z * scl * siluf_(g[2]), o.w * scl * siluf_(g[3]))}; }
        }
    }
}
__device__ __forceinline__ void small_outproj(const Ctx& c, int wt, int K, int l) {
    const int lane = c.lane, r = lane & 31, hl = lane >> 5, nks = K / 128;
    const bf16* ap = C_U + (size_t)(TP + r) * K + 8 * hl + c.wave * nks * 16; const bf16* bp = C_WTOUT_L(l) + (size_t)(32 * wt + r) * K + 8 * hl + c.wave * nks * 16;
    f32x16 acc;
#pragma unroll
    for (int i = 0; i < 16; ++i) acc[i] = 0.f;
    if (nks == 16) {
#pragma unroll
        for (int ks = 0; ks < 16; ++ks) acc = mfma32(*(const bf16x8*)(ap + 16 * ks), *(const bf16x8*)(bp + 16 * ks), acc);
    } else {
#pragma unroll
        for (int ks = 0; ks < 12; ++ks) acc = mfma32(*(const bf16x8*)(ap + 16 * ks), *(const bf16x8*)(bp + 16 * ks), acc);
    }
    LAS float* part = (LAS float*)c.lds;
#pragma unroll
    for (int i = 0; i < 16; ++i) part[(c.wave * 16 + i) * 64 + lane] = acc[i];
    __syncthreads();
    for (int idx = c.tid; idx < 1024; idx += 512) { float sum = 0.f;
#pragma unroll
        for (int w = 0; w < 8; ++w) sum += part[w * 1024 + idx];
        const int i = idx >> 6, ln = idx & 63, row = TP + (i & 3) + 8 * (i >> 2) + 4 * (ln >> 5), col = 32 * wt + (ln & 31);
        const float xres = (l == 0) ? C_IN(1)[(size_t)(row - TP) * DM + col] : C_XZ[(size_t)row * DM + col];
        C_Z[(size_t)row * DM + col] = xres * ALPHA + sum; }
    __syncthreads();
}
__device__ __forceinline__ void phase_ln(const Ctx& c, int l) {
    const float* g = C_IN(15) + l * DM; const float* bta = C_IN(16) + l * DM;
    f32x4 gg[8], bb[8];
#pragma unroll
    for (int j = 0; j < 8; ++j) { const int col = 4 * c.lane + 256 * j; gg[j] = *(const f32x4*)(g + col); bb[j] = *(const f32x4*)(bta + col); }
    for (int R0 = c.bid * 8 + c.wave; R0 < TT; R0 += 2 * c.G * 8) {
        const int R1 = R0 + c.G * 8; const bool has1 = R1 < TT; const int R1c = has1 ? R1 : R0;
        f32x4 v0[8], v1[8]; float s0 = 0.f, s1 = 0.f;
        { const f32x4* z0 = (const f32x4*)(C_Z + (size_t)R0 * DM) + c.lane; const f32x4* z1 = (const f32x4*)(C_Z + (size_t)R1c * DM) + c.lane;
#pragma unroll
            for (int j = 0; j < 8; ++j) { v0[j] = z0[64 * j]; v1[j] = z1[64 * j]; } }
#pragma unroll
        for (int j = 0; j < 8; ++j) { s0 += (v0[j].x + v0[j].y) + (v0[j].z + v0[j].w); s1 += (v1[j].x + v1[j].y) + (v1[j].z + v1[j].w); }
        const float m0 = wave_sum(s0) * (1.0f / DM), m1 = wave_sum(s1) * (1.0f / DM); float q0 = 0.f, q1 = 0.f;
#pragma unroll
        for (int j = 0; j < 8; ++j) { v0[j] = v0[j] - m0; v1[j] = v1[j] - m1; q0 += (v0[j].x * v0[j].x + v0[j].y * v0[j].y) + (v0[j].z * v0[j].z + v0[j].w * v0[j].w); q1 += (v1[j].x * v1[j].x + v1[j].y * v1[j].y) + (v1[j].z * v1[j].z + v1[j].w * v1[j].w); }
        const float r0 = rsqrtf(wave_sum(q0) * (1.0f / DM) + LN_EPS), r1 = rsqrtf(wave_sum(q1) * (1.0f / DM) + LN_EPS);
        float* d0 = (l == 3) ? (R0 < TP ? C_OUT + O_YP + (size_t)R0 * DM : C_OUT + O_YS + (size_t)(R0 - TP) * DM) : C_XZ + (size_t)R0 * DM;
        float* d1 = (l == 3) ? (R1c < TP ? C_OUT + O_YP + (size_t)R1c * DM : C_OUT + O_YS + (size_t)(R1c - TP) * DM) : C_XZ + (size_t)R1c * DM;
#pragma unroll
        for (int j = 0; j < 8; ++j) { const int col = 4 * c.lane + 256 * j;
            const f32x4 x0 = v0[j] * r0 * gg[j] + bb[j]; *(f32x4*)(d0 + col) = x0; if (l != 3) *(u32x2*)(C_XB + (size_t)R0 * DM + col) = (u32x2){pk2(x0.x, x0.y), pk2(x0.z, x0.w)};
            if (has1) { const f32x4 x1 = v1[j] * r1 * gg[j] + bb[j]; *(f32x4*)(d1 + col) = x1; if (l != 3) *(u32x2*)(C_XB + (size_t)R1 * DM + col) = (u32x2){pk2(x1.x, x1.y), pk2(x1.z, x1.w)}; } }
    }
}

#define XB_TMO      128
#define XB_XCNT(j)  (256  + 64 * (j))
#define XB_XSUB(j)  (1280 + 64 * (j))
#define XB_XGEN(j)  (2304 + 64 * (j))
#define XB_TOP      3328
#define XB_TOPGEN   3392
#define XCD_BAR_WORDS 3456
#define XB_SPIN_CAP (1u << 18)

__device__ __forceinline__ unsigned xb_ld(unsigned* p)              { return __hip_atomic_load(p, __ATOMIC_RELAXED, __HIP_MEMORY_SCOPE_AGENT); }
__device__ __forceinline__ unsigned xb_add(unsigned* p, unsigned v) { return __hip_atomic_fetch_add(p, v, __ATOMIC_RELAXED, __HIP_MEMORY_SCOPE_AGENT); }
__device__ __forceinline__ unsigned xb_xcc_id() { return (unsigned)__builtin_amdgcn_s_getreg((3 << 11) | 20) & 0xFu; }
#define XB_SPIN(cond, bar) do { unsigned _sp = 0; while (cond) { __builtin_amdgcn_s_sleep(1); \
    if ((++_sp & 255u) == 0u) { if (xb_ld(&(bar)[XB_TMO])) break; if (_sp > XB_SPIN_CAP) { atomicAdd(&(bar)[XB_TMO], 1u); break; } } } } while (0)

struct XcdBarrier {
    unsigned* bar; unsigned x;
    volatile LAS unsigned* st;
};

__device__ __forceinline__ XcdBarrier xcd_barrier_post(unsigned* bar, volatile LAS unsigned* st) {
    XcdBarrier b; b.bar = bar; b.x = xb_xcc_id(); b.st = st;
    if (threadIdx.x == 0) (void)xb_add(&bar[XB_XCNT(b.x)], 1u);
    return b;
}
__device__ __forceinline__ void xcd_barrier_complete(unsigned* bar, unsigned x, unsigned& nloc, unsigned& nx) {
    const unsigned G = gridDim.x * gridDim.y * gridDim.z;
    unsigned sum, cnt, mine, sp = 0u;
    for (;;) {
        sum = 0u; cnt = 0u; mine = 0u;
#pragma unroll
        for (unsigned j = 0; j < 16; ++j) { const unsigned c = xb_ld(&bar[XB_XCNT(j)]); sum += c; cnt += (c > 0u) ? 1u : 0u; mine = (j == x) ? c : mine; }
        if (sum == G) break;
        __builtin_amdgcn_s_sleep(1);
        if ((++sp & 255u) == 0u) { if (xb_ld(&bar[XB_TMO])) break; if (sp > XB_SPIN_CAP) { atomicAdd(&bar[XB_TMO], 1u); break; } }
    }
    nloc = mine > 0u ? mine : 1u; nx = cnt > 0u ? cnt : 1u;
}

__device__ __forceinline__ void xcd_barrier(const XcdBarrier& b) {
    asm volatile("s_waitcnt vmcnt(0)" ::: "memory");
    __syncthreads();
    if (threadIdx.x == 0) {
        unsigned* bar = b.bar;
        __builtin_amdgcn_s_waitcnt(0);
        unsigned nloc = b.st[0], nx = b.st[1];
        if (nloc == 0u) { xcd_barrier_complete(bar, b.x, nloc, nx); b.st[0] = nloc; b.st[1] = nx; }
        const unsigned old = xb_add(&bar[XB_XSUB(b.x)], 1u);
        const unsigned gen = old / nloc;
        if (old + 1u == (gen + 1u) * nloc) {
            __builtin_amdgcn_fence(__ATOMIC_RELEASE, "agent");
            asm volatile("s_waitcnt vmcnt(0)" ::: "memory");
            const unsigned og = xb_add(&bar[XB_TOP], 1u);
            const unsigned tg = og / nx;
            if (og + 1u == (tg + 1u) * nx) xb_add(&bar[XB_TOPGEN], 1u);
            else XB_SPIN(xb_ld(&bar[XB_TOPGEN]) == tg, bar);
            __builtin_amdgcn_fence(__ATOMIC_ACQUIRE, "agent");
            xb_add(&bar[XB_XGEN(b.x)], 1u);
            asm volatile("s_waitcnt vmcnt(0)" ::: "memory");
        } else {
            XB_SPIN(xb_ld(&bar[XB_XGEN(b.x)]) == gen, bar);
            __builtin_amdgcn_fence(__ATOMIC_ACQUIRE, "agent");
            asm volatile("s_waitcnt vmcnt(0)" ::: "memory");
        }
    }
    __syncthreads();
}

constexpr int NPH = 25;
__global__ void __launch_bounds__(512, 2) mk(Args args) {
    extern __shared__ __attribute__((aligned(16))) unsigned char lds_raw[];
    Ctx c;
    c.ap = (ArgsP)__builtin_amdgcn_kernarg_segment_ptr(); c.lds = (LAS unsigned char*)lds_raw;
    c.tid = threadIdx.x; c.lane = c.tid & 63; c.wave = __builtin_amdgcn_readfirstlane(c.tid >> 6); c.bid = blockIdx.x; c.G = gridDim.x;
    for (int u = c.tid; u < 16; u += 512) ((LAS unsigned*)(c.lds + 131072))[u] = 0u;
    __syncthreads();
    XcdBarrier xbar = xcd_barrier_post((unsigned*)(c.ap->ws + WS_CTL) + 4096, (volatile LAS unsigned*)(c.lds + 131072));
#define LAUNDER() do { asm volatile("" : "+s"(c.ap), "+v"(c.tid), "+s"(c.bid), "+s"(c.G)); c.lane = c.tid & 63; c.wave = __builtin_amdgcn_readfirstlane(c.tid >> 6); } while (0)
    const int lo = args.ph_lo, hi = args.ph_hi;
#define IN(k) (lo <= (k) && (k) < hi)
#if USE_CG
#define SEAM(k) do { if (IN(k) && IN((k) + 1)) { cg::this_grid().sync(); } } while (0)
#else
#define SEAM(k) do { if (IN(k) && IN((k) + 1)) { asm volatile("" : "+s"(xbar.bar)); xcd_barrier(xbar); } } while (0)
#endif
    #if !(DIS & 1)
    if (IN(0)) { for (int rep = 0; rep < ((DUP & 128) ? 2 : 1); ++rep) { LAUNDER(); phase_prologue(c); if (DUP & 128) { asm volatile("" : "+s"(xbar.bar)); xcd_barrier(xbar); } } }
#endif
    SEAM(0);
#pragma unroll 1
    for (int l = 0; l < 4; ++l) {
        const int p0 = 1 + 6 * l; const bool even = (l & 1) == 0;
#if !(DIS & 2)
        if (IN(p0)) { for (int rep = 0; rep < ((DUP & 16) ? 2 : 1); ++rep) { LAUNDER();
            if (l == 0) { pg8::Gemm g{C_MEMB, C_WTMEM, 512, 4096, DM}; pg8::StaticOrder S; S.init(512, 4096, c.G, (c.bid + c.G - c.G / 2) % c.G);
                pg8::EpiF32Split E{C_OUT + O_MEM, 1024, 1024, (size_t)512 * 1024, C_MKVB};
                pg8::gemm_phase<pg8::EpiF32Split, pg8::StaticOrder, true, true>(c.lds, g, S, E); }
            const int ngemm = (l == 0) ? 5 : 1;
#pragma unroll 1
            for (int gi = 0; gi < ngemm; ++gi) {
                const int NI = even ? EVEN_INP : ODD_IN;
                const bf16* A = gi ? C_WTMEM + ((size_t)(gi - 1) * 1024 + 512) * DM : C_XB; const bf16* Bt = gi ? C_MEMB : C_WTIN_L(l);
                const bool defer = (gi == 0) && !even;
                const int Mg = gi ? 512 : MPAD, Ng = gi ? 512 : (defer ? NI - 5 * 256 : NI);
                bf16* Og = gi ? C_VT + (size_t)(gi - 1) * 512 * 512 : C_HB; const int ldo = gi ? 512 : LDH;
                pg8::Gemm g{A, Bt, Mg, Ng, DM}; pg8::StaticOrder S; S.init(Mg, Ng, c.G, gi ? (c.bid + 2 * c.G - (5 * c.G) / 8 - 8 * (gi - 1)) % c.G : c.bid, defer ? 18 : (1 << 30), defer ? 5 : 0); if (defer) { S.ex_n = 9; S.ex_pm0 = 24; S.ex_pn = 22; }
                pg8::EpiBf16NP E{Og, ldo, C_TAB, (gi == 0 && !even) ? 3072 : 0, 1536};
                pg8::gemm_phase<pg8::EpiBf16NP, pg8::StaticOrder, true, true>(c.lds, g, S, E);
            }
            if (DUP & 16) { asm volatile("" : "+s"(xbar.bar)); xcd_barrier(xbar); }
        } }
#endif
        SEAM(p0);
#if !(DIS & 4)
        if (IN(p0 + 1)) { for (int rep = 0; rep < ((DUP & 1) ? 2 : 1); ++rep) { LAUNDER(); if (even) phase_even_tok_pre(c, l); if (DUP & 1) { asm volatile("" : "+s"(xbar.bar)); xcd_barrier(xbar); } } }
#endif
#if !(DIS & 8)
        if (IN(p0 + 1)) { LAUNDER(); if (!even) { for (int it = c.bid; it < 768; it += c.G) ret_s_prepass_item(c, it); } }
#endif
        SEAM(p0 + 1);
#if !(DIS & 16)
        if (IN(p0 + 2)) { for (int rep = 0; rep < ((DUP & 4) ? 2 : 1); ++rep) { LAUNDER(); if (even) phase_even_scan(c, l); if (DUP & 4) { asm volatile("" : "+s"(xbar.bar)); xcd_barrier(xbar); } } }
#if !(DIS & 8)
        if (IN(p0 + 2)) { for (int rep = 0; rep < ((DUP & 2) ? 2 : 1); ++rep) { LAUNDER(); if (!even) phase_odd_tok(c, l); if (DUP & 2) { asm volatile("" : "+s"(xbar.bar)); xcd_barrier(xbar); } } }
#endif
#endif
        SEAM(p0 + 2);
#if !(DIS & 32)
        if (IN(p0 + 3)) { for (int rep = 0; rep < ((DUP & 8) ? 2 : 1); ++rep) { LAUNDER(); if (even) { phase_even_ubuild(c, l); LAUNDER(); even_combine_dil(c); } else phase_odd_ubuild(c); if (DUP & 8) { asm volatile("" : "+s"(xbar.bar)); xcd_barrier(xbar); } } }
#endif
        SEAM(p0 + 3);
#if !(DIS & 64)
        if (IN(p0 + 4)) { for (int rep = 0; rep < ((DUP & 32) ? 2 : 1); ++rep) { LAUNDER(); const int K = even ? EVEN_OUT : ODD_OUT;
            pg8::Gemm g{C_U, C_WTOUT_L(l), TP, DM, K}; pg8::StaticOrder S; S.init(TP, DM, c.G, c.bid); pg8::EpiResid E{(l == 0) ? C_IN(0) : C_XZ, C_Z, DM, ALPHA};
            pg8::gemm_phase<pg8::EpiResid, pg8::StaticOrder, true, true>(c.lds, g, S, E);
            LAUNDER(); if (c.bid < 64) small_outproj(c, c.bid, K, l); if (DUP & 32) { asm volatile("" : "+s"(xbar.bar)); xcd_barrier(xbar); } } }
#endif
        SEAM(p0 + 4);
#if !(DIS & 128)
        if (IN(p0 + 5)) { for (int rep = 0; rep < ((DUP & 64) ? 2 : 1); ++rep) { LAUNDER(); phase_ln(c, l); if (DUP & 64) { asm volatile("" : "+s"(xbar.bar)); xcd_barrier(xbar); } } }
#endif
        SEAM(p0 + 5);
    }
#undef IN
#undef SEAM
}

extern "C" void kernel_launch(void* const* d_in, const int* in_sizes, int n_in, void* d_out, int out_size, void* d_ws, size_t ws_size, hipStream_t stream) {
    static int grid = 0;
    if (grid == 0) {
        if (n_in != 27 || (size_t)out_size != O_END || ws_size < WS_END) { fprintf(stderr, "kernel_launch: unexpected shapes: n_in %d out %d ws %zu (need %zu)\n", n_in, out_size, ws_size, (size_t)WS_END); grid = -1; return; }
        int dev = 0, cus = 0, per_cu = 0;
        hipGetDevice(&dev); hipDeviceGetAttribute(&cus, hipDeviceAttributeMultiprocessorCount, dev);
        if (hipFuncSetAttribute((const void*)mk, hipFuncAttributeMaxDynamicSharedMemorySize, LDS_BYTES) != hipSuccess) { fprintf(stderr, "kernel_launch: hipFuncSetAttribute failed\n"); grid = -1; return; }
        if (hipOccupancyMaxActiveBlocksPerMultiprocessor(&per_cu, (const void*)mk, 512, LDS_BYTES) != hipSuccess || per_cu < 1) { fprintf(stderr, "kernel_launch: occupancy query says %d\n", per_cu); per_cu = 1; }
        (void)hipGetLastError();
        grid = cus;
        fprintf(stderr, "kernel_launch: grid %d (cus %d, per_cu %d)\n", grid, cus, per_cu);
    }
    if (grid < 0) return;
    if (hipMemsetAsync((char*)d_ws + WS_CTL, 0, 1u << 20, stream) != hipSuccess) { fprintf(stderr, "kernel_launch: memset failed\n"); return; }
    Args a{};
    for (int i = 0; i < 27; ++i) a.in[i] = (const float*)d_in[i];
    a.out = (float*)d_out; a.ws = (unsigned char*)d_ws;
#if ONE_LAUNCH
    a.ph_lo = 0; a.ph_hi = NPH;
    void* kargs[] = {&a};
    hipError_t e = hipLaunchCooperativeKernel((const void*)mk, dim3(grid), dim3(512), kargs, LDS_BYTES, stream);
    if (e != hipSuccess) fprintf(stderr, "kernel_launch: cooperative launch failed: %s\n", hipGetErrorString(e));
#else
    for (int p = 0; p < NPH; ++p) {
        if (p >= 1 && ((p - 1) % 6) == 2 && (((p - 1) / 6) & 1)) continue;
        a.ph_lo = p; a.ph_hi = p + 1;
        hipLaunchKernelGGL(mk, dim3(grid), dim3(512), LDS_BYTES, stream, a);
    }
#endif
}
```

```cpp
#include <hip/hip_runtime.h>
#include <hip/hip_cooperative_groups.h>
#include <cstdio>
#include <cstdint>
namespace cg = cooperative_groups;
#ifndef DIS
#define DIS 0
#endif
#ifndef REPE
#define REPE 1
#endif
#ifndef REPD
#define REPD 1
#endif
#ifndef REPM
#define REPM 1
#endif
#ifndef REPC
#define REPC 1
#endif
#ifndef REPS
#define REPS 1
#endif
#ifndef REP9
#define REP9 1
#endif
#ifndef REP3
#define REP3 1
#endif
#ifndef REP8
#define REP8 1
#endif
#ifndef REP1
#define REP1 1
#endif
#ifndef DUP
#define DUP 0
#endif
#ifndef USE_CG
#define USE_CG 0
#endif
#ifndef ONE_LAUNCH
#define ONE_LAUNCH 1
#endif
namespace pg8 {
#define PG8_LAS __attribute__((address_space(3)))
typedef unsigned short bf16_t;
typedef short bf16x8 __attribute__((ext_vector_type(8)));
typedef float f32x4 __attribute__((ext_vector_type(4)));
typedef unsigned u32x4 __attribute__((ext_vector_type(4)));
constexpr int BM = 256, BK = 64, HALF = 128, HTB = HALF * BK * 2  , STAGE_BYTES = 8 * HTB, NXCD = 8, WGM = 8;

__host__ __device__ __forceinline__ int lds_byte(int r, int c) { const int st = (r >> 4) * 2 + (c >> 5), rr = r & 15, cc = c & 31, ob = rr * 64 + cc * 2; return st * 1024 + (ob ^ (((ob >> 9) & 1) << 5)); }
__host__ __device__ __forceinline__ void stage_rc(int b, int& R, int& C) { const int st = b / 1024, sb = b % 1024, swz = sb ^ (((sb >> 9) & 1) << 5); R = (st >> 1) * 16 + swz / 64; C = (st & 1) * 32 + (swz % 64) / 2; }
__host__ __device__ __forceinline__ int perm32(int rho) { const int n = rho >> 4, i = rho & 15; return 8 * (i >> 2) + 4 * n + (i & 3); }

struct Unit { int pm, pn; };
struct Gemm { const bf16_t* A; const bf16_t* Bt; int M, N, K; };

struct StaticOrder {
    int nM, nN, nwg, G, c, skip_from, skip_n, ex_n, ex_pm0, ex_pn;
    __host__ __device__ void init(int M, int N, int G_, int c_, int sf = 1 << 30, int sn = 0) { nM = M / BM; nN = N / BM; nwg = nM * nN; G = G_; c = c_; skip_from = sf; skip_n = sn; ex_n = 0; ex_pm0 = 0; ex_pn = 0; }
    __host__ __device__ bool next(int i, Unit& u) const {
        const long L = (long)i * G + c; if (L >= nwg + ex_n) return false;
        if (L >= nwg) { u.pm = ex_pm0 + (int)(L - nwg); u.pn = ex_pn; return true; }
        int wgid = (int)L; { const int q = nwg / NXCD, r = nwg % NXCD, xcd = wgid % NXCD, off = wgid / NXCD; wgid = (xcd < r ? xcd * (q + 1) : r * (q + 1) + (xcd - r) * q) + off; }
        const int nig = WGM * nN, gid = wgid / nig, fm = gid * WGM, gsz = (nM - fm) < WGM ? (nM - fm) : WGM;
        u.pm = fm + ((wgid % nig) % gsz); u.pn = (wgid % nig) / gsz; if (u.pn >= skip_from) u.pn += skip_n; return true;
    }
    __device__ __forceinline__ void a_ready(const Unit&) const {}
    __device__ __forceinline__ void done(const Unit&) const {}
};

__device__ __forceinline__ unsigned cvt_pk_bf16(float lo, float hi) { unsigned r; asm volatile("v_cvt_pk_bf16_f32 %0, %1, %2" : "=v"(r) : "v"(lo), "v"(hi)); return r; }
typedef float f32x2 __attribute__((ext_vector_type(2)));
__device__ __forceinline__ f32x2 gelu_pk(f32x2 v) {
    const f32x2 av = __builtin_elementwise_abs(v), d = av * 0.2316418882f + 1.0f;
    f32x2 t; t.x = __builtin_amdgcn_rcpf(d.x); t.y = __builtin_amdgcn_rcpf(d.y);
    f32x2 q = t * 0.5307027145f + (-0.7265760135f); q = q * t + 0.7107068705f; q = q * t + (-0.142248368f); q = q * t + 0.127414796f; q = q * t;
    const f32x2 s = (v * v) * (-0.72134752044f);
    f32x2 e; e.x = __builtin_amdgcn_exp2f(s.x); e.y = __builtin_amdgcn_exp2f(s.y);
    const f32x2 m = v * (q * e), r = v - m;
    f32x2 o; o.x = v.x < 0.f ? m.x : r.x; o.y = v.y < 0.f ? m.y : r.y; return o;
}

template <int ACT  > struct EpiBf16 {
    static constexpr bool PERM = true, AFTER_DRAIN = false; static_assert(ACT == 0 || ACT == 1, "EpiBf16: ACT is 0 (none) or 1 (gelu_pk)");
    bf16_t* O; int ldc; const float* bias; int split_cols; size_t split_stride; float scale0;
    __device__ __forceinline__ void operator()(const f32x4 (&acc)[2][2][4][2], const Unit& u, int wr, int wc, int fr, int fq) const {
        const int row0 = u.pm * BM + wr * 64 + fr; int colt = u.pn * BM; bf16_t* base = O;
        float sc = 1.f; if (split_cols) { const int t = colt / split_cols; base += (size_t)t * split_stride; colt -= t * split_cols; if (t == 0) sc = scale0; }
        const int col0 = colt + wc * 32 + 8 * fq, bcol0 = u.pn * BM + wc * 32 + 8 * fq;
        f32x4 bv[2][2];
#pragma unroll
        for (int bj = 0; bj < 2; ++bj)
#pragma unroll
            for (int n = 0; n < 2; ++n) bv[bj][n] = bias ? *(const f32x4*)(bias + bcol0 + bj * HALF + 4 * n) : (f32x4){0.f, 0.f, 0.f, 0.f};
#pragma unroll
        for (int ai = 0; ai < 2; ++ai)
#pragma unroll
            for (int m = 0; m < 4; ++m) { bf16_t* rowp = base + (size_t)(row0 + ai * HALF + m * 16) * ldc + col0;
#pragma unroll
                for (int bj = 0; bj < 2; ++bj) { f32x4 v0 = acc[ai][bj][m][0] + bv[bj][0], v1 = acc[ai][bj][m][1] + bv[bj][1];
                    if (ACT == 1) { f32x2 a = gelu_pk((f32x2){v0[0], v0[1]}), b = gelu_pk((f32x2){v0[2], v0[3]}), c = gelu_pk((f32x2){v1[0], v1[1]}), d = gelu_pk((f32x2){v1[2], v1[3]});
                        v0 = (f32x4){a.x, a.y, b.x, b.y}; v1 = (f32x4){c.x, c.y, d.x, d.y}; }
                    v0 = v0 * sc; v1 = v1 * sc; u32x4 w; w.x = cvt_pk_bf16(v0[0], v0[1]); w.y = cvt_pk_bf16(v0[2], v0[3]); w.z = cvt_pk_bf16(v1[0], v1[1]); w.w = cvt_pk_bf16(v1[2], v1[3]);
                    *(u32x4*)(rowp + bj * HALF) = w; } }
    }
};
struct EpiF32Split {
    static constexpr bool PERM = false, AFTER_DRAIN = false;
    float* C; int ldc; int split_cols; size_t split_stride; bf16_t* MB;
    __device__ __forceinline__ void operator()(const f32x4 (&acc)[2][2][4][2], const Unit& u, int wr, int wc, int fr, int fq) const {
        typedef unsigned u32x2v __attribute__((ext_vector_type(2)));
        int colt = u.pn * BM; float* base = C; bf16_t* mb = MB;
        if (split_cols) { const int t = colt / split_cols; base += (size_t)t * split_stride; mb += (size_t)t * split_stride; colt -= t * split_cols; }
        const int row0 = u.pm * BM + wr * 64 + fr, col0 = colt + wc * 32 + 4 * fq;
#pragma unroll
        for (int ai = 0; ai < 2; ++ai)
#pragma unroll
            for (int m = 0; m < 4; ++m) { float* rowp = base + (size_t)(row0 + ai * HALF + m * 16) * ldc + col0; bf16_t* rowb = mb + (size_t)(row0 + ai * HALF + m * 16) * ldc + col0;
#pragma unroll
                for (int bj = 0; bj < 2; ++bj)
#pragma unroll
                    for (int n = 0; n < 2; ++n) { const f32x4 v = acc[ai][bj][m][n]; *(f32x4*)(rowp + bj * HALF + n * 16) = v;
                        u32x2v w; w.x = cvt_pk_bf16(v[0], v[1]); w.y = cvt_pk_bf16(v[2], v[3]); *(u32x2v*)(rowb + bj * HALF + n * 16) = w; } }
    }
};
struct EpiBf16NP {
    static constexpr bool PERM = true, AFTER_DRAIN = false;
    bf16_t* O; int ldc; const float* TAB; int rot_cols, kcol0;
    __device__ __forceinline__ void operator()(const f32x4 (&acc)[2][2][4][2], const Unit& u, int wr, int wc, int fr, int fq) const {
        const int row0 = u.pm * BM + wr * 64 + fr, col0 = u.pn * BM + wc * 32 + 8 * fq;
        const bool rot = u.pn * BM < rot_cols; const float scl = (u.pn * BM >= kcol0) ? 0.0625f : 1.0f;
#pragma unroll
        for (int ai = 0; ai < 2; ++ai)
#pragma unroll
            for (int m = 0; m < 4; ++m) { const int row = row0 + ai * HALF + m * 16; bf16_t* rowp = O + (size_t)row * ldc + col0;
                const int p = row < 8192 ? (row & 4095) : (row < 8224 ? 4096 + ((row - 8192) & 3) : 0);
                const float* tb = TAB + ((size_t)p * 128 + ((col0 & 255) >> 1)) * 2;
#pragma unroll
                for (int bj = 0; bj < 2; ++bj) { f32x4 v0 = acc[ai][bj][m][0], v1 = acc[ai][bj][m][1];
                    if (rot) { const f32x4 c0 = *(const f32x4*)(tb + bj * HALF), c1 = *(const f32x4*)(tb + bj * HALF + 4);
                        v0 = (f32x4){(v0[0] * c0[0] - v0[1] * c0[1]) * scl, (v0[1] * c0[0] + v0[0] * c0[1]) * scl, (v0[2] * c0[2] - v0[3] * c0[3]) * scl, (v0[3] * c0[2] + v0[2] * c0[3]) * scl};
                        v1 = (f32x4){(v1[0] * c1[0] - v1[1] * c1[1]) * scl, (v1[1] * c1[0] + v1[0] * c1[1]) * scl, (v1[2] * c1[2] - v1[3] * c1[3]) * scl, (v1[3] * c1[2] + v1[2] * c1[3]) * scl}; }
                    u32x4 w; w.x = cvt_pk_bf16(v0[0], v0[1]); w.y = cvt_pk_bf16(v0[2], v0[3]); w.z = cvt_pk_bf16(v1[0], v1[1]); w.w = cvt_pk_bf16(v1[2], v1[3]);
                    *(u32x4*)(rowp + bj * HALF) = w; } }
    }
};
struct EpiResid {
    static constexpr bool PERM = false, AFTER_DRAIN = false;
    const float* __restrict__ X; float* __restrict__ Z; int ldc; float alpha;
    __device__ __forceinline__ void operator()(const f32x4 (&acc)[2][2][4][2], const Unit& u, int wr, int wc, int fr, int fq) const {
        const int row0 = u.pm * BM + wr * 64 + fr, col0 = u.pn * BM + wc * 32 + 4 * fq;
#pragma unroll
        for (int ai = 0; ai < 2; ++ai)
#pragma unroll
            for (int mp = 0; mp < 2; ++mp) { f32x4 xv[2][2][2];
#pragma unroll
                for (int mm = 0; mm < 2; ++mm) { const float* rowp = X + (size_t)(row0 + ai * HALF + (2 * mp + mm) * 16) * ldc + col0;
#pragma unroll
                    for (int bj = 0; bj < 2; ++bj)
#pragma unroll
                        for (int n = 0; n < 2; ++n) xv[mm][bj][n] = *(const f32x4*)(rowp + bj * HALF + n * 16); }
#pragma unroll
                for (int mm = 0; mm < 2; ++mm) { float* rowz = Z + (size_t)(row0 + ai * HALF + (2 * mp + mm) * 16) * ldc + col0;
#pragma unroll
                    for (int bj = 0; bj < 2; ++bj)
#pragma unroll
                        for (int n = 0; n < 2; ++n) *(f32x4*)(rowz + bj * HALF + n * 16) = xv[mm][bj][n] * alpha + acc[ai][bj][2 * mp + mm][n]; } }
    }
};
template <class Epi, class Sched, bool ALIGN_EPI = false, bool SP2 = false>
__device__ __forceinline__ void gemm_phase(PG8_LAS unsigned char* lds, const Gemm g, const Sched& S, const Epi& E) {
    int tid_ = threadIdx.x; asm volatile("" : "+v"(tid_));
    const int tid = tid_, wid = __builtin_amdgcn_readfirstlane(tid >> 6), lane = tid & 63, wr = wid >> 2, wc = wid & 3, fr = lane & 15, fq = lane >> 4;
    const int K = g.K, nt = K / BK;
    unsigned voffA[2], voffB[2];
#pragma unroll
    for (int i = 0; i < 2; ++i) { int R, C; stage_rc(tid * 16 + i * 8192, R, C); const int Rb = Epi::PERM ? ((R & ~31) + perm32(R & 31)) : R;
        voffA[i] = (unsigned)(R * K + C) * 2u; voffB[i] = (unsigned)(Rb * K + C) * 2u; }
    const size_t kstep = (size_t)(BK * 2);
    const size_t hstep = (size_t)HALF * K * 2;
    const size_t tstep = 2 * hstep;
    const unsigned ldsw = (unsigned)wid * 1024u;
    const int aoff = lds_byte(wr * 64 + fr, fq * 8), boff = lds_byte(wc * 32 + fr, fq * 8);
#define PG8_SA(b, h) (((b) * 2 + (h)) * HTB)
#define PG8_SB(b, h) ((4 + (b) * 2 + (h)) * HTB)
#define PG8_STAGE(bufoff, gbase, voff) do { _Pragma("unroll") for (int _i = 0; _i < 2; ++_i) \
        __builtin_amdgcn_global_load_lds((const unsigned*)((const char*)(gbase) + (voff)[_i]), (PG8_LAS unsigned*)(lds + (bufoff) + ldsw + _i * 8192), 16, 0, 0); } while (0)
#define PG8_LDA(dst, b, h) do { _Pragma("unroll") for (int m = 0; m < 4; ++m) _Pragma("unroll") for (int k = 0; k < 2; ++k) dst[m][k] = *(const PG8_LAS bf16x8*)(lds + PG8_SA(b, h) + aoff + m * 2048 + k * 1024); } while (0)
#define PG8_LDB(dst, b, h) do { _Pragma("unroll") for (int n = 0; n < 2; ++n) _Pragma("unroll") for (int k = 0; k < 2; ++k) dst[n][k] = *(const PG8_LAS bf16x8*)(lds + PG8_SB(b, h) + boff + n * 2048 + k * 1024); } while (0)
#define PG8_MMA(ai, bj, At, Bt) do { __builtin_amdgcn_s_setprio(1); _Pragma("unroll") for (int m = 0; m < 4; ++m) _Pragma("unroll") for (int n = 0; n < 2; ++n) _Pragma("unroll") for (int k = 0; k < 2; ++k) \
        acc[ai][bj][m][n] = __builtin_amdgcn_mfma_f32_16x16x32_bf16(Bt[n][k], At[m][k], acc[ai][bj][m][n], 0, 0, 0); __builtin_amdgcn_s_setprio(0); } while (0)
#define PG8_WAIT_V(n) asm volatile("s_waitcnt vmcnt(" #n ")" ::: "memory")
#define PG8_WAIT_L(n) asm volatile("s_waitcnt lgkmcnt(" #n ")" ::: "memory")
#define PG8_BAR __builtin_amdgcn_s_barrier()
#define PG8_SCHED __builtin_amdgcn_sched_barrier(0)
    Unit cur, nxt; int ui = 0;
    if (!S.next(0, cur)) return;
    f32x4 acc[2][2][4][2];
#pragma unroll
    for (int a = 0; a < 2; ++a)
#pragma unroll
        for (int b = 0; b < 2; ++b)
#pragma unroll
            for (int m = 0; m < 4; ++m)
#pragma unroll
                for (int n = 0; n < 2; ++n) acc[a][b][m][n] = (f32x4){0.f, 0.f, 0.f, 0.f};
    bf16x8 At[4][2], B0[2][2], B1[2][2];
    const char* cA = (const char*)g.A + (size_t)cur.pm * tstep; const char* cB = (const char*)g.Bt + (size_t)cur.pn * tstep;
    S.a_ready(cur);
    if constexpr (SP2) {
        PG8_STAGE(PG8_SB(0, 0), cB, voffB); PG8_STAGE(PG8_SB(0, 1), cB + hstep, voffB); PG8_STAGE(PG8_SA(0, 0), cA, voffA); PG8_STAGE(PG8_SA(0, 1), cA + hstep, voffA);
        if (wr == 1) PG8_BAR;
        PG8_WAIT_V(2); PG8_BAR;
        PG8_STAGE(PG8_SB(1, 0), cB + kstep, voffB); PG8_STAGE(PG8_SA(1, 0), cA + kstep, voffA); PG8_STAGE(PG8_SB(1, 1), cB + hstep + kstep, voffB);
        PG8_WAIT_V(6); PG8_BAR;
    } else {
        PG8_STAGE(PG8_SB(0, 0), cB, voffB); PG8_STAGE(PG8_SA(0, 0), cA, voffA); PG8_STAGE(PG8_SB(0, 1), cB + hstep, voffB); PG8_STAGE(PG8_SA(0, 1), cA + hstep, voffA);
        if (wr == 1) PG8_BAR;
        PG8_WAIT_V(4); PG8_BAR;
        PG8_STAGE(PG8_SB(1, 0), cB + kstep, voffB); PG8_STAGE(PG8_SA(1, 0), cA + kstep, voffA); PG8_STAGE(PG8_SB(1, 1), cB + hstep + kstep, voffB);
        PG8_WAIT_V(6); PG8_BAR;
    }
    for (;;) {
        const bool has_next = S.next(ui + 1, nxt);
        const char* nA = has_next ? (const char*)g.A + (size_t)nxt.pm * tstep : cA; const char* nB = has_next ? (const char*)g.Bt + (size_t)nxt.pn * tstep : cB;
        for (int t = 0; t < nt; t += 2) {
            const bool last = (t == nt - 2);
            const char* a1 = cA + (size_t)(t + 1) * kstep;
            const char* a2 = last ? nA : cA + (size_t)(t + 2) * kstep; const char* b2 = last ? nB : cB + (size_t)(t + 2) * kstep;
            const char* a3 = a2 + kstep; const char* b3 = b2 + kstep;
            if (last && has_next) S.a_ready(nxt);
            if constexpr (SP2) {
            PG8_LDB(B0, 0, 0); PG8_LDB(B1, 0, 1); PG8_SCHED; PG8_LDA(At, 0, 0); PG8_STAGE(PG8_SA(1, 1), a1 + hstep, voffA);
            PG8_WAIT_V(8); PG8_WAIT_L(0); PG8_BAR; PG8_MMA(0, 0, At, B0); PG8_MMA(0, 1, At, B1); PG8_BAR; PG8_SCHED;
            PG8_LDA(At, 0, 1); PG8_STAGE(PG8_SB(0, 0), b2, voffB); PG8_STAGE(PG8_SB(0, 1), b2 + hstep, voffB); PG8_STAGE(PG8_SA(0, 0), a2, voffA);
            PG8_WAIT_V(8); PG8_WAIT_L(0); PG8_BAR; PG8_MMA(1, 0, At, B0); PG8_MMA(1, 1, At, B1); PG8_BAR; PG8_SCHED;
            PG8_LDB(B0, 1, 0); PG8_LDB(B1, 1, 1); PG8_SCHED; PG8_LDA(At, 1, 0); PG8_STAGE(PG8_SA(0, 1), a2 + hstep, voffA);
            PG8_WAIT_V(8); PG8_WAIT_L(0); PG8_BAR; PG8_MMA(0, 0, At, B0); PG8_MMA(0, 1, At, B1); PG8_BAR; PG8_SCHED;
            PG8_LDA(At, 1, 1); PG8_STAGE(PG8_SB(1, 0), b3, voffB); PG8_STAGE(PG8_SB(1, 1), b3 + hstep, voffB); PG8_STAGE(PG8_SA(1, 0), a3, voffA);
            PG8_WAIT_V(8); PG8_WAIT_L(0); PG8_BAR; PG8_MMA(1, 0, At, B0); PG8_MMA(1, 1, At, B1); PG8_BAR; PG8_SCHED;
            } else {
            PG8_LDB(B0, 0, 0); PG8_SCHED; PG8_LDA(At, 0, 0); PG8_STAGE(PG8_SA(1, 1), a1 + hstep, voffA);
            PG8_WAIT_L(8); PG8_BAR; PG8_WAIT_L(0); PG8_MMA(0, 0, At, B0); PG8_BAR; PG8_SCHED;
            PG8_LDB(B1, 0, 1); PG8_STAGE(PG8_SB(0, 0), b2, voffB);
            PG8_BAR; PG8_WAIT_L(0); PG8_MMA(0, 1, At, B1); PG8_BAR;
            PG8_LDA(At, 0, 1); PG8_STAGE(PG8_SA(0, 0), a2, voffA);
            PG8_BAR; PG8_WAIT_L(0); PG8_MMA(1, 0, At, B0); PG8_BAR; PG8_SCHED;
            PG8_STAGE(PG8_SB(0, 1), b2 + hstep, voffB);
            PG8_WAIT_V(6); PG8_BAR; PG8_MMA(1, 1, At, B1); PG8_BAR;
            PG8_LDB(B0, 1, 0); PG8_SCHED; PG8_LDA(At, 1, 0); PG8_STAGE(PG8_SA(0, 1), a2 + hstep, voffA);
            PG8_WAIT_L(8); PG8_BAR; PG8_WAIT_L(0); PG8_MMA(0, 0, At, B0); PG8_BAR; PG8_SCHED;
            PG8_LDB(B1, 1, 1); PG8_STAGE(PG8_SB(1, 0), b3, voffB);
            PG8_BAR; PG8_WAIT_L(0); PG8_MMA(0, 1, At, B1); PG8_BAR;
            PG8_LDA(At, 1, 1); PG8_STAGE(PG8_SA(1, 0), a3, voffA);
            PG8_BAR; PG8_WAIT_L(0); PG8_MMA(1, 0, At, B0); PG8_BAR; PG8_SCHED;
            PG8_STAGE(PG8_SB(1, 1), b3 + hstep, voffB);
            PG8_WAIT_V(6); PG8_BAR; PG8_MMA(1, 1, At, B1); PG8_BAR;
            }
        }
        if constexpr (ALIGN_EPI) { if (wr == 0) PG8_BAR; }
        if constexpr (!Epi::AFTER_DRAIN) { for (int rpe_ = 0; rpe_ < REPE; ++rpe_) { E(acc, cur, wr, wc, fr, fq); asm volatile("" ::: "memory"); } S.done(cur); }
        if (!has_next) break;
#pragma unroll
        for (int a = 0; a < 2; ++a)
#pragma unroll
            for (int b = 0; b < 2; ++b)
#pragma unroll
                for (int m = 0; m < 4; ++m)
#pragma unroll
                    for (int n = 0; n < 2; ++n) acc[a][b][m][n] = (f32x4){0.f, 0.f, 0.f, 0.f};
        cur = nxt; cA = nA; cB = nB; ++ui;
        if constexpr (ALIGN_EPI) { if (wr == 1) PG8_BAR; }
    }
    PG8_WAIT_V(0);
    if constexpr (!ALIGN_EPI) { if (wr == 0) PG8_BAR; }
    PG8_BAR;
    if constexpr (Epi::AFTER_DRAIN) { E.fused(acc, cur, wr, wc, fr, fq, lds, wid, lane); S.done(cur); }
#undef PG8_SA
#undef PG8_SB
#undef PG8_STAGE
#undef PG8_LDA
#undef PG8_LDB
#undef PG8_MMA
#undef PG8_WAIT_V
#undef PG8_WAIT_L
#undef PG8_BAR
#undef PG8_SCHED
}
}
constexpr int DM = 2048, SEQ = 4096, TP = 8192, TS = 32, TT = TP + TS, MPAD = 8448;
constexpr int EVEN_IN = 6784, EVEN_INP = 6912, ODD_IN = 7168, LDH = 7168;
constexpr int EVEN_OUT = 1536, ODD_OUT = 2048;
constexpr float ALPHA = 1.6817928305074292f;
constexpr float LN_EPS = 1e-5f;
constexpr int EC_R = 0, EC_K = 768, EC_V = 1536, EC_HW = 2304, EC_HA = 2368, EC_GA = 2432, EC_QB = 3200, EC_KB = 3968, EC_VB = 4736, EC_GB = 5504, EC_QM = 5760, EC_GM = 6272;
constexpr int OC_Q = 0, OC_K = 1536, OC_V = 3072, OC_G = 4608, OC_QM = 6144, OC_GM = 6656;
constexpr size_t O_YP = 0, O_YS = 16777216, O_RWKV_P = O_YS + 65536, O_RWKV_S = O_RWKV_P + 196608, O_SH_P = O_RWKV_S + 786432, O_SH_S = O_SH_P + 9728,
    O_G0P = O_SH_S + 38912, O_G0S = O_G0P + 262144, O_G1P = O_G0S + 32768, O_G1S = O_G1P + 1048576, O_G2P = O_G1S + 32768, O_G2S = O_G2P + 4194304,
    O_RET_P = O_G2S + 32768, O_RET_S = O_RET_P + 1572864, O_MEM = O_RET_S + 6291456, O_END = O_MEM + 2097152;
constexpr size_t MiB = 1u << 20;
constexpr size_t WS_CTL = 0, WS_WTIN = 1 * MiB, WS_WTOUT = 29 * MiB, WS_WTMEM = 37 * MiB, WS_MEMB = 53 * MiB, WS_TAB = 55 * MiB, WS_XB = 60 * MiB, WS_XZ = 93 * MiB,
    WS_HB = 159 * MiB, WS_U = 275 * MiB, WS_YA = 308 * MiB, WS_PREP = 333 * MiB, WS_OG = 478 * MiB, WS_LSE = 478 * MiB + 49 * MiB / 2, WS_MKVB = 503 * MiB, WS_VT = 507 * MiB, WS_WTOUT2 = 509 * MiB, WS_END = 517 * MiB;
constexpr int LDS_BYTES = 147456;

#define LAS __attribute__((address_space(3)))
typedef unsigned short bf16;
typedef float f32x4 __attribute__((ext_vector_type(4)));
typedef short bf16x8 __attribute__((ext_vector_type(8)));
typedef unsigned u32x4 __attribute__((ext_vector_type(4)));
typedef unsigned u32x2 __attribute__((ext_vector_type(2)));

__device__ const double ANG[128] = {
1.0, 0.9300449458481392, 0.8649836012976682, 0.8044736266284181, 0.7481966305138833, 0.6958564947100448, 0.6471778159406796, 0.6019044567806663, 0.5597981979123284, 0.5206374846632574, 0.48421626123015066, 0.45034288645458387, 0.41883912544574814, 0.3895392117442728, 0.362288975092429, 0.336945030221216, 0.31337402238589046, 0.29145192568009903, 0.2710633904364836, 0.2521011362799124, 0.23446538763970548, 0.21806334875063282, 0.20280871538024622, 0.18862122071335174, 0.17542621300415914, 0.1631542627737973, 0.15174079748634942, 0.14112576178114528, 0.13125330147352265, 0.12207146966133185, 0.11353195339077617, 0.10558981944335787, 0.09820327790631257, 0.09133346228248625, 0.08494422498263796, 0.07900194712408967, 0.07347536163492155, 0.06833538873292307, 0.06355498291362295, 0.059108990642279875, 0.05497401800103736, 0.05112830759482943, 0.04755162406834012, 0.04422514763163046, 0.04113137503418572, 0.03825402746632876, 0.03557796490339495, 0.03308910644196496, 0.030774356208980617, 0.02862153445389273, 0.026619313461261302, 0.024757157946593413, 0.023025269621793302, 0.02141453563853956, 0.019916480638308563, 0.018523222156741202, 0.017227429147699425, 0.01602228340877477, 0.014901443705277463, 0.013859012403933875, 0.01288950444072537, 0.01198781845958378, 0.011149209970080915, 0.01036926638287344, 0.009643883791544459, 0.008969245378672715, 0.008341801332506338, 0.007758250168566794, 0.007215521357901014, 0.006710759170575141, 0.006241307649397462, 0.00580469663480544, 0.005398628767382501, 0.005020967399614466, 0.004669725353279709, 0.0043430544633167095, 0.0040392358531509045, 0.003756670890311596, 0.0034938727747491297, 0.0032494587155918425, 0.0030221426551783792, 0.002810728502080728, 0.002614103837511492, 0.002431234061999789, 0.002261156951536743, 0.002102977594546134, 0.0019558636830395095, 0.0018190411331788228, 0.0016917900122028363, 0.0015734407502856099, 0.0014633706173946357, 0.0013610004466105522, 0.001265791586667203, 0.001177243067676929, 0.001094888965127687, 0.0010182959482819048, 0.0009470610000772239, 0.0008808092965317064, 0.0008191922344953685, 0.0007618855973704613, 0.0007085878491488872, 0.0006590185477903263, 0.0006129168695925734, 0.0005700402367896359, 0.0005301630411562774, 0.000493075456902875, 0.00045858233661428085, 0.00042650218442334204, 0.0003966662010161199, 0.00036891739544382435, 0.0003431097590679882, 0.0003191074972923552, 0.00029678431503900375, 0.0002760227522090274, 0.00025671356563109924, 0.00023875515424585844, 0.00022205302450155334, 0.00020651929314796272, 0.00019207222481239299, 0.0001786358019245737, 0.00016613932472747905, 0.0001545170392694147, 0.0001437077914199376, 0.00013365470508911156, 0.00012430488295695166, 0.00011560912813835741, 0.00010752168531898921, 0.0001};
__device__ const float LG2G[6] = {-0.04580368961312479f, -0.02272007650008353f, -0.011315313227834146f, -0.005646563141142063f, -0.0028205190623786626f, -0.0014095702546713536f};

__device__ __forceinline__ float bf2f(unsigned b) { return __uint_as_float(b << 16); }
typedef __bf16 bf16x2_t __attribute__((ext_vector_type(2)));
typedef float f32x2_t __attribute__((ext_vector_type(2)));
__device__ __forceinline__ unsigned f2bf(float f) { return (unsigned)__builtin_bit_cast(unsigned short, (__bf16)f); }
__device__ __forceinline__ unsigned pk2(float lo, float hi) { const f32x2_t v = {lo, hi}; return __builtin_bit_cast(unsigned, __builtin_convertvector(v, bf16x2_t)); }
__device__ __forceinline__ void unpk4(u32x2 w, float (&x)[4]) { x[0] = __uint_as_float(w.x << 16); x[1] = __uint_as_float(w.x & 0xffff0000u); x[2] = __uint_as_float(w.y << 16); x[3] = __uint_as_float(w.y & 0xffff0000u); }
__device__ __forceinline__ void unpk8(u32x4 w, float (&x)[8]) {
    x[0] = __uint_as_float(w.x << 16); x[1] = __uint_as_float(w.x & 0xffff0000u); x[2] = __uint_as_float(w.y << 16); x[3] = __uint_as_float(w.y & 0xffff0000u);
    x[4] = __uint_as_float(w.z << 16); x[5] = __uint_as_float(w.z & 0xffff0000u); x[6] = __uint_as_float(w.w << 16); x[7] = __uint_as_float(w.w & 0xffff0000u); }
template <int CTRL> __device__ __forceinline__ float dppf(float x) { return __builtin_bit_cast(float, __builtin_amdgcn_update_dpp(0, __builtin_bit_cast(int, x), CTRL, 0xF, 0xF, true)); }
__device__ __forceinline__ float red16(float x) { x += dppf<0xB1>(x); x += dppf<0x4E>(x); x += dppf<0x141>(x); x += dppf<0x140>(x); return x; }
__device__ __forceinline__ float wave_sum(float x) { x = red16(x); x += __shfl_xor(x, 16); x += __shfl_xor(x, 32); return x; }
__device__ __forceinline__ float sigmoidf_(float x) { return 1.0f / (1.0f + __expf(-x)); }
__device__ __forceinline__ float siluf_(float x) { return x / (1.0f + __expf(-x)); }
#define LDS_WAIT() asm volatile("s_waitcnt lgkmcnt(0)" ::: "memory")

struct Args { const float* in[27]; float* out; unsigned char* ws; int ph_lo, ph_hi; };
typedef const __attribute__((address_space(4))) Args* ArgsP;
struct Ctx {
    ArgsP ap;
    LAS unsigned char* lds;
    int tid, lane, wave, bid, G;
};
#define C_IN(k) (c.ap->in[k])
#define C_OUT (c.ap->out)
#define C_WTIN_L(l_) (((l_) & 1) ? (bf16*)(c.ap->out + O_YP) : (bf16*)(c.ap->ws + WS_WTIN))
#define C_WTOUT_L(l_) ((bf16*)(c.ap->ws + (((l_) & 1) ? WS_WTOUT2 : WS_WTOUT)))
#define C_WTMEM ((bf16*)(c.ap->ws + WS_WTMEM))
#define C_MEMB ((bf16*)(c.ap->ws + WS_MEMB))
#define C_XB ((bf16*)(c.ap->ws + WS_XB))
#define C_HB ((bf16*)(c.ap->ws + WS_HB))
#define C_U ((bf16*)(c.ap->ws + WS_U))
#define C_TAB ((float*)(c.ap->ws + WS_TAB))
#define C_XZ ((float*)(c.ap->ws + WS_XZ))
#define C_YA ((float*)(c.ap->ws + WS_YA))
#define C_PREP ((float*)(c.ap->ws + WS_PREP))
#define C_CHK ((unsigned char*)(c.ap->ws + WS_PREP))
#define C_PREPS ((float*)(c.ap->ws + WS_PREP + 120 * MiB))
#define C_BONUS ((float*)(c.ap->ws + WS_PREP + 125 * MiB))
#define C_WUT ((bf16*)(c.ap->ws + WS_PREP + 126 * MiB))
#define C_AUT ((bf16*)(c.ap->ws + WS_PREP + 126 * MiB) + 2 * 768 * 64)
constexpr int CHK_BYTES = 40960, CK_A = 0, CK_RQ = 9216, CK_GT = 13824, CK_YVT = 31232;
#define C_YR ((float*)(c.ap->ws + WS_PREP))
#define C_Z ((float*)(c.ap->ws + WS_HB))
#define C_OG ((float*)(c.ap->ws + WS_OG))
#define C_LSE ((float*)(c.ap->ws + WS_LSE))
#define C_MKVB ((bf16*)(c.ap->ws + WS_MKVB))
#define C_VT ((bf16*)(c.ap->ws + WS_VT))

__device__ __forceinline__ void transpose_item(const float* W, int K, int N, bf16* WT, int row_off, LAS float* scr, int item, int lane) {
    const int nblk = N / 32, kb = item / nblk, nb = item % nblk, k0 = 64 * kb, n0 = 32 * nb;
    f32x4 wv[8];
#pragma unroll
    for (int i = 0; i < 8; ++i) { const int kk = 8 * i + (lane >> 3), c4 = 4 * (lane & 7); wv[i] = *(const f32x4*)(W + (size_t)(k0 + kk) * N + n0 + c4); }
#pragma unroll
    for (int i = 0; i < 8; ++i) { const int kk = 8 * i + (lane >> 3), c4 = 4 * (lane & 7); const f32x4 w4 = wv[i];
        scr[kk * 33 + c4] = w4.x; scr[kk * 33 + c4 + 1] = w4.y; scr[kk * 33 + c4 + 2] = w4.z; scr[kk * 33 + c4 + 3] = w4.w; }
    LDS_WAIT(); asm volatile("" ::: "memory");
    const int c = lane & 7;
#pragma unroll
    for (int j = 0; j < 4; ++j) { const int n = (lane >> 3) + 8 * j; const LAS float* s = scr + (8 * c) * 33 + n;
        u32x4 o; o.x = pk2(s[0 * 33], s[1 * 33]); o.y = pk2(s[2 * 33], s[3 * 33]); o.z = pk2(s[4 * 33], s[5 * 33]); o.w = pk2(s[6 * 33], s[7 * 33]);
        *(u32x4*)(WT + (size_t)(row_off + n0 + n) * K + k0 + 8 * c) = o; }
    LDS_WAIT(); asm volatile("" ::: "memory");
}
__device__ __forceinline__ void transpose_matrix(const Ctx& c, const float* W, int K, int N, bf16* WT, int row_off) {
    LAS float* scr = (LAS float*)(c.lds + c.wave * 16384);
    const int gw = c.bid * 8 + c.wave, NGW = c.G * 8, nitems = (K / 64) * (N / 32);
    for (int it = gw; it < nitems; it += NGW) transpose_item(W, K, N, WT, row_off, scr, it, c.lane);
}
__device__ __forceinline__ void convert_layer_weights(const Ctx& c, int l) {
    if ((l & 1) == 0) { const int e = l >> 1;
        transpose_matrix(c, C_IN(10) + (size_t)e * DM * EVEN_IN, DM, EVEN_IN, C_WTIN_L(l), 0);
        transpose_matrix(c, C_IN(11) + (size_t)e * EVEN_OUT * DM, EVEN_OUT, DM, C_WTOUT_L(l), 0);
        const int n16 = (EVEN_INP - EVEN_IN) * DM * 2 / 16; u32x4* p = (u32x4*)(C_WTIN_L(l) + (size_t)EVEN_IN * DM);
        for (int i = c.bid * 512 + c.tid; i < n16; i += c.G * 512) p[i] = (u32x4){0u, 0u, 0u, 0u};
    } else { const int o = l >> 1;
        transpose_matrix(c, C_IN(12) + (size_t)o * DM * ODD_IN, DM, ODD_IN, C_WTIN_L(l), 0);
        transpose_matrix(c, C_IN(13) + (size_t)o * ODD_OUT * DM, ODD_OUT, DM, C_WTOUT_L(l), 0);
    }
}

__device__ __forceinline__ void phase_prologue(const Ctx& c) {
    for (int l = 0; l < 4; ++l) transpose_matrix(c, C_IN(14) + (size_t)l * DM * 1024, DM, 1024, C_WTMEM, l * 1024);
    convert_layer_weights(c, 0);
    const int gt = c.bid * 512 + c.tid, NT = c.G * 512;
    for (int i = gt; i < 2 * 768 * 64; i += NT) { const int e = i / (768 * 64), rem = i % (768 * 64), col = rem >> 6, k = rem & 63;
        C_WUT[i] = (bf16)f2bf(C_IN(19)[((size_t)e * 64 + k) * 768 + col]); C_AUT[i] = (bf16)f2bf(C_IN(21)[((size_t)e * 64 + k) * 768 + col]); }
    for (int i = gt; i < 512 * DM / 4; i += NT) { const f32x4 v = ((const f32x4*)C_IN(9))[i]; ((u32x2*)C_MEMB)[i] = (u32x2){pk2(v.x, v.y), pk2(v.z, v.w)}; }
    for (int i0 = gt; i0 < MPAD * DM / 4; i0 += 8 * NT) {
        f32x4 v[8];
#pragma unroll
        for (int k = 0; k < 8; ++k) { const int i = i0 + k * NT, row = i / (DM / 4); v[k] = (f32x4){0.f, 0.f, 0.f, 0.f};
            if (i < MPAD * DM / 4) { if (row < TP) v[k] = ((const f32x4*)C_IN(0))[i]; else if (row < TT) v[k] = ((const f32x4*)C_IN(1))[i - TP * (DM / 4)]; } }
#pragma unroll
        for (int k = 0; k < 8; ++k) { const int i = i0 + k * NT; if (i < MPAD * DM / 4) ((u32x2*)C_XB)[i] = (u32x2){pk2(v[k].x, v[k].y), pk2(v[k].z, v[k].w)}; }
    }
    for (int i = gt; i < 4100 * 128; i += NT) {
        const int p = i >> 7, ci = i & 127; const double pos = (double)(p < 4096 ? p : 16384 + (p - 4096));
        double ph = pos * ANG[ci];
        const double k = __builtin_rint(ph * 0.15915494309189535); ph = __builtin_fma(-k, 6.283185307179586, ph); ph = __builtin_fma(-k, 2.4492935982947064e-16, ph);
        const double q = __builtin_rint(ph * 0.6366197723675814); const double y = __builtin_fma(-q, 1.5707963267948966, ph) - q * 6.123233995736766e-17;
        const double y2 = y * y;
        const double sn = y * (1.0 + y2 * (-1.0 / 6 + y2 * (1.0 / 120 + y2 * (-1.0 / 5040 + y2 * (1.0 / 362880 + y2 * (-1.0 / 39916800 + y2 * (1.0 / 6227020800.0)))))));
        const double cs = 1.0 + y2 * (-0.5 + y2 * (1.0 / 24 + y2 * (-1.0 / 720 + y2 * (1.0 / 40320 + y2 * (-1.0 / 3628800 + y2 * (1.0 / 479001600.0 + y2 * (-1.0 / 87178291200.0)))))));
        const int qi = ((int)q) & 3; double co, si;
        if (qi == 0) { co = cs; si = sn; } else if (qi == 1) { co = -sn; si = cs; } else if (qi == 2) { co = -cs; si = -sn; } else { co = sn; si = -cs; }
        C_TAB[2 * i] = (float)co; C_TAB[2 * i + 1] = (float)si;
    }
}

__device__ __forceinline__ void rwkv_prep_item(const Ctx& c, int it, int e) {
    LAS float* lw = (LAS float*)c.lds;
    LAS float* la = lw + 16 * 64;
    const float* mu = C_IN(17) + e * 2432; const float* shift = C_IN(3) + (size_t)e * 8 * 2432;
    const int R0 = it * 16;
    for (int i = c.tid; i < 16 * 128; i += 512) {
        const int tk = i >> 7, cc = i & 127, R = R0 + tk; float val = 0.f;
        if (R < TT) { const int col = EC_HW + cc; const float hcur = bf2f(C_HB[(size_t)R * LDH + col]);
            float hprev;
            if (R < TP) hprev = ((R & (SEQ - 1)) == 0) ? 0.f : bf2f(C_HB[(size_t)(R - 1) * LDH + col]);
            else { const int n = (R - TP) >> 2, t = (R - TP) & 3; hprev = (t == 0) ? shift[n * 2432 + col] : bf2f(C_HB[(size_t)(R - 1) * LDH + col]); }
            const float hs = hcur + (hprev - hcur) * mu[col];
            val = (cc < 64) ? tanhf(hs) : hs; }
        if (cc < 64) lw[tk * 64 + cc] = val; else la[tk * 64 + (cc - 64)] = val;
    }
    __syncthreads();
    const int tl = c.tid & 255, tg = c.tid >> 8;
    const float* w_up = C_IN(19) + (size_t)e * 64 * 768; const float* a_up = C_IN(21) + (size_t)e * 64 * 768;
    const float* w0 = C_IN(18) + e * 768; const float* a0 = C_IN(20) + e * 768; const float* k_k = C_IN(22) + e * 768; const float* k_a = C_IN(23) + e * 768;
#pragma unroll 1
    for (int m = 0; m < 3; ++m) {
        const int col = tl + 256 * m, h = col >> 6, ci = col & 63;
        float xw[8], xa[8];
#pragma unroll
        for (int t = 0; t < 8; ++t) { xw[t] = 0.f; xa[t] = 0.f; }
#pragma unroll 4
        for (int kk = 0; kk < 64; ++kk) { const float wu = w_up[kk * 768 + col], au = a_up[kk * 768 + col];
#pragma unroll
            for (int t = 0; t < 8; ++t) { xw[t] += lw[(tg * 8 + t) * 64 + kk] * wu; xa[t] += la[(tg * 8 + t) * 64 + kk] * au; } }
        const float w0c = w0[col], a0c = a0[col], kkc = k_k[col], kac = k_a[col], mur = mu[EC_R + col], muk = mu[EC_K + col], muv = mu[EC_V + col];
#pragma unroll
        for (int t = 0; t < 8; ++t) {
            const int R = R0 + tg * 8 + t;
            if (R >= TT || R < TP) continue;
            const bf16* hc = C_HB + (size_t)R * LDH; float pr, pk, pv;
            const float cr = bf2f(hc[EC_R + col]), ck = bf2f(hc[EC_K + col]), cv = bf2f(hc[EC_V + col]);
            bool has_prev_row; int n = 0;
            if (R < TP) has_prev_row = (R & (SEQ - 1)) != 0; else { n = (R - TP) >> 2; has_prev_row = ((R - TP) & 3) != 0; }
            if (has_prev_row) { const bf16* hp = hc - LDH; pr = bf2f(hp[EC_R + col]); pk = bf2f(hp[EC_K + col]); pv = bf2f(hp[EC_V + col]); }
            else if (R < TP) { pr = 0.f; pk = 0.f; pv = 0.f; }
            else { const float* sp = shift + n * 2432; pr = sp[EC_R + col]; pk = sp[EC_K + col]; pv = sp[EC_V + col]; }
            const float r = cr + (pr - cr) * mur, k = ck + (pk - ck) * muk, v = cv + (pv - cv) * muv;
            const float decay = __expf(-0.6065306597126334f * sigmoidf_(w0c + xw[t]));
            const float a = sigmoidf_(a0c + xa[t]);
            float kk = k * kkc; const float ss = wave_sum(kk * kk); kk *= rsqrtf(fmaxf(ss, 1e-24f));
            const float k2 = k * (1.0f + (a - 1.0f) * kac);
            float* dst = C_PREPS + ((size_t)(R - TP) * 12 + h) * 384 + ci;
            dst[0] = r; dst[64] = decay; dst[128] = k2; dst[192] = v; dst[256] = -kk; dst[320] = kk * a;
        }
    }
    __syncthreads();
}

__device__ __forceinline__ void dil_attn_item(const Ctx& c, int R, int hh, int e) {
    const int lane = c.lane, kg = lane >> 4, dl = lane & 15;
    float m = -1e30f, l = 0.f, acc[4] = {0.f, 0.f, 0.f, 0.f};
    const bool is_p = R < TP; const int t = is_p ? (R & (SEQ - 1)) : ((R - TP) & 3); const int n = is_p ? 0 : ((R - TP) >> 2);
    const size_t rowbase = is_p ? (size_t)(R - t) : (size_t)(TP + n * 4);
#pragma unroll
    for (int g = 0; g < 3; ++g) {
        const int dil = (g == 0) ? 1 : (g == 1 ? 4 : 16), W = 128 * dil;
        float q[4]; { const u32x2 w = *(const u32x2*)(C_HB + (size_t)R * LDH + EC_QB + g * 256 + hh * 64 + 4 * dl); unpk4(w, q); }
#pragma unroll
        for (int i = 0; i < 4; ++i) q[i] *= 0.125f;
        const float* cache = ((g == 0) ? C_IN(4) : (g == 1 ? C_IN(5) : C_IN(6))) + ((size_t)(e * 8 + n) * W) * 512;
#pragma unroll 1
        for (int j0 = 0; j0 < 129; j0 += 4) {
            const int j = j0 + kg; bool valid = j < 129; float kf[4] = {0.f, 0.f, 0.f, 0.f}, vf[4] = {0.f, 0.f, 0.f, 0.f};
            if (is_p) { const int pos = t - dil * j; valid = valid && pos >= 0;
                if (valid) { const bf16* kp = C_HB + (rowbase + pos) * LDH + g * 256 + hh * 64 + 4 * dl; unpk4(*(const u32x2*)(kp + EC_KB), kf); unpk4(*(const u32x2*)(kp + EC_VB), vf); } }
            else if (valid) { const int idx = W + t - dil * j;
                if (idx >= W) { const bf16* kp = C_HB + (rowbase + (idx - W)) * LDH + g * 256 + hh * 64 + 4 * dl; unpk4(*(const u32x2*)(kp + EC_KB), kf); unpk4(*(const u32x2*)(kp + EC_VB), vf); }
                else { const float* kp = cache + (size_t)idx * 512 + hh * 64 + 4 * dl; const f32x4 k4 = *(const f32x4*)kp, v4 = *(const f32x4*)(kp + 256);
                    kf[0] = k4.x; kf[1] = k4.y; kf[2] = k4.z; kf[3] = k4.w; vf[0] = v4.x; vf[1] = v4.y; vf[2] = v4.z; vf[3] = v4.w; } }
            float s = q[0] * kf[0] + q[1] * kf[1] + q[2] * kf[2] + q[3] * kf[3];
            s = red16(s);
            if (valid) { const float mn = fmaxf(m, s), sc = __expf(m - mn), p = __expf(s - mn);
                l = l * sc + p;
#pragma unroll
                for (int i = 0; i < 4; ++i) acc[i] = acc[i] * sc + p * vf[i];
                m = mn; }
        }
    }
#pragma unroll
    for (int off = 16; off <= 32; off <<= 1) {
        const float m2 = __shfl_xor(m, off), l2 = __shfl_xor(l, off); float a2[4];
#pragma unroll
        for (int i = 0; i < 4; ++i) a2[i] = __shfl_xor(acc[i], off);
        const float mn = fmaxf(m, m2), s1 = __expf(m - mn), s2 = __expf(m2 - mn);
        l = l * s1 + l2 * s2;
#pragma unroll
        for (int i = 0; i < 4; ++i) acc[i] = acc[i] * s1 + a2[i] * s2;
        m = mn;
    }
    if (kg == 0) { float gt[4]; unpk4(*(const u32x2*)(C_HB + (size_t)R * LDH + EC_GB + hh * 64 + 4 * dl), gt);
        const float inv = 1.0f / l; float o[4];
#pragma unroll
        for (int i = 0; i < 4; ++i) o[i] = acc[i] * inv * siluf_(gt[i]);
        *(u32x2*)(C_U + (size_t)R * EVEN_OUT + 768 + hh * 64 + 4 * dl) = (u32x2){pk2(o[0], o[1]), pk2(o[2], o[3])}; }
}

__device__ __forceinline__ void mem_attn_item(const Ctx& c, int R, int mh, int l, int qcol, int gcol, int ucol, int ldu) {
    const int lane = c.lane, kg = lane >> 5, dl = lane & 31;
    const float* mkv;
    if (R < TP) mkv = C_OUT + O_MEM + ((size_t)l * 512 + (R >> 12) * 256) * 1024; else mkv = C_IN(8) + ((size_t)l * 8 + ((R - TP) >> 2)) * 256 * 1024;
    float q[4]; unpk4(*(const u32x2*)(C_HB + (size_t)R * LDH + qcol + mh * 128 + 4 * dl), q);
#pragma unroll
    for (int i = 0; i < 4; ++i) q[i] *= 0.08838834764831845f;
    float m = -1e30f, lsum = 0.f, acc[4] = {0.f, 0.f, 0.f, 0.f};
#pragma unroll 8
    for (int j0 = 0; j0 < 256; j0 += 2) {
        const float* kp = mkv + (size_t)(j0 + kg) * 1024 + mh * 128 + 4 * dl; const f32x4 k4 = *(const f32x4*)kp, v4 = *(const f32x4*)(kp + 512);
        float s = q[0] * k4.x + q[1] * k4.y + q[2] * k4.z + q[3] * k4.w;
        s = red16(s); s += __shfl_xor(s, 16);
        const float mn = fmaxf(m, s), sc = __expf(m - mn), p = __expf(s - mn);
        lsum = lsum * sc + p; acc[0] = acc[0] * sc + p * v4.x; acc[1] = acc[1] * sc + p * v4.y; acc[2] = acc[2] * sc + p * v4.z; acc[3] = acc[3] * sc + p * v4.w; m = mn;
    }
    { const float m2 = __shfl_xor(m, 32), l2 = __shfl_xor(lsum, 32); float a2[4];
#pragma unroll
        for (int i = 0; i < 4; ++i) a2[i] = __shfl_xor(acc[i], 32);
        const float mn = fmaxf(m, m2), s1 = __expf(m - mn), s2 = __expf(m2 - mn);
        lsum = lsum * s1 + l2 * s2;
#pragma unroll
        for (int i = 0; i < 4; ++i) acc[i] = acc[i] * s1 + a2[i] * s2; }
    if (kg == 0) { float gt[4]; unpk4(*(const u32x2*)(C_HB + (size_t)R * LDH + gcol + mh * 128 + 4 * dl), gt);
        const float inv = 1.0f / lsum; float o[4];
#pragma unroll
        for (int i = 0; i < 4; ++i) o[i] = acc[i] * inv * siluf_(gt[i]);
        *(u32x2*)(C_U + (size_t)R * ldu + ucol + mh * 128 + 4 * dl) = (u32x2){pk2(o[0], o[1]), pk2(o[2], o[3])}; }
}


typedef float f32x16 __attribute__((ext_vector_type(16)));
__device__ __forceinline__ f32x16 mfma32(bf16x8 a, bf16x8 b, f32x16 cacc) { return __builtin_amdgcn_mfma_f32_32x32x16_bf16(a, b, cacc, 0, 0, 0); }
__device__ __forceinline__ void mem_attn_mfma_item(const Ctx& c, int item, int l, int qcol, int gcol, int ucol, int ldu) {
    const int blk = item >> 2, mh = item & 3, R0 = blk * 32, b = R0 >> 12;
    const int lane = c.lane, r = lane & 31, hh = lane >> 5;
    const bf16* Kb = C_MKVB + ((size_t)l * 512 + b * 256) * 1024 + mh * 128 + 8 * hh;
    const bf16* Vt = C_VT + ((size_t)l * 512 + mh * 128) * 512 + b * 256 + 4 * hh;
    bf16x8 Qf[8];
    { const bf16* qp = C_HB + (size_t)(R0 + r) * LDH + qcol + mh * 128 + 8 * hh;
#pragma unroll
        for (int ks = 0; ks < 8; ++ks) Qf[ks] = *(const bf16x8*)(qp + 16 * ks); }
    f32x16 O[4];
#pragma unroll
    for (int dt = 0; dt < 4; ++dt)
#pragma unroll
        for (int i = 0; i < 16; ++i) O[dt][i] = 0.f;
    float m = -1e30f, lsum = 0.f;
    const float cs = 0.08838834764831845f * 1.4426950408889634f;
#pragma unroll 1
    for (int half = 0; half < 2; ++half) {
        f32x16 S[4];
#pragma unroll
        for (int kt = 0; kt < 4; ++kt) {
#pragma unroll
            for (int i = 0; i < 16; ++i) S[kt][i] = 0.f;
            const bf16* kp = Kb + (size_t)(128 * half + 32 * kt + r) * 1024;
#pragma unroll
            for (int ks = 0; ks < 8; ++ks) S[kt] = mfma32(*(const bf16x8*)(kp + 16 * ks), Qf[ks], S[kt]);
        }
        float mx = -1e30f;
#pragma unroll
        for (int kt = 0; kt < 4; ++kt)
#pragma unroll
            for (int i = 0; i < 16; ++i) mx = fmaxf(mx, S[kt][i]);
        mx = fmaxf(mx, __shfl_xor(mx, 32));
        const float mn = fmaxf(m, mx), sc = __builtin_amdgcn_exp2f((m - mn) * cs); m = mn;
        lsum *= sc;
#pragma unroll
        for (int dt = 0; dt < 4; ++dt)
#pragma unroll
            for (int i = 0; i < 16; ++i) O[dt][i] *= sc;
        float ps = 0.f;
#pragma unroll
        for (int kt = 0; kt < 4; ++kt)
#pragma unroll
            for (int i = 0; i < 16; ++i) { const float p = __builtin_amdgcn_exp2f((S[kt][i] - mn) * cs); S[kt][i] = p; ps += p; }
        lsum += ps;
#pragma unroll
        for (int kt = 0; kt < 4; ++kt)
#pragma unroll
            for (int s2 = 0; s2 < 2; ++s2) {
                const u32x4 pw = (u32x4){pk2(S[kt][8 * s2 + 0], S[kt][8 * s2 + 1]), pk2(S[kt][8 * s2 + 2], S[kt][8 * s2 + 3]), pk2(S[kt][8 * s2 + 4], S[kt][8 * s2 + 5]), pk2(S[kt][8 * s2 + 6], S[kt][8 * s2 + 7])};
                const bf16x8 Pf = __builtin_bit_cast(bf16x8, pw);
                const int kb = 128 * half + 32 * kt + 16 * s2;
#pragma unroll
                for (int dt = 0; dt < 4; ++dt) { const bf16* vp = Vt + (size_t)(32 * dt + r) * 512 + kb;
                    const u32x2 v0 = *(const u32x2*)vp, v1 = *(const u32x2*)(vp + 8); const u32x4 vw = (u32x4){v0.x, v0.y, v1.x, v1.y};
                    O[dt] = mfma32(__builtin_bit_cast(bf16x8, vw), Pf, O[dt]); }
            }
    }
    lsum += __shfl_xor(lsum, 32); const float inv = 1.0f / lsum;
    const bf16* gp = C_HB + (size_t)(R0 + r) * LDH + gcol + mh * 128 + 4 * hh; bf16* up = C_U + (size_t)(R0 + r) * ldu + ucol + mh * 128 + 4 * hh;
#pragma unroll
    for (int dt = 0; dt < 4; ++dt)
#pragma unroll
        for (int g4 = 0; g4 < 4; ++g4) { float gt[4]; unpk4(*(const u32x2*)(gp + 32 * dt + 8 * g4), gt);
            const float o0 = O[dt][4 * g4 + 0] * inv * siluf_(gt[0]), o1 = O[dt][4 * g4 + 1] * inv * siluf_(gt[1]), o2 = O[dt][4 * g4 + 2] * inv * siluf_(gt[2]), o3 = O[dt][4 * g4 + 3] * inv * siluf_(gt[3]);
            *(u32x2*)(up + 32 * dt + 8 * g4) = (u32x2){pk2(o0, o1), pk2(o2, o3)}; }
}
__device__ __forceinline__ void mem_attn_sample_block(const Ctx& c, int item, int l, int qcol, int gcol, int ucol, int ldu);
__device__ __forceinline__ void mem_attn_all(const Ctx& c, int l, int qcol, int gcol, int ucol, int ldu) {
    constexpr int NM = (TP / 32) * 4;
    { const int x = c.bid & 7, nbx = (c.G + 7 - x) >> 3, lb = c.bid >> 3, bb = x >> 2, mh = x & 3;
        for (int r = lb * 8 + c.wave; r < 128; r += nbx * 8) mem_attn_mfma_item(c, ((bb * 128 + r) << 2) | mh, l, qcol, gcol, ucol, ldu); }
    for (int it = c.bid; it < TS * 4; it += c.G) mem_attn_sample_block(c, it, l, qcol, gcol, ucol, ldu);
}

typedef short s16x4 __attribute__((ext_vector_type(4)));
__device__ __forceinline__ f32x4 mfma16(bf16x8 a, bf16x8 b, f32x4 cacc) { return __builtin_amdgcn_mfma_f32_16x16x32_bf16(a, b, cacc, 0, 0, 0); }
__device__ __forceinline__ bf16x8 tr_frag(const LAS bf16* p, int rowstride4) {
    const s16x4 a0 = __builtin_amdgcn_ds_read_tr16_b64_v4i16((LAS s16x4*)p), a1 = __builtin_amdgcn_ds_read_tr16_b64_v4i16((LAS s16x4*)(p + rowstride4));
    return (bf16x8){a0[0], a0[1], a0[2], a0[3], a1[0], a1[1], a1[2], a1[3]};
}
__device__ __forceinline__ void dil_attn_mfma_item(const Ctx& c, int item) {
    const int bh = item / 48, rem = item % 48, b = bh >> 2, hh = bh & 3, g = rem >> 4, idx16 = rem & 15;
    const int dil = 1 << (2 * g), nub = 16 >> (2 * g), rho = idx16 / nub, ub = idx16 % nub;
    LAS bf16* Kl = (LAS bf16*)c.lds;
    LAS bf16* Vl = Kl + 384 * 72;
    const int tid = c.tid, lane = c.lane, wave = c.wave, r = lane & 31, hl = lane >> 5;
    const int ubase = ub * 256 - 128;
    const bf16* hb = C_HB + (size_t)b * SEQ * LDH + g * 256 + hh * 64;
    u32x4 kwv[6], vwv[6];
#pragma unroll
    for (int pass = 0; pass < 6; ++pass) { const int kl = pass * 64 + (tid >> 3), part = tid & 7; int up = ubase + kl; up = up < 0 ? 0 : up;
        const bf16* src = hb + (size_t)(rho + dil * up) * LDH + 8 * part;
        kwv[pass] = *(const u32x4*)(src + EC_KB); vwv[pass] = *(const u32x4*)(src + EC_VB); }
    const int u0 = ub * 256 + 32 * wave;
    bf16x8 Qf[4];
    { const bf16* qp = hb + (size_t)(rho + dil * (u0 + r)) * LDH + EC_QB + 8 * hl;
#pragma unroll
        for (int ks = 0; ks < 4; ++ks) Qf[ks] = *(const bf16x8*)(qp + 16 * ks); }
#pragma unroll
    for (int pass = 0; pass < 6; ++pass) { const int kl = pass * 64 + (tid >> 3), part = tid & 7; *(LAS u32x4*)(Kl + kl * 72 + 8 * part) = kwv[pass]; *(LAS u32x4*)(Vl + kl * 72 + 8 * part) = vwv[pass]; }
    __syncthreads();
    f32x16 S[5];
#pragma unroll
    for (int kt = 0; kt < 5; ++kt) {
#pragma unroll
        for (int i = 0; i < 16; ++i) S[kt][i] = 0.f;
        const LAS bf16* kp = Kl + (32 * wave + 32 * kt + r) * 72 + 8 * hl;
#pragma unroll
        for (int ks = 0; ks < 4; ++ks) S[kt] = mfma32(*(const LAS bf16x8*)(kp + 16 * ks), Qf[ks], S[kt]);
    }
    float mx = -1e30f;
#pragma unroll
    for (int kt = 0; kt < 5; ++kt)
#pragma unroll
        for (int i = 0; i < 16; ++i) { const int kl = 32 * kt + (i & 3) + 8 * (i >> 2) + 4 * hl;
            const bool valid = (kl >= r) && (kl - 128 <= r) && (u0 - 128 + kl >= 0);
            const float sv = valid ? S[kt][i] : -1e30f; S[kt][i] = sv; mx = fmaxf(mx, sv); }
    mx = fmaxf(mx, __shfl_xor(mx, 32));
    const float cs = 0.125f * 1.4426950408889634f;
    float lsum = 0.f;
#pragma unroll
    for (int kt = 0; kt < 5; ++kt)
#pragma unroll
        for (int i = 0; i < 16; ++i) { const float p = __builtin_amdgcn_exp2f((S[kt][i] - mx) * cs); S[kt][i] = p; lsum += p; }
    lsum += __shfl_xor(lsum, 32);
    f32x16 O[2];
#pragma unroll
    for (int dt = 0; dt < 2; ++dt)
#pragma unroll
        for (int i = 0; i < 16; ++i) O[dt][i] = 0.f;
    const LAS bf16* vbase = Vl + (32 * wave + 4 * hl + ((lane & 15) >> 2)) * 72 + 16 * ((lane >> 4) & 1) + 4 * (lane & 3);
#pragma unroll
    for (int kt = 0; kt < 5; ++kt)
#pragma unroll
        for (int s2 = 0; s2 < 2; ++s2) {
            const u32x4 pw = (u32x4){pk2(S[kt][8 * s2 + 0], S[kt][8 * s2 + 1]), pk2(S[kt][8 * s2 + 2], S[kt][8 * s2 + 3]), pk2(S[kt][8 * s2 + 4], S[kt][8 * s2 + 5]), pk2(S[kt][8 * s2 + 6], S[kt][8 * s2 + 7])};
            const bf16x8 Pf = __builtin_bit_cast(bf16x8, pw);
#pragma unroll
            for (int dt = 0; dt < 2; ++dt) { const LAS bf16* vp = vbase + (32 * kt + 16 * s2) * 72 + 32 * dt;
                const s16x4 a0 = __builtin_amdgcn_ds_read_tr16_b64_v4i16((LAS s16x4*)vp), a1 = __builtin_amdgcn_ds_read_tr16_b64_v4i16((LAS s16x4*)(vp + 8 * 72));
                const bf16x8 Af = (bf16x8){a0[0], a0[1], a0[2], a0[3], a1[0], a1[1], a1[2], a1[3]};
                O[dt] = mfma32(Af, Pf, O[dt]); }
        }
    const float inv = 1.0f / lsum; const size_t R = (size_t)b * SEQ + rho + dil * (u0 + r);
    float* og = C_OG + ((size_t)g * TT + R) * 256 + hh * 64 + 4 * hl;
#pragma unroll
    for (int dt = 0; dt < 2; ++dt)
#pragma unroll
        for (int g4 = 0; g4 < 4; ++g4) *(f32x4*)(og + 32 * dt + 8 * g4) = (f32x4){O[dt][4 * g4 + 0] * inv, O[dt][4 * g4 + 1] * inv, O[dt][4 * g4 + 2] * inv, O[dt][4 * g4 + 3] * inv};
    if (hl == 0) C_LSE[((size_t)g * TT + R) * 4 + hh] = mx * 0.125f + __logf(lsum);
    __syncthreads();
}
__device__ __forceinline__ void dil_attn_sample_item(const Ctx& c, int sr, int hh, int e) {
    const int lane = c.lane, kg = lane >> 4, dl = lane & 15, R = TP + sr, n = sr >> 2, t = sr & 3;
    float m = -1e30f, l = 0.f, acc[4] = {0.f, 0.f, 0.f, 0.f};
#pragma unroll
    for (int g = 0; g < 3; ++g) {
        const int dil = (g == 0) ? 1 : (g == 1 ? 4 : 16), W = 128 * dil, jn = t / dil;
        float q[4]; unpk4(*(const u32x2*)(C_HB + (size_t)R * LDH + EC_QB + g * 256 + hh * 64 + 4 * dl), q);
#pragma unroll
        for (int i = 0; i < 4; ++i) q[i] *= 0.125f;
        { const int j = kg; const bool valid = j <= jn; const int tt = valid ? t - dil * j : t;
            const bf16* kp = C_HB + (size_t)(TP + n * 4 + tt) * LDH + g * 256 + hh * 64 + 4 * dl; float kf[4], vf[4]; unpk4(*(const u32x2*)(kp + EC_KB), kf); unpk4(*(const u32x2*)(kp + EC_VB), vf);
            float s = red16(q[0] * kf[0] + q[1] * kf[1] + q[2] * kf[2] + q[3] * kf[3]);
            if (valid) { const float mn = fmaxf(m, s), sc = __expf(m - mn), p = __expf(s - mn); l = l * sc + p;
#pragma unroll
                for (int i = 0; i < 4; ++i) acc[i] = acc[i] * sc + p * vf[i];
                m = mn; } }
        const float* cache = ((g == 0) ? C_IN(4) : (g == 1 ? C_IN(5) : C_IN(6))) + ((size_t)(e * 8 + n) * W) * 512 + hh * 64 + 4 * dl;
#pragma unroll 11
        for (int j0 = 0; j0 < 132; j0 += 4) { const int j = j0 + kg; const bool valid = (j > jn) && (j <= 128); const int idx = valid ? W + t - dil * j : 0;
            const float* kp = cache + (size_t)idx * 512; const f32x4 k4 = *(const f32x4*)kp, v4 = *(const f32x4*)(kp + 256);
            const float s = red16(q[0] * k4.x + q[1] * k4.y + q[2] * k4.z + q[3] * k4.w);
            if (valid) { const float mn = fmaxf(m, s), sc = __expf(m - mn), p = __expf(s - mn); l = l * sc + p;
                acc[0] = acc[0] * sc + p * v4.x; acc[1] = acc[1] * sc + p * v4.y; acc[2] = acc[2] * sc + p * v4.z; acc[3] = acc[3] * sc + p * v4.w; m = mn; } }
    }
#pragma unroll
    for (int off = 16; off <= 32; off <<= 1) {
        const float m2 = __shfl_xor(m, off), l2 = __shfl_xor(l, off); float a2[4];
#pragma unroll
        for (int i = 0; i < 4; ++i) a2[i] = __shfl_xor(acc[i], off);
        const float mn = fmaxf(m, m2), s1 = __expf(m - mn), s2 = __expf(m2 - mn);
        l = l * s1 + l2 * s2;
#pragma unroll
        for (int i = 0; i < 4; ++i) acc[i] = acc[i] * s1 + a2[i] * s2;
        m = mn;
    }
    if (kg == 0) { float gt[4]; unpk4(*(const u32x2*)(C_HB + (size_t)R * LDH + EC_GB + hh * 64 + 4 * dl), gt);
        const float inv = 1.0f / l; float o[4];
#pragma unroll
        for (int i = 0; i < 4; ++i) o[i] = acc[i] * inv * siluf_(gt[i]);
        *(u32x2*)(C_U + (size_t)R * EVEN_OUT + 768 + hh * 64 + 4 * dl) = (u32x2){pk2(o[0], o[1]), pk2(o[2], o[3])}; }
}


__device__ __forceinline__ void mem_attn_sample_block(const Ctx& c, int item, int l, int qcol, int gcol, int ucol, int ldu) {
    const int sr = item >> 2, mh = item & 3, R = TP + sr, lane = c.lane, kg = lane >> 5, dl = lane & 31, wave = c.wave;
    const float* mkv = C_IN(8) + ((size_t)l * 8 + (sr >> 2)) * 256 * 1024 + mh * 128 + 4 * dl;
    float q[4]; unpk4(*(const u32x2*)(C_HB + (size_t)R * LDH + qcol + mh * 128 + 4 * dl), q);
#pragma unroll
    for (int i = 0; i < 4; ++i) q[i] *= 0.08838834764831845f;
    float m = -1e30f, lsum = 0.f, acc[4] = {0.f, 0.f, 0.f, 0.f};
    f32x4 kv[16], vv[16];
#pragma unroll
    for (int jr = 0; jr < 16; ++jr) { const float* kp = mkv + (size_t)(32 * wave + 2 * jr + kg) * 1024; kv[jr] = *(const f32x4*)kp; vv[jr] = *(const f32x4*)(kp + 512); }
#pragma unroll
    for (int jr = 0; jr < 16; ++jr) { const f32x4 k4 = kv[jr], v4 = vv[jr];
        float s = q[0] * k4.x + q[1] * k4.y + q[2] * k4.z + q[3] * k4.w;
        s = red16(s); s += __shfl_xor(s, 16);
        const float mn = fmaxf(m, s), sc = __expf(m - mn), p = __expf(s - mn);
        lsum = lsum * sc + p; acc[0] = acc[0] * sc + p * v4.x; acc[1] = acc[1] * sc + p * v4.y; acc[2] = acc[2] * sc + p * v4.z; acc[3] = acc[3] * sc + p * v4.w; m = mn; }
    { const float m2 = __shfl_xor(m, 32), l2 = __shfl_xor(lsum, 32); float a2[4];
#pragma unroll
        for (int i = 0; i < 4; ++i) a2[i] = __shfl_xor(acc[i], 32);
        const float mn = fmaxf(m, m2), s1 = __expf(m - mn), s2 = __expf(m2 - mn);
        lsum = lsum * s1 + l2 * s2; m = mn;
#pragma unroll
        for (int i = 0; i < 4; ++i) acc[i] = acc[i] * s1 + a2[i] * s2; }
    LAS float* part = (LAS float*)c.lds;
    if (kg == 0) { LAS float* pp = part + (wave * 32 + dl) * 6; pp[0] = m; pp[1] = lsum; pp[2] = acc[0]; pp[3] = acc[1]; pp[4] = acc[2]; pp[5] = acc[3]; }
    __syncthreads();
    if (wave == 0 && kg == 0) {
        float M = -1e30f, Lr = 0.f, A[4] = {0.f, 0.f, 0.f, 0.f};
#pragma unroll
        for (int w = 0; w < 8; ++w) { const LAS float* pp = part + (w * 32 + dl) * 6; const float m2 = pp[0], mn = fmaxf(M, m2), s1 = __expf(M - mn), s2 = __expf(m2 - mn);
            Lr = Lr * s1 + pp[1] * s2; A[0] = A[0] * s1 + pp[2] * s2; A[1] = A[1] * s1 + pp[3] * s2; A[2] = A[2] * s1 + pp[4] * s2; A[3] = A[3] * s1 + pp[5] * s2; M = mn; }
        float gt[4]; unpk4(*(const u32x2*)(C_HB + (size_t)R * LDH + gcol + mh * 128 + 4 * dl), gt);
        const float inv = 1.0f / Lr;
        *(u32x2*)(C_U + (size_t)R * ldu + ucol + mh * 128 + 4 * dl) = (u32x2){pk2(A[0] * inv * siluf_(gt[0]), A[1] * inv * siluf_(gt[1])), pk2(A[2] * inv * siluf_(gt[2]), A[3] * inv * siluf_(gt[3]))}; }
    __syncthreads();
}
__device__ __forceinline__ void dil_attn_sample_block(const Ctx& c, int item, int e) {
    const int sr = item >> 2, hh = item & 3, lane = c.lane, kg = lane >> 4, dl = lane & 15, wave = c.wave, R = TP + sr, n = sr >> 2, t = sr & 3;
    float m = -1e30f, l = 0.f, acc[4] = {0.f, 0.f, 0.f, 0.f};
#pragma unroll
    for (int g = 0; g < 3; ++g) {
        const int dil = (g == 0) ? 1 : (g == 1 ? 4 : 16), W = 128 * dil, jn = t / dil;
        float q[4]; unpk4(*(const u32x2*)(C_HB + (size_t)R * LDH + EC_QB + g * 256 + hh * 64 + 4 * dl), q);
#pragma unroll
        for (int i = 0; i < 4; ++i) q[i] *= 0.125f;
        if (wave == 0) { const int j = kg; const bool valid = j <= jn; const int tt = valid ? t - dil * j : t;
            const bf16* kp = C_HB + (size_t)(TP + n * 4 + tt) * LDH + g * 256 + hh * 64 + 4 * dl; float kf[4], vf[4]; unpk4(*(const u32x2*)(kp + EC_KB), kf); unpk4(*(const u32x2*)(kp + EC_VB), vf);
            float s = red16(q[0] * kf[0] + q[1] * kf[1] + q[2] * kf[2] + q[3] * kf[3]);
            if (valid) { const float mn = fmaxf(m, s), sc = __expf(m - mn), p = __expf(s - mn); l = l * sc + p;
#pragma unroll
                for (int i = 0; i < 4; ++i) acc[i] = acc[i] * sc + p * vf[i];
                m = mn; } }
        const float* cache = ((g == 0) ? C_IN(4) : (g == 1 ? C_IN(5) : C_IN(6))) + ((size_t)(e * 8 + n) * W) * 512 + hh * 64 + 4 * dl;
        f32x4 kv[5], vv[5]; bool ok[5];
#pragma unroll
        for (int jr = 0; jr < 5; ++jr) { const int jo = 4 * jr + kg, j = 17 * wave + jo; ok[jr] = (jo < 17) && (j > jn) && (j <= 128); const int idx = ok[jr] ? W + t - dil * j : 0;
            const float* kp = cache + (size_t)idx * 512; kv[jr] = *(const f32x4*)kp; vv[jr] = *(const f32x4*)(kp + 256); }
#pragma unroll
        for (int jr = 0; jr < 5; ++jr) { const f32x4 k4 = kv[jr], v4 = vv[jr];
            const float s = red16(q[0] * k4.x + q[1] * k4.y + q[2] * k4.z + q[3] * k4.w);
            if (ok[jr]) { const float mn = fmaxf(m, s), sc = __expf(m - mn), p = __expf(s - mn); l = l * sc + p;
                acc[0] = acc[0] * sc + p * v4.x; acc[1] = acc[1] * sc + p * v4.y; acc[2] = acc[2] * sc + p * v4.z; acc[3] = acc[3] * sc + p * v4.w; m = mn; } }
    }
#pragma unroll
    for (int off = 16; off <= 32; off <<= 1) {
        const float m2 = __shfl_xor(m, off), l2 = __shfl_xor(l, off); float a2[4];
#pragma unroll
        for (int i = 0; i < 4; ++i) a2[i] = __shfl_xor(acc[i], off);
        const float mn = fmaxf(m, m2), s1 = __expf(m - mn), s2 = __expf(m2 - mn);
        l = l * s1 + l2 * s2;
#pragma unroll
        for (int i = 0; i < 4; ++i) acc[i] = acc[i] * s1 + a2[i] * s2;
        m = mn;
    }
    LAS float* part = (LAS float*)c.lds;
    if (kg == 0) { LAS float* pp = part + (wave * 16 + dl) * 6; pp[0] = m; pp[1] = l; pp[2] = acc[0]; pp[3] = acc[1]; pp[4] = acc[2]; pp[5] = acc[3]; }
    __syncthreads();
    if (wave == 0 && kg == 0) {
        float M = -1e30f, Lr = 0.f, A[4] = {0.f, 0.f, 0.f, 0.f};
#pragma unroll
        for (int w = 0; w < 8; ++w) { const LAS float* pp = part + (w * 16 + dl) * 6; const float m2 = pp[0], mn = fmaxf(M, m2), s1 = __expf(M - mn), s2 = __expf(m2 - mn);
            Lr = Lr * s1 + pp[1] * s2; A[0] = A[0] * s1 + pp[2] * s2; A[1] = A[1] * s1 + pp[3] * s2; A[2] = A[2] * s1 + pp[4] * s2; A[3] = A[3] * s1 + pp[5] * s2; M = mn; }
        float gt[4]; unpk4(*(const u32x2*)(C_HB + (size_t)R * LDH + EC_GB + hh * 64 + 4 * dl), gt);
        const float inv = 1.0f / Lr;
        *(u32x2*)(C_U + (size_t)R * EVEN_OUT + 768 + hh * 64 + 4 * dl) = (u32x2){pk2(A[0] * inv * siluf_(gt[0]), A[1] * inv * siluf_(gt[1])), pk2(A[2] * inv * siluf_(gt[2]), A[3] * inv * siluf_(gt[3]))}; }
    __syncthreads();
}

__device__ __forceinline__ void even_copies(const Ctx& c, int e) {
    const int gt = c.bid * 512 + c.tid, NT = c.G * 512;
    for (int i = gt; i < 10 * 304; i += NT) { const int rw = i / 304, c8 = 8 * (i % 304);
        const size_t src = (rw < 2) ? (size_t)(rw * SEQ + SEQ - 1) : (size_t)(TP + (rw - 2) * 4 + 3);
        float x[8]; unpk8(*(const u32x4*)(C_HB + src * LDH + c8), x);
        float* dst = (rw < 2) ? C_OUT + O_SH_P + ((size_t)e * 2 + rw) * 2432 + c8 : C_OUT + O_SH_S + ((size_t)e * 8 + (rw - 2)) * 2432 + c8;
        *(f32x4*)dst = (f32x4){x[0], x[1], x[2], x[3]}; *(f32x4*)(dst + 4) = (f32x4){x[4], x[5], x[6], x[7]}; }
#pragma unroll 1
    for (int g = 0; g < 3; ++g) {
        const int keep = 128 << (2 * g); const size_t op = (g == 0) ? O_G0P : (g == 1 ? O_G1P : O_G2P), os = (g == 0) ? O_G0S : (g == 1 ? O_G1S : O_G2S);
        for (int i0 = gt; i0 < 2 * keep * 64; i0 += 4 * NT) { u32x4 w[4];
#pragma unroll
            for (int k = 0; k < 4; ++k) { const int i = (i0 + k * NT < 2 * keep * 64) ? i0 + k * NT : i0; const int pc = i & 63, r = (i >> 6) % keep, b = (i >> 6) / keep;
                const int col = ((pc & 32) ? EC_VB : EC_KB) + g * 256 + 8 * (pc & 31); w[k] = *(const u32x4*)(C_HB + (size_t)(b * SEQ + SEQ - keep + r) * LDH + col); }
#pragma unroll
            for (int k = 0; k < 4; ++k) { const int i = i0 + k * NT; if (i < 2 * keep * 64) { const int pc = i & 63, r = (i >> 6) % keep, b = (i >> 6) / keep;
                float x[8]; unpk8(w[k], x); float* dst = C_OUT + op + ((size_t)e * 2 * keep + (size_t)b * keep + r) * 512 + 8 * pc;
                *(f32x4*)dst = (f32x4){x[0], x[1], x[2], x[3]}; *(f32x4*)(dst + 4) = (f32x4){x[4], x[5], x[6], x[7]}; } } }
        for (int i = gt; i < 8 * 4 * 64; i += NT) { const int pc = i & 63, row = i >> 6;
            const int col = ((pc & 32) ? EC_VB : EC_KB) + g * 256 + 8 * (pc & 31);
            float x[8]; unpk8(*(const u32x4*)(C_HB + (size_t)(TP + row) * LDH + col), x);
            float* dst = C_OUT + os + ((size_t)e * 32 + row) * 512 + 8 * pc;
            *(f32x4*)dst = (f32x4){x[0], x[1], x[2], x[3]}; *(f32x4*)(dst + 4) = (f32x4){x[4], x[5], x[6], x[7]}; }
    }
}

#define LAUNDER_C(c) do { asm volatile("" : "+s"((c).ap), "+v"((c).tid), "+s"((c).bid), "+s"((c).G)); (c).lane = (c).tid & 63; (c).wave = __builtin_amdgcn_readfirstlane((c).tid >> 6); } while (0)
__device__ __forceinline__ void phase_even_tok_pre(Ctx c, int l);
__device__ __forceinline__ void even_helper_work(Ctx c, int l) {
    const int e = l >> 1;
    for (int rp = 0; rp < REPD; ++rp) { for (int it = c.bid; it < 384; it += c.G) dil_attn_mfma_item(c, it);
    LAUNDER_C(c); }
    for (int it = c.G - 1 - c.bid; it < TS * 4; it += c.G) dil_attn_sample_block(c, it, e);
    LAUNDER_C(c);
    for (int rp = 0; rp < REPM; ++rp) { mem_attn_all(c, l, EC_QM, EC_GM, 1024, EVEN_OUT);
    LAUNDER_C(c); }
    even_copies(c, e);
    LAUNDER_C(c);
    for (int rp = 0; rp < REPC; ++rp) { if (l < 3) convert_layer_weights(c, l + 1); LAUNDER_C(c); }
}

__device__ __forceinline__ void rwkv_scan_item(const Ctx& c, int item, int e) {
    constexpr int CH = 32;
    LAS float* buf = (LAS float*)c.lds;
    LAS float* ybuf = buf + 2 * CH * 384;
    const bool is_p = item < 48; const int st = is_p ? (item >> 1) : ((item - 48) >> 1), half = item & 1;
    const int h = st % 12, bn = st / 12; const int T = is_p ? SEQ : 4; const size_t tok0 = is_p ? (size_t)bn * SEQ : (size_t)(TP + bn * 4);
    const int lane = c.lane, rw = lane >> 4, cgp = lane & 15, il = 4 * c.wave + rw, i = 32 * half + il;
    float s[4];
    if (is_p) { s[0] = s[1] = s[2] = s[3] = 0.f; }
    else { const f32x4 v = *(const f32x4*)(C_IN(2) + ((((size_t)e * 8 + bn) * 12 + h) * 64 + i) * 64 + 4 * cgp); s[0] = v.x; s[1] = v.y; s[2] = v.z; s[3] = v.w; }
    const int nch = (T + CH - 1) / CH;
    f32x4 pre[6];
#define SCAN_GLOAD(ch_) do { _Pragma("unroll") for (int k = 0; k < 6; ++k) { const int idx = c.tid + 512 * k, tl_ = idx / 96, f4 = idx % 96; const int tk = (ch_) * CH + tl_; \
            pre[k] = (tk < T) ? *(const f32x4*)(C_PREPS + ((tok0 - TP + tk) * 12 + h) * 384 + 4 * f4) : (f32x4){0.f, 0.f, 0.f, 0.f}; } } while (0)
#define SCAN_LSTORE(bi_) do { _Pragma("unroll") for (int k = 0; k < 6; ++k) { const int idx = c.tid + 512 * k; *(LAS f32x4*)(buf + (bi_) * CH * 384 + 4 * idx) = pre[k]; } } while (0)
    SCAN_GLOAD(0); SCAN_LSTORE(0); __syncthreads();
#pragma unroll 1
    for (int ch = 0; ch < nch; ++ch) {
        if (ch + 1 < nch) SCAN_GLOAD(ch + 1);
        const LAS float* bb = buf + (ch & 1) * CH * 384;
        const int nt = (T - ch * CH) < CH ? (T - ch * CH) : CH;
#pragma unroll 2
        for (int tl = 0; tl < nt; ++tl) {
            const LAS float* p = bb + tl * 384;
            const f32x4 r4 = *(const LAS f32x4*)(p + 4 * cgp), d4 = *(const LAS f32x4*)(p + 64 + 4 * cgp), k4 = *(const LAS f32x4*)(p + 128 + 4 * cgp),
                        kk4 = *(const LAS f32x4*)(p + 256 + 4 * cgp), b4 = *(const LAS f32x4*)(p + 320 + 4 * cgp);
            const float vi = p[192 + i];
            float sa = s[0] * kk4.x + s[1] * kk4.y + s[2] * kk4.z + s[3] * kk4.w;
            sa = red16(sa);
            s[0] = s[0] * d4.x + (sa * b4.x + vi * k4.x); s[1] = s[1] * d4.y + (sa * b4.y + vi * k4.y);
            s[2] = s[2] * d4.z + (sa * b4.z + vi * k4.z); s[3] = s[3] * d4.w + (sa * b4.w + vi * k4.w);
            float y = s[0] * r4.x + s[1] * r4.y + s[2] * r4.z + s[3] * r4.w;
            y = red16(y);
            if (cgp == 0) ybuf[tl * 32 + il] = y;
        }
        __syncthreads();
        if (ch + 1 < nch) SCAN_LSTORE((ch + 1) & 1);
        for (int idx = c.tid; idx < nt * 32; idx += 512) { const int tl = idx >> 5, r = idx & 31; C_YA[(tok0 + ch * CH + tl) * 768 + h * 64 + 32 * half + r] = ybuf[idx]; }
        __syncthreads();
    }
    float* so = C_OUT + (is_p ? O_RWKV_P + (((size_t)e * 2 + bn) * 12 + h) * 4096 : O_RWKV_S + (((size_t)e * 8 + bn) * 12 + h) * 4096) + (size_t)i * 64 + 4 * cgp;
    *(f32x4*)so = (f32x4){s[0], s[1], s[2], s[3]};
}

typedef float f32x2 __attribute__((ext_vector_type(2)));
__device__ __forceinline__ void rwkv_scan_prompt(const Ctx& c, int item, int e) {
    constexpr int CH = 32, NCH = SEQ / CH;
    LAS float* buf = (LAS float*)c.lds;
    LAS float* ybuf = buf + 2 * CH * 384;
    const int st = item >> 1, half = item & 1, h = st % 12, bn = st / 12; const size_t tok0 = (size_t)bn * SEQ;
    const int lane = c.lane, rw = lane >> 4, cgp = lane & 15, il = 4 * c.wave + rw, i = 32 * half + il;
    f32x2 s01 = (f32x2){0.f, 0.f}, s23 = (f32x2){0.f, 0.f};
    const float* src = C_PREP + (tok0 * 12 + h) * 384;
    float* ya = C_YA + tok0 * 768 + h * 64 + 32 * half;
    f32x4 pre[6];
#define SP_GLOAD(ch_) do { _Pragma("unroll") for (int k = 0; k < 6; ++k) { const int idx = c.tid + 512 * k, tl_ = idx / 96, f4 = idx % 96; \
        pre[k] = *(const f32x4*)(src + (size_t)((ch_) * CH + tl_) * (12 * 384) + 4 * f4); } } while (0)
#define SP_LSTORE(bi_) do { _Pragma("unroll") for (int k = 0; k < 6; ++k) { const int idx = c.tid + 512 * k; *(LAS f32x4*)(buf + (bi_) * CH * 384 + 4 * idx) = pre[k]; } } while (0)
#define SP_YOUT(ch_) do { for (int idx = c.tid; idx < CH * 32; idx += 512) { const int tl_ = idx >> 5, r_ = idx & 31; ya[(size_t)((ch_) * CH + tl_) * 768 + r_] = ybuf[((ch_) & 1) * CH * 32 + idx]; } } while (0)
    SP_GLOAD(0); SP_LSTORE(0); SP_GLOAD(1); __syncthreads();
#pragma unroll 1
    for (int ch = 0; ch < NCH; ++ch) {
        if (ch + 1 < NCH) SP_LSTORE((ch + 1) & 1);
        if (ch + 2 < NCH) SP_GLOAD(ch + 2);
        if (ch > 0) SP_YOUT(ch - 1);
        const LAS float* bb = buf + (ch & 1) * CH * 384 + 4 * cgp; const LAS float* vb = buf + (ch & 1) * CH * 384 + 192 + i;
        LAS float* yw = (cgp == 0) ? (ybuf + (ch & 1) * CH * 32 + il) : (ybuf + 2 * CH * 32 + lane);
        f32x4 r4 = *(const LAS f32x4*)bb, d4 = *(const LAS f32x4*)(bb + 64), k4 = *(const LAS f32x4*)(bb + 128), n4 = *(const LAS f32x4*)(bb + 256), b4 = *(const LAS f32x4*)(bb + 320); float vi = vb[0];
        float sa;
        { f32x2 p = s01 * (f32x2){n4.x, n4.y}; p = s23 * (f32x2){n4.z, n4.w} + p; sa = red16(p.x + p.y); }
#pragma unroll 4
        for (int tl = 0; tl < CH; ++tl) {
            const int tn = (tl + 1 < CH) ? tl + 1 : tl;
            const f32x4 r4n = *(const LAS f32x4*)(bb + tn * 384), d4n = *(const LAS f32x4*)(bb + tn * 384 + 64), k4n = *(const LAS f32x4*)(bb + tn * 384 + 128),
                        n4n = *(const LAS f32x4*)(bb + tn * 384 + 256), b4n = *(const LAS f32x4*)(bb + tn * 384 + 320); const float vin = vb[tn * 384];
            const f32x2 vi2 = (f32x2){vi, vi}, sa2 = (f32x2){sa, sa};
            const f32x2 u01 = s01 * (f32x2){d4.x, d4.y} + vi2 * (f32x2){k4.x, k4.y}, u23 = s23 * (f32x2){d4.z, d4.w} + vi2 * (f32x2){k4.z, k4.w};
            s01 = sa2 * (f32x2){b4.x, b4.y} + u01; s23 = sa2 * (f32x2){b4.z, b4.w} + u23;
            f32x2 yp = s01 * (f32x2){r4.x, r4.y}; yp = s23 * (f32x2){r4.z, r4.w} + yp;
            f32x2 pn = s01 * (f32x2){n4n.x, n4n.y}; pn = s23 * (f32x2){n4n.z, n4n.w} + pn;
            float ya_ = yp.x + yp.y, sb_ = pn.x + pn.y;
            sb_ += dppf<0xB1>(sb_); ya_ += dppf<0xB1>(ya_); sb_ += dppf<0x4E>(sb_); ya_ += dppf<0x4E>(ya_);
            sb_ += dppf<0x141>(sb_); ya_ += dppf<0x141>(ya_); sb_ += dppf<0x140>(sb_); ya_ += dppf<0x140>(ya_);
            sa = sb_;
            yw[tl * 32] = ya_;
            r4 = r4n; d4 = d4n; k4 = k4n; n4 = n4n; b4 = b4n; vi = vin;
        }
        __syncthreads();
    }
    SP_YOUT(NCH - 1);
    float* so = C_OUT + O_RWKV_P + (((size_t)e * 2 + bn) * 12 + h) * 4096 + (size_t)i * 64 + 4 * cgp;
    *(f32x4*)so = (f32x4){s01.x, s01.y, s23.x, s23.y};
    __syncthreads();
#undef SP_GLOAD
#undef SP_LSTORE
#undef SP_YOUT
}

struct PreIn { u32x2 cr, ck, cv, pr, pk, pv; float hcur[8], hprv[8]; };
__device__ __forceinline__ void rwkv_chunk_preload(const Ctx& c, int item, int e, PreIn& P) {
    const bool is_s = item >= 3072; const int sidx = item - 3072;
    const int bh = item >> 7, n = is_s ? 1 : (item & 127), b = bh / 12, h = is_s ? (sidx % 12) : (bh % 12), ns = sidx / 12;
    const size_t R0 = is_s ? (size_t)(TP + 4 * ns) : (size_t)b * SEQ + 32 * n;
    const float* shift = C_IN(3) + ((size_t)e * 8 + ns) * 2432;
    const int tid = c.tid, t_ = tid >> 4, c4 = 4 * (tid & 15), col = h * 64 + c4;
    const bf16* hc = C_HB + (R0 + t_) * LDH + col; const bool hasprev = is_s ? (t_ != 0) : ((32 * n + t_) != 0);
    const u32x2 z2 = (u32x2){0u, 0u};
    P.cr = *(const u32x2*)(hc + EC_R); P.ck = *(const u32x2*)(hc + EC_K); P.cv = *(const u32x2*)(hc + EC_V);
    P.pr = hasprev ? *(const u32x2*)(hc - LDH + EC_R) : z2; P.pk = hasprev ? *(const u32x2*)(hc - LDH + EC_K) : z2; P.pv = hasprev ? *(const u32x2*)(hc - LDH + EC_V) : z2;
    const int cc = tid & 127, cl = EC_HW + cc, tb = tid >> 7;
#pragma unroll
    for (int k = 0; k < 8; ++k) { const int t = tb + 4 * k; P.hcur[k] = bf2f(C_HB[(R0 + t) * LDH + cl]);
        P.hprv[k] = is_s ? (t != 0 ? bf2f(C_HB[(R0 + t - 1) * LDH + cl]) : shift[cl]) : (((32 * n + t) != 0) ? bf2f(C_HB[(R0 + t - 1) * LDH + cl]) : 0.f); }
}
__device__ __forceinline__ void rwkv_chunk_precompute(const Ctx& c, int item, int e, const PreIn& P) {
    const bool is_s = item >= 3072; const int sidx = item - 3072;
    const int bh = item >> 7, n = is_s ? 1 : (item & 127), b = bh / 12, h = is_s ? (sidx % 12) : (bh % 12), ns = sidx / 12, ntok = is_s ? 4 : 32;
    const size_t R0 = is_s ? (size_t)(TP + 4 * ns) : (size_t)b * SEQ + 32 * n;
    const float* shift = C_IN(3) + ((size_t)e * 8 + ns) * 2432;
    LAS unsigned char* L = c.lds;
    LAS float* XW = (LAS float*)(L + 0); LAS float* XA = (LAS float*)(L + 8192);
    LAS bf16* LW = (LAS bf16*)(L + 16384); LAS bf16* LA = (LAS bf16*)(L + 20992);
    LAS float* PS = (LAS float*)(L + 25600);
    LAS bf16* KKt = (LAS bf16*)(L + 33792); LAS bf16* Bt = (LAS bf16*)(L + 38400); LAS bf16* Kt = (LAS bf16*)(L + 43008); LAS bf16* Rt = (LAS bf16*)(L + 47616);
    LAS bf16* Bh = (LAS bf16*)(L + 52224); LAS bf16* Kh = (LAS bf16*)(L + 56832); LAS bf16* Vb = (LAS bf16*)(L + 61440);
    LAS float* LB = (LAS float*)(L + 66048);
    LAS bf16* Lk = (LAS bf16*)(L + 70144); LAS bf16* Mb = (LAS bf16*)(L + 72704); LAS bf16* Mk = (LAS bf16*)(L + 75264);
    LAS float* SOL = (LAS float*)(L + 77824);
    LAS bf16* KTb = (LAS bf16*)(L + 94208); LAS bf16* UVb = (LAS bf16*)(L + 98816);
    LAS float* RTf = (LAS float*)(L + 103424); LAS float* c31 = (LAS float*)(L + 111616);
    const int tid = c.tid, lane = c.lane, wave = c.wave, fr = lane & 15, fq = lane >> 4, trow = (lane & 15) >> 2, tcol = 4 * (lane & 3);
    const int t_ = tid >> 4, c4 = 4 * (tid & 15), col = h * 64 + c4;
    const float* mu = C_IN(17) + e * 2432;
    const bf16* hc = C_HB + (R0 + t_) * LDH + col; const bool hasprev = is_s ? (t_ != 0) : ((32 * n + t_) != 0);
    const u32x2 cr = P.cr, ck = P.ck, cv = P.cv, pr = P.pr, pk = P.pk, pv = P.pv;
    f32x4 sh_r = (f32x4){0.f, 0.f, 0.f, 0.f}, sh_k = sh_r, sh_v = sh_r;
    if (is_s && t_ == 0) { sh_r = *(const f32x4*)(shift + EC_R + col); sh_k = *(const f32x4*)(shift + EC_K + col); sh_v = *(const f32x4*)(shift + EC_V + col); }
    { const int cc = tid & 127, cl = EC_HW + cc, tb = tid >> 7; const float muc = mu[cl];
#pragma unroll
        for (int k = 0; k < 8; ++k) { const int t = tb + 4 * k; const float hs = P.hcur[k] + (P.hprv[k] - P.hcur[k]) * muc;
            if (cc < 64) LW[t * 72 + cc] = (bf16)f2bf(1.0f - 2.0f / (1.0f + __expf(2.0f * hs))); else LA[t * 72 + cc - 64] = (bf16)f2bf(hs); } }
    __syncthreads();
    { const int p = wave >> 2, tt = (wave >> 1) & 1; const LAS bf16* As = p ? LA : LW; const bf16* WT = (p ? C_AUT : C_WUT) + ((size_t)e * 768 + h * 64) * 64; LAS float* X = p ? XA : XW;
#pragma unroll
        for (int cc = 0; cc < 2; ++cc) { const int ct = 2 * (wave & 1) + cc; f32x4 acc = (f32x4){0.f, 0.f, 0.f, 0.f};
#pragma unroll
            for (int ks = 0; ks < 2; ++ks) acc = mfma16(*(const LAS bf16x8*)(As + (16 * tt + fr) * 72 + 32 * ks + 8 * fq), *(const bf16x8*)(WT + (size_t)(16 * ct + fr) * 64 + 32 * ks + 8 * fq), acc);
#pragma unroll
            for (int r = 0; r < 4; ++r) X[(16 * tt + 4 * fq + r) * 64 + 16 * ct + fr] = acc[r]; } }
    __syncthreads();
    float rr[4], k2[4], vv[4], kkv[4], bb[4];
    for (int rep3 = 0; rep3 < REP3; ++rep3) { asm volatile("" ::: "memory");
    { const f32x4 xw4 = *(const LAS f32x4*)(XW + t_ * 64 + c4), xa4 = *(const LAS f32x4*)(XA + t_ * 64 + c4);
        const f32x4 w04 = *(const f32x4*)(C_IN(18) + e * 768 + col), a04 = *(const f32x4*)(C_IN(20) + e * 768 + col), kk4 = *(const f32x4*)(C_IN(22) + e * 768 + col), ka4 = *(const f32x4*)(C_IN(23) + e * 768 + col),
                    rk4 = *(const f32x4*)(C_IN(24) + e * 768 + col), mr4 = *(const f32x4*)(mu + EC_R + col), mk4 = *(const f32x4*)(mu + EC_K + col), mv4 = *(const f32x4*)(mu + EC_V + col);
        float crf[4], ckf[4], cvf[4], prf[4], pkf[4], pvf[4]; unpk4(cr, crf); unpk4(ck, ckf); unpk4(cv, cvf); unpk4(pr, prf); unpk4(pk, pkf); unpk4(pv, pvf);
        const bool tok_ok = t_ < ntok;
#pragma unroll
        for (int i = 0; i < 4; ++i) { prf[i] += sh_r[i]; pkf[i] += sh_k[i]; pvf[i] += sh_v[i]; }
        float wl[4], av[4], ssum = 0.f, bsum = 0.f;
#pragma unroll
        for (int i = 0; i < 4; ++i) { const float r = crf[i] + (prf[i] - crf[i]) * mr4[i], k = ckf[i] + (pkf[i] - ckf[i]) * mk4[i], v = cvf[i] + (pvf[i] - cvf[i]) * mv4[i];
            wl[i] = -0.6065306597126334f * sigmoidf_(w04[i] + xw4[i]); av[i] = sigmoidf_(a04[i] + xa4[i]);
            const float kk = tok_ok ? k * kk4[i] : 0.f; ssum += kk * kk; kkv[i] = kk; k2[i] = tok_ok ? k * (1.0f + (av[i] - 1.0f) * ka4[i]) : 0.f; rr[i] = tok_ok ? r : 0.f; vv[i] = tok_ok ? v : 0.f; bsum += rr[i] * k2[i] * rk4[i];
            if (!tok_ok) wl[i] = 0.f; }
        ssum = red16(ssum); bsum = red16(bsum); const float inv = rsqrtf(fmaxf(ssum, 1e-24f));
#pragma unroll
        for (int i = 0; i < 4; ++i) { kkv[i] *= inv; bb[i] = kkv[i] * av[i]; }
        if ((tid & 15) == 0 && tok_ok) C_BONUS[(R0 + t_) * 12 + h] = bsum;
        *(LAS f32x4*)(PS + t_ * 64 + c4) = (f32x4){wl[0], wl[1], wl[2], wl[3]}; }
    __syncthreads();
    if (tid < 64) { float run = 0.f;
#pragma unroll 8
        for (int t = 0; t < 32; ++t) { run += PS[t * 64 + tid]; PS[t * 64 + tid] = run; } }
    __syncthreads();
    { const f32x4 pt = *(const LAS f32x4*)(PS + t_ * 64 + c4), pe = *(const LAS f32x4*)(PS + 31 * 64 + c4); const f32x4 pp = (t_ > 0) ? *(const LAS f32x4*)(PS + (t_ - 1) * 64 + c4) : (f32x4){0.f, 0.f, 0.f, 0.f};
        float o_kk[4], o_b[4], o_k[4], o_r[4], o_bh[4], o_kh[4];
#pragma unroll
        for (int i = 0; i < 4; ++i) { const float ct = __expf(pt[i]), cp = __expf(pp[i]), ci = __expf(-pt[i]), chh = __expf(pe[i] - pt[i]);
            o_kk[i] = kkv[i] * cp; o_b[i] = bb[i] * ci; o_k[i] = k2[i] * ci; o_r[i] = rr[i] * ct; o_bh[i] = bb[i] * chh; o_kh[i] = k2[i] * chh; }
        *(LAS u32x2*)(KKt + t_ * 72 + c4) = (u32x2){pk2(o_kk[0], o_kk[1]), pk2(o_kk[2], o_kk[3])}; *(LAS u32x2*)(Bt + t_ * 72 + c4) = (u32x2){pk2(o_b[0], o_b[1]), pk2(o_b[2], o_b[3])};
        *(LAS u32x2*)(Kt + t_ * 72 + c4) = (u32x2){pk2(o_k[0], o_k[1]), pk2(o_k[2], o_k[3])}; *(LAS u32x2*)(Rt + t_ * 72 + c4) = (u32x2){pk2(o_r[0], o_r[1]), pk2(o_r[2], o_r[3])};
        *(LAS u32x2*)(Bh + t_ * 72 + c4) = (u32x2){pk2(o_bh[0], o_bh[1]), pk2(o_bh[2], o_bh[3])}; *(LAS u32x2*)(Kh + t_ * 72 + c4) = (u32x2){pk2(o_kh[0], o_kh[1]), pk2(o_kh[2], o_kh[3])};
        *(LAS u32x2*)(Vb + t_ * 72 + c4) = (u32x2){pk2(vv[0], vv[1]), pk2(vv[2], vv[3])};
        *(LAS f32x4*)(RTf + t_ * 64 + c4) = (f32x4){o_r[0], o_r[1], o_r[2], o_r[3]}; *(LAS f32x4*)(SOL + t_ * 128 + c4) = (f32x4){o_kk[0], o_kk[1], o_kk[2], o_kk[3]};
        if (t_ == 31) *(LAS f32x4*)(c31 + c4) = (f32x4){__expf(pt[0]), __expf(pt[1]), __expf(pt[2]), __expf(pt[3])}; }
    __syncthreads(); }
    { const int m = wave >> 1, tt = wave & 1; const LAS bf16* X = (m < 2) ? KKt : Rt; const LAS bf16* Yv = (m & 1) ? Kt : Bt;
#pragma unroll
        for (int st = 0; st < 2; ++st) { f32x4 acc = (f32x4){0.f, 0.f, 0.f, 0.f};
            if (st <= tt) {
#pragma unroll
                for (int ks = 0; ks < 2; ++ks) acc = mfma16(*(const LAS bf16x8*)(X + (16 * tt + fr) * 72 + 32 * ks + 8 * fq), *(const LAS bf16x8*)(Yv + (16 * st + fr) * 72 + 32 * ks + 8 * fq), acc); }
#pragma unroll
            for (int r = 0; r < 4; ++r) { const int t = 16 * tt + 4 * fq + r, s_ = 16 * st + fr; const bool keep = (m < 2) ? (s_ < t) : (s_ <= t); const float val = keep ? acc[r] : 0.f;
                if (m == 0) LB[t * 32 + (s_ & 3) * 8 + (s_ >> 2)] = val; else if (m == 1) Lk[t * 40 + s_] = (bf16)f2bf(val); else if (m == 2) Mb[t * 40 + s_] = (bf16)f2bf(val); else Mk[t * 40 + s_] = (bf16)f2bf(val); } } }
    __syncthreads();
    { const int tt = wave >> 2, ict = wave & 3;
        const f32x4 acc = mfma16(*(const LAS bf16x8*)(Lk + (16 * tt + fr) * 40 + 8 * fq), tr_frag(Vb + (8 * fq + trow) * 72 + 16 * ict + tcol, 4 * 72), (f32x4){0.f, 0.f, 0.f, 0.f});
#pragma unroll
        for (int r = 0; r < 4; ++r) SOL[(16 * tt + 4 * fq + r) * 128 + 64 + 16 * ict + fr] = acc[r]; }
    __syncthreads();
    { const int cidx = tid >> 2, q = tid & 3; float xq[8];
#pragma unroll
        for (int u = 0; u < 8; ++u) xq[u] = 0.f;
#pragma unroll
        for (int t = 0; t < 32; ++t) { float part = 0.f;
            if (t > 0) { const f32x4 la = *(const LAS f32x4*)(LB + t * 32 + q * 8); part = la[0] * xq[0];
                if (t > 4) part += la[1] * xq[1]; if (t > 8) part += la[2] * xq[2]; if (t > 12) part += la[3] * xq[3];
                if (t > 16) { const f32x4 lb = *(const LAS f32x4*)(LB + t * 32 + q * 8 + 4); part += lb[0] * xq[4];
                    if (t > 20) part += lb[1] * xq[5]; if (t > 24) part += lb[2] * xq[6]; if (t > 28) part += lb[3] * xq[7]; }
                part += dppf<0xB1>(part); part += dppf<0x4E>(part); }
            const float xt = SOL[t * 128 + cidx] - part;
            if (q == (t & 3)) { xq[t >> 2] = xt;
                if (cidx < 64) KTb[t * 72 + cidx] = (bf16)f2bf(xt); else UVb[t * 72 + cidx - 64] = (bf16)f2bf(-xt); } } }
    __syncthreads();
    for (int rep9 = 0; rep9 < REP9; ++rep9) { asm volatile("" ::: "memory");
    unsigned char* chk = C_CHK + (size_t)item * CHK_BYTES; bf16* Ag = (bf16*)(chk + CK_A); bf16* RQg = (bf16*)(chk + CK_RQ); float* GTg = (float*)(chk + CK_GT); float* YVTg = (float*)(chk + CK_YVT);
    const f32x4 z4 = (f32x4){0.f, 0.f, 0.f, 0.f};
    { const int jt = wave >> 1;
        const bf16x8 BhT = tr_frag(Bh + (8 * fq + trow) * 72 + 16 * jt + tcol, 4 * 72), KhT = tr_frag(Kh + (8 * fq + trow) * 72 + 16 * jt + tcol, 4 * 72);
#pragma unroll
        for (int cc = 0; cc < 2; ++cc) { const int ct = 2 * (wave & 1) + cc;
            const f32x4 aA = mfma16(BhT, tr_frag(KTb + (8 * fq + trow) * 72 + 16 * ct + tcol, 4 * 72), z4);
            f32x4 aG = mfma16(BhT, tr_frag(UVb + (8 * fq + trow) * 72 + 16 * ct + tcol, 4 * 72), z4); aG = mfma16(KhT, tr_frag(Vb + (8 * fq + trow) * 72 + 16 * ct + tcol, 4 * 72), aG);
#pragma unroll
            for (int r = 0; r < 4; ++r) { const int j = 16 * jt + 4 * fq + r, jp = 16 * ct + fr; Ag[j * 72 + jp] = (bf16)f2bf(((j == jp) ? c31[j] : 0.f) - aA[r]); }
            *(f32x4*)(GTg + (16 * ct + fr) * 68 + 16 * jt + 4 * fq) = aG; } }
    { const int tt = wave >> 2, jt2 = wave & 3; const bf16x8 MbF = *(const LAS bf16x8*)(Mb + (16 * tt + fr) * 40 + 8 * fq);
        const f32x4 a = mfma16(MbF, tr_frag(KTb + (8 * fq + trow) * 72 + 16 * jt2 + tcol, 4 * 72), z4);
#pragma unroll
        for (int r = 0; r < 4; ++r) { const int t = 16 * tt + 4 * fq + r, j = 16 * jt2 + fr; RQg[t * 72 + j] = (bf16)f2bf(RTf[t * 64 + j] - a[r]); }
        f32x4 y = mfma16(MbF, tr_frag(UVb + (8 * fq + trow) * 72 + 16 * jt2 + tcol, 4 * 72), z4);
        y = mfma16(*(const LAS bf16x8*)(Mk + (16 * tt + fr) * 40 + 8 * fq), tr_frag(Vb + (8 * fq + trow) * 72 + 16 * jt2 + tcol, 4 * 72), y);
        *(f32x4*)(YVTg + (16 * jt2 + fr) * 36 + 16 * tt + 4 * fq) = y; }
    __syncthreads(); }
}
__device__ __forceinline__ void rwkv_stream(const Ctx& c, int bh, int it, int e) {
    const int b = bh / 12, h = bh % 12, lane = c.lane, fr = lane & 15, fq = lane >> 4;
    LAS bf16* Sl = (LAS bf16*)c.lds + c.wave * (16 * 72);
    const unsigned char* chk0 = C_CHK + (size_t)bh * 128 * CHK_BYTES;
    float* ya = C_YA + ((size_t)b * SEQ) * 768 + h * 64 + 16 * it + fr;
    f32x4 S[4];
#pragma unroll
    for (int jt = 0; jt < 4; ++jt) S[jt] = (f32x4){0.f, 0.f, 0.f, 0.f};
    bf16x8 A0[4][2], R0f[2][2], A1[4][2], R1f[2][2]; f32x4 G0[4], Y0[2], G1[4], Y1[2];
#define ST_LOAD(AF, RF, GV, YV, n_) do { const unsigned char* base_ = chk0 + (size_t)(n_) * CHK_BYTES; \
        _Pragma("unroll") for (int jt = 0; jt < 4; ++jt) { _Pragma("unroll") for (int ks = 0; ks < 2; ++ks) AF[jt][ks] = *(const bf16x8*)((const bf16*)(base_ + CK_A) + (16 * jt + fr) * 72 + 32 * ks + 8 * fq); \
            GV[jt] = *(const f32x4*)((const float*)(base_ + CK_GT) + (16 * it + fr) * 68 + 16 * jt + 4 * fq); } \
        _Pragma("unroll") for (int tt = 0; tt < 2; ++tt) { _Pragma("unroll") for (int ks = 0; ks < 2; ++ks) RF[tt][ks] = *(const bf16x8*)((const bf16*)(base_ + CK_RQ) + (16 * tt + fr) * 72 + 32 * ks + 8 * fq); \
            YV[tt] = *(const f32x4*)((const float*)(base_ + CK_YVT) + (16 * it + fr) * 36 + 16 * tt + 4 * fq); } } while (0)
#define ST_STEP(AF, RF, GV, YV, n_, tmax_) do { \
        _Pragma("unroll") for (int jt = 0; jt < 4; ++jt) *(LAS u32x2*)(Sl + fr * 72 + 16 * jt + 4 * fq) = (u32x2){pk2(S[jt][0], S[jt][1]), pk2(S[jt][2], S[jt][3])}; \
        asm volatile("s_waitcnt lgkmcnt(0)" ::: "memory"); \
        const bf16x8 Sf0 = *(const LAS bf16x8*)(Sl + fr * 72 + 8 * fq), Sf1 = *(const LAS bf16x8*)(Sl + fr * 72 + 32 + 8 * fq); \
        asm volatile("s_waitcnt lgkmcnt(0)" ::: "memory"); \
        _Pragma("unroll") for (int tt = 0; tt < 2; ++tt) { f32x4 y_ = mfma16(RF[tt][0], Sf0, YV[tt]); y_ = mfma16(RF[tt][1], Sf1, y_); \
            _Pragma("unroll") for (int r = 0; r < 4; ++r) if (16 * tt + 4 * fq + r < (tmax_)) ya[(size_t)(32 * (n_) + 16 * tt + 4 * fq + r) * 768] = y_[r]; } \
        _Pragma("unroll") for (int jt = 0; jt < 4; ++jt) { f32x4 a_ = mfma16(AF[jt][0], Sf0, GV[jt]); S[jt] = mfma16(AF[jt][1], Sf1, a_); } } while (0)
    ST_LOAD(A0, R0f, G0, Y0, 0);
#pragma unroll 1
    for (int n = 0; n < 128; n += 2) {
        ST_LOAD(A1, R1f, G1, Y1, n + 1);
        ST_STEP(A0, R0f, G0, Y0, n, 32);
        if (n + 2 < 128) ST_LOAD(A0, R0f, G0, Y0, n + 2);
        ST_STEP(A1, R1f, G1, Y1, n + 1, 32);
    }
    float* so = C_OUT + O_RWKV_P + (((size_t)e * 2 + b) * 12 + h) * 4096 + (size_t)(16 * it + fr) * 64 + 4 * fq;
#pragma unroll
    for (int jt = 0; jt < 4; ++jt) *(f32x4*)(so + 16 * jt) = S[jt];
}
__device__ __forceinline__ void rwkv_stream_block(const Ctx& c, int sb, int e) {
    const int bh = sb >> 1, ih = sb & 1, b = bh / 12, h = bh % 12, tid = c.tid, lane = c.lane, wave = c.wave, fr = lane & 15, fq = lane >> 4, il = wave >> 2, jt = wave & 3, it = 2 * ih + il;
    constexpr int SLOT = 13824 + 2 * 4352 + 2 * 2304;
    LAS unsigned char* slots = c.lds;
    LAS bf16* Sl = (LAS bf16*)(c.lds + 2 * SLOT) + il * (2 * 16 * 72);
    const unsigned char* rec0 = C_CHK + (size_t)bh * 128 * CHK_BYTES;
    int soff[4];
#pragma unroll
    for (int k = 0; k < 4; ++k) { const int p = tid + 512 * k; soff[k] = (p < 864) ? 16 * p : (p < 864 + 544) ? CK_GT + ih * 8704 + 16 * (p - 864) : CK_YVT + ih * 4608 + 16 * (p - 1408); }
    const bool has3 = (tid + 1536) < SLOT / 16;
    float* ya = C_YA + ((size_t)b * SEQ + 16 * jt + 4 * fq) * 768 + h * 64 + 16 * it + fr;
    f32x4 S1 = (f32x4){0.f, 0.f, 0.f, 0.f};
    *(LAS u32x2*)(Sl + fr * 72 + 16 * jt + 4 * fq) = (u32x2){0u, 0u};
    u32x4 P0[4], P1[4], P2[4], P3[4];
#define SB_GLOAD(P, n_) do { const int nn_ = (n_) < 128 ? (n_) : 127; const unsigned char* r_ = rec0 + (size_t)nn_ * CHK_BYTES; \
        _Pragma("unroll") for (int k = 0; k < 3; ++k) P[k] = *(const u32x4*)(r_ + soff[k]); P[3] = *(const u32x4*)(r_ + (has3 ? soff[3] : soff[0])); } while (0)
#define SB_LWRITE(P, s_) do { _Pragma("unroll") for (int k = 0; k < 3; ++k) *(LAS u32x4*)(slots + (s_) * SLOT + tid * 16 + k * 8192) = P[k]; if (has3) *(LAS u32x4*)(slots + (s_) * SLOT + tid * 16 + 3 * 8192) = P[3]; } while (0)
#define SB_STEP(s_, n_) do { const LAS unsigned char* sb_ = slots + (s_) * SLOT; const LAS bf16* si_ = Sl + (s_) * (16 * 72) + fr * 72 + 8 * fq; \
        const LAS bf16* a_ = (const LAS bf16*)sb_ + (16 * jt + fr) * 72 + 8 * fq; const bf16x8 af0 = *(const LAS bf16x8*)a_, af1 = *(const LAS bf16x8*)(a_ + 32); \
        const f32x4 gv_ = *(const LAS f32x4*)((const LAS float*)(sb_ + 13824) + (16 * il + fr) * 68 + 16 * jt + 4 * fq); \
        const LAS bf16* rq_ = (const LAS bf16*)(sb_ + CK_RQ) + (16 * (jt & 1) + fr) * 72 + 8 * fq; const bf16x8 rf0 = *(const LAS bf16x8*)rq_, rf1 = *(const LAS bf16x8*)(rq_ + 32); \
        const f32x4 yv_ = *(const LAS f32x4*)((const LAS float*)(sb_ + 13824 + 8704) + (16 * il + fr) * 36 + 16 * (jt & 1) + 4 * fq); \
        const bf16x8 Sf0 = *(const LAS bf16x8*)si_, Sf1 = *(const LAS bf16x8*)(si_ + 32); \
        asm volatile("s_waitcnt lgkmcnt(0)" ::: "memory"); __builtin_amdgcn_sched_barrier(0); \
        { f32x4 t_ = mfma16(af0, Sf0, gv_); S1 = mfma16(af1, Sf1, t_); } \
        if (jt < 2) { f32x4 y_ = mfma16(rf0, Sf0, yv_); y_ = mfma16(rf1, Sf1, y_); \
            _Pragma("unroll") for (int r = 0; r < 4; ++r) ya[(size_t)(32 * (n_) + r) * 768] = y_[r]; } \
        *(LAS u32x2*)(Sl + ((s_) ^ 1) * (16 * 72) + fr * 72 + 16 * jt + 4 * fq) = (u32x2){pk2(S1[0], S1[1]), pk2(S1[2], S1[3])}; \
        } while (0)
    SB_GLOAD(P0, 0); SB_GLOAD(P1, 1); SB_GLOAD(P2, 2); SB_GLOAD(P3, 3);
    SB_LWRITE(P0, 0); __syncthreads();
#pragma unroll 1
    for (int n = 0; n < 128; n += 4) {
        SB_LWRITE(P1, 1); SB_GLOAD(P0, n + 4); SB_STEP(0, n); __syncthreads();
        SB_LWRITE(P2, 0); SB_GLOAD(P1, n + 5); SB_STEP(1, n + 1); __syncthreads();
        SB_LWRITE(P3, 1); SB_GLOAD(P2, n + 6); SB_STEP(0, n + 2); __syncthreads();
        SB_LWRITE(P0, 0); SB_GLOAD(P3, n + 7); SB_STEP(1, n + 3); __syncthreads();
    }
#undef SB_GLOAD
#undef SB_LWRITE
#undef SB_STEP
    *(f32x4*)(C_OUT + O_RWKV_P + (((size_t)e * 2 + b) * 12 + h) * 4096 + (size_t)(16 * it + fr) * 64 + 16 * jt + 4 * fq) = S1;
}
__device__ __forceinline__ void rwkv_stream_sample(const Ctx& c, int sidx, int it, int e) {
    const int ns = sidx / 12, h = sidx % 12, lane = c.lane, fr = lane & 15, fq = lane >> 4;
    LAS bf16* Sl = (LAS bf16*)c.lds + c.wave * (16 * 72);
    const unsigned char* chk0 = C_CHK + (size_t)(3072 + sidx) * CHK_BYTES;
    float* ya = C_YA + ((size_t)(TP + 4 * ns)) * 768 + h * 64 + 16 * it + fr;
    const float* si = C_IN(2) + (((size_t)e * 8 + ns) * 12 + h) * 4096 + (size_t)(16 * it + fr) * 64 + 4 * fq;
    f32x4 S[4];
#pragma unroll
    for (int jt = 0; jt < 4; ++jt) S[jt] = *(const f32x4*)(si + 16 * jt);
    bf16x8 A0[4][2], R0f[2][2]; f32x4 G0[4], Y0[2];
    ST_LOAD(A0, R0f, G0, Y0, 0);
    ST_STEP(A0, R0f, G0, Y0, 0, 4);
    float* so = C_OUT + O_RWKV_S + (((size_t)e * 8 + ns) * 12 + h) * 4096 + (size_t)(16 * it + fr) * 64 + 4 * fq;
#pragma unroll
    for (int jt = 0; jt < 4; ++jt) *(f32x4*)(so + 16 * jt) = S[jt];
}
#undef ST_LOAD
#undef ST_STEP
__device__ __forceinline__ void phase_even_tok_pre(Ctx c, int l) {
    const int e = l >> 1;
    constexpr int NI = 3072 + 96;
    PreIn A; if (c.bid < NI) rwkv_chunk_preload(c, c.bid, e, A);
    for (int it = c.bid; it < NI; it += c.G) { PreIn B; const int nx = (it + c.G < NI) ? it + c.G : it;
        rwkv_chunk_preload(c, nx, e, B); rwkv_chunk_precompute(c, it, e, A); A = B; }
}
__device__ __forceinline__ void phase_even_scan(Ctx c, int l) {
    const int e = l >> 1;
    if (c.G >= 240) {
        if (c.bid < 48) { for (int rp = 0; rp < REPS; ++rp) { rwkv_stream_block(c, 6 * (c.bid & 7) + (c.bid >> 3), e); __syncthreads(); LAUNDER_C(c); } }
        else { Ctx h = c; h.bid = c.bid - 48; h.G = c.G - 48; LAUNDER_C(h);
            if (h.bid < 96) { if (h.wave < 4) rwkv_stream_sample(h, h.bid, h.wave, e); __syncthreads(); }
            even_helper_work(h, l); }
    } else {
        for (int it = c.bid; it < 48; it += c.G) { rwkv_stream_block(c, it, e); __syncthreads(); }
        for (int it = c.bid; it < 96; it += c.G) { if (c.wave < 4) rwkv_stream_sample(c, it, c.wave, e); __syncthreads(); }
        LAUNDER_C(c);
        even_helper_work(c, l);
    }
}
__device__ __forceinline__ void phase_even_ubuild(const Ctx& c, int l) {
    const int e = l >> 1; const float* r_k = C_IN(24) + e * 768; const float* lg = C_IN(25) + e * 768; const float* lb = C_IN(26) + e * 768; const float* muv = C_IN(17) + e * 2432 + EC_V;
    for (int R = c.bid * 8 + c.wave; R < TT; R += c.G * 8) {
        const bool hasprev = (R < TP) ? ((R & (SEQ - 1)) != 0) : (((R - TP) & 3) != 0);
        const float* shiftv = C_IN(3) + ((size_t)e * 8 + ((R >= TP) ? ((R - TP) >> 2) : 0)) * 2432 + EC_V;
        const bf16* hrow = C_HB + (size_t)R * LDH;
#pragma unroll 1
        for (int hb = 0; hb < 12; hb += 4) {
            float y[4], gate[4], cvv[4], pvv[4], bon[4], lgv[4], lbv[4], mv[4];
#pragma unroll
            for (int k = 0; k < 4; ++k) { const int col = (hb + k) * 64 + c.lane;
                y[k] = C_YA[(size_t)R * 768 + col]; gate[k] = bf2f(hrow[EC_GA + col]); cvv[k] = bf2f(hrow[EC_V + col]);
                pvv[k] = hasprev ? bf2f(hrow[EC_V + col - LDH]) : ((R < TP) ? 0.f : shiftv[col]);
                bon[k] = C_BONUS[(size_t)R * 12 + hb + k]; lgv[k] = lg[col]; lbv[k] = lb[col]; mv[k] = muv[col]; }
#pragma unroll
            for (int k = 0; k < 4; ++k) { const int col = (hb + k) * 64 + c.lane;
                const float mean = wave_sum(y[k]) * (1.0f / 64.0f); const float dlt = y[k] - mean; const float var = wave_sum(dlt * dlt) * (1.0f / 64.0f);
                const float yn = dlt * rsqrtf(var + 64e-5f) * lgv[k] + lbv[k];
                const float bonus = bon[k] * (cvv[k] + (pvv[k] - cvv[k]) * mv[k]);
                C_U[(size_t)R * EVEN_OUT + col] = (bf16)f2bf((yn + bonus) * siluf_(gate[k])); }
        }
    }
}

__device__ __forceinline__ void even_combine_dil(const Ctx& c) {
    const int hh = c.lane >> 4, d4 = 4 * (c.lane & 15);
    for (int R0 = c.bid * 8 + c.wave; R0 < TP; R0 += 2 * c.G * 8) {
        const int R1 = (R0 + c.G * 8 < TP) ? R0 + c.G * 8 : R0;
        float ls[2][3]; f32x4 og[2][3]; u32x2 gw[2];
#pragma unroll
        for (int k = 0; k < 2; ++k) { const int R = k ? R1 : R0;
#pragma unroll
            for (int g = 0; g < 3; ++g) { ls[k][g] = C_LSE[((size_t)g * TT + R) * 4 + hh]; og[k][g] = *(const f32x4*)(C_OG + ((size_t)g * TT + R) * 256 + hh * 64 + d4); }
            gw[k] = *(const u32x2*)(C_HB + (size_t)R * LDH + EC_GB + hh * 64 + d4); }
#pragma unroll
        for (int k = 0; k < 2; ++k) { const int R = k ? R1 : R0;
            const float mx = fmaxf(ls[k][0], fmaxf(ls[k][1], ls[k][2])); const float w0 = __expf(ls[k][0] - mx), w1 = __expf(ls[k][1] - mx), w2 = __expf(ls[k][2] - mx); const float inv = 1.0f / (w0 + w1 + w2);
            const f32x4 y = (og[k][0] * w0 + og[k][1] * w1 + og[k][2] * w2) * inv;
            float gt[4]; unpk4(gw[k], gt);
            *(u32x2*)(C_U + (size_t)R * EVEN_OUT + 768 + hh * 64 + d4) = (u32x2){pk2(y.x * siluf_(gt[0]), y.y * siluf_(gt[1])), pk2(y.z * siluf_(gt[2]), y.w * siluf_(gt[3]))}; }
    }
}
__device__ __forceinline__ void rot8(u32x4 w, const float* tb, float scale, float (&y)[8]) {
    float x[8]; unpk8(w, x); const f32x4 t0 = *(const f32x4*)tb, t1 = *(const f32x4*)(tb + 4);
    const float cs[8] = {t0.x, t0.y, t0.z, t0.w, t1.x, t1.y, t1.z, t1.w};
#pragma unroll
    for (int p = 0; p < 4; ++p) { const float co = cs[2 * p], si = cs[2 * p + 1], x0 = x[2 * p], x1 = x[2 * p + 1]; y[2 * p] = (x0 * co - x1 * si) * scale; y[2 * p + 1] = (x1 * co + x0 * si) * scale; }
}
#define C_SB ((bf16*)(c.ap->ws + WS_OG))
__device__ __forceinline__ void ret_s_prepass_item(const Ctx& c, int item) {
    const int bh = item >> 6, ch = item & 63, b = bh / 6, h = bh % 6;
    LAS bf16* Qc = (LAS bf16*)c.lds;
    LAS bf16* Kc = Qc + 64 * 264;
    const float lg = LG2G[h];
    const int tid = c.tid, lane = c.lane, wave = c.wave, fr = lane & 15, fq = lane >> 4, it = wave >> 1, jt0 = (wave & 1) * 2;
    const bf16* g0 = C_HB + ((size_t)b * SEQ + ch * 64) * LDH + h * 256;
    u32x4 tq[4], tk[4];
#pragma unroll
    for (int q = 0; q < 4; ++q) { const int p = tid + 512 * q, row = p >> 5, c8 = (p & 31) * 8; tq[q] = *(const u32x4*)(g0 + (size_t)row * LDH + OC_Q + c8); tk[q] = *(const u32x4*)(g0 + (size_t)row * LDH + OC_K + c8); }
#pragma unroll
    for (int q = 0; q < 4; ++q) { const int p = tid + 512 * q, row = p >> 5, c8 = (p & 31) * 8; *(LAS u32x4*)(Qc + row * 264 + c8) = tq[q]; *(LAS u32x4*)(Kc + row * 264 + c8) = tk[q]; }
    __syncthreads();
    f32x4 accS[2];
#pragma unroll
    for (int q = 0; q < 2; ++q) accS[q] = (f32x4){0.f, 0.f, 0.f, 0.f};
#pragma unroll
    for (int kp = 0; kp < 4; ++kp) { bf16x8 Qf2[2], Kf2[2][2];
#pragma unroll
        for (int kk = 0; kk < 2; ++kk) { const int ks = 2 * kp + kk; Qf2[kk] = *(const LAS bf16x8*)(Qc + (16 * it + fr) * 264 + 32 * ks + 8 * fq);
#pragma unroll
            for (int q = 0; q < 2; ++q) Kf2[kk][q] = *(const LAS bf16x8*)(Kc + (16 * (jt0 + q) + fr) * 264 + 32 * ks + 8 * fq); }
        asm volatile("s_waitcnt lgkmcnt(0)" ::: "memory"); __builtin_amdgcn_sched_barrier(0);
#pragma unroll
        for (int kk = 0; kk < 2; ++kk)
#pragma unroll
            for (int q = 0; q < 2; ++q) accS[q] = mfma16(Qf2[kk], Kf2[kk][q], accS[q]); }
    bf16* sb = C_SB + (size_t)item * 4096;
#pragma unroll
    for (int jj = 0; jj < 2; ++jj) { const int jt = jt0 + jj;
#pragma unroll
        for (int r = 0; r < 4; ++r) { const int i = 16 * it + 4 * fq + r, j = 16 * jt + fr; const float val = (i >= j) ? accS[jj][r] * exp2f(lg * (float)(i - j)) : 0.f; sb[i * 64 + j] = (bf16)f2bf(val); } }
    __syncthreads();
}
__device__ __forceinline__ void ret_prompt_unit(const Ctx& c, int unit, int o) {
    const int b = unit / 48, h = (unit >> 3) % 6, es = unit & 7;
    LAS bf16* Qc = (LAS bf16*)c.lds;
    LAS bf16* Kc = Qc + 64 * 264;
    LAS bf16* Vc = Kc + 64 * 264;
    LAS bf16* Vz = Vc + 64 * 40;
    LAS bf16* Rt = Vz + 64 * 40;
    const float lg = LG2G[h];
    const int tid = c.tid, lane = c.lane, wave = c.wave, fr = lane & 15, fq = lane >> 4, it = wave >> 1, eto = wave & 1;
    f32x4 Racc[2][2];
#pragma unroll
    for (int a = 0; a < 2; ++a)
#pragma unroll
        for (int q = 0; q < 2; ++q) Racc[a][q] = (f32x4){0.f, 0.f, 0.f, 0.f};
    for (int i = tid; i < 32 * 264 / 2; i += 512) ((LAS unsigned*)Rt)[i] = 0u;
    const float g64 = exp2f(lg * 64.f);
    const int vj = (tid & 255) >> 2, vp = tid & 3; const float zeta = exp2f(lg * (float)(63 - vj));
    const bf16* g0 = C_HB + ((size_t)b * SEQ) * LDH + h * 256;
    const bf16* gv = C_HB + ((size_t)b * SEQ + vj) * LDH + OC_V + h * 256 + es * 32 + vp * 8;
    const bf16* gs = C_SB + (size_t)((b * 6 + h) * 64) * 4096 + (16 * it + fr) * 64 + 8 * fq;
    u32x4 pq[4], pk[4], pv; bf16x8 sfn[2];
#pragma unroll
    for (int q = 0; q < 4; ++q) { const int p = tid + 512 * q, row = p >> 5, c8 = (p & 31) * 8; pq[q] = *(const u32x4*)(g0 + (size_t)row * LDH + OC_Q + c8); pk[q] = *(const u32x4*)(g0 + (size_t)row * LDH + OC_K + c8); }
    pv = *(const u32x4*)gv; sfn[0] = *(const bf16x8*)gs; sfn[1] = *(const bf16x8*)(gs + 32);
    const int trow = (lane & 15) >> 2, tcol = 4 * (lane & 3);
#pragma unroll 1
    for (int ch = 0; ch < 64; ++ch) {
        const size_t row0 = (size_t)b * SEQ + ch * 64;
#pragma unroll
        for (int q = 0; q < 4; ++q) { const int p = tid + 512 * q, row = p >> 5, c8 = (p & 31) * 8; *(LAS u32x4*)(Qc + row * 264 + c8) = pq[q]; *(LAS u32x4*)(Kc + row * 264 + c8) = pk[q]; }
        if (wave < 4) { *(LAS u32x4*)(Vc + vj * 40 + vp * 8) = pv; float x[8]; unpk8(pv, x);
            *(LAS u32x4*)(Vz + vj * 40 + vp * 8) = (u32x4){pk2(x[0] * zeta, x[1] * zeta), pk2(x[2] * zeta, x[3] * zeta), pk2(x[4] * zeta, x[5] * zeta), pk2(x[6] * zeta, x[7] * zeta)}; }
        const bf16x8 Sf0 = sfn[0], Sf1 = sfn[1];
        { const int cn = (ch + 1 < 64) ? ch + 1 : 63; const size_t adv = (size_t)cn * 64 * LDH;
#pragma unroll
            for (int q = 0; q < 4; ++q) { const int p = tid + 512 * q, row = p >> 5, c8 = (p & 31) * 8; pq[q] = *(const u32x4*)(g0 + adv + (size_t)row * LDH + OC_Q + c8); pk[q] = *(const u32x4*)(g0 + adv + (size_t)row * LDH + OC_K + c8); }
            pv = *(const u32x4*)(gv + adv); sfn[0] = *(const bf16x8*)(gs + (size_t)cn * 4096); sfn[1] = *(const bf16x8*)(gs + (size_t)cn * 4096 + 32); }
        __syncthreads();
        f32x4 accQ = (f32x4){0.f, 0.f, 0.f, 0.f};
        { bf16x8 Qf[8], Rf[8];
#pragma unroll
            for (int ks = 0; ks < 8; ++ks) { Qf[ks] = *(const LAS bf16x8*)(Qc + (16 * it + fr) * 264 + 32 * ks + 8 * fq); Rf[ks] = *(const LAS bf16x8*)(Rt + (16 * eto + fr) * 264 + 32 * ks + 8 * fq); }
            asm volatile("s_waitcnt lgkmcnt(0)" ::: "memory"); __builtin_amdgcn_sched_barrier(0);
#pragma unroll
            for (int ks = 0; ks < 8; ++ks) accQ = mfma16(Qf[ks], Rf[ks], accQ); }
        { bf16x8 Vfr[2], Kfr[2][2], Zfr[2][2];
#pragma unroll
            for (int k2 = 0; k2 < 2; ++k2) { Vfr[k2] = tr_frag(Vc + (32 * k2 + 8 * fq + trow) * 40 + 16 * eto + tcol, 4 * 40);
#pragma unroll
                for (int dd = 0; dd < 2; ++dd) Kfr[dd][k2] = tr_frag(Kc + (32 * k2 + 8 * fq + trow) * 264 + 16 * (2 * wave + dd) + tcol, 4 * 264);
#pragma unroll
                for (int et = 0; et < 2; ++et) Zfr[et][k2] = tr_frag(Vz + (32 * k2 + 8 * fq + trow) * 40 + 16 * et + tcol, 4 * 40); }
            asm volatile("s_waitcnt lgkmcnt(0)" ::: "memory"); __builtin_amdgcn_sched_barrier(0);
            { f32x4 a2 = mfma16(Sf0, Vfr[0], (f32x4){0.f, 0.f, 0.f, 0.f}); a2 = mfma16(Sf1, Vfr[1], a2);
#pragma unroll
                for (int r = 0; r < 4; ++r) { const int i = 16 * it + 4 * fq + r; C_YR[(row0 + i) * 1536 + h * 256 + es * 32 + 16 * eto + fr] = a2[r] + accQ[r] * exp2f(lg * (float)(i + 1)); } }
#pragma unroll
            for (int dd = 0; dd < 2; ++dd)
#pragma unroll
                for (int et = 0; et < 2; ++et) { f32x4 a = Racc[dd][et] * g64; a = mfma16(Kfr[dd][0], Zfr[et][0], a); Racc[dd][et] = mfma16(Kfr[dd][1], Zfr[et][1], a); } }
        __syncthreads();
#pragma unroll
        for (int dd = 0; dd < 2; ++dd)
#pragma unroll
            for (int et = 0; et < 2; ++et) { const f32x4 a = Racc[dd][et]; const int dt = 2 * wave + dd;
                *(LAS u32x2*)(Rt + (16 * et + fr) * 264 + 16 * dt + 4 * fq) = (u32x2){pk2(a[0], a[1]), pk2(a[2], a[3])}; }
    }
    int fq_l = fq; asm volatile("" : "+v"(fq_l));
    float* ro = C_OUT + O_RET_P + ((((size_t)o * 2 + b) * 6 + h) * 256) * 256 + es * 32;
#pragma unroll
    for (int dd = 0; dd < 2; ++dd)
#pragma unroll
        for (int et = 0; et < 2; ++et)
#pragma unroll
            for (int r = 0; r < 4; ++r) ro[(size_t)(16 * (2 * wave + dd) + 4 * fq_l + r) * 256 + 16 * et + fr] = Racc[dd][et][r];
    __syncthreads();
}
__device__ __forceinline__ void ret_sample_unit(const Ctx& c, int unit, int o) {
    const int n = unit / 6, h = unit % 6, tid = c.tid;
    LAS float* qs = (LAS float*)c.lds; LAS float* ks = qs + 1024; LAS float* vs = ks + 1024; LAS float* red = vs + 1024; LAS float* sc = red + 2048;
    const float lg = LG2G[h];
    for (int idx = tid; idx < 4 * 256; idx += 512) { const int t = idx >> 8, dd = idx & 255; const bf16* hr = C_HB + (size_t)(TP + n * 4 + t) * LDH + h * 256 + dd; qs[idx] = bf2f(hr[OC_Q]); ks[idx] = bf2f(hr[OC_K]); }
    for (int idx = tid; idx < 4 * 256; idx += 512) { const int t = idx >> 8, ee = idx & 255; vs[idx] = bf2f(C_HB[(size_t)(TP + n * 4 + t) * LDH + OC_V + h * 256 + ee]); }
    __syncthreads();
    if (tid < 16) { const int i = tid >> 2, j = tid & 3; float a = 0.f; for (int d = 0; d < 256; ++d) a += qs[i * 256 + d] * ks[j * 256 + d]; sc[tid] = (j <= i) ? a * exp2f(lg * (float)(i - j)) : 0.f; }
    __syncthreads();
    const int ee = tid & 255, dh = tid >> 8;
    const float* R0 = C_IN(7) + ((((size_t)o * 8 + n) * 6 + h) * 256) * 256; float* Rn = C_OUT + O_RET_S + ((((size_t)o * 8 + n) * 6 + h) * 256) * 256;
    const float g4 = exp2f(lg * 4.f), z0 = exp2f(lg * 3.f), z1 = exp2f(lg * 2.f), z2 = exp2f(lg), z3 = 1.0f;
    const float v0 = vs[ee] * z0, v1 = vs[256 + ee] * z1, v2 = vs[512 + ee] * z2, v3 = vs[768 + ee] * z3;
    float acc[4] = {0.f, 0.f, 0.f, 0.f};
#pragma unroll 1
    for (int d0 = dh * 128; d0 < dh * 128 + 128; d0 += 16) { float rv[16];
#pragma unroll
        for (int u = 0; u < 16; ++u) rv[u] = R0[(size_t)(d0 + u) * 256 + ee];
#pragma unroll
        for (int u = 0; u < 16; ++u) { const int d = d0 + u; const float r0 = rv[u];
            acc[0] += qs[d] * r0; acc[1] += qs[256 + d] * r0; acc[2] += qs[512 + d] * r0; acc[3] += qs[768 + d] * r0;
            Rn[(size_t)d * 256 + ee] = g4 * r0 + ks[d] * v0 + ks[256 + d] * v1 + ks[512 + d] * v2 + ks[768 + d] * v3; } }
#pragma unroll
    for (int i = 0; i < 4; ++i) red[(dh * 4 + i) * 256 + ee] = acc[i];
    __syncthreads();
    if (dh == 0) {
#pragma unroll
        for (int i = 0; i < 4; ++i) { float ov = (red[i * 256 + ee] + red[(4 + i) * 256 + ee]) * exp2f(lg * (float)(i + 1));
            for (int j = 0; j <= i; ++j) ov += sc[i * 4 + j] * vs[j * 256 + ee];
            C_YR[(size_t)(TP + n * 4 + i) * 1536 + h * 256 + ee] = ov; } }
    __syncthreads();
}
__device__ __forceinline__ void odd_helper_work(Ctx c, int l) {
    { pg8::Gemm g{C_XB, C_WTIN_L(l), MPAD, 4 * 256, DM}; pg8::StaticOrder S; S.init(MPAD, 4 * 256, c.G, c.bid, 0, 18); S.ex_n = 24; S.ex_pm0 = 0; S.ex_pn = 22;
        pg8::EpiBf16NP E{C_HB, LDH, C_TAB, 0, 1536};
        pg8::gemm_phase<pg8::EpiBf16NP, pg8::StaticOrder, true, true>(c.lds, g, S, E); }
    LAUNDER_C(c);
    mem_attn_all(c, l, OC_QM, OC_GM, 1536, ODD_OUT);
    LAUNDER_C(c);
    if (l < 3) convert_layer_weights(c, l + 1);
}
__device__ __forceinline__ void phase_odd_tok(Ctx c, int l) {
    const int o = l >> 1;
    if (c.G >= 256) {
        if (c.bid < 96) ret_prompt_unit(c, 12 * (c.bid & 7) + (c.bid >> 3), o);
        else { if (c.bid < 144) ret_sample_unit(c, c.bid - 96, o);
            Ctx h = c; h.bid = c.bid - 96; h.G = c.G - 96; LAUNDER_C(h); odd_helper_work(h, l); }
    } else {
        for (int it = c.bid; it < 144; it += c.G) { if (it < 96) ret_prompt_unit(c, it, o); else ret_sample_unit(c, it - 96, o); }
        LAUNDER_C(c);
        odd_helper_work(c, l);
    }
}
__device__ __forceinline__ void phase_odd_ubuild(const Ctx& c) {
    for (int R = c.bid * 8 + c.wave; R < TT; R += c.G * 8) {
#pragma unroll 1
        for (int hb = 0; hb < 6; hb += 3) {
            f32x4 ov[3]; u32x2 gw[3];
#pragma unroll
            for (int k = 0; k < 3; ++k) { const int col = (hb + k) * 256 + 4 * c.lane; ov[k] = *(const f32x4*)(C_YR + (size_t)R * 1536 + col); gw[k] = *(const u32x2*)(C_HB + (size_t)R * LDH + OC_G + col); }
#pragma unroll
            for (int k = 0; k < 3; ++k) { const int col = (hb + k) * 256 + 4 * c.lane; const f32x4 o = ov[k];
                const float ss = wave_sum(o.x * o.x + o.y * o.y + o.z * o.z + o.w * o.w); const float scl = rsqrtf(ss * (1.0f / 256.0f) + 1e-6f);
                float g[4]; unpk4(gw[k], g);
                *(u32x2*)(C_U + (size_t)R * DM + col) = (u32x2){pk2(o.x * scl * siluf_(g[0]), o.y * scl * siluf_(g[1])), pk2(o.z * scl * siluf_(g[2]), o.w * scl * siluf_(g[3]))}; }
        }
    }
}
__device__ __forceinline__ void small_outproj(const Ctx& c, int wt, int K, int l) {
    const int lane = c.lane, r = lane & 31, hl = lane >> 5, nks = K / 128;
    const bf16* ap = C_U + (size_t)(TP + r) * K + 8 * hl + c.wave * nks * 16; const bf16* bp = C_WTOUT_L(l) + (size_t)(32 * wt + r) * K + 8 * hl + c.wave * nks * 16;
    f32x16 acc;
#pragma unroll
    for (int i = 0; i < 16; ++i) acc[i] = 0.f;
    if (nks == 16) {
#pragma unroll
        for (int ks = 0; ks < 16; ++ks) acc = mfma32(*(const bf16x8*)(ap + 16 * ks), *(const bf16x8*)(bp + 16 * ks), acc);
    } else {
#pragma unroll
        for (int ks = 0; ks < 12; ++ks) acc = mfma32(*(const bf16x8*)(ap + 16 * ks), *(const bf16x8*)(bp + 16 * ks), acc);
    }
    LAS float* part = (LAS float*)c.lds;
#pragma unroll
    for (int i = 0; i < 16; ++i) part[(c.wave * 16 + i) * 64 + lane] = acc[i];
    __syncthreads();
    for (int idx = c.tid; idx < 1024; idx += 512) { float sum = 0.f;
#pragma unroll
        for (int w = 0; w < 8; ++w) sum += part[w * 1024 + idx];
        const int i = idx >> 6, ln = idx & 63, row = TP + (i & 3) + 8 * (i >> 2) + 4 * (ln >> 5), col = 32 * wt + (ln & 31);
        const float xres = (l == 0) ? C_IN(1)[(size_t)(row - TP) * DM + col] : C_XZ[(size_t)row * DM + col];
        C_Z[(size_t)row * DM + col] = xres * ALPHA + sum; }
    __syncthreads();
}
__device__ __forceinline__ void phase_ln(const Ctx& c, int l) {
    const float* g = C_IN(15) + l * DM; const float* bta = C_IN(16) + l * DM;
    f32x4 gg[8], bb[8];
#pragma unroll
    for (int j = 0; j < 8; ++j) { const int col = 4 * c.lane + 256 * j; gg[j] = *(const f32x4*)(g + col); bb[j] = *(const f32x4*)(bta + col); }
    for (int R0 = c.bid * 8 + c.wave; R0 < TT; R0 += 2 * c.G * 8) {
        const int R1 = R0 + c.G * 8; const bool has1 = R1 < TT; const int R1c = has1 ? R1 : R0;
        f32x4 v0[8], v1[8]; float s0 = 0.f, s1 = 0.f;
        { const f32x4* z0 = (const f32x4*)(C_Z + (size_t)R0 * DM) + c.lane; const f32x4* z1 = (const f32x4*)(C_Z + (size_t)R1c * DM) + c.lane;
#pragma unroll
            for (int j = 0; j < 8; ++j) { v0[j] = z0[64 * j]; v1[j] = z1[64 * j]; } }
#pragma unroll
        for (int j = 0; j < 8; ++j) { s0 += (v0[j].x + v0[j].y) + (v0[j].z + v0[j].w); s1 += (v1[j].x + v1[j].y) + (v1[j].z + v1[j].w); }
        const float m0 = wave_sum(s0) * (1.0f / DM), m1 = wave_sum(s1) * (1.0f / DM); float q0 = 0.f, q1 = 0.f;
#pragma unroll
        for (int j = 0; j < 8; ++j) { v0[j] = v0[j] - m0; v1[j] = v1[j] - m1; q0 += (v0[j].x * v0[j].x + v0[j].y * v0[j].y) + (v0[j].z * v0[j].z + v0[j].w * v0[j].w); q1 += (v1[j].x * v1[j].x + v1[j].y * v1[j].y) + (v1[j].z * v1[j].z + v1[j].w * v1[j].w); }
        const float r0 = rsqrtf(wave_sum(q0) * (1.0f / DM) + LN_EPS), r1 = rsqrtf(wave_sum(q1) * (1.0f / DM) + LN_EPS);
        float* d0 = (l == 3) ? (R0 < TP ? C_OUT + O_YP + (size_t)R0 * DM : C_OUT + O_YS + (size_t)(R0 - TP) * DM) : C_XZ + (size_t)R0 * DM;
        float* d1 = (l == 3) ? (R1c < TP ? C_OUT + O_YP + (size_t)R1c * DM : C_OUT + O_YS + (size_t)(R1c - TP) * DM) : C_XZ + (size_t)R1c * DM;
#pragma unroll
        for (int j = 0; j < 8; ++j) { const int col = 4 * c.lane + 256 * j;
            const f32x4 x0 = v0[j] * r0 * gg[j] + bb[j]; *(f32x4*)(d0 + col) = x0; if (l != 3) *(u32x2*)(C_XB + (size_t)R0 * DM + col) = (u32x2){pk2(x0.x, x0.y), pk2(x0.z, x0.w)};
            if (has1) { const f32x4 x1 = v1[j] * r1 * gg[j] + bb[j]; *(f32x4*)(d1 + col) = x1; if (l != 3) *(u32x2*)(C_XB + (size_t)R1 * DM + col) = (u32x2){pk2(x1.x, x1.y), pk2(x1.z, x1.w)}; } }
    }
}

#define XB_TMO      128
#define XB_XCNT(j)  (256  + 64 * (j))
#define XB_XSUB(j)  (1280 + 64 * (j))
#define XB_XGEN(j)  (2304 + 64 * (j))
#define XB_TOP      3328
#define XB_TOPGEN   3392
#define XCD_BAR_WORDS 3456
#define XB_SPIN_CAP (1u << 18)

__device__ __forceinline__ unsigned xb_ld(unsigned* p)              { return __hip_atomic_load(p, __ATOMIC_RELAXED, __HIP_MEMORY_SCOPE_AGENT); }
__device__ __forceinline__ unsigned xb_add(unsigned* p, unsigned v) { return __hip_atomic_fetch_add(p, v, __ATOMIC_RELAXED, __HIP_MEMORY_SCOPE_AGENT); }
__device__ __forceinline__ unsigned xb_xcc_id() { return (unsigned)__builtin_amdgcn_s_getreg((3 << 11) | 20) & 0xFu; }
#define XB_SPIN(cond, bar) do { unsigned _sp = 0; while (cond) { __builtin_amdgcn_s_sleep(1); \
    if ((++_sp & 255u) == 0u) { if (xb_ld(&(bar)[XB_TMO])) break; if (_sp > XB_SPIN_CAP) { atomicAdd(&(bar)[XB_TMO], 1u); break; } } } } while (0)

struct XcdBarrier {
    unsigned* bar; unsigned x;
    volatile LAS unsigned* st;
};

__device__ __forceinline__ XcdBarrier xcd_barrier_post(unsigned* bar, volatile LAS unsigned* st) {
    XcdBarrier b; b.bar = bar; b.x = xb_xcc_id(); b.st = st;
    if (threadIdx.x == 0) (void)xb_add(&bar[XB_XCNT(b.x)], 1u);
    return b;
}
__device__ __forceinline__ void xcd_barrier_complete(unsigned* bar, unsigned x, unsigned& nloc, unsigned& nx) {
    const unsigned G = gridDim.x * gridDim.y * gridDim.z;
    unsigned sum, cnt, mine, sp = 0u;
    for (;;) {
        sum = 0u; cnt = 0u; mine = 0u;
#pragma unroll
        for (unsigned j = 0; j < 16; ++j) { const unsigned c = xb_ld(&bar[XB_XCNT(j)]); sum += c; cnt += (c > 0u) ? 1u : 0u; mine = (j == x) ? c : mine; }
        if (sum == G) break;
        __builtin_amdgcn_s_sleep(1);
        if ((++sp & 255u) == 0u) { if (xb_ld(&bar[XB_TMO])) break; if (sp > XB_SPIN_CAP) { atomicAdd(&bar[XB_TMO], 1u); break; } }
    }
    nloc = mine > 0u ? mine : 1u; nx = cnt > 0u ? cnt : 1u;
}

__device__ __forceinline__ void xcd_barrier(const XcdBarrier& b) {
    asm volatile("s_waitcnt vmcnt(0)" ::: "memory");
    __syncthreads();
    if (threadIdx.x == 0) {
        unsigned* bar = b.bar;
        __builtin_amdgcn_s_waitcnt(0);
        unsigned nloc = b.st[0], nx = b.st[1];
        if (nloc == 0u) { xcd_barrier_complete(bar, b.x, nloc, nx); b.st[0] = nloc; b.st[1] = nx; }
        const unsigned old = xb_add(&bar[XB_XSUB(b.x)], 1u);
        const unsigned gen = old / nloc;
        if (old + 1u == (gen + 1u) * nloc) {
            __builtin_amdgcn_fence(__ATOMIC_RELEASE, "agent");
            asm volatile("s_waitcnt vmcnt(0)" ::: "memory");
            const unsigned og = xb_add(&bar[XB_TOP], 1u);
            const unsigned tg = og / nx;
            if (og + 1u == (tg + 1u) * nx) xb_add(&bar[XB_TOPGEN], 1u);
            else XB_SPIN(xb_ld(&bar[XB_TOPGEN]) == tg, bar);
            __builtin_amdgcn_fence(__ATOMIC_ACQUIRE, "agent");
            xb_add(&bar[XB_XGEN(b.x)], 1u);
            asm volatile("s_waitcnt vmcnt(0)" ::: "memory");
        } else {
            XB_SPIN(xb_ld(&bar[XB_XGEN(b.x)]) == gen, bar);
            __builtin_amdgcn_fence(__ATOMIC_ACQUIRE, "agent");
            asm volatile("s_waitcnt vmcnt(0)" ::: "memory");
        }
    }
    __syncthreads();
}

constexpr int NPH = 25;
__global__ void __launch_bounds__(512, 2) mk(Args args) {
    extern __shared__ __attribute__((aligned(16))) unsigned char lds_raw[];
    Ctx c;
    c.ap = (ArgsP)__builtin_amdgcn_kernarg_segment_ptr(); c.lds = (LAS unsigned char*)lds_raw;
    c.tid = threadIdx.x; c.lane = c.tid & 63; c.wave = __builtin_amdgcn_readfirstlane(c.tid >> 6); c.bid = blockIdx.x; c.G = gridDim.x;
    for (int u = c.tid; u < 16; u += 512) ((LAS unsigned*)(c.lds + 131072))[u] = 0u;
    __syncthreads();
    XcdBarrier xbar = xcd_barrier_post((unsigned*)(c.ap->ws + WS_CTL) + 4096, (volatile LAS unsigned*)(c.lds + 131072));
#define LAUNDER() do { asm volatile("" : "+s"(c.ap), "+v"(c.tid), "+s"(c.bid), "+s"(c.G)); c.lane = c.tid & 63; c.wave = __builtin_amdgcn_readfirstlane(c.tid >> 6); } while (0)
    const int lo = args.ph_lo, hi = args.ph_hi;
#define IN(k) (lo <= (k) && (k) < hi)
#if USE_CG
#define SEAM(k) do { if (IN(k) && IN((k) + 1)) { cg::this_grid().sync(); } } while (0)
#else
#define SEAM(k) do { if (IN(k) && IN((k) + 1)) { asm volatile("" : "+s"(xbar.bar)); xcd_barrier(xbar); } } while (0)
#endif
    #if !(DIS & 1)
    if (IN(0)) { for (int rep = 0; rep < ((DUP & 128) ? 2 : 1); ++rep) { LAUNDER(); phase_prologue(c); if (DUP & 128) { asm volatile("" : "+s"(xbar.bar)); xcd_barrier(xbar); } } }
#endif
    SEAM(0);
#pragma unroll 1
    for (int l = 0; l < 4; ++l) {
        const int p0 = 1 + 6 * l; const bool even = (l & 1) == 0;
#if !(DIS & 2)
        if (IN(p0)) { for (int rep = 0; rep < ((DUP & 16) ? 2 : 1); ++rep) { LAUNDER();
            if (l == 0) { pg8::Gemm g{C_MEMB, C_WTMEM, 512, 4096, DM}; pg8::StaticOrder S; S.init(512, 4096, c.G, (c.bid + c.G - c.G / 2) % c.G);
                pg8::EpiF32Split E{C_OUT + O_MEM, 1024, 1024, (size_t)512 * 1024, C_MKVB};
                pg8::gemm_phase<pg8::EpiF32Split, pg8::StaticOrder, true, true>(c.lds, g, S, E); }
            const int ngemm = (l == 0) ? 5 : 1;
#pragma unroll 1
            for (int gi = 0; gi < ngemm; ++gi) {
                const int NI = even ? EVEN_INP : ODD_IN;
                const bf16* A = gi ? C_WTMEM + ((size_t)(gi - 1) * 1024 + 512) * DM : C_XB; const bf16* Bt = gi ? C_MEMB : C_WTIN_L(l);
                const bool defer = (gi == 0) && !even;
                const int Mg = gi ? 512 : MPAD, Ng = gi ? 512 : (defer ? NI - 5 * 256 : NI);
                bf16* Og = gi ? C_VT + (size_t)(gi - 1) * 512 * 512 : C_HB; const int ldo = gi ? 512 : LDH;
                pg8::Gemm g{A, Bt, Mg, Ng, DM}; pg8::StaticOrder S; S.init(Mg, Ng, c.G, gi ? (c.bid + 2 * c.G - (5 * c.G) / 8 - 8 * (gi - 1)) % c.G : c.bid, defer ? 18 : (1 << 30), defer ? 5 : 0); if (defer) { S.ex_n = 9; S.ex_pm0 = 24; S.ex_pn = 22; }
                pg8::EpiBf16NP E{Og, ldo, C_TAB, (gi == 0 && !even) ? 3072 : 0, 1536};
                pg8::gemm_phase<pg8::EpiBf16NP, pg8::StaticOrder, true, true>(c.lds, g, S, E);
            }
            if (DUP & 16) { asm volatile("" : "+s"(xbar.bar)); xcd_barrier(xbar); }
        } }
#endif
        SEAM(p0);
#if !(DIS & 4)
        if (IN(p0 + 1)) { for (int rep = 0; rep < ((DUP & 1) ? 2 : 1); ++rep) { LAUNDER(); if (even) phase_even_tok_pre(c, l); if (DUP & 1) { asm volatile("" : "+s"(xbar.bar)); xcd_barrier(xbar); } } }
#endif
#if !(DIS & 8)
        if (IN(p0 + 1)) { LAUNDER(); if (!even) { for (int it = c.bid; it < 768; it += c.G) ret_s_prepass_item(c, it); } }
#endif
        SEAM(p0 + 1);
#if !(DIS & 16)
        if (IN(p0 + 2)) { for (int rep = 0; rep < ((DUP & 4) ? 2 : 1); ++rep) { LAUNDER(); if (even) phase_even_scan(c, l); if (DUP & 4) { asm volatile("" : "+s"(xbar.bar)); xcd_barrier(xbar); } } }
#if !(DIS & 8)
        if (IN(p0 + 2)) { for (int rep = 0; rep < ((DUP & 2) ? 2 : 1); ++rep) { LAUNDER(); if (!even) phase_odd_tok(c, l); if (DUP & 2) { asm volatile("" : "+s"(xbar.bar)); xcd_barrier(xbar); } } }
#endif
#endif
        SEAM(p0 + 2);
#if !(DIS & 32)
        if (IN(p0 + 3)) { for (int rep = 0; rep < ((DUP & 8) ? 2 : 1); ++rep) { LAUNDER(); if (even) { phase_even_ubuild(c, l); LAUNDER(); even_combine_dil(c); } else phase_odd_ubuild(c); if (DUP & 8) { asm volatile("" : "+s"(xbar.bar)); xcd_barrier(xbar); } } }
#endif
        SEAM(p0 + 3);
#if !(DIS & 64)
        if (IN(p0 + 4)) { for (int rep = 0; rep < ((DUP & 32) ? 2 : 1); ++rep) { LAUNDER(); const int K = even ? EVEN_OUT : ODD_OUT;
            pg8::Gemm g{C_U, C_WTOUT_L(l), TP, DM, K}; pg8::StaticOrder S; S.init(TP, DM, c.G, c.bid); pg8::EpiResid E{(l == 0) ? C_IN(0) : C_XZ, C_Z, DM, ALPHA};
            pg8::gemm_phase<pg8::EpiResid, pg8::StaticOrder, true, true>(c.lds, g, S, E);
            LAUNDER(); if (c.bid < 64) small_outproj(c, c.bid, K, l); if (DUP & 32) { asm volatile("" : "+s"(xbar.bar)); xcd_barrier(xbar); } } }
#endif
        SEAM(p0 + 4);
#if !(DIS & 128)
        if (IN(p0 + 5)) { for (int rep = 0; rep < ((DUP & 64) ? 2 : 1); ++rep) { LAUNDER(); phase_ln(c, l); if (DUP & 64) { asm volatile("" : "+s"(xbar.bar)); xcd_barrier(xbar); } } }
#endif
        SEAM(p0 + 5);
    }
#undef IN
#undef SEAM
}

extern "C" void kernel_launch(void* const* d_in, const int* in_sizes, int n_in, void* d_out, int out_size, void* d_ws, size_t ws_size, hipStream_t stream) {
    static int grid = 0;
    if (grid == 0) {
        if (n_in != 27 || (size_t)out_size != O_END || ws_size < WS_END) { fprintf(stderr, "kernel_launch: unexpected shapes: n_in %d out %d ws %zu (need %zu)\n", n_in, out_size, ws_size, (size_t)WS_END); grid = -1; return; }
        int dev = 0, cus = 0, per_cu = 0;
        hipGetDevice(&dev); hipDeviceGetAttribute(&cus, hipDeviceAttributeMultiprocessorCount, dev);
        if (hipFuncSetAttribute((const void*)mk, hipFuncAttributeMaxDynamicSharedMemorySize, LDS_BYTES) != hipSuccess) { fprintf(stderr, "kernel_launch: hipFuncSetAttribute failed\n"); grid = -1; return; }
        if (hipOccupancyMaxActiveBlocksPerMultiprocessor(&per_cu, (const void*)mk, 512, LDS_BYTES) != hipSuccess || per_cu < 1) { fprintf(stderr, "kernel_launch: occupancy query says %d\n", per_cu); per_cu = 1; }
        (void)hipGetLastError();
        grid = cus;
        fprintf(stderr, "kernel_launch: grid %d (cus %d, per_cu %d)\n", grid, cus, per_cu);
    }
    if (grid < 0) return;
    if (hipMemsetAsync((char*)d_ws + WS_CTL, 0, 1u << 20, stream) != hipSuccess) { fprintf(stderr, "kernel_launch: memset failed\n"); return; }
    Args a{};
    for (int i = 0; i < 27; ++i) a.in[i] = (const float*)d_in[i];
    a.out = (float*)d_out; a.ws = (unsigned char*)d_ws;
#if ONE_LAUNCH
    a.ph_lo = 0; a.ph_hi = NPH;
    void* kargs[] = {&a};
    hipError_t e = hipLaunchCooperativeKernel((const void*)mk, dim3(grid), dim3(512), kargs, LDS_BYTES, stream);
    if (e != hipSuccess) fprintf(stderr, "kernel_launch: cooperative launch failed: %s\n", hipGetErrorString(e));
#else
    for (int p = 0; p < NPH; ++p) {
        if (p >= 1 && ((p - 1) % 6) == 2 && (((p - 1) / 6) & 1)) continue;
        a.ph_lo = p; a.ph_hi = p + 1;
        hipLaunchKernelGGL(mk, dim3(grid), dim3(512), LDS_BYTES, stream, a);
    }
#endif
}
```

```cpp
#include <hip/hip_runtime.h>
#include <hip/hip_cooperative_groups.h>
#include <cstdio>
#include <cstdint>
namespace cg = cooperative_groups;
#ifndef DIS
#define DIS 0
#endif
#ifndef REPE
#define REPE 1
#endif
#ifndef REPD
#define REPD 1
#endif
#ifndef REPM
#define REPM 1
#endif
#ifndef REPC
#define REPC 1
#endif
#ifndef REPS
#define REPS 1
#endif
#ifndef REP9
#define REP9 1
#endif
#ifndef REP3
#define REP3 1
#endif
#ifndef REP8
#define REP8 1
#endif
#ifndef REP1
#define REP1 1
#endif
#ifndef DUP
#define DUP 0
#endif
#ifndef USE_CG
#define USE_CG 0
#endif
#ifndef ONE_LAUNCH
#define ONE_LAUNCH 1
#endif
namespace pg8 {
#define PG8_LAS __attribute__((address_space(3)))
typedef unsigned short bf16_t;
typedef short bf16x8 __attribute__((ext_vector_type(8)));
typedef float f32x4 __attribute__((ext_vector_type(4)));
typedef unsigned u32x4 __attribute__((ext_vector_type(4)));
constexpr int BM = 256, BK = 64, HALF = 128, HTB = HALF * BK * 2  , STAGE_BYTES = 8 * HTB, NXCD = 8, WGM = 8;

__host__ __device__ __forceinline__ int lds_byte(int r, int c) { const int st = (r >> 4) * 2 + (c >> 5), rr = r & 15, cc = c & 31, ob = rr * 64 + cc * 2; return st * 1024 + (ob ^ (((ob >> 9) & 1) << 5)); }
__host__ __device__ __forceinline__ void stage_rc(int b, int& R, int& C) { const int st = b / 1024, sb = b % 1024, swz = sb ^ (((sb >> 9) & 1) << 5); R = (st >> 1) * 16 + swz / 64; C = (st & 1) * 32 + (swz % 64) / 2; }
__host__ __device__ __forceinline__ int perm32(int rho) { const int n = rho >> 4, i = rho & 15; return 8 * (i >> 2) + 4 * n + (i & 3); }

struct Unit { int pm, pn; };
struct Gemm { const bf16_t* A; const bf16_t* Bt; int M, N, K; };

struct StaticOrder {
    int nM, nN, nwg, G, c, skip_from, skip_n, ex_n, ex_pm0, ex_pn;
    __host__ __device__ void init(int M, int N, int G_, int c_, int sf = 1 << 30, int sn = 0) { nM = M / BM; nN = N / BM; nwg = nM * nN; G = G_; c = c_; skip_from = sf; skip_n = sn; ex_n = 0; ex_pm0 = 0; ex_pn = 0; }
    __host__ __device__ bool next(int i, Unit& u) const {
        const long L = (long)i * G + c; if (L >= nwg + ex_n) return false;
        if (L >= nwg) { u.pm = ex_pm0 + (int)(L - nwg); u.pn = ex_pn; return true; }
        int wgid = (int)L; { const int q = nwg / NXCD, r = nwg % NXCD, xcd = wgid % NXCD, off = wgid / NXCD; wgid = (xcd < r ? xcd * (q + 1) : r * (q + 1) + (xcd - r) * q) + off; }
        const int nig = WGM * nN, gid = wgid / nig, fm = gid * WGM, gsz = (nM - fm) < WGM ? (nM - fm) : WGM;
        u.pm = fm + ((wgid % nig) % gsz); u.pn = (wgid % nig) / gsz; if (u.pn >= skip_from) u.pn += skip_n; return true;
    }
    __device__ __forceinline__ void a_ready(const Unit&) const {}
    __device__ __forceinline__ void done(const Unit&) const {}
};

__device__ __forceinline__ unsigned cvt_pk_bf16(float lo, float hi) { unsigned r; asm volatile("v_cvt_pk_bf16_f32 %0, %1, %2" : "=v"(r) : "v"(lo), "v"(hi)); return r; }
typedef float f32x2 __attribute__((ext_vector_type(2)));
__device__ __forceinline__ f32x2 gelu_pk(f32x2 v) {
    const f32x2 av = __builtin_elementwise_abs(v), d = av * 0.2316418882f + 1.0f;
    f32x2 t; t.x = __builtin_amdgcn_rcpf(d.x); t.y = __builtin_amdgcn_rcpf(d.y);
    f32x2 q = t * 0.5307027145f + (-0.7265760135f); q = q * t + 0.7107068705f; q = q * t + (-0.142248368f); q = q * t + 0.127414796f; q = q * t;
    const f32x2 s = (v * v) * (-0.72134752044f);
    f32x2 e; e.x = __builtin_amdgcn_exp2f(s.x); e.y = __builtin_amdgcn_exp2f(s.y);
    const f32x2 m = v * (q * e), r = v - m;
    f32x2 o; o.x = v.x < 0.f ? m.x : r.x; o.y = v.y < 0.f ? m.y : r.y; return o;
}

template <int ACT  > struct EpiBf16 {
    static constexpr bool PERM = true, AFTER_DRAIN = false; static_assert(ACT == 0 || ACT == 1, "EpiBf16: ACT is 0 (none) or 1 (gelu_pk)");
    bf16_t* O; int ldc; const float* bias; int split_cols; size_t split_stride; float scale0;
    __device__ __forceinline__ void operator()(const f32x4 (&acc)[2][2][4][2], const Unit& u, int wr, int wc, int fr, int fq) const {
        const int row0 = u.pm * BM + wr * 64 + fr; int colt = u.pn * BM; bf16_t* base = O;
        float sc = 1.f; if (split_cols) { const int t = colt / split_cols; base += (size_t)t * split_stride; colt -= t * split_cols; if (t == 0) sc = scale0; }
        const int col0 = colt + wc * 32 + 8 * fq, bcol0 = u.pn * BM + wc * 32 + 8 * fq;
        f32x4 bv[2][2];
#pragma unroll
        for (int bj = 0; bj < 2; ++bj)
#pragma unroll
            for (int n = 0; n < 2; ++n) bv[bj][n] = bias ? *(const f32x4*)(bias + bcol0 + bj * HALF + 4 * n) : (f32x4){0.f, 0.f, 0.f, 0.f};
#pragma unroll
        for (int ai = 0; ai < 2; ++ai)
#pragma unroll
            for (int m = 0; m < 4; ++m) { bf16_t* rowp = base + (size_t)(row0 + ai * HALF + m * 16) * ldc + col0;
#pragma unroll
                for (int bj = 0; bj < 2; ++bj) { f32x4 v0 = acc[ai][bj][m][0] + bv[bj][0], v1 = acc[ai][bj][m][1] + bv[bj][1];
                    if (ACT == 1) { f32x2 a = gelu_pk((f32x2){v0[0], v0[1]}), b = gelu_pk((f32x2){v0[2], v0[3]}), c = gelu_pk((f32x2){v1[0], v1[1]}), d = gelu_pk((f32x2){v1[2], v1[3]});
                        v0 = (f32x4){a.x, a.y, b.x, b.y}; v1 = (f32x4){c.x, c.y, d.x, d.y}; }
                    v0 = v0 * sc; v1 = v1 * sc; u32x4 w; w.x = cvt_pk_bf16(v0[0], v0[1]); w.y = cvt_pk_bf16(v0[2], v0[3]); w.z = cvt_pk_bf16(v1[0], v1[1]); w.w = cvt_pk_bf16(v1[2], v1[3]);
                    *(u32x4*)(rowp + bj * HALF) = w; } }
    }
};
struct EpiF32Split {
    static constexpr bool PERM = false, AFTER_DRAIN = false;
    float* C; int ldc; int split_cols; size_t split_stride; bf16_t* MB;
    __device__ __forceinline__ void operator()(const f32x4 (&acc)[2][2][4][2], const Unit& u, int wr, int wc, int fr, int fq) const {
        typedef unsigned u32x2v __attribute__((ext_vector_type(2)));
        int colt = u.pn * BM; float* base = C; bf16_t* mb = MB;
        if (split_cols) { const int t = colt / split_cols; base += (size_t)t * split_stride; mb += (size_t)t * split_stride; colt -= t * split_cols; }
        const int row0 = u.pm * BM + wr * 64 + fr, col0 = colt + wc * 32 + 4 * fq;
#pragma unroll
        for (int ai = 0; ai < 2; ++ai)
#pragma unroll
            for (int m = 0; m < 4; ++m) { float* rowp = base + (size_t)(row0 + ai * HALF + m * 16) * ldc + col0; bf16_t* rowb = mb + (size_t)(row0 + ai * HALF + m * 16) * ldc + col0;
#pragma unroll
                for (int bj = 0; bj < 2; ++bj)
#pragma unroll
                    for (int n = 0; n < 2; ++n) { const f32x4 v = acc[ai][bj][m][n]; *(f32x4*)(rowp + bj * HALF + n * 16) = v;
                        u32x2v w; w.x = cvt_pk_bf16(v[0], v[1]); w.y = cvt_pk_bf16(v[2], v[3]); *(u32x2v*)(rowb + bj * HALF + n * 16) = w; } }
    }
};
struct EpiBf16NP {
    static constexpr bool PERM = true, AFTER_DRAIN = false;
    bf16_t* O; int ldc; const float* TAB; int rot_cols, kcol0;
    __device__ __forceinline__ void operator()(const f32x4 (&acc)[2][2][4][2], const Unit& u, int wr, int wc, int fr, int fq) const {
        const int row0 = u.pm * BM + wr * 64 + fr, col0 = u.pn * BM + wc * 32 + 8 * fq;
        const bool rot = u.pn * BM < rot_cols; const float scl = (u.pn * BM >= kcol0) ? 0.0625f : 1.0f;
#pragma unroll
        for (int ai = 0; ai < 2; ++ai)
#pragma unroll
            for (int m = 0; m < 4; ++m) { const int row = row0 + ai * HALF + m * 16; bf16_t* rowp = O + (size_t)row * ldc + col0;
                const int p = row < 8192 ? (row & 4095) : (row < 8224 ? 4096 + ((row - 8192) & 3) : 0);
                const float* tb = TAB + ((size_t)p * 128 + ((col0 & 255) >> 1)) * 2;
#pragma unroll
                for (int bj = 0; bj < 2; ++bj) { f32x4 v0 = acc[ai][bj][m][0], v1 = acc[ai][bj][m][1];
                    if (rot) { const f32x4 c0 = *(const f32x4*)(tb + bj * HALF), c1 = *(const f32x4*)(tb + bj * HALF + 4);
                        v0 = (f32x4){(v0[0] * c0[0] - v0[1] * c0[1]) * scl, (v0[1] * c0[0] + v0[0] * c0[1]) * scl, (v0[2] * c0[2] - v0[3] * c0[3]) * scl, (v0[3] * c0[2] + v0[2] * c0[3]) * scl};
                        v1 = (f32x4){(v1[0] * c1[0] - v1[1] * c1[1]) * scl, (v1[1] * c1[0] + v1[0] * c1[1]) * scl, (v1[2] * c1[2] - v1[3] * c1[3]) * scl, (v1[3] * c1[2] + v1[2] * c1[3]) * scl}; }
                    u32x4 w; w.x = cvt_pk_bf16(v0[0], v0[1]); w.y = cvt_pk_bf16(v0[2], v0[3]); w.z = cvt_pk_bf16(v1[0], v1[1]); w.w = cvt_pk_bf16(v1[2], v1[3]);
                    *(u32x4*)(rowp + bj * HALF) = w; } }
    }
};
struct EpiResid {
    static constexpr bool PERM = false, AFTER_DRAIN = false;
    const float* __restrict__ X; float* __restrict__ Z; int ldc; float alpha;
    __device__ __forceinline__ void operator()(const f32x4 (&acc)[2][2][4][2], const Unit& u, int wr, int wc, int fr, int fq) const {
        const int row0 = u.pm * BM + wr * 64 + fr, col0 = u.pn * BM + wc * 32 + 4 * fq;
#pragma unroll
        for (int ai = 0; ai < 2; ++ai)
#pragma unroll
            for (int mp = 0; mp < 2; ++mp) { f32x4 xv[2][2][2];
#pragma unroll
                for (int mm = 0; mm < 2; ++mm) { const float* rowp = X + (size_t)(row0 + ai * HALF + (2 * mp + mm) * 16) * ldc + col0;
#pragma unroll
                    for (int bj = 0; bj < 2; ++bj)
#pragma unroll
                        for (int n = 0; n < 2; ++n) xv[mm][bj][n] = *(const f32x4*)(rowp + bj * HALF + n * 16); }
#pragma unroll
                for (int mm = 0; mm < 2; ++mm) { float* rowz = Z + (size_t)(row0 + ai * HALF + (2 * mp + mm) * 16) * ldc + col0;
#pragma unroll
                    for (int bj = 0; bj < 2; ++bj)
#pragma unroll
                        for (int n = 0; n < 2; ++n) *(f32x4*)(rowz + bj * HALF + n * 16) = xv[mm][bj][n] * alpha + acc[ai][bj][2 * mp + mm][n]; } }
    }
};
template <class Epi, class Sched, bool ALIGN_EPI = false, bool SP2 = false>
__device__ __forceinline__ void gemm_phase(PG8_LAS unsigned char* lds, const Gemm g, const Sched& S, const Epi& E) {
    int tid_ = threadIdx.x; asm volatile("" : "+v"(tid_));
    const int tid = tid_, wid = __builtin_amdgcn_readfirstlane(tid >> 6), lane = tid & 63, wr = wid >> 2, wc = wid & 3, fr = lane & 15, fq = lane >> 4;
    const int K = g.K, nt = K / BK;
    unsigned voffA[2], voffB[2];
#pragma unroll
    for (int i = 0; i < 2; ++i) { int R, C; stage_rc(tid * 16 + i * 8192, R, C); const int Rb = Epi::PERM ? ((R & ~31) + perm32(R & 31)) : R;
        voffA[i] = (unsigned)(R * K + C) * 2u; voffB[i] = (unsigned)(Rb * K + C) * 2u; }
    const size_t kstep = (size_t)(BK * 2);
    const size_t hstep = (size_t)HALF * K * 2;
    const size_t tstep = 2 * hstep;
    const unsigned ldsw = (unsigned)wid * 1024u;
    const int aoff = lds_byte(wr * 64 + fr, fq * 8), boff = lds_byte(wc * 32 + fr, fq * 8);
#define PG8_SA(b, h) (((b) * 2 + (h)) * HTB)
#define PG8_SB(b, h) ((4 + (b) * 2 + (h)) * HTB)
#define PG8_STAGE(bufoff, gbase, voff) do { _Pragma("unroll") for (int _i = 0; _i < 2; ++_i) \
        __builtin_amdgcn_global_load_lds((const unsigned*)((const char*)(gbase) + (voff)[_i]), (PG8_LAS unsigned*)(lds + (bufoff) + ldsw + _i * 8192), 16, 0, 0); } while (0)
#define PG8_LDA(dst, b, h) do { _Pragma("unroll") for (int m = 0; m < 4; ++m) _Pragma("unroll") for (int k = 0; k < 2; ++k) dst[m][k] = *(const PG8_LAS bf16x8*)(lds + PG8_SA(b, h) + aoff + m * 2048 + k * 1024); } while (0)
#define PG8_LDB(dst, b, h) do { _Pragma("unroll") for (int n = 0; n < 2; ++n) _Pragma("unroll") for (int k = 0; k < 2; ++k) dst[n][k] = *(const PG8_LAS bf16x8*)(lds + PG8_SB(b, h) + boff + n * 2048 + k * 1024); } while (0)
#define PG8_MMA(ai, bj, At, Bt) do { __builtin_amdgcn_s_setprio(1); _Pragma("unroll") for (int m = 0; m < 4; ++m) _Pragma("unroll") for (int n = 0; n < 2; ++n) _Pragma("unroll") for (int k = 0; k < 2; ++k) \
        acc[ai][bj][m][n] = __builtin_amdgcn_mfma_f32_16x16x32_bf16(Bt[n][k], At[m][k], acc[ai][bj][m][n], 0, 0, 0); __builtin_amdgcn_s_setprio(0); } while (0)
#define PG8_WAIT_V(n) asm volatile("s_waitcnt vmcnt(" #n ")" ::: "memory")
#define PG8_WAIT_L(n) asm volatile("s_waitcnt lgkmcnt(" #n ")" ::: "memory")
#define PG8_BAR __builtin_amdgcn_s_barrier()
#define PG8_SCHED __builtin_amdgcn_sched_barrier(0)
    Unit cur, nxt; int ui = 0;
    if (!S.next(0, cur)) return;
    f32x4 acc[2][2][4][2];
#pragma unroll
    for (int a = 0; a < 2; ++a)
#pragma unroll
        for (int b = 0; b < 2; ++b)
#pragma unroll
            for (int m = 0; m < 4; ++m)
#pragma unroll
                for (int n = 0; n < 2; ++n) acc[a][b][m][n] = (f32x4){0.f, 0.f, 0.f, 0.f};
    bf16x8 At[4][2], B0[2][2], B1[2][2];
    const char* cA = (const char*)g.A + (size_t)cur.pm * tstep; const char* cB = (const char*)g.Bt + (size_t)cur.pn * tstep;
    S.a_ready(cur);
    if constexpr (SP2) {
        PG8_STAGE(PG8_SB(0, 0), cB, voffB); PG8_STAGE(PG8_SB(0, 1), cB + hstep, voffB); PG8_STAGE(PG8_SA(0, 0), cA, voffA); PG8_STAGE(PG8_SA(0, 1), cA + hstep, voffA);
        if (wr == 1) PG8_BAR;
        PG8_WAIT_V(2); PG8_BAR;
        PG8_STAGE(PG8_SB(1, 0), cB + kstep, voffB); PG8_STAGE(PG8_SA(1, 0), cA + kstep, voffA); PG8_STAGE(PG8_SB(1, 1), cB + hstep + kstep, voffB);
        PG8_WAIT_V(6); PG8_BAR;
    } else {
        PG8_STAGE(PG8_SB(0, 0), cB, voffB); PG8_STAGE(PG8_SA(0, 0), cA, voffA); PG8_STAGE(PG8_SB(0, 1), cB + hstep, voffB); PG8_STAGE(PG8_SA(0, 1), cA + hstep, voffA);
        if (wr == 1) PG8_BAR;
        PG8_WAIT_V(4); PG8_BAR;
        PG8_STAGE(PG8_SB(1, 0), cB + kstep, voffB); PG8_STAGE(PG8_SA(1, 0), cA + kstep, voffA); PG8_STAGE(PG8_SB(1, 1), cB + hstep + kstep, voffB);
        PG8_WAIT_V(6); PG8_BAR;
    }
    for (;;) {
        const bool has_next = S.next(ui + 1, nxt);
        const char* nA = has_next ? (const char*)g.A + (size_t)nxt.pm * tstep : cA; const char* nB = has_next ? (const char*)g.Bt + (size_t)nxt.pn * tstep : cB;
        for (int t = 0; t < nt; t += 2) {
            const bool last = (t == nt - 2);
            const char* a1 = cA + (size_t)(t + 1) * kstep;
            const char* a2 = last ? nA : cA + (size_t)(t + 2) * kstep; const char* b2 = last ? nB : cB + (size_t)(t + 2) * kstep;
            const char* a3 = a2 + kstep; const char* b3 = b2 + kstep;
            if (last && has_next) S.a_ready(nxt);
            if constexpr (SP2) {
            PG8_LDB(B0, 0, 0); PG8_LDB(B1, 0, 1); PG8_SCHED; PG8_LDA(At, 0, 0); PG8_STAGE(PG8_SA(1, 1), a1 + hstep, voffA);
            PG8_WAIT_V(8); PG8_WAIT_L(0); PG8_BAR; PG8_MMA(0, 0, At, B0); PG8_MMA(0, 1, At, B1); PG8_BAR; PG8_SCHED;
            PG8_LDA(At, 0, 1); PG8_STAGE(PG8_SB(0, 0), b2, voffB); PG8_STAGE(PG8_SB(0, 1), b2 + hstep, voffB); PG8_STAGE(PG8_SA(0, 0), a2, voffA);
            PG8_WAIT_V(8); PG8_WAIT_L(0); PG8_BAR; PG8_MMA(1, 0, At, B0); PG8_MMA(1, 1, At, B1); PG8_BAR; PG8_SCHED;
            PG8_LDB(B0, 1, 0); PG8_LDB(B1, 1, 1); PG8_SCHED; PG8_LDA(At, 1, 0); PG8_STAGE(PG8_SA(0, 1), a2 + hstep, voffA);
            PG8_WAIT_V(8); PG8_WAIT_L(0); PG8_BAR; PG8_MMA(0, 0, At, B0); PG8_MMA(0, 1, At, B1); PG8_BAR; PG8_SCHED;
            PG8_LDA(At, 1, 1); PG8_STAGE(PG8_SB(1, 0), b3, voffB); PG8_STAGE(PG8_SB(1, 1), b3 + hstep, voffB); PG8_STAGE(PG8_SA(1, 0), a3, voffA);
            PG8_WAIT_V(8); PG8_WAIT_L(0); PG8_BAR; PG8_MMA(1, 0, At, B0); PG8_MMA(1, 1, At, B1); PG8_BAR; PG8_SCHED;
            } else {
            PG8_LDB(B0, 0, 0); PG8_SCHED; PG8_LDA(At, 0, 0); PG8_STAGE(PG8_SA(1, 1), a1 + hstep, voffA);
            PG8_WAIT_L(8); PG8_BAR; PG8_WAIT_L(0); PG8_MMA(0, 0, At, B0); PG8_BAR; PG8_SCHED;
            PG8_LDB(B1, 0, 1); PG8_STAGE(PG8_SB(0, 0), b2, voffB);
            PG8_BAR; PG8_WAIT_L(0); PG8_MMA(0, 1, At, B1); PG8_BAR;
            PG8_LDA(At, 0, 1); PG8_STAGE(PG8_SA(0, 0), a2, voffA);
            PG8_BAR; PG8_WAIT_L(0); PG8_MMA(1, 0, At, B0); PG8_BAR; PG8_SCHED;
            PG8_STAGE(PG8_SB(0, 1), b2 + hstep, voffB);
            PG8_WAIT_V(6); PG8_BAR; PG8_MMA(1, 1, At, B1); PG8_BAR;
            PG8_LDB(B0, 1, 0); PG8_SCHED; PG8_LDA(At, 1, 0); PG8_STAGE(PG8_SA(0, 1), a2 + hstep, voffA);
            PG8_WAIT_L(8); PG8_BAR; PG8_WAIT_L(0); PG8_MMA(0, 0, At, B0); PG8_BAR; PG8_SCHED;
            PG8_LDB(B1, 1, 1); PG8_STAGE(PG8_SB(1, 0), b3, voffB);
            PG8_BAR; PG8_WAIT_L(0); PG8_MMA(0, 1, At, B1); PG8_BAR;
            PG8_LDA(At, 1, 1); PG8_STAGE(PG8_SA(1, 0), a3, voffA);
            PG8_BAR; PG8_WAIT_L(0); PG8_MMA(1, 0, At, B0); PG8_BAR; PG8_SCHED;
            PG8_STAGE(PG8_SB(1, 1), b3 + hstep, voffB);
            PG8_WAIT_V(6); PG8_BAR; PG8_MMA(1, 1, At, B1); PG8_BAR;
            }
        }
        if constexpr (ALIGN_EPI) { if (wr == 0) PG8_BAR; }
        if constexpr (!Epi::AFTER_DRAIN) { for (int rpe_ = 0; rpe_ < REPE; ++rpe_) { E(acc, cur, wr, wc, fr, fq); asm volatile("" ::: "memory"); } S.done(cur); }
        if (!has_next) break;
#pragma unroll
        for (int a = 0; a < 2; ++a)
#pragma unroll
            for (int b = 0; b < 2; ++b)
#pragma unroll
                for (int m = 0; m < 4; ++m)
#pragma unroll
                    for (int n = 0; n < 2; ++n) acc[a][b][m][n] = (f32x4){0.f, 0.f, 0.f, 0.f};
        cur = nxt; cA = nA; cB = nB; ++ui;
        if constexpr (ALIGN_EPI) { if (wr == 1) PG8_BAR; }
    }
    PG8_WAIT_V(0);
    if constexpr (!ALIGN_EPI) { if (wr == 0) PG8_BAR; }
    PG8_BAR;
    if constexpr (Epi::AFTER_DRAIN) { E.fused(acc, cur, wr, wc, fr, fq, lds, wid, lane); S.done(cur); }
#undef PG8_SA
#undef PG8_SB
#undef PG8_STAGE
#undef PG8_LDA
#undef PG8_LDB
#undef PG8_MMA
#undef PG8_WAIT_V
#undef PG8_WAIT_L
#undef PG8_BAR
#undef PG8_SCHED
}
}
constexpr int DM = 2048, SEQ = 4096, TP = 8192, TS = 32, TT = TP + TS, MPAD = 8448;
constexpr int EVEN_IN = 6784, EVEN_INP = 6912, ODD_IN = 7168, LDH = 7168;
constexpr int EVEN_OUT = 1536, ODD_OUT = 2048;
constexpr float ALPHA = 1.6817928305074292f;
constexpr float LN_EPS = 1e-5f;
constexpr int EC_R = 0, EC_K = 768, EC_V = 1536, EC_HW = 2304, EC_HA = 2368, EC_GA = 2432, EC_QB = 3200, EC_KB = 3968, EC_VB = 4736, EC_GB = 5504, EC_QM = 5760, EC_GM = 6272;
constexpr int OC_Q = 0, OC_K = 1536, OC_V = 3072, OC_G = 4608, OC_QM = 6144, OC_GM = 6656;
constexpr size_t O_YP = 0, O_YS = 16777216, O_RWKV_P = O_YS + 65536, O_RWKV_S = O_RWKV_P + 196608, O_SH_P = O_RWKV_S + 786432, O_SH_S = O_SH_P + 9728,
    O_G0P = O_SH_S + 38912, O_G0S = O_G0P + 262144, O_G1P = O_G0S + 32768, O_G1S = O_G1P + 1048576, O_G2P = O_G1S + 32768, O_G2S = O_G2P + 4194304,
    O_RET_P = O_G2S + 32768, O_RET_S = O_RET_P + 1572864, O_MEM = O_RET_S + 6291456, O_END = O_MEM + 2097152;
constexpr size_t MiB = 1u << 20;
constexpr size_t WS_CTL = 0, WS_WTIN = 1 * MiB, WS_WTOUT = 29 * MiB, WS_WTMEM = 37 * MiB, WS_MEMB = 53 * MiB, WS_TAB = 55 * MiB, WS_XB = 60 * MiB, WS_XZ = 93 * MiB,
    WS_HB = 159 * MiB, WS_U = 275 * MiB, WS_YA = 308 * MiB, WS_PREP = 333 * MiB, WS_OG = 478 * MiB, WS_LSE = 478 * MiB + 49 * MiB / 2, WS_MKVB = 503 * MiB, WS_VT = 507 * MiB, WS_WTOUT2 = 509 * MiB, WS_END = 517 * MiB;
constexpr int LDS_BYTES = 147456, XB_LDS_OFF = LDS_BYTES - 64;

#define LAS __attribute__((address_space(3)))
typedef unsigned short bf16;
typedef float f32x4 __attribute__((ext_vector_type(4)));
typedef short bf16x8 __attribute__((ext_vector_type(8)));
typedef unsigned u32x4 __attribute__((ext_vector_type(4)));
typedef unsigned u32x2 __attribute__((ext_vector_type(2)));

__device__ const double ANG[128] = {
1.0, 0.9300449458481392, 0.8649836012976682, 0.8044736266284181, 0.7481966305138833, 0.6958564947100448, 0.6471778159406796, 0.6019044567806663, 0.5597981979123284, 0.5206374846632574, 0.48421626123015066, 0.45034288645458387, 0.41883912544574814, 0.3895392117442728, 0.362288975092429, 0.336945030221216, 0.31337402238589046, 0.29145192568009903, 0.2710633904364836, 0.2521011362799124, 0.23446538763970548, 0.21806334875063282, 0.20280871538024622, 0.18862122071335174, 0.17542621300415914, 0.1631542627737973, 0.15174079748634942, 0.14112576178114528, 0.13125330147352265, 0.12207146966133185, 0.11353195339077617, 0.10558981944335787, 0.09820327790631257, 0.09133346228248625, 0.08494422498263796, 0.07900194712408967, 0.07347536163492155, 0.06833538873292307, 0.06355498291362295, 0.059108990642279875, 0.05497401800103736, 0.05112830759482943, 0.04755162406834012, 0.04422514763163046, 0.04113137503418572, 0.03825402746632876, 0.03557796490339495, 0.03308910644196496, 0.030774356208980617, 0.02862153445389273, 0.026619313461261302, 0.024757157946593413, 0.023025269621793302, 0.02141453563853956, 0.019916480638308563, 0.018523222156741202, 0.017227429147699425, 0.01602228340877477, 0.014901443705277463, 0.013859012403933875, 0.01288950444072537, 0.01198781845958378, 0.011149209970080915, 0.01036926638287344, 0.009643883791544459, 0.008969245378672715, 0.008341801332506338, 0.007758250168566794, 0.007215521357901014, 0.006710759170575141, 0.006241307649397462, 0.00580469663480544, 0.005398628767382501, 0.005020967399614466, 0.004669725353279709, 0.0043430544633167095, 0.0040392358531509045, 0.003756670890311596, 0.0034938727747491297, 0.0032494587155918425, 0.0030221426551783792, 0.002810728502080728, 0.002614103837511492, 0.002431234061999789, 0.002261156951536743, 0.002102977594546134, 0.0019558636830395095, 0.0018190411331788228, 0.0016917900122028363, 0.0015734407502856099, 0.0014633706173946357, 0.0013610004466105522, 0.001265791586667203, 0.001177243067676929, 0.001094888965127687, 0.0010182959482819048, 0.0009470610000772239, 0.0008808092965317064, 0.0008191922344953685, 0.0007618855973704613, 0.0007085878491488872, 0.0006590185477903263, 0.0006129168695925734, 0.0005700402367896359, 0.0005301630411562774, 0.000493075456902875, 0.00045858233661428085, 0.00042650218442334204, 0.0003966662010161199, 0.00036891739544382435, 0.0003431097590679882, 0.0003191074972923552, 0.00029678431503900375, 0.0002760227522090274, 0.00025671356563109924, 0.00023875515424585844, 0.00022205302450155334, 0.00020651929314796272, 0.00019207222481239299, 0.0001786358019245737, 0.00016613932472747905, 0.0001545170392694147, 0.0001437077914199376, 0.00013365470508911156, 0.00012430488295695166, 0.00011560912813835741, 0.00010752168531898921, 0.0001};
__device__ const float LG2G[6] = {-0.04580368961312479f, -0.02272007650008353f, -0.011315313227834146f, -0.005646563141142063f, -0.0028205190623786626f, -0.0014095702546713536f};

__device__ __forceinline__ float bf2f(unsigned b) { return __uint_as_float(b << 16); }
typedef __bf16 bf16x2_t __attribute__((ext_vector_type(2)));
typedef float f32x2_t __attribute__((ext_vector_type(2)));
__device__ __forceinline__ unsigned f2bf(float f) { return (unsigned)__builtin_bit_cast(unsigned short, (__bf16)f); }
__device__ __forceinline__ unsigned pk2(float lo, float hi) { const f32x2_t v = {lo, hi}; return __builtin_bit_cast(unsigned, __builtin_convertvector(v, bf16x2_t)); }
__device__ __forceinline__ void unpk4(u32x2 w, float (&x)[4]) { x[0] = __uint_as_float(w.x << 16); x[1] = __uint_as_float(w.x & 0xffff0000u); x[2] = __uint_as_float(w.y << 16); x[3] = __uint_as_float(w.y & 0xffff0000u); }
__device__ __forceinline__ void unpk8(u32x4 w, float (&x)[8]) {
    x[0] = __uint_as_float(w.x << 16); x[1] = __uint_as_float(w.x & 0xffff0000u); x[2] = __uint_as_float(w.y << 16); x[3] = __uint_as_float(w.y & 0xffff0000u);
    x[4] = __uint_as_float(w.z << 16); x[5] = __uint_as_float(w.z & 0xffff0000u); x[6] = __uint_as_float(w.w << 16); x[7] = __uint_as_float(w.w & 0xffff0000u); }
template <int CTRL> __device__ __forceinline__ float dppf(float x) { return __builtin_bit_cast(float, __builtin_amdgcn_update_dpp(0, __builtin_bit_cast(int, x), CTRL, 0xF, 0xF, true)); }
__device__ __forceinline__ float red16(float x) { x += dppf<0xB1>(x); x += dppf<0x4E>(x); x += dppf<0x141>(x); x += dppf<0x140>(x); return x; }
__device__ __forceinline__ float wave_sum(float x) { x = red16(x); x += __shfl_xor(x, 16); x += __shfl_xor(x, 32); return x; }
__device__ __forceinline__ float sigmoidf_(float x) { return 1.0f / (1.0f + __expf(-x)); }
__device__ __forceinline__ float siluf_(float x) { return x / (1.0f + __expf(-x)); }
#define LDS_WAIT() asm volatile("s_waitcnt lgkmcnt(0)" ::: "memory")

struct Args { const float* in[27]; float* out; unsigned char* ws; int ph_lo, ph_hi; };
typedef const __attribute__((address_space(4))) Args* ArgsP;
struct Ctx {
    ArgsP ap;
    LAS unsigned char* lds;
    int tid, lane, wave, bid, G;
};
#define C_IN(k) (c.ap->in[k])
#define C_OUT (c.ap->out)
#define C_WTIN_L(l_) (((l_) & 1) ? (bf16*)(c.ap->out + O_YP) : (bf16*)(c.ap->ws + WS_WTIN))
#define C_WTOUT_L(l_) ((bf16*)(c.ap->ws + (((l_) & 1) ? WS_WTOUT2 : WS_WTOUT)))
#define C_WTMEM ((bf16*)(c.ap->ws + WS_WTMEM))
#define C_MEMB ((bf16*)(c.ap->ws + WS_MEMB))
#define C_XB ((bf16*)(c.ap->ws + WS_XB))
#define C_HB ((bf16*)(c.ap->ws + WS_HB))
#define C_U ((bf16*)(c.ap->ws + WS_U))
#define C_TAB ((float*)(c.ap->ws + WS_TAB))
#define C_XZ ((float*)(c.ap->ws + WS_XZ))
#define C_YA ((float*)(c.ap->ws + WS_YA))
#define C_PREP ((float*)(c.ap->ws + WS_PREP))
#define C_CHK ((unsigned char*)(c.ap->ws + WS_PREP))
#define C_PREPS ((float*)(c.ap->ws + WS_PREP + 120 * MiB))
#define C_BONUS ((float*)(c.ap->ws + WS_PREP + 125 * MiB))
#define C_WUT ((bf16*)(c.ap->ws + WS_PREP + 126 * MiB))
#define C_AUT ((bf16*)(c.ap->ws + WS_PREP + 126 * MiB) + 2 * 768 * 64)
constexpr int CHK_BYTES = 27136, CK_A = 0, CK_RQ = 9216, CK_GT = 13824, CK_YVT = 22528;
#define C_YR ((float*)(c.ap->ws + WS_PREP))
#define C_Z ((float*)(c.ap->ws + WS_HB))
#define C_OG ((float*)(c.ap->ws + WS_OG))
#define C_LSE ((float*)(c.ap->ws + WS_LSE))
#define C_MKVB ((bf16*)(c.ap->ws + WS_MKVB))
#define C_VT ((bf16*)(c.ap->ws + WS_VT))

__device__ __forceinline__ void transpose_item(const float* W, int K, int N, bf16* WT, int row_off, LAS float* scr, int item, int lane) {
    const int nblk = N / 32, kb = item / nblk, nb = item % nblk, k0 = 64 * kb, n0 = 32 * nb;
    f32x4 wv[8];
#pragma unroll
    for (int i = 0; i < 8; ++i) { const int kk = 8 * i + (lane >> 3), c4 = 4 * (lane & 7); wv[i] = *(const f32x4*)(W + (size_t)(k0 + kk) * N + n0 + c4); }
#pragma unroll
    for (int i = 0; i < 8; ++i) { const int kk = 8 * i + (lane >> 3), c4 = 4 * (lane & 7); const f32x4 w4 = wv[i];
        scr[kk * 33 + c4] = w4.x; scr[kk * 33 + c4 + 1] = w4.y; scr[kk * 33 + c4 + 2] = w4.z; scr[kk * 33 + c4 + 3] = w4.w; }
    LDS_WAIT(); asm volatile("" ::: "memory");
    const int c = lane & 7;
#pragma unroll
    for (int j = 0; j < 4; ++j) { const int n = (lane >> 3) + 8 * j; const LAS float* s = scr + (8 * c) * 33 + n;
        u32x4 o; o.x = pk2(s[0 * 33], s[1 * 33]); o.y = pk2(s[2 * 33], s[3 * 33]); o.z = pk2(s[4 * 33], s[5 * 33]); o.w = pk2(s[6 * 33], s[7 * 33]);
        *(u32x4*)(WT + (size_t)(row_off + n0 + n) * K + k0 + 8 * c) = o; }
    LDS_WAIT(); asm volatile("" ::: "memory");
}
__device__ __forceinline__ void transpose_matrix(const Ctx& c, const float* W, int K, int N, bf16* WT, int row_off) {
    LAS float* scr = (LAS float*)(c.lds + c.wave * 16384);
    const int gw = c.bid * 8 + c.wave, NGW = c.G * 8, nitems = (K / 64) * (N / 32);
    for (int it = gw; it < nitems; it += NGW) transpose_item(W, K, N, WT, row_off, scr, it, c.lane);
}
__device__ __forceinline__ void convert_layer_weights(const Ctx& c, int l) {
    if ((l & 1) == 0) { const int e = l >> 1;
        transpose_matrix(c, C_IN(10) + (size_t)e * DM * EVEN_IN, DM, EVEN_IN, C_WTIN_L(l), 0);
        transpose_matrix(c, C_IN(11) + (size_t)e * EVEN_OUT * DM, EVEN_OUT, DM, C_WTOUT_L(l), 0);
        const int n16 = (EVEN_INP - EVEN_IN) * DM * 2 / 16; u32x4* p = (u32x4*)(C_WTIN_L(l) + (size_t)EVEN_IN * DM);
        for (int i = c.bid * 512 + c.tid; i < n16; i += c.G * 512) p[i] = (u32x4){0u, 0u, 0u, 0u};
    } else { const int o = l >> 1;
        transpose_matrix(c, C_IN(12) + (size_t)o * DM * ODD_IN, DM, ODD_IN, C_WTIN_L(l), 0);
        transpose_matrix(c, C_IN(13) + (size_t)o * ODD_OUT * DM, ODD_OUT, DM, C_WTOUT_L(l), 0);
    }
}

__device__ __forceinline__ void phase_prologue(const Ctx& c) {
    for (int l = 0; l < 4; ++l) transpose_matrix(c, C_IN(14) + (size_t)l * DM * 1024, DM, 1024, C_WTMEM, l * 1024);
    convert_layer_weights(c, 0);
    const int gt = c.bid * 512 + c.tid, NT = c.G * 512;
    for (int i = gt; i < 2 * 768 * 64; i += NT) { const int e = i / (768 * 64), rem = i % (768 * 64), col = rem >> 6, k = rem & 63;
        C_WUT[i] = (bf16)f2bf(C_IN(19)[((size_t)e * 64 + k) * 768 + col]); C_AUT[i] = (bf16)f2bf(C_IN(21)[((size_t)e * 64 + k) * 768 + col]); }
    for (int i = gt; i < 512 * DM / 4; i += NT) { const f32x4 v = ((const f32x4*)C_IN(9))[i]; ((u32x2*)C_MEMB)[i] = (u32x2){pk2(v.x, v.y), pk2(v.z, v.w)}; }
    for (int i0 = gt; i0 < MPAD * DM / 4; i0 += 8 * NT) {
        f32x4 v[8];
#pragma unroll
        for (int k = 0; k < 8; ++k) { const int i = i0 + k * NT, row = i / (DM / 4); v[k] = (f32x4){0.f, 0.f, 0.f, 0.f};
            if (i < MPAD * DM / 4) { if (row < TP) v[k] = ((const f32x4*)C_IN(0))[i]; else if (row < TT) v[k] = ((const f32x4*)C_IN(1))[i - TP * (DM / 4)]; } }
#pragma unroll
        for (int k = 0; k < 8; ++k) { const int i = i0 + k * NT; if (i < MPAD * DM / 4) ((u32x2*)C_XB)[i] = (u32x2){pk2(v[k].x, v[k].y), pk2(v[k].z, v[k].w)}; }
    }
    for (int i = gt; i < 4100 * 128; i += NT) {
        const int p = i >> 7, ci = i & 127; const double pos = (double)(p < 4096 ? p : 16384 + (p - 4096));
        double ph = pos * ANG[ci];
        const double k = __builtin_rint(ph * 0.15915494309189535); ph = __builtin_fma(-k, 6.283185307179586, ph); ph = __builtin_fma(-k, 2.4492935982947064e-16, ph);
        const double q = __builtin_rint(ph * 0.6366197723675814); const double y = __builtin_fma(-q, 1.5707963267948966, ph) - q * 6.123233995736766e-17;
        const double y2 = y * y;
        const double sn = y * (1.0 + y2 * (-1.0 / 6 + y2 * (1.0 / 120 + y2 * (-1.0 / 5040 + y2 * (1.0 / 362880 + y2 * (-1.0 / 39916800 + y2 * (1.0 / 6227020800.0)))))));
        const double cs = 1.0 + y2 * (-0.5 + y2 * (1.0 / 24 + y2 * (-1.0 / 720 + y2 * (1.0 / 40320 + y2 * (-1.0 / 3628800 + y2 * (1.0 / 479001600.0 + y2 * (-1.0 / 87178291200.0)))))));
        const int qi = ((int)q) & 3; double co, si;
        if (qi == 0) { co = cs; si = sn; } else if (qi == 1) { co = -sn; si = cs; } else if (qi == 2) { co = -cs; si = -sn; } else { co = sn; si = -cs; }
        C_TAB[2 * i] = (float)co; C_TAB[2 * i + 1] = (float)si;
    }
}

__device__ __forceinline__ void rwkv_prep_item(const Ctx& c, int it, int e) {
    LAS float* lw = (LAS float*)c.lds;
    LAS float* la = lw + 16 * 64;
    const float* mu = C_IN(17) + e * 2432; const float* shift = C_IN(3) + (size_t)e * 8 * 2432;
    const int R0 = it * 16;
    for (int i = c.tid; i < 16 * 128; i += 512) {
        const int tk = i >> 7, cc = i & 127, R = R0 + tk; float val = 0.f;
        if (R < TT) { const int col = EC_HW + cc; const float hcur = bf2f(C_HB[(size_t)R * LDH + col]);
            float hprev;
            if (R < TP) hprev = ((R & (SEQ - 1)) == 0) ? 0.f : bf2f(C_HB[(size_t)(R - 1) * LDH + col]);
            else { const int n = (R - TP) >> 2, t = (R - TP) & 3; hprev = (t == 0) ? shift[n * 2432 + col] : bf2f(C_HB[(size_t)(R - 1) * LDH + col]); }
            const float hs = hcur + (hprev - hcur) * mu[col];
            val = (cc < 64) ? tanhf(hs) : hs; }
        if (cc < 64) lw[tk * 64 + cc] = val; else la[tk * 64 + (cc - 64)] = val;
    }
    __syncthreads();
    const int tl = c.tid & 255, tg = c.tid >> 8;
    const float* w_up = C_IN(19) + (size_t)e * 64 * 768; const float* a_up = C_IN(21) + (size_t)e * 64 * 768;
    const float* w0 = C_IN(18) + e * 768; const float* a0 = C_IN(20) + e * 768; const float* k_k = C_IN(22) + e * 768; const float* k_a = C_IN(23) + e * 768;
#pragma unroll 1
    for (int m = 0; m < 3; ++m) {
        const int col = tl + 256 * m, h = col >> 6, ci = col & 63;
        float xw[8], xa[8];
#pragma unroll
        for (int t = 0; t < 8; ++t) { xw[t] = 0.f; xa[t] = 0.f; }
#pragma unroll 4
        for (int kk = 0; kk < 64; ++kk) { const float wu = w_up[kk * 768 + col], au = a_up[kk * 768 + col];
#pragma unroll
            for (int t = 0; t < 8; ++t) { xw[t] += lw[(tg * 8 + t) * 64 + kk] * wu; xa[t] += la[(tg * 8 + t) * 64 + kk] * au; } }
        const float w0c = w0[col], a0c = a0[col], kkc = k_k[col], kac = k_a[col], mur = mu[EC_R + col], muk = mu[EC_K + col], muv = mu[EC_V + col];
#pragma unroll
        for (int t = 0; t < 8; ++t) {
            const int R = R0 + tg * 8 + t;
            if (R >= TT || R < TP) continue;
            const bf16* hc = C_HB + (size_t)R * LDH; float pr, pk, pv;
            const float cr = bf2f(hc[EC_R + col]), ck = bf2f(hc[EC_K + col]), cv = bf2f(hc[EC_V + col]);
            bool has_prev_row; int n = 0;
            if (R < TP) has_prev_row = (R & (SEQ - 1)) != 0; else { n = (R - TP) >> 2; has_prev_row = ((R - TP) & 3) != 0; }
            if (has_prev_row) { const bf16* hp = hc - LDH; pr = bf2f(hp[EC_R + col]); pk = bf2f(hp[EC_K + col]); pv = bf2f(hp[EC_V + col]); }
            else if (R < TP) { pr = 0.f; pk = 0.f; pv = 0.f; }
            else { const float* sp = shift + n * 2432; pr = sp[EC_R + col]; pk = sp[EC_K + col]; pv = sp[EC_V + col]; }
            const float r = cr + (pr - cr) * mur, k = ck + (pk - ck) * muk, v = cv + (pv - cv) * muv;
            const float decay = __expf(-0.6065306597126334f * sigmoidf_(w0c + xw[t]));
            const float a = sigmoidf_(a0c + xa[t]);
            float kk = k * kkc; const float ss = wave_sum(kk * kk); kk *= rsqrtf(fmaxf(ss, 1e-24f));
            const float k2 = k * (1.0f + (a - 1.0f) * kac);
            float* dst = C_PREPS + ((size_t)(R - TP) * 12 + h) * 384 + ci;
            dst[0] = r; dst[64] = decay; dst[128] = k2; dst[192] = v; dst[256] = -kk; dst[320] = kk * a;
        }
    }
    __syncthreads();
}

__device__ __forceinline__ void dil_attn_item(const Ctx& c, int R, int hh, int e) {
    const int lane = c.lane, kg = lane >> 4, dl = lane & 15;
    float m = -1e30f, l = 0.f, acc[4] = {0.f, 0.f, 0.f, 0.f};
    const bool is_p = R < TP; const int t = is_p ? (R & (SEQ - 1)) : ((R - TP) & 3); const int n = is_p ? 0 : ((R - TP) >> 2);
    const size_t rowbase = is_p ? (size_t)(R - t) : (size_t)(TP + n * 4);
#pragma unroll
    for (int g = 0; g < 3; ++g) {
        const int dil = (g == 0) ? 1 : (g == 1 ? 4 : 16), W = 128 * dil;
        float q[4]; { const u32x2 w = *(const u32x2*)(C_HB + (size_t)R * LDH + EC_QB + g * 256 + hh * 64 + 4 * dl); unpk4(w, q); }
#pragma unroll
        for (int i = 0; i < 4; ++i) q[i] *= 0.125f;
        const float* cache = ((g == 0) ? C_IN(4) : (g == 1 ? C_IN(5) : C_IN(6))) + ((size_t)(e * 8 + n) * W) * 512;
#pragma unroll 1
        for (int j0 = 0; j0 < 129; j0 += 4) {
            const int j = j0 + kg; bool valid = j < 129; float kf[4] = {0.f, 0.f, 0.f, 0.f}, vf[4] = {0.f, 0.f, 0.f, 0.f};
            if (is_p) { const int pos = t - dil * j; valid = valid && pos >= 0;
                if (valid) { const bf16* kp = C_HB + (rowbase + pos) * LDH + g * 256 + hh * 64 + 4 * dl; unpk4(*(const u32x2*)(kp + EC_KB), kf); unpk4(*(const u32x2*)(kp + EC_VB), vf); } }
            else if (valid) { const int idx = W + t - dil * j;
                if (idx >= W) { const bf16* kp = C_HB + (rowbase + (idx - W)) * LDH + g * 256 + hh * 64 + 4 * dl; unpk4(*(const u32x2*)(kp + EC_KB), kf); unpk4(*(const u32x2*)(kp + EC_VB), vf); }
                else { const float* kp = cache + (size_t)idx * 512 + hh * 64 + 4 * dl; const f32x4 k4 = *(const f32x4*)kp, v4 = *(const f32x4*)(kp + 256);
                    kf[0] = k4.x; kf[1] = k4.y; kf[2] = k4.z; kf[3] = k4.w; vf[0] = v4.x; vf[1] = v4.y; vf[2] = v4.z; vf[3] = v4.w; } }
            float s = q[0] * kf[0] + q[1] * kf[1] + q[2] * kf[2] + q[3] * kf[3];
            s = red16(s);
            if (valid) { const float mn = fmaxf(m, s), sc = __expf(m - mn), p = __expf(s - mn);
                l = l * sc + p;
#pragma unroll
                for (int i = 0; i < 4; ++i) acc[i] = acc[i] * sc + p * vf[i];
                m = mn; }
        }
    }
#pragma unroll
    for (int off = 16; off <= 32; off <<= 1) {
        const float m2 = __shfl_xor(m, off), l2 = __shfl_xor(l, off); float a2[4];
#pragma unroll
        for (int i = 0; i < 4; ++i) a2[i] = __shfl_xor(acc[i], off);
        const float mn = fmaxf(m, m2), s1 = __expf(m - mn), s2 = __expf(m2 - mn);
        l = l * s1 + l2 * s2;
#pragma unroll
        for (int i = 0; i < 4; ++i) acc[i] = acc[i] * s1 + a2[i] * s2;
        m = mn;
    }
    if (kg == 0) { float gt[4]; unpk4(*(const u32x2*)(C_HB + (size_t)R * LDH + EC_GB + hh * 64 + 4 * dl), gt);
        const float inv = 1.0f / l; float o[4];
#pragma unroll
        for (int i = 0; i < 4; ++i) o[i] = acc[i] * inv * siluf_(gt[i]);
        *(u32x2*)(C_U + (size_t)R * EVEN_OUT + 768 + hh * 64 + 4 * dl) = (u32x2){pk2(o[0], o[1]), pk2(o[2], o[3])}; }
}

__device__ __forceinline__ void mem_attn_item(const Ctx& c, int R, int mh, int l, int qcol, int gcol, int ucol, int ldu) {
    const int lane = c.lane, kg = lane >> 5, dl = lane & 31;
    const float* mkv;
    if (R < TP) mkv = C_OUT + O_MEM + ((size_t)l * 512 + (R >> 12) * 256) * 1024; else mkv = C_IN(8) + ((size_t)l * 8 + ((R - TP) >> 2)) * 256 * 1024;
    float q[4]; unpk4(*(const u32x2*)(C_HB + (size_t)R * LDH + qcol + mh * 128 + 4 * dl), q);
#pragma unroll
    for (int i = 0; i < 4; ++i) q[i] *= 0.08838834764831845f;
    float m = -1e30f, lsum = 0.f, acc[4] = {0.f, 0.f, 0.f, 0.f};
#pragma unroll 8
    for (int j0 = 0; j0 < 256; j0 += 2) {
        const float* kp = mkv + (size_t)(j0 + kg) * 1024 + mh * 128 + 4 * dl; const f32x4 k4 = *(const f32x4*)kp, v4 = *(const f32x4*)(kp + 512);
        float s = q[0] * k4.x + q[1] * k4.y + q[2] * k4.z + q[3] * k4.w;
        s = red16(s); s += __shfl_xor(s, 16);
        const float mn = fmaxf(m, s), sc = __expf(m - mn), p = __expf(s - mn);
        lsum = lsum * sc + p; acc[0] = acc[0] * sc + p * v4.x; acc[1] = acc[1] * sc + p * v4.y; acc[2] = acc[2] * sc + p * v4.z; acc[3] = acc[3] * sc + p * v4.w; m = mn;
    }
    { const float m2 = __shfl_xor(m, 32), l2 = __shfl_xor(lsum, 32); float a2[4];
#pragma unroll
        for (int i = 0; i < 4; ++i) a2[i] = __shfl_xor(acc[i], 32);
        const float mn = fmaxf(m, m2), s1 = __expf(m - mn), s2 = __expf(m2 - mn);
        lsum = lsum * s1 + l2 * s2;
#pragma unroll
        for (int i = 0; i < 4; ++i) acc[i] = acc[i] * s1 + a2[i] * s2; }
    if (kg == 0) { float gt[4]; unpk4(*(const u32x2*)(C_HB + (size_t)R * LDH + gcol + mh * 128 + 4 * dl), gt);
        const float inv = 1.0f / lsum; float o[4];
#pragma unroll
        for (int i = 0; i < 4; ++i) o[i] = acc[i] * inv * siluf_(gt[i]);
        *(u32x2*)(C_U + (size_t)R * ldu + ucol + mh * 128 + 4 * dl) = (u32x2){pk2(o[0], o[1]), pk2(o[2], o[3])}; }
}


typedef float f32x16 __attribute__((ext_vector_type(16)));
__device__ __forceinline__ f32x16 mfma32(bf16x8 a, bf16x8 b, f32x16 cacc) { return __builtin_amdgcn_mfma_f32_32x32x16_bf16(a, b, cacc, 0, 0, 0); }
__device__ __forceinline__ void mem_attn_mfma_item(const Ctx& c, int item, int l, int qcol, int gcol, int ucol, int ldu) {
    const int blk = item >> 2, mh = item & 3, R0 = blk * 32, b = R0 >> 12;
    const int lane = c.lane, r = lane & 31, hh = lane >> 5;
    const bf16* Kb = C_MKVB + ((size_t)l * 512 + b * 256) * 1024 + mh * 128 + 8 * hh;
    const bf16* Vt = C_VT + ((size_t)l * 512 + mh * 128) * 512 + b * 256 + 4 * hh;
    bf16x8 Qf[8];
    { const bf16* qp = C_HB + (size_t)(R0 + r) * LDH + qcol + mh * 128 + 8 * hh;
#pragma unroll
        for (int ks = 0; ks < 8; ++ks) Qf[ks] = *(const bf16x8*)(qp + 16 * ks); }
    f32x16 O[4];
#pragma unroll
    for (int dt = 0; dt < 4; ++dt)
#pragma unroll
        for (int i = 0; i < 16; ++i) O[dt][i] = 0.f;
    float m = -1e30f, lsum = 0.f;
    const float cs = 0.08838834764831845f * 1.4426950408889634f;
#pragma unroll 1
    for (int half = 0; half < 2; ++half) {
        f32x16 S[4];
#pragma unroll
        for (int kt = 0; kt < 4; ++kt) {
#pragma unroll
            for (int i = 0; i < 16; ++i) S[kt][i] = 0.f;
            const bf16* kp = Kb + (size_t)(128 * half + 32 * kt + r) * 1024;
#pragma unroll
            for (int ks = 0; ks < 8; ++ks) S[kt] = mfma32(*(const bf16x8*)(kp + 16 * ks), Qf[ks], S[kt]);
        }
        float mx = -1e30f;
#pragma unroll
        for (int kt = 0; kt < 4; ++kt)
#pragma unroll
            for (int i = 0; i < 16; ++i) mx = fmaxf(mx, S[kt][i]);
        mx = fmaxf(mx, __shfl_xor(mx, 32));
        const float mn = fmaxf(m, mx), sc = __builtin_amdgcn_exp2f((m - mn) * cs); m = mn;
        lsum *= sc;
#pragma unroll
        for (int dt = 0; dt < 4; ++dt)
#pragma unroll
            for (int i = 0; i < 16; ++i) O[dt][i] *= sc;
        float ps = 0.f;
#pragma unroll
        for (int kt = 0; kt < 4; ++kt)
#pragma unroll
            for (int i = 0; i < 16; ++i) { const float p = __builtin_amdgcn_exp2f((S[kt][i] - mn) * cs); S[kt][i] = p; ps += p; }
        lsum += ps;
#pragma unroll
        for (int kt = 0; kt < 4; ++kt)
#pragma unroll
            for (int s2 = 0; s2 < 2; ++s2) {
                const u32x4 pw = (u32x4){pk2(S[kt][8 * s2 + 0], S[kt][8 * s2 + 1]), pk2(S[kt][8 * s2 + 2], S[kt][8 * s2 + 3]), pk2(S[kt][8 * s2 + 4], S[kt][8 * s2 + 5]), pk2(S[kt][8 * s2 + 6], S[kt][8 * s2 + 7])};
                const bf16x8 Pf = __builtin_bit_cast(bf16x8, pw);
                const int kb = 128 * half + 32 * kt + 16 * s2;
#pragma unroll
                for (int dt = 0; dt < 4; ++dt) { const bf16* vp = Vt + (size_t)(32 * dt + r) * 512 + kb;
                    const u32x2 v0 = *(const u32x2*)vp, v1 = *(const u32x2*)(vp + 8); const u32x4 vw = (u32x4){v0.x, v0.y, v1.x, v1.y};
                    O[dt] = mfma32(__builtin_bit_cast(bf16x8, vw), Pf, O[dt]); }
            }
    }
    lsum += __shfl_xor(lsum, 32); const float inv = 1.0f / lsum;
    const bf16* gp = C_HB + (size_t)(R0 + r) * LDH + gcol + mh * 128 + 4 * hh; bf16* up = C_U + (size_t)(R0 + r) * ldu + ucol + mh * 128 + 4 * hh;
#pragma unroll
    for (int dt = 0; dt < 4; ++dt)
#pragma unroll
        for (int g4 = 0; g4 < 4; ++g4) { float gt[4]; unpk4(*(const u32x2*)(gp + 32 * dt + 8 * g4), gt);
            const float o0 = O[dt][4 * g4 + 0] * inv * siluf_(gt[0]), o1 = O[dt][4 * g4 + 1] * inv * siluf_(gt[1]), o2 = O[dt][4 * g4 + 2] * inv * siluf_(gt[2]), o3 = O[dt][4 * g4 + 3] * inv * siluf_(gt[3]);
            *(u32x2*)(up + 32 * dt + 8 * g4) = (u32x2){pk2(o0, o1), pk2(o2, o3)}; }
}
constexpr int MA_KS = 136, MA_VS = 260;
__device__ __forceinline__ void mem_attn_stage(const Ctx& c, int bb, int mh, int l) {
    LAS bf16* Kl = (LAS bf16*)c.lds; LAS bf16* Vl = Kl + 256 * MA_KS;
    const int tid = c.tid;
    const bf16* Kg = C_MKVB + ((size_t)l * 512 + bb * 256 + (tid >> 4)) * 1024 + mh * 128 + (tid & 15) * 8;
    const bf16* Vg = C_VT + ((size_t)l * 512 + mh * 128 + (tid >> 5)) * 512 + bb * 256 + (tid & 31) * 8;
    u32x4 kw[8], vw[8];
#pragma unroll
    for (int p = 0; p < 8; ++p) { kw[p] = *(const u32x4*)(Kg + (size_t)(32 * p) * 1024); vw[p] = *(const u32x4*)(Vg + (size_t)(16 * p) * 512); }
#pragma unroll
    for (int p = 0; p < 8; ++p) { *(LAS u32x4*)(Kl + ((tid >> 4) + 32 * p) * MA_KS + (tid & 15) * 8) = kw[p];
        LAS bf16* vd = Vl + ((tid >> 5) + 16 * p) * MA_VS + (tid & 31) * 8; *(LAS u32x2*)vd = (u32x2){vw[p].x, vw[p].y}; *(LAS u32x2*)(vd + 4) = (u32x2){vw[p].z, vw[p].w}; }
}
__device__ __forceinline__ void mem_attn_mfma_item_lds(const Ctx& c, int item, int qcol, int gcol, int ucol, int ldu) {
    const int blk = item >> 2, mh = item & 3, R0 = blk * 32;
    const int lane = c.lane, r = lane & 31, hh = lane >> 5;
    const LAS bf16* Kl = (const LAS bf16*)c.lds + r * MA_KS + 8 * hh; const LAS bf16* Vl = (const LAS bf16*)c.lds + 256 * MA_KS + r * MA_VS + 4 * hh;
    bf16x8 Qf[8];
    { const bf16* qp = C_HB + (size_t)(R0 + r) * LDH + qcol + mh * 128 + 8 * hh;
#pragma unroll
        for (int ks = 0; ks < 8; ++ks) Qf[ks] = *(const bf16x8*)(qp + 16 * ks); }
    f32x16 O[4];
#pragma unroll
    for (int dt = 0; dt < 4; ++dt)
#pragma unroll
        for (int i = 0; i < 16; ++i) O[dt][i] = 0.f;
    float m = -1e30f, lsum = 0.f;
    const float cs = 0.08838834764831845f * 1.4426950408889634f;
#pragma unroll 1
    for (int half = 0; half < 2; ++half) {
        f32x16 S[4];
#pragma unroll
        for (int kt = 0; kt < 4; ++kt) {
#pragma unroll
            for (int i = 0; i < 16; ++i) S[kt][i] = 0.f;
            bf16x8 Kf[8];
#pragma unroll
            for (int ks = 0; ks < 8; ++ks) Kf[ks] = *(const LAS bf16x8*)(Kl + (128 * half + 32 * kt) * MA_KS + 16 * ks);
#pragma unroll
            for (int ks = 0; ks < 8; ++ks) S[kt] = mfma32(Kf[ks], Qf[ks], S[kt]);
        }
        float mx = -1e30f;
#pragma unroll
        for (int kt = 0; kt < 4; ++kt)
#pragma unroll
            for (int i = 0; i < 16; ++i) mx = fmaxf(mx, S[kt][i]);
        mx = fmaxf(mx, __shfl_xor(mx, 32));
        const float mn = fmaxf(m, mx), sc = __builtin_amdgcn_exp2f((m - mn) * cs); m = mn;
        lsum *= sc;
#pragma unroll
        for (int dt = 0; dt < 4; ++dt)
#pragma unroll
            for (int i = 0; i < 16; ++i) O[dt][i] *= sc;
        float ps = 0.f;
#pragma unroll
        for (int kt = 0; kt < 4; ++kt)
#pragma unroll
            for (int i = 0; i < 16; ++i) { const float p = __builtin_amdgcn_exp2f((S[kt][i] - mn) * cs); S[kt][i] = p; ps += p; }
        lsum += ps;
#pragma unroll
        for (int kt = 0; kt < 4; ++kt)
#pragma unroll
            for (int s2 = 0; s2 < 2; ++s2) {
                const u32x4 pw = (u32x4){pk2(S[kt][8 * s2 + 0], S[kt][8 * s2 + 1]), pk2(S[kt][8 * s2 + 2], S[kt][8 * s2 + 3]), pk2(S[kt][8 * s2 + 4], S[kt][8 * s2 + 5]), pk2(S[kt][8 * s2 + 6], S[kt][8 * s2 + 7])};
                const bf16x8 Pf = __builtin_bit_cast(bf16x8, pw);
                const int kb = 128 * half + 32 * kt + 16 * s2;
                u32x2 va[4][2];
#pragma unroll
                for (int dt = 0; dt < 4; ++dt) { va[dt][0] = *(const LAS u32x2*)(Vl + (32 * dt) * MA_VS + kb); va[dt][1] = *(const LAS u32x2*)(Vl + (32 * dt) * MA_VS + kb + 8); }
#pragma unroll
                for (int dt = 0; dt < 4; ++dt) { const u32x4 vw = (u32x4){va[dt][0].x, va[dt][0].y, va[dt][1].x, va[dt][1].y};
                    O[dt] = mfma32(__builtin_bit_cast(bf16x8, vw), Pf, O[dt]); }
            }
    }
    lsum += __shfl_xor(lsum, 32); const float inv = 1.0f / lsum;
    const bf16* gp = C_HB + (size_t)(R0 + r) * LDH + gcol + mh * 128 + 4 * hh; bf16* up = C_U + (size_t)(R0 + r) * ldu + ucol + mh * 128 + 4 * hh;
#pragma unroll
    for (int dt = 0; dt < 4; ++dt) { u32x2 gw[4];
#pragma unroll
        for (int g4 = 0; g4 < 4; ++g4) gw[g4] = *(const u32x2*)(gp + 32 * dt + 8 * g4);
#pragma unroll
        for (int g4 = 0; g4 < 4; ++g4) { float gt[4]; unpk4(gw[g4], gt);
            const float o0 = O[dt][4 * g4 + 0] * inv * siluf_(gt[0]), o1 = O[dt][4 * g4 + 1] * inv * siluf_(gt[1]), o2 = O[dt][4 * g4 + 2] * inv * siluf_(gt[2]), o3 = O[dt][4 * g4 + 3] * inv * siluf_(gt[3]);
            *(u32x2*)(up + 32 * dt + 8 * g4) = (u32x2){pk2(o0, o1), pk2(o2, o3)}; } }
}
__device__ __forceinline__ void mem_attn_sample_block(const Ctx& c, int item, int l, int qcol, int gcol, int ucol, int ldu);
__device__ __forceinline__ void mem_attn_all(const Ctx& c, int l, int qcol, int gcol, int ucol, int ldu) {
    constexpr int NM = (TP / 32) * 4;
    { const int x = c.bid & 7, nbx = (c.G + 7 - x) >> 3, lb = c.bid >> 3, bb = x >> 2, mh = x & 3;
        if (lb * 8 < 128) {
            mem_attn_stage(c, bb, mh, l); __syncthreads();
            for (int r = lb * 8 + c.wave; r < 128; r += nbx * 8) mem_attn_mfma_item_lds(c, ((bb * 128 + r) << 2) | mh, qcol, gcol, ucol, ldu);
            __syncthreads(); } }
    for (int it = c.bid; it < TS * 4; it += c.G) mem_attn_sample_block(c, it, l, qcol, gcol, ucol, ldu);
}

typedef short s16x4 __attribute__((ext_vector_type(4)));
__device__ __forceinline__ f32x4 mfma16(bf16x8 a, bf16x8 b, f32x4 cacc) { return __builtin_amdgcn_mfma_f32_16x16x32_bf16(a, b, cacc, 0, 0, 0); }
__device__ __forceinline__ bf16x8 tr_frag(const LAS bf16* p, int rowstride4) {
    const s16x4 a0 = __builtin_amdgcn_ds_read_tr16_b64_v4i16((LAS s16x4*)p), a1 = __builtin_amdgcn_ds_read_tr16_b64_v4i16((LAS s16x4*)(p + rowstride4));
    return (bf16x8){a0[0], a0[1], a0[2], a0[3], a1[0], a1[1], a1[2], a1[3]};
}
__device__ __forceinline__ void dil_attn_mfma_item(const Ctx& c, int item) {
    const int bh = item / 48, rem = item % 48, b = bh >> 2, hh = bh & 3, g = rem >> 4, idx16 = rem & 15;
    const int dil = 1 << (2 * g), nub = 16 >> (2 * g), rho = idx16 / nub, ub = idx16 % nub;
    LAS bf16* Kl = (LAS bf16*)c.lds;
    LAS bf16* Vl = Kl + 384 * 72;
    const int tid = c.tid, lane = c.lane, wave = c.wave, r = lane & 31, hl = lane >> 5;
    const int ubase = ub * 256 - 128;
    const bf16* hb = C_HB + (size_t)b * SEQ * LDH + g * 256 + hh * 64;
    u32x4 kwv[6], vwv[6];
#pragma unroll
    for (int pass = 0; pass < 6; ++pass) { const int kl = pass * 64 + (tid >> 3), part = tid & 7; int up = ubase + kl; up = up < 0 ? 0 : up;
        const bf16* src = hb + (size_t)(rho + dil * up) * LDH + 8 * part;
        kwv[pass] = *(const u32x4*)(src + EC_KB); vwv[pass] = *(const u32x4*)(src + EC_VB); }
    const int u0 = ub * 256 + 32 * wave;
    bf16x8 Qf[4];
    { const bf16* qp = hb + (size_t)(rho + dil * (u0 + r)) * LDH + EC_QB + 8 * hl;
#pragma unroll
        for (int ks = 0; ks < 4; ++ks) Qf[ks] = *(const bf16x8*)(qp + 16 * ks); }
#pragma unroll
    for (int pass = 0; pass < 6; ++pass) { const int kl = pass * 64 + (tid >> 3), part = tid & 7; *(LAS u32x4*)(Kl + kl * 72 + 8 * part) = kwv[pass]; *(LAS u32x4*)(Vl + kl * 72 + 8 * part) = vwv[pass]; }
    __syncthreads();
    f32x16 S[5];
#pragma unroll
    for (int kt = 0; kt < 5; ++kt) {
#pragma unroll
        for (int i = 0; i < 16; ++i) S[kt][i] = 0.f;
        const LAS bf16* kp = Kl + (32 * wave + 32 * kt + r) * 72 + 8 * hl;
#pragma unroll
        for (int ks = 0; ks < 4; ++ks) S[kt] = mfma32(*(const LAS bf16x8*)(kp + 16 * ks), Qf[ks], S[kt]);
    }
    float mx = -1e30f;
#pragma unroll
    for (int kt = 0; kt < 5; ++kt)
#pragma unroll
        for (int i = 0; i < 16; ++i) { const int kl = 32 * kt + (i & 3) + 8 * (i >> 2) + 4 * hl;
            const bool valid = (kl >= r) && (kl - 128 <= r) && (u0 - 128 + kl >= 0);
            const float sv = valid ? S[kt][i] : -1e30f; S[kt][i] = sv; mx = fmaxf(mx, sv); }
    mx = fmaxf(mx, __shfl_xor(mx, 32));
    const float cs = 0.125f * 1.4426950408889634f;
    float lsum = 0.f;
#pragma unroll
    for (int kt = 0; kt < 5; ++kt)
#pragma unroll
        for (int i = 0; i < 16; ++i) { const float p = __builtin_amdgcn_exp2f((S[kt][i] - mx) * cs); S[kt][i] = p; lsum += p; }
    lsum += __shfl_xor(lsum, 32);
    f32x16 O[2];
#pragma unroll
    for (int dt = 0; dt < 2; ++dt)
#pragma unroll
        for (int i = 0; i < 16; ++i) O[dt][i] = 0.f;
    const LAS bf16* vbase = Vl + (32 * wave + 4 * hl + ((lane & 15) >> 2)) * 72 + 16 * ((lane >> 4) & 1) + 4 * (lane & 3);
#pragma unroll
    for (int kt = 0; kt < 5; ++kt)
#pragma unroll
        for (int s2 = 0; s2 < 2; ++s2) {
            const u32x4 pw = (u32x4){pk2(S[kt][8 * s2 + 0], S[kt][8 * s2 + 1]), pk2(S[kt][8 * s2 + 2], S[kt][8 * s2 + 3]), pk2(S[kt][8 * s2 + 4], S[kt][8 * s2 + 5]), pk2(S[kt][8 * s2 + 6], S[kt][8 * s2 + 7])};
            const bf16x8 Pf = __builtin_bit_cast(bf16x8, pw);
#pragma unroll
            for (int dt = 0; dt < 2; ++dt) { const LAS bf16* vp = vbase + (32 * kt + 16 * s2) * 72 + 32 * dt;
                const s16x4 a0 = __builtin_amdgcn_ds_read_tr16_b64_v4i16((LAS s16x4*)vp), a1 = __builtin_amdgcn_ds_read_tr16_b64_v4i16((LAS s16x4*)(vp + 8 * 72));
                const bf16x8 Af = (bf16x8){a0[0], a0[1], a0[2], a0[3], a1[0], a1[1], a1[2], a1[3]};
                O[dt] = mfma32(Af, Pf, O[dt]); }
        }
    const float inv = 1.0f / lsum; const size_t R = (size_t)b * SEQ + rho + dil * (u0 + r);
    float* og = C_OG + ((size_t)g * TT + R) * 256 + hh * 64 + 4 * hl;
#pragma unroll
    for (int dt = 0; dt < 2; ++dt)
#pragma unroll
        for (int g4 = 0; g4 < 4; ++g4) *(f32x4*)(og + 32 * dt + 8 * g4) = (f32x4){O[dt][4 * g4 + 0] * inv, O[dt][4 * g4 + 1] * inv, O[dt][4 * g4 + 2] * inv, O[dt][4 * g4 + 3] * inv};
    if (hl == 0) C_LSE[((size_t)g * TT + R) * 4 + hh] = mx * 0.125f + __logf(lsum);
    __syncthreads();
}
__device__ __forceinline__ void dil_attn_sample_item(const Ctx& c, int sr, int hh, int e) {
    const int lane = c.lane, kg = lane >> 4, dl = lane & 15, R = TP + sr, n = sr >> 2, t = sr & 3;
    float m = -1e30f, l = 0.f, acc[4] = {0.f, 0.f, 0.f, 0.f};
#pragma unroll
    for (int g = 0; g < 3; ++g) {
        const int dil = (g == 0) ? 1 : (g == 1 ? 4 : 16), W = 128 * dil, jn = t / dil;
        float q[4]; unpk4(*(const u32x2*)(C_HB + (size_t)R * LDH + EC_QB + g * 256 + hh * 64 + 4 * dl), q);
#pragma unroll
        for (int i = 0; i < 4; ++i) q[i] *= 0.125f;
        { const int j = kg; const bool valid = j <= jn; const int tt = valid ? t - dil * j : t;
            const bf16* kp = C_HB + (size_t)(TP + n * 4 + tt) * LDH + g * 256 + hh * 64 + 4 * dl; float kf[4], vf[4]; unpk4(*(const u32x2*)(kp + EC_KB), kf); unpk4(*(const u32x2*)(kp + EC_VB), vf);
            float s = red16(q[0] * kf[0] + q[1] * kf[1] + q[2] * kf[2] + q[3] * kf[3]);
            if (valid) { const float mn = fmaxf(m, s), sc = __expf(m - mn), p = __expf(s - mn); l = l * sc + p;
#pragma unroll
                for (int i = 0; i < 4; ++i) acc[i] = acc[i] * sc + p * vf[i];
                m = mn; } }
        const float* cache = ((g == 0) ? C_IN(4) : (g == 1 ? C_IN(5) : C_IN(6))) + ((size_t)(e * 8 + n) * W) * 512 + hh * 64 + 4 * dl;
#pragma unroll 11
        for (int j0 = 0; j0 < 132; j0 += 4) { const int j = j0 + kg; const bool valid = (j > jn) && (j <= 128); const int idx = valid ? W + t - dil * j : 0;
            const float* kp = cache + (size_t)idx * 512; const f32x4 k4 = *(const f32x4*)kp, v4 = *(const f32x4*)(kp + 256);
            const float s = red16(q[0] * k4.x + q[1] * k4.y + q[2] * k4.z + q[3] * k4.w);
            if (valid) { const float mn = fmaxf(m, s), sc = __expf(m - mn), p = __expf(s - mn); l = l * sc + p;
                acc[0] = acc[0] * sc + p * v4.x; acc[1] = acc[1] * sc + p * v4.y; acc[2] = acc[2] * sc + p * v4.z; acc[3] = acc[3] * sc + p * v4.w; m = mn; } }
    }
#pragma unroll
    for (int off = 16; off <= 32; off <<= 1) {
        const float m2 = __shfl_xor(m, off), l2 = __shfl_xor(l, off); float a2[4];
#pragma unroll
        for (int i = 0; i < 4; ++i) a2[i] = __shfl_xor(acc[i], off);
        const float mn = fmaxf(m, m2), s1 = __expf(m - mn), s2 = __expf(m2 - mn);
        l = l * s1 + l2 * s2;
#pragma unroll
        for (int i = 0; i < 4; ++i) acc[i] = acc[i] * s1 + a2[i] * s2;
        m = mn;
    }
    if (kg == 0) { float gt[4]; unpk4(*(const u32x2*)(C_HB + (size_t)R * LDH + EC_GB + hh * 64 + 4 * dl), gt);
        const float inv = 1.0f / l; float o[4];
#pragma unroll
        for (int i = 0; i < 4; ++i) o[i] = acc[i] * inv * siluf_(gt[i]);
        *(u32x2*)(C_U + (size_t)R * EVEN_OUT + 768 + hh * 64 + 4 * dl) = (u32x2){pk2(o[0], o[1]), pk2(o[2], o[3])}; }
}


__device__ __forceinline__ void mem_attn_sample_block(const Ctx& c, int item, int l, int qcol, int gcol, int ucol, int ldu) {
    const int sr = item >> 2, mh = item & 3, R = TP + sr, lane = c.lane, kg = lane >> 5, dl = lane & 31, wave = c.wave;
    const float* mkv = C_IN(8) + ((size_t)l * 8 + (sr >> 2)) * 256 * 1024 + mh * 128 + 4 * dl;
    float q[4]; unpk4(*(const u32x2*)(C_HB + (size_t)R * LDH + qcol + mh * 128 + 4 * dl), q);
#pragma unroll
    for (int i = 0; i < 4; ++i) q[i] *= 0.08838834764831845f;
    float m = -1e30f, lsum = 0.f, acc[4] = {0.f, 0.f, 0.f, 0.f};
    f32x4 kv[16], vv[16];
#pragma unroll
    for (int jr = 0; jr < 16; ++jr) { const float* kp = mkv + (size_t)(32 * wave + 2 * jr + kg) * 1024; kv[jr] = *(const f32x4*)kp; vv[jr] = *(const f32x4*)(kp + 512); }
#pragma unroll
    for (int jr = 0; jr < 16; ++jr) { const f32x4 k4 = kv[jr], v4 = vv[jr];
        float s = q[0] * k4.x + q[1] * k4.y + q[2] * k4.z + q[3] * k4.w;
        s = red16(s); s += __shfl_xor(s, 16);
        const float mn = fmaxf(m, s), sc = __expf(m - mn), p = __expf(s - mn);
        lsum = lsum * sc + p; acc[0] = acc[0] * sc + p * v4.x; acc[1] = acc[1] * sc + p * v4.y; acc[2] = acc[2] * sc + p * v4.z; acc[3] = acc[3] * sc + p * v4.w; m = mn; }
    { const float m2 = __shfl_xor(m, 32), l2 = __shfl_xor(lsum, 32); float a2[4];
#pragma unroll
        for (int i = 0; i < 4; ++i) a2[i] = __shfl_xor(acc[i], 32);
        const float mn = fmaxf(m, m2), s1 = __expf(m - mn), s2 = __expf(m2 - mn);
        lsum = lsum * s1 + l2 * s2; m = mn;
#pragma unroll
        for (int i = 0; i < 4; ++i) acc[i] = acc[i] * s1 + a2[i] * s2; }
    LAS float* part = (LAS float*)c.lds;
    if (kg == 0) { LAS float* pp = part + (wave * 32 + dl) * 6; pp[0] = m; pp[1] = lsum; pp[2] = acc[0]; pp[3] = acc[1]; pp[4] = acc[2]; pp[5] = acc[3]; }
    __syncthreads();
    if (wave == 0 && kg == 0) {
        float M = -1e30f, Lr = 0.f, A[4] = {0.f, 0.f, 0.f, 0.f};
#pragma unroll
        for (int w = 0; w < 8; ++w) { const LAS float* pp = part + (w * 32 + dl) * 6; const float m2 = pp[0], mn = fmaxf(M, m2), s1 = __expf(M - mn), s2 = __expf(m2 - mn);
            Lr = Lr * s1 + pp[1] * s2; A[0] = A[0] * s1 + pp[2] * s2; A[1] = A[1] * s1 + pp[3] * s2; A[2] = A[2] * s1 + pp[4] * s2; A[3] = A[3] * s1 + pp[5] * s2; M = mn; }
        float gt[4]; unpk4(*(const u32x2*)(C_HB + (size_t)R * LDH + gcol + mh * 128 + 4 * dl), gt);
        const float inv = 1.0f / Lr;
        *(u32x2*)(C_U + (size_t)R * ldu + ucol + mh * 128 + 4 * dl) = (u32x2){pk2(A[0] * inv * siluf_(gt[0]), A[1] * inv * siluf_(gt[1])), pk2(A[2] * inv * siluf_(gt[2]), A[3] * inv * siluf_(gt[3]))}; }
    __syncthreads();
}
__device__ __forceinline__ void dil_attn_sample_block(const Ctx& c, int item, int e) {
    const int sr = item >> 2, hh = item & 3, lane = c.lane, kg = lane >> 4, dl = lane & 15, wave = c.wave, R = TP + sr, n = sr >> 2, t = sr & 3;
    float m = -1e30f, l = 0.f, acc[4] = {0.f, 0.f, 0.f, 0.f};
#pragma unroll
    for (int g = 0; g < 3; ++g) {
        const int dil = (g == 0) ? 1 : (g == 1 ? 4 : 16), W = 128 * dil, jn = t / dil;
        float q[4]; unpk4(*(const u32x2*)(C_HB + (size_t)R * LDH + EC_QB + g * 256 + hh * 64 + 4 * dl), q);
#pragma unroll
        for (int i = 0; i < 4; ++i) q[i] *= 0.125f;
        if (wave == 0) { const int j = kg; const bool valid = j <= jn; const int tt = valid ? t - dil * j : t;
            const bf16* kp = C_HB + (size_t)(TP + n * 4 + tt) * LDH + g * 256 + hh * 64 + 4 * dl; float kf[4], vf[4]; unpk4(*(const u32x2*)(kp + EC_KB), kf); unpk4(*(const u32x2*)(kp + EC_VB), vf);
            float s = red16(q[0] * kf[0] + q[1] * kf[1] + q[2] * kf[2] + q[3] * kf[3]);
            if (valid) { const float mn = fmaxf(m, s), sc = __expf(m - mn), p = __expf(s - mn); l = l * sc + p;
#pragma unroll
                for (int i = 0; i < 4; ++i) acc[i] = acc[i] * sc + p * vf[i];
                m = mn; } }
        const float* cache = ((g == 0) ? C_IN(4) : (g == 1 ? C_IN(5) : C_IN(6))) + ((size_t)(e * 8 + n) * W) * 512 + hh * 64 + 4 * dl;
        f32x4 kv[5], vv[5]; bool ok[5];
#pragma unroll
        for (int jr = 0; jr < 5; ++jr) { const int jo = 4 * jr + kg, j = 17 * wave + jo; ok[jr] = (jo < 17) && (j > jn) && (j <= 128); const int idx = ok[jr] ? W + t - dil * j : 0;
            const float* kp = cache + (size_t)idx * 512; kv[jr] = *(const f32x4*)kp; vv[jr] = *(const f32x4*)(kp + 256); }
#pragma unroll
        for (int jr = 0; jr < 5; ++jr) { const f32x4 k4 = kv[jr], v4 = vv[jr];
            const float s = red16(q[0] * k4.x + q[1] * k4.y + q[2] * k4.z + q[3] * k4.w);
            if (ok[jr]) { const float mn = fmaxf(m, s), sc = __expf(m - mn), p = __expf(s - mn); l = l * sc + p;
                acc[0] = acc[0] * sc + p * v4.x; acc[1] = acc[1] * sc + p * v4.y; acc[2] = acc[2] * sc + p * v4.z; acc[3] = acc[3] * sc + p * v4.w; m = mn; } }
    }
#pragma unroll
    for (int off = 16; off <= 32; off <<= 1) {
        const float m2 = __shfl_xor(m, off), l2 = __shfl_xor(l, off); float a2[4];
#pragma unroll
        for (int i = 0; i < 4; ++i) a2[i] = __shfl_xor(acc[i], off);
        const float mn = fmaxf(m, m2), s1 = __expf(m - mn), s2 = __expf(m2 - mn);
        l = l * s1 + l2 * s2;
#pragma unroll
        for (int i = 0; i < 4; ++i) acc[i] = acc[i] * s1 + a2[i] * s2;
        m = mn;
    }
    LAS float* part = (LAS float*)c.lds;
    if (kg == 0) { LAS float* pp = part + (wave * 16 + dl) * 6; pp[0] = m; pp[1] = l; pp[2] = acc[0]; pp[3] = acc[1]; pp[4] = acc[2]; pp[5] = acc[3]; }
    __syncthreads();
    if (wave == 0 && kg == 0) {
        float M = -1e30f, Lr = 0.f, A[4] = {0.f, 0.f, 0.f, 0.f};
#pragma unroll
        for (int w = 0; w < 8; ++w) { const LAS float* pp = part + (w * 16 + dl) * 6; const float m2 = pp[0], mn = fmaxf(M, m2), s1 = __expf(M - mn), s2 = __expf(m2 - mn);
            Lr = Lr * s1 + pp[1] * s2; A[0] = A[0] * s1 + pp[2] * s2; A[1] = A[1] * s1 + pp[3] * s2; A[2] = A[2] * s1 + pp[4] * s2; A[3] = A[3] * s1 + pp[5] * s2; M = mn; }
        float gt[4]; unpk4(*(const u32x2*)(C_HB + (size_t)R * LDH + EC_GB + hh * 64 + 4 * dl), gt);
        const float inv = 1.0f / Lr;
        *(u32x2*)(C_U + (size_t)R * EVEN_OUT + 768 + hh * 64 + 4 * dl) = (u32x2){pk2(A[0] * inv * siluf_(gt[0]), A[1] * inv * siluf_(gt[1])), pk2(A[2] * inv * siluf_(gt[2]), A[3] * inv * siluf_(gt[3]))}; }
    __syncthreads();
}

__device__ __forceinline__ void even_copies(const Ctx& c, int e) {
    const int gt = c.bid * 512 + c.tid, NT = c.G * 512;
    for (int i = gt; i < 10 * 304; i += NT) { const int rw = i / 304, c8 = 8 * (i % 304);
        const size_t src = (rw < 2) ? (size_t)(rw * SEQ + SEQ - 1) : (size_t)(TP + (rw - 2) * 4 + 3);
        float x[8]; unpk8(*(const u32x4*)(C_HB + src * LDH + c8), x);
        float* dst = (rw < 2) ? C_OUT + O_SH_P + ((size_t)e * 2 + rw) * 2432 + c8 : C_OUT + O_SH_S + ((size_t)e * 8 + (rw - 2)) * 2432 + c8;
        *(f32x4*)dst = (f32x4){x[0], x[1], x[2], x[3]}; *(f32x4*)(dst + 4) = (f32x4){x[4], x[5], x[6], x[7]}; }
#pragma unroll 1
    for (int g = 0; g < 3; ++g) {
        const int keep = 128 << (2 * g); const size_t op = (g == 0) ? O_G0P : (g == 1 ? O_G1P : O_G2P), os = (g == 0) ? O_G0S : (g == 1 ? O_G1S : O_G2S);
        for (int i0 = gt; i0 < 2 * keep * 64; i0 += 4 * NT) { u32x4 w[4];
#pragma unroll
            for (int k = 0; k < 4; ++k) { const int i = (i0 + k * NT < 2 * keep * 64) ? i0 + k * NT : i0; const int pc = i & 63, r = (i >> 6) % keep, b = (i >> 6) / keep;
                const int col = ((pc & 32) ? EC_VB : EC_KB) + g * 256 + 8 * (pc & 31); w[k] = *(const u32x4*)(C_HB + (size_t)(b * SEQ + SEQ - keep + r) * LDH + col); }
#pragma unroll
            for (int k = 0; k < 4; ++k) { const int i = i0 + k * NT; if (i < 2 * keep * 64) { const int pc = i & 63, r = (i >> 6) % keep, b = (i >> 6) / keep;
                float x[8]; unpk8(w[k], x); float* dst = C_OUT + op + ((size_t)e * 2 * keep + (size_t)b * keep + r) * 512 + 8 * pc;
                *(f32x4*)dst = (f32x4){x[0], x[1], x[2], x[3]}; *(f32x4*)(dst + 4) = (f32x4){x[4], x[5], x[6], x[7]}; } } }
        for (int i = gt; i < 8 * 4 * 64; i += NT) { const int pc = i & 63, row = i >> 6;
            const int col = ((pc & 32) ? EC_VB : EC_KB) + g * 256 + 8 * (pc & 31);
            float x[8]; unpk8(*(const u32x4*)(C_HB + (size_t)(TP + row) * LDH + col), x);
            float* dst = C_OUT + os + ((size_t)e * 32 + row) * 512 + 8 * pc;
            *(f32x4*)dst = (f32x4){x[0], x[1], x[2], x[3]}; *(f32x4*)(dst + 4) = (f32x4){x[4], x[5], x[6], x[7]}; }
    }
}

#define LAUNDER_C(c) do { asm volatile("" : "+s"((c).ap), "+v"((c).tid), "+s"((c).bid), "+s"((c).G)); (c).lane = (c).tid & 63; (c).wave = __builtin_amdgcn_readfirstlane((c).tid >> 6); } while (0)
__device__ __forceinline__ void phase_even_tok_pre(Ctx c, int l);
__device__ __forceinline__ void even_helper_work(Ctx c, int l) {
    const int e = l >> 1;
    for (int rp = 0; rp < REPD; ++rp) { for (int it = c.bid; it < 384; it += c.G) dil_attn_mfma_item(c, it);
    LAUNDER_C(c); }
    for (int it = c.G - 1 - c.bid; it < TS * 4; it += c.G) dil_attn_sample_block(c, it, e);
    LAUNDER_C(c);
    for (int rp = 0; rp < REPM; ++rp) { mem_attn_all(c, l, EC_QM, EC_GM, 1024, EVEN_OUT);
    LAUNDER_C(c); }
    even_copies(c, e);
    LAUNDER_C(c);
    for (int rp = 0; rp < REPC; ++rp) { if (l < 3) convert_layer_weights(c, l + 1); LAUNDER_C(c); }
}

__device__ __forceinline__ void rwkv_scan_item(const Ctx& c, int item, int e) {
    constexpr int CH = 32;
    LAS float* buf = (LAS float*)c.lds;
    LAS float* ybuf = buf + 2 * CH * 384;
    const bool is_p = item < 48; const int st = is_p ? (item >> 1) : ((item - 48) >> 1), half = item & 1;
    const int h = st % 12, bn = st / 12; const int T = is_p ? SEQ : 4; const size_t tok0 = is_p ? (size_t)bn * SEQ : (size_t)(TP + bn * 4);
    const int lane = c.lane, rw = lane >> 4, cgp = lane & 15, il = 4 * c.wave + rw, i = 32 * half + il;
    float s[4];
    if (is_p) { s[0] = s[1] = s[2] = s[3] = 0.f; }
    else { const f32x4 v = *(const f32x4*)(C_IN(2) + ((((size_t)e * 8 + bn) * 12 + h) * 64 + i) * 64 + 4 * cgp); s[0] = v.x; s[1] = v.y; s[2] = v.z; s[3] = v.w; }
    const int nch = (T + CH - 1) / CH;
    f32x4 pre[6];
#define SCAN_GLOAD(ch_) do { _Pragma("unroll") for (int k = 0; k < 6; ++k) { const int idx = c.tid + 512 * k, tl_ = idx / 96, f4 = idx % 96; const int tk = (ch_) * CH + tl_; \
            pre[k] = (tk < T) ? *(const f32x4*)(C_PREPS + ((tok0 - TP + tk) * 12 + h) * 384 + 4 * f4) : (f32x4){0.f, 0.f, 0.f, 0.f}; } } while (0)
#define SCAN_LSTORE(bi_) do { _Pragma("unroll") for (int k = 0; k < 6; ++k) { const int idx = c.tid + 512 * k; *(LAS f32x4*)(buf + (bi_) * CH * 384 + 4 * idx) = pre[k]; } } while (0)
    SCAN_GLOAD(0); SCAN_LSTORE(0); __syncthreads();
#pragma unroll 1
    for (int ch = 0; ch < nch; ++ch) {
        if (ch + 1 < nch) SCAN_GLOAD(ch + 1);
        const LAS float* bb = buf + (ch & 1) * CH * 384;
        const int nt = (T - ch * CH) < CH ? (T - ch * CH) : CH;
#pragma unroll 2
        for (int tl = 0; tl < nt; ++tl) {
            const LAS float* p = bb + tl * 384;
            const f32x4 r4 = *(const LAS f32x4*)(p + 4 * cgp), d4 = *(const LAS f32x4*)(p + 64 + 4 * cgp), k4 = *(const LAS f32x4*)(p + 128 + 4 * cgp),
                        kk4 = *(const LAS f32x4*)(p + 256 + 4 * cgp), b4 = *(const LAS f32x4*)(p + 320 + 4 * cgp);
            const float vi = p[192 + i];
            float sa = s[0] * kk4.x + s[1] * kk4.y + s[2] * kk4.z + s[3] * kk4.w;
            sa = red16(sa);
            s[0] = s[0] * d4.x + (sa * b4.x + vi * k4.x); s[1] = s[1] * d4.y + (sa * b4.y + vi * k4.y);
            s[2] = s[2] * d4.z + (sa * b4.z + vi * k4.z); s[3] = s[3] * d4.w + (sa * b4.w + vi * k4.w);
            float y = s[0] * r4.x + s[1] * r4.y + s[2] * r4.z + s[3] * r4.w;
            y = red16(y);
            if (cgp == 0) ybuf[tl * 32 + il] = y;
        }
        __syncthreads();
        if (ch + 1 < nch) SCAN_LSTORE((ch + 1) & 1);
        for (int idx = c.tid; idx < nt * 32; idx += 512) { const int tl = idx >> 5, r = idx & 31; C_YA[(tok0 + ch * CH + tl) * 768 + h * 64 + 32 * half + r] = ybuf[idx]; }
        __syncthreads();
    }
    float* so = C_OUT + (is_p ? O_RWKV_P + (((size_t)e * 2 + bn) * 12 + h) * 4096 : O_RWKV_S + (((size_t)e * 8 + bn) * 12 + h) * 4096) + (size_t)i * 64 + 4 * cgp;
    *(f32x4*)so = (f32x4){s[0], s[1], s[2], s[3]};
}

typedef float f32x2 __attribute__((ext_vector_type(2)));
__device__ __forceinline__ void rwkv_scan_prompt(const Ctx& c, int item, int e) {
    constexpr int CH = 32, NCH = SEQ / CH;
    LAS float* buf = (LAS float*)c.lds;
    LAS float* ybuf = buf + 2 * CH * 384;
    const int st = item >> 1, half = item & 1, h = st % 12, bn = st / 12; const size_t tok0 = (size_t)bn * SEQ;
    const int lane = c.lane, rw = lane >> 4, cgp = lane & 15, il = 4 * c.wave + rw, i = 32 * half + il;
    f32x2 s01 = (f32x2){0.f, 0.f}, s23 = (f32x2){0.f, 0.f};
    const float* src = C_PREP + (tok0 * 12 + h) * 384;
    float* ya = C_YA + tok0 * 768 + h * 64 + 32 * half;
    f32x4 pre[6];
#define SP_GLOAD(ch_) do { _Pragma("unroll") for (int k = 0; k < 6; ++k) { const int idx = c.tid + 512 * k, tl_ = idx / 96, f4 = idx % 96; \
        pre[k] = *(const f32x4*)(src + (size_t)((ch_) * CH + tl_) * (12 * 384) + 4 * f4); } } while (0)
#define SP_LSTORE(bi_) do { _Pragma("unroll") for (int k = 0; k < 6; ++k) { const int idx = c.tid + 512 * k; *(LAS f32x4*)(buf + (bi_) * CH * 384 + 4 * idx) = pre[k]; } } while (0)
#define SP_YOUT(ch_) do { for (int idx = c.tid; idx < CH * 32; idx += 512) { const int tl_ = idx >> 5, r_ = idx & 31; ya[(size_t)((ch_) * CH + tl_) * 768 + r_] = ybuf[((ch_) & 1) * CH * 32 + idx]; } } while (0)
    SP_GLOAD(0); SP_LSTORE(0); SP_GLOAD(1); __syncthreads();
#pragma unroll 1
    for (int ch = 0; ch < NCH; ++ch) {
        if (ch + 1 < NCH) SP_LSTORE((ch + 1) & 1);
        if (ch + 2 < NCH) SP_GLOAD(ch + 2);
        if (ch > 0) SP_YOUT(ch - 1);
        const LAS float* bb = buf + (ch & 1) * CH * 384 + 4 * cgp; const LAS float* vb = buf + (ch & 1) * CH * 384 + 192 + i;
        LAS float* yw = (cgp == 0) ? (ybuf + (ch & 1) * CH * 32 + il) : (ybuf + 2 * CH * 32 + lane);
        f32x4 r4 = *(const LAS f32x4*)bb, d4 = *(const LAS f32x4*)(bb + 64), k4 = *(const LAS f32x4*)(bb + 128), n4 = *(const LAS f32x4*)(bb + 256), b4 = *(const LAS f32x4*)(bb + 320); float vi = vb[0];
        float sa;
        { f32x2 p = s01 * (f32x2){n4.x, n4.y}; p = s23 * (f32x2){n4.z, n4.w} + p; sa = red16(p.x + p.y); }
#pragma unroll 4
        for (int tl = 0; tl < CH; ++tl) {
            const int tn = (tl + 1 < CH) ? tl + 1 : tl;
            const f32x4 r4n = *(const LAS f32x4*)(bb + tn * 384), d4n = *(const LAS f32x4*)(bb + tn * 384 + 64), k4n = *(const LAS f32x4*)(bb + tn * 384 + 128),
                        n4n = *(const LAS f32x4*)(bb + tn * 384 + 256), b4n = *(const LAS f32x4*)(bb + tn * 384 + 320); const float vin = vb[tn * 384];
            const f32x2 vi2 = (f32x2){vi, vi}, sa2 = (f32x2){sa, sa};
            const f32x2 u01 = s01 * (f32x2){d4.x, d4.y} + vi2 * (f32x2){k4.x, k4.y}, u23 = s23 * (f32x2){d4.z, d4.w} + vi2 * (f32x2){k4.z, k4.w};
            s01 = sa2 * (f32x2){b4.x, b4.y} + u01; s23 = sa2 * (f32x2){b4.z, b4.w} + u23;
            f32x2 yp = s01 * (f32x2){r4.x, r4.y}; yp = s23 * (f32x2){r4.z, r4.w} + yp;
            f32x2 pn = s01 * (f32x2){n4n.x, n4n.y}; pn = s23 * (f32x2){n4n.z, n4n.w} + pn;
            float ya_ = yp.x + yp.y, sb_ = pn.x + pn.y;
            sb_ += dppf<0xB1>(sb_); ya_ += dppf<0xB1>(ya_); sb_ += dppf<0x4E>(sb_); ya_ += dppf<0x4E>(ya_);
            sb_ += dppf<0x141>(sb_); ya_ += dppf<0x141>(ya_); sb_ += dppf<0x140>(sb_); ya_ += dppf<0x140>(ya_);
            sa = sb_;
            yw[tl * 32] = ya_;
            r4 = r4n; d4 = d4n; k4 = k4n; n4 = n4n; b4 = b4n; vi = vin;
        }
        __syncthreads();
    }
    SP_YOUT(NCH - 1);
    float* so = C_OUT + O_RWKV_P + (((size_t)e * 2 + bn) * 12 + h) * 4096 + (size_t)i * 64 + 4 * cgp;
    *(f32x4*)so = (f32x4){s01.x, s01.y, s23.x, s23.y};
    __syncthreads();
#undef SP_GLOAD
#undef SP_LSTORE
#undef SP_YOUT
}

struct PreIn { u32x2 cr, ck, cv, pr, pk, pv; float hcur[8], hprv[8]; };
__device__ __forceinline__ void rwkv_chunk_preload(const Ctx& c, int item, int e, PreIn& P) {
    const bool is_s = item >= 3072; const int sidx = item - 3072;
    const int bh = item >> 7, n = is_s ? 1 : (item & 127), b = bh / 12, h = is_s ? (sidx % 12) : (bh % 12), ns = sidx / 12;
    const size_t R0 = is_s ? (size_t)(TP + 4 * ns) : (size_t)b * SEQ + 32 * n;
    const float* shift = C_IN(3) + ((size_t)e * 8 + ns) * 2432;
    const int tid = c.tid, t_ = tid >> 4, c4 = 4 * (tid & 15), col = h * 64 + c4;
    const bf16* hc = C_HB + (R0 + t_) * LDH + col; const bool hasprev = is_s ? (t_ != 0) : ((32 * n + t_) != 0);
    const u32x2 z2 = (u32x2){0u, 0u};
    P.cr = *(const u32x2*)(hc + EC_R); P.ck = *(const u32x2*)(hc + EC_K); P.cv = *(const u32x2*)(hc + EC_V);
    P.pr = hasprev ? *(const u32x2*)(hc - LDH + EC_R) : z2; P.pk = hasprev ? *(const u32x2*)(hc - LDH + EC_K) : z2; P.pv = hasprev ? *(const u32x2*)(hc - LDH + EC_V) : z2;
    const int cc = tid & 127, cl = EC_HW + cc, tb = tid >> 7;
#pragma unroll
    for (int k = 0; k < 8; ++k) { const int t = tb + 4 * k; P.hcur[k] = bf2f(C_HB[(R0 + t) * LDH + cl]);
        P.hprv[k] = is_s ? (t != 0 ? bf2f(C_HB[(R0 + t - 1) * LDH + cl]) : shift[cl]) : (((32 * n + t) != 0) ? bf2f(C_HB[(R0 + t - 1) * LDH + cl]) : 0.f); }
}
__device__ __forceinline__ void rwkv_chunk_precompute(const Ctx& c, int item, int e, const PreIn& P) {
    const bool is_s = item >= 3072; const int sidx = item - 3072;
    const int bh = item >> 7, n = is_s ? 1 : (item & 127), b = bh / 12, h = is_s ? (sidx % 12) : (bh % 12), ns = sidx / 12, ntok = is_s ? 4 : 32;
    const size_t R0 = is_s ? (size_t)(TP + 4 * ns) : (size_t)b * SEQ + 32 * n;
    const float* shift = C_IN(3) + ((size_t)e * 8 + ns) * 2432;
    LAS unsigned char* L = c.lds;
    LAS float* XW = (LAS float*)(L + 0); LAS float* XA = (LAS float*)(L + 8192);
    LAS bf16* LW = (LAS bf16*)(L + 16384); LAS bf16* LA = (LAS bf16*)(L + 20992);
    LAS float* PS = (LAS float*)(L + 25600);
    LAS bf16* KKt = (LAS bf16*)(L + 33792); LAS bf16* Bt = (LAS bf16*)(L + 38400); LAS bf16* Kt = (LAS bf16*)(L + 43008); LAS bf16* Rt = (LAS bf16*)(L + 47616);
    LAS bf16* Bh = (LAS bf16*)(L + 52224); LAS bf16* Kh = (LAS bf16*)(L + 56832); LAS bf16* Vb = (LAS bf16*)(L + 61440);
    LAS float* LB = (LAS float*)(L + 66048);
    LAS bf16* Lk = (LAS bf16*)(L + 70144); LAS bf16* Mb = (LAS bf16*)(L + 72704); LAS bf16* Mk = (LAS bf16*)(L + 75264);
    LAS float* SOL = (LAS float*)(L + 77824);
    LAS bf16* KTb = (LAS bf16*)(L + 94208); LAS bf16* UVb = (LAS bf16*)(L + 98816);
    LAS float* RTf = (LAS float*)(L + 103424); LAS float* c31 = (LAS float*)(L + 111616);
    const int tid = c.tid, lane = c.lane, wave = c.wave, fr = lane & 15, fq = lane >> 4, trow = (lane & 15) >> 2, tcol = 4 * (lane & 3);
    const int t_ = tid >> 4, c4 = 4 * (tid & 15), col = h * 64 + c4;
    const float* mu = C_IN(17) + e * 2432;
    const bf16* hc = C_HB + (R0 + t_) * LDH + col; const bool hasprev = is_s ? (t_ != 0) : ((32 * n + t_) != 0);
    const u32x2 cr = P.cr, ck = P.ck, cv = P.cv, pr = P.pr, pk = P.pk, pv = P.pv;
    f32x4 sh_r = (f32x4){0.f, 0.f, 0.f, 0.f}, sh_k = sh_r, sh_v = sh_r;
    if (is_s && t_ == 0) { sh_r = *(const f32x4*)(shift + EC_R + col); sh_k = *(const f32x4*)(shift + EC_K + col); sh_v = *(const f32x4*)(shift + EC_V + col); }
    { const int cc = tid & 127, cl = EC_HW + cc, tb = tid >> 7; const float muc = mu[cl];
#pragma unroll
        for (int k = 0; k < 8; ++k) { const int t = tb + 4 * k; const float hs = P.hcur[k] + (P.hprv[k] - P.hcur[k]) * muc;
            if (cc < 64) LW[t * 72 + cc] = (bf16)f2bf(1.0f - 2.0f / (1.0f + __expf(2.0f * hs))); else LA[t * 72 + cc - 64] = (bf16)f2bf(hs); } }
    __syncthreads();
    { const int p = wave >> 2, tt = (wave >> 1) & 1; const LAS bf16* As = p ? LA : LW; const bf16* WT = (p ? C_AUT : C_WUT) + ((size_t)e * 768 + h * 64) * 64; LAS float* X = p ? XA : XW;
#pragma unroll
        for (int cc = 0; cc < 2; ++cc) { const int ct = 2 * (wave & 1) + cc; f32x4 acc = (f32x4){0.f, 0.f, 0.f, 0.f};
#pragma unroll
            for (int ks = 0; ks < 2; ++ks) acc = mfma16(*(const LAS bf16x8*)(As + (16 * tt + fr) * 72 + 32 * ks + 8 * fq), *(const bf16x8*)(WT + (size_t)(16 * ct + fr) * 64 + 32 * ks + 8 * fq), acc);
#pragma unroll
            for (int r = 0; r < 4; ++r) X[(16 * tt + 4 * fq + r) * 64 + 16 * ct + fr] = acc[r]; } }
    __syncthreads();
    float rr[4], k2[4], vv[4], kkv[4], bb[4];
    for (int rep3 = 0; rep3 < REP3; ++rep3) { asm volatile("" ::: "memory");
    { const f32x4 xw4 = *(const LAS f32x4*)(XW + t_ * 64 + c4), xa4 = *(const LAS f32x4*)(XA + t_ * 64 + c4);
        const f32x4 w04 = *(const f32x4*)(C_IN(18) + e * 768 + col), a04 = *(const f32x4*)(C_IN(20) + e * 768 + col), kk4 = *(const f32x4*)(C_IN(22) + e * 768 + col), ka4 = *(const f32x4*)(C_IN(23) + e * 768 + col),
                    rk4 = *(const f32x4*)(C_IN(24) + e * 768 + col), mr4 = *(const f32x4*)(mu + EC_R + col), mk4 = *(const f32x4*)(mu + EC_K + col), mv4 = *(const f32x4*)(mu + EC_V + col);
        float crf[4], ckf[4], cvf[4], prf[4], pkf[4], pvf[4]; unpk4(cr, crf); unpk4(ck, ckf); unpk4(cv, cvf); unpk4(pr, prf); unpk4(pk, pkf); unpk4(pv, pvf);
        const bool tok_ok = t_ < ntok;
#pragma unroll
        for (int i = 0; i < 4; ++i) { prf[i] += sh_r[i]; pkf[i] += sh_k[i]; pvf[i] += sh_v[i]; }
        float wl[4], av[4], ssum = 0.f, bsum = 0.f;
#pragma unroll
        for (int i = 0; i < 4; ++i) { const float r = crf[i] + (prf[i] - crf[i]) * mr4[i], k = ckf[i] + (pkf[i] - ckf[i]) * mk4[i], v = cvf[i] + (pvf[i] - cvf[i]) * mv4[i];
            wl[i] = -0.6065306597126334f * sigmoidf_(w04[i] + xw4[i]); av[i] = sigmoidf_(a04[i] + xa4[i]);
            const float kk = tok_ok ? k * kk4[i] : 0.f; ssum += kk * kk; kkv[i] = kk; k2[i] = tok_ok ? k * (1.0f + (av[i] - 1.0f) * ka4[i]) : 0.f; rr[i] = tok_ok ? r : 0.f; vv[i] = tok_ok ? v : 0.f; bsum += rr[i] * k2[i] * rk4[i];
            if (!tok_ok) wl[i] = 0.f; }
        ssum = red16(ssum); bsum = red16(bsum); const float inv = rsqrtf(fmaxf(ssum, 1e-24f));
#pragma unroll
        for (int i = 0; i < 4; ++i) { kkv[i] *= inv; bb[i] = kkv[i] * av[i]; }
        if ((tid & 15) == 0 && tok_ok) C_BONUS[(R0 + t_) * 12 + h] = bsum;
        *(LAS f32x4*)(PS + t_ * 64 + c4) = (f32x4){wl[0], wl[1], wl[2], wl[3]}; }
    __syncthreads();
    if (tid < 64) { float run = 0.f;
#pragma unroll 8
        for (int t = 0; t < 32; ++t) { run += PS[t * 64 + tid]; PS[t * 64 + tid] = run; } }
    __syncthreads();
    { const f32x4 pt = *(const LAS f32x4*)(PS + t_ * 64 + c4), pe = *(const LAS f32x4*)(PS + 31 * 64 + c4); const f32x4 pp = (t_ > 0) ? *(const LAS f32x4*)(PS + (t_ - 1) * 64 + c4) : (f32x4){0.f, 0.f, 0.f, 0.f};
        float o_kk[4], o_b[4], o_k[4], o_r[4], o_bh[4], o_kh[4];
#pragma unroll
        for (int i = 0; i < 4; ++i) { const float ct = __expf(pt[i]), cp = __expf(pp[i]), ci = __expf(-pt[i]), chh = __expf(pe[i] - pt[i]);
            o_kk[i] = kkv[i] * cp; o_b[i] = bb[i] * ci; o_k[i] = k2[i] * ci; o_r[i] = rr[i] * ct; o_bh[i] = bb[i] * chh; o_kh[i] = k2[i] * chh; }
        *(LAS u32x2*)(KKt + t_ * 72 + c4) = (u32x2){pk2(o_kk[0], o_kk[1]), pk2(o_kk[2], o_kk[3])}; *(LAS u32x2*)(Bt + t_ * 72 + c4) = (u32x2){pk2(o_b[0], o_b[1]), pk2(o_b[2], o_b[3])};
        *(LAS u32x2*)(Kt + t_ * 72 + c4) = (u32x2){pk2(o_k[0], o_k[1]), pk2(o_k[2], o_k[3])}; *(LAS u32x2*)(Rt + t_ * 72 + c4) = (u32x2){pk2(o_r[0], o_r[1]), pk2(o_r[2], o_r[3])};
        *(LAS u32x2*)(Bh + t_ * 72 + c4) = (u32x2){pk2(o_bh[0], o_bh[1]), pk2(o_bh[2], o_bh[3])}; *(LAS u32x2*)(Kh + t_ * 72 + c4) = (u32x2){pk2(o_kh[0], o_kh[1]), pk2(o_kh[2], o_kh[3])};
        *(LAS u32x2*)(Vb + t_ * 72 + c4) = (u32x2){pk2(vv[0], vv[1]), pk2(vv[2], vv[3])};
        *(LAS f32x4*)(RTf + t_ * 64 + c4) = (f32x4){o_r[0], o_r[1], o_r[2], o_r[3]}; *(LAS f32x4*)(SOL + t_ * 128 + c4) = (f32x4){o_kk[0], o_kk[1], o_kk[2], o_kk[3]};
        if (t_ == 31) *(LAS f32x4*)(c31 + c4) = (f32x4){__expf(pt[0]), __expf(pt[1]), __expf(pt[2]), __expf(pt[3])}; }
    __syncthreads(); }
    { const int m = wave >> 1, tt = wave & 1; const LAS bf16* X = (m < 2) ? KKt : Rt; const LAS bf16* Yv = (m & 1) ? Kt : Bt;
#pragma unroll
        for (int st = 0; st < 2; ++st) { f32x4 acc = (f32x4){0.f, 0.f, 0.f, 0.f};
            if (st <= tt) {
#pragma unroll
                for (int ks = 0; ks < 2; ++ks) acc = mfma16(*(const LAS bf16x8*)(X + (16 * tt + fr) * 72 + 32 * ks + 8 * fq), *(const LAS bf16x8*)(Yv + (16 * st + fr) * 72 + 32 * ks + 8 * fq), acc); }
#pragma unroll
            for (int r = 0; r < 4; ++r) { const int t = 16 * tt + 4 * fq + r, s_ = 16 * st + fr; const bool keep = (m < 2) ? (s_ < t) : (s_ <= t); const float val = keep ? acc[r] : 0.f;
                if (m == 0) LB[t * 32 + (s_ & 3) * 8 + (s_ >> 2)] = val; else if (m == 1) Lk[t * 40 + s_] = (bf16)f2bf(val); else if (m == 2) Mb[t * 40 + s_] = (bf16)f2bf(val); else Mk[t * 40 + s_] = (bf16)f2bf(val); } } }
    __syncthreads();
    { const int tt = wave >> 2, ict = wave & 3;
        const f32x4 acc = mfma16(*(const LAS bf16x8*)(Lk + (16 * tt + fr) * 40 + 8 * fq), tr_frag(Vb + (8 * fq + trow) * 72 + 16 * ict + tcol, 4 * 72), (f32x4){0.f, 0.f, 0.f, 0.f});
#pragma unroll
        for (int r = 0; r < 4; ++r) SOL[(16 * tt + 4 * fq + r) * 128 + 64 + 16 * ict + fr] = acc[r]; }
    __syncthreads();
    { const int cidx = tid >> 2, q = tid & 3; float xq[8];
#pragma unroll
        for (int u = 0; u < 8; ++u) xq[u] = 0.f;
#pragma unroll
        for (int t = 0; t < 32; ++t) { float part = 0.f;
            if (t > 0) { const f32x4 la = *(const LAS f32x4*)(LB + t * 32 + q * 8); part = la[0] * xq[0];
                if (t > 4) part += la[1] * xq[1]; if (t > 8) part += la[2] * xq[2]; if (t > 12) part += la[3] * xq[3];
                if (t > 16) { const f32x4 lb = *(const LAS f32x4*)(LB + t * 32 + q * 8 + 4); part += lb[0] * xq[4];
                    if (t > 20) part += lb[1] * xq[5]; if (t > 24) part += lb[2] * xq[6]; if (t > 28) part += lb[3] * xq[7]; }
                part += dppf<0xB1>(part); part += dppf<0x4E>(part); }
            const float xt = SOL[t * 128 + cidx] - part;
            if (q == (t & 3)) { xq[t >> 2] = xt;
                if (cidx < 64) KTb[t * 72 + cidx] = (bf16)f2bf(xt); else UVb[t * 72 + cidx - 64] = (bf16)f2bf(-xt); } } }
    __syncthreads();
    for (int rep9 = 0; rep9 < REP9; ++rep9) { asm volatile("" ::: "memory");
    unsigned char* chk = C_CHK + (size_t)item * CHK_BYTES; bf16* Ag = (bf16*)(chk + CK_A); bf16* RQg = (bf16*)(chk + CK_RQ); bf16* GTg = (bf16*)(chk + CK_GT); bf16* YVTg = (bf16*)(chk + CK_YVT);
    const f32x4 z4 = (f32x4){0.f, 0.f, 0.f, 0.f};
    { const int jt = wave >> 1;
        const bf16x8 BhT = tr_frag(Bh + (8 * fq + trow) * 72 + 16 * jt + tcol, 4 * 72), KhT = tr_frag(Kh + (8 * fq + trow) * 72 + 16 * jt + tcol, 4 * 72);
#pragma unroll
        for (int cc = 0; cc < 2; ++cc) { const int ct = 2 * (wave & 1) + cc;
            const f32x4 aA = mfma16(BhT, tr_frag(KTb + (8 * fq + trow) * 72 + 16 * ct + tcol, 4 * 72), z4);
            f32x4 aG = mfma16(BhT, tr_frag(UVb + (8 * fq + trow) * 72 + 16 * ct + tcol, 4 * 72), z4); aG = mfma16(KhT, tr_frag(Vb + (8 * fq + trow) * 72 + 16 * ct + tcol, 4 * 72), aG);
#pragma unroll
            for (int r = 0; r < 4; ++r) { const int j = 16 * jt + 4 * fq + r, jp = 16 * ct + fr; Ag[j * 72 + jp] = (bf16)f2bf(((j == jp) ? c31[j] : 0.f) - aA[r]); }
            *(u32x2*)(GTg + (16 * ct + fr) * 68 + 16 * jt + 4 * fq) = (u32x2){pk2(aG[0], aG[1]), pk2(aG[2], aG[3])}; } }
    { const int tt = wave >> 2, jt2 = wave & 3; const bf16x8 MbF = *(const LAS bf16x8*)(Mb + (16 * tt + fr) * 40 + 8 * fq);
        const f32x4 a = mfma16(MbF, tr_frag(KTb + (8 * fq + trow) * 72 + 16 * jt2 + tcol, 4 * 72), z4);
#pragma unroll
        for (int r = 0; r < 4; ++r) { const int t = 16 * tt + 4 * fq + r, j = 16 * jt2 + fr; RQg[t * 72 + j] = (bf16)f2bf(RTf[t * 64 + j] - a[r]); }
        f32x4 y = mfma16(MbF, tr_frag(UVb + (8 * fq + trow) * 72 + 16 * jt2 + tcol, 4 * 72), z4);
        y = mfma16(*(const LAS bf16x8*)(Mk + (16 * tt + fr) * 40 + 8 * fq), tr_frag(Vb + (8 * fq + trow) * 72 + 16 * jt2 + tcol, 4 * 72), y);
        *(u32x2*)(YVTg + (16 * jt2 + fr) * 36 + 16 * tt + 4 * fq) = (u32x2){pk2(y[0], y[1]), pk2(y[2], y[3])}; }
    __syncthreads(); }
}
__device__ __forceinline__ void rwkv_stream(const Ctx& c, int bh, int it, int e) {
    const int b = bh / 12, h = bh % 12, lane = c.lane, fr = lane & 15, fq = lane >> 4;
    LAS bf16* Sl = (LAS bf16*)c.lds + c.wave * (16 * 72);
    const unsigned char* chk0 = C_CHK + (size_t)bh * 128 * CHK_BYTES;
    float* ya = C_YA + ((size_t)b * SEQ) * 768 + h * 64 + 16 * it + fr;
    f32x4 S[4];
#pragma unroll
    for (int jt = 0; jt < 4; ++jt) S[jt] = (f32x4){0.f, 0.f, 0.f, 0.f};
    bf16x8 A0[4][2], R0f[2][2], A1[4][2], R1f[2][2]; f32x4 G0[4], Y0[2], G1[4], Y1[2];
#define ST_LOAD(AF, RF, GV, YV, n_) do { const unsigned char* base_ = chk0 + (size_t)(n_) * CHK_BYTES; \
        _Pragma("unroll") for (int jt = 0; jt < 4; ++jt) { _Pragma("unroll") for (int ks = 0; ks < 2; ++ks) AF[jt][ks] = *(const bf16x8*)((const bf16*)(base_ + CK_A) + (16 * jt + fr) * 72 + 32 * ks + 8 * fq); \
            { float g_[4]; unpk4(*(const u32x2*)((const bf16*)(base_ + CK_GT) + (16 * it + fr) * 68 + 16 * jt + 4 * fq), g_); GV[jt] = (f32x4){g_[0], g_[1], g_[2], g_[3]}; } } \
        _Pragma("unroll") for (int tt = 0; tt < 2; ++tt) { _Pragma("unroll") for (int ks = 0; ks < 2; ++ks) RF[tt][ks] = *(const bf16x8*)((const bf16*)(base_ + CK_RQ) + (16 * tt + fr) * 72 + 32 * ks + 8 * fq); \
            { float y4_[4]; unpk4(*(const u32x2*)((const bf16*)(base_ + CK_YVT) + (16 * it + fr) * 36 + 16 * tt + 4 * fq), y4_); YV[tt] = (f32x4){y4_[0], y4_[1], y4_[2], y4_[3]}; } } } while (0)
#define ST_STEP(AF, RF, GV, YV, n_, tmax_) do { \
        _Pragma("unroll") for (int jt = 0; jt < 4; ++jt) *(LAS u32x2*)(Sl + fr * 72 + 16 * jt + 4 * fq) = (u32x2){pk2(S[jt][0], S[jt][1]), pk2(S[jt][2], S[jt][3])}; \
        asm volatile("s_waitcnt lgkmcnt(0)" ::: "memory"); \
        const bf16x8 Sf0 = *(const LAS bf16x8*)(Sl + fr * 72 + 8 * fq), Sf1 = *(const LAS bf16x8*)(Sl + fr * 72 + 32 + 8 * fq); \
        asm volatile("s_waitcnt lgkmcnt(0)" ::: "memory"); \
        _Pragma("unroll") for (int tt = 0; tt < 2; ++tt) { f32x4 y_ = mfma16(RF[tt][0], Sf0, YV[tt]); y_ = mfma16(RF[tt][1], Sf1, y_); \
            _Pragma("unroll") for (int r = 0; r < 4; ++r) if (16 * tt + 4 * fq + r < (tmax_)) ya[(size_t)(32 * (n_) + 16 * tt + 4 * fq + r) * 768] = y_[r]; } \
        _Pragma("unroll") for (int jt = 0; jt < 4; ++jt) { f32x4 a_ = mfma16(AF[jt][0], Sf0, GV[jt]); S[jt] = mfma16(AF[jt][1], Sf1, a_); } } while (0)
    ST_LOAD(A0, R0f, G0, Y0, 0);
#pragma unroll 1
    for (int n = 0; n < 128; n += 2) {
        ST_LOAD(A1, R1f, G1, Y1, n + 1);
        ST_STEP(A0, R0f, G0, Y0, n, 32);
        if (n + 2 < 128) ST_LOAD(A0, R0f, G0, Y0, n + 2);
        ST_STEP(A1, R1f, G1, Y1, n + 1, 32);
    }
    float* so = C_OUT + O_RWKV_P + (((size_t)e * 2 + b) * 12 + h) * 4096 + (size_t)(16 * it + fr) * 64 + 4 * fq;
#pragma unroll
    for (int jt = 0; jt < 4; ++jt) *(f32x4*)(so + 16 * jt) = S[jt];
}
__device__ __forceinline__ void rwkv_stream_block(const Ctx& c, int sb, int e) {
    const int bh = sb >> 2, it = sb & 3, b = bh / 12, h = bh % 12, tid = c.tid, lane = c.lane, wave = c.wave, fr = lane & 15, fq = lane >> 4, jt = wave & 3;
    constexpr int SLOT = 13824 + 2176 + 1152;
    LAS unsigned char* slots = c.lds;
    LAS bf16* Sl = (LAS bf16*)(c.lds + 2 * SLOT);
    const unsigned char* rec0 = C_CHK + (size_t)bh * 128 * CHK_BYTES;
    int soff[3];
#pragma unroll
    for (int k = 0; k < 3; ++k) { const int p = tid + 512 * k; soff[k] = (p < 864) ? 16 * p : (p < 864 + 136) ? CK_GT + it * 2176 + 16 * (p - 864) : CK_YVT + it * 1152 + 16 * (p - 1000); }
    const bool has2 = (tid + 1024) < SLOT / 16;
    float* ya = C_YA + ((size_t)b * SEQ + 16 * jt + 4 * fq) * 768 + h * 64 + 16 * it + fr;
    f32x4 S1 = (f32x4){0.f, 0.f, 0.f, 0.f};
    *(LAS u32x2*)(Sl + fr * 72 + 16 * jt + 4 * fq) = (u32x2){0u, 0u};
    u32x4 P0[3], P1[3], P2[3], P3[3];
#define SB_GLOAD(P, n_) do { const int nn_ = (n_) < 128 ? (n_) : 127; const unsigned char* r_ = rec0 + (size_t)nn_ * CHK_BYTES; \
        _Pragma("unroll") for (int k = 0; k < 2; ++k) P[k] = *(const u32x4*)(r_ + soff[k]); P[2] = *(const u32x4*)(r_ + (has2 ? soff[2] : soff[0])); } while (0)
#define SB_LWRITE(P, s_) do { _Pragma("unroll") for (int k = 0; k < 2; ++k) *(LAS u32x4*)(slots + (s_) * SLOT + tid * 16 + k * 8192) = P[k]; if (has2) *(LAS u32x4*)(slots + (s_) * SLOT + tid * 16 + 2 * 8192) = P[2]; } while (0)
#define SB_STEP(s_, n_) do { const LAS unsigned char* sb_ = slots + (s_) * SLOT; const LAS bf16* si_ = Sl + (s_) * (16 * 72) + fr * 72 + 8 * fq; \
        const LAS bf16* a_ = (const LAS bf16*)sb_ + (16 * jt + fr) * 72 + 8 * fq; const bf16x8 af0 = *(const LAS bf16x8*)a_, af1 = *(const LAS bf16x8*)(a_ + 32); \
        const u32x2 gw_ = *(const LAS u32x2*)((const LAS bf16*)(sb_ + 13824) + fr * 68 + 16 * jt + 4 * fq); \
        const LAS bf16* rq_ = (const LAS bf16*)(sb_ + CK_RQ) + (16 * (jt & 1) + fr) * 72 + 8 * fq; const bf16x8 rf0 = *(const LAS bf16x8*)rq_, rf1 = *(const LAS bf16x8*)(rq_ + 32); \
        const u32x2 yw_ = *(const LAS u32x2*)((const LAS bf16*)(sb_ + 13824 + 2176) + fr * 36 + 16 * (jt & 1) + 4 * fq); \
        const bf16x8 Sf0 = *(const LAS bf16x8*)si_, Sf1 = *(const LAS bf16x8*)(si_ + 32); \
        asm volatile("s_waitcnt lgkmcnt(0)" ::: "memory"); __builtin_amdgcn_sched_barrier(0); \
        float g4_[4], y4_[4]; unpk4(gw_, g4_); unpk4(yw_, y4_); const f32x4 gv_ = (f32x4){g4_[0], g4_[1], g4_[2], g4_[3]}, yv_ = (f32x4){y4_[0], y4_[1], y4_[2], y4_[3]}; \
        { f32x4 t_ = mfma16(af0, Sf0, gv_); S1 = mfma16(af1, Sf1, t_); } \
        if (jt < 2) { f32x4 y_ = mfma16(rf0, Sf0, yv_); y_ = mfma16(rf1, Sf1, y_); \
            _Pragma("unroll") for (int r = 0; r < 4; ++r) ya[(size_t)(32 * (n_) + r) * 768] = y_[r]; } \
        *(LAS u32x2*)(Sl + ((s_) ^ 1) * (16 * 72) + fr * 72 + 16 * jt + 4 * fq) = (u32x2){pk2(S1[0], S1[1]), pk2(S1[2], S1[3])}; \
        } while (0)
    SB_GLOAD(P0, 0); SB_GLOAD(P1, 1); SB_GLOAD(P2, 2); SB_GLOAD(P3, 3);
    SB_LWRITE(P0, 0); __syncthreads();
#pragma unroll 1
    for (int n = 0; n < 128; n += 4) {
        SB_LWRITE(P1, 1); SB_GLOAD(P0, n + 4); SB_STEP(0, n); __syncthreads();
        SB_LWRITE(P2, 0); SB_GLOAD(P1, n + 5); SB_STEP(1, n + 1); __syncthreads();
        SB_LWRITE(P3, 1); SB_GLOAD(P2, n + 6); SB_STEP(0, n + 2); __syncthreads();
        SB_LWRITE(P0, 0); SB_GLOAD(P3, n + 7); SB_STEP(1, n + 3); __syncthreads();
    }
#undef SB_GLOAD
#undef SB_LWRITE
#undef SB_STEP
    *(f32x4*)(C_OUT + O_RWKV_P + (((size_t)e * 2 + b) * 12 + h) * 4096 + (size_t)(16 * it + fr) * 64 + 16 * jt + 4 * fq) = S1;
}
__device__ __forceinline__ void rwkv_stream_sample(const Ctx& c, int sidx, int it, int e) {
    const int ns = sidx / 12, h = sidx % 12, lane = c.lane, fr = lane & 15, fq = lane >> 4;
    LAS bf16* Sl = (LAS bf16*)c.lds + c.wave * (16 * 72);
    const unsigned char* chk0 = C_CHK + (size_t)(3072 + sidx) * CHK_BYTES;
    float* ya = C_YA + ((size_t)(TP + 4 * ns)) * 768 + h * 64 + 16 * it + fr;
    const float* si = C_IN(2) + (((size_t)e * 8 + ns) * 12 + h) * 4096 + (size_t)(16 * it + fr) * 64 + 4 * fq;
    f32x4 S[4];
#pragma unroll
    for (int jt = 0; jt < 4; ++jt) S[jt] = *(const f32x4*)(si + 16 * jt);
    bf16x8 A0[4][2], R0f[2][2]; f32x4 G0[4], Y0[2];
    ST_LOAD(A0, R0f, G0, Y0, 0);
    ST_STEP(A0, R0f, G0, Y0, 0, 4);
    float* so = C_OUT + O_RWKV_S + (((size_t)e * 8 + ns) * 12 + h) * 4096 + (size_t)(16 * it + fr) * 64 + 4 * fq;
#pragma unroll
    for (int jt = 0; jt < 4; ++jt) *(f32x4*)(so + 16 * jt) = S[jt];
}
#undef ST_LOAD
#undef ST_STEP
__device__ __forceinline__ void phase_even_tok_pre(Ctx c, int l) {
    const int e = l >> 1;
    constexpr int NI = 3072 + 96;
    const bool split = (c.G == 256); const int NTB = split ? (l == 0 ? 171 : 123) : 0;
    if (split) {
        { pg8::Gemm g{C_XB, C_WTIN_L(l), MPAD, 3 * 256, DM}; pg8::StaticOrder S; S.init(MPAD, 3 * 256, c.G, c.bid, 0, 24); S.ex_n = 24; S.ex_pm0 = 9; S.ex_pn = 23;
            pg8::EpiBf16NP E{C_HB, LDH, C_TAB, 0, 1536};
            pg8::gemm_phase<pg8::EpiBf16NP, pg8::StaticOrder, true, true>(c.lds, g, S, E); }
        LAUNDER_C(c);
    }
    if (l == 0) {
        { pg8::Gemm g{C_MEMB, C_WTMEM, 512, 4096, DM}; pg8::StaticOrder S; S.init(512, 4096, c.G, split ? (c.bid + c.G - 123) % c.G : c.bid);
            pg8::EpiF32Split E{C_OUT + O_MEM, 1024, 1024, (size_t)512 * 1024, C_MKVB};
            pg8::gemm_phase<pg8::EpiF32Split, pg8::StaticOrder, true, true>(c.lds, g, S, E); }
        LAUNDER_C(c);
#pragma unroll 1
        for (int gi = 0; gi < 4; ++gi) {
            pg8::Gemm g{C_WTMEM + ((size_t)gi * 1024 + 512) * DM, C_MEMB, 512, 512, DM}; pg8::StaticOrder S; S.init(512, 512, c.G, split ? (c.bid + 2 * c.G - 155 - 4 * gi) % c.G : c.bid);
            pg8::EpiBf16NP E{C_VT + (size_t)gi * 512 * 512, 512, C_TAB, 0, 1536};
            pg8::gemm_phase<pg8::EpiBf16NP, pg8::StaticOrder, true, true>(c.lds, g, S, E);
            LAUNDER_C(c);
        }
    }
    if (!split) {
        PreIn A; if (c.bid < NI) rwkv_chunk_preload(c, c.bid, e, A);
        for (int it = c.bid; it < NI; it += c.G) { PreIn B; const int nx = (it + c.G < NI) ? it + c.G : it;
            rwkv_chunk_preload(c, nx, e, B); rwkv_chunk_precompute(c, it, e, A); A = B; }
    } else {
        const int na = (NI - 4 * (256 - NTB)) / 256, rem = NI - 256 * na - 4 * (256 - NTB);
        const int nmid = (c.bid >= NTB) ? 4 : 0, nb = na + nmid + ((c.bid < rem) ? 1 : 0);
#define PRE_ITEM(k_) ((k_) < na ? (k_) * 256 + c.bid : ((k_) < na + nmid ? 256 * na + ((k_) - na) * (256 - NTB) + (c.bid - NTB) : 256 * na + 4 * (256 - NTB) + c.bid))
        PreIn A; rwkv_chunk_preload(c, PRE_ITEM(0), e, A);
        for (int k = 0; k < nb; ++k) { PreIn B; const int it = PRE_ITEM(k), nx = (k + 1 < nb) ? PRE_ITEM(k + 1) : it;
            rwkv_chunk_preload(c, nx, e, B); rwkv_chunk_precompute(c, it, e, A); A = B; }
#undef PRE_ITEM
    }
}
__device__ __forceinline__ void phase_even_scan(Ctx c, int l) {
    const int e = l >> 1;
    if (c.G >= 240) {
        if (c.bid < 96) { for (int rp = 0; rp < REPS; ++rp) { rwkv_stream_block(c, 12 * (c.bid & 7) + (c.bid >> 3), e); __syncthreads(); LAUNDER_C(c); } }
        else { Ctx h = c; h.bid = c.bid - 96; h.G = c.G - 96; LAUNDER_C(h);
            if (h.bid < 96) { if (h.wave < 4) rwkv_stream_sample(h, h.bid, h.wave, e); __syncthreads(); }
            even_helper_work(h, l); }
    } else {
        for (int it = c.bid; it < 96; it += c.G) { rwkv_stream_block(c, it, e); __syncthreads(); }
        for (int it = c.bid; it < 96; it += c.G) { if (c.wave < 4) rwkv_stream_sample(c, it, c.wave, e); __syncthreads(); }
        LAUNDER_C(c);
        even_helper_work(c, l);
    }
}
__device__ __forceinline__ void phase_even_ubuild(const Ctx& c, int l) {
    const int e = l >> 1; const float* r_k = C_IN(24) + e * 768; const float* lg = C_IN(25) + e * 768; const float* lb = C_IN(26) + e * 768; const float* muv = C_IN(17) + e * 2432 + EC_V;
    for (int R = c.bid * 8 + c.wave; R < TT; R += c.G * 8) {
        const bool hasprev = (R < TP) ? ((R & (SEQ - 1)) != 0) : (((R - TP) & 3) != 0);
        const float* shiftv = C_IN(3) + ((size_t)e * 8 + ((R >= TP) ? ((R - TP) >> 2) : 0)) * 2432 + EC_V;
        const bf16* hrow = C_HB + (size_t)R * LDH;
#pragma unroll 1
        for (int hb = 0; hb < 12; hb += 4) {
            float y[4], gate[4], cvv[4], pvv[4], bon[4], lgv[4], lbv[4], mv[4];
#pragma unroll
            for (int k = 0; k < 4; ++k) { const int col = (hb + k) * 64 + c.lane;
                y[k] = C_YA[(size_t)R * 768 + col]; gate[k] = bf2f(hrow[EC_GA + col]); cvv[k] = bf2f(hrow[EC_V + col]);
                pvv[k] = hasprev ? bf2f(hrow[EC_V + col - LDH]) : ((R < TP) ? 0.f : shiftv[col]);
                bon[k] = C_BONUS[(size_t)R * 12 + hb + k]; lgv[k] = lg[col]; lbv[k] = lb[col]; mv[k] = muv[col]; }
#pragma unroll
            for (int k = 0; k < 4; ++k) { const int col = (hb + k) * 64 + c.lane;
                const float mean = wave_sum(y[k]) * (1.0f / 64.0f); const float dlt = y[k] - mean; const float var = wave_sum(dlt * dlt) * (1.0f / 64.0f);
                const float yn = dlt * rsqrtf(var + 64e-5f) * lgv[k] + lbv[k];
                const float bonus = bon[k] * (cvv[k] + (pvv[k] - cvv[k]) * mv[k]);
                C_U[(size_t)R * EVEN_OUT + col] = (bf16)f2bf((yn + bonus) * siluf_(gate[k])); }
        }
    }
}

__device__ __forceinline__ void even_combine_dil(const Ctx& c) {
    const int hh = c.lane >> 4, d4 = 4 * (c.lane & 15);
    for (int R0 = c.bid * 8 + c.wave; R0 < TP; R0 += 2 * c.G * 8) {
        const int R1 = (R0 + c.G * 8 < TP) ? R0 + c.G * 8 : R0;
        float ls[2][3]; f32x4 og[2][3]; u32x2 gw[2];
#pragma unroll
        for (int k = 0; k < 2; ++k) { const int R = k ? R1 : R0;
#pragma unroll
            for (int g = 0; g < 3; ++g) { ls[k][g] = C_LSE[((size_t)g * TT + R) * 4 + hh]; og[k][g] = *(const f32x4*)(C_OG + ((size_t)g * TT + R) * 256 + hh * 64 + d4); }
            gw[k] = *(const u32x2*)(C_HB + (size_t)R * LDH + EC_GB + hh * 64 + d4); }
#pragma unroll
        for (int k = 0; k < 2; ++k) { const int R = k ? R1 : R0;
            const float mx = fmaxf(ls[k][0], fmaxf(ls[k][1], ls[k][2])); const float w0 = __expf(ls[k][0] - mx), w1 = __expf(ls[k][1] - mx), w2 = __expf(ls[k][2] - mx); const float inv = 1.0f / (w0 + w1 + w2);
            const f32x4 y = (og[k][0] * w0 + og[k][1] * w1 + og[k][2] * w2) * inv;
            float gt[4]; unpk4(gw[k], gt);
            *(u32x2*)(C_U + (size_t)R * EVEN_OUT + 768 + hh * 64 + d4) = (u32x2){pk2(y.x * siluf_(gt[0]), y.y * siluf_(gt[1])), pk2(y.z * siluf_(gt[2]), y.w * siluf_(gt[3]))}; }
    }
}
__device__ __forceinline__ void rot8(u32x4 w, const float* tb, float scale, float (&y)[8]) {
    float x[8]; unpk8(w, x); const f32x4 t0 = *(const f32x4*)tb, t1 = *(const f32x4*)(tb + 4);
    const float cs[8] = {t0.x, t0.y, t0.z, t0.w, t1.x, t1.y, t1.z, t1.w};
#pragma unroll
    for (int p = 0; p < 4; ++p) { const float co = cs[2 * p], si = cs[2 * p + 1], x0 = x[2 * p], x1 = x[2 * p + 1]; y[2 * p] = (x0 * co - x1 * si) * scale; y[2 * p + 1] = (x1 * co + x0 * si) * scale; }
}
#define C_SB ((bf16*)(c.ap->ws + WS_OG))
__device__ __forceinline__ void ret_s_prepass_item(const Ctx& c, int item) {
    const int bh = item >> 6, ch = item & 63, b = bh / 6, h = bh % 6;
    LAS bf16* Qc = (LAS bf16*)c.lds;
    LAS bf16* Kc = Qc + 64 * 264;
    const float lg = LG2G[h];
    const int tid = c.tid, lane = c.lane, wave = c.wave, fr = lane & 15, fq = lane >> 4, it = wave >> 1, jt0 = (wave & 1) * 2;
    const bf16* g0 = C_HB + ((size_t)b * SEQ + ch * 64) * LDH + h * 256;
    u32x4 tq[4], tk[4];
#pragma unroll
    for (int q = 0; q < 4; ++q) { const int p = tid + 512 * q, row = p >> 5, c8 = (p & 31) * 8; tq[q] = *(const u32x4*)(g0 + (size_t)row * LDH + OC_Q + c8); tk[q] = *(const u32x4*)(g0 + (size_t)row * LDH + OC_K + c8); }
#pragma unroll
    for (int q = 0; q < 4; ++q) { const int p = tid + 512 * q, row = p >> 5, c8 = (p & 31) * 8; *(LAS u32x4*)(Qc + row * 264 + c8) = tq[q]; *(LAS u32x4*)(Kc + row * 264 + c8) = tk[q]; }
    __syncthreads();
    f32x4 accS[2];
#pragma unroll
    for (int q = 0; q < 2; ++q) accS[q] = (f32x4){0.f, 0.f, 0.f, 0.f};
#pragma unroll
    for (int kp = 0; kp < 4; ++kp) { bf16x8 Qf2[2], Kf2[2][2];
#pragma unroll
        for (int kk = 0; kk < 2; ++kk) { const int ks = 2 * kp + kk; Qf2[kk] = *(const LAS bf16x8*)(Qc + (16 * it + fr) * 264 + 32 * ks + 8 * fq);
#pragma unroll
            for (int q = 0; q < 2; ++q) Kf2[kk][q] = *(const LAS bf16x8*)(Kc + (16 * (jt0 + q) + fr) * 264 + 32 * ks + 8 * fq); }
        asm volatile("s_waitcnt lgkmcnt(0)" ::: "memory"); __builtin_amdgcn_sched_barrier(0);
#pragma unroll
        for (int kk = 0; kk < 2; ++kk)
#pragma unroll
            for (int q = 0; q < 2; ++q) accS[q] = mfma16(Qf2[kk], Kf2[kk][q], accS[q]); }
    bf16* sb = C_SB + (size_t)item * 4096;
#pragma unroll
    for (int jj = 0; jj < 2; ++jj) { const int jt = jt0 + jj;
#pragma unroll
        for (int r = 0; r < 4; ++r) { const int i = 16 * it + 4 * fq + r, j = 16 * jt + fr; const float val = (i >= j) ? accS[jj][r] * exp2f(lg * (float)(i - j)) : 0.f; sb[i * 64 + j] = (bf16)f2bf(val); } }
    __syncthreads();
}
__device__ __forceinline__ void ret_prompt_unit(const Ctx& c, int unit, int o) {
    const int b = unit / 48, h = (unit >> 3) % 6, es = unit & 7;
    LAS bf16* Qc = (LAS bf16*)c.lds;
    LAS bf16* Kc = Qc + 64 * 264;
    LAS bf16* Vc = Kc + 64 * 264;
    LAS bf16* Vz = Vc + 64 * 40;
    LAS bf16* Rt = Vz + 64 * 40;
    const float lg = LG2G[h];
    const int tid = c.tid, lane = c.lane, wave = c.wave, fr = lane & 15, fq = lane >> 4, it = wave >> 1, eto = wave & 1;
    f32x4 Racc[2][2];
#pragma unroll
    for (int a = 0; a < 2; ++a)
#pragma unroll
        for (int q = 0; q < 2; ++q) Racc[a][q] = (f32x4){0.f, 0.f, 0.f, 0.f};
    for (int i = tid; i < 32 * 264 / 2; i += 512) ((LAS unsigned*)Rt)[i] = 0u;
    const float g64 = exp2f(lg * 64.f);
    const int vj = (tid & 255) >> 2, vp = tid & 3; const float zeta = exp2f(lg * (float)(63 - vj));
    const bf16* g0 = C_HB + ((size_t)b * SEQ) * LDH + h * 256;
    const bf16* gv = C_HB + ((size_t)b * SEQ + vj) * LDH + OC_V + h * 256 + es * 32 + vp * 8;
    const bf16* gs = C_SB + (size_t)((b * 6 + h) * 64) * 4096 + (16 * it + fr) * 64 + 8 * fq;
    u32x4 pq[4], pk[4], pv; bf16x8 sfn[2];
#pragma unroll
    for (int q = 0; q < 4; ++q) { const int p = tid + 512 * q, row = p >> 5, c8 = (p & 31) * 8; pq[q] = *(const u32x4*)(g0 + (size_t)row * LDH + OC_Q + c8); pk[q] = *(const u32x4*)(g0 + (size_t)row * LDH + OC_K + c8); }
    pv = *(const u32x4*)gv; sfn[0] = *(const bf16x8*)gs; sfn[1] = *(const bf16x8*)(gs + 32);
    const int trow = (lane & 15) >> 2, tcol = 4 * (lane & 3);
#pragma unroll 1
    for (int ch = 0; ch < 64; ++ch) {
        const size_t row0 = (size_t)b * SEQ + ch * 64;
#pragma unroll
        for (int q = 0; q < 4; ++q) { const int p = tid + 512 * q, row = p >> 5, c8 = (p & 31) * 8; *(LAS u32x4*)(Qc + row * 264 + c8) = pq[q]; *(LAS u32x4*)(Kc + row * 264 + c8) = pk[q]; }
        if (wave < 4) { *(LAS u32x4*)(Vc + vj * 40 + vp * 8) = pv; float x[8]; unpk8(pv, x);
            *(LAS u32x4*)(Vz + vj * 40 + vp * 8) = (u32x4){pk2(x[0] * zeta, x[1] * zeta), pk2(x[2] * zeta, x[3] * zeta), pk2(x[4] * zeta, x[5] * zeta), pk2(x[6] * zeta, x[7] * zeta)}; }
        const bf16x8 Sf0 = sfn[0], Sf1 = sfn[1];
        { const int cn = (ch + 1 < 64) ? ch + 1 : 63; const size_t adv = (size_t)cn * 64 * LDH;
#pragma unroll
            for (int q = 0; q < 4; ++q) { const int p = tid + 512 * q, row = p >> 5, c8 = (p & 31) * 8; pq[q] = *(const u32x4*)(g0 + adv + (size_t)row * LDH + OC_Q + c8); pk[q] = *(const u32x4*)(g0 + adv + (size_t)row * LDH + OC_K + c8); }
            pv = *(const u32x4*)(gv + adv); sfn[0] = *(const bf16x8*)(gs + (size_t)cn * 4096); sfn[1] = *(const bf16x8*)(gs + (size_t)cn * 4096 + 32); }
        __syncthreads();
        f32x4 accQ = (f32x4){0.f, 0.f, 0.f, 0.f};
        { bf16x8 Qf[8], Rf[8];
#pragma unroll
            for (int ks = 0; ks < 8; ++ks) { Qf[ks] = *(const LAS bf16x8*)(Qc + (16 * it + fr) * 264 + 32 * ks + 8 * fq); Rf[ks] = *(const LAS bf16x8*)(Rt + (16 * eto + fr) * 264 + 32 * ks + 8 * fq); }
            asm volatile("s_waitcnt lgkmcnt(0)" ::: "memory"); __builtin_amdgcn_sched_barrier(0);
#pragma unroll
            for (int ks = 0; ks < 8; ++ks) accQ = mfma16(Qf[ks], Rf[ks], accQ); }
        { bf16x8 Vfr[2], Kfr[2][2], Zfr[2][2];
#pragma unroll
            for (int k2 = 0; k2 < 2; ++k2) { Vfr[k2] = tr_frag(Vc + (32 * k2 + 8 * fq + trow) * 40 + 16 * eto + tcol, 4 * 40);
#pragma unroll
                for (int dd = 0; dd < 2; ++dd) Kfr[dd][k2] = tr_frag(Kc + (32 * k2 + 8 * fq + trow) * 264 + 16 * (2 * wave + dd) + tcol, 4 * 264);
#pragma unroll
                for (int et = 0; et < 2; ++et) Zfr[et][k2] = tr_frag(Vz + (32 * k2 + 8 * fq + trow) * 40 + 16 * et + tcol, 4 * 40); }
            asm volatile("s_waitcnt lgkmcnt(0)" ::: "memory"); __builtin_amdgcn_sched_barrier(0);
            { f32x4 a2 = mfma16(Sf0, Vfr[0], (f32x4){0.f, 0.f, 0.f, 0.f}); a2 = mfma16(Sf1, Vfr[1], a2);
#pragma unroll
                for (int r = 0; r < 4; ++r) { const int i = 16 * it + 4 * fq + r; C_YR[(row0 + i) * 1536 + h * 256 + es * 32 + 16 * eto + fr] = a2[r] + accQ[r] * exp2f(lg * (float)(i + 1)); } }
#pragma unroll
            for (int dd = 0; dd < 2; ++dd)
#pragma unroll
                for (int et = 0; et < 2; ++et) { f32x4 a = Racc[dd][et] * g64; a = mfma16(Kfr[dd][0], Zfr[et][0], a); Racc[dd][et] = mfma16(Kfr[dd][1], Zfr[et][1], a); } }
        __syncthreads();
#pragma unroll
        for (int dd = 0; dd < 2; ++dd)
#pragma unroll
            for (int et = 0; et < 2; ++et) { const f32x4 a = Racc[dd][et]; const int dt = 2 * wave + dd;
                *(LAS u32x2*)(Rt + (16 * et + fr) * 264 + 16 * dt + 4 * fq) = (u32x2){pk2(a[0], a[1]), pk2(a[2], a[3])}; }
    }
    int fq_l = fq; asm volatile("" : "+v"(fq_l));
    float* ro = C_OUT + O_RET_P + ((((size_t)o * 2 + b) * 6 + h) * 256) * 256 + es * 32;
#pragma unroll
    for (int dd = 0; dd < 2; ++dd)
#pragma unroll
        for (int et = 0; et < 2; ++et)
#pragma unroll
            for (int r = 0; r < 4; ++r) ro[(size_t)(16 * (2 * wave + dd) + 4 * fq_l + r) * 256 + 16 * et + fr] = Racc[dd][et][r];
    __syncthreads();
}
__device__ __forceinline__ void ret_sample_unit(const Ctx& c, int unit, int o) {
    const int n = unit / 6, h = unit % 6, tid = c.tid;
    LAS float* qs = (LAS float*)c.lds; LAS float* ks = qs + 1024; LAS float* vs = ks + 1024; LAS float* red = vs + 1024; LAS float* sc = red + 2048;
    const float lg = LG2G[h];
    for (int idx = tid; idx < 4 * 256; idx += 512) { const int t = idx >> 8, dd = idx & 255; const bf16* hr = C_HB + (size_t)(TP + n * 4 + t) * LDH + h * 256 + dd; qs[idx] = bf2f(hr[OC_Q]); ks[idx] = bf2f(hr[OC_K]); }
    for (int idx = tid; idx < 4 * 256; idx += 512) { const int t = idx >> 8, ee = idx & 255; vs[idx] = bf2f(C_HB[(size_t)(TP + n * 4 + t) * LDH + OC_V + h * 256 + ee]); }
    __syncthreads();
    if (tid < 16) { const int i = tid >> 2, j = tid & 3; float a = 0.f; for (int d = 0; d < 256; ++d) a += qs[i * 256 + d] * ks[j * 256 + d]; sc[tid] = (j <= i) ? a * exp2f(lg * (float)(i - j)) : 0.f; }
    __syncthreads();
    const int ee = tid & 255, dh = tid >> 8;
    const float* R0 = C_IN(7) + ((((size_t)o * 8 + n) * 6 + h) * 256) * 256; float* Rn = C_OUT + O_RET_S + ((((size_t)o * 8 + n) * 6 + h) * 256) * 256;
    const float g4 = exp2f(lg * 4.f), z0 = exp2f(lg * 3.f), z1 = exp2f(lg * 2.f), z2 = exp2f(lg), z3 = 1.0f;
    const float v0 = vs[ee] * z0, v1 = vs[256 + ee] * z1, v2 = vs[512 + ee] * z2, v3 = vs[768 + ee] * z3;
    float acc[4] = {0.f, 0.f, 0.f, 0.f};
#pragma unroll 1
    for (int d0 = dh * 128; d0 < dh * 128 + 128; d0 += 16) { float rv[16];
#pragma unroll
        for (int u = 0; u < 16; ++u) rv[u] = R0[(size_t)(d0 + u) * 256 + ee];
#pragma unroll
        for (int u = 0; u < 16; ++u) { const int d = d0 + u; const float r0 = rv[u];
            acc[0] += qs[d] * r0; acc[1] += qs[256 + d] * r0; acc[2] += qs[512 + d] * r0; acc[3] += qs[768 + d] * r0;
            Rn[(size_t)d * 256 + ee] = g4 * r0 + ks[d] * v0 + ks[256 + d] * v1 + ks[512 + d] * v2 + ks[768 + d] * v3; } }
#pragma unroll
    for (int i = 0; i < 4; ++i) red[(dh * 4 + i) * 256 + ee] = acc[i];
    __syncthreads();
    if (dh == 0) {
#pragma unroll
        for (int i = 0; i < 4; ++i) { float ov = (red[i * 256 + ee] + red[(4 + i) * 256 + ee]) * exp2f(lg * (float)(i + 1));
            for (int j = 0; j <= i; ++j) ov += sc[i * 4 + j] * vs[j * 256 + ee];
            C_YR[(size_t)(TP + n * 4 + i) * 1536 + h * 256 + ee] = ov; } }
    __syncthreads();
}
__device__ __forceinline__ void odd_helper_work(Ctx c, int l) {
    { pg8::Gemm g{C_XB, C_WTIN_L(l), MPAD, 4 * 256, DM}; pg8::StaticOrder S; S.init(MPAD, 4 * 256, c.G, c.bid, 0, 18); S.ex_n = 24; S.ex_pm0 = 0; S.ex_pn = 22;
        pg8::EpiBf16NP E{C_HB, LDH, C_TAB, 0, 1536};
        pg8::gemm_phase<pg8::EpiBf16NP, pg8::StaticOrder, true, true>(c.lds, g, S, E); }
    LAUNDER_C(c);
    mem_attn_all(c, l, OC_QM, OC_GM, 1536, ODD_OUT);
    LAUNDER_C(c);
    if (l < 3) convert_layer_weights(c, l + 1);
}
__device__ __forceinline__ void phase_odd_tok(Ctx c, int l) {
    const int o = l >> 1;
    if (c.G >= 256) {
        if (c.bid < 96) ret_prompt_unit(c, 12 * (c.bid & 7) + (c.bid >> 3), o);
        else { if (c.bid < 144) ret_sample_unit(c, c.bid - 96, o);
            Ctx h = c; h.bid = c.bid - 96; h.G = c.G - 96; LAUNDER_C(h); odd_helper_work(h, l); }
    } else {
        for (int it = c.bid; it < 144; it += c.G) { if (it < 96) ret_prompt_unit(c, it, o); else ret_sample_unit(c, it - 96, o); }
        LAUNDER_C(c);
        odd_helper_work(c, l);
    }
}
__device__ __forceinline__ void phase_odd_ubuild(const Ctx& c) {
    for (int R = c.bid * 8 + c.wave; R < TT; R += c.G * 8) {
#pragma unroll 1
        for (int hb = 0; hb < 6; hb += 3) {
            f32x4 ov[3]; u32x2 gw[3];
#pragma unroll
            for (int k = 0; k < 3; ++k) { const int col = (hb + k) * 256 + 4 * c.lane; ov[k] = *(const f32x4*)(C_YR + (size_t)R * 1536 + col); gw[k] = *(const u32x2*)(C_HB + (size_t)R * LDH + OC_G + col); }
#pragma unroll
            for (int k = 0; k < 3; ++k) { const int col = (hb + k) * 256 + 4 * c.lane; const f32x4 o = ov[k];
                const float ss = wave_sum(o.x * o.x + o.y * o.y + o.z * o.z + o.w * o.w); const float scl = rsqrtf(ss * (1.0f / 256.0f) + 1e-6f);
                float g[4]; unpk4(gw[k], g);
                *(u32x2*)(C_U + (size_t)R * DM + col) = (u32x2){pk2(o.x * scl * siluf_(g[0]), o.y * scl * siluf_(g[1])), pk2(o.z * scl * siluf_(g[2]), o.w * scl * siluf_(g[3]))}; }
        }
    }
}
__device__ __forceinline__ void small_outproj(const Ctx& c, int wt, int K, int l) {
    const int lane = c.lane, r = lane & 31, hl = lane >> 5, nks = K / 128;
    const bf16* ap = C_U + (size_t)(TP + r) * K + 8 * hl + c.wave * nks * 16; const bf16* bp = C_WTOUT_L(l) + (size_t)(32 * wt + r) * K + 8 * hl + c.wave * nks * 16;
    f32x16 acc;
#pragma unroll
    for (int i = 0; i < 16; ++i) acc[i] = 0.f;
    if (nks == 16) {
#pragma unroll
        for (int ks = 0; ks < 16; ++ks) acc = mfma32(*(const bf16x8*)(ap + 16 * ks), *(const bf16x8*)(bp + 16 * ks), acc);
    } else {
#pragma unroll
        for (int ks = 0; ks < 12; ++ks) acc = mfma32(*(const bf16x8*)(ap + 16 * ks), *(const bf16x8*)(bp + 16 * ks), acc);
    }
    LAS float* part = (LAS float*)c.lds;
#pragma unroll
    for (int i = 0; i < 16; ++i) part[(c.wave * 16 + i) * 64 + lane] = acc[i];
    __syncthreads();
    for (int idx = c.tid; idx < 1024; idx += 512) { float sum = 0.f;
#pragma unroll
        for (int w = 0; w < 8; ++w) sum += part[w * 1024 + idx];
        const int i = idx >> 6, ln = idx & 63, row = TP + (i & 3) + 8 * (i >> 2) + 4 * (ln >> 5), col = 32 * wt + (ln & 31);
        const float xres = (l == 0) ? C_IN(1)[(size_t)(row - TP) * DM + col] : C_XZ[(size_t)row * DM + col];
        C_Z[(size_t)row * DM + col] = xres * ALPHA + sum; }
    __syncthreads();
}
__device__ __forceinline__ void phase_ln(const Ctx& c, int l) {
    const float* g = C_IN(15) + l * DM; const float* bta = C_IN(16) + l * DM;
    f32x4 gg[8], bb[8];
#pragma unroll
    for (int j = 0; j < 8; ++j) { const int col = 4 * c.lane + 256 * j; gg[j] = *(const f32x4*)(g + col); bb[j] = *(const f32x4*)(bta + col); }
    for (int R0 = c.bid * 8 + c.wave; R0 < TT; R0 += 2 * c.G * 8) {
        const int R1 = R0 + c.G * 8; const bool has1 = R1 < TT; const int R1c = has1 ? R1 : R0;
        f32x4 v0[8], v1[8]; float s0 = 0.f, s1 = 0.f;
        { const f32x4* z0 = (const f32x4*)(C_Z + (size_t)R0 * DM) + c.lane; const f32x4* z1 = (const f32x4*)(C_Z + (size_t)R1c * DM) + c.lane;
#pragma unroll
            for (int j = 0; j < 8; ++j) { v0[j] = z0[64 * j]; v1[j] = z1[64 * j]; } }
#pragma unroll
        for (int j = 0; j < 8; ++j) { s0 += (v0[j].x + v0[j].y) + (v0[j].z + v0[j].w); s1 += (v1[j].x + v1[j].y) + (v1[j].z + v1[j].w); }
        const float m0 = wave_sum(s0) * (1.0f / DM), m1 = wave_sum(s1) * (1.0f / DM); float q0 = 0.f, q1 = 0.f;
#pragma unroll
        for (int j = 0; j < 8; ++j) { v0[j] = v0[j] - m0; v1[j] = v1[j] - m1; q0 += (v0[j].x * v0[j].x + v0[j].y * v0[j].y) + (v0[j].z * v0[j].z + v0[j].w * v0[j].w); q1 += (v1[j].x * v1[j].x + v1[j].y * v1[j].y) + (v1[j].z * v1[j].z + v1[j].w * v1[j].w); }
        const float r0 = rsqrtf(wave_sum(q0) * (1.0f / DM) + LN_EPS), r1 = rsqrtf(wave_sum(q1) * (1.0f / DM) + LN_EPS);
        float* d0 = (l == 3) ? (R0 < TP ? C_OUT + O_YP + (size_t)R0 * DM : C_OUT + O_YS + (size_t)(R0 - TP) * DM) : C_XZ + (size_t)R0 * DM;
        float* d1 = (l == 3) ? (R1c < TP ? C_OUT + O_YP + (size_t)R1c * DM : C_OUT + O_YS + (size_t)(R1c - TP) * DM) : C_XZ + (size_t)R1c * DM;
#pragma unroll
        for (int j = 0; j < 8; ++j) { const int col = 4 * c.lane + 256 * j;
            const f32x4 x0 = v0[j] * r0 * gg[j] + bb[j]; *(f32x4*)(d0 + col) = x0; if (l != 3) *(u32x2*)(C_XB + (size_t)R0 * DM + col) = (u32x2){pk2(x0.x, x0.y), pk2(x0.z, x0.w)};
            if (has1) { const f32x4 x1 = v1[j] * r1 * gg[j] + bb[j]; *(f32x4*)(d1 + col) = x1; if (l != 3) *(u32x2*)(C_XB + (size_t)R1 * DM + col) = (u32x2){pk2(x1.x, x1.y), pk2(x1.z, x1.w)}; } }
    }
}

#define XB_TMO      128
#define XB_XCNT(j)  (256  + 64 * (j))
#define XB_XSUB(j)  (1280 + 64 * (j))
#define XB_XGEN(j)  (2304 + 64 * (j))
#define XB_TOP      3328
#define XB_TOPGEN   3392
#define XCD_BAR_WORDS 3456
#define XB_SPIN_CAP (1u << 18)

__device__ __forceinline__ unsigned xb_ld(unsigned* p)              { return __hip_atomic_load(p, __ATOMIC_RELAXED, __HIP_MEMORY_SCOPE_AGENT); }
__device__ __forceinline__ unsigned xb_add(unsigned* p, unsigned v) { return __hip_atomic_fetch_add(p, v, __ATOMIC_RELAXED, __HIP_MEMORY_SCOPE_AGENT); }
__device__ __forceinline__ unsigned xb_xcc_id() { return (unsigned)__builtin_amdgcn_s_getreg((3 << 11) | 20) & 0xFu; }
#define XB_SPIN(cond, bar) do { unsigned _sp = 0; while (cond) { __builtin_amdgcn_s_sleep(1); \
    if ((++_sp & 255u) == 0u) { if (xb_ld(&(bar)[XB_TMO])) break; if (_sp > XB_SPIN_CAP) { atomicAdd(&(bar)[XB_TMO], 1u); break; } } } } while (0)

struct XcdBarrier {
    unsigned* bar; unsigned x;
    volatile LAS unsigned* st;
};

__device__ __forceinline__ XcdBarrier xcd_barrier_post(unsigned* bar, volatile LAS unsigned* st) {
    XcdBarrier b; b.bar = bar; b.x = xb_xcc_id(); b.st = st;
    if (threadIdx.x == 0) (void)xb_add(&bar[XB_XCNT(b.x)], 1u);
    return b;
}
__device__ __forceinline__ void xcd_barrier_complete(unsigned* bar, unsigned x, unsigned& nloc, unsigned& nx) {
    const unsigned G = gridDim.x * gridDim.y * gridDim.z;
    unsigned sum, cnt, mine, sp = 0u;
    for (;;) {
        sum = 0u; cnt = 0u; mine = 0u;
#pragma unroll
        for (unsigned j = 0; j < 16; ++j) { const unsigned c = xb_ld(&bar[XB_XCNT(j)]); sum += c; cnt += (c > 0u) ? 1u : 0u; mine = (j == x) ? c : mine; }
        if (sum == G) break;
        __builtin_amdgcn_s_sleep(1);
        if ((++sp & 255u) == 0u) { if (xb_ld(&bar[XB_TMO])) break; if (sp > XB_SPIN_CAP) { atomicAdd(&bar[XB_TMO], 1u); break; } }
    }
    nloc = mine > 0u ? mine : 1u; nx = cnt > 0u ? cnt : 1u;
}

__device__ __forceinline__ void xcd_barrier(const XcdBarrier& b) {
    asm volatile("s_waitcnt vmcnt(0)" ::: "memory");
    __syncthreads();
    if (threadIdx.x == 0) {
        unsigned* bar = b.bar;
        __builtin_amdgcn_s_waitcnt(0);
        unsigned nloc = b.st[0], nx = b.st[1];
        if (nloc == 0u) { xcd_barrier_complete(bar, b.x, nloc, nx); b.st[0] = nloc; b.st[1] = nx; }
        const unsigned old = xb_add(&bar[XB_XSUB(b.x)], 1u);
        const unsigned gen = old / nloc;
        if (old + 1u == (gen + 1u) * nloc) {
            __builtin_amdgcn_fence(__ATOMIC_RELEASE, "agent");
            asm volatile("s_waitcnt vmcnt(0)" ::: "memory");
            const unsigned og = xb_add(&bar[XB_TOP], 1u);
            const unsigned tg = og / nx;
            if (og + 1u == (tg + 1u) * nx) xb_add(&bar[XB_TOPGEN], 1u);
            else XB_SPIN(xb_ld(&bar[XB_TOPGEN]) == tg, bar);
            __builtin_amdgcn_fence(__ATOMIC_ACQUIRE, "agent");
            xb_add(&bar[XB_XGEN(b.x)], 1u);
            asm volatile("s_waitcnt vmcnt(0)" ::: "memory");
        } else {
            XB_SPIN(xb_ld(&bar[XB_XGEN(b.x)]) == gen, bar);
            __builtin_amdgcn_fence(__ATOMIC_ACQUIRE, "agent");
            asm volatile("s_waitcnt vmcnt(0)" ::: "memory");
        }
    }
    __syncthreads();
}

constexpr int NPH = 25;
__global__ void __launch_bounds__(512, 2) mk(Args args) {
    extern __shared__ __attribute__((aligned(16))) unsigned char lds_raw[];
    Ctx c;
    c.ap = (ArgsP)__builtin_amdgcn_kernarg_segment_ptr(); c.lds = (LAS unsigned char*)lds_raw;
    c.tid = threadIdx.x; c.lane = c.tid & 63; c.wave = __builtin_amdgcn_readfirstlane(c.tid >> 6); c.bid = blockIdx.x; c.G = gridDim.x;
    for (int u = c.tid; u < 16; u += 512) ((LAS unsigned*)(c.lds + XB_LDS_OFF))[u] = 0u;
    __syncthreads();
    XcdBarrier xbar = xcd_barrier_post((unsigned*)(c.ap->ws + WS_CTL) + 4096, (volatile LAS unsigned*)(c.lds + XB_LDS_OFF));
#define LAUNDER() do { asm volatile("" : "+s"(c.ap), "+v"(c.tid), "+s"(c.bid), "+s"(c.G)); c.lane = c.tid & 63; c.wave = __builtin_amdgcn_readfirstlane(c.tid >> 6); } while (0)
    const int lo = args.ph_lo, hi = args.ph_hi;
#define IN(k) (lo <= (k) && (k) < hi)
#if USE_CG
#define SEAM(k) do { if (IN(k) && IN((k) + 1)) { cg::this_grid().sync(); } } while (0)
#else
#define SEAM(k) do { if (IN(k) && IN((k) + 1)) { asm volatile("" : "+s"(xbar.bar)); xcd_barrier(xbar); } } while (0)
#endif
    #if !(DIS & 1)
    if (IN(0)) { for (int rep = 0; rep < ((DUP & 128) ? 2 : 1); ++rep) { LAUNDER(); phase_prologue(c); if (DUP & 128) { asm volatile("" : "+s"(xbar.bar)); xcd_barrier(xbar); } } }
#endif
    SEAM(0);
#pragma unroll 1
    for (int l = 0; l < 4; ++l) {
        const int p0 = 1 + 6 * l; const bool even = (l & 1) == 0;
#if !(DIS & 2)
        if (IN(p0)) { for (int rep = 0; rep < ((DUP & 16) ? 2 : 1); ++rep) { LAUNDER();
            { const int NI = even ? EVEN_INP : ODD_IN; const bool full = (c.G != 256);
                const int Ng = full ? NI : (even ? 23 * 256 : NI - 5 * 256);
                pg8::Gemm g{C_XB, C_WTIN_L(l), MPAD, Ng, DM}; pg8::StaticOrder S; S.init(MPAD, Ng, c.G, c.bid, (!even && !full) ? 18 : (1 << 30), (!even && !full) ? 5 : 0);
                if (!full) { S.ex_n = 9; S.ex_pm0 = even ? 0 : 24; S.ex_pn = even ? 23 : 22; }
                pg8::EpiBf16NP E{C_HB, LDH, C_TAB, even ? 0 : 3072, 1536};
                pg8::gemm_phase<pg8::EpiBf16NP, pg8::StaticOrder, true, true>(c.lds, g, S, E);
            }
            if (DUP & 16) { asm volatile("" : "+s"(xbar.bar)); xcd_barrier(xbar); }
        } }
#endif
        SEAM(p0);
#if !(DIS & 4)
        if (IN(p0 + 1)) { for (int rep = 0; rep < ((DUP & 1) ? 2 : 1); ++rep) { LAUNDER(); if (even) phase_even_tok_pre(c, l); if (DUP & 1) { asm volatile("" : "+s"(xbar.bar)); xcd_barrier(xbar); } } }
#endif
#if !(DIS & 8)
        if (IN(p0 + 1)) { LAUNDER(); if (!even) { for (int it = c.bid; it < 768; it += c.G) ret_s_prepass_item(c, it); } }
#endif
        SEAM(p0 + 1);
#if !(DIS & 16)
        if (IN(p0 + 2)) { for (int rep = 0; rep < ((DUP & 4) ? 2 : 1); ++rep) { LAUNDER(); if (even) phase_even_scan(c, l); if (DUP & 4) { asm volatile("" : "+s"(xbar.bar)); xcd_barrier(xbar); } } }
#if !(DIS & 8)
        if (IN(p0 + 2)) { for (int rep = 0; rep < ((DUP & 2) ? 2 : 1); ++rep) { LAUNDER(); if (!even) phase_odd_tok(c, l); if (DUP & 2) { asm volatile("" : "+s"(xbar.bar)); xcd_barrier(xbar); } } }
#endif
#endif
        SEAM(p0 + 2);
#if !(DIS & 32)
        if (IN(p0 + 3)) { for (int rep = 0; rep < ((DUP & 8) ? 2 : 1); ++rep) { LAUNDER(); if (even) { phase_even_ubuild(c, l); LAUNDER(); even_combine_dil(c); } else phase_odd_ubuild(c); if (DUP & 8) { asm volatile("" : "+s"(xbar.bar)); xcd_barrier(xbar); } } }
#endif
        SEAM(p0 + 3);
#if !(DIS & 64)
        if (IN(p0 + 4)) { for (int rep = 0; rep < ((DUP & 32) ? 2 : 1); ++rep) { LAUNDER(); const int K = even ? EVEN_OUT : ODD_OUT;
            pg8::Gemm g{C_U, C_WTOUT_L(l), TP, DM, K}; pg8::StaticOrder S; S.init(TP, DM, c.G, c.bid); pg8::EpiResid E{(l == 0) ? C_IN(0) : C_XZ, C_Z, DM, ALPHA};
            pg8::gemm_phase<pg8::EpiResid, pg8::StaticOrder, true, true>(c.lds, g, S, E);
            LAUNDER(); if (c.bid < 64) small_outproj(c, c.bid, K, l); if (DUP & 32) { asm volatile("" : "+s"(xbar.bar)); xcd_barrier(xbar); } } }
#endif
        SEAM(p0 + 4);
#if !(DIS & 128)
        if (IN(p0 + 5)) { for (int rep = 0; rep < ((DUP & 64) ? 2 : 1); ++rep) { LAUNDER(); phase_ln(c, l); if (DUP & 64) { asm volatile("" : "+s"(xbar.bar)); xcd_barrier(xbar); } } }
#endif
        SEAM(p0 + 5);
    }
#undef IN
#undef SEAM
}

extern "C" void kernel_launch(void* const* d_in, const int* in_sizes, int n_in, void* d_out, int out_size, void* d_ws, size_t ws_size, hipStream_t stream) {
    static int grid = 0;
    if (grid == 0) {
        if (n_in != 27 || (size_t)out_size != O_END || ws_size < WS_END) { fprintf(stderr, "kernel_launch: unexpected shapes: n_in %d out %d ws %zu (need %zu)\n", n_in, out_size, ws_size, (size_t)WS_END); grid = -1; return; }
        int dev = 0, cus = 0, per_cu = 0;
        hipGetDevice(&dev); hipDeviceGetAttribute(&cus, hipDeviceAttributeMultiprocessorCount, dev);
        if (hipFuncSetAttribute((const void*)mk, hipFuncAttributeMaxDynamicSharedMemorySize, LDS_BYTES) != hipSuccess) { fprintf(stderr, "kernel_launch: hipFuncSetAttribute failed\n"); grid = -1; return; }
        if (hipOccupancyMaxActiveBlocksPerMultiprocessor(&per_cu, (const void*)mk, 512, LDS_BYTES) != hipSuccess || per_cu < 1) { fprintf(stderr, "kernel_launch: occupancy query says %d\n", per_cu); per_cu = 1; }
        (void)hipGetLastError();
        grid = cus;
        fprintf(stderr, "kernel_launch: grid %d (cus %d, per_cu %d)\n", grid, cus, per_cu);
    }
    if (grid < 0) return;
    if (hipMemsetAsync((char*)d_ws + WS_CTL, 0, 1u << 20, stream) != hipSuccess) { fprintf(stderr, "kernel_launch: memset failed\n"); return; }
    Args a{};
    for (int i = 0; i < 27; ++i) a.in[i] = (const float*)d_in[i];
    a.out = (float*)d_out; a.ws = (unsigned char*)d_ws;
#if ONE_LAUNCH
    a.ph_lo = 0; a.ph_hi = NPH;
    void* kargs[] = {&a};
    hipError_t e = hipLaunchCooperativeKernel((const void*)mk, dim3(grid), dim3(512), kargs, LDS_BYTES, stream);
    if (e != hipSuccess) fprintf(stderr, "kernel_launch: cooperative launch failed: %s\n", hipGetErrorString(e));
#else
    for (int p = 0; p < NPH; ++p) {
        if (p >= 1 && ((p - 1) % 6) == 2 && (((p - 1) / 6) & 1)) continue;
        a.ph_lo = p; a.ph_hi = p + 1;
        hipLaunchKernelGGL(mk, dim3(grid), dim3(512), LDS_BYTES, stream, a);
    }
#endif
}
```

```cpp
#include <hip/hip_runtime.h>
#include <hip/hip_cooperative_groups.h>
#include <cstdio>
#include <cstdint>
namespace cg = cooperative_groups;
#ifndef DIS
#define DIS 0
#endif
#ifndef REPE
#define REPE 1
#endif
#ifndef REPD
#define REPD 1
#endif
#ifndef REPM
#define REPM 1
#endif
#ifndef REPC
#define REPC 1
#endif
#ifndef REPS
#define REPS 1
#endif
#ifndef REP9
#define REP9 1
#endif
#ifndef REP3
#define REP3 1
#endif
#ifndef REP8
#define REP8 1
#endif
#ifndef REP1
#define REP1 1
#endif
#ifndef DUP
#define DUP 0
#endif
#ifndef USE_CG
#define USE_CG 0
#endif
#ifndef ONE_LAUNCH
#define ONE_LAUNCH 1
#endif
namespace pg8 {
#define PG8_LAS __attribute__((address_space(3)))
typedef unsigned short bf16_t;
typedef short bf16x8 __attribute__((ext_vector_type(8)));
typedef float f32x4 __attribute__((ext_vector_type(4)));
typedef unsigned u32x4 __attribute__((ext_vector_type(4)));
constexpr int BM = 256, BK = 64, HALF = 128, HTB = HALF * BK * 2  , STAGE_BYTES = 8 * HTB, NXCD = 8, WGM = 4;

__host__ __device__ __forceinline__ int lds_byte(int r, int c) { const int st = (r >> 4) * 2 + (c >> 5), rr = r & 15, cc = c & 31, ob = rr * 64 + cc * 2; return st * 1024 + (ob ^ (((ob >> 9) & 1) << 5)); }
__host__ __device__ __forceinline__ void stage_rc(int b, int& R, int& C) { const int st = b / 1024, sb = b % 1024, swz = sb ^ (((sb >> 9) & 1) << 5); R = (st >> 1) * 16 + swz / 64; C = (st & 1) * 32 + (swz % 64) / 2; }
__host__ __device__ __forceinline__ int perm32(int rho) { const int n = rho >> 4, i = rho & 15; return 8 * (i >> 2) + 4 * n + (i & 3); }

struct Unit { int pm, pn; };
struct Gemm { const bf16_t* A; const bf16_t* Bt; int M, N, K; };

struct StaticOrder {
    int nM, nN, nwg, G, c, skip_from, skip_n, ex_n, ex_pm0, ex_pn;
    __host__ __device__ void init(int M, int N, int G_, int c_, int sf = 1 << 30, int sn = 0) { nM = M / BM; nN = N / BM; nwg = nM * nN; G = G_; c = c_; skip_from = sf; skip_n = sn; ex_n = 0; ex_pm0 = 0; ex_pn = 0; }
    __host__ __device__ bool next(int i, Unit& u) const {
        const long L = (long)i * G + c; if (L >= nwg + ex_n) return false;
        if (L >= nwg) { u.pm = ex_pm0 + (int)(L - nwg); u.pn = ex_pn; return true; }
        int wgid = (int)L; { const int q = nwg / NXCD, r = nwg % NXCD, xcd = wgid % NXCD, off = wgid / NXCD; wgid = (xcd < r ? xcd * (q + 1) : r * (q + 1) + (xcd - r) * q) + off; }
        const int nig = WGM * nN, gid = wgid / nig, fm = gid * WGM, gsz = (nM - fm) < WGM ? (nM - fm) : WGM;
        u.pm = fm + ((wgid % nig) % gsz); u.pn = (wgid % nig) / gsz; if (u.pn >= skip_from) u.pn += skip_n; return true;
    }
    __device__ __forceinline__ void a_ready(const Unit&) const {}
    __device__ __forceinline__ void done(const Unit&) const {}
};

__device__ __forceinline__ unsigned cvt_pk_bf16(float lo, float hi) { unsigned r; asm volatile("v_cvt_pk_bf16_f32 %0, %1, %2" : "=v"(r) : "v"(lo), "v"(hi)); return r; }
typedef float f32x2 __attribute__((ext_vector_type(2)));
__device__ __forceinline__ f32x2 gelu_pk(f32x2 v) {
    const f32x2 av = __builtin_elementwise_abs(v), d = av * 0.2316418882f + 1.0f;
    f32x2 t; t.x = __builtin_amdgcn_rcpf(d.x); t.y = __builtin_amdgcn_rcpf(d.y);
    f32x2 q = t * 0.5307027145f + (-0.7265760135f); q = q * t + 0.7107068705f; q = q * t + (-0.142248368f); q = q * t + 0.127414796f; q = q * t;
    const f32x2 s = (v * v) * (-0.72134752044f);
    f32x2 e; e.x = __builtin_amdgcn_exp2f(s.x); e.y = __builtin_amdgcn_exp2f(s.y);
    const f32x2 m = v * (q * e), r = v - m;
    f32x2 o; o.x = v.x < 0.f ? m.x : r.x; o.y = v.y < 0.f ? m.y : r.y; return o;
}

template <int ACT  > struct EpiBf16 {
    static constexpr bool PERM = true, AFTER_DRAIN = false; static_assert(ACT == 0 || ACT == 1, "EpiBf16: ACT is 0 (none) or 1 (gelu_pk)");
    bf16_t* O; int ldc; const float* bias; int split_cols; size_t split_stride; float scale0;
    __device__ __forceinline__ void operator()(const f32x4 (&acc)[2][2][4][2], const Unit& u, int wr, int wc, int fr, int fq) const {
        const int row0 = u.pm * BM + wr * 64 + fr; int colt = u.pn * BM; bf16_t* base = O;
        float sc = 1.f; if (split_cols) { const int t = colt / split_cols; base += (size_t)t * split_stride; colt -= t * split_cols; if (t == 0) sc = scale0; }
        const int col0 = colt + wc * 32 + 8 * fq, bcol0 = u.pn * BM + wc * 32 + 8 * fq;
        f32x4 bv[2][2];
#pragma unroll
        for (int bj = 0; bj < 2; ++bj)
#pragma unroll
            for (int n = 0; n < 2; ++n) bv[bj][n] = bias ? *(const f32x4*)(bias + bcol0 + bj * HALF + 4 * n) : (f32x4){0.f, 0.f, 0.f, 0.f};
#pragma unroll
        for (int ai = 0; ai < 2; ++ai)
#pragma unroll
            for (int m = 0; m < 4; ++m) { bf16_t* rowp = base + (size_t)(row0 + ai * HALF + m * 16) * ldc + col0;
#pragma unroll
                for (int bj = 0; bj < 2; ++bj) { f32x4 v0 = acc[ai][bj][m][0] + bv[bj][0], v1 = acc[ai][bj][m][1] + bv[bj][1];
                    if (ACT == 1) { f32x2 a = gelu_pk((f32x2){v0[0], v0[1]}), b = gelu_pk((f32x2){v0[2], v0[3]}), c = gelu_pk((f32x2){v1[0], v1[1]}), d = gelu_pk((f32x2){v1[2], v1[3]});
                        v0 = (f32x4){a.x, a.y, b.x, b.y}; v1 = (f32x4){c.x, c.y, d.x, d.y}; }
                    v0 = v0 * sc; v1 = v1 * sc; u32x4 w; w.x = cvt_pk_bf16(v0[0], v0[1]); w.y = cvt_pk_bf16(v0[2], v0[3]); w.z = cvt_pk_bf16(v1[0], v1[1]); w.w = cvt_pk_bf16(v1[2], v1[3]);
                    *(u32x4*)(rowp + bj * HALF) = w; } }
    }
};
struct EpiF32Split {
    static constexpr bool PERM = false, AFTER_DRAIN = false;
    float* C; int ldc; int split_cols; size_t split_stride; bf16_t* MB;
    __device__ __forceinline__ void operator()(const f32x4 (&acc)[2][2][4][2], const Unit& u, int wr, int wc, int fr, int fq) const {
        typedef unsigned u32x2v __attribute__((ext_vector_type(2)));
        int colt = u.pn * BM; float* base = C; bf16_t* mb = MB;
        if (split_cols) { const int t = colt / split_cols; base += (size_t)t * split_stride; mb += (size_t)t * split_stride; colt -= t * split_cols; }
        const int row0 = u.pm * BM + wr * 64 + fr, col0 = colt + wc * 32 + 4 * fq;
#pragma unroll
        for (int ai = 0; ai < 2; ++ai)
#pragma unroll
            for (int m = 0; m < 4; ++m) { float* rowp = base + (size_t)(row0 + ai * HALF + m * 16) * ldc + col0; bf16_t* rowb = mb + (size_t)(row0 + ai * HALF + m * 16) * ldc + col0;
#pragma unroll
                for (int bj = 0; bj < 2; ++bj)
#pragma unroll
                    for (int n = 0; n < 2; ++n) { const f32x4 v = acc[ai][bj][m][n]; *(f32x4*)(rowp + bj * HALF + n * 16) = v;
                        u32x2v w; w.x = cvt_pk_bf16(v[0], v[1]); w.y = cvt_pk_bf16(v[2], v[3]); *(u32x2v*)(rowb + bj * HALF + n * 16) = w; } }
    }
};
struct EpiBf16NP {
    static constexpr bool PERM = true, AFTER_DRAIN = false;
    bf16_t* O; int ldc; const float* TAB; int rot_cols, kcol0;
    __device__ __forceinline__ void operator()(const f32x4 (&acc)[2][2][4][2], const Unit& u, int wr, int wc, int fr, int fq) const {
        const int row0 = u.pm * BM + wr * 64 + fr, col0 = u.pn * BM + wc * 32 + 8 * fq;
        const bool rot = u.pn * BM < rot_cols; const float scl = (u.pn * BM >= kcol0) ? 0.0625f : 1.0f;
#pragma unroll
        for (int ai = 0; ai < 2; ++ai)
#pragma unroll
            for (int m = 0; m < 4; ++m) { const int row = row0 + ai * HALF + m * 16; bf16_t* rowp = O + (size_t)row * ldc + col0;
                const int p = row < 8192 ? (row & 4095) : (row < 8224 ? 4096 + ((row - 8192) & 3) : 0);
                const float* tb = TAB + ((size_t)p * 128 + ((col0 & 255) >> 1)) * 2;
#pragma unroll
                for (int bj = 0; bj < 2; ++bj) { f32x4 v0 = acc[ai][bj][m][0], v1 = acc[ai][bj][m][1];
                    if (rot) { const f32x4 c0 = *(const f32x4*)(tb + bj * HALF), c1 = *(const f32x4*)(tb + bj * HALF + 4);
                        v0 = (f32x4){(v0[0] * c0[0] - v0[1] * c0[1]) * scl, (v0[1] * c0[0] + v0[0] * c0[1]) * scl, (v0[2] * c0[2] - v0[3] * c0[3]) * scl, (v0[3] * c0[2] + v0[2] * c0[3]) * scl};
                        v1 = (f32x4){(v1[0] * c1[0] - v1[1] * c1[1]) * scl, (v1[1] * c1[0] + v1[0] * c1[1]) * scl, (v1[2] * c1[2] - v1[3] * c1[3]) * scl, (v1[3] * c1[2] + v1[2] * c1[3]) * scl}; }
                    u32x4 w; w.x = cvt_pk_bf16(v0[0], v0[1]); w.y = cvt_pk_bf16(v0[2], v0[3]); w.z = cvt_pk_bf16(v1[0], v1[1]); w.w = cvt_pk_bf16(v1[2], v1[3]);
                    *(u32x4*)(rowp + bj * HALF) = w; } }
    }
};
struct EpiResid {
    static constexpr bool PERM = true, AFTER_DRAIN = false;
    const bf16_t* __restrict__ X; bf16_t* __restrict__ Z; int ldc; float alpha;
    __device__ __forceinline__ void operator()(const f32x4 (&acc)[2][2][4][2], const Unit& u, int wr, int wc, int fr, int fq) const {
        const int row0 = u.pm * BM + wr * 64 + fr, col0 = u.pn * BM + wc * 32 + 8 * fq;
#pragma unroll
        for (int ai = 0; ai < 2; ++ai) { u32x4 xv[4][2];
#pragma unroll
            for (int m = 0; m < 4; ++m)
#pragma unroll
                for (int bj = 0; bj < 2; ++bj) xv[m][bj] = *(const u32x4*)(X + (size_t)(row0 + ai * HALF + m * 16) * ldc + col0 + bj * HALF);
#pragma unroll
            for (int m = 0; m < 4; ++m)
#pragma unroll
                for (int bj = 0; bj < 2; ++bj) { const u32x4 xw = xv[m][bj]; const f32x4 v0 = acc[ai][bj][m][0], v1 = acc[ai][bj][m][1]; u32x4 w;
                    w.x = cvt_pk_bf16(__uint_as_float(xw.x << 16) * alpha + v0[0], __uint_as_float(xw.x & 0xffff0000u) * alpha + v0[1]); w.y = cvt_pk_bf16(__uint_as_float(xw.y << 16) * alpha + v0[2], __uint_as_float(xw.y & 0xffff0000u) * alpha + v0[3]);
                    w.z = cvt_pk_bf16(__uint_as_float(xw.z << 16) * alpha + v1[0], __uint_as_float(xw.z & 0xffff0000u) * alpha + v1[1]); w.w = cvt_pk_bf16(__uint_as_float(xw.w << 16) * alpha + v1[2], __uint_as_float(xw.w & 0xffff0000u) * alpha + v1[3]);
                    *(u32x4*)(Z + (size_t)(row0 + ai * HALF + m * 16) * ldc + col0 + bj * HALF) = w; } }
    }
};
template <class Epi, class Sched, bool ALIGN_EPI = false, bool SP2 = false>
__device__ __forceinline__ void gemm_phase(PG8_LAS unsigned char* lds, const Gemm g, const Sched& S, const Epi& E) {
    int tid_ = threadIdx.x; asm volatile("" : "+v"(tid_));
    const int tid = tid_, wid = __builtin_amdgcn_readfirstlane(tid >> 6), lane = tid & 63, wr = wid >> 2, wc = wid & 3, fr = lane & 15, fq = lane >> 4;
    const int K = g.K, nt = K / BK;
    unsigned voffA[2], voffB[2];
#pragma unroll
    for (int i = 0; i < 2; ++i) { int R, C; stage_rc(tid * 16 + i * 8192, R, C); const int Rb = Epi::PERM ? ((R & ~31) + perm32(R & 31)) : R;
        voffA[i] = (unsigned)(R * K + C) * 2u; voffB[i] = (unsigned)(Rb * K + C) * 2u; }
    const size_t kstep = (size_t)(BK * 2);
    const size_t hstep = (size_t)HALF * K * 2;
    const size_t tstep = 2 * hstep;
    const unsigned ldsw = (unsigned)wid * 1024u;
    const int aoff = lds_byte(wr * 64 + fr, fq * 8), boff = lds_byte(wc * 32 + fr, fq * 8);
#define PG8_SA(b, h) (((b) * 2 + (h)) * HTB)
#define PG8_SB(b, h) ((4 + (b) * 2 + (h)) * HTB)
#define PG8_STAGE(bufoff, gbase, voff) do { _Pragma("unroll") for (int _i = 0; _i < 2; ++_i) \
        __builtin_amdgcn_global_load_lds((const unsigned*)((const char*)(gbase) + (voff)[_i]), (PG8_LAS unsigned*)(lds + (bufoff) + ldsw + _i * 8192), 16, 0, 0); } while (0)
#define PG8_LDA(dst, b, h) do { _Pragma("unroll") for (int m = 0; m < 4; ++m) _Pragma("unroll") for (int k = 0; k < 2; ++k) dst[m][k] = *(const PG8_LAS bf16x8*)(lds + PG8_SA(b, h) + aoff + m * 2048 + k * 1024); } while (0)
#define PG8_LDB(dst, b, h) do { _Pragma("unroll") for (int n = 0; n < 2; ++n) _Pragma("unroll") for (int k = 0; k < 2; ++k) dst[n][k] = *(const PG8_LAS bf16x8*)(lds + PG8_SB(b, h) + boff + n * 2048 + k * 1024); } while (0)
#define PG8_MMA(ai, bj, At, Bt) do { __builtin_amdgcn_s_setprio(1); _Pragma("unroll") for (int m = 0; m < 4; ++m) _Pragma("unroll") for (int n = 0; n < 2; ++n) _Pragma("unroll") for (int k = 0; k < 2; ++k) \
        acc[ai][bj][m][n] = __builtin_amdgcn_mfma_f32_16x16x32_bf16(Bt[n][k], At[m][k], acc[ai][bj][m][n], 0, 0, 0); __builtin_amdgcn_s_setprio(0); } while (0)
#define PG8_WAIT_V(n) asm volatile("s_waitcnt vmcnt(" #n ")" ::: "memory")
#define PG8_WAIT_L(n) asm volatile("s_waitcnt lgkmcnt(" #n ")" ::: "memory")
#define PG8_BAR __builtin_amdgcn_s_barrier()
#define PG8_SCHED __builtin_amdgcn_sched_barrier(0)
    Unit cur, nxt; int ui = 0;
    if (!S.next(0, cur)) return;
    f32x4 acc[2][2][4][2];
#pragma unroll
    for (int a = 0; a < 2; ++a)
#pragma unroll
        for (int b = 0; b < 2; ++b)
#pragma unroll
            for (int m = 0; m < 4; ++m)
#pragma unroll
                for (int n = 0; n < 2; ++n) acc[a][b][m][n] = (f32x4){0.f, 0.f, 0.f, 0.f};
    bf16x8 At[4][2], B0[2][2], B1[2][2];
    const char* cA = (const char*)g.A + (size_t)cur.pm * tstep; const char* cB = (const char*)g.Bt + (size_t)cur.pn * tstep;
    S.a_ready(cur);
    if constexpr (SP2) {
        PG8_STAGE(PG8_SB(0, 0), cB, voffB); PG8_STAGE(PG8_SB(0, 1), cB + hstep, voffB); PG8_STAGE(PG8_SA(0, 0), cA, voffA); PG8_STAGE(PG8_SA(0, 1), cA + hstep, voffA);
        if (wr == 1) PG8_BAR;
        PG8_WAIT_V(2); PG8_BAR;
        PG8_STAGE(PG8_SB(1, 0), cB + kstep, voffB); PG8_STAGE(PG8_SA(1, 0), cA + kstep, voffA); PG8_STAGE(PG8_SB(1, 1), cB + hstep + kstep, voffB);
        PG8_WAIT_V(6); PG8_BAR;
    } else {
        PG8_STAGE(PG8_SB(0, 0), cB, voffB); PG8_STAGE(PG8_SA(0, 0), cA, voffA); PG8_STAGE(PG8_SB(0, 1), cB + hstep, voffB); PG8_STAGE(PG8_SA(0, 1), cA + hstep, voffA);
        if (wr == 1) PG8_BAR;
        PG8_WAIT_V(4); PG8_BAR;
        PG8_STAGE(PG8_SB(1, 0), cB + kstep, voffB); PG8_STAGE(PG8_SA(1, 0), cA + kstep, voffA); PG8_STAGE(PG8_SB(1, 1), cB + hstep + kstep, voffB);
        PG8_WAIT_V(6); PG8_BAR;
    }
    for (;;) {
        const bool has_next = S.next(ui + 1, nxt);
        const char* nA = has_next ? (const char*)g.A + (size_t)nxt.pm * tstep : cA; const char* nB = has_next ? (const char*)g.Bt + (size_t)nxt.pn * tstep : cB;
        for (int t = 0; t < nt; t += 2) {
            const bool last = (t == nt - 2);
            const char* a1 = cA + (size_t)(t + 1) * kstep;
            const char* a2 = last ? nA : cA + (size_t)(t + 2) * kstep; const char* b2 = last ? nB : cB + (size_t)(t + 2) * kstep;
            const char* a3 = a2 + kstep; const char* b3 = b2 + kstep;
            if (last && has_next) S.a_ready(nxt);
            if constexpr (SP2) {
            PG8_LDB(B0, 0, 0); PG8_LDB(B1, 0, 1); PG8_SCHED; PG8_LDA(At, 0, 0); PG8_STAGE(PG8_SA(1, 1), a1 + hstep, voffA);
            PG8_WAIT_V(8); PG8_WAIT_L(0); PG8_BAR; PG8_MMA(0, 0, At, B0); PG8_MMA(0, 1, At, B1); PG8_BAR; PG8_SCHED;
            PG8_LDA(At, 0, 1); PG8_STAGE(PG8_SB(0, 0), b2, voffB); PG8_STAGE(PG8_SB(0, 1), b2 + hstep, voffB); PG8_STAGE(PG8_SA(0, 0), a2, voffA);
            PG8_WAIT_V(8); PG8_WAIT_L(0); PG8_BAR; PG8_MMA(1, 0, At, B0); PG8_MMA(1, 1, At, B1); PG8_BAR; PG8_SCHED;
            PG8_LDB(B0, 1, 0); PG8_LDB(B1, 1, 1); PG8_SCHED; PG8_LDA(At, 1, 0); PG8_STAGE(PG8_SA(0, 1), a2 + hstep, voffA);
            PG8_WAIT_V(8); PG8_WAIT_L(0); PG8_BAR; PG8_MMA(0, 0, At, B0); PG8_MMA(0, 1, At, B1); PG8_BAR; PG8_SCHED;
            PG8_LDA(At, 1, 1); PG8_STAGE(PG8_SB(1, 0), b3, voffB); PG8_STAGE(PG8_SB(1, 1), b3 + hstep, voffB); PG8_STAGE(PG8_SA(1, 0), a3, voffA);
            PG8_WAIT_V(8); PG8_WAIT_L(0); PG8_BAR; PG8_MMA(1, 0, At, B0); PG8_MMA(1, 1, At, B1); PG8_BAR; PG8_SCHED;
            } else {
            PG8_LDB(B0, 0, 0); PG8_SCHED; PG8_LDA(At, 0, 0); PG8_STAGE(PG8_SA(1, 1), a1 + hstep, voffA);
            PG8_WAIT_L(8); PG8_BAR; PG8_WAIT_L(0); PG8_MMA(0, 0, At, B0); PG8_BAR; PG8_SCHED;
            PG8_LDB(B1, 0, 1); PG8_STAGE(PG8_SB(0, 0), b2, voffB);
            PG8_BAR; PG8_WAIT_L(0); PG8_MMA(0, 1, At, B1); PG8_BAR;
            PG8_LDA(At, 0, 1); PG8_STAGE(PG8_SA(0, 0), a2, voffA);
            PG8_BAR; PG8_WAIT_L(0); PG8_MMA(1, 0, At, B0); PG8_BAR; PG8_SCHED;
            PG8_STAGE(PG8_SB(0, 1), b2 + hstep, voffB);
            PG8_WAIT_V(6); PG8_BAR; PG8_MMA(1, 1, At, B1); PG8_BAR;
            PG8_LDB(B0, 1, 0); PG8_SCHED; PG8_LDA(At, 1, 0); PG8_STAGE(PG8_SA(0, 1), a2 + hstep, voffA);
            PG8_WAIT_L(8); PG8_BAR; PG8_WAIT_L(0); PG8_MMA(0, 0, At, B0); PG8_BAR; PG8_SCHED;
            PG8_LDB(B1, 1, 1); PG8_STAGE(PG8_SB(1, 0), b3, voffB);
            PG8_BAR; PG8_WAIT_L(0); PG8_MMA(0, 1, At, B1); PG8_BAR;
            PG8_LDA(At, 1, 1); PG8_STAGE(PG8_SA(1, 0), a3, voffA);
            PG8_BAR; PG8_WAIT_L(0); PG8_MMA(1, 0, At, B0); PG8_BAR; PG8_SCHED;
            PG8_STAGE(PG8_SB(1, 1), b3 + hstep, voffB);
            PG8_WAIT_V(6); PG8_BAR; PG8_MMA(1, 1, At, B1); PG8_BAR;
            }
        }
        if constexpr (ALIGN_EPI) { if (wr == 0) PG8_BAR; }
        if constexpr (!Epi::AFTER_DRAIN) { for (int rpe_ = 0; rpe_ < REPE; ++rpe_) { E(acc, cur, wr, wc, fr, fq); asm volatile("" ::: "memory"); } S.done(cur); }
        if (!has_next) break;
#pragma unroll
        for (int a = 0; a < 2; ++a)
#pragma unroll
            for (int b = 0; b < 2; ++b)
#pragma unroll
                for (int m = 0; m < 4; ++m)
#pragma unroll
                    for (int n = 0; n < 2; ++n) acc[a][b][m][n] = (f32x4){0.f, 0.f, 0.f, 0.f};
        cur = nxt; cA = nA; cB = nB; ++ui;
        if constexpr (ALIGN_EPI) { if (wr == 1) PG8_BAR; }
    }
    PG8_WAIT_V(0);
    if constexpr (!ALIGN_EPI) { if (wr == 0) PG8_BAR; }
    PG8_BAR;
    if constexpr (Epi::AFTER_DRAIN) { E.fused(acc, cur, wr, wc, fr, fq, lds, wid, lane); S.done(cur); }
#undef PG8_SA
#undef PG8_SB
#undef PG8_STAGE
#undef PG8_LDA
#undef PG8_LDB
#undef PG8_MMA
#undef PG8_WAIT_V
#undef PG8_WAIT_L
#undef PG8_BAR
#undef PG8_SCHED
}
}
constexpr int DM = 2048, SEQ = 4096, TP = 8192, TS = 32, TT = TP + TS, MPAD = 8448;
constexpr int EVEN_IN = 6784, EVEN_INP = 6912, ODD_IN = 7168, LDH = 7168;
constexpr int EVEN_OUT = 1536, ODD_OUT = 2048;
constexpr float ALPHA = 1.6817928305074292f;
constexpr float LN_EPS = 1e-5f;
constexpr int EC_R = 0, EC_K = 768, EC_V = 1536, EC_HW = 2304, EC_HA = 2368, EC_GA = 2432, EC_QB = 3200, EC_KB = 3968, EC_VB = 4736, EC_GB = 5504, EC_QM = 5760, EC_GM = 6272;
constexpr int OC_Q = 0, OC_K = 1536, OC_V = 3072, OC_G = 4608, OC_QM = 6144, OC_GM = 6656;
constexpr size_t O_YP = 0, O_YS = 16777216, O_RWKV_P = O_YS + 65536, O_RWKV_S = O_RWKV_P + 196608, O_SH_P = O_RWKV_S + 786432, O_SH_S = O_SH_P + 9728,
    O_G0P = O_SH_S + 38912, O_G0S = O_G0P + 262144, O_G1P = O_G0S + 32768, O_G1S = O_G1P + 1048576, O_G2P = O_G1S + 32768, O_G2S = O_G2P + 4194304,
    O_RET_P = O_G2S + 32768, O_RET_S = O_RET_P + 1572864, O_MEM = O_RET_S + 6291456, O_END = O_MEM + 2097152;
constexpr size_t MiB = 1u << 20;
constexpr size_t WS_CTL = 0, WS_WTIN = 1 * MiB, WS_WTOUT = 29 * MiB, WS_WTMEM = 37 * MiB, WS_MEMB = 53 * MiB, WS_TAB = 55 * MiB, WS_XB = 60 * MiB, WS_XZ = 93 * MiB,
    WS_HB = 159 * MiB, WS_U = 275 * MiB, WS_YA = 308 * MiB, WS_PREP = 333 * MiB, WS_OG = 478 * MiB, WS_LSE = 478 * MiB + 49 * MiB / 2, WS_MKVB = 503 * MiB, WS_VT = 507 * MiB, WS_WTOUT2 = 509 * MiB, WS_END = 517 * MiB;
constexpr int LDS_BYTES = 147456, XB_LDS_OFF = LDS_BYTES - 64;

#define LAS __attribute__((address_space(3)))
typedef unsigned short bf16;
typedef float f32x4 __attribute__((ext_vector_type(4)));
typedef short bf16x8 __attribute__((ext_vector_type(8)));
typedef unsigned u32x4 __attribute__((ext_vector_type(4)));
typedef unsigned u32x2 __attribute__((ext_vector_type(2)));

__device__ const double ANG[128] = {
1.0, 0.9300449458481392, 0.8649836012976682, 0.8044736266284181, 0.7481966305138833, 0.6958564947100448, 0.6471778159406796, 0.6019044567806663, 0.5597981979123284, 0.5206374846632574, 0.48421626123015066, 0.45034288645458387, 0.41883912544574814, 0.3895392117442728, 0.362288975092429, 0.336945030221216, 0.31337402238589046, 0.29145192568009903, 0.2710633904364836, 0.2521011362799124, 0.23446538763970548, 0.21806334875063282, 0.20280871538024622, 0.18862122071335174, 0.17542621300415914, 0.1631542627737973, 0.15174079748634942, 0.14112576178114528, 0.13125330147352265, 0.12207146966133185, 0.11353195339077617, 0.10558981944335787, 0.09820327790631257, 0.09133346228248625, 0.08494422498263796, 0.07900194712408967, 0.07347536163492155, 0.06833538873292307, 0.06355498291362295, 0.059108990642279875, 0.05497401800103736, 0.05112830759482943, 0.04755162406834012, 0.04422514763163046, 0.04113137503418572, 0.03825402746632876, 0.03557796490339495, 0.03308910644196496, 0.030774356208980617, 0.02862153445389273, 0.026619313461261302, 0.024757157946593413, 0.023025269621793302, 0.02141453563853956, 0.019916480638308563, 0.018523222156741202, 0.017227429147699425, 0.01602228340877477, 0.014901443705277463, 0.013859012403933875, 0.01288950444072537, 0.01198781845958378, 0.011149209970080915, 0.01036926638287344, 0.009643883791544459, 0.008969245378672715, 0.008341801332506338, 0.007758250168566794, 0.007215521357901014, 0.006710759170575141, 0.006241307649397462, 0.00580469663480544, 0.005398628767382501, 0.005020967399614466, 0.004669725353279709, 0.0043430544633167095, 0.0040392358531509045, 0.003756670890311596, 0.0034938727747491297, 0.0032494587155918425, 0.0030221426551783792, 0.002810728502080728, 0.002614103837511492, 0.002431234061999789, 0.002261156951536743, 0.002102977594546134, 0.0019558636830395095, 0.0018190411331788228, 0.0016917900122028363, 0.0015734407502856099, 0.0014633706173946357, 0.0013610004466105522, 0.001265791586667203, 0.001177243067676929, 0.001094888965127687, 0.0010182959482819048, 0.0009470610000772239, 0.0008808092965317064, 0.0008191922344953685, 0.0007618855973704613, 0.0007085878491488872, 0.0006590185477903263, 0.0006129168695925734, 0.0005700402367896359, 0.0005301630411562774, 0.000493075456902875, 0.00045858233661428085, 0.00042650218442334204, 0.0003966662010161199, 0.00036891739544382435, 0.0003431097590679882, 0.0003191074972923552, 0.00029678431503900375, 0.0002760227522090274, 0.00025671356563109924, 0.00023875515424585844, 0.00022205302450155334, 0.00020651929314796272, 0.00019207222481239299, 0.0001786358019245737, 0.00016613932472747905, 0.0001545170392694147, 0.0001437077914199376, 0.00013365470508911156, 0.00012430488295695166, 0.00011560912813835741, 0.00010752168531898921, 0.0001};
__device__ const float LG2G[6] = {-0.04580368961312479f, -0.02272007650008353f, -0.011315313227834146f, -0.005646563141142063f, -0.0028205190623786626f, -0.0014095702546713536f};

__device__ __forceinline__ float bf2f(unsigned b) { return __uint_as_float(b << 16); }
typedef __bf16 bf16x2_t __attribute__((ext_vector_type(2)));
typedef float f32x2_t __attribute__((ext_vector_type(2)));
__device__ __forceinline__ unsigned f2bf(float f) { return (unsigned)__builtin_bit_cast(unsigned short, (__bf16)f); }
__device__ __forceinline__ unsigned pk2(float lo, float hi) { const f32x2_t v = {lo, hi}; return __builtin_bit_cast(unsigned, __builtin_convertvector(v, bf16x2_t)); }
__device__ __forceinline__ void unpk4(u32x2 w, float (&x)[4]) { x[0] = __uint_as_float(w.x << 16); x[1] = __uint_as_float(w.x & 0xffff0000u); x[2] = __uint_as_float(w.y << 16); x[3] = __uint_as_float(w.y & 0xffff0000u); }
__device__ __forceinline__ void unpk8(u32x4 w, float (&x)[8]) {
    x[0] = __uint_as_float(w.x << 16); x[1] = __uint_as_float(w.x & 0xffff0000u); x[2] = __uint_as_float(w.y << 16); x[3] = __uint_as_float(w.y & 0xffff0000u);
    x[4] = __uint_as_float(w.z << 16); x[5] = __uint_as_float(w.z & 0xffff0000u); x[6] = __uint_as_float(w.w << 16); x[7] = __uint_as_float(w.w & 0xffff0000u); }
template <int CTRL> __device__ __forceinline__ float dppf(float x) { return __builtin_bit_cast(float, __builtin_amdgcn_update_dpp(0, __builtin_bit_cast(int, x), CTRL, 0xF, 0xF, true)); }
__device__ __forceinline__ float red16(float x) { x += dppf<0xB1>(x); x += dppf<0x4E>(x); x += dppf<0x141>(x); x += dppf<0x140>(x); return x; }
__device__ __forceinline__ float wave_sum(float x) { x = red16(x); x += __shfl_xor(x, 16); x += __shfl_xor(x, 32); return x; }
__device__ __forceinline__ float sigmoidf_(float x) { return __builtin_amdgcn_rcpf(1.0f + __expf(-x)); }
__device__ __forceinline__ float siluf_(float x) { return x * __builtin_amdgcn_rcpf(1.0f + __expf(-x)); }
#define LDS_WAIT() asm volatile("s_waitcnt lgkmcnt(0)" ::: "memory")

struct Args { const float* in[27]; float* out; unsigned char* ws; int ph_lo, ph_hi; };
typedef const __attribute__((address_space(4))) Args* ArgsP;
struct Ctx {
    ArgsP ap;
    LAS unsigned char* lds;
    int tid, lane, wave, bid, G;
};
#define C_IN(k) (c.ap->in[k])
#define C_OUT (c.ap->out)
#define C_WTIN_L(l_) (((l_) & 1) ? (bf16*)(c.ap->out + O_YP) : (bf16*)(c.ap->ws + WS_WTIN))
#define C_WTOUT_L(l_) ((bf16*)(c.ap->ws + (((l_) & 1) ? WS_WTOUT2 : WS_WTOUT)))
#define C_WTMEM ((bf16*)(c.ap->ws + WS_WTMEM))
#define C_MEMB ((bf16*)(c.ap->ws + WS_MEMB))
#define C_XB ((bf16*)(c.ap->ws + WS_XB))
#define C_HB ((bf16*)(c.ap->ws + WS_HB))
#define C_U ((bf16*)(c.ap->ws + WS_U))
#define C_TAB ((float*)(c.ap->ws + WS_TAB))
#define C_XZ ((float*)(c.ap->ws + WS_XZ))
#define C_YA ((bf16*)(c.ap->ws + WS_YA))
#define C_PREP ((float*)(c.ap->ws + WS_PREP))
#define C_CHK ((unsigned char*)(c.ap->ws + WS_PREP))
#define C_PREPS ((float*)(c.ap->ws + WS_PREP + 120 * MiB))
#define C_BONUS ((float*)(c.ap->ws + WS_PREP + 125 * MiB))
#define C_WUT ((bf16*)(c.ap->ws + WS_PREP + 126 * MiB))
#define C_AUT ((bf16*)(c.ap->ws + WS_PREP + 126 * MiB) + 2 * 768 * 64)
constexpr int CHK_BYTES = 27136, CK_A = 0, CK_RQ = 9216, CK_GT = 13824, CK_YVT = 22528;
#define C_YR ((bf16*)(c.ap->ws + WS_PREP))
#define C_Z ((bf16*)(c.ap->ws + WS_HB))
#define C_OG ((bf16*)(c.ap->ws + WS_OG))
#define C_LSE ((float*)(c.ap->ws + WS_LSE))
#define C_MKVB ((bf16*)(c.ap->ws + WS_MKVB))
#define C_VT ((bf16*)(c.ap->ws + WS_VT))

__device__ __forceinline__ void transpose_item(const float* W, int K, int N, bf16* WT, int row_off, LAS float* scr, int item, int lane) {
    const int nblk = N / 32, kb = item / nblk, nb = item % nblk, k0 = 64 * kb, n0 = 32 * nb;
    f32x4 wv[8];
#pragma unroll
    for (int i = 0; i < 8; ++i) { const int kk = 8 * i + (lane >> 3), c4 = 4 * (lane & 7); wv[i] = *(const f32x4*)(W + (size_t)(k0 + kk) * N + n0 + c4); }
#pragma unroll
    for (int i = 0; i < 8; ++i) { const int kk = 8 * i + (lane >> 3), c4 = 4 * (lane & 7); const f32x4 w4 = wv[i];
        scr[kk * 33 + c4] = w4.x; scr[kk * 33 + c4 + 1] = w4.y; scr[kk * 33 + c4 + 2] = w4.z; scr[kk * 33 + c4 + 3] = w4.w; }
    LDS_WAIT(); asm volatile("" ::: "memory");
    const int c = lane & 7;
#pragma unroll
    for (int j = 0; j < 4; ++j) { const int n = (lane >> 3) + 8 * j; const LAS float* s = scr + (8 * c) * 33 + n;
        u32x4 o; o.x = pk2(s[0 * 33], s[1 * 33]); o.y = pk2(s[2 * 33], s[3 * 33]); o.z = pk2(s[4 * 33], s[5 * 33]); o.w = pk2(s[6 * 33], s[7 * 33]);
        *(u32x4*)(WT + (size_t)(row_off + n0 + n) * K + k0 + 8 * c) = o; }
    LDS_WAIT(); asm volatile("" ::: "memory");
}
__device__ __forceinline__ void transpose_matrix(const Ctx& c, const float* W, int K, int N, bf16* WT, int row_off) {
    LAS float* scr = (LAS float*)(c.lds + c.wave * 16384);
    const int gw = c.bid * 8 + c.wave, NGW = c.G * 8, nitems = (K / 64) * (N / 32);
    for (int it = gw; it < nitems; it += NGW) transpose_item(W, K, N, WT, row_off, scr, it, c.lane);
}
__device__ __forceinline__ void convert_layer_weights(const Ctx& c, int l) {
    if ((l & 1) == 0) { const int e = l >> 1;
        transpose_matrix(c, C_IN(10) + (size_t)e * DM * EVEN_IN, DM, EVEN_IN, C_WTIN_L(l), 0);
        transpose_matrix(c, C_IN(11) + (size_t)e * EVEN_OUT * DM, EVEN_OUT, DM, C_WTOUT_L(l), 0);
        const int n16 = (EVEN_INP - EVEN_IN) * DM * 2 / 16; u32x4* p = (u32x4*)(C_WTIN_L(l) + (size_t)EVEN_IN * DM);
        unsigned zz = 0u; asm volatile("" : "+v"(zz));
        for (int i = c.bid * 512 + c.tid; i < n16; i += c.G * 512) p[i] = (u32x4){zz, zz, zz, zz};
    } else { const int o = l >> 1;
        transpose_matrix(c, C_IN(12) + (size_t)o * DM * ODD_IN, DM, ODD_IN, C_WTIN_L(l), 0);
        transpose_matrix(c, C_IN(13) + (size_t)o * ODD_OUT * DM, ODD_OUT, DM, C_WTOUT_L(l), 0);
    }
}

__device__ __forceinline__ void phase_prologue(const Ctx& c) {
    for (int l = 0; l < 4; ++l) transpose_matrix(c, C_IN(14) + (size_t)l * DM * 1024, DM, 1024, C_WTMEM, l * 1024);
    convert_layer_weights(c, 0);
    const int gt = c.bid * 512 + c.tid, NT = c.G * 512;
    for (int i = gt; i < 2 * 768 * 64; i += NT) { const int e = i / (768 * 64), rem = i % (768 * 64), col = rem >> 6, k = rem & 63;
        C_WUT[i] = (bf16)f2bf(C_IN(19)[((size_t)e * 64 + k) * 768 + col]); C_AUT[i] = (bf16)f2bf(C_IN(21)[((size_t)e * 64 + k) * 768 + col]); }
    for (int i = gt; i < 512 * DM / 4; i += NT) { const f32x4 v = ((const f32x4*)C_IN(9))[i]; ((u32x2*)C_MEMB)[i] = (u32x2){pk2(v.x, v.y), pk2(v.z, v.w)}; }
    for (int i0 = gt; i0 < MPAD * DM / 4; i0 += 8 * NT) {
        f32x4 v[8];
#pragma unroll
        for (int k = 0; k < 8; ++k) { const int i = i0 + k * NT, row = i / (DM / 4); v[k] = (f32x4){0.f, 0.f, 0.f, 0.f};
            if (i < MPAD * DM / 4) { if (row < TP) v[k] = ((const f32x4*)C_IN(0))[i]; else if (row < TT) v[k] = ((const f32x4*)C_IN(1))[i - TP * (DM / 4)]; } }
#pragma unroll
        for (int k = 0; k < 8; ++k) { const int i = i0 + k * NT; if (i < MPAD * DM / 4) ((u32x2*)C_XB)[i] = (u32x2){pk2(v[k].x, v[k].y), pk2(v[k].z, v[k].w)}; }
    }
    for (int i = gt; i < 4100 * 128; i += NT) {
        const int p = i >> 7, ci = i & 127; const double pos = (double)(p < 4096 ? p : 16384 + (p - 4096));
        double ph = pos * ANG[ci];
        const double k = __builtin_rint(ph * 0.15915494309189535); ph = __builtin_fma(-k, 6.283185307179586, ph); ph = __builtin_fma(-k, 2.4492935982947064e-16, ph);
        const double q = __builtin_rint(ph * 0.6366197723675814); const double y = __builtin_fma(-q, 1.5707963267948966, ph) - q * 6.123233995736766e-17;
        const double y2 = y * y;
        const double sn = y * (1.0 + y2 * (-1.0 / 6 + y2 * (1.0 / 120 + y2 * (-1.0 / 5040 + y2 * (1.0 / 362880 + y2 * (-1.0 / 39916800 + y2 * (1.0 / 6227020800.0)))))));
        const double cs = 1.0 + y2 * (-0.5 + y2 * (1.0 / 24 + y2 * (-1.0 / 720 + y2 * (1.0 / 40320 + y2 * (-1.0 / 3628800 + y2 * (1.0 / 479001600.0 + y2 * (-1.0 / 87178291200.0)))))));
        const int qi = ((int)q) & 3; double co, si;
        if (qi == 0) { co = cs; si = sn; } else if (qi == 1) { co = -sn; si = cs; } else if (qi == 2) { co = -cs; si = -sn; } else { co = sn; si = -cs; }
        C_TAB[2 * i] = (float)co; C_TAB[2 * i + 1] = (float)si;
    }
}

__device__ __forceinline__ void rwkv_prep_item(const Ctx& c, int it, int e) {
    LAS float* lw = (LAS float*)c.lds;
    LAS float* la = lw + 16 * 64;
    const float* mu = C_IN(17) + e * 2432; const float* shift = C_IN(3) + (size_t)e * 8 * 2432;
    const int R0 = it * 16;
    for (int i = c.tid; i < 16 * 128; i += 512) {
        const int tk = i >> 7, cc = i & 127, R = R0 + tk; float val = 0.f;
        if (R < TT) { const int col = EC_HW + cc; const float hcur = bf2f(C_HB[(size_t)R * LDH + col]);
            float hprev;
            if (R < TP) hprev = ((R & (SEQ - 1)) == 0) ? 0.f : bf2f(C_HB[(size_t)(R - 1) * LDH + col]);
            else { const int n = (R - TP) >> 2, t = (R - TP) & 3; hprev = (t == 0) ? shift[n * 2432 + col] : bf2f(C_HB[(size_t)(R - 1) * LDH + col]); }
            const float hs = hcur + (hprev - hcur) * mu[col];
            val = (cc < 64) ? tanhf(hs) : hs; }
        if (cc < 64) lw[tk * 64 + cc] = val; else la[tk * 64 + (cc - 64)] = val;
    }
    __syncthreads();
    const int tl = c.tid & 255, tg = c.tid >> 8;
    const float* w_up = C_IN(19) + (size_t)e * 64 * 768; const float* a_up = C_IN(21) + (size_t)e * 64 * 768;
    const float* w0 = C_IN(18) + e * 768; const float* a0 = C_IN(20) + e * 768; const float* k_k = C_IN(22) + e * 768; const float* k_a = C_IN(23) + e * 768;
#pragma unroll 1
    for (int m = 0; m < 3; ++m) {
        const int col = tl + 256 * m, h = col >> 6, ci = col & 63;
        float xw[8], xa[8];
#pragma unroll
        for (int t = 0; t < 8; ++t) { xw[t] = 0.f; xa[t] = 0.f; }
#pragma unroll 4
        for (int kk = 0; kk < 64; ++kk) { const float wu = w_up[kk * 768 + col], au = a_up[kk * 768 + col];
#pragma unroll
            for (int t = 0; t < 8; ++t) { xw[t] += lw[(tg * 8 + t) * 64 + kk] * wu; xa[t] += la[(tg * 8 + t) * 64 + kk] * au; } }
        const float w0c = w0[col], a0c = a0[col], kkc = k_k[col], kac = k_a[col], mur = mu[EC_R + col], muk = mu[EC_K + col], muv = mu[EC_V + col];
#pragma unroll
        for (int t = 0; t < 8; ++t) {
            const int R = R0 + tg * 8 + t;
            if (R >= TT || R < TP) continue;
            const bf16* hc = C_HB + (size_t)R * LDH; float pr, pk, pv;
            const float cr = bf2f(hc[EC_R + col]), ck = bf2f(hc[EC_K + col]), cv = bf2f(hc[EC_V + col]);
            bool has_prev_row; int n = 0;
            if (R < TP) has_prev_row = (R & (SEQ - 1)) != 0; else { n = (R - TP) >> 2; has_prev_row = ((R - TP) & 3) != 0; }
            if (has_prev_row) { const bf16* hp = hc - LDH; pr = bf2f(hp[EC_R + col]); pk = bf2f(hp[EC_K + col]); pv = bf2f(hp[EC_V + col]); }
            else if (R < TP) { pr = 0.f; pk = 0.f; pv = 0.f; }
            else { const float* sp = shift + n * 2432; pr = sp[EC_R + col]; pk = sp[EC_K + col]; pv = sp[EC_V + col]; }
            const float r = cr + (pr - cr) * mur, k = ck + (pk - ck) * muk, v = cv + (pv - cv) * muv;
            const float decay = __expf(-0.6065306597126334f * sigmoidf_(w0c + xw[t]));
            const float a = sigmoidf_(a0c + xa[t]);
            float kk = k * kkc; const float ss = wave_sum(kk * kk); kk *= rsqrtf(fmaxf(ss, 1e-24f));
            const float k2 = k * (1.0f + (a - 1.0f) * kac);
            float* dst = C_PREPS + ((size_t)(R - TP) * 12 + h) * 384 + ci;
            dst[0] = r; dst[64] = decay; dst[128] = k2; dst[192] = v; dst[256] = -kk; dst[320] = kk * a;
        }
    }
    __syncthreads();
}

__device__ __forceinline__ void dil_attn_item(const Ctx& c, int R, int hh, int e) {
    const int lane = c.lane, kg = lane >> 4, dl = lane & 15;
    float m = -1e30f, l = 0.f, acc[4] = {0.f, 0.f, 0.f, 0.f};
    const bool is_p = R < TP; const int t = is_p ? (R & (SEQ - 1)) : ((R - TP) & 3); const int n = is_p ? 0 : ((R - TP) >> 2);
    const size_t rowbase = is_p ? (size_t)(R - t) : (size_t)(TP + n * 4);
#pragma unroll
    for (int g = 0; g < 3; ++g) {
        const int dil = (g == 0) ? 1 : (g == 1 ? 4 : 16), W = 128 * dil;
        float q[4]; { const u32x2 w = *(const u32x2*)(C_HB + (size_t)R * LDH + EC_QB + g * 256 + hh * 64 + 4 * dl); unpk4(w, q); }
#pragma unroll
        for (int i = 0; i < 4; ++i) q[i] *= 0.125f;
        const float* cache = ((g == 0) ? C_IN(4) : (g == 1 ? C_IN(5) : C_IN(6))) + ((size_t)(e * 8 + n) * W) * 512;
#pragma unroll 1
        for (int j0 = 0; j0 < 129; j0 += 4) {
            const int j = j0 + kg; bool valid = j < 129; float kf[4] = {0.f, 0.f, 0.f, 0.f}, vf[4] = {0.f, 0.f, 0.f, 0.f};
            if (is_p) { const int pos = t - dil * j; valid = valid && pos >= 0;
                if (valid) { const bf16* kp = C_HB + (rowbase + pos) * LDH + g * 256 + hh * 64 + 4 * dl; unpk4(*(const u32x2*)(kp + EC_KB), kf); unpk4(*(const u32x2*)(kp + EC_VB), vf); } }
            else if (valid) { const int idx = W + t - dil * j;
                if (idx >= W) { const bf16* kp = C_HB + (rowbase + (idx - W)) * LDH + g * 256 + hh * 64 + 4 * dl; unpk4(*(const u32x2*)(kp + EC_KB), kf); unpk4(*(const u32x2*)(kp + EC_VB), vf); }
                else { const float* kp = cache + (size_t)idx * 512 + hh * 64 + 4 * dl; const f32x4 k4 = *(const f32x4*)kp, v4 = *(const f32x4*)(kp + 256);
                    kf[0] = k4.x; kf[1] = k4.y; kf[2] = k4.z; kf[3] = k4.w; vf[0] = v4.x; vf[1] = v4.y; vf[2] = v4.z; vf[3] = v4.w; } }
            float s = q[0] * kf[0] + q[1] * kf[1] + q[2] * kf[2] + q[3] * kf[3];
            s = red16(s);
            if (valid) { const float mn = fmaxf(m, s), sc = __expf(m - mn), p = __expf(s - mn);
                l = l * sc + p;
#pragma unroll
                for (int i = 0; i < 4; ++i) acc[i] = acc[i] * sc + p * vf[i];
                m = mn; }
        }
    }
#pragma unroll
    for (int off = 16; off <= 32; off <<= 1) {
        const float m2 = __shfl_xor(m, off), l2 = __shfl_xor(l, off); float a2[4];
#pragma unroll
        for (int i = 0; i < 4; ++i) a2[i] = __shfl_xor(acc[i], off);
        const float mn = fmaxf(m, m2), s1 = __expf(m - mn), s2 = __expf(m2 - mn);
        l = l * s1 + l2 * s2;
#pragma unroll
        for (int i = 0; i < 4; ++i) acc[i] = acc[i] * s1 + a2[i] * s2;
        m = mn;
    }
    if (kg == 0) { float gt[4]; unpk4(*(const u32x2*)(C_HB + (size_t)R * LDH + EC_GB + hh * 64 + 4 * dl), gt);
        const float inv = 1.0f / l; float o[4];
#pragma unroll
        for (int i = 0; i < 4; ++i) o[i] = acc[i] * inv * siluf_(gt[i]);
        *(u32x2*)(C_U + (size_t)R * EVEN_OUT + 768 + hh * 64 + 4 * dl) = (u32x2){pk2(o[0], o[1]), pk2(o[2], o[3])}; }
}

__device__ __forceinline__ void mem_attn_item(const Ctx& c, int R, int mh, int l, int qcol, int gcol, int ucol, int ldu) {
    const int lane = c.lane, kg = lane >> 5, dl = lane & 31;
    const float* mkv;
    if (R < TP) mkv = C_OUT + O_MEM + ((size_t)l * 512 + (R >> 12) * 256) * 1024; else mkv = C_IN(8) + ((size_t)l * 8 + ((R - TP) >> 2)) * 256 * 1024;
    float q[4]; unpk4(*(const u32x2*)(C_HB + (size_t)R * LDH + qcol + mh * 128 + 4 * dl), q);
#pragma unroll
    for (int i = 0; i < 4; ++i) q[i] *= 0.08838834764831845f;
    float m = -1e30f, lsum = 0.f, acc[4] = {0.f, 0.f, 0.f, 0.f};
#pragma unroll 8
    for (int j0 = 0; j0 < 256; j0 += 2) {
        const float* kp = mkv + (size_t)(j0 + kg) * 1024 + mh * 128 + 4 * dl; const f32x4 k4 = *(const f32x4*)kp, v4 = *(const f32x4*)(kp + 512);
        float s = q[0] * k4.x + q[1] * k4.y + q[2] * k4.z + q[3] * k4.w;
        s = red16(s); s += __shfl_xor(s, 16);
        const float mn = fmaxf(m, s), sc = __expf(m - mn), p = __expf(s - mn);
        lsum = lsum * sc + p; acc[0] = acc[0] * sc + p * v4.x; acc[1] = acc[1] * sc + p * v4.y; acc[2] = acc[2] * sc + p * v4.z; acc[3] = acc[3] * sc + p * v4.w; m = mn;
    }
    { const float m2 = __shfl_xor(m, 32), l2 = __shfl_xor(lsum, 32); float a2[4];
#pragma unroll
        for (int i = 0; i < 4; ++i) a2[i] = __shfl_xor(acc[i], 32);
        const float mn = fmaxf(m, m2), s1 = __expf(m - mn), s2 = __expf(m2 - mn);
        lsum = lsum * s1 + l2 * s2;
#pragma unroll
        for (int i = 0; i < 4; ++i) acc[i] = acc[i] * s1 + a2[i] * s2; }
    if (kg == 0) { float gt[4]; unpk4(*(const u32x2*)(C_HB + (size_t)R * LDH + gcol + mh * 128 + 4 * dl), gt);
        const float inv = 1.0f / lsum; float o[4];
#pragma unroll
        for (int i = 0; i < 4; ++i) o[i] = acc[i] * inv * siluf_(gt[i]);
        *(u32x2*)(C_U + (size_t)R * ldu + ucol + mh * 128 + 4 * dl) = (u32x2){pk2(o[0], o[1]), pk2(o[2], o[3])}; }
}


typedef float f32x16 __attribute__((ext_vector_type(16)));
__device__ __forceinline__ f32x16 mfma32(bf16x8 a, bf16x8 b, f32x16 cacc) { return __builtin_amdgcn_mfma_f32_32x32x16_bf16(a, b, cacc, 0, 0, 0); }
__device__ __forceinline__ void mem_attn_mfma_item(const Ctx& c, int item, int l, int qcol, int gcol, int ucol, int ldu) {
    const int blk = item >> 2, mh = item & 3, R0 = blk * 32, b = R0 >> 12;
    const int lane = c.lane, r = lane & 31, hh = lane >> 5;
    const bf16* Kb = C_MKVB + ((size_t)l * 512 + b * 256) * 1024 + mh * 128 + 8 * hh;
    const bf16* Vt = C_VT + ((size_t)l * 512 + mh * 128) * 512 + b * 256 + 4 * hh;
    bf16x8 Qf[8];
    { const bf16* qp = C_HB + (size_t)(R0 + r) * LDH + qcol + mh * 128 + 8 * hh;
#pragma unroll
        for (int ks = 0; ks < 8; ++ks) Qf[ks] = *(const bf16x8*)(qp + 16 * ks); }
    f32x16 O[4];
#pragma unroll
    for (int dt = 0; dt < 4; ++dt)
#pragma unroll
        for (int i = 0; i < 16; ++i) O[dt][i] = 0.f;
    float m = -1e30f, lsum = 0.f;
    const float cs = 0.08838834764831845f * 1.4426950408889634f;
#pragma unroll 1
    for (int half = 0; half < 2; ++half) {
        f32x16 S[4];
#pragma unroll
        for (int kt = 0; kt < 4; ++kt) {
#pragma unroll
            for (int i = 0; i < 16; ++i) S[kt][i] = 0.f;
            const bf16* kp = Kb + (size_t)(128 * half + 32 * kt + r) * 1024;
#pragma unroll
            for (int ks = 0; ks < 8; ++ks) S[kt] = mfma32(*(const bf16x8*)(kp + 16 * ks), Qf[ks], S[kt]);
        }
        float mx = -1e30f;
#pragma unroll
        for (int kt = 0; kt < 4; ++kt)
#pragma unroll
            for (int i = 0; i < 16; ++i) mx = fmaxf(mx, S[kt][i]);
        mx = fmaxf(mx, __shfl_xor(mx, 32));
        const float mn = fmaxf(m, mx), sc = __builtin_amdgcn_exp2f((m - mn) * cs); m = mn;
        lsum *= sc;
#pragma unroll
        for (int dt = 0; dt < 4; ++dt)
#pragma unroll
            for (int i = 0; i < 16; ++i) O[dt][i] *= sc;
        float ps = 0.f;
#pragma unroll
        for (int kt = 0; kt < 4; ++kt)
#pragma unroll
            for (int i = 0; i < 16; ++i) { const float p = __builtin_amdgcn_exp2f((S[kt][i] - mn) * cs); S[kt][i] = p; ps += p; }
        lsum += ps;
#pragma unroll
        for (int kt = 0; kt < 4; ++kt)
#pragma unroll
            for (int s2 = 0; s2 < 2; ++s2) {
                const u32x4 pw = (u32x4){pk2(S[kt][8 * s2 + 0], S[kt][8 * s2 + 1]), pk2(S[kt][8 * s2 + 2], S[kt][8 * s2 + 3]), pk2(S[kt][8 * s2 + 4], S[kt][8 * s2 + 5]), pk2(S[kt][8 * s2 + 6], S[kt][8 * s2 + 7])};
                const bf16x8 Pf = __builtin_bit_cast(bf16x8, pw);
                const int kb = 128 * half + 32 * kt + 16 * s2;
#pragma unroll
                for (int dt = 0; dt < 4; ++dt) { const bf16* vp = Vt + (size_t)(32 * dt + r) * 512 + kb;
                    const u32x2 v0 = *(const u32x2*)vp, v1 = *(const u32x2*)(vp + 8); const u32x4 vw = (u32x4){v0.x, v0.y, v1.x, v1.y};
                    O[dt] = mfma32(__builtin_bit_cast(bf16x8, vw), Pf, O[dt]); }
            }
    }
    lsum += __shfl_xor(lsum, 32); const float inv = 1.0f / lsum;
    const bf16* gp = C_HB + (size_t)(R0 + r) * LDH + gcol + mh * 128 + 4 * hh; bf16* up = C_U + (size_t)(R0 + r) * ldu + ucol + mh * 128 + 4 * hh;
#pragma unroll
    for (int dt = 0; dt < 4; ++dt)
#pragma unroll
        for (int g4 = 0; g4 < 4; ++g4) { float gt[4]; unpk4(*(const u32x2*)(gp + 32 * dt + 8 * g4), gt);
            const float o0 = O[dt][4 * g4 + 0] * inv * siluf_(gt[0]), o1 = O[dt][4 * g4 + 1] * inv * siluf_(gt[1]), o2 = O[dt][4 * g4 + 2] * inv * siluf_(gt[2]), o3 = O[dt][4 * g4 + 3] * inv * siluf_(gt[3]);
            *(u32x2*)(up + 32 * dt + 8 * g4) = (u32x2){pk2(o0, o1), pk2(o2, o3)}; }
}
constexpr int MA_KS = 136, MA_VS = 260;
__device__ __forceinline__ void mem_attn_stage(const Ctx& c, int bb, int mh, int l) {
    LAS bf16* Kl = (LAS bf16*)c.lds; LAS bf16* Vl = Kl + 256 * MA_KS;
    const int tid = c.tid;
    const bf16* Kg = C_MKVB + ((size_t)l * 512 + bb * 256 + (tid >> 4)) * 1024 + mh * 128 + (tid & 15) * 8;
    const bf16* Vg = C_VT + ((size_t)l * 512 + mh * 128 + (tid >> 5)) * 512 + bb * 256 + (tid & 31) * 8;
    u32x4 kw[8], vw[8];
#pragma unroll
    for (int p = 0; p < 8; ++p) { kw[p] = *(const u32x4*)(Kg + (size_t)(32 * p) * 1024); vw[p] = *(const u32x4*)(Vg + (size_t)(16 * p) * 512); }
#pragma unroll
    for (int p = 0; p < 8; ++p) { *(LAS u32x4*)(Kl + ((tid >> 4) + 32 * p) * MA_KS + (tid & 15) * 8) = kw[p];
        LAS bf16* vd = Vl + ((tid >> 5) + 16 * p) * MA_VS + (tid & 31) * 8; *(LAS u32x2*)vd = (u32x2){vw[p].x, vw[p].y}; *(LAS u32x2*)(vd + 4) = (u32x2){vw[p].z, vw[p].w}; }
}
__device__ __forceinline__ void mem_attn_mfma_item_lds(const Ctx& c, int item, int qcol, int gcol, int ucol, int ldu) {
    const int blk = item >> 2, mh = item & 3, R0 = blk * 32;
    const int lane = c.lane, r = lane & 31, hh = lane >> 5;
    const LAS bf16* Kl = (const LAS bf16*)c.lds + r * MA_KS + 8 * hh; const LAS bf16* Vl = (const LAS bf16*)c.lds + 256 * MA_KS + r * MA_VS + 4 * hh;
    bf16x8 Qf[8];
    { const bf16* qp = C_HB + (size_t)(R0 + r) * LDH + qcol + mh * 128 + 8 * hh;
#pragma unroll
        for (int ks = 0; ks < 8; ++ks) Qf[ks] = *(const bf16x8*)(qp + 16 * ks); }
    f32x16 O[4];
#pragma unroll
    for (int dt = 0; dt < 4; ++dt)
#pragma unroll
        for (int i = 0; i < 16; ++i) O[dt][i] = 0.f;
    float m = -1e30f, lsum = 0.f;
    const float cs = 0.08838834764831845f * 1.4426950408889634f;
#pragma unroll 1
    for (int half = 0; half < 2; ++half) {
        f32x16 S[4];
#pragma unroll
        for (int kt = 0; kt < 4; ++kt) {
#pragma unroll
            for (int i = 0; i < 16; ++i) S[kt][i] = 0.f;
            bf16x8 Kf[8];
#pragma unroll
            for (int ks = 0; ks < 8; ++ks) Kf[ks] = *(const LAS bf16x8*)(Kl + (128 * half + 32 * kt) * MA_KS + 16 * ks);
#pragma unroll
            for (int ks = 0; ks < 8; ++ks) S[kt] = mfma32(Kf[ks], Qf[ks], S[kt]);
        }
        float mx = -1e30f;
#pragma unroll
        for (int kt = 0; kt < 4; ++kt)
#pragma unroll
            for (int i = 0; i < 16; ++i) mx = fmaxf(mx, S[kt][i]);
        mx = fmaxf(mx, __shfl_xor(mx, 32));
        const float mn = fmaxf(m, mx), sc = __builtin_amdgcn_exp2f((m - mn) * cs); m = mn;
        lsum *= sc;
#pragma unroll
        for (int dt = 0; dt < 4; ++dt)
#pragma unroll
            for (int i = 0; i < 16; ++i) O[dt][i] *= sc;
        float ps = 0.f;
#pragma unroll
        for (int kt = 0; kt < 4; ++kt)
#pragma unroll
            for (int i = 0; i < 16; ++i) { const float p = __builtin_amdgcn_exp2f((S[kt][i] - mn) * cs); S[kt][i] = p; ps += p; }
        lsum += ps;
#pragma unroll
        for (int kt = 0; kt < 4; ++kt)
#pragma unroll
            for (int s2 = 0; s2 < 2; ++s2) {
                const u32x4 pw = (u32x4){pk2(S[kt][8 * s2 + 0], S[kt][8 * s2 + 1]), pk2(S[kt][8 * s2 + 2], S[kt][8 * s2 + 3]), pk2(S[kt][8 * s2 + 4], S[kt][8 * s2 + 5]), pk2(S[kt][8 * s2 + 6], S[kt][8 * s2 + 7])};
                const bf16x8 Pf = __builtin_bit_cast(bf16x8, pw);
                const int kb = 128 * half + 32 * kt + 16 * s2;
                u32x2 va[4][2];
#pragma unroll
                for (int dt = 0; dt < 4; ++dt) { va[dt][0] = *(const LAS u32x2*)(Vl + (32 * dt) * MA_VS + kb); va[dt][1] = *(const LAS u32x2*)(Vl + (32 * dt) * MA_VS + kb + 8); }
#pragma unroll
                for (int dt = 0; dt < 4; ++dt) { const u32x4 vw = (u32x4){va[dt][0].x, va[dt][0].y, va[dt][1].x, va[dt][1].y};
                    O[dt] = mfma32(__builtin_bit_cast(bf16x8, vw), Pf, O[dt]); }
            }
    }
    lsum += __shfl_xor(lsum, 32); const float inv = 1.0f / lsum;
    const bf16* gp = C_HB + (size_t)(R0 + r) * LDH + gcol + mh * 128 + 4 * hh; bf16* up = C_U + (size_t)(R0 + r) * ldu + ucol + mh * 128 + 4 * hh;
#pragma unroll
    for (int dt = 0; dt < 4; ++dt) { u32x2 gw[4];
#pragma unroll
        for (int g4 = 0; g4 < 4; ++g4) gw[g4] = *(const u32x2*)(gp + 32 * dt + 8 * g4);
#pragma unroll
        for (int g4 = 0; g4 < 4; ++g4) { float gt[4]; unpk4(gw[g4], gt);
            const float o0 = O[dt][4 * g4 + 0] * inv * siluf_(gt[0]), o1 = O[dt][4 * g4 + 1] * inv * siluf_(gt[1]), o2 = O[dt][4 * g4 + 2] * inv * siluf_(gt[2]), o3 = O[dt][4 * g4 + 3] * inv * siluf_(gt[3]);
            *(u32x2*)(up + 32 * dt + 8 * g4) = (u32x2){pk2(o0, o1), pk2(o2, o3)}; } }
}
__device__ __forceinline__ void mem_attn_sample_block(const Ctx& c, int item, int l, int qcol, int gcol, int ucol, int ldu);
__device__ __forceinline__ void mem_attn_all(const Ctx& c, int l, int qcol, int gcol, int ucol, int ldu) {
    constexpr int NM = (TP / 32) * 4;
    { const int x = c.bid & 7, nbx = (c.G + 7 - x) >> 3, lb = c.bid >> 3, bb = x >> 2, mh = x & 3;
        if (lb * 8 < 128) {
            mem_attn_stage(c, bb, mh, l); __syncthreads();
            for (int r = lb * 8 + c.wave; r < 128; r += nbx * 8) mem_attn_mfma_item_lds(c, ((bb * 128 + r) << 2) | mh, qcol, gcol, ucol, ldu);
            __syncthreads(); } }
    for (int it = c.bid; it < TS * 4; it += c.G) mem_attn_sample_block(c, it, l, qcol, gcol, ucol, ldu);
}

typedef short s16x4 __attribute__((ext_vector_type(4)));
__device__ __forceinline__ f32x4 mfma16(bf16x8 a, bf16x8 b, f32x4 cacc) { return __builtin_amdgcn_mfma_f32_16x16x32_bf16(a, b, cacc, 0, 0, 0); }
__device__ __forceinline__ bf16x8 tr_frag(const LAS bf16* p, int rowstride4) {
    const s16x4 a0 = __builtin_amdgcn_ds_read_tr16_b64_v4i16((LAS s16x4*)p), a1 = __builtin_amdgcn_ds_read_tr16_b64_v4i16((LAS s16x4*)(p + rowstride4));
    return (bf16x8){a0[0], a0[1], a0[2], a0[3], a1[0], a1[1], a1[2], a1[3]};
}
__device__ __forceinline__ void dil_attn_mfma_item(const Ctx& c, int item) {
    const int bh = item / 48, rem = item % 48, b = bh >> 2, hh = bh & 3, g = rem >> 4, idx16 = rem & 15;
    const int dil = 1 << (2 * g), nub = 16 >> (2 * g), rho = idx16 / nub, ub = idx16 % nub;
    LAS bf16* Kl = (LAS bf16*)c.lds;
    LAS bf16* Vl = Kl + 384 * 72;
    const int tid = c.tid, lane = c.lane, wave = c.wave, r = lane & 31, hl = lane >> 5;
    const int ubase = ub * 256 - 128;
    const bf16* hb = C_HB + (size_t)b * SEQ * LDH + g * 256 + hh * 64;
    u32x4 kwv[6], vwv[6];
#pragma unroll
    for (int pass = 0; pass < 6; ++pass) { const int kl = pass * 64 + (tid >> 3), part = tid & 7; int up = ubase + kl; up = up < 0 ? 0 : up;
        const bf16* src = hb + (size_t)(rho + dil * up) * LDH + 8 * part;
        kwv[pass] = *(const u32x4*)(src + EC_KB); vwv[pass] = *(const u32x4*)(src + EC_VB); }
    const int u0 = ub * 256 + 32 * wave;
    bf16x8 Qf[4];
    { const bf16* qp = hb + (size_t)(rho + dil * (u0 + r)) * LDH + EC_QB + 8 * hl;
#pragma unroll
        for (int ks = 0; ks < 4; ++ks) Qf[ks] = *(const bf16x8*)(qp + 16 * ks); }
#pragma unroll
    for (int pass = 0; pass < 6; ++pass) { const int kl = pass * 64 + (tid >> 3), part = tid & 7; *(LAS u32x4*)(Kl + kl * 72 + 8 * part) = kwv[pass]; *(LAS u32x4*)(Vl + kl * 72 + 8 * part) = vwv[pass]; }
    __syncthreads();
    f32x16 S[5];
#pragma unroll
    for (int kt = 0; kt < 5; ++kt) {
#pragma unroll
        for (int i = 0; i < 16; ++i) S[kt][i] = 0.f;
        const LAS bf16* kp = Kl + (32 * wave + 32 * kt + r) * 72 + 8 * hl;
#pragma unroll
        for (int ks = 0; ks < 4; ++ks) S[kt] = mfma32(*(const LAS bf16x8*)(kp + 16 * ks), Qf[ks], S[kt]);
    }
    float mx = -1e30f;
#pragma unroll
    for (int kt = 0; kt < 5; ++kt)
#pragma unroll
        for (int i = 0; i < 16; ++i) { const int kl = 32 * kt + (i & 3) + 8 * (i >> 2) + 4 * hl;
            const bool valid = (kl >= r) && (kl - 128 <= r) && (u0 - 128 + kl >= 0);
            const float sv = valid ? S[kt][i] : -1e30f; S[kt][i] = sv; mx = fmaxf(mx, sv); }
    mx = fmaxf(mx, __shfl_xor(mx, 32));
    const float cs = 0.125f * 1.4426950408889634f;
    float lsum = 0.f;
#pragma unroll
    for (int kt = 0; kt < 5; ++kt)
#pragma unroll
        for (int i = 0; i < 16; ++i) { const float p = __builtin_amdgcn_exp2f((S[kt][i] - mx) * cs); S[kt][i] = p; lsum += p; }
    lsum += __shfl_xor(lsum, 32);
    f32x16 O[2];
#pragma unroll
    for (int dt = 0; dt < 2; ++dt)
#pragma unroll
        for (int i = 0; i < 16; ++i) O[dt][i] = 0.f;
    const LAS bf16* vbase = Vl + (32 * wave + 4 * hl + ((lane & 15) >> 2)) * 72 + 16 * ((lane >> 4) & 1) + 4 * (lane & 3);
#pragma unroll
    for (int kt = 0; kt < 5; ++kt)
#pragma unroll
        for (int s2 = 0; s2 < 2; ++s2) {
            const u32x4 pw = (u32x4){pk2(S[kt][8 * s2 + 0], S[kt][8 * s2 + 1]), pk2(S[kt][8 * s2 + 2], S[kt][8 * s2 + 3]), pk2(S[kt][8 * s2 + 4], S[kt][8 * s2 + 5]), pk2(S[kt][8 * s2 + 6], S[kt][8 * s2 + 7])};
            const bf16x8 Pf = __builtin_bit_cast(bf16x8, pw);
#pragma unroll
            for (int dt = 0; dt < 2; ++dt) { const LAS bf16* vp = vbase + (32 * kt + 16 * s2) * 72 + 32 * dt;
                const s16x4 a0 = __builtin_amdgcn_ds_read_tr16_b64_v4i16((LAS s16x4*)vp), a1 = __builtin_amdgcn_ds_read_tr16_b64_v4i16((LAS s16x4*)(vp + 8 * 72));
                const bf16x8 Af = (bf16x8){a0[0], a0[1], a0[2], a0[3], a1[0], a1[1], a1[2], a1[3]};
                O[dt] = mfma32(Af, Pf, O[dt]); }
        }
    const float inv = 1.0f / lsum; const size_t R = (size_t)b * SEQ + rho + dil * (u0 + r);
    bf16* og = C_OG + ((size_t)g * TT + R) * 256 + hh * 64 + 4 * hl;
#pragma unroll
    for (int dt = 0; dt < 2; ++dt)
#pragma unroll
        for (int g4 = 0; g4 < 4; ++g4) *(u32x2*)(og + 32 * dt + 8 * g4) = (u32x2){pk2(O[dt][4 * g4 + 0] * inv, O[dt][4 * g4 + 1] * inv), pk2(O[dt][4 * g4 + 2] * inv, O[dt][4 * g4 + 3] * inv)};
    if (hl == 0) C_LSE[((size_t)g * TT + R) * 4 + hh] = mx * 0.125f + __logf(lsum);
    __syncthreads();
}
__device__ __forceinline__ void dil_attn_sample_item(const Ctx& c, int sr, int hh, int e) {
    const int lane = c.lane, kg = lane >> 4, dl = lane & 15, R = TP + sr, n = sr >> 2, t = sr & 3;
    float m = -1e30f, l = 0.f, acc[4] = {0.f, 0.f, 0.f, 0.f};
#pragma unroll
    for (int g = 0; g < 3; ++g) {
        const int dil = (g == 0) ? 1 : (g == 1 ? 4 : 16), W = 128 * dil, jn = t / dil;
        float q[4]; unpk4(*(const u32x2*)(C_HB + (size_t)R * LDH + EC_QB + g * 256 + hh * 64 + 4 * dl), q);
#pragma unroll
        for (int i = 0; i < 4; ++i) q[i] *= 0.125f;
        { const int j = kg; const bool valid = j <= jn; const int tt = valid ? t - dil * j : t;
            const bf16* kp = C_HB + (size_t)(TP + n * 4 + tt) * LDH + g * 256 + hh * 64 + 4 * dl; float kf[4], vf[4]; unpk4(*(const u32x2*)(kp + EC_KB), kf); unpk4(*(const u32x2*)(kp + EC_VB), vf);
            float s = red16(q[0] * kf[0] + q[1] * kf[1] + q[2] * kf[2] + q[3] * kf[3]);
            if (valid) { const float mn = fmaxf(m, s), sc = __expf(m - mn), p = __expf(s - mn); l = l * sc + p;
#pragma unroll
                for (int i = 0; i < 4; ++i) acc[i] = acc[i] * sc + p * vf[i];
                m = mn; } }
        const float* cache = ((g == 0) ? C_IN(4) : (g == 1 ? C_IN(5) : C_IN(6))) + ((size_t)(e * 8 + n) * W) * 512 + hh * 64 + 4 * dl;
#pragma unroll 11
        for (int j0 = 0; j0 < 132; j0 += 4) { const int j = j0 + kg; const bool valid = (j > jn) && (j <= 128); const int idx = valid ? W + t - dil * j : 0;
            const float* kp = cache + (size_t)idx * 512; const f32x4 k4 = *(const f32x4*)kp, v4 = *(const f32x4*)(kp + 256);
            const float s = red16(q[0] * k4.x + q[1] * k4.y + q[2] * k4.z + q[3] * k4.w);
            if (valid) { const float mn = fmaxf(m, s), sc = __expf(m - mn), p = __expf(s - mn); l = l * sc + p;
                acc[0] = acc[0] * sc + p * v4.x; acc[1] = acc[1] * sc + p * v4.y; acc[2] = acc[2] * sc + p * v4.z; acc[3] = acc[3] * sc + p * v4.w; m = mn; } }
    }
#pragma unroll
    for (int off = 16; off <= 32; off <<= 1) {
        const float m2 = __shfl_xor(m, off), l2 = __shfl_xor(l, off); float a2[4];
#pragma unroll
        for (int i = 0; i < 4; ++i) a2[i] = __shfl_xor(acc[i], off);
        const float mn = fmaxf(m, m2), s1 = __expf(m - mn), s2 = __expf(m2 - mn);
        l = l * s1 + l2 * s2;
#pragma unroll
        for (int i = 0; i < 4; ++i) acc[i] = acc[i] * s1 + a2[i] * s2;
        m = mn;
    }
    if (kg == 0) { float gt[4]; unpk4(*(const u32x2*)(C_HB + (size_t)R * LDH + EC_GB + hh * 64 + 4 * dl), gt);
        const float inv = 1.0f / l; float o[4];
#pragma unroll
        for (int i = 0; i < 4; ++i) o[i] = acc[i] * inv * siluf_(gt[i]);
        *(u32x2*)(C_U + (size_t)R * EVEN_OUT + 768 + hh * 64 + 4 * dl) = (u32x2){pk2(o[0], o[1]), pk2(o[2], o[3])}; }
}


__device__ __forceinline__ void mem_attn_sample_block(const Ctx& c, int item, int l, int qcol, int gcol, int ucol, int ldu) {
    const int sr = item >> 2, mh = item & 3, R = TP + sr, lane = c.lane, kg = lane >> 5, dl = lane & 31, wave = c.wave;
    const float* mkv = C_IN(8) + ((size_t)l * 8 + (sr >> 2)) * 256 * 1024 + mh * 128 + 4 * dl;
    float q[4]; unpk4(*(const u32x2*)(C_HB + (size_t)R * LDH + qcol + mh * 128 + 4 * dl), q);
#pragma unroll
    for (int i = 0; i < 4; ++i) q[i] *= 0.08838834764831845f;
    float m = -1e30f, lsum = 0.f, acc[4] = {0.f, 0.f, 0.f, 0.f};
    f32x4 kv[16], vv[16];
#pragma unroll
    for (int jr = 0; jr < 16; ++jr) { const float* kp = mkv + (size_t)(32 * wave + 2 * jr + kg) * 1024; kv[jr] = *(const f32x4*)kp; vv[jr] = *(const f32x4*)(kp + 512); }
#pragma unroll
    for (int jr = 0; jr < 16; ++jr) { const f32x4 k4 = kv[jr], v4 = vv[jr];
        float s = q[0] * k4.x + q[1] * k4.y + q[2] * k4.z + q[3] * k4.w;
        s = red16(s); s += __shfl_xor(s, 16);
        const float mn = fmaxf(m, s), sc = __expf(m - mn), p = __expf(s - mn);
        lsum = lsum * sc + p; acc[0] = acc[0] * sc + p * v4.x; acc[1] = acc[1] * sc + p * v4.y; acc[2] = acc[2] * sc + p * v4.z; acc[3] = acc[3] * sc + p * v4.w; m = mn; }
    { const float m2 = __shfl_xor(m, 32), l2 = __shfl_xor(lsum, 32); float a2[4];
#pragma unroll
        for (int i = 0; i < 4; ++i) a2[i] = __shfl_xor(acc[i], 32);
        const float mn = fmaxf(m, m2), s1 = __expf(m - mn), s2 = __expf(m2 - mn);
        lsum = lsum * s1 + l2 * s2; m = mn;
#pragma unroll
        for (int i = 0; i < 4; ++i) acc[i] = acc[i] * s1 + a2[i] * s2; }
    LAS float* part = (LAS float*)c.lds;
    if (kg == 0) { LAS float* pp = part + (wave * 32 + dl) * 6; pp[0] = m; pp[1] = lsum; pp[2] = acc[0]; pp[3] = acc[1]; pp[4] = acc[2]; pp[5] = acc[3]; }
    __syncthreads();
    if (wave == 0 && kg == 0) {
        float M = -1e30f, Lr = 0.f, A[4] = {0.f, 0.f, 0.f, 0.f};
#pragma unroll
        for (int w = 0; w < 8; ++w) { const LAS float* pp = part + (w * 32 + dl) * 6; const float m2 = pp[0], mn = fmaxf(M, m2), s1 = __expf(M - mn), s2 = __expf(m2 - mn);
            Lr = Lr * s1 + pp[1] * s2; A[0] = A[0] * s1 + pp[2] * s2; A[1] = A[1] * s1 + pp[3] * s2; A[2] = A[2] * s1 + pp[4] * s2; A[3] = A[3] * s1 + pp[5] * s2; M = mn; }
        float gt[4]; unpk4(*(const u32x2*)(C_HB + (size_t)R * LDH + gcol + mh * 128 + 4 * dl), gt);
        const float inv = 1.0f / Lr;
        *(u32x2*)(C_U + (size_t)R * ldu + ucol + mh * 128 + 4 * dl) = (u32x2){pk2(A[0] * inv * siluf_(gt[0]), A[1] * inv * siluf_(gt[1])), pk2(A[2] * inv * siluf_(gt[2]), A[3] * inv * siluf_(gt[3]))}; }
    __syncthreads();
}
__device__ __forceinline__ void dil_attn_sample_block(const Ctx& c, int item, int e) {
    const int sr = item >> 2, hh = item & 3, lane = c.lane, kg = lane >> 4, dl = lane & 15, wave = c.wave, R = TP + sr, n = sr >> 2, t = sr & 3;
    float m = -1e30f, l = 0.f, acc[4] = {0.f, 0.f, 0.f, 0.f};
#pragma unroll
    for (int g = 0; g < 3; ++g) {
        const int dil = (g == 0) ? 1 : (g == 1 ? 4 : 16), W = 128 * dil, jn = t / dil;
        float q[4]; unpk4(*(const u32x2*)(C_HB + (size_t)R * LDH + EC_QB + g * 256 + hh * 64 + 4 * dl), q);
#pragma unroll
        for (int i = 0; i < 4; ++i) q[i] *= 0.125f;
        if (wave == 0) { const int j = kg; const bool valid = j <= jn; const int tt = valid ? t - dil * j : t;
            const bf16* kp = C_HB + (size_t)(TP + n * 4 + tt) * LDH + g * 256 + hh * 64 + 4 * dl; float kf[4], vf[4]; unpk4(*(const u32x2*)(kp + EC_KB), kf); unpk4(*(const u32x2*)(kp + EC_VB), vf);
            float s = red16(q[0] * kf[0] + q[1] * kf[1] + q[2] * kf[2] + q[3] * kf[3]);
            if (valid) { const float mn = fmaxf(m, s), sc = __expf(m - mn), p = __expf(s - mn); l = l * sc + p;
#pragma unroll
                for (int i = 0; i < 4; ++i) acc[i] = acc[i] * sc + p * vf[i];
                m = mn; } }
        const float* cache = ((g == 0) ? C_IN(4) : (g == 1 ? C_IN(5) : C_IN(6))) + ((size_t)(e * 8 + n) * W) * 512 + hh * 64 + 4 * dl;
        f32x4 kv[5], vv[5]; bool ok[5];
#pragma unroll
        for (int jr = 0; jr < 5; ++jr) { const int jo = 4 * jr + kg, j = 17 * wave + jo; ok[jr] = (jo < 17) && (j > jn) && (j <= 128); const int idx = ok[jr] ? W + t - dil * j : 0;
            const float* kp = cache + (size_t)idx * 512; kv[jr] = *(const f32x4*)kp; vv[jr] = *(const f32x4*)(kp + 256); }
#pragma unroll
        for (int jr = 0; jr < 5; ++jr) { const f32x4 k4 = kv[jr], v4 = vv[jr];
            const float s = red16(q[0] * k4.x + q[1] * k4.y + q[2] * k4.z + q[3] * k4.w);
            if (ok[jr]) { const float mn = fmaxf(m, s), sc = __expf(m - mn), p = __expf(s - mn); l = l * sc + p;
                acc[0] = acc[0] * sc + p * v4.x; acc[1] = acc[1] * sc + p * v4.y; acc[2] = acc[2] * sc + p * v4.z; acc[3] = acc[3] * sc + p * v4.w; m = mn; } }
    }
#pragma unroll
    for (int off = 16; off <= 32; off <<= 1) {
        const float m2 = __shfl_xor(m, off), l2 = __shfl_xor(l, off); float a2[4];
#pragma unroll
        for (int i = 0; i < 4; ++i) a2[i] = __shfl_xor(acc[i], off);
        const float mn = fmaxf(m, m2), s1 = __expf(m - mn), s2 = __expf(m2 - mn);
        l = l * s1 + l2 * s2;
#pragma unroll
        for (int i = 0; i < 4; ++i) acc[i] = acc[i] * s1 + a2[i] * s2;
        m = mn;
    }
    LAS float* part = (LAS float*)c.lds;
    if (kg == 0) { LAS float* pp = part + (wave * 16 + dl) * 6; pp[0] = m; pp[1] = l; pp[2] = acc[0]; pp[3] = acc[1]; pp[4] = acc[2]; pp[5] = acc[3]; }
    __syncthreads();
    if (wave == 0 && kg == 0) {
        float M = -1e30f, Lr = 0.f, A[4] = {0.f, 0.f, 0.f, 0.f};
#pragma unroll
        for (int w = 0; w < 8; ++w) { const LAS float* pp = part + (w * 16 + dl) * 6; const float m2 = pp[0], mn = fmaxf(M, m2), s1 = __expf(M - mn), s2 = __expf(m2 - mn);
            Lr = Lr * s1 + pp[1] * s2; A[0] = A[0] * s1 + pp[2] * s2; A[1] = A[1] * s1 + pp[3] * s2; A[2] = A[2] * s1 + pp[4] * s2; A[3] = A[3] * s1 + pp[5] * s2; M = mn; }
        float gt[4]; unpk4(*(const u32x2*)(C_HB + (size_t)R * LDH + EC_GB + hh * 64 + 4 * dl), gt);
        const float inv = 1.0f / Lr;
        *(u32x2*)(C_U + (size_t)R * EVEN_OUT + 768 + hh * 64 + 4 * dl) = (u32x2){pk2(A[0] * inv * siluf_(gt[0]), A[1] * inv * siluf_(gt[1])), pk2(A[2] * inv * siluf_(gt[2]), A[3] * inv * siluf_(gt[3]))}; }
    __syncthreads();
}

__device__ __forceinline__ void even_copies(const Ctx& c, int e) {
    const int gt = c.bid * 512 + c.tid, NT = c.G * 512;
    for (int i = gt; i < 10 * 304; i += NT) { const int rw = i / 304, c8 = 8 * (i % 304);
        const size_t src = (rw < 2) ? (size_t)(rw * SEQ + SEQ - 1) : (size_t)(TP + (rw - 2) * 4 + 3);
        float x[8]; unpk8(*(const u32x4*)(C_HB + src * LDH + c8), x);
        float* dst = (rw < 2) ? C_OUT + O_SH_P + ((size_t)e * 2 + rw) * 2432 + c8 : C_OUT + O_SH_S + ((size_t)e * 8 + (rw - 2)) * 2432 + c8;
        *(f32x4*)dst = (f32x4){x[0], x[1], x[2], x[3]}; *(f32x4*)(dst + 4) = (f32x4){x[4], x[5], x[6], x[7]}; }
#pragma unroll 1
    for (int g = 0; g < 3; ++g) {
        const int keep = 128 << (2 * g); const size_t op = (g == 0) ? O_G0P : (g == 1 ? O_G1P : O_G2P), os = (g == 0) ? O_G0S : (g == 1 ? O_G1S : O_G2S);
        for (int i0 = gt; i0 < 2 * keep * 64; i0 += 4 * NT) { u32x4 w[4];
#pragma unroll
            for (int k = 0; k < 4; ++k) { const int i = (i0 + k * NT < 2 * keep * 64) ? i0 + k * NT : i0; const int pc = i & 63, r = (i >> 6) % keep, b = (i >> 6) / keep;
                const int col = ((pc & 32) ? EC_VB : EC_KB) + g * 256 + 8 * (pc & 31); w[k] = *(const u32x4*)(C_HB + (size_t)(b * SEQ + SEQ - keep + r) * LDH + col); }
#pragma unroll
            for (int k = 0; k < 4; ++k) { const int i = i0 + k * NT; if (i < 2 * keep * 64) { const int pc = i & 63, r = (i >> 6) % keep, b = (i >> 6) / keep;
                float x[8]; unpk8(w[k], x); float* dst = C_OUT + op + ((size_t)e * 2 * keep + (size_t)b * keep + r) * 512 + 8 * pc;
                *(f32x4*)dst = (f32x4){x[0], x[1], x[2], x[3]}; *(f32x4*)(dst + 4) = (f32x4){x[4], x[5], x[6], x[7]}; } } }
        for (int i = gt; i < 8 * 4 * 64; i += NT) { const int pc = i & 63, row = i >> 6;
            const int col = ((pc & 32) ? EC_VB : EC_KB) + g * 256 + 8 * (pc & 31);
            float x[8]; unpk8(*(const u32x4*)(C_HB + (size_t)(TP + row) * LDH + col), x);
            float* dst = C_OUT + os + ((size_t)e * 32 + row) * 512 + 8 * pc;
            *(f32x4*)dst = (f32x4){x[0], x[1], x[2], x[3]}; *(f32x4*)(dst + 4) = (f32x4){x[4], x[5], x[6], x[7]}; }
    }
}

#define LAUNDER_C(c) do { asm volatile("" : "+s"((c).ap), "+v"((c).tid), "+s"((c).bid), "+s"((c).G)); (c).lane = (c).tid & 63; (c).wave = __builtin_amdgcn_readfirstlane((c).tid >> 6); } while (0)
__device__ __forceinline__ void phase_even_tok_pre(Ctx c, int l);
__device__ __forceinline__ void even_helper_work(Ctx c, int l) {
    const int e = l >> 1;
    for (int rp = 0; rp < REPD; ++rp) { for (int it = c.bid; it < 384; it += c.G) dil_attn_mfma_item(c, it);
    LAUNDER_C(c); }
    for (int it = c.G - 1 - c.bid; it < TS * 4; it += c.G) dil_attn_sample_block(c, it, e);
    LAUNDER_C(c);
    for (int rp = 0; rp < REPM; ++rp) { mem_attn_all(c, l, EC_QM, EC_GM, 1024, EVEN_OUT);
    LAUNDER_C(c); }
    even_copies(c, e);
    LAUNDER_C(c);
    for (int rp = 0; rp < REPC; ++rp) { if (l < 3) convert_layer_weights(c, l + 1); LAUNDER_C(c); }
}

__device__ __forceinline__ void rwkv_scan_item(const Ctx& c, int item, int e) {
    constexpr int CH = 32;
    LAS float* buf = (LAS float*)c.lds;
    LAS float* ybuf = buf + 2 * CH * 384;
    const bool is_p = item < 48; const int st = is_p ? (item >> 1) : ((item - 48) >> 1), half = item & 1;
    const int h = st % 12, bn = st / 12; const int T = is_p ? SEQ : 4; const size_t tok0 = is_p ? (size_t)bn * SEQ : (size_t)(TP + bn * 4);
    const int lane = c.lane, rw = lane >> 4, cgp = lane & 15, il = 4 * c.wave + rw, i = 32 * half + il;
    float s[4];
    if (is_p) { s[0] = s[1] = s[2] = s[3] = 0.f; }
    else { const f32x4 v = *(const f32x4*)(C_IN(2) + ((((size_t)e * 8 + bn) * 12 + h) * 64 + i) * 64 + 4 * cgp); s[0] = v.x; s[1] = v.y; s[2] = v.z; s[3] = v.w; }
    const int nch = (T + CH - 1) / CH;
    f32x4 pre[6];
#define SCAN_GLOAD(ch_) do { _Pragma("unroll") for (int k = 0; k < 6; ++k) { const int idx = c.tid + 512 * k, tl_ = idx / 96, f4 = idx % 96; const int tk = (ch_) * CH + tl_; \
            pre[k] = (tk < T) ? *(const f32x4*)(C_PREPS + ((tok0 - TP + tk) * 12 + h) * 384 + 4 * f4) : (f32x4){0.f, 0.f, 0.f, 0.f}; } } while (0)
#define SCAN_LSTORE(bi_) do { _Pragma("unroll") for (int k = 0; k < 6; ++k) { const int idx = c.tid + 512 * k; *(LAS f32x4*)(buf + (bi_) * CH * 384 + 4 * idx) = pre[k]; } } while (0)
    SCAN_GLOAD(0); SCAN_LSTORE(0); __syncthreads();
#pragma unroll 1
    for (int ch = 0; ch < nch; ++ch) {
        if (ch + 1 < nch) SCAN_GLOAD(ch + 1);
        const LAS float* bb = buf + (ch & 1) * CH * 384;
        const int nt = (T - ch * CH) < CH ? (T - ch * CH) : CH;
#pragma unroll 2
        for (int tl = 0; tl < nt; ++tl) {
            const LAS float* p = bb + tl * 384;
            const f32x4 r4 = *(const LAS f32x4*)(p + 4 * cgp), d4 = *(const LAS f32x4*)(p + 64 + 4 * cgp), k4 = *(const LAS f32x4*)(p + 128 + 4 * cgp),
                        kk4 = *(const LAS f32x4*)(p + 256 + 4 * cgp), b4 = *(const LAS f32x4*)(p + 320 + 4 * cgp);
            const float vi = p[192 + i];
            float sa = s[0] * kk4.x + s[1] * kk4.y + s[2] * kk4.z + s[3] * kk4.w;
            sa = red16(sa);
            s[0] = s[0] * d4.x + (sa * b4.x + vi * k4.x); s[1] = s[1] * d4.y + (sa * b4.y + vi * k4.y);
            s[2] = s[2] * d4.z + (sa * b4.z + vi * k4.z); s[3] = s[3] * d4.w + (sa * b4.w + vi * k4.w);
            float y = s[0] * r4.x + s[1] * r4.y + s[2] * r4.z + s[3] * r4.w;
            y = red16(y);
            if (cgp == 0) ybuf[tl * 32 + il] = y;
        }
        __syncthreads();
        if (ch + 1 < nch) SCAN_LSTORE((ch + 1) & 1);
        for (int idx = c.tid; idx < nt * 32; idx += 512) { const int tl = idx >> 5, r = idx & 31; C_YA[(tok0 + ch * CH + tl) * 768 + h * 64 + 32 * half + r] = (bf16)f2bf(ybuf[idx]); }
        __syncthreads();
    }
    float* so = C_OUT + (is_p ? O_RWKV_P + (((size_t)e * 2 + bn) * 12 + h) * 4096 : O_RWKV_S + (((size_t)e * 8 + bn) * 12 + h) * 4096) + (size_t)i * 64 + 4 * cgp;
    *(f32x4*)so = (f32x4){s[0], s[1], s[2], s[3]};
}

typedef float f32x2 __attribute__((ext_vector_type(2)));
__device__ __forceinline__ void rwkv_scan_prompt(const Ctx& c, int item, int e) {
    constexpr int CH = 32, NCH = SEQ / CH;
    LAS float* buf = (LAS float*)c.lds;
    LAS float* ybuf = buf + 2 * CH * 384;
    const int st = item >> 1, half = item & 1, h = st % 12, bn = st / 12; const size_t tok0 = (size_t)bn * SEQ;
    const int lane = c.lane, rw = lane >> 4, cgp = lane & 15, il = 4 * c.wave + rw, i = 32 * half + il;
    f32x2 s01 = (f32x2){0.f, 0.f}, s23 = (f32x2){0.f, 0.f};
    const float* src = C_PREP + (tok0 * 12 + h) * 384;
    bf16* ya = C_YA + tok0 * 768 + h * 64 + 32 * half;
    f32x4 pre[6];
#define SP_GLOAD(ch_) do { _Pragma("unroll") for (int k = 0; k < 6; ++k) { const int idx = c.tid + 512 * k, tl_ = idx / 96, f4 = idx % 96; \
        pre[k] = *(const f32x4*)(src + (size_t)((ch_) * CH + tl_) * (12 * 384) + 4 * f4); } } while (0)
#define SP_LSTORE(bi_) do { _Pragma("unroll") for (int k = 0; k < 6; ++k) { const int idx = c.tid + 512 * k; *(LAS f32x4*)(buf + (bi_) * CH * 384 + 4 * idx) = pre[k]; } } while (0)
#define SP_YOUT(ch_) do { for (int idx = c.tid; idx < CH * 32; idx += 512) { const int tl_ = idx >> 5, r_ = idx & 31; ya[(size_t)((ch_) * CH + tl_) * 768 + r_] = (bf16)f2bf(ybuf[((ch_) & 1) * CH * 32 + idx]); } } while (0)
    SP_GLOAD(0); SP_LSTORE(0); SP_GLOAD(1); __syncthreads();
#pragma unroll 1
    for (int ch = 0; ch < NCH; ++ch) {
        if (ch + 1 < NCH) SP_LSTORE((ch + 1) & 1);
        if (ch + 2 < NCH) SP_GLOAD(ch + 2);
        if (ch > 0) SP_YOUT(ch - 1);
        const LAS float* bb = buf + (ch & 1) * CH * 384 + 4 * cgp; const LAS float* vb = buf + (ch & 1) * CH * 384 + 192 + i;
        LAS float* yw = (cgp == 0) ? (ybuf + (ch & 1) * CH * 32 + il) : (ybuf + 2 * CH * 32 + lane);
        f32x4 r4 = *(const LAS f32x4*)bb, d4 = *(const LAS f32x4*)(bb + 64), k4 = *(const LAS f32x4*)(bb + 128), n4 = *(const LAS f32x4*)(bb + 256), b4 = *(const LAS f32x4*)(bb + 320); float vi = vb[0];
        float sa;
        { f32x2 p = s01 * (f32x2){n4.x, n4.y}; p = s23 * (f32x2){n4.z, n4.w} + p; sa = red16(p.x + p.y); }
#pragma unroll 4
        for (int tl = 0; tl < CH; ++tl) {
            const int tn = (tl + 1 < CH) ? tl + 1 : tl;
            const f32x4 r4n = *(const LAS f32x4*)(bb + tn * 384), d4n = *(const LAS f32x4*)(bb + tn * 384 + 64), k4n = *(const LAS f32x4*)(bb + tn * 384 + 128),
                        n4n = *(const LAS f32x4*)(bb + tn * 384 + 256), b4n = *(const LAS f32x4*)(bb + tn * 384 + 320); const float vin = vb[tn * 384];
            const f32x2 vi2 = (f32x2){vi, vi}, sa2 = (f32x2){sa, sa};
            const f32x2 u01 = s01 * (f32x2){d4.x, d4.y} + vi2 * (f32x2){k4.x, k4.y}, u23 = s23 * (f32x2){d4.z, d4.w} + vi2 * (f32x2){k4.z, k4.w};
            s01 = sa2 * (f32x2){b4.x, b4.y} + u01; s23 = sa2 * (f32x2){b4.z, b4.w} + u23;
            f32x2 yp = s01 * (f32x2){r4.x, r4.y}; yp = s23 * (f32x2){r4.z, r4.w} + yp;
            f32x2 pn = s01 * (f32x2){n4n.x, n4n.y}; pn = s23 * (f32x2){n4n.z, n4n.w} + pn;
            float ya_ = yp.x + yp.y, sb_ = pn.x + pn.y;
            sb_ += dppf<0xB1>(sb_); ya_ += dppf<0xB1>(ya_); sb_ += dppf<0x4E>(sb_); ya_ += dppf<0x4E>(ya_);
            sb_ += dppf<0x141>(sb_); ya_ += dppf<0x141>(ya_); sb_ += dppf<0x140>(sb_); ya_ += dppf<0x140>(ya_);
            sa = sb_;
            yw[tl * 32] = ya_;
            r4 = r4n; d4 = d4n; k4 = k4n; n4 = n4n; b4 = b4n; vi = vin;
        }
        __syncthreads();
    }
    SP_YOUT(NCH - 1);
    float* so = C_OUT + O_RWKV_P + (((size_t)e * 2 + bn) * 12 + h) * 4096 + (size_t)i * 64 + 4 * cgp;
    *(f32x4*)so = (f32x4){s01.x, s01.y, s23.x, s23.y};
    __syncthreads();
#undef SP_GLOAD
#undef SP_LSTORE
#undef SP_YOUT
}

typedef unsigned short u16x2 __attribute__((ext_vector_type(2)));
struct PreIn { u32x2 cr, ck, cv, pr, pk, pv; u16x2 hh[8]; float hsh; bf16x8 wtf[2][2]; };
__device__ __forceinline__ void rwkv_chunk_preload(const Ctx& c, int item, int e, PreIn& P) {
    const bool is_s = item >= 3072; const int sidx = item - 3072;
    const int bh = item >> 7, n = is_s ? 1 : (item & 127), b = bh / 12, h = is_s ? (sidx % 12) : (bh % 12), ns = sidx / 12;
    const size_t R0 = is_s ? (size_t)(TP + 4 * ns) : (size_t)b * SEQ + 32 * n;
    const float* shift = C_IN(3) + ((size_t)e * 8 + ns) * 2432;
    const int tid = c.tid, t_ = tid >> 4, c4 = 4 * (tid & 15), col = h * 64 + c4;
    const bf16* hc = C_HB + (R0 + t_) * LDH + col; const bool hasprev = is_s ? (t_ != 0) : ((32 * n + t_) != 0);
    const u32x2 z2 = (u32x2){0u, 0u};
    P.cr = *(const u32x2*)(hc + EC_R); P.ck = *(const u32x2*)(hc + EC_K); P.cv = *(const u32x2*)(hc + EC_V);
    P.pr = hasprev ? *(const u32x2*)(hc - LDH + EC_R) : z2; P.pk = hasprev ? *(const u32x2*)(hc - LDH + EC_K) : z2; P.pv = hasprev ? *(const u32x2*)(hc - LDH + EC_V) : z2;
    const int cc = tid & 127, cl = EC_HW + cc, tb = tid >> 7;
#pragma unroll
    for (int k = 0; k < 8; ++k) { const int t = tb + 4 * k; const unsigned short* hp = (const unsigned short*)C_HB + (R0 + t) * LDH + cl; const bool first = is_s ? (t == 0) : ((32 * n + t) == 0);
        P.hh[k].x = hp[0]; P.hh[k].y = hp[first ? 0 : -(ptrdiff_t)LDH]; }
    P.hsh = is_s ? shift[cl] : 0.f;
    { const int wave = c.wave, fr = c.lane & 15, fq = c.lane >> 4, p = wave >> 2; const bf16* WT = (p ? C_AUT : C_WUT) + ((size_t)e * 768 + h * 64) * 64;
#pragma unroll
        for (int cc = 0; cc < 2; ++cc) { const int ct = 2 * (wave & 1) + cc;
#pragma unroll
            for (int ks = 0; ks < 2; ++ks) P.wtf[cc][ks] = *(const bf16x8*)(WT + (size_t)(16 * ct + fr) * 64 + 32 * ks + 8 * fq); } }
}
constexpr int PRE_PAR_OFF = 114688;
__device__ __forceinline__ void rwkv_stage_params(const Ctx& c, int e) {
    LAS float* PP = (LAS float*)(c.lds + PRE_PAR_OFF);
    for (int i = c.tid; i < 768 / 4; i += 512) { const int o = 4 * i;
        *(LAS f32x4*)(PP + o) = *(const f32x4*)(C_IN(18) + e * 768 + o); *(LAS f32x4*)(PP + 768 + o) = *(const f32x4*)(C_IN(20) + e * 768 + o); *(LAS f32x4*)(PP + 1536 + o) = *(const f32x4*)(C_IN(22) + e * 768 + o);
        *(LAS f32x4*)(PP + 2304 + o) = *(const f32x4*)(C_IN(23) + e * 768 + o); *(LAS f32x4*)(PP + 3072 + o) = *(const f32x4*)(C_IN(24) + e * 768 + o); }
    for (int i = c.tid; i < 2432 / 4; i += 512) *(LAS f32x4*)(PP + 3840 + 4 * i) = *(const f32x4*)(C_IN(17) + e * 2432 + 4 * i);
    __syncthreads();
}
__device__ __forceinline__ void rwkv_chunk_precompute(const Ctx& c, int item, int e, const PreIn& P, int nx_item, PreIn& PN) {
    const bool is_s = item >= 3072; const int sidx = item - 3072;
    const int bh = item >> 7, n = is_s ? 1 : (item & 127), b = bh / 12, h = is_s ? (sidx % 12) : (bh % 12), ns = sidx / 12, ntok = is_s ? 4 : 32;
    const size_t R0 = is_s ? (size_t)(TP + 4 * ns) : (size_t)b * SEQ + 32 * n;
    const float* shift = C_IN(3) + ((size_t)e * 8 + ns) * 2432;
    LAS unsigned char* L = c.lds;
    LAS float* XW = (LAS float*)(L + 0); LAS float* XA = (LAS float*)(L + 8704);
    LAS bf16* LW = (LAS bf16*)(L + 17408); LAS bf16* LA = (LAS bf16*)(L + 22016);
    LAS float* PS = (LAS float*)(L + 26624);
    LAS bf16* KKt = (LAS bf16*)(L + 34816); LAS bf16* Bt = (LAS bf16*)(L + 39424); LAS bf16* Kt = (LAS bf16*)(L + 44032); LAS bf16* Rt = (LAS bf16*)(L + 48640);
    LAS bf16* Bh = (LAS bf16*)(L + 53248); LAS bf16* Kh = (LAS bf16*)(L + 57856); LAS bf16* Vb = (LAS bf16*)(L + 62464);
    LAS float* LB = (LAS float*)(L + 67072);
    LAS bf16* Lk = (LAS bf16*)(L + 71680); LAS bf16* Mb = (LAS bf16*)(L + 74240); LAS bf16* Mk = (LAS bf16*)(L + 76800);
    LAS float* SOL = (LAS float*)(L + 79360);
    LAS bf16* KTb = (LAS bf16*)(L + 96256); LAS bf16* UVb = (LAS bf16*)(L + 100864);
    LAS float* RTf = (LAS float*)(L + 105472); LAS float* c31 = (LAS float*)(L + 114176);
    const int tid = c.tid, lane = c.lane, wave = c.wave, fr = lane & 15, fq = lane >> 4, trow = (lane & 15) >> 2, tcol = 4 * (lane & 3);
    const int t_ = tid >> 4, c4 = 4 * (tid & 15), col = h * 64 + c4;
    const LAS float* PP = (const LAS float*)(c.lds + PRE_PAR_OFF); const LAS float* mu = PP + 3840;
    const bf16* hc = C_HB + (R0 + t_) * LDH + col; const bool hasprev = is_s ? (t_ != 0) : ((32 * n + t_) != 0);
    const u32x2 cr = P.cr, ck = P.ck, cv = P.cv, pr = P.pr, pk = P.pk, pv = P.pv;
    f32x4 sh_r = (f32x4){0.f, 0.f, 0.f, 0.f}, sh_k = sh_r, sh_v = sh_r;
    if (is_s && t_ == 0) { sh_r = *(const f32x4*)(shift + EC_R + col); sh_k = *(const f32x4*)(shift + EC_K + col); sh_v = *(const f32x4*)(shift + EC_V + col); }
    { const int cc = tid & 127, cl = EC_HW + cc, tb = tid >> 7; const float muc = mu[cl];
#pragma unroll
        for (int k = 0; k < 8; ++k) { const int t = tb + 4 * k; const bool first = is_s ? (t == 0) : ((32 * n + t) == 0); const float hcur = bf2f((unsigned)P.hh[k].x), hprv = first ? P.hsh : bf2f((unsigned)P.hh[k].y);
            const float hs = hcur + (hprv - hcur) * muc;
            if (cc < 64) LW[t * 72 + cc] = (bf16)f2bf(1.0f - 2.0f * __builtin_amdgcn_rcpf(1.0f + __expf(2.0f * hs))); else LA[t * 72 + cc - 64] = (bf16)f2bf(hs); } }
    __syncthreads();
    { const int p = wave >> 2, tt = (wave >> 1) & 1; const LAS bf16* As = p ? LA : LW; LAS float* X = p ? XA : XW;
#pragma unroll
        for (int cc = 0; cc < 2; ++cc) { const int ct = 2 * (wave & 1) + cc; f32x4 acc = (f32x4){0.f, 0.f, 0.f, 0.f};
#pragma unroll
            for (int ks = 0; ks < 2; ++ks) acc = mfma16(*(const LAS bf16x8*)(As + (16 * tt + fr) * 72 + 32 * ks + 8 * fq), P.wtf[cc][ks], acc);
#pragma unroll
            for (int r = 0; r < 4; ++r) X[(16 * tt + 4 * fq + r) * 68 + 16 * ct + fr] = acc[r]; } }
    __syncthreads();
    float rr[4], k2[4], vv[4], kkv[4], bb[4];
    for (int rep3 = 0; rep3 < REP3; ++rep3) { asm volatile("" ::: "memory");
    { const bool tok_ok = t_ < ntok;
        float rv[4], kv[4], vv0[4], wl[4], av[4], ssum = 0.f, bsum = 0.f;
        { const f32x4 mr4 = *(const LAS f32x4*)(mu + EC_R + col), mk4 = *(const LAS f32x4*)(mu + EC_K + col), mv4 = *(const LAS f32x4*)(mu + EC_V + col);
            float crf[4], ckf[4], cvf[4], prf[4], pkf[4], pvf[4]; unpk4(cr, crf); unpk4(ck, ckf); unpk4(cv, cvf); unpk4(pr, prf); unpk4(pk, pkf); unpk4(pv, pvf);
#pragma unroll
            for (int i = 0; i < 4; ++i) { prf[i] += sh_r[i]; pkf[i] += sh_k[i]; pvf[i] += sh_v[i];
                rv[i] = crf[i] + (prf[i] - crf[i]) * mr4[i]; kv[i] = ckf[i] + (pkf[i] - ckf[i]) * mk4[i]; vv0[i] = cvf[i] + (pvf[i] - cvf[i]) * mv4[i]; } }
        __builtin_amdgcn_sched_barrier(0);
        { const f32x4 xw4 = *(const LAS f32x4*)(XW + t_ * 68 + c4), xa4 = *(const LAS f32x4*)(XA + t_ * 68 + c4), w04 = *(const LAS f32x4*)(PP + col), a04 = *(const LAS f32x4*)(PP + 768 + col);
#pragma unroll
            for (int i = 0; i < 4; ++i) { wl[i] = tok_ok ? -0.6065306597126334f * sigmoidf_(w04[i] + xw4[i]) : 0.f; av[i] = sigmoidf_(a04[i] + xa4[i]); } }
        __builtin_amdgcn_sched_barrier(0);
        { const f32x4 kk4 = *(const LAS f32x4*)(PP + 1536 + col), ka4 = *(const LAS f32x4*)(PP + 2304 + col), rk4 = *(const LAS f32x4*)(PP + 3072 + col);
#pragma unroll
            for (int i = 0; i < 4; ++i) { const float r = rv[i], k = kv[i], v = vv0[i];
                const float kk = tok_ok ? k * kk4[i] : 0.f; ssum += kk * kk; kkv[i] = kk; k2[i] = tok_ok ? k * (1.0f + (av[i] - 1.0f) * ka4[i]) : 0.f; rr[i] = tok_ok ? r : 0.f; vv[i] = tok_ok ? v : 0.f; bsum += rr[i] * k2[i] * rk4[i]; } }
        ssum = red16(ssum); bsum = red16(bsum); const float inv = rsqrtf(fmaxf(ssum, 1e-24f));
#pragma unroll
        for (int i = 0; i < 4; ++i) { kkv[i] *= inv; bb[i] = kkv[i] * av[i]; }
        if ((tid & 15) == 0 && tok_ok) C_BONUS[(R0 + t_) * 12 + h] = bsum;
        *(LAS f32x4*)(PS + t_ * 64 + c4) = (f32x4){wl[0], wl[1], wl[2], wl[3]}; }
    __syncthreads();
    if (REP3 == 1) rwkv_chunk_preload(c, nx_item, e, PN);
    if (tid < 64) { float run = 0.f;
#pragma unroll 8
        for (int t = 0; t < 32; ++t) { run += PS[t * 64 + tid]; PS[t * 64 + tid] = run; } }
    __syncthreads();
    { const f32x4 pt = *(const LAS f32x4*)(PS + t_ * 64 + c4), pe = *(const LAS f32x4*)(PS + 31 * 64 + c4); const f32x4 pp = (t_ > 0) ? *(const LAS f32x4*)(PS + (t_ - 1) * 64 + c4) : (f32x4){0.f, 0.f, 0.f, 0.f};
        float o_kk[4], o_b[4], o_k[4], o_r[4], o_bh[4], o_kh[4];
#pragma unroll
        for (int i = 0; i < 4; ++i) { const float ct = __expf(pt[i]), cp = __expf(pp[i]), ci = __expf(-pt[i]), chh = __expf(pe[i] - pt[i]);
            o_kk[i] = kkv[i] * cp; o_b[i] = bb[i] * ci; o_k[i] = k2[i] * ci; o_r[i] = rr[i] * ct; o_bh[i] = bb[i] * chh; o_kh[i] = k2[i] * chh; }
        *(LAS u32x2*)(KKt + t_ * 72 + c4) = (u32x2){pk2(o_kk[0], o_kk[1]), pk2(o_kk[2], o_kk[3])}; *(LAS u32x2*)(Bt + t_ * 72 + c4) = (u32x2){pk2(o_b[0], o_b[1]), pk2(o_b[2], o_b[3])};
        *(LAS u32x2*)(Kt + t_ * 72 + c4) = (u32x2){pk2(o_k[0], o_k[1]), pk2(o_k[2], o_k[3])}; *(LAS u32x2*)(Rt + t_ * 72 + c4) = (u32x2){pk2(o_r[0], o_r[1]), pk2(o_r[2], o_r[3])};
        *(LAS u32x2*)(Bh + t_ * 72 + c4) = (u32x2){pk2(o_bh[0], o_bh[1]), pk2(o_bh[2], o_bh[3])}; *(LAS u32x2*)(Kh + t_ * 72 + c4) = (u32x2){pk2(o_kh[0], o_kh[1]), pk2(o_kh[2], o_kh[3])};
        *(LAS u32x2*)(Vb + t_ * 72 + c4) = (u32x2){pk2(vv[0], vv[1]), pk2(vv[2], vv[3])};
        *(LAS f32x4*)(RTf + t_ * 68 + c4) = (f32x4){o_r[0], o_r[1], o_r[2], o_r[3]}; *(LAS f32x4*)(SOL + t_ * 132 + c4) = (f32x4){o_kk[0], o_kk[1], o_kk[2], o_kk[3]};
        if (t_ == 31) *(LAS f32x4*)(c31 + c4) = (f32x4){__expf(pt[0]), __expf(pt[1]), __expf(pt[2]), __expf(pt[3])}; }
    __syncthreads(); }
    { const int m = wave >> 1, tt = wave & 1; const LAS bf16* X = (m < 2) ? KKt : Rt; const LAS bf16* Yv = (m & 1) ? Kt : Bt;
#pragma unroll
        for (int st = 0; st < 2; ++st) { f32x4 acc = (f32x4){0.f, 0.f, 0.f, 0.f};
            if (st <= tt) {
#pragma unroll
                for (int ks = 0; ks < 2; ++ks) acc = mfma16(*(const LAS bf16x8*)(X + (16 * tt + fr) * 72 + 32 * ks + 8 * fq), *(const LAS bf16x8*)(Yv + (16 * st + fr) * 72 + 32 * ks + 8 * fq), acc); }
#pragma unroll
            for (int r = 0; r < 4; ++r) { const int t = 16 * tt + 4 * fq + r, s_ = 16 * st + fr; const bool keep = (m < 2) ? (s_ < t) : (s_ <= t); const float val = keep ? acc[r] : 0.f;
                if (m == 0) LB[s_ * 36 + (t & 3) * 8 + (t >> 2)] = val; else if (m == 1) Lk[t * 40 + s_] = (bf16)f2bf(val); else if (m == 2) Mb[t * 40 + s_] = (bf16)f2bf(val); else Mk[t * 40 + s_] = (bf16)f2bf(val); } } }
    __syncthreads();
    { const int tt = wave >> 2, ict = wave & 3;
        const f32x4 acc = mfma16(*(const LAS bf16x8*)(Lk + (16 * tt + fr) * 40 + 8 * fq), tr_frag(Vb + (8 * fq + trow) * 72 + 16 * ict + tcol, 4 * 72), (f32x4){0.f, 0.f, 0.f, 0.f});
#pragma unroll
        for (int r = 0; r < 4; ++r) SOL[(16 * tt + 4 * fq + r) * 132 + 64 + 16 * ict + fr] = acc[r]; }
    __syncthreads();
    { const int cidx = tid >> 2, q = tid & 3; f32x2 xb[4];
#pragma unroll
        for (int k = 0; k < 4; ++k) xb[k] = (f32x2){SOL[(8 * k + q) * 132 + cidx], SOL[(8 * k + 4 + q) * 132 + cidx]};
#pragma unroll
        for (int t = 0; t < 31; ++t) { if ((t & 7) == 0) __builtin_amdgcn_sched_barrier(0);
            const float src = ((t >> 2) & 1) ? xb[t >> 3].y : xb[t >> 3].x; float xt;
            switch (t & 3) { case 0: xt = dppf<0x00>(src); break; case 1: xt = dppf<0x55>(src); break; case 2: xt = dppf<0xAA>(src); break; default: xt = dppf<0xFF>(src); break; }
            const f32x2 x2 = (f32x2){xt, xt};
            if (t < 16) { const f32x4 la = *(const LAS f32x4*)(LB + t * 36 + q * 8); if (t < 8) xb[0] = xb[0] - (f32x2){la.x, la.y} * x2; xb[1] = xb[1] - (f32x2){la.z, la.w} * x2; }
            { const f32x4 lb = *(const LAS f32x4*)(LB + t * 36 + q * 8 + 4); if (t < 24) xb[2] = xb[2] - (f32x2){lb.x, lb.y} * x2; xb[3] = xb[3] - (f32x2){lb.z, lb.w} * x2; } }
        { LAS bf16* dst = (cidx < 64) ? KTb + cidx : UVb + (cidx - 64); const float sg = (cidx < 64) ? 1.0f : -1.0f;
#pragma unroll
            for (int k = 0; k < 4; ++k) { dst[(8 * k + q) * 72] = (bf16)f2bf(sg * xb[k].x); dst[(8 * k + 4 + q) * 72] = (bf16)f2bf(sg * xb[k].y); } } }
    __syncthreads();
    for (int rep9 = 0; rep9 < REP9; ++rep9) { asm volatile("" ::: "memory");
    unsigned char* chk = C_CHK + (size_t)item * CHK_BYTES; bf16* Ag = (bf16*)(chk + CK_A); bf16* RQg = (bf16*)(chk + CK_RQ); bf16* GTg = (bf16*)(chk + CK_GT); bf16* YVTg = (bf16*)(chk + CK_YVT);
    const f32x4 z4 = (f32x4){0.f, 0.f, 0.f, 0.f};
    { const int jt = wave >> 1;
        const bf16x8 BhT = tr_frag(Bh + (8 * fq + trow) * 72 + 16 * jt + tcol, 4 * 72), KhT = tr_frag(Kh + (8 * fq + trow) * 72 + 16 * jt + tcol, 4 * 72);
#pragma unroll
        for (int cc = 0; cc < 2; ++cc) { const int ct = 2 * (wave & 1) + cc;
            const f32x4 aA = mfma16(BhT, tr_frag(KTb + (8 * fq + trow) * 72 + 16 * ct + tcol, 4 * 72), z4);
            f32x4 aG = mfma16(BhT, tr_frag(UVb + (8 * fq + trow) * 72 + 16 * ct + tcol, 4 * 72), z4); aG = mfma16(KhT, tr_frag(Vb + (8 * fq + trow) * 72 + 16 * ct + tcol, 4 * 72), aG);
#pragma unroll
            for (int r = 0; r < 4; ++r) { const int j = 16 * jt + 4 * fq + r, jp = 16 * ct + fr; Ag[j * 72 + jp] = (bf16)f2bf(((j == jp) ? c31[j] : 0.f) - aA[r]); }
            *(u32x2*)(GTg + (16 * ct + fr) * 68 + 16 * jt + 4 * fq) = (u32x2){pk2(aG[0], aG[1]), pk2(aG[2], aG[3])}; } }
    { const int tt = wave >> 2, jt2 = wave & 3; const bf16x8 MbF = *(const LAS bf16x8*)(Mb + (16 * tt + fr) * 40 + 8 * fq);
        const f32x4 a = mfma16(MbF, tr_frag(KTb + (8 * fq + trow) * 72 + 16 * jt2 + tcol, 4 * 72), z4);
#pragma unroll
        for (int r = 0; r < 4; ++r) { const int t = 16 * tt + 4 * fq + r, j = 16 * jt2 + fr; RQg[t * 72 + j] = (bf16)f2bf(RTf[t * 68 + j] - a[r]); }
        f32x4 y = mfma16(MbF, tr_frag(UVb + (8 * fq + trow) * 72 + 16 * jt2 + tcol, 4 * 72), z4);
        y = mfma16(*(const LAS bf16x8*)(Mk + (16 * tt + fr) * 40 + 8 * fq), tr_frag(Vb + (8 * fq + trow) * 72 + 16 * jt2 + tcol, 4 * 72), y);
        *(u32x2*)(YVTg + (16 * jt2 + fr) * 36 + 16 * tt + 4 * fq) = (u32x2){pk2(y[0], y[1]), pk2(y[2], y[3])}; }
    __syncthreads(); }
}
__device__ __forceinline__ void rwkv_stream(const Ctx& c, int bh, int it, int e) {
    const int b = bh / 12, h = bh % 12, lane = c.lane, fr = lane & 15, fq = lane >> 4;
    LAS bf16* Sl = (LAS bf16*)c.lds + c.wave * (16 * 72);
    const unsigned char* chk0 = C_CHK + (size_t)bh * 128 * CHK_BYTES;
    bf16* ya = C_YA + ((size_t)b * SEQ) * 768 + h * 64 + 16 * it + fr;
    f32x4 S[4];
#pragma unroll
    for (int jt = 0; jt < 4; ++jt) S[jt] = (f32x4){0.f, 0.f, 0.f, 0.f};
    bf16x8 A0[4][2], R0f[2][2], A1[4][2], R1f[2][2]; f32x4 G0[4], Y0[2], G1[4], Y1[2];
#define ST_LOAD(AF, RF, GV, YV, n_) do { const unsigned char* base_ = chk0 + (size_t)(n_) * CHK_BYTES; \
        _Pragma("unroll") for (int jt = 0; jt < 4; ++jt) { _Pragma("unroll") for (int ks = 0; ks < 2; ++ks) AF[jt][ks] = *(const bf16x8*)((const bf16*)(base_ + CK_A) + (16 * jt + fr) * 72 + 32 * ks + 8 * fq); \
            { float g_[4]; unpk4(*(const u32x2*)((const bf16*)(base_ + CK_GT) + (16 * it + fr) * 68 + 16 * jt + 4 * fq), g_); GV[jt] = (f32x4){g_[0], g_[1], g_[2], g_[3]}; } } \
        _Pragma("unroll") for (int tt = 0; tt < 2; ++tt) { _Pragma("unroll") for (int ks = 0; ks < 2; ++ks) RF[tt][ks] = *(const bf16x8*)((const bf16*)(base_ + CK_RQ) + (16 * tt + fr) * 72 + 32 * ks + 8 * fq); \
            { float y4_[4]; unpk4(*(const u32x2*)((const bf16*)(base_ + CK_YVT) + (16 * it + fr) * 36 + 16 * tt + 4 * fq), y4_); YV[tt] = (f32x4){y4_[0], y4_[1], y4_[2], y4_[3]}; } } } while (0)
#define ST_STEP(AF, RF, GV, YV, n_, tmax_) do { \
        _Pragma("unroll") for (int jt = 0; jt < 4; ++jt) *(LAS u32x2*)(Sl + fr * 72 + 16 * jt + 4 * fq) = (u32x2){pk2(S[jt][0], S[jt][1]), pk2(S[jt][2], S[jt][3])}; \
        asm volatile("s_waitcnt lgkmcnt(0)" ::: "memory"); \
        const bf16x8 Sf0 = *(const LAS bf16x8*)(Sl + fr * 72 + 8 * fq), Sf1 = *(const LAS bf16x8*)(Sl + fr * 72 + 32 + 8 * fq); \
        asm volatile("s_waitcnt lgkmcnt(0)" ::: "memory"); \
        _Pragma("unroll") for (int tt = 0; tt < 2; ++tt) { f32x4 y_ = mfma16(RF[tt][0], Sf0, YV[tt]); y_ = mfma16(RF[tt][1], Sf1, y_); \
            _Pragma("unroll") for (int r = 0; r < 4; ++r) if (16 * tt + 4 * fq + r < (tmax_)) ya[(size_t)(32 * (n_) + 16 * tt + 4 * fq + r) * 768] = (bf16)f2bf(y_[r]); } \
        _Pragma("unroll") for (int jt = 0; jt < 4; ++jt) { f32x4 a_ = mfma16(AF[jt][0], Sf0, GV[jt]); S[jt] = mfma16(AF[jt][1], Sf1, a_); } } while (0)
    ST_LOAD(A0, R0f, G0, Y0, 0);
#pragma unroll 1
    for (int n = 0; n < 128; n += 2) {
        ST_LOAD(A1, R1f, G1, Y1, n + 1);
        ST_STEP(A0, R0f, G0, Y0, n, 32);
        if (n + 2 < 128) ST_LOAD(A0, R0f, G0, Y0, n + 2);
        ST_STEP(A1, R1f, G1, Y1, n + 1, 32);
    }
    float* so = C_OUT + O_RWKV_P + (((size_t)e * 2 + b) * 12 + h) * 4096 + (size_t)(16 * it + fr) * 64 + 4 * fq;
#pragma unroll
    for (int jt = 0; jt < 4; ++jt) *(f32x4*)(so + 16 * jt) = S[jt];
}
__device__ __forceinline__ void rwkv_stream_block(const Ctx& c, int sb, int e) {
    const int bh = sb >> 2, it = sb & 3, b = bh / 12, h = bh % 12, tid = c.tid, lane = c.lane, wave = c.wave, fr = lane & 15, fq = lane >> 4, jt = wave & 3;
    constexpr int SLOT = 13824 + 2176 + 1152;
    LAS unsigned char* slots = c.lds;
    LAS bf16* Sl = (LAS bf16*)(c.lds + 2 * SLOT);
    const unsigned char* rec0 = C_CHK + (size_t)bh * 128 * CHK_BYTES;
    int soff[3];
#pragma unroll
    for (int k = 0; k < 3; ++k) { const int p = tid + 512 * k; soff[k] = (p < 864) ? 16 * p : (p < 864 + 136) ? CK_GT + it * 2176 + 16 * (p - 864) : CK_YVT + it * 1152 + 16 * (p - 1000); }
    const bool has2 = (tid + 1024) < SLOT / 16;
    bf16* ya = C_YA + ((size_t)b * SEQ + 16 * jt + 4 * fq) * 768 + h * 64 + 16 * it + fr;
    f32x4 S1 = (f32x4){0.f, 0.f, 0.f, 0.f};
    *(LAS u32x2*)(Sl + fr * 72 + 16 * jt + 4 * fq) = (u32x2){0u, 0u};
    u32x4 P0[3], P1[3], P2[3], P3[3];
#define SB_GLOAD(P, n_) do { const int nn_ = (n_) < 128 ? (n_) : 127; const unsigned char* r_ = rec0 + (size_t)nn_ * CHK_BYTES; \
        _Pragma("unroll") for (int k = 0; k < 2; ++k) P[k] = *(const u32x4*)(r_ + soff[k]); P[2] = *(const u32x4*)(r_ + (has2 ? soff[2] : soff[0])); } while (0)
#define SB_LWRITE(P, s_) do { _Pragma("unroll") for (int k = 0; k < 2; ++k) *(LAS u32x4*)(slots + (s_) * SLOT + tid * 16 + k * 8192) = P[k]; if (has2) *(LAS u32x4*)(slots + (s_) * SLOT + tid * 16 + 2 * 8192) = P[2]; } while (0)
#define SB_STEP(s_, n_) do { const LAS unsigned char* sb_ = slots + (s_) * SLOT; const LAS bf16* si_ = Sl + (s_) * (16 * 72) + fr * 72 + 8 * fq; \
        const LAS bf16* a_ = (const LAS bf16*)sb_ + (16 * jt + fr) * 72 + 8 * fq; const bf16x8 af0 = *(const LAS bf16x8*)a_, af1 = *(const LAS bf16x8*)(a_ + 32); \
        const u32x2 gw_ = *(const LAS u32x2*)((const LAS bf16*)(sb_ + 13824) + fr * 68 + 16 * jt + 4 * fq); \
        const LAS bf16* rq_ = (const LAS bf16*)(sb_ + CK_RQ) + (16 * (jt & 1) + fr) * 72 + 8 * fq; const bf16x8 rf0 = *(const LAS bf16x8*)rq_, rf1 = *(const LAS bf16x8*)(rq_ + 32); \
        const u32x2 yw_ = *(const LAS u32x2*)((const LAS bf16*)(sb_ + 13824 + 2176) + fr * 36 + 16 * (jt & 1) + 4 * fq); \
        const bf16x8 Sf0 = *(const LAS bf16x8*)si_, Sf1 = *(const LAS bf16x8*)(si_ + 32); \
        asm volatile("s_waitcnt lgkmcnt(0)" ::: "memory"); __builtin_amdgcn_sched_barrier(0); \
        float g4_[4], y4_[4]; unpk4(gw_, g4_); unpk4(yw_, y4_); const f32x4 gv_ = (f32x4){g4_[0], g4_[1], g4_[2], g4_[3]}, yv_ = (f32x4){y4_[0], y4_[1], y4_[2], y4_[3]}; \
        { f32x4 t_ = mfma16(af0, Sf0, gv_); S1 = mfma16(af1, Sf1, t_); } \
        if (jt < 2) { f32x4 y_ = mfma16(rf0, Sf0, yv_); y_ = mfma16(rf1, Sf1, y_); \
            _Pragma("unroll") for (int r = 0; r < 4; ++r) ya[(size_t)(32 * (n_) + r) * 768] = (bf16)f2bf(y_[r]); } \
        *(LAS u32x2*)(Sl + ((s_) ^ 1) * (16 * 72) + fr * 72 + 16 * jt + 4 * fq) = (u32x2){pk2(S1[0], S1[1]), pk2(S1[2], S1[3])}; \
        } while (0)
    SB_GLOAD(P0, 0); SB_GLOAD(P1, 1); SB_GLOAD(P2, 2); SB_GLOAD(P3, 3);
    SB_LWRITE(P0, 0); __syncthreads();
#pragma unroll 1
    for (int n = 0; n < 128; n += 4) {
        SB_LWRITE(P1, 1); SB_GLOAD(P0, n + 4); SB_STEP(0, n); __syncthreads();
        SB_LWRITE(P2, 0); SB_GLOAD(P1, n + 5); SB_STEP(1, n + 1); __syncthreads();
        SB_LWRITE(P3, 1); SB_GLOAD(P2, n + 6); SB_STEP(0, n + 2); __syncthreads();
        SB_LWRITE(P0, 0); SB_GLOAD(P3, n + 7); SB_STEP(1, n + 3); __syncthreads();
    }
#undef SB_GLOAD
#undef SB_LWRITE
#undef SB_STEP
    *(f32x4*)(C_OUT + O_RWKV_P + (((size_t)e * 2 + b) * 12 + h) * 4096 + (size_t)(16 * it + fr) * 64 + 16 * jt + 4 * fq) = S1;
}
__device__ __forceinline__ void rwkv_stream_sample(const Ctx& c, int sidx, int it, int e) {
    const int ns = sidx / 12, h = sidx % 12, lane = c.lane, fr = lane & 15, fq = lane >> 4;
    LAS bf16* Sl = (LAS bf16*)c.lds + c.wave * (16 * 72);
    const unsigned char* chk0 = C_CHK + (size_t)(3072 + sidx) * CHK_BYTES;
    bf16* ya = C_YA + ((size_t)(TP + 4 * ns)) * 768 + h * 64 + 16 * it + fr;
    const float* si = C_IN(2) + (((size_t)e * 8 + ns) * 12 + h) * 4096 + (size_t)(16 * it + fr) * 64 + 4 * fq;
    f32x4 S[4];
#pragma unroll
    for (int jt = 0; jt < 4; ++jt) S[jt] = *(const f32x4*)(si + 16 * jt);
    bf16x8 A0[4][2], R0f[2][2]; f32x4 G0[4], Y0[2];
    ST_LOAD(A0, R0f, G0, Y0, 0);
    ST_STEP(A0, R0f, G0, Y0, 0, 4);
    float* so = C_OUT + O_RWKV_S + (((size_t)e * 8 + ns) * 12 + h) * 4096 + (size_t)(16 * it + fr) * 64 + 4 * fq;
#pragma unroll
    for (int jt = 0; jt < 4; ++jt) *(f32x4*)(so + 16 * jt) = S[jt];
}
#undef ST_LOAD
#undef ST_STEP
__device__ __forceinline__ void phase_even_tok_pre(Ctx c, int l) {
    const int e = l >> 1;
    constexpr int NI = 3072 + 96;
    const bool split = (c.G == 256); const int NTB = split ? (l == 0 ? 171 : 123) : 0;
    if (split) {
        { pg8::Gemm g{C_XB, C_WTIN_L(l), MPAD, 3 * 256, DM}; pg8::StaticOrder S; S.init(MPAD, 3 * 256, c.G, c.bid, 0, 24); S.ex_n = 24; S.ex_pm0 = 9; S.ex_pn = 23;
            pg8::EpiBf16NP E{C_HB, LDH, C_TAB, 0, 1536};
            pg8::gemm_phase<pg8::EpiBf16NP, pg8::StaticOrder, true, true>(c.lds, g, S, E); }
        LAUNDER_C(c);
    }
    if (l == 0) {
        { pg8::Gemm g{C_MEMB, C_WTMEM, 512, 4096, DM}; pg8::StaticOrder S; S.init(512, 4096, c.G, split ? (c.bid + c.G - 123) % c.G : c.bid);
            pg8::EpiF32Split E{C_OUT + O_MEM, 1024, 1024, (size_t)512 * 1024, C_MKVB};
            pg8::gemm_phase<pg8::EpiF32Split, pg8::StaticOrder, true, true>(c.lds, g, S, E); }
        LAUNDER_C(c);
#pragma unroll 1
        for (int gi = 0; gi < 4; ++gi) {
            pg8::Gemm g{C_WTMEM + ((size_t)gi * 1024 + 512) * DM, C_MEMB, 512, 512, DM}; pg8::StaticOrder S; S.init(512, 512, c.G, split ? (c.bid + 2 * c.G - 155 - 4 * gi) % c.G : c.bid);
            pg8::EpiBf16NP E{C_VT + (size_t)gi * 512 * 512, 512, C_TAB, 0, 1536};
            pg8::gemm_phase<pg8::EpiBf16NP, pg8::StaticOrder, true, true>(c.lds, g, S, E);
            LAUNDER_C(c);
        }
    }
    rwkv_stage_params(c, e);
    if (!split) {
        PreIn A; if (c.bid < NI) rwkv_chunk_preload(c, c.bid, e, A);
        for (int it = c.bid; it < NI; it += c.G) { PreIn B; const int nx = (it + c.G < NI) ? it + c.G : it;
            rwkv_chunk_precompute(c, it, e, A, nx, B); A = B; }
    } else {
        constexpr int DI = 5;
        const int na = (NI - DI * (256 - NTB)) / 256, rem = NI - 256 * na - DI * (256 - NTB);
        const int nmid = (c.bid >= NTB) ? DI : 0, nb = na + nmid + ((c.bid < rem) ? 1 : 0);
#define PRE_ITEM(k_) ((k_) < na ? (k_) * 256 + c.bid : ((k_) < na + nmid ? 256 * na + ((k_) - na) * (256 - NTB) + (c.bid - NTB) : 256 * na + DI * (256 - NTB) + c.bid))
        PreIn A; rwkv_chunk_preload(c, PRE_ITEM(0), e, A);
        for (int k = 0; k < nb; ++k) { PreIn B; const int it = PRE_ITEM(k), nx = (k + 1 < nb) ? PRE_ITEM(k + 1) : it;
            rwkv_chunk_precompute(c, it, e, A, nx, B); A = B; }
#undef PRE_ITEM
    }
}
__device__ __forceinline__ void phase_even_scan(Ctx c, int l) {
    const int e = l >> 1;
    if (c.G >= 240) {
        if (c.bid < 96) { for (int rp = 0; rp < REPS; ++rp) { rwkv_stream_block(c, 12 * (c.bid & 7) + (c.bid >> 3), e); __syncthreads(); LAUNDER_C(c); } }
        else { Ctx h = c; h.bid = c.bid - 96; h.G = c.G - 96; LAUNDER_C(h);
            if (h.bid < 96) { if (h.wave < 4) rwkv_stream_sample(h, h.bid, h.wave, e); __syncthreads(); }
            even_helper_work(h, l); }
    } else {
        for (int it = c.bid; it < 96; it += c.G) { rwkv_stream_block(c, it, e); __syncthreads(); }
        for (int it = c.bid; it < 96; it += c.G) { if (c.wave < 4) rwkv_stream_sample(c, it, c.wave, e); __syncthreads(); }
        LAUNDER_C(c);
        even_helper_work(c, l);
    }
}
__device__ __forceinline__ void phase_even_ubuild(const Ctx& c, int l) {
    const int e = l >> 1; const float* lg = C_IN(25) + e * 768; const float* lb = C_IN(26) + e * 768; const float* muv = C_IN(17) + e * 2432 + EC_V;
    const int hq = c.lane >> 4, c4 = 4 * (c.lane & 15);
    f32x4 lgv[3], lbv[3], mvv[3];
#pragma unroll
    for (int g = 0; g < 3; ++g) { const int col = (4 * g + hq) * 64 + c4; lgv[g] = *(const f32x4*)(lg + col); lbv[g] = *(const f32x4*)(lb + col); mvv[g] = *(const f32x4*)(muv + col); }
    for (int R = c.bid * 8 + c.wave; R < TT; R += c.G * 8) {
        const bool hasprev = (R < TP) ? ((R & (SEQ - 1)) != 0) : (((R - TP) & 3) != 0);
        const float* shiftv = C_IN(3) + ((size_t)e * 8 + ((R >= TP) ? ((R - TP) >> 2) : 0)) * 2432 + EC_V;
        const bf16* hrow = C_HB + (size_t)R * LDH; const bf16* prow = hrow - (hasprev ? LDH : 0);
        f32x4 y[3], sh[3]; u32x2 yw[3], gw[3], cw[3], pw[3]; float bon[3];
#pragma unroll
        for (int g = 0; g < 3; ++g) { const int col = (4 * g + hq) * 64 + c4;
            yw[g] = *(const u32x2*)(C_YA + (size_t)R * 768 + col); gw[g] = *(const u32x2*)(hrow + EC_GA + col); cw[g] = *(const u32x2*)(hrow + EC_V + col); pw[g] = *(const u32x2*)(prow + EC_V + col);
            bon[g] = C_BONUS[(size_t)R * 12 + 4 * g + hq]; sh[g] = (f32x4){0.f, 0.f, 0.f, 0.f}; }
        if (!hasprev && R >= TP) {
#pragma unroll
            for (int g = 0; g < 3; ++g) sh[g] = *(const f32x4*)(shiftv + (4 * g + hq) * 64 + c4); }
#pragma unroll
        for (int g = 0; g < 3; ++g) { const int col = (4 * g + hq) * 64 + c4; { float y4[4]; unpk4(yw[g], y4); y[g] = (f32x4){y4[0], y4[1], y4[2], y4[3]}; }
            const float mean = red16((y[g].x + y[g].y) + (y[g].z + y[g].w)) * (1.0f / 64.0f); const f32x4 d = y[g] - mean;
            const float var = red16((d.x * d.x + d.y * d.y) + (d.z * d.z + d.w * d.w)) * (1.0f / 64.0f); const float rs = rsqrtf(var + 64e-5f);
            float gt[4], cv[4], pv[4]; unpk4(gw[g], gt); unpk4(cw[g], cv); unpk4(pw[g], pv);
            float o[4];
#pragma unroll
            for (int i = 0; i < 4; ++i) { const float pvi = hasprev ? pv[i] : sh[g][i]; const float yn = d[i] * rs * lgv[g][i] + lbv[g][i]; const float bonus = bon[g] * (cv[i] + (pvi - cv[i]) * mvv[g][i]); o[i] = (yn + bonus) * siluf_(gt[i]); }
            *(u32x2*)(C_U + (size_t)R * EVEN_OUT + col) = (u32x2){pk2(o[0], o[1]), pk2(o[2], o[3])}; }
    }
}

__device__ __forceinline__ void even_combine_dil(const Ctx& c) {
    const int hh = c.lane >> 4, d4 = 4 * (c.lane & 15);
    for (int R0 = c.bid * 8 + c.wave; R0 < TP; R0 += 2 * c.G * 8) {
        const int R1 = (R0 + c.G * 8 < TP) ? R0 + c.G * 8 : R0;
        float ls[2][3]; u32x2 ogw[2][3]; u32x2 gw[2];
#pragma unroll
        for (int k = 0; k < 2; ++k) { const int R = k ? R1 : R0;
#pragma unroll
            for (int g = 0; g < 3; ++g) { ls[k][g] = C_LSE[((size_t)g * TT + R) * 4 + hh]; ogw[k][g] = *(const u32x2*)(C_OG + ((size_t)g * TT + R) * 256 + hh * 64 + d4); }
            gw[k] = *(const u32x2*)(C_HB + (size_t)R * LDH + EC_GB + hh * 64 + d4); }
#pragma unroll
        for (int k = 0; k < 2; ++k) { const int R = k ? R1 : R0;
            const float mx = fmaxf(ls[k][0], fmaxf(ls[k][1], ls[k][2])); const float w0 = __expf(ls[k][0] - mx), w1 = __expf(ls[k][1] - mx), w2 = __expf(ls[k][2] - mx); const float inv = 1.0f / (w0 + w1 + w2);
            float o0[4], o1[4], o2[4]; unpk4(ogw[k][0], o0); unpk4(ogw[k][1], o1); unpk4(ogw[k][2], o2);
            const f32x4 y = ((f32x4){o0[0], o0[1], o0[2], o0[3]} * w0 + (f32x4){o1[0], o1[1], o1[2], o1[3]} * w1 + (f32x4){o2[0], o2[1], o2[2], o2[3]} * w2) * inv;
            float gt[4]; unpk4(gw[k], gt);
            *(u32x2*)(C_U + (size_t)R * EVEN_OUT + 768 + hh * 64 + d4) = (u32x2){pk2(y.x * siluf_(gt[0]), y.y * siluf_(gt[1])), pk2(y.z * siluf_(gt[2]), y.w * siluf_(gt[3]))}; }
    }
}
__device__ __forceinline__ void rot8(u32x4 w, const float* tb, float scale, float (&y)[8]) {
    float x[8]; unpk8(w, x); const f32x4 t0 = *(const f32x4*)tb, t1 = *(const f32x4*)(tb + 4);
    const float cs[8] = {t0.x, t0.y, t0.z, t0.w, t1.x, t1.y, t1.z, t1.w};
#pragma unroll
    for (int p = 0; p < 4; ++p) { const float co = cs[2 * p], si = cs[2 * p + 1], x0 = x[2 * p], x1 = x[2 * p + 1]; y[2 * p] = (x0 * co - x1 * si) * scale; y[2 * p + 1] = (x1 * co + x0 * si) * scale; }
}
#define C_SB ((bf16*)(c.ap->ws + WS_OG))
__device__ __forceinline__ void ret_s_prepass_block(const Ctx& c) {
    LAS bf16* Qc = (LAS bf16*)c.lds;
    LAS bf16* Kc = Qc + 64 * 264;
    const int tid = c.tid, lane = c.lane, wave = c.wave, fr = lane & 15, fq = lane >> 4, it = wave >> 1, jt0 = (wave & 1) * 2;
    u32x4 tq[4], tk[4];
#define SP_LOAD(item_) do { const int bh_ = (item_) >> 6, ch_ = (item_) & 63, b_ = bh_ / 6, h_ = bh_ % 6; const bf16* g0_ = C_HB + ((size_t)b_ * SEQ + ch_ * 64) * LDH + h_ * 256; \
        _Pragma("unroll") \
        for (int q = 0; q < 4; ++q) { const int p = tid + 512 * q, row = p >> 5, c8 = (p & 31) * 8; tq[q] = *(const u32x4*)(g0_ + (size_t)row * LDH + OC_Q + c8); tk[q] = *(const u32x4*)(g0_ + (size_t)row * LDH + OC_K + c8); } } while (0)
    if (c.bid < 768) {
        SP_LOAD(c.bid);
#pragma unroll 1
        for (int item = c.bid; item < 768; item += c.G) {
            const int nx = (item + c.G < 768) ? item + c.G : item;
            const float lg = LG2G[(item >> 6) % 6];
#pragma unroll
            for (int q = 0; q < 4; ++q) { const int p = tid + 512 * q, row = p >> 5, c8 = (p & 31) * 8; *(LAS u32x4*)(Qc + row * 264 + c8) = tq[q]; *(LAS u32x4*)(Kc + row * 264 + c8) = tk[q]; }
            SP_LOAD(nx);
            __syncthreads();
            f32x4 accS[2];
#pragma unroll
            for (int q = 0; q < 2; ++q) accS[q] = (f32x4){0.f, 0.f, 0.f, 0.f};
#pragma unroll
            for (int kp = 0; kp < 4; ++kp) { bf16x8 Qf2[2], Kf2[2][2];
#pragma unroll
                for (int kk = 0; kk < 2; ++kk) { const int ks = 2 * kp + kk; Qf2[kk] = *(const LAS bf16x8*)(Qc + (16 * it + fr) * 264 + 32 * ks + 8 * fq);
#pragma unroll
                    for (int q = 0; q < 2; ++q) Kf2[kk][q] = *(const LAS bf16x8*)(Kc + (16 * (jt0 + q) + fr) * 264 + 32 * ks + 8 * fq); }
                asm volatile("s_waitcnt lgkmcnt(0)" ::: "memory"); __builtin_amdgcn_sched_barrier(0);
#pragma unroll
                for (int kk = 0; kk < 2; ++kk)
#pragma unroll
                    for (int q = 0; q < 2; ++q) accS[q] = mfma16(Qf2[kk], Kf2[kk][q], accS[q]); }
            bf16* sb = C_SB + (size_t)item * 4096;
#pragma unroll
            for (int jj = 0; jj < 2; ++jj) { const int jt = jt0 + jj;
#pragma unroll
                for (int r = 0; r < 4; ++r) { const int i = 16 * it + 4 * fq + r, j = 16 * jt + fr; const float val = (i >= j) ? accS[jj][r] * __builtin_amdgcn_exp2f(lg * (float)(i - j)) : 0.f; sb[i * 64 + j] = (bf16)f2bf(val); } }
            __syncthreads();
        }
    }
#undef SP_LOAD
}
__device__ __forceinline__ void ret_prompt_unit(const Ctx& c, int unit, int o) {
    const int b = unit / 48, h = (unit >> 3) % 6, es = unit & 7;
    LAS bf16* Qc = (LAS bf16*)c.lds;
    LAS bf16* Kc = Qc + 64 * 264;
    LAS bf16* Vc = Kc + 64 * 264;
    LAS bf16* Vz = Vc + 64 * 40;
    LAS bf16* Rt = Vz + 64 * 40;
    const float lg = LG2G[h];
    const int tid = c.tid, lane = c.lane, wave = c.wave, fr = lane & 15, fq = lane >> 4, it = wave >> 1, eto = wave & 1;
    f32x4 Racc[2][2];
#pragma unroll
    for (int a = 0; a < 2; ++a)
#pragma unroll
        for (int q = 0; q < 2; ++q) Racc[a][q] = (f32x4){0.f, 0.f, 0.f, 0.f};
    for (int i = tid; i < 32 * 264 / 2; i += 512) ((LAS unsigned*)Rt)[i] = 0u;
    const float g64 = exp2f(lg * 64.f);
    const int vj = (tid & 255) >> 2, vp = tid & 3; const float zeta = exp2f(lg * (float)(63 - vj));
    float xi[4];
#pragma unroll
    for (int r = 0; r < 4; ++r) xi[r] = exp2f(lg * (float)(16 * (wave >> 1) + 4 * (lane >> 4) + r + 1));
    const bf16* g0 = C_HB + ((size_t)b * SEQ + (tid >> 5)) * LDH + h * 256 + (tid & 31) * 8;
    const bf16* gv = C_HB + ((size_t)b * SEQ + vj) * LDH + OC_V + h * 256 + es * 32 + vp * 8;
    const bf16* gs = C_SB + (size_t)((b * 6 + h) * 64) * 4096 + (16 * it + fr) * 64 + 8 * fq;
    const int trow = (lane & 15) >> 2, tcol = 4 * (lane & 3);
    u32x4 pqA[4], pkA[4], pvA, pqB[4], pkB[4], pvB; bf16x8 sfA[2], sfB[2];
#define RET_LOADS(SF_, CN_) do { const int cn_ = (CN_) < 64 ? (CN_) : 63; SF_[0] = *(const bf16x8*)(gs + (size_t)cn_ * 4096); SF_[1] = *(const bf16x8*)(gs + (size_t)cn_ * 4096 + 32); } while (0)
#define RET_LOADK(PQ_, PK_, PV_, CN_) do { const int cn_ = (CN_) < 64 ? (CN_) : 63; const size_t adv = (size_t)cn_ * 64 * LDH; \
        _Pragma("unroll") \
        for (int q = 0; q < 4; ++q) { PQ_[q] = *(const u32x4*)(g0 + adv + (size_t)(16 * q) * LDH + OC_Q); PK_[q] = *(const u32x4*)(g0 + adv + (size_t)(16 * q) * LDH + OC_K); } \
        PV_ = *(const u32x4*)(gv + adv); } while (0)
#define RET_CHUNK(PQ_, PK_, PV_, SF_, CH_) do { const size_t row0 = (size_t)b * SEQ + (CH_) * 64; \
        _Pragma("unroll") \
        for (int q = 0; q < 4; ++q) { *(LAS u32x4*)(Qc + ((tid >> 5) + 16 * q) * 264 + (tid & 31) * 8) = PQ_[q]; *(LAS u32x4*)(Kc + ((tid >> 5) + 16 * q) * 264 + (tid & 31) * 8) = PK_[q]; } \
        if (wave < 4) { *(LAS u32x4*)(Vc + vj * 40 + vp * 8) = PV_; float x[8]; unpk8(PV_, x); \
            *(LAS u32x4*)(Vz + vj * 40 + vp * 8) = (u32x4){pk2(x[0] * zeta, x[1] * zeta), pk2(x[2] * zeta, x[3] * zeta), pk2(x[4] * zeta, x[5] * zeta), pk2(x[6] * zeta, x[7] * zeta)}; } \
        __syncthreads(); \
        f32x4 accQ = (f32x4){0.f, 0.f, 0.f, 0.f}; \
        { bf16x8 Qf[8], Rf[8]; \
            _Pragma("unroll") \
            for (int ks = 0; ks < 8; ++ks) { Qf[ks] = *(const LAS bf16x8*)(Qc + (16 * it + fr) * 264 + 32 * ks + 8 * fq); Rf[ks] = *(const LAS bf16x8*)(Rt + (16 * eto + fr) * 264 + 32 * ks + 8 * fq); } \
            asm volatile("s_waitcnt lgkmcnt(0)" ::: "memory"); __builtin_amdgcn_sched_barrier(0); \
            _Pragma("unroll") \
            for (int ks = 0; ks < 8; ++ks) accQ = mfma16(Qf[ks], Rf[ks], accQ); } \
        __builtin_amdgcn_sched_barrier(0); \
        RET_LOADK(PQ_, PK_, PV_, (CH_) + 2); \
        __builtin_amdgcn_sched_barrier(0); \
        { bf16x8 Vfr[2], Kfr[2][2], Zfr[2][2]; \
            _Pragma("unroll") \
            for (int k2 = 0; k2 < 2; ++k2) { Vfr[k2] = tr_frag(Vc + (32 * k2 + 8 * fq + trow) * 40 + 16 * eto + tcol, 4 * 40); \
                _Pragma("unroll") \
                for (int dd = 0; dd < 2; ++dd) Kfr[dd][k2] = tr_frag(Kc + (32 * k2 + 8 * fq + trow) * 264 + 16 * (2 * wave + dd) + tcol, 4 * 264); \
                _Pragma("unroll") \
                for (int et = 0; et < 2; ++et) Zfr[et][k2] = tr_frag(Vz + (32 * k2 + 8 * fq + trow) * 40 + 16 * et + tcol, 4 * 40); } \
            asm volatile("s_waitcnt lgkmcnt(0)" ::: "memory"); __builtin_amdgcn_sched_barrier(0); \
            { f32x4 a2 = mfma16(SF_[0], Vfr[0], (f32x4){0.f, 0.f, 0.f, 0.f}); a2 = mfma16(SF_[1], Vfr[1], a2); \
                __builtin_amdgcn_sched_barrier(0); RET_LOADS(SF_, (CH_) + 2); __builtin_amdgcn_sched_barrier(0); \
                _Pragma("unroll") \
                for (int r = 0; r < 4; ++r) { const int i = 16 * it + 4 * fq + r; C_YR[(row0 + i) * 1536 + h * 256 + es * 32 + 16 * eto + fr] = (bf16)f2bf(a2[r] + accQ[r] * xi[r]); } } \
            __builtin_amdgcn_sched_barrier(0); \
            _Pragma("unroll") \
            for (int dd = 0; dd < 2; ++dd) \
                _Pragma("unroll") \
                for (int et = 0; et < 2; ++et) { f32x4 a = Racc[dd][et] * g64; a = mfma16(Kfr[dd][0], Zfr[et][0], a); Racc[dd][et] = mfma16(Kfr[dd][1], Zfr[et][1], a); } } \
        __syncthreads(); \
        _Pragma("unroll") \
        for (int dd = 0; dd < 2; ++dd) \
            _Pragma("unroll") \
            for (int et = 0; et < 2; ++et) { const f32x4 a = Racc[dd][et]; const int dt = 2 * wave + dd; \
                *(LAS u32x2*)(Rt + (16 * et + fr) * 264 + 16 * dt + 4 * fq) = (u32x2){pk2(a[0], a[1]), pk2(a[2], a[3])}; } \
    } while (0)
    RET_LOADK(pqA, pkA, pvA, 0); RET_LOADS(sfA, 0); RET_LOADK(pqB, pkB, pvB, 1); RET_LOADS(sfB, 1);
#pragma unroll 1
    for (int ch = 0; ch < 64; ch += 2) { RET_CHUNK(pqA, pkA, pvA, sfA, ch); RET_CHUNK(pqB, pkB, pvB, sfB, ch + 1); }
#undef RET_CHUNK
#undef RET_LOADK
#undef RET_LOADS
    int fq_l = fq; asm volatile("" : "+v"(fq_l));
    float* ro = C_OUT + O_RET_P + ((((size_t)o * 2 + b) * 6 + h) * 256) * 256 + es * 32;
#pragma unroll
    for (int dd = 0; dd < 2; ++dd)
#pragma unroll
        for (int et = 0; et < 2; ++et)
#pragma unroll
            for (int r = 0; r < 4; ++r) ro[(size_t)(16 * (2 * wave + dd) + 4 * fq_l + r) * 256 + 16 * et + fr] = Racc[dd][et][r];
    __syncthreads();
}
__device__ __forceinline__ void ret_sample_unit(const Ctx& c, int unit, int o) {
    const int n = unit / 6, h = unit % 6, tid = c.tid;
    LAS float* qs = (LAS float*)c.lds; LAS float* ks = qs + 1024; LAS float* vs = ks + 1024; LAS float* red = vs + 1024; LAS float* sc = red + 2048;
    const float lg = LG2G[h];
    for (int idx = tid; idx < 4 * 256; idx += 512) { const int t = idx >> 8, dd = idx & 255; const bf16* hr = C_HB + (size_t)(TP + n * 4 + t) * LDH + h * 256 + dd; qs[idx] = bf2f(hr[OC_Q]); ks[idx] = bf2f(hr[OC_K]); }
    for (int idx = tid; idx < 4 * 256; idx += 512) { const int t = idx >> 8, ee = idx & 255; vs[idx] = bf2f(C_HB[(size_t)(TP + n * 4 + t) * LDH + OC_V + h * 256 + ee]); }
    __syncthreads();
    if (tid < 16) { const int i = tid >> 2, j = tid & 3; float a = 0.f; for (int d = 0; d < 256; ++d) a += qs[i * 256 + d] * ks[j * 256 + d]; sc[tid] = (j <= i) ? a * exp2f(lg * (float)(i - j)) : 0.f; }
    __syncthreads();
    const int ee = tid & 255, dh = tid >> 8;
    const float* R0 = C_IN(7) + ((((size_t)o * 8 + n) * 6 + h) * 256) * 256; float* Rn = C_OUT + O_RET_S + ((((size_t)o * 8 + n) * 6 + h) * 256) * 256;
    const float g4 = exp2f(lg * 4.f), z0 = exp2f(lg * 3.f), z1 = exp2f(lg * 2.f), z2 = exp2f(lg), z3 = 1.0f;
    const float v0 = vs[ee] * z0, v1 = vs[256 + ee] * z1, v2 = vs[512 + ee] * z2, v3 = vs[768 + ee] * z3;
    float acc[4] = {0.f, 0.f, 0.f, 0.f};
#pragma unroll 1
    for (int d0 = dh * 128; d0 < dh * 128 + 128; d0 += 16) { float rv[16];
#pragma unroll
        for (int u = 0; u < 16; ++u) rv[u] = R0[(size_t)(d0 + u) * 256 + ee];
#pragma unroll
        for (int u = 0; u < 16; ++u) { const int d = d0 + u; const float r0 = rv[u];
            acc[0] += qs[d] * r0; acc[1] += qs[256 + d] * r0; acc[2] += qs[512 + d] * r0; acc[3] += qs[768 + d] * r0;
            Rn[(size_t)d * 256 + ee] = g4 * r0 + ks[d] * v0 + ks[256 + d] * v1 + ks[512 + d] * v2 + ks[768 + d] * v3; } }
#pragma unroll
    for (int i = 0; i < 4; ++i) red[(dh * 4 + i) * 256 + ee] = acc[i];
    __syncthreads();
    if (dh == 0) {
#pragma unroll
        for (int i = 0; i < 4; ++i) { float ov = (red[i * 256 + ee] + red[(4 + i) * 256 + ee]) * exp2f(lg * (float)(i + 1));
            for (int j = 0; j <= i; ++j) ov += sc[i * 4 + j] * vs[j * 256 + ee];
            C_YR[(size_t)(TP + n * 4 + i) * 1536 + h * 256 + ee] = (bf16)f2bf(ov); } }
    __syncthreads();
}
__device__ __forceinline__ void odd_helper_work(Ctx c, int l) {
    { pg8::Gemm g{C_XB, C_WTIN_L(l), MPAD, 4 * 256, DM}; pg8::StaticOrder S; S.init(MPAD, 4 * 256, c.G, c.bid, 0, 18); S.ex_n = 24; S.ex_pm0 = 0; S.ex_pn = 22;
        pg8::EpiBf16NP E{C_HB, LDH, C_TAB, 0, 1536};
        pg8::gemm_phase<pg8::EpiBf16NP, pg8::StaticOrder, true, true>(c.lds, g, S, E); }
    LAUNDER_C(c);
    mem_attn_all(c, l, OC_QM, OC_GM, 1536, ODD_OUT);
    LAUNDER_C(c);
    if (l < 3) convert_layer_weights(c, l + 1);
}
__device__ __forceinline__ void phase_odd_tok(Ctx c, int l) {
    const int o = l >> 1;
    if (c.G >= 256) {
        if (c.bid < 96) ret_prompt_unit(c, 12 * (c.bid & 7) + (c.bid >> 3), o);
        else { if (c.bid < 144) ret_sample_unit(c, c.bid - 96, o);
            Ctx h = c; h.bid = c.bid - 96; h.G = c.G - 96; LAUNDER_C(h); odd_helper_work(h, l); }
    } else {
        for (int it = c.bid; it < 144; it += c.G) { if (it < 96) ret_prompt_unit(c, it, o); else ret_sample_unit(c, it - 96, o); }
        LAUNDER_C(c);
        odd_helper_work(c, l);
    }
}
__device__ __forceinline__ void phase_odd_ubuild(const Ctx& c) {
    for (int R = c.bid * 8 + c.wave; R < TT; R += c.G * 8) {
        u32x2 ow[6], gw[6];
#pragma unroll
        for (int k = 0; k < 6; ++k) { const int col = k * 256 + 4 * c.lane; ow[k] = *(const u32x2*)(C_YR + (size_t)R * 1536 + col); gw[k] = *(const u32x2*)(C_HB + (size_t)R * LDH + OC_G + col); }
#pragma unroll
        for (int k = 0; k < 6; ++k) { const int col = k * 256 + 4 * c.lane; float o[4]; unpk4(ow[k], o);
            const float ss = wave_sum(o[0] * o[0] + o[1] * o[1] + o[2] * o[2] + o[3] * o[3]); const float scl = rsqrtf(ss * (1.0f / 256.0f) + 1e-6f);
            float g[4]; unpk4(gw[k], g);
            *(u32x2*)(C_U + (size_t)R * DM + col) = (u32x2){pk2(o[0] * scl * siluf_(g[0]), o[1] * scl * siluf_(g[1])), pk2(o[2] * scl * siluf_(g[2]), o[3] * scl * siluf_(g[3]))}; }
    }
}
__device__ __forceinline__ void small_outproj(const Ctx& c, int wt, int K, int l) {
    const int lane = c.lane, fr = lane & 15, fq = lane >> 4, kw = K >> 3, k0 = c.wave * kw;
    const bf16* ap = C_U + (size_t)(TP + fr) * K + k0 + 8 * fq; const bf16* bp = C_WTOUT_L(l) + (size_t)(16 * wt + fr) * K + k0 + 8 * fq;
    f32x4 acc[2] = {(f32x4){0.f, 0.f, 0.f, 0.f}, (f32x4){0.f, 0.f, 0.f, 0.f}};
    bf16x8 af[2][8], bf[8];
    if (kw == 256) {
#pragma unroll
        for (int ks = 0; ks < 8; ++ks) { af[0][ks] = *(const bf16x8*)(ap + 32 * ks); af[1][ks] = *(const bf16x8*)(ap + (size_t)16 * K + 32 * ks); bf[ks] = *(const bf16x8*)(bp + 32 * ks); }
#pragma unroll
        for (int ks = 0; ks < 8; ++ks) { acc[0] = mfma16(af[0][ks], bf[ks], acc[0]); acc[1] = mfma16(af[1][ks], bf[ks], acc[1]); }
    } else {
#pragma unroll
        for (int ks = 0; ks < 6; ++ks) { af[0][ks] = *(const bf16x8*)(ap + 32 * ks); af[1][ks] = *(const bf16x8*)(ap + (size_t)16 * K + 32 * ks); bf[ks] = *(const bf16x8*)(bp + 32 * ks); }
#pragma unroll
        for (int ks = 0; ks < 6; ++ks) { acc[0] = mfma16(af[0][ks], bf[ks], acc[0]); acc[1] = mfma16(af[1][ks], bf[ks], acc[1]); }
    }
    LAS float* part = (LAS float*)c.lds;
#pragma unroll
    for (int mt = 0; mt < 2; ++mt)
#pragma unroll
        for (int r = 0; r < 4; ++r) part[((c.wave * 2 + mt) * 4 + r) * 64 + lane] = acc[mt][r];
    __syncthreads();
    { const int idx = c.tid; float sum = 0.f;
#pragma unroll
        for (int w = 0; w < 8; ++w) sum += part[w * 512 + idx];
        const int mt = idx >> 8, r = (idx >> 6) & 3, ln = idx & 63, row = TP + 16 * mt + 4 * (ln >> 4) + r, col = 16 * wt + (ln & 15);
        const float xres = bf2f((unsigned)C_XB[(size_t)row * DM + col]);
        C_Z[(size_t)row * DM + col] = (bf16)f2bf(xres * ALPHA + sum); }
    __syncthreads();
}
__device__ __forceinline__ void phase_ln(const Ctx& c, int l) {
    const float* g = C_IN(15) + l * DM; const float* bta = C_IN(16) + l * DM;
    f32x4 gg[4][2], bb[4][2];
#pragma unroll
    for (int j = 0; j < 4; ++j)
#pragma unroll
        for (int q = 0; q < 2; ++q) { const int col = 8 * c.lane + 512 * j + 4 * q; gg[j][q] = *(const f32x4*)(g + col); bb[j][q] = *(const f32x4*)(bta + col); }
    for (int R0 = c.bid * 8 + c.wave; R0 < TT; R0 += 2 * c.G * 8) {
        const int R1 = R0 + c.G * 8; const bool has1 = R1 < TT; const int R1c = has1 ? R1 : R0;
        u32x4 w0[4], w1[4]; float v0[4][8], v1[4][8]; float s0 = 0.f, s1 = 0.f;
        { const u32x4* z0 = (const u32x4*)(C_Z + (size_t)R0 * DM) + c.lane; const u32x4* z1 = (const u32x4*)(C_Z + (size_t)R1c * DM) + c.lane;
#pragma unroll
            for (int j = 0; j < 4; ++j) { w0[j] = z0[64 * j]; w1[j] = z1[64 * j]; } }
#pragma unroll
        for (int j = 0; j < 4; ++j) { unpk8(w0[j], v0[j]); unpk8(w1[j], v1[j]);
#pragma unroll
            for (int i = 0; i < 8; i += 2) { s0 += v0[j][i] + v0[j][i + 1]; s1 += v1[j][i] + v1[j][i + 1]; } }
        const float m0 = wave_sum(s0) * (1.0f / DM), m1 = wave_sum(s1) * (1.0f / DM); float q0 = 0.f, q1 = 0.f;
#pragma unroll
        for (int j = 0; j < 4; ++j)
#pragma unroll
            for (int i = 0; i < 8; ++i) { v0[j][i] -= m0; v1[j][i] -= m1; q0 += v0[j][i] * v0[j][i]; q1 += v1[j][i] * v1[j][i]; }
        const float r0 = rsqrtf(wave_sum(q0) * (1.0f / DM) + LN_EPS), r1 = rsqrtf(wave_sum(q1) * (1.0f / DM) + LN_EPS);
        float* d0 = (R0 < TP ? C_OUT + O_YP + (size_t)R0 * DM : C_OUT + O_YS + (size_t)(R0 - TP) * DM);
        float* d1 = (R1c < TP ? C_OUT + O_YP + (size_t)R1c * DM : C_OUT + O_YS + (size_t)(R1c - TP) * DM);
#pragma unroll
        for (int j = 0; j < 4; ++j) { const int col = 8 * c.lane + 512 * j;
            { const f32x4 xa = (f32x4){v0[j][0], v0[j][1], v0[j][2], v0[j][3]} * r0 * gg[j][0] + bb[j][0], xb = (f32x4){v0[j][4], v0[j][5], v0[j][6], v0[j][7]} * r0 * gg[j][1] + bb[j][1];
                if (l == 3) { *(f32x4*)(d0 + col) = xa; *(f32x4*)(d0 + col + 4) = xb; } else *(u32x4*)(C_XB + (size_t)R0 * DM + col) = (u32x4){pk2(xa.x, xa.y), pk2(xa.z, xa.w), pk2(xb.x, xb.y), pk2(xb.z, xb.w)}; }
            if (has1) { const f32x4 xa = (f32x4){v1[j][0], v1[j][1], v1[j][2], v1[j][3]} * r1 * gg[j][0] + bb[j][0], xb = (f32x4){v1[j][4], v1[j][5], v1[j][6], v1[j][7]} * r1 * gg[j][1] + bb[j][1];
                if (l == 3) { *(f32x4*)(d1 + col) = xa; *(f32x4*)(d1 + col + 4) = xb; } else *(u32x4*)(C_XB + (size_t)R1 * DM + col) = (u32x4){pk2(xa.x, xa.y), pk2(xa.z, xa.w), pk2(xb.x, xb.y), pk2(xb.z, xb.w)}; } }
    }
}

#define XB_TMO      128
#define XB_XCNT(j)  (256  + 64 * (j))
#define XB_XSUB(j)  (1280 + 64 * (j))
#define XB_XGEN(j)  (2304 + 64 * (j))
#define XB_TOP      3328
#define XB_TOPGEN   3392
#define XCD_BAR_WORDS 3456
#define XB_SPIN_CAP (1u << 18)

__device__ __forceinline__ unsigned xb_ld(unsigned* p)              { return __hip_atomic_load(p, __ATOMIC_RELAXED, __HIP_MEMORY_SCOPE_AGENT); }
__device__ __forceinline__ unsigned xb_add(unsigned* p, unsigned v) { return __hip_atomic_fetch_add(p, v, __ATOMIC_RELAXED, __HIP_MEMORY_SCOPE_AGENT); }
__device__ __forceinline__ unsigned xb_xcc_id() { return (unsigned)__builtin_amdgcn_s_getreg((3 << 11) | 20) & 0xFu; }
#define XB_SPIN(cond, bar) do { unsigned _sp = 0; while (cond) { __builtin_amdgcn_s_sleep(1); \
    if ((++_sp & 255u) == 0u) { if (xb_ld(&(bar)[XB_TMO])) break; if (_sp > XB_SPIN_CAP) { atomicAdd(&(bar)[XB_TMO], 1u); break; } } } } while (0)

struct XcdBarrier {
    unsigned* bar; unsigned x;
    volatile LAS unsigned* st;
};

__device__ __forceinline__ XcdBarrier xcd_barrier_post(unsigned* bar, volatile LAS unsigned* st) {
    XcdBarrier b; b.bar = bar; b.x = xb_xcc_id(); b.st = st;
    if (threadIdx.x == 0) (void)xb_add(&bar[XB_XCNT(b.x)], 1u);
    return b;
}
__device__ __forceinline__ void xcd_barrier_complete(unsigned* bar, unsigned x, unsigned& nloc, unsigned& nx) {
    const unsigned G = gridDim.x * gridDim.y * gridDim.z;
    unsigned sum, cnt, mine, sp = 0u;
    for (;;) {
        sum = 0u; cnt = 0u; mine = 0u;
#pragma unroll
        for (unsigned j = 0; j < 16; ++j) { const unsigned c = xb_ld(&bar[XB_XCNT(j)]); sum += c; cnt += (c > 0u) ? 1u : 0u; mine = (j == x) ? c : mine; }
        if (sum == G) break;
        __builtin_amdgcn_s_sleep(1);
        if ((++sp & 255u) == 0u) { if (xb_ld(&bar[XB_TMO])) break; if (sp > XB_SPIN_CAP) { atomicAdd(&bar[XB_TMO], 1u); break; } }
    }
    nloc = mine > 0u ? mine : 1u; nx = cnt > 0u ? cnt : 1u;
}

__device__ __forceinline__ void xcd_barrier(const XcdBarrier& b) {
    asm volatile("s_waitcnt vmcnt(0)" ::: "memory");
    __syncthreads();
    if (threadIdx.x == 0) {
        unsigned* bar = b.bar;
        __builtin_amdgcn_s_waitcnt(0);
        unsigned nloc = b.st[0], nx = b.st[1];
        if (nloc == 0u) { xcd_barrier_complete(bar, b.x, nloc, nx); b.st[0] = nloc; b.st[1] = nx; }
        const unsigned old = xb_add(&bar[XB_XSUB(b.x)], 1u);
        const unsigned gen = old / nloc;
        if (old + 1u == (gen + 1u) * nloc) {
            __builtin_amdgcn_fence(__ATOMIC_RELEASE, "agent");
            asm volatile("s_waitcnt vmcnt(0)" ::: "memory");
            const unsigned og = xb_add(&bar[XB_TOP], 1u);
            const unsigned tg = og / nx;
            if (og + 1u == (tg + 1u) * nx) xb_add(&bar[XB_TOPGEN], 1u);
            else XB_SPIN(xb_ld(&bar[XB_TOPGEN]) == tg, bar);
            __builtin_amdgcn_fence(__ATOMIC_ACQUIRE, "agent");
            xb_add(&bar[XB_XGEN(b.x)], 1u);
            asm volatile("s_waitcnt vmcnt(0)" ::: "memory");
        } else {
            XB_SPIN(xb_ld(&bar[XB_XGEN(b.x)]) == gen, bar);
            __builtin_amdgcn_fence(__ATOMIC_ACQUIRE, "agent");
            asm volatile("s_waitcnt vmcnt(0)" ::: "memory");
        }
    }
    __syncthreads();
}

constexpr int NPH = 25;
__global__ void __launch_bounds__(512, 2) mk(Args args) {
    extern __shared__ __attribute__((aligned(16))) unsigned char lds_raw[];
    Ctx c;
    c.ap = (ArgsP)__builtin_amdgcn_kernarg_segment_ptr(); c.lds = (LAS unsigned char*)lds_raw;
    c.tid = threadIdx.x; c.lane = c.tid & 63; c.wave = __builtin_amdgcn_readfirstlane(c.tid >> 6); c.bid = blockIdx.x; c.G = gridDim.x;
    for (int u = c.tid; u < 16; u += 512) ((LAS unsigned*)(c.lds + XB_LDS_OFF))[u] = 0u;
    __syncthreads();
    XcdBarrier xbar = xcd_barrier_post((unsigned*)(c.ap->ws + WS_CTL) + 4096, (volatile LAS unsigned*)(c.lds + XB_LDS_OFF));
#define LAUNDER() do { asm volatile("" : "+s"(c.ap), "+v"(c.tid), "+s"(c.bid), "+s"(c.G)); c.lane = c.tid & 63; c.wave = __builtin_amdgcn_readfirstlane(c.tid >> 6); } while (0)
    const int lo = args.ph_lo, hi = args.ph_hi;
#define IN(k) (lo <= (k) && (k) < hi)
#if USE_CG
#define SEAM(k) do { if (IN(k) && IN((k) + 1)) { cg::this_grid().sync(); } } while (0)
#else
#define SEAM(k) do { if (IN(k) && IN((k) + 1)) { asm volatile("" : "+s"(xbar.bar)); xcd_barrier(xbar); } } while (0)
#endif
    #if !(DIS & 1)
    if (IN(0)) { for (int rep = 0; rep < ((DUP & 128) ? 2 : 1); ++rep) { LAUNDER(); phase_prologue(c); if (DUP & 128) { asm volatile("" : "+s"(xbar.bar)); xcd_barrier(xbar); } } }
#endif
    SEAM(0);
#pragma unroll 1
    for (int l = 0; l < 4; ++l) {
        const int p0 = 1 + 6 * l; const bool even = (l & 1) == 0;
#if !(DIS & 2)
        if (IN(p0)) { for (int rep = 0; rep < ((DUP & 16) ? 2 : 1); ++rep) { LAUNDER();
            { const int NI = even ? EVEN_INP : ODD_IN; const bool full = (c.G != 256);
                const int Ng = full ? NI : (even ? 23 * 256 : NI - 5 * 256);
                pg8::Gemm g{C_XB, C_WTIN_L(l), MPAD, Ng, DM}; pg8::StaticOrder S; S.init(MPAD, Ng, c.G, c.bid, (!even && !full) ? 18 : (1 << 30), (!even && !full) ? 5 : 0);
                if (!full) { S.ex_n = 9; S.ex_pm0 = even ? 0 : 24; S.ex_pn = even ? 23 : 22; }
                pg8::EpiBf16NP E{C_HB, LDH, C_TAB, even ? 0 : 3072, 1536};
                pg8::gemm_phase<pg8::EpiBf16NP, pg8::StaticOrder, true, true>(c.lds, g, S, E);
            }
            if (DUP & 16) { asm volatile("" : "+s"(xbar.bar)); xcd_barrier(xbar); }
        } }
#endif
        SEAM(p0);
#if !(DIS & 4)
        if (IN(p0 + 1)) { for (int rep = 0; rep < ((DUP & 1) ? 2 : 1); ++rep) { LAUNDER(); if (even) phase_even_tok_pre(c, l); if (DUP & 1) { asm volatile("" : "+s"(xbar.bar)); xcd_barrier(xbar); } } }
#endif
#if !(DIS & 8)
        if (IN(p0 + 1)) { LAUNDER(); if (!even) ret_s_prepass_block(c); }
#endif
        SEAM(p0 + 1);
#if !(DIS & 16)
        if (IN(p0 + 2)) { for (int rep = 0; rep < ((DUP & 4) ? 2 : 1); ++rep) { LAUNDER(); if (even) phase_even_scan(c, l); if (DUP & 4) { asm volatile("" : "+s"(xbar.bar)); xcd_barrier(xbar); } } }
#if !(DIS & 8)
        if (IN(p0 + 2)) { for (int rep = 0; rep < ((DUP & 2) ? 2 : 1); ++rep) { LAUNDER(); if (!even) phase_odd_tok(c, l); if (DUP & 2) { asm volatile("" : "+s"(xbar.bar)); xcd_barrier(xbar); } } }
#endif
#endif
        SEAM(p0 + 2);
#if !(DIS & 32)
        if (IN(p0 + 3)) { for (int rep = 0; rep < ((DUP & 8) ? 2 : 1); ++rep) { LAUNDER(); if (even) { phase_even_ubuild(c, l); LAUNDER(); even_combine_dil(c); } else phase_odd_ubuild(c); if (DUP & 8) { asm volatile("" : "+s"(xbar.bar)); xcd_barrier(xbar); } } }
#endif
        SEAM(p0 + 3);
#if !(DIS & 64)
        if (IN(p0 + 4)) { for (int rep = 0; rep < ((DUP & 32) ? 2 : 1); ++rep) { LAUNDER(); const int K = even ? EVEN_OUT : ODD_OUT;
            pg8::Gemm g{C_U, C_WTOUT_L(l), TP, DM, K}; pg8::StaticOrder S; S.init(TP, DM, c.G, c.bid); pg8::EpiResid E{C_XB, C_Z, DM, ALPHA};
            pg8::gemm_phase<pg8::EpiResid, pg8::StaticOrder, true, true>(c.lds, g, S, E);
            LAUNDER(); if (c.bid < 128) small_outproj(c, c.bid, K, l); if (DUP & 32) { asm volatile("" : "+s"(xbar.bar)); xcd_barrier(xbar); } } }
#endif
        SEAM(p0 + 4);
#if !(DIS & 128)
        if (IN(p0 + 5)) { for (int rep = 0; rep < ((DUP & 64) ? 2 : 1); ++rep) { LAUNDER(); phase_ln(c, l); if (DUP & 64) { asm volatile("" : "+s"(xbar.bar)); xcd_barrier(xbar); } } }
#endif
        SEAM(p0 + 5);
    }
#undef IN
#undef SEAM
}

extern "C" void kernel_launch(void* const* d_in, const int* in_sizes, int n_in, void* d_out, int out_size, void* d_ws, size_t ws_size, hipStream_t stream) {
    static int grid = 0;
    if (grid == 0) {
        if (n_in != 27 || (size_t)out_size != O_END || ws_size < WS_END) { fprintf(stderr, "kernel_launch: unexpected shapes: n_in %d out %d ws %zu (need %zu)\n", n_in, out_size, ws_size, (size_t)WS_END); grid = -1; return; }
        int dev = 0, cus = 0, per_cu = 0;
        hipGetDevice(&dev); hipDeviceGetAttribute(&cus, hipDeviceAttributeMultiprocessorCount, dev);
        if (hipFuncSetAttribute((const void*)mk, hipFuncAttributeMaxDynamicSharedMemorySize, LDS_BYTES) != hipSuccess) { fprintf(stderr, "kernel_launch: hipFuncSetAttribute failed\n"); grid = -1; return; }
        if (hipOccupancyMaxActiveBlocksPerMultiprocessor(&per_cu, (const void*)mk, 512, LDS_BYTES) != hipSuccess || per_cu < 1) { fprintf(stderr, "kernel_launch: occupancy query says %d\n", per_cu); per_cu = 1; }
        (void)hipGetLastError();
        grid = cus;
        fprintf(stderr, "kernel_launch: grid %d (cus %d, per_cu %d)\n", grid, cus, per_cu);
    }
    if (grid < 0) return;
    if (hipMemsetAsync((char*)d_ws + WS_CTL, 0, 32u << 10, stream)        != hipSuccess) { fprintf(stderr, "kernel_launch: memset failed\n"); return; }
    Args a{};
    for (int i = 0; i < 27; ++i) a.in[i] = (const float*)d_in[i];
    a.out = (float*)d_out; a.ws = (unsigned char*)d_ws;
#if ONE_LAUNCH
    a.ph_lo = 0; a.ph_hi = NPH;
    void* kargs[] = {&a};
    hipError_t e = hipLaunchCooperativeKernel((const void*)mk, dim3(grid), dim3(512), kargs, LDS_BYTES, stream);
    if (e != hipSuccess) fprintf(stderr, "kernel_launch: cooperative launch failed: %s\n", hipGetErrorString(e));
#else
    for (int p = 0; p < NPH; ++p) {
        if (p >= 1 && ((p - 1) % 6) == 2 && (((p - 1) / 6) & 1)) continue;
        a.ph_lo = p; a.ph_hi = p + 1;
        hipLaunchKernelGGL(mk, dim3(grid), dim3(512), LDS_BYTES, stream, a);
    }
#endif
}
```
